# Optimizing an MI355X kernel written in HIP

```python
import math
import jax
import jax.numpy as jnp
from jax import lax
import numpy as np

D_MODEL = 1024
BATCH = 8
SEQ = 8192
DEPTH = 2

GRID_W = 64
CTX_LEN = 256
HEAD_DIM = 64
F32 = jnp.float32
RG_WIDTH = 256
RG_BLOCKS = 4
RG_BLOCK = RG_WIDTH // RG_BLOCKS
RG_CONV = 4
RG_C = 8.0
NA_HEADS = 6
NA_WIDTH = NA_HEADS * HEAD_DIM
NA_WIN_R = 8
NA_WIN_C = 16
GQA_HEADS = 6
GQA_KV_HEADS = 2
GQA_GROUP = GQA_HEADS // GQA_KV_HEADS
GQA_WIDTH = GQA_HEADS * HEAD_DIM
GQA_KV_WIDTH = GQA_KV_HEADS * HEAD_DIM
GQA_WINDOW = 128
GQA_BLOCK = 128
ROPE_BASE = 10000.0
KV_SIZES = (RG_WIDTH, NA_WIDTH, NA_WIDTH, GQA_KV_WIDTH, GQA_KV_WIDTH)
Q_SIZES = (RG_WIDTH, NA_WIDTH, GQA_WIDTH)
PROJ_KV = sum(KV_SIZES)
PROJ_WIDTH = PROJ_KV + sum(Q_SIZES)
MIX_WIDTH = RG_WIDTH + NA_WIDTH + GQA_WIDTH
N_GROUPS = 4
EXPERTS_PER_GROUP = 8
N_EXPERTS = N_GROUPS * EXPERTS_PER_GROUP
TOP_K = 2
EXPERT_FF = 512
MOE_BLOCK = 128
DN_ALPHA = (2 * DEPTH) ** 0.25
DN_BETA = (8 * DEPTH) ** -0.25
LN_EPS = 1e-5

kernel_name = 'hymba_style_rglru_na_swa_hmoe_diffusion_block'


def layer_norm(x, g, b):
    xf = x.astype(F32)
    mu = jnp.mean(xf, -1, keepdims=True)
    var = jnp.mean(jnp.square(xf - mu), -1, keepdims=True)
    return ((xf - mu) * lax.rsqrt(var + LN_EPS) * g + b).astype(x.dtype)


def modulate(x, shift, scale):
    return x * (1 + scale) + shift


def split_cols(p, sizes):
    idx = np.cumsum(sizes)[:-1].tolist()
    return jnp.split(p, idx, axis=-1)


def heads(t, n):
    return t.reshape(t.shape[:-1] + (n, HEAD_DIM))


def centred_dwconv(x, w, b):
    y = lax.conv_general_dilated(x, w[:, None, :].astype(x.dtype), window_strides=(1,),
                                 padding=[(RG_CONV // 2, RG_CONV - 1 - RG_CONV // 2)],
                                 dimension_numbers=('NWC', 'WIO', 'NWC'),
                                 feature_group_count=x.shape[-1])
    return y + b


def block_diag(x, w, b):
    xs = x.reshape(x.shape[:-1] + (RG_BLOCKS, RG_BLOCK))
    return jnp.einsum('blnd,nde->blne', xs, w).reshape(x.shape) + b


def rglru_coeffs(x, wa, ba, wi, bi, lam):
    r = jax.nn.sigmoid(block_diag(x, wa, ba).astype(F32))
    i = jax.nn.sigmoid(block_diag(x, wi, bi).astype(F32))
    log_a = -RG_C * r * jax.nn.softplus(-lam.astype(F32))
    a = jnp.exp(log_a)
    b = jnp.sqrt(-jnp.expm1(2.0 * log_a)) * (i * x.astype(F32))
    return a, b


def _combine(left, right):
    a_l, b_l = left
    a_r, b_r = right
    return a_l * a_r, a_r * b_l + b_r


def linear_scan(a, b, h0):
    a_cum, b_cum = lax.associative_scan(_combine, (a, b), axis=1)
    return a_cum * h0[:, None] + b_cum


def rglru_mixer(x_lat, x_ctx, gate_lat, gate_ctx, conv_w, conv_b, wa, ba, wi, bi, lam):
    xl = centred_dwconv(x_lat, conv_w, conv_b)
    xc = centred_dwconv(x_ctx, conv_w, conv_b)
    h0 = jnp.zeros((xl.shape[0], RG_WIDTH), F32)
    a_c, b_c = rglru_coeffs(xc, wa[0], ba[0], wi[0], bi[0], lam[0])
    a_l, b_l = rglru_coeffs(xl, wa[0], ba[0], wi[0], bi[0], lam[0])
    hc_f = linear_scan(a_c, b_c, h0)
    hl_f = linear_scan(a_l, b_l, hc_f[:, -1])
    a_c, b_c = rglru_coeffs(xc[:, ::-1], wa[1], ba[1], wi[1], bi[1], lam[1])
    a_l, b_l = rglru_coeffs(xl[:, ::-1], wa[1], ba[1], wi[1], bi[1], lam[1])
    hc_b = linear_scan(a_c, b_c, h0)
    hl_b = linear_scan(a_l, b_l, hc_b[:, -1])[:, ::-1]
    y_lat = (hl_f + hl_b).astype(x_lat.dtype) * jax.nn.gelu(gate_lat)
    if gate_ctx is None:
        return y_lat, None
    y_ctx = (hc_f + hc_b[:, ::-1]).astype(x_ctx.dtype) * jax.nn.gelu(gate_ctx)
    return y_lat, y_ctx


def axial_rope(x, row, col):
    half = x.shape[-1] // 2
    quarter = half // 2
    inv = ROPE_BASE ** (-jnp.arange(quarter, dtype=F32) / quarter)

    def rot(xp, pos):
        ang = pos.astype(F32)[:, None] * inv
        cos = jnp.cos(ang)[None, :, None]
        sin = jnp.sin(ang)[None, :, None]
        x1 = xp[..., :quarter].astype(F32)
        x2 = xp[..., quarter:].astype(F32)
        return jnp.concatenate([x1 * cos - x2 * sin, x2 * cos + x1 * sin], -1)

    return jnp.concatenate([rot(x[..., :half], row), rot(x[..., half:], col)], -1).astype(x.dtype)


def ctx_attention(q, k, v, sink):
    B, C, H, dh = q.shape
    hk = k.shape[2]
    g = H // hk
    qg = q.reshape(B, C, hk, g, dh)
    s = jnp.einsum('bqkgd,bjkd->bkgqj', qg, k).astype(F32) * dh ** -0.5
    if sink is None:
        p = jax.nn.softmax(s, -1)
    else:
        sink_col = jnp.broadcast_to(sink.astype(F32).reshape(1, hk, g, 1, 1), (B, hk, g, C, 1))
        p = jax.nn.softmax(jnp.concatenate([s, sink_col], -1), -1)[..., :-1]
    o = jnp.einsum('bkgqj,bjkd->bqkgd', p.astype(v.dtype), v)
    return o.reshape(B, C, H * dh)


def neighbourhood_attention(q, k, v, k_ctx, v_ctx, rpb):
    B, S, H, dh = q.shape
    rows = S // GRID_W
    wr = min(NA_WIN_R, rows)
    n_nb = wr * NA_WIN_C
    qg = q.reshape(B, rows, GRID_W, H, dh)
    kg = k.reshape(B, rows, GRID_W, H, dh)
    vg = v.reshape(B, rows, GRID_W, H, dh)
    cols = jnp.arange(GRID_W)
    col_idx = jnp.clip(cols - NA_WIN_C // 2, 0, GRID_W - NA_WIN_C)[:, None] + jnp.arange(NA_WIN_C)
    col_bias_idx = col_idx - cols[:, None] + NA_WIN_C - 1
    rpb_f = rpb.astype(F32)
    scale = dh ** -0.5

    def row_block(args):
        r, q_row = args
        rs = jnp.clip(r - NA_WIN_R // 2, 0, rows - wr)
        k_rows = lax.dynamic_slice_in_dim(kg, rs, wr, axis=1)
        v_rows = lax.dynamic_slice_in_dim(vg, rs, wr, axis=1)
        k_win = k_rows[:, :, col_idx]
        v_win = v_rows[:, :, col_idx]
        row_bias_idx = rs + jnp.arange(wr) - r + NA_WIN_R - 1
        bias = rpb_f[:, row_bias_idx][:, :, col_bias_idx].transpose(0, 2, 1, 3)
        s_nb = jnp.einsum('bqhd,brqchd->bhqrc', q_row, k_win).astype(F32) * scale + bias
        s_cx = jnp.einsum('bqhd,bkhd->bhqk', q_row, k_ctx).astype(F32) * scale
        s = jnp.concatenate([s_nb.reshape(B, H, GRID_W, n_nb), s_cx], -1)
        p = jax.nn.softmax(s, -1).astype(v.dtype)
        p_nb = p[..., :n_nb].reshape(B, H, GRID_W, wr, NA_WIN_C)
        return (jnp.einsum('bhqrc,brqchd->bqhd', p_nb, v_win)
                + jnp.einsum('bhqk,bkhd->bqhd', p[..., n_nb:], v_ctx))

    o = lax.map(row_block, (jnp.arange(rows), jnp.moveaxis(qg, 1, 0)))
    return jnp.moveaxis(o, 0, 1).reshape(B, S, H * dh)


def window_gqa(q, k, v, k_ctx, v_ctx, sink):
    B, S, H, dh = q.shape
    n_blk = S // GQA_BLOCK
    span = GQA_BLOCK + 2 * GQA_WINDOW
    C = k_ctx.shape[1]
    qb = q.reshape(B, n_blk, GQA_BLOCK, GQA_KV_HEADS, GQA_GROUP, dh)
    pad = ((0, 0), (GQA_WINDOW, GQA_WINDOW), (0, 0), (0, 0))
    k_pad = jnp.pad(k, pad)
    v_pad = jnp.pad(v, pad)
    sink_col = jnp.broadcast_to(sink.astype(F32).reshape(1, GQA_KV_HEADS, GQA_GROUP, 1, 1),
                                (B, GQA_KV_HEADS, GQA_GROUP, GQA_BLOCK, 1))
    scale = dh ** -0.5

    def block(args):
        bi, q_blk = args
        start = bi * GQA_BLOCK
        k_w = lax.dynamic_slice_in_dim(k_pad, start, span, axis=1)
        v_w = lax.dynamic_slice_in_dim(v_pad, start, span, axis=1)
        qpos = start + jnp.arange(GQA_BLOCK)
        kpos = start - GQA_WINDOW + jnp.arange(span)
        valid = (jnp.abs(qpos[:, None] - kpos[None, :]) <= GQA_WINDOW) & (kpos >= 0) & (kpos < S)
        s_loc = jnp.einsum('bqkgd,bjkd->bkgqj', q_blk, k_w).astype(F32) * scale
        s_loc = jnp.where(valid, s_loc, -jnp.inf)
        s_cx = jnp.einsum('bqkgd,bjkd->bkgqj', q_blk, k_ctx).astype(F32) * scale
        p = jax.nn.softmax(jnp.concatenate([s_loc, s_cx, sink_col], -1), -1).astype(v.dtype)
        return (jnp.einsum('bkgqj,bjkd->bqkgd', p[..., :span], v_w)
                + jnp.einsum('bkgqj,bjkd->bqkgd', p[..., span:span + C], v_ctx))

    o = lax.map(block, (jnp.arange(n_blk), jnp.moveaxis(qb, 1, 0)))
    return jnp.moveaxis(o, 0, 1).reshape(B, S, H * dh)


def mixer(h_lat, h_ctx, row, col, w_in, conv_w, conv_b, rg_a_w, rg_a_b, rg_i_w, rg_i_b, rg_lambda,
          na_rpb, gqa_sink, w_out, need_ctx):
    p_lat = h_lat @ w_in
    p_ctx = h_ctx @ (w_in if need_ctx else w_in[:, :PROJ_KV])
    rg_x, na_k, na_v, g_k, g_v, rg_gate, na_q, g_q = split_cols(p_lat, KV_SIZES + Q_SIZES)
    c_rg_x, c_na_k, c_na_v, c_g_k, c_g_v = split_cols(p_ctx[..., :PROJ_KV], KV_SIZES)
    c_rg_gate = None
    if need_ctx:
        c_rg_gate, c_na_q, c_g_q = split_cols(p_ctx[..., PROJ_KV:], Q_SIZES)
    y_rg, y_rg_c = rglru_mixer(rg_x, c_rg_x, rg_gate, c_rg_gate, conv_w, conv_b,
                               rg_a_w, rg_a_b, rg_i_w, rg_i_b, rg_lambda)
    k_na_c = heads(c_na_k, NA_HEADS)
    v_na_c = heads(c_na_v, NA_HEADS)
    k_ga_c = heads(c_g_k, GQA_KV_HEADS)
    v_ga_c = heads(c_g_v, GQA_KV_HEADS)
    o_na = neighbourhood_attention(heads(na_q, NA_HEADS), heads(na_k, NA_HEADS), heads(na_v, NA_HEADS),
                                   k_na_c, v_na_c, na_rpb)
    o_ga = window_gqa(axial_rope(heads(g_q, GQA_HEADS), row, col),
                      axial_rope(heads(g_k, GQA_KV_HEADS), row, col),
                      heads(g_v, GQA_KV_HEADS), k_ga_c, v_ga_c, gqa_sink)
    out_lat = jnp.concatenate([y_rg, o_na, o_ga], -1) @ w_out
    if not need_ctx:
        return out_lat, None
    o_na_c = ctx_attention(heads(c_na_q, NA_HEADS), k_na_c, v_na_c, None)
    o_ga_c = ctx_attention(heads(c_g_q, GQA_HEADS), k_ga_c, v_ga_c, gqa_sink)
    out_ctx = jnp.concatenate([y_rg_c, o_na_c, o_ga_c], -1) @ w_out
    return out_lat, out_ctx


def hier_route(h, wg, bg, we, be):
    pg = jax.nn.softmax((h @ wg).astype(F32) + bg.astype(F32), -1)
    p_top_g, g_idx = lax.top_k(pg, 1)
    le = ((h @ we).astype(F32) + be.astype(F32)).reshape(-1, N_GROUPS, EXPERTS_PER_GROUP)
    le_g = jnp.take_along_axis(le, g_idx[:, :, None], axis=1)[:, 0]
    top_l, e_local = lax.top_k(le_g, TOP_K)
    w = jax.nn.softmax(top_l, -1) * p_top_g
    return g_idx * EXPERTS_PER_GROUP + e_local, w


def hier_moe(h, wg, bg, we, be, w_gate, w_up, w_down):
    N, D = h.shape
    expert_id, gate = hier_route(h, wg, bg, we, be)
    M = N * TOP_K
    flat_e = expert_id.reshape(M)
    flat_tok = jnp.arange(M, dtype=jnp.int32) // TOP_K
    flat_w = gate.reshape(M)
    order = jnp.argsort(flat_e, stable=True)
    se, stok, sw = flat_e[order], flat_tok[order], flat_w[order]
    counts = jnp.bincount(flat_e, length=N_EXPERTS)
    padded = (counts + MOE_BLOCK - 1) // MOE_BLOCK * MOE_BLOCK
    end_pad = jnp.cumsum(padded)
    start_pad = end_pad - padded
    start_sorted = jnp.cumsum(counts) - counts
    dest = start_pad[se] + jnp.arange(M, dtype=jnp.int32) - start_sorted[se]
    cap = -(-M // MOE_BLOCK) * MOE_BLOCK + N_EXPERTS * MOE_BLOCK
    n_blk = cap // MOE_BLOCK
    slot_tok = jnp.full((cap,), N, jnp.int32).at[dest].set(stok)
    slot_w = jnp.zeros((cap,), F32).at[dest].set(sw)
    blk_e = jnp.minimum(jnp.searchsorted(end_pad, jnp.arange(n_blk, dtype=jnp.int32) * MOE_BLOCK,
                                         side='right'), N_EXPERTS - 1)
    h_pad = jnp.concatenate([h, jnp.zeros((1, D), h.dtype)], 0)
    xb = h_pad[slot_tok].reshape(n_blk, MOE_BLOCK, D)

    def expert_block(args):
        xe, e = args
        return (jax.nn.silu(xe @ w_gate[e]) * (xe @ w_up[e])) @ w_down[e]

    yb = lax.map(expert_block, (xb, blk_e)).reshape(cap, D)
    out = jnp.zeros((N + 1, D), yb.dtype).at[slot_tok].add(yb * slot_w[:, None].astype(yb.dtype))
    return out[:N]


def setup_inputs(seed: int = 0) -> dict:
    key = jax.random.key(seed)
    ks = iter(jax.random.split(key, 40))
    L, D = DEPTH, D_MODEL

    def nrm(shape, s):
        return jax.random.normal(next(ks), shape, F32) * s

    u = jax.random.uniform(next(ks), (L, 2, RG_WIDTH), F32, minval=0.9, maxval=0.999)
    a0 = u ** (1.0 / RG_C)
    rg_lambda = jnp.log(a0) - jnp.log1p(-a0)
    return {
        'x': nrm((BATCH, SEQ, D), 1.0),
        'c': nrm((BATCH, D), 1.0),
        'ctx': nrm((BATCH, CTX_LEN, D), 1.0),
        'c_ctx': nrm((D,), 1.0),
        'w_ada': nrm((L, D, 6 * D), 0.5 * D ** -0.5),
        'b_ada': nrm((L, 6 * D), 0.02),
        'w_in': nrm((L, D, PROJ_WIDTH), D ** -0.5),
        'conv_w': nrm((L, RG_CONV, RG_WIDTH), RG_CONV ** -0.5),
        'conv_b': nrm((L, RG_WIDTH), 0.02),
        'rg_a_w': nrm((L, 2, RG_BLOCKS, RG_BLOCK, RG_BLOCK), RG_BLOCK ** -0.5),
        'rg_a_b': nrm((L, 2, RG_WIDTH), 0.02),
        'rg_i_w': nrm((L, 2, RG_BLOCKS, RG_BLOCK, RG_BLOCK), RG_BLOCK ** -0.5),
        'rg_i_b': nrm((L, 2, RG_WIDTH), 0.02),
        'rg_lambda': rg_lambda,
        'na_rpb': nrm((L, NA_HEADS, 2 * NA_WIN_R - 1, 2 * NA_WIN_C - 1), 0.1),
        'gqa_sink': nrm((L, GQA_HEADS), 0.5),
        'w_out': nrm((L, MIX_WIDTH, D), DN_BETA * MIX_WIDTH ** -0.5),
        'ln1_g': 1.0 + nrm((L, D), 0.05),
        'ln1_b': nrm((L, D), 0.02),
        'router_g_w': nrm((L, D, N_GROUPS), D ** -0.5),
        'router_g_b': nrm((L, N_GROUPS), 0.01),
        'router_e_w': nrm((L, D, N_EXPERTS), D ** -0.5),
        'router_e_b': nrm((L, N_EXPERTS), 0.01),
        'exp_w_gate': nrm((L, N_EXPERTS, D, EXPERT_FF), D ** -0.5),
        'exp_w_up': nrm((L, N_EXPERTS, D, EXPERT_FF), D ** -0.5),
        'exp_w_down': nrm((L, N_EXPERTS, EXPERT_FF, D), DN_BETA * EXPERT_FF ** -0.5),
        'ln2_g': 1.0 + nrm((L, D), 0.05),
        'ln2_b': nrm((L, D), 0.02),
    }


def reference(x, c, ctx, c_ctx, w_ada, b_ada, w_in, conv_w, conv_b, rg_a_w, rg_a_b, rg_i_w, rg_i_b,
              rg_lambda, na_rpb, gqa_sink, w_out, ln1_g, ln1_b, router_g_w, router_g_b, router_e_w,
              router_e_b, exp_w_gate, exp_w_up, exp_w_down, ln2_g, ln2_b):
    B, S, D = x.shape
    C = ctx.shape[1]
    t = jnp.arange(S, dtype=jnp.int32)
    row, col = t // GRID_W, t % GRID_W
    silu_c = jax.nn.silu(c)
    silu_cc = jax.nn.silu(c_ctx)
    x_lat, x_ctx = x, ctx
    for l in range(DEPTH):
        need_ctx = l < DEPTH - 1
        mod = (silu_c @ w_ada[l] + b_ada[l])[:, None, :]
        mod_c = silu_cc @ w_ada[l] + b_ada[l]
        sh1, sc1, g1, sh2, sc2, g2 = jnp.split(mod, 6, -1)
        csh1, csc1, cg1, csh2, csc2, cg2 = jnp.split(mod_c, 6, -1)
        mix_lat, mix_ctx = mixer(modulate(x_lat, sh1, sc1), modulate(x_ctx, csh1, csc1), row, col,
                                 w_in[l], conv_w[l], conv_b[l], rg_a_w[l], rg_a_b[l], rg_i_w[l], rg_i_b[l],
                                 rg_lambda[l], na_rpb[l], gqa_sink[l], w_out[l], need_ctx)
        x_lat = layer_norm(DN_ALPHA * x_lat + g1 * mix_lat, ln1_g[l], ln1_b[l])
        h2 = modulate(x_lat, sh2, sc2).reshape(B * S, D)
        if need_ctx:
            x_ctx = layer_norm(DN_ALPHA * x_ctx + cg1 * mix_ctx, ln1_g[l], ln1_b[l])
            h2 = jnp.concatenate([h2, modulate(x_ctx, csh2, csc2).reshape(B * C, D)], 0)
        f = hier_moe(h2, router_g_w[l], router_g_b[l], router_e_w[l], router_e_b[l],
                     exp_w_gate[l], exp_w_up[l], exp_w_down[l])
        x_lat = layer_norm(DN_ALPHA * x_lat + g2 * f[:B * S].reshape(B, S, D), ln2_g[l], ln2_b[l])
        if need_ctx:
            x_ctx = layer_norm(DN_ALPHA * x_ctx + cg2 * f[B * S:].reshape(B, C, D), ln2_g[l], ln2_b[l])
    return x_lat
```

```cpp
#include <hip/hip_runtime.h>
#include <stdint.h>
#include <cstdio>

typedef unsigned short bf16_t;
typedef short bf16x8 __attribute__((ext_vector_type(8)));
typedef float f32x4 __attribute__((ext_vector_type(4)));

#define DEV __device__ __forceinline__

constexpr int D = 1024, NB = 8, S = 8192, CTX = 256;
constexpr int NLAT = NB * S, NCTX = NB * CTX, NTOK = NLAT + NCTX;
constexpr int PWS = 1792;
constexpr int COL_RGX = 0, COL_NAK = 256, COL_GK = 640, COL_GATE = 768, COL_NAQ = 1024, COL_GQ = 1408;
constexpr int NE = 32, FF = 512;
constexpr int LISTCAP = NTOK;
constexpr float ALPHA = 1.4142135623730951f;
constexpr float LN_EPS = 1e-5f;

constexpr size_t al256(size_t x) { return (x + 255) & ~(size_t)255; }
constexpr size_t OFF_CTL   = 0;
constexpr size_t CTL_BYTES = 4096;
constexpr size_t OFF_MOD   = OFF_CTL + CTL_BYTES;
constexpr size_t OFF_ROPE  = al256(OFF_MOD + (size_t)2 * 9 * 6144 * 4);
constexpr size_t OFF_RTE   = al256(OFF_ROPE + (size_t)2 * 128 * 16 * 4);
constexpr size_t OFF_RTW   = al256(OFF_RTE + (size_t)NTOK * 8);
constexpr size_t OFF_LIST  = al256(OFF_RTW + (size_t)NTOK * 8);
constexpr size_t OFF_WR    = al256(OFF_LIST + (size_t)NE * LISTCAP * 4);
constexpr size_t OFF_WINT  = al256(OFF_WR + (size_t)2 * 2 * 48 * 1024 * 2);
constexpr size_t OFF_WOUTT = al256(OFF_WINT + (size_t)2 * 2304 * 1024 * 2);
constexpr size_t OFF_WGU   = al256(OFF_WOUTT + (size_t)2 * 1024 * 1024 * 2);
constexpr size_t OFF_WD    = al256(OFF_WGU + (size_t)NE * 1024 * 1024 * 2);
constexpr size_t OFF_XCTX  = al256(OFF_WD + (size_t)NE * 1024 * 512 * 2);
constexpr size_t OFF_X1    = al256(OFF_XCTX + (size_t)NCTX * D * 4);
constexpr size_t OFF_X2    = al256(OFF_X1 + (size_t)NTOK * D * 2);
constexpr size_t OFF_P     = al256(OFF_X2 + (size_t)NTOK * D * 2);
constexpr size_t OFF_NAVT  = al256(OFF_P + (size_t)NTOK * PWS * 2);
constexpr size_t OFF_NAVTC = al256(OFF_NAVT + (size_t)NB * 6 * 64 * S * 2);
constexpr size_t OFF_GVT   = al256(OFF_NAVTC + (size_t)NB * 6 * 64 * CTX * 2);
constexpr size_t OFF_GVTC  = al256(OFF_GVT + (size_t)NB * 2 * 64 * S * 2);
constexpr size_t OFF_Y     = al256(OFF_GVTC + (size_t)NB * 2 * 64 * CTX * 2);
constexpr size_t WS_TOTAL  = al256(OFF_Y + (size_t)2 * NTOK * D * 2);
constexpr int CW_CNT = 0;

struct Params {
    const float *x, *c, *ctx, *c_ctx, *w_ada, *b_ada, *w_in, *conv_w, *conv_b, *rg_a_w, *rg_a_b, *rg_i_w, *rg_i_b, *rg_lambda,
        *na_rpb, *gqa_sink, *w_out, *ln1_g, *ln1_b, *router_g_w, *router_g_b, *router_e_w, *router_e_b, *exp_w_gate, *exp_w_up,
        *exp_w_down, *ln2_g, *ln2_b;
    float* out;
    unsigned char* ws;
};

DEV float bf2f(bf16_t h) { return __uint_as_float((unsigned)h << 16); }
DEV bf16_t f2bf(float f) { unsigned u = __float_as_uint(f); u += 0x7fffu + ((u >> 16) & 1u); return (bf16_t)(u >> 16); }
DEV unsigned pk2(float lo, float hi) { return (unsigned)f2bf(lo) | ((unsigned)f2bf(hi) << 16); }
DEV float wave_sum(float v) {
#pragma unroll
    for (int o = 1; o < 64; o <<= 1) v += __shfl_xor(v, o);
    return v;
}
DEV float wave_max(float v) {
#pragma unroll
    for (int o = 1; o < 64; o <<= 1) v = fmaxf(v, __shfl_xor(v, o));
    return v;
}
DEV float sigmoidf_(float x) { return 1.f / (1.f + __expf(-x)); }
DEV float gelu_tanh(float x) {
    const float u = 0.7978845608028654f * (x + 0.044715f * x * x * x);
    const float t = 1.f - 2.f / (1.f + __expf(2.f * u));
    return 0.5f * x * (1.f + t);
}
DEV float* xres_row(const Params& p, int R) {
    return R < NLAT ? p.out + (size_t)R * D : (float*)(p.ws + OFF_XCTX) + (size_t)(R - NLAT) * D;
}
DEV const float* modvec(const Params& p, int l, int R, int seg) {
    const int b = R < NLAT ? R / S : 8;
    return (const float*)(p.ws + OFF_MOD) + ((size_t)(l * 9 + b) * 6 + seg) * 1024;
}

__global__ void __launch_bounds__(256) k_mod(Params p) {
    __shared__ float sc[9 * 1024];
    for (int i = threadIdx.x; i < 9 * 1024; i += 256) { const float v = (i < 8192) ? p.c[i] : p.c_ctx[i - 8192]; sc[i] = v / (1.f + expf(-v)); }
    __syncthreads();
    const int col = blockIdx.x * 256 + threadIdx.x;
    const int l = col / 6144, j = col % 6144;
    const float* w = p.w_ada + (size_t)l * 1024 * 6144 + j;
    float a0 = 0, a1 = 0, a2 = 0, a3 = 0, a4 = 0, a5 = 0, a6 = 0, a7 = 0, a8 = 0;
    for (int k = 0; k < 1024; ++k) {
        const float wv = w[(size_t)k * 6144];
        a0 += sc[k] * wv; a1 += sc[1024 + k] * wv; a2 += sc[2048 + k] * wv; a3 += sc[3072 + k] * wv; a4 += sc[4096 + k] * wv;
        a5 += sc[5120 + k] * wv; a6 += sc[6144 + k] * wv; a7 += sc[7168 + k] * wv; a8 += sc[8192 + k] * wv;
    }
    const float bias = p.b_ada[l * 6144 + j];
    float* mod = (float*)(p.ws + OFF_MOD) + (size_t)l * 9 * 6144 + j;
    mod[0 * 6144] = a0 + bias; mod[1 * 6144] = a1 + bias; mod[2 * 6144] = a2 + bias; mod[3 * 6144] = a3 + bias; mod[4 * 6144] = a4 + bias;
    mod[5 * 6144] = a5 + bias; mod[6 * 6144] = a6 + bias; mod[7 * 6144] = a7 + bias; mod[8 * 6144] = a8 + bias;
}

DEV void sincos_red(float ang, float& sn, float& cs) {
    const float n = rintf(ang * 0.15915494309189535f);
    float r = fmaf(-n, 6.2831854820251465f, ang);
    r = fmaf(-n, -1.7484555e-07f, r);
    float sgn = 1.f;
    if (r > 1.5707963267948966f) { r = 3.14159265358979f - r; sgn = -1.f; }
    else if (r < -1.5707963267948966f) { r = -3.14159265358979f - r; sgn = -1.f; }
    const float r2 = r * r;
    float sp = -1.6059044e-10f; sp = fmaf(sp, r2, 2.5052108e-08f); sp = fmaf(sp, r2, -2.7557319e-06f); sp = fmaf(sp, r2, 1.9841270e-04f);
    sp = fmaf(sp, r2, -8.3333333e-03f); sp = fmaf(sp, r2, 1.6666667e-01f); sp = fmaf(sp * -1.f, r2, 1.f);
    sn = r * sp;
    float cp = -1.1470746e-11f; cp = fmaf(cp, r2, 2.0876757e-09f); cp = fmaf(cp, r2, -2.7557319e-07f); cp = fmaf(cp, r2, 2.4801587e-05f);
    cp = fmaf(cp, r2, -1.3888889e-03f); cp = fmaf(cp, r2, 4.1666667e-02f); cp = fmaf(cp, r2, -0.5f); cp = fmaf(cp, r2, 1.f);
    cs = sgn * cp;
}
__global__ void __launch_bounds__(256) k_rope(Params p) {
    const int i = blockIdx.x * 256 + threadIdx.x;
    if (i >= 128 * 16) return;
    const int pos = i >> 4, q = i & 15;
    const float inv = exp2f(-(float)q * (13.287712379549449f / 16.f));
    float sn, cs; sincos_red((float)pos * inv, sn, cs);
    float* tab = (float*)(p.ws + OFF_ROPE);
    tab[i] = cs; tab[2048 + i] = sn;
}

__global__ void __launch_bounds__(256) k_routerw(Params p) {
    const int i = blockIdx.x * 256 + threadIdx.x;
    if (i >= 2 * 48 * 1024) return;
    const int l = i / (48 * 1024), f = (i / 1024) % 48, k = i & 1023;
    float w = 0.f;
    if (f < 4) w = p.router_g_w[((size_t)l * 1024 + k) * 4 + f]; else if (f < 36) w = p.router_e_w[((size_t)l * 1024 + k) * 32 + (f - 4)];
    const bf16_t hi = f2bf(w), lo = f2bf(w - bf2f(hi));
    bf16_t* WR = (bf16_t*)(p.ws + OFF_WR);
    WR[((size_t)(l * 2 + 0) * 48 + f) * 1024 + k] = hi;
    WR[((size_t)(l * 2 + 1) * 48 + f) * 1024 + k] = lo;
}

DEV int tr_row(int n, int mode) { return mode == 0 ? n : ((n >> 7) * 256 + ((n >> 6) & 1) * 128 + (n & 63) + (mode == 2 ? 64 : 0)); }
DEV void transpose_tile(const float* src, bf16_t* dst, int K, int N, int mode, int tile, float* lds) {
    const int ntn = N >> 6, kt = tile / ntn, nt = tile % ntn, k0 = kt * 64, n0 = nt * 64, t = threadIdx.x;
#pragma unroll
    for (int i = 0; i < 4; ++i) {
        const int r = (t >> 4) + 16 * i, c4 = (t & 15) * 4;
        const float4 v = *(const float4*)(src + (size_t)(k0 + r) * N + n0 + c4);
        lds[r * 65 + c4] = v.x; lds[r * 65 + c4 + 1] = v.y; lds[r * 65 + c4 + 2] = v.z; lds[r * 65 + c4 + 3] = v.w;
    }
    __syncthreads();
#pragma unroll
    for (int i = 0; i < 2; ++i) {
        const int n = (t >> 3) + 32 * i, kc = (t & 7) * 8;
        uint4 o;
        o.x = pk2(lds[(kc + 0) * 65 + n], lds[(kc + 1) * 65 + n]); o.y = pk2(lds[(kc + 2) * 65 + n], lds[(kc + 3) * 65 + n]);
        o.z = pk2(lds[(kc + 4) * 65 + n], lds[(kc + 5) * 65 + n]); o.w = pk2(lds[(kc + 6) * 65 + n], lds[(kc + 7) * 65 + n]);
        *(uint4*)(dst + (size_t)tr_row(n0 + n, mode) * K + k0 + kc) = o;
    }
    __syncthreads();
}
__global__ void __launch_bounds__(256) k_transpose(const float* src, bf16_t* dst, int K, int N, int mode, int nmat, size_t sstride, size_t dstride) {
    __shared__ float lds[64 * 65];
    const int per = (K >> 6) * (N >> 6);
    for (int it = blockIdx.x; it < nmat * per; it += gridDim.x) {
        const int m = it / per, tile = it % per;
        transpose_tile(src + (size_t)m * sstride, dst + (size_t)m * dstride, K, N, mode, tile, lds);
    }
}

template <int MODE> DEV void rowop(const Params& p, int l, int R) {
    const int lane = threadIdx.x & 63;
    float4 v[4];
    if (MODE == 0) {
        const float* src = R < NLAT ? p.x + (size_t)R * D : p.ctx + (size_t)(R - NLAT) * D;
#pragma unroll
        for (int i = 0; i < 4; ++i) v[i] = *(const float4*)(src + i * 256 + lane * 4);
    } else {
        float* xr = xres_row(p, R);
        const float* g2 = modvec(p, l - 1, R, 5);
        const bf16_t* y0 = (const bf16_t*)(p.ws + OFF_Y) + (size_t)(2 * R) * D;
        const bf16_t* y1 = y0 + D;
        const float* lg = p.ln2_g + (l - 1) * D; const float* lb = p.ln2_b + (l - 1) * D;
        float s = 0.f;
#pragma unroll
        for (int i = 0; i < 4; ++i) {
            const int k = i * 256 + lane * 4;
            const float4 xv = *(const float4*)(xr + k); const float4 gv = *(const float4*)(g2 + k);
            const uint2 a = *(const uint2*)(y0 + k); const uint2 b = *(const uint2*)(y1 + k);
            float4 u;
            u.x = ALPHA * xv.x + gv.x * (bf2f((bf16_t)(a.x & 0xffff)) + bf2f((bf16_t)(b.x & 0xffff)));
            u.y = ALPHA * xv.y + gv.y * (bf2f((bf16_t)(a.x >> 16)) + bf2f((bf16_t)(b.x >> 16)));
            u.z = ALPHA * xv.z + gv.z * (bf2f((bf16_t)(a.y & 0xffff)) + bf2f((bf16_t)(b.y & 0xffff)));
            u.w = ALPHA * xv.w + gv.w * (bf2f((bf16_t)(a.y >> 16)) + bf2f((bf16_t)(b.y >> 16)));
            v[i] = u; s += (u.x + u.y) + (u.z + u.w);
        }
        const float mean = wave_sum(s) * (1.f / D);
        float q = 0.f;
#pragma unroll
        for (int i = 0; i < 4; ++i) { v[i].x -= mean; v[i].y -= mean; v[i].z -= mean; v[i].w -= mean; q += (v[i].x * v[i].x + v[i].y * v[i].y) + (v[i].z * v[i].z + v[i].w * v[i].w); }
        const float rstd = rsqrtf(wave_sum(q) * (1.f / D) + LN_EPS);
#pragma unroll
        for (int i = 0; i < 4; ++i) {
            const int k = i * 256 + lane * 4;
            const float4 gg = *(const float4*)(lg + k); const float4 bb = *(const float4*)(lb + k);
            v[i].x = v[i].x * rstd * gg.x + bb.x; v[i].y = v[i].y * rstd * gg.y + bb.y; v[i].z = v[i].z * rstd * gg.z + bb.z; v[i].w = v[i].w * rstd * gg.w + bb.w;
            *(float4*)(xr + k) = v[i];
        }
    }
    if (MODE != 2) {
        const float* sh = modvec(p, l, R, 0); const float* sc = modvec(p, l, R, 1);
        bf16_t* ha = (bf16_t*)(p.ws + OFF_X1) + (size_t)R * D;
#pragma unroll
        for (int i = 0; i < 4; ++i) {
            const int k = i * 256 + lane * 4;
            const float4 s4 = *(const float4*)(sh + k); const float4 c4 = *(const float4*)(sc + k);
            uint2 o; o.x = pk2(v[i].x * (1.f + c4.x) + s4.x, v[i].y * (1.f + c4.y) + s4.y); o.y = pk2(v[i].z * (1.f + c4.z) + s4.z, v[i].w * (1.f + c4.w) + s4.w);
            *(uint2*)(ha + k) = o;
        }
    }
}
template <int MODE> __global__ void __launch_bounds__(256) k_rowop(Params p, int l, int nrows) {
    const int w = threadIdx.x >> 6;
    for (int R = blockIdx.x * 4 + w; R < nrows; R += gridDim.x * 4) rowop<MODE>(p, l, R);
}

constexpr int GEMM_LDS_ELEMS = 2 * (128 + 256) * 32;
DEV void gemm_mainloop(const bf16_t* a0, const bf16_t* a1, const bf16_t* bp, size_t ldb, int nk, bf16_t* lds, f32x4 (&acc)[4][8]) {
    const int t = threadIdx.x, lane = t & 63, w = t >> 6, wm = w >> 1, wn = w & 1;
    const int wofs = (t >> 2) * 32 + (((t & 3) ^ ((0 - (t >> 4)) & 3)) * 8);
    const int pc = ((lane >> 4) ^ ((0 - ((lane & 15) >> 2)) & 3)) * 8;
    const int arow = (wm * 64 + (lane & 15)) * 32 + pc, brow = (128 + wn * 128 + (lane & 15)) * 32 + pc;
    const bf16_t* b1 = bp + (size_t)64 * ldb; const bf16_t* b2 = bp + (size_t)128 * ldb; const bf16_t* b3 = bp + (size_t)192 * ldb;
    uint4 ra0 = *(const uint4*)a0, ra1 = *(const uint4*)a1;
    uint4 rb0 = *(const uint4*)bp, rb1 = *(const uint4*)b1, rb2 = *(const uint4*)b2, rb3 = *(const uint4*)b3;
    __syncthreads();
    *(uint4*)(lds + wofs) = ra0; *(uint4*)(lds + wofs + 64 * 32) = ra1;
    *(uint4*)(lds + 128 * 32 + wofs) = rb0; *(uint4*)(lds + 192 * 32 + wofs) = rb1; *(uint4*)(lds + 256 * 32 + wofs) = rb2; *(uint4*)(lds + 320 * 32 + wofs) = rb3;
    __syncthreads();
    for (int kt = 0; kt < nk; ++kt) {
        const bf16_t* cur = lds + (kt & 1) * (384 * 32);
        bf16_t* nxt = lds + ((kt + 1) & 1) * (384 * 32);
        const bool more = kt + 1 < nk;
        if (more) {
            const int ko = (kt + 1) * 32;
            ra0 = *(const uint4*)(a0 + ko); ra1 = *(const uint4*)(a1 + ko);
            rb0 = *(const uint4*)(bp + ko); rb1 = *(const uint4*)(b1 + ko); rb2 = *(const uint4*)(b2 + ko); rb3 = *(const uint4*)(b3 + ko);
        }
        const bf16x8 af0 = *(const bf16x8*)(cur + arow), af1 = *(const bf16x8*)(cur + arow + 16 * 32), af2 = *(const bf16x8*)(cur + arow + 32 * 32), af3 = *(const bf16x8*)(cur + arow + 48 * 32);
#pragma unroll
        for (int nt = 0; nt < 8; ++nt) {
            const bf16x8 bfr = *(const bf16x8*)(cur + brow + nt * 16 * 32);
            acc[0][nt] = __builtin_amdgcn_mfma_f32_16x16x32_bf16(bfr, af0, acc[0][nt], 0, 0, 0);
            acc[1][nt] = __builtin_amdgcn_mfma_f32_16x16x32_bf16(bfr, af1, acc[1][nt], 0, 0, 0);
            acc[2][nt] = __builtin_amdgcn_mfma_f32_16x16x32_bf16(bfr, af2, acc[2][nt], 0, 0, 0);
            acc[3][nt] = __builtin_amdgcn_mfma_f32_16x16x32_bf16(bfr, af3, acc[3][nt], 0, 0, 0);
        }
        if (more) {
            *(uint4*)(nxt + wofs) = ra0; *(uint4*)(nxt + wofs + 64 * 32) = ra1;
            *(uint4*)(nxt + 128 * 32 + wofs) = rb0; *(uint4*)(nxt + 192 * 32 + wofs) = rb1; *(uint4*)(nxt + 256 * 32 + wofs) = rb2; *(uint4*)(nxt + 320 * 32 + wofs) = rb3;
        }
        __syncthreads();
    }
}
DEV void zero_acc(f32x4 (&acc)[4][8]) {
#pragma unroll
    for (int a = 0; a < 4; ++a)
#pragma unroll
        for (int b = 0; b < 8; ++b) acc[a][b] = (f32x4){0.f, 0.f, 0.f, 0.f};
}

DEV void inproj_item(const Params& p, int l, int rt, int pass, bf16_t* lds) {
    const int t = threadIdx.x, lane = t & 63, w = t >> 6, wm = w >> 1, wn = w & 1;
    const bf16_t* A = (const bf16_t*)(p.ws + OFF_X1) + (size_t)(rt * 128 + (t >> 2)) * D + (t & 3) * 8;
    const bf16_t* Bt = (const bf16_t*)(p.ws + OFF_WINT) + ((size_t)l * 2304 + pass * 256 + (t >> 2)) * 1024 + (t & 3) * 8;
    f32x4 acc[4][8]; zero_acc(acc);
    gemm_mainloop(A, A + 64 * D, Bt, 1024, 32, lds, acc);
    bf16_t* P = (bf16_t*)(p.ws + OFF_P);
    const float* ctab = (const float*)(p.ws + OFF_ROPE); const float* stab = ctab + 2048;
    const bool isctx = rt >= 512;
    const int fq = lane >> 4, fr = lane & 15;
#pragma unroll
    for (int hci = 0; hci < 2; ++hci) {
        const int hc = pass * 4 + wn * 2 + hci;
        int type, dcol = 0, vh = 0;
        if (hc < 4) { type = 0; dcol = COL_RGX + hc * 64; }
        else if (hc < 10) { type = 0; dcol = COL_NAK + (hc - 4) * 64; }
        else if (hc < 16) { type = 4; vh = hc - 10; }
        else if (hc < 18) { type = 2; dcol = COL_GK + (hc - 16) * 64; }
        else if (hc < 20) { type = 5; vh = hc - 18; }
        else if (hc < 24) { type = 0; dcol = COL_GATE + (hc - 20) * 64; }
        else if (hc < 30) { type = 1; dcol = COL_NAQ + (hc - 24) * 64; }
        else { type = 3; dcol = COL_GQ + (hc - 30) * 64; }
#pragma unroll
        for (int mt = 0; mt < 4; ++mt) {
            const int R = rt * 128 + wm * 64 + mt * 16 + fr;
            f32x4 v0 = acc[mt][hci * 4 + 0], v1 = acc[mt][hci * 4 + 1], v2 = acc[mt][hci * 4 + 2], v3 = acc[mt][hci * 4 + 3];
            if ((type == 2 || type == 3) && !isctx) {
                const int tt = R & (S - 1), pr = tt >> 6, pc = tt & 63;
                const f32x4 cr = *(const f32x4*)(ctab + pr * 16 + fq * 4), sr = *(const f32x4*)(stab + pr * 16 + fq * 4);
                const f32x4 cc = *(const f32x4*)(ctab + pc * 16 + fq * 4), sc = *(const f32x4*)(stab + pc * 16 + fq * 4);
                const f32x4 o0 = v0 * cr - v1 * sr, o1 = v1 * cr + v0 * sr, o2 = v2 * cc - v3 * sc, o3 = v3 * cc + v2 * sc;
                v0 = o0; v1 = o1; v2 = o2; v3 = o3;
            }
            if (type == 1 || type == 3) { v0 = v0 * 0.125f; v1 = v1 * 0.125f; v2 = v2 * 0.125f; v3 = v3 * 0.125f; }
            if (type < 4) {
                bf16_t* o = P + (size_t)R * PWS + dcol + fq * 4;
                uint2 q;
                q.x = pk2(v0[0], v0[1]); q.y = pk2(v0[2], v0[3]); *(uint2*)(o) = q;
                q.x = pk2(v1[0], v1[1]); q.y = pk2(v1[2], v1[3]); *(uint2*)(o + 16) = q;
                q.x = pk2(v2[0], v2[1]); q.y = pk2(v2[2], v2[3]); *(uint2*)(o + 32) = q;
                q.x = pk2(v3[0], v3[1]); q.y = pk2(v3[2], v3[3]); *(uint2*)(o + 48) = q;
            } else {
                bf16_t* base; size_t dstride;
                if (!isctx) { const int b = R >> 13, tt = R & (S - 1);
                    base = (type == 4 ? (bf16_t*)(p.ws + OFF_NAVT) + (size_t)(b * 6 + vh) * 64 * S : (bf16_t*)(p.ws + OFF_GVT) + (size_t)(b * 2 + vh) * 64 * S) + tt; dstride = S; }
                else { const int cR = R - NLAT, b = cR >> 8, tt = cR & 255;
                    base = (type == 4 ? (bf16_t*)(p.ws + OFF_NAVTC) + (size_t)(b * 6 + vh) * 64 * CTX : (bf16_t*)(p.ws + OFF_GVTC) + (size_t)(b * 2 + vh) * 64 * CTX) + tt; dstride = CTX; }
#pragma unroll
                for (int j = 0; j < 4; ++j) {
                    base[(size_t)(0 * 16 + fq * 4 + j) * dstride] = f2bf(v0[j]);
                    base[(size_t)(1 * 16 + fq * 4 + j) * dstride] = f2bf(v1[j]);
                    base[(size_t)(2 * 16 + fq * 4 + j) * dstride] = f2bf(v2[j]);
                    base[(size_t)(3 * 16 + fq * 4 + j) * dstride] = f2bf(v3[j]);
                }
            }
        }
    }
}
__global__ void __launch_bounds__(256, 2) k_inproj(Params p, int l) {
    __shared__ __attribute__((aligned(16))) bf16_t lds[GEMM_LDS_ELEMS];
    const int nctxp = (l == 0) ? 9 : 5;
    const int nitems = 512 * 9 + 16 * nctxp;
    for (int it = blockIdx.x; it < nitems; it += gridDim.x) {
        int rt, pass;
        if (it < 512 * 9) { rt = it / 9; pass = it % 9; } else { const int r = it - 512 * 9; rt = 512 + r / nctxp; pass = r % nctxp; }
        inproj_item(p, l, rt, pass, lds);
    }
}

__global__ void __launch_bounds__(256) k_rg1(Params p, int l) {
    __shared__ float xl[256];
    const bf16_t* P = (const bf16_t*)(p.ws + OFF_P);
    float* AB = (float*)(p.ws + OFF_Y);
    const int c = threadIdx.x, n = c >> 6, e = c & 63;
    for (int R = blockIdx.x; R < NTOK; R += gridDim.x) {
        const bool isctx = R >= NLAT;
        const int L = isctx ? CTX : S, base = isctx ? NLAT + ((R - NLAT) / CTX) * CTX : (R / S) * S, tt = R - base;
        float acc = p.conv_b[l * 256 + c];
#pragma unroll
        for (int j = 0; j < 4; ++j) { const int ts = tt + j - 2; if (ts >= 0 && ts < L) acc += p.conv_w[(l * 4 + j) * 256 + c] * bf2f(P[(size_t)(base + ts) * PWS + COL_RGX + c]); }
        __syncthreads();
        xl[c] = acc;
        __syncthreads();
#pragma unroll
        for (int dir = 0; dir < 2; ++dir) {
            const float* wa = p.rg_a_w + ((size_t)((l * 2 + dir) * 4 + n) * 64) * 64 + e;
            const float* wi = p.rg_i_w + ((size_t)((l * 2 + dir) * 4 + n) * 64) * 64 + e;
            float za = p.rg_a_b[(l * 2 + dir) * 256 + c], zi = p.rg_i_b[(l * 2 + dir) * 256 + c];
#pragma unroll 8
            for (int d = 0; d < 64; ++d) { const float xv = xl[n * 64 + d]; za += xv * wa[d * 64]; zi += xv * wi[d * 64]; }
            const float r = 1.f / (1.f + expf(-za)), ig = 1.f / (1.f + expf(-zi));
            const float lam = p.rg_lambda[(l * 2 + dir) * 256 + c];
            const float sp = log1pf(expf(-lam));
            const float log_a = -8.f * r * sp;
            const float a = expf(log_a);
            const float bb = sqrtf(-expm1f(2.f * log_a)) * (ig * acc);
            AB[((size_t)R * 2 + dir) * 512 + c] = a;
            AB[((size_t)R * 2 + dir) * 512 + 256 + c] = bb;
        }
    }
}
__global__ void __launch_bounds__(256) k_rg2(Params p) {
    const float* AB = (const float*)(p.ws + OFF_Y);
    float* H = (float*)(p.ws + OFF_X2);
    const int gid = blockIdx.x * 256 + threadIdx.x;
    const int c = gid & 255, b = (gid >> 8) & 7, dir = gid >> 11;
    float h = 0.f;
    float* Hd = H + (size_t)dir * NTOK * 256;
    for (int seg = 0; seg < 2; ++seg) {
        const int L = seg == 0 ? CTX : S, base = seg == 0 ? NLAT + b * CTX : b * S;
#pragma unroll 8
        for (int s = 0; s < L; ++s) {
            const int tt = dir == 0 ? s : L - 1 - s;
            const size_t R = (size_t)base + tt;
            const float a = AB[(R * 2 + dir) * 512 + c], bb = AB[(R * 2 + dir) * 512 + 256 + c];
            h = a * h + bb;
            Hd[R * 256 + c] = h;
        }
    }
}
__global__ void __launch_bounds__(256) k_rg3(Params p, int nrows) {
    const float* H = (const float*)(p.ws + OFF_X2);
    const bf16_t* P = (const bf16_t*)(p.ws + OFF_P);
    bf16_t* X1 = (bf16_t*)(p.ws + OFF_X1);
    const int c = threadIdx.x;
    for (int R = blockIdx.x; R < nrows; R += gridDim.x) {
        const float hs = H[(size_t)R * 256 + c] + H[(size_t)NTOK * 256 + (size_t)R * 256 + c];
        const float gt = bf2f(P[(size_t)R * PWS + COL_GATE + c]);
        X1[(size_t)R * D + c] = f2bf(hs * gelu_tanh(gt));
    }
}

DEV void attn_naive_task(const Params& p, int l, int R, int hh, float* s_sc, int* s_vi, float* s_q) {
    const int lane = threadIdx.x & 63;
    const bool isctx = R >= NLAT;
    const int b = isctx ? (R - NLAT) / CTX : R / S, tt = isctx ? (R - NLAT) % CTX : R % S;
    const bool na = hh < 6; const int h = na ? hh : hh - 6, kvh = h / 3;
    const bf16_t* P = (const bf16_t*)(p.ws + OFF_P);
    s_q[lane] = bf2f(P[(size_t)R * PWS + (na ? COL_NAQ : COL_GQ) + h * 64 + lane]);
    asm volatile("s_waitcnt lgkmcnt(0)" ::: "memory");
    int nloc = 0, r = 0, c = 0, rs = 0, cs = 0, j0 = 0;
    if (!isctx) {
        if (na) { r = tt >> 6; c = tt & 63; rs = min(max(r - 4, 0), 120); cs = min(max(c - 8, 0), 48); nloc = 128; }
        else { j0 = max(0, tt - 128); const int j1 = min(S - 1, tt + 128); nloc = j1 - j0 + 1; }
    }
    const int ntot = nloc + CTX;
    const int kcol = na ? COL_NAK + h * 64 : COL_GK + kvh * 64;
    float mx = -INFINITY;
    for (int k = lane; k < ntot; k += 64) {
        size_t krow; float bias = 0.f; int vi;
        if (k < nloc) {
            int tok;
            if (na) { const int ri = k >> 4, cj = k & 15; tok = (rs + ri) * 64 + cs + cj; bias = p.na_rpb[((size_t)(l * 6 + h) * 15 + (rs + ri - r + 7)) * 31 + (cs + cj - c + 15)]; }
            else tok = j0 + k;
            krow = (size_t)b * S + tok; vi = tok;
        } else { const int kc = k - nloc; krow = (size_t)NLAT + b * CTX + kc; vi = -1 - kc; }
        const bf16_t* kp = P + krow * PWS + kcol;
        float acc = 0.f;
#pragma unroll
        for (int d8 = 0; d8 < 8; ++d8) {
            const uint4 v = *(const uint4*)(kp + d8 * 8);
            acc += s_q[d8 * 8 + 0] * __uint_as_float(v.x << 16) + s_q[d8 * 8 + 1] * __uint_as_float(v.x & 0xffff0000u);
            acc += s_q[d8 * 8 + 2] * __uint_as_float(v.y << 16) + s_q[d8 * 8 + 3] * __uint_as_float(v.y & 0xffff0000u);
            acc += s_q[d8 * 8 + 4] * __uint_as_float(v.z << 16) + s_q[d8 * 8 + 5] * __uint_as_float(v.z & 0xffff0000u);
            acc += s_q[d8 * 8 + 6] * __uint_as_float(v.w << 16) + s_q[d8 * 8 + 7] * __uint_as_float(v.w & 0xffff0000u);
        }
        const float sv = acc + bias;
        s_sc[k] = sv; s_vi[k] = vi; mx = fmaxf(mx, sv);
    }
    mx = wave_max(mx);
    float sinkv = 0.f;
    if (!na) { sinkv = p.gqa_sink[l * 6 + h]; mx = fmaxf(mx, sinkv); }
    asm volatile("s_waitcnt lgkmcnt(0)" ::: "memory");
    float sum = 0.f;
    for (int k = lane; k < ntot; k += 64) { const float e = __expf(s_sc[k] - mx); s_sc[k] = e; sum += e; }
    sum = wave_sum(sum);
    if (!na) sum += __expf(sinkv - mx);
    asm volatile("s_waitcnt lgkmcnt(0)" ::: "memory");
    const bf16_t* vt_lat = na ? (const bf16_t*)(p.ws + OFF_NAVT) + (size_t)((b * 6 + h) * 64 + lane) * S : (const bf16_t*)(p.ws + OFF_GVT) + (size_t)((b * 2 + kvh) * 64 + lane) * S;
    const bf16_t* vt_ctx = na ? (const bf16_t*)(p.ws + OFF_NAVTC) + (size_t)((b * 6 + h) * 64 + lane) * CTX : (const bf16_t*)(p.ws + OFF_GVTC) + (size_t)((b * 2 + kvh) * 64 + lane) * CTX;
    float o = 0.f;
    for (int k = 0; k < ntot; ++k) { const int vi = s_vi[k]; const float pv = s_sc[k]; const bf16_t vv = vi >= 0 ? vt_lat[vi] : vt_ctx[-1 - vi]; o += pv * bf2f(vv); }
    o /= sum;
    ((bf16_t*)(p.ws + OFF_X1))[(size_t)R * D + (na ? 256 : 640) + h * 64 + lane] = f2bf(o);
    asm volatile("s_waitcnt lgkmcnt(0)" ::: "memory");
}
__global__ void __launch_bounds__(256) k_attn_naive(Params p, int l, int nrows) {
    __shared__ float s_sc[4][528]; __shared__ int s_vi[4][528]; __shared__ float s_q[4][64];
    const int w = threadIdx.x >> 6;
    const long ntask = (long)nrows * 12;
    for (long tk = (long)blockIdx.x * 4 + w; tk < ntask; tk += (long)gridDim.x * 4) {
        const int R = (int)(tk / 12), hh = (int)(tk % 12);
        attn_naive_task(p, l, R, hh, s_sc[w], s_vi[w], s_q[w]);
    }
}

DEV void outproj_item(const Params& p, int l, int rt, bf16_t* lds, float* stat  ) {
    const int t = threadIdx.x, lane = t & 63, w = t >> 6, wm = w >> 1, wn = w & 1, fq = lane >> 4, fr = lane & 15;
    const bf16_t* A = (const bf16_t*)(p.ws + OFF_X1) + (size_t)(rt * 128 + (t >> 2)) * D + (t & 3) * 8;
    const bool isctx = rt >= 512;
    const float* g1 = modvec(p, l, rt * 128, 2);
#pragma unroll 1
    for (int pass = 0; pass < 4; ++pass) {
        const bf16_t* Bt = (const bf16_t*)(p.ws + OFF_WOUTT) + ((size_t)l * 1024 + pass * 256 + (t >> 2)) * 1024 + (t & 3) * 8;
        f32x4 acc[4][8]; zero_acc(acc);
        gemm_mainloop(A, A + 64 * D, Bt, 1024, 32, lds, acc);
#pragma unroll
        for (int mt = 0; mt < 4; ++mt) {
            const int rl = wm * 64 + mt * 16 + fr, R = rt * 128 + rl;
            const float* xin = (l == 0) ? (isctx ? p.ctx + (size_t)(R - NLAT) * D : p.x + (size_t)R * D) : xres_row(p, R);
            float* xo = xres_row(p, R);
            float s = 0.f, q = 0.f;
#pragma unroll
            for (int nt = 0; nt < 8; ++nt) {
                const int col = pass * 256 + wn * 128 + nt * 16 + fq * 4;
                const f32x4 xv = *(const f32x4*)(xin + col), gv = *(const f32x4*)(g1 + col);
                const f32x4 u = xv * ALPHA + gv * acc[mt][nt];
                *(f32x4*)(xo + col) = u;
                s += (u[0] + u[1]) + (u[2] + u[3]); q += (u[0] * u[0] + u[1] * u[1]) + (u[2] * u[2] + u[3] * u[3]);
            }
            s += __shfl_xor(s, 16); s += __shfl_xor(s, 32); q += __shfl_xor(q, 16); q += __shfl_xor(q, 32);
            if (fq == 0) { stat[((pass * 2 + wn) * 128 + rl) * 2] = s; stat[((pass * 2 + wn) * 128 + rl) * 2 + 1] = q; }
        }
    }
    __threadfence();
    __syncthreads();
    __builtin_amdgcn_fence(__ATOMIC_ACQUIRE, "agent");
    {
        const float* lg = p.ln1_g + l * D; const float* lb = p.ln1_b + l * D;
        const float* sh2 = modvec(p, l, rt * 128, 3); const float* sc2 = modvec(p, l, rt * 128, 4);
        bf16_t* X2 = (bf16_t*)(p.ws + OFF_X2);
        const bf16_t* WRh = (const bf16_t*)(p.ws + OFF_WR) + (size_t)(l * 2) * 48 * 1024 + (size_t)fr * 1024 + fq * 8;
        const bf16_t* WRl = WRh + 48 * 1024;
        float mean[2], rstd[2];
#pragma unroll
        for (int tm = 0; tm < 2; ++tm) {
            const int rl = w * 32 + tm * 16 + fr;
            float s = 0.f, q = 0.f;
#pragma unroll
            for (int i = 0; i < 8; ++i) { s += stat[(i * 128 + rl) * 2]; q += stat[(i * 128 + rl) * 2 + 1]; }
            mean[tm] = s * (1.f / D);
            rstd[tm] = rsqrtf(fmaxf(q * (1.f / D) - mean[tm] * mean[tm], 0.f) + LN_EPS);
        }
        f32x4 lacc[3][2];
#pragma unroll
        for (int a = 0; a < 3; ++a) { lacc[a][0] = (f32x4){0.f, 0.f, 0.f, 0.f}; lacc[a][1] = (f32x4){0.f, 0.f, 0.f, 0.f}; }
#pragma unroll 2
        for (int ks = 0; ks < 32; ++ks) {
            const int k = ks * 32 + fq * 8;
            const f32x4 g0 = *(const f32x4*)(lg + k), g1v = *(const f32x4*)(lg + k + 4), b0 = *(const f32x4*)(lb + k), b1 = *(const f32x4*)(lb + k + 4);
            const f32x4 s0 = *(const f32x4*)(sh2 + k), s1 = *(const f32x4*)(sh2 + k + 4), c0 = *(const f32x4*)(sc2 + k), c1 = *(const f32x4*)(sc2 + k + 4);
            bf16x8 hh[2], hl[2];
#pragma unroll
            for (int tm = 0; tm < 2; ++tm) {
                const int R = rt * 128 + w * 32 + tm * 16 + fr;
                float* xr = xres_row(p, R) + k;
                const f32x4 u0 = *(const f32x4*)xr, u1 = *(const f32x4*)(xr + 4);
                const f32x4 x0 = (u0 - mean[tm]) * rstd[tm] * g0 + b0, x1 = (u1 - mean[tm]) * rstd[tm] * g1v + b1;
                *(f32x4*)xr = x0; *(f32x4*)(xr + 4) = x1;
                const f32x4 h0 = x0 * (c0 + 1.f) + s0, h1 = x1 * (c1 + 1.f) + s1;
#pragma unroll
                for (int e = 0; e < 4; ++e) {
                    const bf16_t a = f2bf(h0[e]), b = f2bf(h1[e]);
                    hh[tm][e] = (short)a; hh[tm][4 + e] = (short)b;
                    hl[tm][e] = (short)f2bf(h0[e] - bf2f(a)); hl[tm][4 + e] = (short)f2bf(h1[e] - bf2f(b));
                }
                *(bf16x8*)(X2 + (size_t)R * D + k) = hh[tm];
            }
#pragma unroll
            for (int ft = 0; ft < 3; ++ft) {
                const bf16x8 wh = *(const bf16x8*)(WRh + (size_t)ft * 16 * 1024 + ks * 32), wl = *(const bf16x8*)(WRl + (size_t)ft * 16 * 1024 + ks * 32);
#pragma unroll
                for (int tm = 0; tm < 2; ++tm) {
                    lacc[ft][tm] = __builtin_amdgcn_mfma_f32_16x16x32_bf16(wh, hh[tm], lacc[ft][tm], 0, 0, 0);
                    lacc[ft][tm] = __builtin_amdgcn_mfma_f32_16x16x32_bf16(wl, hh[tm], lacc[ft][tm], 0, 0, 0);
                    lacc[ft][tm] = __builtin_amdgcn_mfma_f32_16x16x32_bf16(wh, hl[tm], lacc[ft][tm], 0, 0, 0);
                }
            }
        }
        float* lt = (float*)lds;
#pragma unroll
        for (int ft = 0; ft < 3; ++ft)
#pragma unroll
            for (int tm = 0; tm < 2; ++tm)
#pragma unroll
                for (int j = 0; j < 4; ++j) lt[(w * 32 + tm * 16 + fr) * 48 + ft * 16 + fq * 4 + j] = lacc[ft][tm][j];
        asm volatile("s_waitcnt lgkmcnt(0)" ::: "memory");
        if (lane < 32) {
            const int rl = w * 32 + lane, R = rt * 128 + rl;
            const float* lr = lt + rl * 48;
            int gi = 0; float gm = lr[0] + p.router_g_b[l * 4];
            float gl[4]; gl[0] = gm;
#pragma unroll
            for (int j = 1; j < 4; ++j) { gl[j] = lr[j] + p.router_g_b[l * 4 + j]; if (gl[j] > gm) { gm = gl[j]; gi = j; } }
            float gs = 0.f;
#pragma unroll
            for (int j = 0; j < 4; ++j) gs += expf(gl[j] - gm);
            const float ptop = 1.f / gs;
            int e0 = 0, e1 = 0; float m0 = -INFINITY, m1 = -INFINITY;
            for (int j = 0; j < 8; ++j) {
                const float v = lr[4 + gi * 8 + j] + p.router_e_b[l * 32 + gi * 8 + j];
                if (v > m0) { m1 = m0; e1 = e0; m0 = v; e0 = j; } else if (v > m1) { m1 = v; e1 = j; }
            }
            const float ex = expf(m1 - m0);
            const float w0 = ptop / (1.f + ex), w1 = ptop * ex / (1.f + ex);
            int* rte = (int*)(p.ws + OFF_RTE); float* rtw = (float*)(p.ws + OFF_RTW);
            unsigned* cnt = (unsigned*)(p.ws + OFF_CTL) + CW_CNT + l * 32;
            int* list = (int*)(p.ws + OFF_LIST);
            const int E0 = gi * 8 + e0, E1 = gi * 8 + e1;
            rte[R * 2] = E0; rte[R * 2 + 1] = E1; rtw[R * 2] = w0; rtw[R * 2 + 1] = w1;
            const unsigned p0 = atomicAdd(cnt + E0, 1u); list[(size_t)E0 * LISTCAP + p0] = R * 2;
            const unsigned p1 = atomicAdd(cnt + E1, 1u); list[(size_t)E1 * LISTCAP + p1] = R * 2 + 1;
        }
    }
}
__global__ void __launch_bounds__(256, 2) k_outproj(Params p, int l) {
    __shared__ __attribute__((aligned(16))) bf16_t lds[GEMM_LDS_ELEMS];
    __shared__ float stat[8 * 128 * 2];
    const int ntiles = (l == 0) ? 528 : 512;
    for (int rt = blockIdx.x; rt < ntiles; rt += gridDim.x) { outproj_item(p, l, rt, lds, stat); __syncthreads(); }
}

DEV void moe_item(const Params& p, int l, int e, int j, int item, int cnt, bf16_t* lds) {
    const int t = threadIdx.x, lane = t & 63, w = t >> 6, wm = w >> 1, wn = w & 1, fq = lane >> 4, fr = lane & 15;
    const int* list = (const int*)(p.ws + OFF_LIST) + (size_t)e * LISTCAP;
    const bf16_t* X2 = (const bf16_t*)(p.ws + OFF_X2);
    bf16_t* Hs = (bf16_t*)(p.ws + OFF_P) + (size_t)item * 128 * FF;
    const bf16_t *ap0, *ap1;
    { const int s0 = j * 128 + (t >> 2), s1 = s0 + 64;
      const int tok0 = s0 < cnt ? (list[s0] >> 1) : 0, tok1 = s1 < cnt ? (list[s1] >> 1) : 0;
      ap0 = X2 + (size_t)tok0 * D + (t & 3) * 8; ap1 = X2 + (size_t)tok1 * D + (t & 3) * 8; }
#pragma unroll 1
    for (int pass = 0; pass < 4; ++pass) {
        const bf16_t* Bt = (const bf16_t*)(p.ws + OFF_WGU) + ((size_t)e * 1024 + pass * 256 + (t >> 2)) * 1024 + (t & 3) * 8;
        f32x4 acc[4][8]; zero_acc(acc);
        gemm_mainloop(ap0, ap1, Bt, 1024, 32, lds, acc);
#pragma unroll
        for (int mt = 0; mt < 4; ++mt) {
            const int rl = wm * 64 + mt * 16 + fr;
#pragma unroll
            for (int nt = 0; nt < 4; ++nt) {
                const f32x4 gv = acc[mt][nt], uv = acc[mt][nt + 4];
                float hv[4];
#pragma unroll
                for (int jj = 0; jj < 4; ++jj) hv[jj] = gv[jj] / (1.f + __expf(-gv[jj])) * uv[jj];
                uint2 o; o.x = pk2(hv[0], hv[1]); o.y = pk2(hv[2], hv[3]);
                *(uint2*)(Hs + (size_t)rl * FF + pass * 128 + wn * 64 + nt * 16 + fq * 4) = o;
            }
        }
    }
    __threadfence();
    __syncthreads();
    __builtin_amdgcn_fence(__ATOMIC_ACQUIRE, "agent");
    const bf16_t* A = Hs + (size_t)(t >> 2) * FF + (t & 3) * 8;
    const float* rtw = (const float*)(p.ws + OFF_RTW);
    bf16_t* Y = (bf16_t*)(p.ws + OFF_Y);
#pragma unroll 1
    for (int pass = 0; pass < 4; ++pass) {
        const bf16_t* Bt = (const bf16_t*)(p.ws + OFF_WD) + ((size_t)e * 1024 + pass * 256 + (t >> 2)) * FF + (t & 3) * 8;
        f32x4 acc[4][8]; zero_acc(acc);
        gemm_mainloop(A, A + 64 * FF, Bt, FF, 16, lds, acc);
#pragma unroll
        for (int mt = 0; mt < 4; ++mt) {
            const int s = j * 128 + wm * 64 + mt * 16 + fr;
            if (s < cnt) {
                const int ent = list[s];
                const float gw = rtw[ent];
                bf16_t* yo = Y + (size_t)ent * D + pass * 256 + wn * 128 + fq * 4;
#pragma unroll
                for (int nt = 0; nt < 8; ++nt) { const f32x4 v = acc[mt][nt] * gw; uint2 o; o.x = pk2(v[0], v[1]); o.y = pk2(v[2], v[3]); *(uint2*)(yo + nt * 16) = o; }
            }
        }
    }
}
__global__ void __launch_bounds__(256, 2) k_moe(Params p, int l) {
    __shared__ __attribute__((aligned(16))) bf16_t lds[GEMM_LDS_ELEMS];
    __shared__ int s_pref[33]; __shared__ int s_cnt[32];
    const unsigned* cnt = (const unsigned*)(p.ws + OFF_CTL) + CW_CNT + l * 32;
    if (threadIdx.x == 0) { int a = 0; for (int e = 0; e < 32; ++e) { const int c = (int)cnt[e]; s_cnt[e] = c; s_pref[e] = a; a += (c + 127) >> 7; } s_pref[32] = a; }
    __syncthreads();
    const int nitems = s_pref[32];
    for (int it = blockIdx.x; it < nitems; it += gridDim.x) {
        int e = 0;
        while (e < 31 && it >= s_pref[e + 1]) ++e;
        moe_item(p, l, e, it - s_pref[e], it, s_cnt[e], lds);
        __syncthreads();
    }
}

extern "C" void kernel_launch(void* const* d_in, const int* in_sizes, int n_in, void* d_out, int out_size, void* d_ws, size_t ws_size, hipStream_t stream) {
    if (n_in != 28 || ws_size < WS_TOTAL || out_size != NLAT * D) { fprintf(stderr, "kernel_launch: unexpected shapes / workspace (%d inputs, ws %zu need %zu)\n", n_in, ws_size, (size_t)WS_TOTAL); return; }
    Params p{};
    const float** pp = (const float**)&p;
    for (int i = 0; i < 28; ++i) pp[i] = (const float*)d_in[i];
    p.out = (float*)d_out; p.ws = (unsigned char*)d_ws;
    unsigned char* ws = (unsigned char*)d_ws;
    (void)hipMemsetAsync(ws + OFF_CTL, 0, CTL_BYTES, stream);
    k_mod<<<48, 256, 0, stream>>>(p);
    k_rope<<<8, 256, 0, stream>>>(p);
    k_routerw<<<384, 256, 0, stream>>>(p);
    k_transpose<<<1024, 256, 0, stream>>>(p.w_in, (bf16_t*)(ws + OFF_WINT), 1024, 2304, 0, 2, (size_t)1024 * 2304, (size_t)2304 * 1024);
    k_transpose<<<512, 256, 0, stream>>>(p.w_out, (bf16_t*)(ws + OFF_WOUTT), 1024, 1024, 0, 2, (size_t)1024 * 1024, (size_t)1024 * 1024);
    for (int l = 0; l < 2; ++l) {
        k_transpose<<<2048, 256, 0, stream>>>(p.exp_w_gate + (size_t)l * NE * 1024 * 512, (bf16_t*)(ws + OFF_WGU), 1024, 512, 1, NE, (size_t)1024 * 512, (size_t)1024 * 1024);
        k_transpose<<<2048, 256, 0, stream>>>(p.exp_w_up + (size_t)l * NE * 1024 * 512, (bf16_t*)(ws + OFF_WGU), 1024, 512, 2, NE, (size_t)1024 * 512, (size_t)1024 * 1024);
        k_transpose<<<2048, 256, 0, stream>>>(p.exp_w_down + (size_t)l * NE * 512 * 1024, (bf16_t*)(ws + OFF_WD), 512, 1024, 0, NE, (size_t)512 * 1024, (size_t)1024 * 512);
        if (l == 0) k_rowop<0><<<2048, 256, 0, stream>>>(p, 0, NTOK); else k_rowop<1><<<2048, 256, 0, stream>>>(p, 1, NTOK);
        k_inproj<<<512, 256, 0, stream>>>(p, l);
        k_rg1<<<4096, 256, 0, stream>>>(p, l);
        k_rg2<<<16, 256, 0, stream>>>(p);
        k_rg3<<<4096, 256, 0, stream>>>(p, l == 0 ? NTOK : NLAT);
        k_attn_naive<<<8192, 256, 0, stream>>>(p, l, l == 0 ? NTOK : NLAT);
        k_outproj<<<512, 256, 0, stream>>>(p, l);
        k_moe<<<512, 256, 0, stream>>>(p, l);
    }
    k_rowop<2><<<2048, 256, 0, stream>>>(p, 2, NLAT);
}
```

```cpp
#include <hip/hip_runtime.h>
#include <hip/hip_cooperative_groups.h>
#include <stdint.h>
#include <cstdio>

typedef unsigned short bf16_t;
typedef short bf16x8 __attribute__((ext_vector_type(8)));
typedef float f32x4 __attribute__((ext_vector_type(4)));

#define DEV __device__ __forceinline__

constexpr int D = 1024, NB = 8, S = 8192, CTX = 256;
constexpr int NLAT = NB * S, NCTX = NB * CTX, NTOK = NLAT + NCTX;
constexpr int PWS = 1792;
constexpr int COL_RGX = 0, COL_NAK = 256, COL_GK = 640, COL_GATE = 768, COL_NAQ = 1024, COL_GQ = 1408;
constexpr int NE = 32, FF = 512;
constexpr int LISTCAP = NTOK;
constexpr float ALPHA = 1.4142135623730951f;
constexpr float LN_EPS = 1e-5f;

constexpr size_t al256(size_t x) { return (x + 255) & ~(size_t)255; }
constexpr size_t OFF_CTL   = 0;
constexpr size_t CTL_BYTES = 4096;
constexpr size_t OFF_MOD   = OFF_CTL + CTL_BYTES;
constexpr size_t OFF_ROPE  = al256(OFF_MOD + (size_t)2 * 9 * 6144 * 4);
constexpr size_t OFF_RTE   = al256(OFF_ROPE + (size_t)2 * 128 * 16 * 4);
constexpr size_t OFF_RTW   = al256(OFF_RTE + (size_t)NTOK * 8);
constexpr size_t OFF_LIST  = al256(OFF_RTW + (size_t)NTOK * 8);
constexpr size_t OFF_WR    = al256(OFF_LIST + (size_t)NE * LISTCAP * 4);
constexpr size_t OFF_WINT  = al256(OFF_WR + (size_t)2 * 2 * 48 * 1024 * 2);
constexpr size_t OFF_WOUTT = al256(OFF_WINT + (size_t)2 * 2304 * 1024 * 2);
constexpr size_t OFF_WGU   = al256(OFF_WOUTT + (size_t)2 * 1024 * 1024 * 2);
constexpr size_t OFF_WD    = al256(OFF_WGU + (size_t)NE * 1024 * 1024 * 2);
constexpr size_t OFF_XCTX  = al256(OFF_WD + (size_t)NE * 1024 * 512 * 2);
constexpr size_t OFF_X1    = al256(OFF_XCTX + (size_t)NCTX * D * 4);
constexpr size_t OFF_X2    = al256(OFF_X1 + (size_t)NTOK * D * 2);
constexpr size_t OFF_P     = al256(OFF_X2 + (size_t)NTOK * D * 2);
constexpr size_t OFF_NAVT  = al256(OFF_P + (size_t)NTOK * PWS * 2);
constexpr size_t OFF_NAVTC = al256(OFF_NAVT + (size_t)NB * 6 * 64 * S * 2);
constexpr size_t OFF_GVT   = al256(OFF_NAVTC + (size_t)NB * 6 * 64 * CTX * 2);
constexpr size_t OFF_GVTC  = al256(OFF_GVT + (size_t)NB * 2 * 64 * S * 2);
constexpr size_t OFF_Y     = al256(OFF_GVTC + (size_t)NB * 2 * 64 * CTX * 2);
constexpr size_t WS_TOTAL  = al256(OFF_Y + (size_t)2 * NTOK * D * 2);
constexpr int CW_CNT = 0;

struct Params {
    const float *x, *c, *ctx, *c_ctx, *w_ada, *b_ada, *w_in, *conv_w, *conv_b, *rg_a_w, *rg_a_b, *rg_i_w, *rg_i_b, *rg_lambda,
        *na_rpb, *gqa_sink, *w_out, *ln1_g, *ln1_b, *router_g_w, *router_g_b, *router_e_w, *router_e_b, *exp_w_gate, *exp_w_up,
        *exp_w_down, *ln2_g, *ln2_b;
    float* out;
    unsigned char* ws;
};

DEV int tid_() { int t = threadIdx.x; asm volatile("" : "+v"(t)); return t; }
DEV int bid_() { int b = blockIdx.x; asm volatile("" : "+s"(b)); return b; }
DEV float bf2f(bf16_t h) { return __uint_as_float((unsigned)h << 16); }
DEV bf16_t f2bf(float f) { unsigned u = __float_as_uint(f); u += 0x7fffu + ((u >> 16) & 1u); return (bf16_t)(u >> 16); }
DEV unsigned pk2(float lo, float hi) { return (unsigned)f2bf(lo) | ((unsigned)f2bf(hi) << 16); }
DEV float wave_sum(float v) {
#pragma unroll
    for (int o = 1; o < 64; o <<= 1) v += __shfl_xor(v, o);
    return v;
}
DEV float wave_max(float v) {
#pragma unroll
    for (int o = 1; o < 64; o <<= 1) v = fmaxf(v, __shfl_xor(v, o));
    return v;
}
DEV float sigmoidf_(float x) { return 1.f / (1.f + __expf(-x)); }
DEV float gelu_tanh(float x) {
    const float u = 0.7978845608028654f * (x + 0.044715f * x * x * x);
    const float t = 1.f - 2.f / (1.f + __expf(2.f * u));
    return 0.5f * x * (1.f + t);
}
DEV float* xres_row(const Params& p, int R) {
    return R < NLAT ? p.out + (size_t)R * D : (float*)(p.ws + OFF_XCTX) + (size_t)(R - NLAT) * D;
}
DEV const float* modvec(const Params& p, int l, int R, int seg) {
    const int b = R < NLAT ? R / S : 8;
    return (const float*)(p.ws + OFF_MOD) + ((size_t)(l * 9 + b) * 6 + seg) * 1024;
}

DEV void ph_mod(const Params& p, float* sc  ) {
    if (bid_() >= 48) return;
    for (int i = tid_(); i < 9 * 1024; i += 256) { const float v = (i < 8192) ? p.c[i] : p.c_ctx[i - 8192]; sc[i] = v / (1.f + expf(-v)); }
    __syncthreads();
    const int col = bid_() * 256 + tid_();
    const int l = col / 6144, j = col % 6144;
    const float* w = p.w_ada + (size_t)l * 1024 * 6144 + j;
    float a0 = 0, a1 = 0, a2 = 0, a3 = 0, a4 = 0, a5 = 0, a6 = 0, a7 = 0, a8 = 0;
    for (int k = 0; k < 1024; ++k) {
        const float wv = w[(size_t)k * 6144];
        a0 += sc[k] * wv; a1 += sc[1024 + k] * wv; a2 += sc[2048 + k] * wv; a3 += sc[3072 + k] * wv; a4 += sc[4096 + k] * wv;
        a5 += sc[5120 + k] * wv; a6 += sc[6144 + k] * wv; a7 += sc[7168 + k] * wv; a8 += sc[8192 + k] * wv;
    }
    const float bias = p.b_ada[l * 6144 + j];
    float* mod = (float*)(p.ws + OFF_MOD) + (size_t)l * 9 * 6144 + j;
    mod[0 * 6144] = a0 + bias; mod[1 * 6144] = a1 + bias; mod[2 * 6144] = a2 + bias; mod[3 * 6144] = a3 + bias; mod[4 * 6144] = a4 + bias;
    mod[5 * 6144] = a5 + bias; mod[6 * 6144] = a6 + bias; mod[7 * 6144] = a7 + bias; mod[8 * 6144] = a8 + bias;
}

DEV void sincos_red(float ang, float& sn, float& cs) {
    const float n = rintf(ang * 0.15915494309189535f);
    float r = fmaf(-n, 6.2831854820251465f, ang);
    r = fmaf(-n, -1.7484555e-07f, r);
    float sgn = 1.f;
    if (r > 1.5707963267948966f) { r = 3.14159265358979f - r; sgn = -1.f; }
    else if (r < -1.5707963267948966f) { r = -3.14159265358979f - r; sgn = -1.f; }
    const float r2 = r * r;
    float sp = -1.6059044e-10f; sp = fmaf(sp, r2, 2.5052108e-08f); sp = fmaf(sp, r2, -2.7557319e-06f); sp = fmaf(sp, r2, 1.9841270e-04f);
    sp = fmaf(sp, r2, -8.3333333e-03f); sp = fmaf(sp, r2, 1.6666667e-01f); sp = fmaf(sp * -1.f, r2, 1.f);
    sn = r * sp;
    float cp = -1.1470746e-11f; cp = fmaf(cp, r2, 2.0876757e-09f); cp = fmaf(cp, r2, -2.7557319e-07f); cp = fmaf(cp, r2, 2.4801587e-05f);
    cp = fmaf(cp, r2, -1.3888889e-03f); cp = fmaf(cp, r2, 4.1666667e-02f); cp = fmaf(cp, r2, -0.5f); cp = fmaf(cp, r2, 1.f);
    cs = sgn * cp;
}
DEV void ph_rope(const Params& p) {
    const int i = (bid_() - 48) * 256 + tid_();
    if (i < 0 || i >= 128 * 16) return;
    const int pos = i >> 4, q = i & 15;
    const float inv = exp2f(-(float)q * (13.287712379549449f / 16.f));
    float sn, cs; sincos_red((float)pos * inv, sn, cs);
    float* tab = (float*)(p.ws + OFF_ROPE);
    tab[i] = cs; tab[2048 + i] = sn;
}

DEV void ph_routerw(const Params& p) {
  for (int i = bid_() * 256 + tid_(); i < 2 * 48 * 1024; i += gridDim.x * 256) {
    const int l = i / (48 * 1024), f = (i / 1024) % 48, k = i & 1023;
    float w = 0.f;
    if (f < 4) w = p.router_g_w[((size_t)l * 1024 + k) * 4 + f]; else if (f < 36) w = p.router_e_w[((size_t)l * 1024 + k) * 32 + (f - 4)];
    const bf16_t hi = f2bf(w), lo = f2bf(w - bf2f(hi));
    bf16_t* WR = (bf16_t*)(p.ws + OFF_WR);
    WR[((size_t)(l * 2 + 0) * 48 + f) * 1024 + k] = hi;
    WR[((size_t)(l * 2 + 1) * 48 + f) * 1024 + k] = lo;
  }
}

DEV int tr_row(int n, int mode) { return mode == 0 ? n : ((n >> 7) * 256 + ((n >> 6) & 1) * 128 + (n & 63) + (mode == 2 ? 64 : 0)); }
DEV void transpose_tile(const float* src, bf16_t* dst, int K, int N, int mode, int tile, float* lds) {
    const int ntn = N >> 6, kt = tile / ntn, nt = tile % ntn, k0 = kt * 64, n0 = nt * 64, t = tid_();
#pragma unroll
    for (int i = 0; i < 4; ++i) {
        const int r = (t >> 4) + 16 * i, c4 = (t & 15) * 4;
        const float4 v = *(const float4*)(src + (size_t)(k0 + r) * N + n0 + c4);
        lds[r * 65 + c4] = v.x; lds[r * 65 + c4 + 1] = v.y; lds[r * 65 + c4 + 2] = v.z; lds[r * 65 + c4 + 3] = v.w;
    }
    __syncthreads();
#pragma unroll
    for (int i = 0; i < 2; ++i) {
        const int n = (t >> 3) + 32 * i, kc = (t & 7) * 8;
        uint4 o;
        o.x = pk2(lds[(kc + 0) * 65 + n], lds[(kc + 1) * 65 + n]); o.y = pk2(lds[(kc + 2) * 65 + n], lds[(kc + 3) * 65 + n]);
        o.z = pk2(lds[(kc + 4) * 65 + n], lds[(kc + 5) * 65 + n]); o.w = pk2(lds[(kc + 6) * 65 + n], lds[(kc + 7) * 65 + n]);
        *(uint4*)(dst + (size_t)tr_row(n0 + n, mode) * K + k0 + kc) = o;
    }
    __syncthreads();
}
DEV void ph_transpose(const float* src, bf16_t* dst, int K, int N, int mode, int nmat, size_t sstride, size_t dstride, float* lds  ) {
    const int per = (K >> 6) * (N >> 6);
    for (int it = bid_(); it < nmat * per; it += gridDim.x) {
        const int m = it / per, tile = it % per;
        transpose_tile(src + (size_t)m * sstride, dst + (size_t)m * dstride, K, N, mode, tile, lds);
    }
}

template <int MODE> DEV void rowop(const Params& p, int l, int R) {
    const int lane = tid_() & 63;
    float4 v[4];
    if (MODE == 0) {
        const float* src = R < NLAT ? p.x + (size_t)R * D : p.ctx + (size_t)(R - NLAT) * D;
#pragma unroll
        for (int i = 0; i < 4; ++i) v[i] = *(const float4*)(src + i * 256 + lane * 4);
    } else {
        float* xr = xres_row(p, R);
        const float* g2 = modvec(p, l - 1, R, 5);
        const bf16_t* y0 = (const bf16_t*)(p.ws + OFF_Y) + (size_t)(2 * R) * D;
        const bf16_t* y1 = y0 + D;
        const float* lg = p.ln2_g + (l - 1) * D; const float* lb = p.ln2_b + (l - 1) * D;
        float s = 0.f;
#pragma unroll
        for (int i = 0; i < 4; ++i) {
            const int k = i * 256 + lane * 4;
            const float4 xv = *(const float4*)(xr + k); const float4 gv = *(const float4*)(g2 + k);
            const uint2 a = *(const uint2*)(y0 + k); const uint2 b = *(const uint2*)(y1 + k);
            float4 u;
            u.x = ALPHA * xv.x + gv.x * (bf2f((bf16_t)(a.x & 0xffff)) + bf2f((bf16_t)(b.x & 0xffff)));
            u.y = ALPHA * xv.y + gv.y * (bf2f((bf16_t)(a.x >> 16)) + bf2f((bf16_t)(b.x >> 16)));
            u.z = ALPHA * xv.z + gv.z * (bf2f((bf16_t)(a.y & 0xffff)) + bf2f((bf16_t)(b.y & 0xffff)));
            u.w = ALPHA * xv.w + gv.w * (bf2f((bf16_t)(a.y >> 16)) + bf2f((bf16_t)(b.y >> 16)));
            v[i] = u; s += (u.x + u.y) + (u.z + u.w);
        }
        const float mean = wave_sum(s) * (1.f / D);
        float q = 0.f;
#pragma unroll
        for (int i = 0; i < 4; ++i) { v[i].x -= mean; v[i].y -= mean; v[i].z -= mean; v[i].w -= mean; q += (v[i].x * v[i].x + v[i].y * v[i].y) + (v[i].z * v[i].z + v[i].w * v[i].w); }
        const float rstd = rsqrtf(wave_sum(q) * (1.f / D) + LN_EPS);
#pragma unroll
        for (int i = 0; i < 4; ++i) {
            const int k = i * 256 + lane * 4;
            const float4 gg = *(const float4*)(lg + k); const float4 bb = *(const float4*)(lb + k);
            v[i].x = v[i].x * rstd * gg.x + bb.x; v[i].y = v[i].y * rstd * gg.y + bb.y; v[i].z = v[i].z * rstd * gg.z + bb.z; v[i].w = v[i].w * rstd * gg.w + bb.w;
            *(float4*)(xr + k) = v[i];
        }
    }
    if (MODE != 2) {
        const float* sh = modvec(p, l, R, 0); const float* sc = modvec(p, l, R, 1);
        bf16_t* ha = (bf16_t*)(p.ws + OFF_X1) + (size_t)R * D;
#pragma unroll
        for (int i = 0; i < 4; ++i) {
            const int k = i * 256 + lane * 4;
            const float4 s4 = *(const float4*)(sh + k); const float4 c4 = *(const float4*)(sc + k);
            uint2 o; o.x = pk2(v[i].x * (1.f + c4.x) + s4.x, v[i].y * (1.f + c4.y) + s4.y); o.y = pk2(v[i].z * (1.f + c4.z) + s4.z, v[i].w * (1.f + c4.w) + s4.w);
            *(uint2*)(ha + k) = o;
        }
    }
}
template <int MODE> DEV void ph_rowop(const Params& p, int l, int nrows) {
    const int w = tid_() >> 6;
    for (int R = bid_() * 4 + w; R < nrows; R += gridDim.x * 4) rowop<MODE>(p, l, R);
}

constexpr int GEMM_LDS_ELEMS = 2 * (128 + 256) * 32;
DEV void gemm_mainloop(const bf16_t* a0, const bf16_t* a1, const bf16_t* bp, size_t ldb, int nk, bf16_t* lds, f32x4 (&acc)[4][8]) {
    const int t = tid_(), lane = t & 63, w = t >> 6, wm = w >> 1, wn = w & 1;
    const int wofs = (t >> 2) * 32 + (((t & 3) ^ ((0 - (t >> 4)) & 3)) * 8);
    const int pc = ((lane >> 4) ^ ((0 - ((lane & 15) >> 2)) & 3)) * 8;
    const int arow = (wm * 64 + (lane & 15)) * 32 + pc, brow = (128 + wn * 128 + (lane & 15)) * 32 + pc;
    const bf16_t* b1 = bp + (size_t)64 * ldb; const bf16_t* b2 = bp + (size_t)128 * ldb; const bf16_t* b3 = bp + (size_t)192 * ldb;
    uint4 ra0 = *(const uint4*)a0, ra1 = *(const uint4*)a1;
    uint4 rb0 = *(const uint4*)bp, rb1 = *(const uint4*)b1, rb2 = *(const uint4*)b2, rb3 = *(const uint4*)b3;
    __syncthreads();
    *(uint4*)(lds + wofs) = ra0; *(uint4*)(lds + wofs + 64 * 32) = ra1;
    *(uint4*)(lds + 128 * 32 + wofs) = rb0; *(uint4*)(lds + 192 * 32 + wofs) = rb1; *(uint4*)(lds + 256 * 32 + wofs) = rb2; *(uint4*)(lds + 320 * 32 + wofs) = rb3;
    __syncthreads();
    for (int kt = 0; kt < nk; ++kt) {
        const bf16_t* cur = lds + (kt & 1) * (384 * 32);
        bf16_t* nxt = lds + ((kt + 1) & 1) * (384 * 32);
        const bool more = kt + 1 < nk;
        if (more) {
            const int ko = (kt + 1) * 32;
            ra0 = *(const uint4*)(a0 + ko); ra1 = *(const uint4*)(a1 + ko);
            rb0 = *(const uint4*)(bp + ko); rb1 = *(const uint4*)(b1 + ko); rb2 = *(const uint4*)(b2 + ko); rb3 = *(const uint4*)(b3 + ko);
        }
        const bf16x8 af0 = *(const bf16x8*)(cur + arow), af1 = *(const bf16x8*)(cur + arow + 16 * 32), af2 = *(const bf16x8*)(cur + arow + 32 * 32), af3 = *(const bf16x8*)(cur + arow + 48 * 32);
#pragma unroll
        for (int nt = 0; nt < 8; ++nt) {
            const bf16x8 bfr = *(const bf16x8*)(cur + brow + nt * 16 * 32);
            acc[0][nt] = __builtin_amdgcn_mfma_f32_16x16x32_bf16(bfr, af0, acc[0][nt], 0, 0, 0);
            acc[1][nt] = __builtin_amdgcn_mfma_f32_16x16x32_bf16(bfr, af1, acc[1][nt], 0, 0, 0);
            acc[2][nt] = __builtin_amdgcn_mfma_f32_16x16x32_bf16(bfr, af2, acc[2][nt], 0, 0, 0);
            acc[3][nt] = __builtin_amdgcn_mfma_f32_16x16x32_bf16(bfr, af3, acc[3][nt], 0, 0, 0);
        }
        if (more) {
            *(uint4*)(nxt + wofs) = ra0; *(uint4*)(nxt + wofs + 64 * 32) = ra1;
            *(uint4*)(nxt + 128 * 32 + wofs) = rb0; *(uint4*)(nxt + 192 * 32 + wofs) = rb1; *(uint4*)(nxt + 256 * 32 + wofs) = rb2; *(uint4*)(nxt + 320 * 32 + wofs) = rb3;
        }
        __syncthreads();
    }
}
DEV void zero_acc(f32x4 (&acc)[4][8]) {
#pragma unroll
    for (int a = 0; a < 4; ++a)
#pragma unroll
        for (int b = 0; b < 8; ++b) acc[a][b] = (f32x4){0.f, 0.f, 0.f, 0.f};
}

DEV void inproj_item(const Params& p, int l, int rt, int pass, bf16_t* lds) {
    const int t = tid_(), lane = t & 63, w = t >> 6, wm = w >> 1, wn = w & 1;
    const bf16_t* A = (const bf16_t*)(p.ws + OFF_X1) + (size_t)(rt * 128 + (t >> 2)) * D + (t & 3) * 8;
    const bf16_t* Bt = (const bf16_t*)(p.ws + OFF_WINT) + ((size_t)l * 2304 + pass * 256 + (t >> 2)) * 1024 + (t & 3) * 8;
    f32x4 acc[4][8]; zero_acc(acc);
    gemm_mainloop(A, A + 64 * D, Bt, 1024, 32, lds, acc);
    bf16_t* P = (bf16_t*)(p.ws + OFF_P);
    const float* ctab = (const float*)(p.ws + OFF_ROPE); const float* stab = ctab + 2048;
    const bool isctx = rt >= 512;
    const int fq = lane >> 4, fr = lane & 15;
#pragma unroll
    for (int hci = 0; hci < 2; ++hci) {
        const int hc = pass * 4 + wn * 2 + hci;
        int type, dcol = 0, vh = 0;
        if (hc < 4) { type = 0; dcol = COL_RGX + hc * 64; }
        else if (hc < 10) { type = 0; dcol = COL_NAK + (hc - 4) * 64; }
        else if (hc < 16) { type = 4; vh = hc - 10; }
        else if (hc < 18) { type = 2; dcol = COL_GK + (hc - 16) * 64; }
        else if (hc < 20) { type = 5; vh = hc - 18; }
        else if (hc < 24) { type = 0; dcol = COL_GATE + (hc - 20) * 64; }
        else if (hc < 30) { type = 1; dcol = COL_NAQ + (hc - 24) * 64; }
        else { type = 3; dcol = COL_GQ + (hc - 30) * 64; }
#pragma unroll
        for (int mt = 0; mt < 4; ++mt) {
            const int R = rt * 128 + wm * 64 + mt * 16 + fr;
            f32x4 v0 = acc[mt][hci * 4 + 0], v1 = acc[mt][hci * 4 + 1], v2 = acc[mt][hci * 4 + 2], v3 = acc[mt][hci * 4 + 3];
            if ((type == 2 || type == 3) && !isctx) {
                const int tt = R & (S - 1), pr = tt >> 6, pc = tt & 63;
                const f32x4 cr = *(const f32x4*)(ctab + pr * 16 + fq * 4), sr = *(const f32x4*)(stab + pr * 16 + fq * 4);
                const f32x4 cc = *(const f32x4*)(ctab + pc * 16 + fq * 4), sc = *(const f32x4*)(stab + pc * 16 + fq * 4);
                const f32x4 o0 = v0 * cr - v1 * sr, o1 = v1 * cr + v0 * sr, o2 = v2 * cc - v3 * sc, o3 = v3 * cc + v2 * sc;
                v0 = o0; v1 = o1; v2 = o2; v3 = o3;
            }
            if (type == 1 || type == 3) { v0 = v0 * 0.125f; v1 = v1 * 0.125f; v2 = v2 * 0.125f; v3 = v3 * 0.125f; }
            if (type < 4) {
                bf16_t* o = P + (size_t)R * PWS + dcol + fq * 4;
                uint2 q;
                q.x = pk2(v0[0], v0[1]); q.y = pk2(v0[2], v0[3]); *(uint2*)(o) = q;
                q.x = pk2(v1[0], v1[1]); q.y = pk2(v1[2], v1[3]); *(uint2*)(o + 16) = q;
                q.x = pk2(v2[0], v2[1]); q.y = pk2(v2[2], v2[3]); *(uint2*)(o + 32) = q;
                q.x = pk2(v3[0], v3[1]); q.y = pk2(v3[2], v3[3]); *(uint2*)(o + 48) = q;
            } else {
                bf16_t* base; size_t dstride;
                if (!isctx) { const int b = R >> 13, tt = R & (S - 1);
                    base = (type == 4 ? (bf16_t*)(p.ws + OFF_NAVT) + (size_t)(b * 6 + vh) * 64 * S : (bf16_t*)(p.ws + OFF_GVT) + (size_t)(b * 2 + vh) * 64 * S) + tt; dstride = S; }
                else { const int cR = R - NLAT, b = cR >> 8, tt = cR & 255;
                    base = (type == 4 ? (bf16_t*)(p.ws + OFF_NAVTC) + (size_t)(b * 6 + vh) * 64 * CTX : (bf16_t*)(p.ws + OFF_GVTC) + (size_t)(b * 2 + vh) * 64 * CTX) + tt; dstride = CTX; }
#pragma unroll
                for (int j = 0; j < 4; ++j) {
                    base[(size_t)(0 * 16 + fq * 4 + j) * dstride] = f2bf(v0[j]);
                    base[(size_t)(1 * 16 + fq * 4 + j) * dstride] = f2bf(v1[j]);
                    base[(size_t)(2 * 16 + fq * 4 + j) * dstride] = f2bf(v2[j]);
                    base[(size_t)(3 * 16 + fq * 4 + j) * dstride] = f2bf(v3[j]);
                }
            }
        }
    }
}
DEV void ph_inproj(const Params& p, int l, bf16_t* lds) {
    const int nctxp = (l == 0) ? 9 : 5;
    const int nitems = 512 * 9 + 16 * nctxp;
    for (int it = bid_(); it < nitems; it += gridDim.x) {
        int rt, pass;
        if (it < 512 * 9) { rt = it / 9; pass = it % 9; } else { const int r = it - 512 * 9; rt = 512 + r / nctxp; pass = r % nctxp; }
        inproj_item(p, l, rt, pass, lds);
    }
}

DEV void ph_rg1(const Params& p, int l, float* xl  ) {
    const bf16_t* P = (const bf16_t*)(p.ws + OFF_P);
    float* AB = (float*)(p.ws + OFF_Y);
    const int c = tid_(), n = c >> 6, e = c & 63;
    for (int R = bid_(); R < NTOK; R += gridDim.x) {
        const bool isctx = R >= NLAT;
        const int L = isctx ? CTX : S, base = isctx ? NLAT + ((R - NLAT) / CTX) * CTX : (R / S) * S, tt = R - base;
        float acc = p.conv_b[l * 256 + c];
#pragma unroll
        for (int j = 0; j < 4; ++j) { const int ts = tt + j - 2; if (ts >= 0 && ts < L) acc += p.conv_w[(l * 4 + j) * 256 + c] * bf2f(P[(size_t)(base + ts) * PWS + COL_RGX + c]); }
        __syncthreads();
        xl[c] = acc;
        __syncthreads();
#pragma unroll
        for (int dir = 0; dir < 2; ++dir) {
            const float* wa = p.rg_a_w + ((size_t)((l * 2 + dir) * 4 + n) * 64) * 64 + e;
            const float* wi = p.rg_i_w + ((size_t)((l * 2 + dir) * 4 + n) * 64) * 64 + e;
            float za = p.rg_a_b[(l * 2 + dir) * 256 + c], zi = p.rg_i_b[(l * 2 + dir) * 256 + c];
#pragma unroll 8
            for (int d = 0; d < 64; ++d) { const float xv = xl[n * 64 + d]; za += xv * wa[d * 64]; zi += xv * wi[d * 64]; }
            const float r = 1.f / (1.f + expf(-za)), ig = 1.f / (1.f + expf(-zi));
            const float lam = p.rg_lambda[(l * 2 + dir) * 256 + c];
            const float sp = log1pf(expf(-lam));
            const float log_a = -8.f * r * sp;
            const float a = expf(log_a);
            const float bb = sqrtf(-expm1f(2.f * log_a)) * (ig * acc);
            AB[((size_t)R * 2 + dir) * 512 + c] = a;
            AB[((size_t)R * 2 + dir) * 512 + 256 + c] = bb;
        }
    }
}
DEV void ph_rg2(const Params& p) {
    const float* AB = (const float*)(p.ws + OFF_Y);
    float* H = (float*)(p.ws + OFF_X2);
    const int gid = bid_() * 256 + tid_();
    if (gid >= 4096) return;
    const int c = gid & 255, b = (gid >> 8) & 7, dir = gid >> 11;
    float h = 0.f;
    float* Hd = H + (size_t)dir * NTOK * 256;
    for (int seg = 0; seg < 2; ++seg) {
        const int L = seg == 0 ? CTX : S, base = seg == 0 ? NLAT + b * CTX : b * S;
#pragma unroll 8
        for (int s = 0; s < L; ++s) {
            const int tt = dir == 0 ? s : L - 1 - s;
            const size_t R = (size_t)base + tt;
            const float a = AB[(R * 2 + dir) * 512 + c], bb = AB[(R * 2 + dir) * 512 + 256 + c];
            h = a * h + bb;
            Hd[R * 256 + c] = h;
        }
    }
}
DEV void ph_rg3(const Params& p, int nrows) {
    const float* H = (const float*)(p.ws + OFF_X2);
    const bf16_t* P = (const bf16_t*)(p.ws + OFF_P);
    bf16_t* X1 = (bf16_t*)(p.ws + OFF_X1);
    const int c = tid_();
    for (int R = bid_(); R < nrows; R += gridDim.x) {
        const float hs = H[(size_t)R * 256 + c] + H[(size_t)NTOK * 256 + (size_t)R * 256 + c];
        const float gt = bf2f(P[(size_t)R * PWS + COL_GATE + c]);
        X1[(size_t)R * D + c] = f2bf(hs * gelu_tanh(gt));
    }
}

DEV void attn_naive_task(const Params& p, int l, int R, int hh, float* s_sc, int* s_vi, float* s_q) {
    const int lane = tid_() & 63;
    const bool isctx = R >= NLAT;
    const int b = isctx ? (R - NLAT) / CTX : R / S, tt = isctx ? (R - NLAT) % CTX : R % S;
    const bool na = hh < 6; const int h = na ? hh : hh - 6, kvh = h / 3;
    const bf16_t* P = (const bf16_t*)(p.ws + OFF_P);
    s_q[lane] = bf2f(P[(size_t)R * PWS + (na ? COL_NAQ : COL_GQ) + h * 64 + lane]);
    asm volatile("s_waitcnt lgkmcnt(0)" ::: "memory");
    int nloc = 0, r = 0, c = 0, rs = 0, cs = 0, j0 = 0;
    if (!isctx) {
        if (na) { r = tt >> 6; c = tt & 63; rs = min(max(r - 4, 0), 120); cs = min(max(c - 8, 0), 48); nloc = 128; }
        else { j0 = max(0, tt - 128); const int j1 = min(S - 1, tt + 128); nloc = j1 - j0 + 1; }
    }
    const int ntot = nloc + CTX;
    const int kcol = na ? COL_NAK + h * 64 : COL_GK + kvh * 64;
    float mx = -INFINITY;
    for (int k = lane; k < ntot; k += 64) {
        size_t krow; float bias = 0.f; int vi;
        if (k < nloc) {
            int tok;
            if (na) { const int ri = k >> 4, cj = k & 15; tok = (rs + ri) * 64 + cs + cj; bias = p.na_rpb[((size_t)(l * 6 + h) * 15 + (rs + ri - r + 7)) * 31 + (cs + cj - c + 15)]; }
            else tok = j0 + k;
            krow = (size_t)b * S + tok; vi = tok;
        } else { const int kc = k - nloc; krow = (size_t)NLAT + b * CTX + kc; vi = -1 - kc; }
        const bf16_t* kp = P + krow * PWS + kcol;
        float acc = 0.f;
#pragma unroll
        for (int d8 = 0; d8 < 8; ++d8) {
            const uint4 v = *(const uint4*)(kp + d8 * 8);
            acc += s_q[d8 * 8 + 0] * __uint_as_float(v.x << 16) + s_q[d8 * 8 + 1] * __uint_as_float(v.x & 0xffff0000u);
            acc += s_q[d8 * 8 + 2] * __uint_as_float(v.y << 16) + s_q[d8 * 8 + 3] * __uint_as_float(v.y & 0xffff0000u);
            acc += s_q[d8 * 8 + 4] * __uint_as_float(v.z << 16) + s_q[d8 * 8 + 5] * __uint_as_float(v.z & 0xffff0000u);
            acc += s_q[d8 * 8 + 6] * __uint_as_float(v.w << 16) + s_q[d8 * 8 + 7] * __uint_as_float(v.w & 0xffff0000u);
        }
        const float sv = acc + bias;
        s_sc[k] = sv; s_vi[k] = vi; mx = fmaxf(mx, sv);
    }
    mx = wave_max(mx);
    float sinkv = 0.f;
    if (!na) { sinkv = p.gqa_sink[l * 6 + h]; mx = fmaxf(mx, sinkv); }
    asm volatile("s_waitcnt lgkmcnt(0)" ::: "memory");
    float sum = 0.f;
    for (int k = lane; k < ntot; k += 64) { const float e = __expf(s_sc[k] - mx); s_sc[k] = e; sum += e; }
    sum = wave_sum(sum);
    if (!na) sum += __expf(sinkv - mx);
    asm volatile("s_waitcnt lgkmcnt(0)" ::: "memory");
    const bf16_t* vt_lat = na ? (const bf16_t*)(p.ws + OFF_NAVT) + (size_t)((b * 6 + h) * 64 + lane) * S : (const bf16_t*)(p.ws + OFF_GVT) + (size_t)((b * 2 + kvh) * 64 + lane) * S;
    const bf16_t* vt_ctx = na ? (const bf16_t*)(p.ws + OFF_NAVTC) + (size_t)((b * 6 + h) * 64 + lane) * CTX : (const bf16_t*)(p.ws + OFF_GVTC) + (size_t)((b * 2 + kvh) * 64 + lane) * CTX;
    float o = 0.f;
    for (int k = 0; k < ntot; ++k) { const int vi = s_vi[k]; const float pv = s_sc[k]; const bf16_t vv = vi >= 0 ? vt_lat[vi] : vt_ctx[-1 - vi]; o += pv * bf2f(vv); }
    o /= sum;
    ((bf16_t*)(p.ws + OFF_X1))[(size_t)R * D + (na ? 256 : 640) + h * 64 + lane] = f2bf(o);
    asm volatile("s_waitcnt lgkmcnt(0)" ::: "memory");
}
DEV void ph_attn_naive(const Params& p, int l, int nrows, unsigned char* smem) {
    const int w = tid_() >> 6;
    float* s_sc = (float*)smem + w * 528; int* s_vi = (int*)(smem + 4 * 528 * 4) + w * 528; float* s_q = (float*)(smem + 8 * 528 * 4) + w * 64;
    const long ntask = (long)nrows * 12;
    for (long tk = (long)bid_() * 4 + w; tk < ntask; tk += (long)gridDim.x * 4) {
        const int R = (int)(tk / 12), hh = (int)(tk % 12);
        attn_naive_task(p, l, R, hh, s_sc, s_vi, s_q);
    }
}

DEV void outproj_item(const Params& p, int l, int rt, bf16_t* lds, float* stat  ) {
    const int t = tid_(), lane = t & 63, w = t >> 6, wm = w >> 1, wn = w & 1, fq = lane >> 4, fr = lane & 15;
    const bf16_t* A = (const bf16_t*)(p.ws + OFF_X1) + (size_t)(rt * 128 + (t >> 2)) * D + (t & 3) * 8;
    const bool isctx = rt >= 512;
    const float* g1 = modvec(p, l, rt * 128, 2);
#pragma unroll 1
    for (int pass = 0; pass < 4; ++pass) {
        const bf16_t* Bt = (const bf16_t*)(p.ws + OFF_WOUTT) + ((size_t)l * 1024 + pass * 256 + (t >> 2)) * 1024 + (t & 3) * 8;
        f32x4 acc[4][8]; zero_acc(acc);
        gemm_mainloop(A, A + 64 * D, Bt, 1024, 32, lds, acc);
#pragma unroll
        for (int mt = 0; mt < 4; ++mt) {
            const int rl = wm * 64 + mt * 16 + fr, R = rt * 128 + rl;
            const float* xin = (l == 0) ? (isctx ? p.ctx + (size_t)(R - NLAT) * D : p.x + (size_t)R * D) : xres_row(p, R);
            float* xo = xres_row(p, R);
            float s = 0.f, q = 0.f;
#pragma unroll
            for (int nt = 0; nt < 8; ++nt) {
                const int col = pass * 256 + wn * 128 + nt * 16 + fq * 4;
                const f32x4 xv = *(const f32x4*)(xin + col), gv = *(const f32x4*)(g1 + col);
                const f32x4 u = xv * ALPHA + gv * acc[mt][nt];
                *(f32x4*)(xo + col) = u;
                s += (u[0] + u[1]) + (u[2] + u[3]); q += (u[0] * u[0] + u[1] * u[1]) + (u[2] * u[2] + u[3] * u[3]);
            }
            s += __shfl_xor(s, 16); s += __shfl_xor(s, 32); q += __shfl_xor(q, 16); q += __shfl_xor(q, 32);
            if (fq == 0) { stat[((pass * 2 + wn) * 128 + rl) * 2] = s; stat[((pass * 2 + wn) * 128 + rl) * 2 + 1] = q; }
        }
    }
    __threadfence();
    __syncthreads();
    __builtin_amdgcn_fence(__ATOMIC_ACQUIRE, "agent");
    {
        const float* lg = p.ln1_g + l * D; const float* lb = p.ln1_b + l * D;
        const float* sh2 = modvec(p, l, rt * 128, 3); const float* sc2 = modvec(p, l, rt * 128, 4);
        bf16_t* X2 = (bf16_t*)(p.ws + OFF_X2);
        const bf16_t* WRh = (const bf16_t*)(p.ws + OFF_WR) + (size_t)(l * 2) * 48 * 1024 + (size_t)fr * 1024 + fq * 8;
        const bf16_t* WRl = WRh + 48 * 1024;
        float mean[2], rstd[2];
#pragma unroll
        for (int tm = 0; tm < 2; ++tm) {
            const int rl = w * 32 + tm * 16 + fr;
            float s = 0.f, q = 0.f;
#pragma unroll
            for (int i = 0; i < 8; ++i) { s += stat[(i * 128 + rl) * 2]; q += stat[(i * 128 + rl) * 2 + 1]; }
            mean[tm] = s * (1.f / D);
            rstd[tm] = rsqrtf(fmaxf(q * (1.f / D) - mean[tm] * mean[tm], 0.f) + LN_EPS);
        }
        f32x4 lacc[3][2];
#pragma unroll
        for (int a = 0; a < 3; ++a) { lacc[a][0] = (f32x4){0.f, 0.f, 0.f, 0.f}; lacc[a][1] = (f32x4){0.f, 0.f, 0.f, 0.f}; }
#pragma unroll 2
        for (int ks = 0; ks < 32; ++ks) {
            const int k = ks * 32 + fq * 8;
            const f32x4 g0 = *(const f32x4*)(lg + k), g1v = *(const f32x4*)(lg + k + 4), b0 = *(const f32x4*)(lb + k), b1 = *(const f32x4*)(lb + k + 4);
            const f32x4 s0 = *(const f32x4*)(sh2 + k), s1 = *(const f32x4*)(sh2 + k + 4), c0 = *(const f32x4*)(sc2 + k), c1 = *(const f32x4*)(sc2 + k + 4);
            bf16x8 hh[2], hl[2];
#pragma unroll
            for (int tm = 0; tm < 2; ++tm) {
                const int R = rt * 128 + w * 32 + tm * 16 + fr;
                float* xr = xres_row(p, R) + k;
                const f32x4 u0 = *(const f32x4*)xr, u1 = *(const f32x4*)(xr + 4);
                const f32x4 x0 = (u0 - mean[tm]) * rstd[tm] * g0 + b0, x1 = (u1 - mean[tm]) * rstd[tm] * g1v + b1;
                *(f32x4*)xr = x0; *(f32x4*)(xr + 4) = x1;
                const f32x4 h0 = x0 * (c0 + 1.f) + s0, h1 = x1 * (c1 + 1.f) + s1;
#pragma unroll
                for (int e = 0; e < 4; ++e) {
                    const bf16_t a = f2bf(h0[e]), b = f2bf(h1[e]);
                    hh[tm][e] = (short)a; hh[tm][4 + e] = (short)b;
                    hl[tm][e] = (short)f2bf(h0[e] - bf2f(a)); hl[tm][4 + e] = (short)f2bf(h1[e] - bf2f(b));
                }
                *(bf16x8*)(X2 + (size_t)R * D + k) = hh[tm];
            }
#pragma unroll
            for (int ft = 0; ft < 3; ++ft) {
                const bf16x8 wh = *(const bf16x8*)(WRh + (size_t)ft * 16 * 1024 + ks * 32), wl = *(const bf16x8*)(WRl + (size_t)ft * 16 * 1024 + ks * 32);
#pragma unroll
                for (int tm = 0; tm < 2; ++tm) {
                    lacc[ft][tm] = __builtin_amdgcn_mfma_f32_16x16x32_bf16(wh, hh[tm], lacc[ft][tm], 0, 0, 0);
                    lacc[ft][tm] = __builtin_amdgcn_mfma_f32_16x16x32_bf16(wl, hh[tm], lacc[ft][tm], 0, 0, 0);
                    lacc[ft][tm] = __builtin_amdgcn_mfma_f32_16x16x32_bf16(wh, hl[tm], lacc[ft][tm], 0, 0, 0);
                }
            }
        }
        float* lt = (float*)lds;
#pragma unroll
        for (int ft = 0; ft < 3; ++ft)
#pragma unroll
            for (int tm = 0; tm < 2; ++tm)
#pragma unroll
                for (int j = 0; j < 4; ++j) lt[(w * 32 + tm * 16 + fr) * 48 + ft * 16 + fq * 4 + j] = lacc[ft][tm][j];
        asm volatile("s_waitcnt lgkmcnt(0)" ::: "memory");
        if (lane < 32) {
            const int rl = w * 32 + lane, R = rt * 128 + rl;
            const float* lr = lt + rl * 48;
            int gi = 0; float gm = lr[0] + p.router_g_b[l * 4];
            float gl[4]; gl[0] = gm;
#pragma unroll
            for (int j = 1; j < 4; ++j) { gl[j] = lr[j] + p.router_g_b[l * 4 + j]; if (gl[j] > gm) { gm = gl[j]; gi = j; } }
            float gs = 0.f;
#pragma unroll
            for (int j = 0; j < 4; ++j) gs += expf(gl[j] - gm);
            const float ptop = 1.f / gs;
            int e0 = 0, e1 = 0; float m0 = -INFINITY, m1 = -INFINITY;
            for (int j = 0; j < 8; ++j) {
                const float v = lr[4 + gi * 8 + j] + p.router_e_b[l * 32 + gi * 8 + j];
                if (v > m0) { m1 = m0; e1 = e0; m0 = v; e0 = j; } else if (v > m1) { m1 = v; e1 = j; }
            }
            const float ex = expf(m1 - m0);
            const float w0 = ptop / (1.f + ex), w1 = ptop * ex / (1.f + ex);
            int* rte = (int*)(p.ws + OFF_RTE); float* rtw = (float*)(p.ws + OFF_RTW);
            unsigned* cnt = (unsigned*)(p.ws + OFF_CTL) + CW_CNT + l * 32;
            int* list = (int*)(p.ws + OFF_LIST);
            const int E0 = gi * 8 + e0, E1 = gi * 8 + e1;
            rte[R * 2] = E0; rte[R * 2 + 1] = E1; rtw[R * 2] = w0; rtw[R * 2 + 1] = w1;
            const unsigned p0 = atomicAdd(cnt + E0, 1u); list[(size_t)E0 * LISTCAP + p0] = R * 2;
            const unsigned p1 = atomicAdd(cnt + E1, 1u); list[(size_t)E1 * LISTCAP + p1] = R * 2 + 1;
        }
    }
}
DEV void ph_outproj(const Params& p, int l, bf16_t* lds, float* stat  ) {
    const int ntiles = (l == 0) ? 528 : 512;
    for (int rt = bid_(); rt < ntiles; rt += gridDim.x) { outproj_item(p, l, rt, lds, stat); __syncthreads(); }
}

DEV void moe_item(const Params& p, int l, int e, int j, int item, int cnt, bf16_t* lds) {
    const int t = tid_(), lane = t & 63, w = t >> 6, wm = w >> 1, wn = w & 1, fq = lane >> 4, fr = lane & 15;
    const int* list = (const int*)(p.ws + OFF_LIST) + (size_t)e * LISTCAP;
    const bf16_t* X2 = (const bf16_t*)(p.ws + OFF_X2);
    bf16_t* Hs = (bf16_t*)(p.ws + OFF_P) + (size_t)item * 128 * FF;
    const bf16_t *ap0, *ap1;
    { const int s0 = j * 128 + (t >> 2), s1 = s0 + 64;
      const int tok0 = s0 < cnt ? (list[s0] >> 1) : 0, tok1 = s1 < cnt ? (list[s1] >> 1) : 0;
      ap0 = X2 + (size_t)tok0 * D + (t & 3) * 8; ap1 = X2 + (size_t)tok1 * D + (t & 3) * 8; }
#pragma unroll 1
    for (int pass = 0; pass < 4; ++pass) {
        const bf16_t* Bt = (const bf16_t*)(p.ws + OFF_WGU) + ((size_t)e * 1024 + pass * 256 + (t >> 2)) * 1024 + (t & 3) * 8;
        f32x4 acc[4][8]; zero_acc(acc);
        gemm_mainloop(ap0, ap1, Bt, 1024, 32, lds, acc);
#pragma unroll
        for (int mt = 0; mt < 4; ++mt) {
            const int rl = wm * 64 + mt * 16 + fr;
#pragma unroll
            for (int nt = 0; nt < 4; ++nt) {
                const f32x4 gv = acc[mt][nt], uv = acc[mt][nt + 4];
                float hv[4];
#pragma unroll
                for (int jj = 0; jj < 4; ++jj) hv[jj] = gv[jj] / (1.f + __expf(-gv[jj])) * uv[jj];
                uint2 o; o.x = pk2(hv[0], hv[1]); o.y = pk2(hv[2], hv[3]);
                *(uint2*)(Hs + (size_t)rl * FF + pass * 128 + wn * 64 + nt * 16 + fq * 4) = o;
            }
        }
    }
    __threadfence();
    __syncthreads();
    __builtin_amdgcn_fence(__ATOMIC_ACQUIRE, "agent");
    const bf16_t* A = Hs + (size_t)(t >> 2) * FF + (t & 3) * 8;
    const float* rtw = (const float*)(p.ws + OFF_RTW);
    bf16_t* Y = (bf16_t*)(p.ws + OFF_Y);
#pragma unroll 1
    for (int pass = 0; pass < 4; ++pass) {
        const bf16_t* Bt = (const bf16_t*)(p.ws + OFF_WD) + ((size_t)e * 1024 + pass * 256 + (t >> 2)) * FF + (t & 3) * 8;
        f32x4 acc[4][8]; zero_acc(acc);
        gemm_mainloop(A, A + 64 * FF, Bt, FF, 16, lds, acc);
#pragma unroll
        for (int mt = 0; mt < 4; ++mt) {
            const int s = j * 128 + wm * 64 + mt * 16 + fr;
            if (s < cnt) {
                const int ent = list[s];
                const float gw = rtw[ent];
                bf16_t* yo = Y + (size_t)ent * D + pass * 256 + wn * 128 + fq * 4;
#pragma unroll
                for (int nt = 0; nt < 8; ++nt) { const f32x4 v = acc[mt][nt] * gw; uint2 o; o.x = pk2(v[0], v[1]); o.y = pk2(v[2], v[3]); *(uint2*)(yo + nt * 16) = o; }
            }
        }
    }
}
DEV void ph_moe(const Params& p, int l, bf16_t* lds, int* s_pref  , int* s_cnt  ) {
    const unsigned* cnt = (const unsigned*)(p.ws + OFF_CTL) + CW_CNT + l * 32;
    if (tid_() == 0) { int a = 0; for (int e = 0; e < 32; ++e) { const int c = (int)cnt[e]; s_cnt[e] = c; s_pref[e] = a; a += (c + 127) >> 7; } s_pref[32] = a; }
    __syncthreads();
    const int nitems = s_pref[32];
    for (int it = bid_(); it < nitems; it += gridDim.x) {
        int e = 0;
        while (e < 31 && it >= s_pref[e + 1]) ++e;
        moe_item(p, l, e, it - s_pref[e], it, s_cnt[e], lds);
        __syncthreads();
    }
}

namespace cg = cooperative_groups;
constexpr int SMEM_BYTES = GEMM_LDS_ELEMS * 2 + 8 * 128 * 2 * 4 + 512;
constexpr int NPHASE = 16;
__global__ void __launch_bounds__(256, 2) mega(Params p, int ph_lo, int ph_hi) {
    __shared__ __attribute__((aligned(16))) unsigned char smem[SMEM_BYTES];
    bf16_t* lds = (bf16_t*)smem;
    float* stat = (float*)(smem + GEMM_LDS_ELEMS * 2);
    int* s_pref = (int*)(smem + GEMM_LDS_ELEMS * 2 + 8 * 128 * 2 * 4); int* s_cnt = s_pref + 40;
    unsigned char* ws = p.ws;
#define IN(k) (ph_lo <= (k) && (k) < ph_hi)
#define SEAM(k) do { if (IN(k) && IN((k) + 1)) cg::this_grid().sync(); } while (0)
    if (IN(0)) {
        ph_mod(p, (float*)smem); __syncthreads();
        ph_rope(p);
        ph_routerw(p);
        ph_transpose(p.w_in, (bf16_t*)(ws + OFF_WINT), 1024, 2304, 0, 2, (size_t)1024 * 2304, (size_t)2304 * 1024, (float*)smem);
        ph_transpose(p.w_out, (bf16_t*)(ws + OFF_WOUTT), 1024, 1024, 0, 2, (size_t)1024 * 1024, (size_t)1024 * 1024, (float*)smem);
    }
    SEAM(0);
#pragma unroll 1
    for (int l = 0; l < 2; ++l) {
        const int pb = 1 + l * 7;
        if (IN(pb + 0)) { if (l == 0) ph_rowop<0>(p, 0, NTOK); else ph_rowop<1>(p, 1, NTOK); }
        SEAM(pb + 0);
        if (IN(pb + 1)) ph_inproj(p, l, lds);
        SEAM(pb + 1);
        if (IN(pb + 2)) {
            ph_rg1(p, l, (float*)smem); __syncthreads();
            ph_attn_naive(p, l, l == 0 ? NTOK : NLAT, smem); __syncthreads();
            ph_transpose(p.exp_w_gate + (size_t)l * NE * 1024 * 512, (bf16_t*)(ws + OFF_WGU), 1024, 512, 1, NE, (size_t)1024 * 512, (size_t)1024 * 1024, (float*)smem);
            ph_transpose(p.exp_w_up + (size_t)l * NE * 1024 * 512, (bf16_t*)(ws + OFF_WGU), 1024, 512, 2, NE, (size_t)1024 * 512, (size_t)1024 * 1024, (float*)smem);
            ph_transpose(p.exp_w_down + (size_t)l * NE * 512 * 1024, (bf16_t*)(ws + OFF_WD), 512, 1024, 0, NE, (size_t)512 * 1024, (size_t)1024 * 512, (float*)smem);
        }
        SEAM(pb + 2);
        if (IN(pb + 3)) ph_rg2(p);
        SEAM(pb + 3);
        if (IN(pb + 4)) ph_rg3(p, l == 0 ? NTOK : NLAT);
        SEAM(pb + 4);
        if (IN(pb + 5)) ph_outproj(p, l, lds, stat);
        SEAM(pb + 5);
        if (IN(pb + 6)) ph_moe(p, l, lds, s_pref, s_cnt);
        SEAM(pb + 6);
    }
    if (IN(NPHASE - 1)) ph_rowop<2>(p, 2, NLAT);
#undef IN
#undef SEAM
}

#ifndef ONE_LAUNCH
#define ONE_LAUNCH 1
#endif
extern "C" void kernel_launch(void* const* d_in, const int* in_sizes, int n_in, void* d_out, int out_size, void* d_ws, size_t ws_size, hipStream_t stream) {
    if (n_in != 28 || ws_size < WS_TOTAL || out_size != NLAT * D) { fprintf(stderr, "kernel_launch: unexpected shapes / workspace (%d inputs, ws %zu need %zu)\n", n_in, ws_size, (size_t)WS_TOTAL); return; }
    static int grid = 0;
    if (grid == 0) {
        int dev = 0, cus = 0, per_cu = 0;
        (void)hipGetDevice(&dev);
        (void)hipDeviceGetAttribute(&cus, hipDeviceAttributeMultiprocessorCount, dev);
        (void)hipOccupancyMaxActiveBlocksPerMultiprocessor(&per_cu, (const void*)mega, 256, 0);
        if (per_cu > 2) per_cu = 2;
        grid = cus * per_cu;
        if (grid <= 0) { fprintf(stderr, "kernel_launch: occupancy query gave %d blocks per CU on %d CUs\n", per_cu, cus); grid = -1; }
    }
    if (grid < 0) return;
    Params p{};
    const float** pp = (const float**)&p;
    for (int i = 0; i < 28; ++i) pp[i] = (const float*)d_in[i];
    p.out = (float*)d_out; p.ws = (unsigned char*)d_ws;
    (void)hipMemsetAsync((unsigned char*)d_ws + OFF_CTL, 0, CTL_BYTES, stream);
#if ONE_LAUNCH
    int lo = 0, hi = NPHASE;
    void* args[] = {(void*)&p, (void*)&lo, (void*)&hi};
    hipError_t e = hipLaunchCooperativeKernel((const void*)mega, dim3(grid), dim3(256), args, 0, stream);
    if (e != hipSuccess) fprintf(stderr, "kernel_launch: cooperative launch failed: %s (grid %d)\n", hipGetErrorString(e), grid);
#else
    for (int ph = 0; ph < NPHASE; ++ph) mega<<<grid, 256, 0, stream>>>(p, ph, ph + 1);
#endif
}
```

```cpp
#include <hip/hip_runtime.h>
#include <hip/hip_cooperative_groups.h>
#include <stdint.h>
#include <cstdio>

typedef unsigned short bf16_t;
typedef short bf16x8 __attribute__((ext_vector_type(8)));
typedef float f32x4 __attribute__((ext_vector_type(4)));

#define DEV __device__ __forceinline__

constexpr int D = 1024, NB = 8, S = 8192, CTX = 256;
constexpr int NLAT = NB * S, NCTX = NB * CTX, NTOK = NLAT + NCTX;
constexpr int PWS = 1792;
constexpr int COL_RGX = 0, COL_NAK = 256, COL_GK = 640, COL_GATE = 768, COL_NAQ = 1024, COL_GQ = 1408;
constexpr int NE = 32, FF = 512;
constexpr int LISTCAP = NTOK;
constexpr float ALPHA = 1.4142135623730951f;
constexpr float LN_EPS = 1e-5f;

constexpr size_t al256(size_t x) { return (x + 255) & ~(size_t)255; }
constexpr size_t OFF_CTL   = 0;
constexpr size_t CTL_BYTES = 4096;
constexpr size_t OFF_MOD   = OFF_CTL + CTL_BYTES;
constexpr size_t OFF_ROPE  = al256(OFF_MOD + (size_t)2 * 9 * 6144 * 4);
constexpr size_t OFF_RTE   = al256(OFF_ROPE + (size_t)2 * 128 * 16 * 4);
constexpr size_t OFF_RTW   = al256(OFF_RTE + (size_t)NTOK * 8);
constexpr size_t OFF_LIST  = al256(OFF_RTW + (size_t)NTOK * 8);
constexpr size_t OFF_WR    = al256(OFF_LIST + (size_t)NE * LISTCAP * 4);
constexpr size_t OFF_WINT  = al256(OFF_WR + (size_t)2 * 2 * 48 * 1024 * 2);
constexpr size_t OFF_WOUTT = al256(OFF_WINT + (size_t)2 * 2304 * 1024 * 2);
constexpr size_t OFF_WGU   = al256(OFF_WOUTT + (size_t)2 * 1024 * 1024 * 2);
constexpr size_t OFF_WD    = al256(OFF_WGU + (size_t)NE * 1024 * 1024 * 2);
constexpr size_t OFF_XCTX  = al256(OFF_WD + (size_t)NE * 1024 * 512 * 2);
constexpr size_t OFF_X1    = al256(OFF_XCTX + (size_t)NCTX * D * 4);
constexpr size_t OFF_X2    = al256(OFF_X1 + (size_t)NTOK * D * 2);
constexpr size_t OFF_P     = al256(OFF_X2 + (size_t)NTOK * D * 2);
constexpr size_t OFF_NAVT  = al256(OFF_P + (size_t)NTOK * PWS * 2);
constexpr size_t OFF_NAVTC = al256(OFF_NAVT + (size_t)NB * 6 * 64 * S * 2);
constexpr size_t OFF_GVT   = al256(OFF_NAVTC + (size_t)NB * 6 * 64 * CTX * 2);
constexpr size_t OFF_GVTC  = al256(OFF_GVT + (size_t)NB * 2 * 64 * S * 2);
constexpr size_t OFF_Y     = al256(OFF_GVTC + (size_t)NB * 2 * 64 * CTX * 2);
constexpr size_t WS_TOTAL  = al256(OFF_Y + (size_t)2 * NTOK * D * 2);
constexpr int CW_CNT = 0;

struct Params {
    const float *x, *c, *ctx, *c_ctx, *w_ada, *b_ada, *w_in, *conv_w, *conv_b, *rg_a_w, *rg_a_b, *rg_i_w, *rg_i_b, *rg_lambda,
        *na_rpb, *gqa_sink, *w_out, *ln1_g, *ln1_b, *router_g_w, *router_g_b, *router_e_w, *router_e_b, *exp_w_gate, *exp_w_up,
        *exp_w_down, *ln2_g, *ln2_b;
    float* out;
    unsigned char* ws;
};

DEV int tid_() { int t = threadIdx.x; asm volatile("" : "+v"(t)); return t; }
DEV int bid_() { int b = blockIdx.x; asm volatile("" : "+s"(b)); return b; }
DEV float bf2f(bf16_t h) { return __uint_as_float((unsigned)h << 16); }
DEV bf16_t f2bf(float f) { unsigned u = __float_as_uint(f); u += 0x7fffu + ((u >> 16) & 1u); return (bf16_t)(u >> 16); }
DEV unsigned pk2(float lo, float hi) { return (unsigned)f2bf(lo) | ((unsigned)f2bf(hi) << 16); }
DEV float wave_sum(float v) {
#pragma unroll
    for (int o = 1; o < 64; o <<= 1) v += __shfl_xor(v, o);
    return v;
}
DEV float wave_max(float v) {
#pragma unroll
    for (int o = 1; o < 64; o <<= 1) v = fmaxf(v, __shfl_xor(v, o));
    return v;
}
DEV float sigmoidf_(float x) { return 1.f / (1.f + __expf(-x)); }
DEV float gelu_tanh(float x) {
    const float u = 0.7978845608028654f * (x + 0.044715f * x * x * x);
    const float t = 1.f - 2.f / (1.f + __expf(2.f * u));
    return 0.5f * x * (1.f + t);
}
DEV float* xres_row(const Params& p, int R) {
    return R < NLAT ? p.out + (size_t)R * D : (float*)(p.ws + OFF_XCTX) + (size_t)(R - NLAT) * D;
}
DEV const float* modvec(const Params& p, int l, int R, int seg) {
    const int b = R < NLAT ? R / S : 8;
    return (const float*)(p.ws + OFF_MOD) + ((size_t)(l * 9 + b) * 6 + seg) * 1024;
}

DEV void ph_mod(const Params& p, float* sc  ) {
    if (bid_() >= 48) return;
    for (int i = tid_(); i < 9 * 1024; i += 256) { const float v = (i < 8192) ? p.c[i] : p.c_ctx[i - 8192]; sc[i] = v / (1.f + expf(-v)); }
    __syncthreads();
    const int col = bid_() * 256 + tid_();
    const int l = col / 6144, j = col % 6144;
    const float* w = p.w_ada + (size_t)l * 1024 * 6144 + j;
    float a0 = 0, a1 = 0, a2 = 0, a3 = 0, a4 = 0, a5 = 0, a6 = 0, a7 = 0, a8 = 0;
    for (int k = 0; k < 1024; ++k) {
        const float wv = w[(size_t)k * 6144];
        a0 += sc[k] * wv; a1 += sc[1024 + k] * wv; a2 += sc[2048 + k] * wv; a3 += sc[3072 + k] * wv; a4 += sc[4096 + k] * wv;
        a5 += sc[5120 + k] * wv; a6 += sc[6144 + k] * wv; a7 += sc[7168 + k] * wv; a8 += sc[8192 + k] * wv;
    }
    const float bias = p.b_ada[l * 6144 + j];
    float* mod = (float*)(p.ws + OFF_MOD) + (size_t)l * 9 * 6144 + j;
    mod[0 * 6144] = a0 + bias; mod[1 * 6144] = a1 + bias; mod[2 * 6144] = a2 + bias; mod[3 * 6144] = a3 + bias; mod[4 * 6144] = a4 + bias;
    mod[5 * 6144] = a5 + bias; mod[6 * 6144] = a6 + bias; mod[7 * 6144] = a7 + bias; mod[8 * 6144] = a8 + bias;
}

DEV void sincos_red(float ang, float& sn, float& cs) {
    const float n = rintf(ang * 0.15915494309189535f);
    float r = fmaf(-n, 6.2831854820251465f, ang);
    r = fmaf(-n, -1.7484555e-07f, r);
    float sgn = 1.f;
    if (r > 1.5707963267948966f) { r = 3.14159265358979f - r; sgn = -1.f; }
    else if (r < -1.5707963267948966f) { r = -3.14159265358979f - r; sgn = -1.f; }
    const float r2 = r * r;
    float sp = -1.6059044e-10f; sp = fmaf(sp, r2, 2.5052108e-08f); sp = fmaf(sp, r2, -2.7557319e-06f); sp = fmaf(sp, r2, 1.9841270e-04f);
    sp = fmaf(sp, r2, -8.3333333e-03f); sp = fmaf(sp, r2, 1.6666667e-01f); sp = fmaf(sp * -1.f, r2, 1.f);
    sn = r * sp;
    float cp = -1.1470746e-11f; cp = fmaf(cp, r2, 2.0876757e-09f); cp = fmaf(cp, r2, -2.7557319e-07f); cp = fmaf(cp, r2, 2.4801587e-05f);
    cp = fmaf(cp, r2, -1.3888889e-03f); cp = fmaf(cp, r2, 4.1666667e-02f); cp = fmaf(cp, r2, -0.5f); cp = fmaf(cp, r2, 1.f);
    cs = sgn * cp;
}
DEV void ph_rope(const Params& p) {
    const int i = (bid_() - 48) * 256 + tid_();
    if (i < 0 || i >= 128 * 16) return;
    const int pos = i >> 4, q = i & 15;
    const float inv = exp2f(-(float)q * (13.287712379549449f / 16.f));
    float sn, cs; sincos_red((float)pos * inv, sn, cs);
    float* tab = (float*)(p.ws + OFF_ROPE);
    tab[i] = cs; tab[2048 + i] = sn;
}

DEV void ph_routerw(const Params& p) {
  for (int i = bid_() * 256 + tid_(); i < 2 * 48 * 1024; i += gridDim.x * 256) {
    const int l = i / (48 * 1024), f = (i / 1024) % 48, k = i & 1023;
    float w = 0.f;
    if (f < 4) w = p.router_g_w[((size_t)l * 1024 + k) * 4 + f]; else if (f < 36) w = p.router_e_w[((size_t)l * 1024 + k) * 32 + (f - 4)];
    const bf16_t hi = f2bf(w), lo = f2bf(w - bf2f(hi));
    bf16_t* WR = (bf16_t*)(p.ws + OFF_WR);
    WR[((size_t)(l * 2 + 0) * 48 + f) * 1024 + k] = hi;
    WR[((size_t)(l * 2 + 1) * 48 + f) * 1024 + k] = lo;
  }
}

DEV int tr_row(int n, int mode) { return mode == 0 ? n : ((n >> 7) * 256 + ((n >> 6) & 1) * 128 + (n & 63) + (mode == 2 ? 64 : 0)); }
DEV void transpose_tile(const float* src, bf16_t* dst, int K, int N, int mode, int tile, float* lds) {
    const int ntn = N >> 6, kt = tile / ntn, nt = tile % ntn, k0 = kt * 64, n0 = nt * 64, t = tid_();
#pragma unroll
    for (int i = 0; i < 4; ++i) {
        const int r = (t >> 4) + 16 * i, c4 = (t & 15) * 4;
        const float4 v = *(const float4*)(src + (size_t)(k0 + r) * N + n0 + c4);
        lds[r * 65 + c4] = v.x; lds[r * 65 + c4 + 1] = v.y; lds[r * 65 + c4 + 2] = v.z; lds[r * 65 + c4 + 3] = v.w;
    }
    __syncthreads();
#pragma unroll
    for (int i = 0; i < 2; ++i) {
        const int n = (t >> 3) + 32 * i, kc = (t & 7) * 8;
        uint4 o;
        o.x = pk2(lds[(kc + 0) * 65 + n], lds[(kc + 1) * 65 + n]); o.y = pk2(lds[(kc + 2) * 65 + n], lds[(kc + 3) * 65 + n]);
        o.z = pk2(lds[(kc + 4) * 65 + n], lds[(kc + 5) * 65 + n]); o.w = pk2(lds[(kc + 6) * 65 + n], lds[(kc + 7) * 65 + n]);
        *(uint4*)(dst + (size_t)tr_row(n0 + n, mode) * K + k0 + kc) = o;
    }
    __syncthreads();
}
DEV void ph_transpose(const float* src, bf16_t* dst, int K, int N, int mode, int nmat, size_t sstride, size_t dstride, float* lds  ) {
    const int per = (K >> 6) * (N >> 6);
    for (int it = bid_(); it < nmat * per; it += gridDim.x) {
        const int m = it / per, tile = it % per;
        transpose_tile(src + (size_t)m * sstride, dst + (size_t)m * dstride, K, N, mode, tile, lds);
    }
}

template <int MODE> DEV void rowop(const Params& p, int l, int R) {
    const int lane = tid_() & 63;
    float4 v[4];
    if (MODE == 0) {
        const float* src = R < NLAT ? p.x + (size_t)R * D : p.ctx + (size_t)(R - NLAT) * D;
#pragma unroll
        for (int i = 0; i < 4; ++i) v[i] = *(const float4*)(src + i * 256 + lane * 4);
    } else {
        float* xr = xres_row(p, R);
        const float* g2 = modvec(p, l - 1, R, 5);
        const bf16_t* y0 = (const bf16_t*)(p.ws + OFF_Y) + (size_t)(2 * R) * D;
        const bf16_t* y1 = y0 + D;
        const float* lg = p.ln2_g + (l - 1) * D; const float* lb = p.ln2_b + (l - 1) * D;
        float s = 0.f;
#pragma unroll
        for (int i = 0; i < 4; ++i) {
            const int k = i * 256 + lane * 4;
            const float4 xv = *(const float4*)(xr + k); const float4 gv = *(const float4*)(g2 + k);
            const uint2 a = *(const uint2*)(y0 + k); const uint2 b = *(const uint2*)(y1 + k);
            float4 u;
            u.x = ALPHA * xv.x + gv.x * (bf2f((bf16_t)(a.x & 0xffff)) + bf2f((bf16_t)(b.x & 0xffff)));
            u.y = ALPHA * xv.y + gv.y * (bf2f((bf16_t)(a.x >> 16)) + bf2f((bf16_t)(b.x >> 16)));
            u.z = ALPHA * xv.z + gv.z * (bf2f((bf16_t)(a.y & 0xffff)) + bf2f((bf16_t)(b.y & 0xffff)));
            u.w = ALPHA * xv.w + gv.w * (bf2f((bf16_t)(a.y >> 16)) + bf2f((bf16_t)(b.y >> 16)));
            v[i] = u; s += (u.x + u.y) + (u.z + u.w);
        }
        const float mean = wave_sum(s) * (1.f / D);
        float q = 0.f;
#pragma unroll
        for (int i = 0; i < 4; ++i) { v[i].x -= mean; v[i].y -= mean; v[i].z -= mean; v[i].w -= mean; q += (v[i].x * v[i].x + v[i].y * v[i].y) + (v[i].z * v[i].z + v[i].w * v[i].w); }
        const float rstd = rsqrtf(wave_sum(q) * (1.f / D) + LN_EPS);
#pragma unroll
        for (int i = 0; i < 4; ++i) {
            const int k = i * 256 + lane * 4;
            const float4 gg = *(const float4*)(lg + k); const float4 bb = *(const float4*)(lb + k);
            v[i].x = v[i].x * rstd * gg.x + bb.x; v[i].y = v[i].y * rstd * gg.y + bb.y; v[i].z = v[i].z * rstd * gg.z + bb.z; v[i].w = v[i].w * rstd * gg.w + bb.w;
            *(float4*)(xr + k) = v[i];
        }
    }
    if (MODE != 2) {
        const float* sh = modvec(p, l, R, 0); const float* sc = modvec(p, l, R, 1);
        bf16_t* ha = (bf16_t*)(p.ws + OFF_X1) + (size_t)R * D;
#pragma unroll
        for (int i = 0; i < 4; ++i) {
            const int k = i * 256 + lane * 4;
            const float4 s4 = *(const float4*)(sh + k); const float4 c4 = *(const float4*)(sc + k);
            uint2 o; o.x = pk2(v[i].x * (1.f + c4.x) + s4.x, v[i].y * (1.f + c4.y) + s4.y); o.y = pk2(v[i].z * (1.f + c4.z) + s4.z, v[i].w * (1.f + c4.w) + s4.w);
            *(uint2*)(ha + k) = o;
        }
    }
}
template <int MODE> DEV void ph_rowop(const Params& p, int l, int nrows) {
    const int w = tid_() >> 6;
    for (int R = bid_() * 4 + w; R < nrows; R += gridDim.x * 4) rowop<MODE>(p, l, R);
}

constexpr int GEMM_LDS_ELEMS = 2 * (128 + 256) * 32;
DEV void gemm_mainloop(const bf16_t* a0, const bf16_t* a1, const bf16_t* bp, size_t ldb, int nk, bf16_t* lds, f32x4 (&acc)[4][8]) {
    const int t = tid_(), lane = t & 63, w = t >> 6, wm = w >> 1, wn = w & 1;
    const int wofs = (t >> 2) * 32 + (((t & 3) ^ ((0 - (t >> 4)) & 3)) * 8);
    const int pc = ((lane >> 4) ^ ((0 - ((lane & 15) >> 2)) & 3)) * 8;
    const int arow = (wm * 64 + (lane & 15)) * 32 + pc, brow = (128 + wn * 128 + (lane & 15)) * 32 + pc;
    const bf16_t* b1 = bp + (size_t)64 * ldb; const bf16_t* b2 = bp + (size_t)128 * ldb; const bf16_t* b3 = bp + (size_t)192 * ldb;
    uint4 ra0 = *(const uint4*)a0, ra1 = *(const uint4*)a1;
    uint4 rb0 = *(const uint4*)bp, rb1 = *(const uint4*)b1, rb2 = *(const uint4*)b2, rb3 = *(const uint4*)b3;
    __syncthreads();
    *(uint4*)(lds + wofs) = ra0; *(uint4*)(lds + wofs + 64 * 32) = ra1;
    *(uint4*)(lds + 128 * 32 + wofs) = rb0; *(uint4*)(lds + 192 * 32 + wofs) = rb1; *(uint4*)(lds + 256 * 32 + wofs) = rb2; *(uint4*)(lds + 320 * 32 + wofs) = rb3;
    __syncthreads();
    for (int kt = 0; kt < nk; ++kt) {
        const bf16_t* cur = lds + (kt & 1) * (384 * 32);
        bf16_t* nxt = lds + ((kt + 1) & 1) * (384 * 32);
        const bool more = kt + 1 < nk;
        if (more) {
            const int ko = (kt + 1) * 32;
            ra0 = *(const uint4*)(a0 + ko); ra1 = *(const uint4*)(a1 + ko);
            rb0 = *(const uint4*)(bp + ko); rb1 = *(const uint4*)(b1 + ko); rb2 = *(const uint4*)(b2 + ko); rb3 = *(const uint4*)(b3 + ko);
        }
        const bf16x8 af0 = *(const bf16x8*)(cur + arow), af1 = *(const bf16x8*)(cur + arow + 16 * 32), af2 = *(const bf16x8*)(cur + arow + 32 * 32), af3 = *(const bf16x8*)(cur + arow + 48 * 32);
#pragma unroll
        for (int nt = 0; nt < 8; ++nt) {
            const bf16x8 bfr = *(const bf16x8*)(cur + brow + nt * 16 * 32);
            acc[0][nt] = __builtin_amdgcn_mfma_f32_16x16x32_bf16(bfr, af0, acc[0][nt], 0, 0, 0);
            acc[1][nt] = __builtin_amdgcn_mfma_f32_16x16x32_bf16(bfr, af1, acc[1][nt], 0, 0, 0);
            acc[2][nt] = __builtin_amdgcn_mfma_f32_16x16x32_bf16(bfr, af2, acc[2][nt], 0, 0, 0);
            acc[3][nt] = __builtin_amdgcn_mfma_f32_16x16x32_bf16(bfr, af3, acc[3][nt], 0, 0, 0);
        }
        if (more) {
            *(uint4*)(nxt + wofs) = ra0; *(uint4*)(nxt + wofs + 64 * 32) = ra1;
            *(uint4*)(nxt + 128 * 32 + wofs) = rb0; *(uint4*)(nxt + 192 * 32 + wofs) = rb1; *(uint4*)(nxt + 256 * 32 + wofs) = rb2; *(uint4*)(nxt + 320 * 32 + wofs) = rb3;
        }
        __syncthreads();
    }
}
DEV void zero_acc(f32x4 (&acc)[4][8]) {
#pragma unroll
    for (int a = 0; a < 4; ++a)
#pragma unroll
        for (int b = 0; b < 8; ++b) acc[a][b] = (f32x4){0.f, 0.f, 0.f, 0.f};
}

DEV void inproj_item(const Params& p, int l, int rt, int pass, bf16_t* lds) {
    const int t = tid_(), lane = t & 63, w = t >> 6, wm = w >> 1, wn = w & 1;
    const bf16_t* A = (const bf16_t*)(p.ws + OFF_X1) + (size_t)(rt * 128 + (t >> 2)) * D + (t & 3) * 8;
    const bf16_t* Bt = (const bf16_t*)(p.ws + OFF_WINT) + ((size_t)l * 2304 + pass * 256 + (t >> 2)) * 1024 + (t & 3) * 8;
    f32x4 acc[4][8]; zero_acc(acc);
    gemm_mainloop(A, A + 64 * D, Bt, 1024, 32, lds, acc);
    bf16_t* P = (bf16_t*)(p.ws + OFF_P);
    const float* ctab = (const float*)(p.ws + OFF_ROPE); const float* stab = ctab + 2048;
    const bool isctx = rt >= 512;
    const int fq = lane >> 4, fr = lane & 15;
#pragma unroll
    for (int hci = 0; hci < 2; ++hci) {
        const int hc = pass * 4 + wn * 2 + hci;
        int type, dcol = 0, vh = 0;
        if (hc < 4) { type = 0; dcol = COL_RGX + hc * 64; }
        else if (hc < 10) { type = 0; dcol = COL_NAK + (hc - 4) * 64; }
        else if (hc < 16) { type = 4; vh = hc - 10; }
        else if (hc < 18) { type = 2; dcol = COL_GK + (hc - 16) * 64; }
        else if (hc < 20) { type = 5; vh = hc - 18; }
        else if (hc < 24) { type = 0; dcol = COL_GATE + (hc - 20) * 64; }
        else if (hc < 30) { type = 1; dcol = COL_NAQ + (hc - 24) * 64; }
        else { type = 3; dcol = COL_GQ + (hc - 30) * 64; }
#pragma unroll
        for (int mt = 0; mt < 4; ++mt) {
            const int R = rt * 128 + wm * 64 + mt * 16 + fr;
            f32x4 v0 = acc[mt][hci * 4 + 0], v1 = acc[mt][hci * 4 + 1], v2 = acc[mt][hci * 4 + 2], v3 = acc[mt][hci * 4 + 3];
            if ((type == 2 || type == 3) && !isctx) {
                const int tt = R & (S - 1), pr = tt >> 6, pc = tt & 63;
                const f32x4 cr = *(const f32x4*)(ctab + pr * 16 + fq * 4), sr = *(const f32x4*)(stab + pr * 16 + fq * 4);
                const f32x4 cc = *(const f32x4*)(ctab + pc * 16 + fq * 4), sc = *(const f32x4*)(stab + pc * 16 + fq * 4);
                const f32x4 o0 = v0 * cr - v1 * sr, o1 = v1 * cr + v0 * sr, o2 = v2 * cc - v3 * sc, o3 = v3 * cc + v2 * sc;
                v0 = o0; v1 = o1; v2 = o2; v3 = o3;
            }
            if (type == 1 || type == 3) { v0 = v0 * 0.125f; v1 = v1 * 0.125f; v2 = v2 * 0.125f; v3 = v3 * 0.125f; }
            if (type < 4) {
                bf16_t* o = P + (size_t)R * PWS + dcol + fq * 4;
                uint2 q;
                q.x = pk2(v0[0], v0[1]); q.y = pk2(v0[2], v0[3]); *(uint2*)(o) = q;
                q.x = pk2(v1[0], v1[1]); q.y = pk2(v1[2], v1[3]); *(uint2*)(o + 16) = q;
                q.x = pk2(v2[0], v2[1]); q.y = pk2(v2[2], v2[3]); *(uint2*)(o + 32) = q;
                q.x = pk2(v3[0], v3[1]); q.y = pk2(v3[2], v3[3]); *(uint2*)(o + 48) = q;
            } else {
                bf16_t* base; size_t dstride;
                if (!isctx) { const int b = R >> 13, tt = R & (S - 1);
                    base = (type == 4 ? (bf16_t*)(p.ws + OFF_NAVT) + (size_t)(b * 6 + vh) * 64 * S : (bf16_t*)(p.ws + OFF_GVT) + (size_t)(b * 2 + vh) * 64 * S) + tt; dstride = S; }
                else { const int cR = R - NLAT, b = cR >> 8, tt = cR & 255;
                    base = (type == 4 ? (bf16_t*)(p.ws + OFF_NAVTC) + (size_t)(b * 6 + vh) * 64 * CTX : (bf16_t*)(p.ws + OFF_GVTC) + (size_t)(b * 2 + vh) * 64 * CTX) + tt; dstride = CTX; }
#pragma unroll
                for (int j = 0; j < 4; ++j) {
                    base[(size_t)(0 * 16 + fq * 4 + j) * dstride] = f2bf(v0[j]);
                    base[(size_t)(1 * 16 + fq * 4 + j) * dstride] = f2bf(v1[j]);
                    base[(size_t)(2 * 16 + fq * 4 + j) * dstride] = f2bf(v2[j]);
                    base[(size_t)(3 * 16 + fq * 4 + j) * dstride] = f2bf(v3[j]);
                }
            }
        }
    }
}
DEV void ph_inproj(const Params& p, int l, bf16_t* lds) {
    const int nctxp = (l == 0) ? 9 : 5;
    const int nitems = 512 * 9 + 16 * nctxp;
    for (int it = bid_(); it < nitems; it += gridDim.x) {
        int rt, pass;
        if (it < 512 * 9) { rt = it / 9; pass = it % 9; } else { const int r = it - 512 * 9; rt = 512 + r / nctxp; pass = r % nctxp; }
        inproj_item(p, l, rt, pass, lds);
    }
}

DEV void ph_rg1(const Params& p, int l, float* xl  ) {
    const bf16_t* P = (const bf16_t*)(p.ws + OFF_P);
    float* AB = (float*)(p.ws + OFF_Y);
    const int c = tid_(), n = c >> 6, e = c & 63;
    for (int R = bid_(); R < NTOK; R += gridDim.x) {
        const bool isctx = R >= NLAT;
        const int L = isctx ? CTX : S, base = isctx ? NLAT + ((R - NLAT) / CTX) * CTX : (R / S) * S, tt = R - base;
        float acc = p.conv_b[l * 256 + c];
#pragma unroll
        for (int j = 0; j < 4; ++j) { const int ts = tt + j - 2; if (ts >= 0 && ts < L) acc += p.conv_w[(l * 4 + j) * 256 + c] * bf2f(P[(size_t)(base + ts) * PWS + COL_RGX + c]); }
        __syncthreads();
        xl[c] = acc;
        __syncthreads();
#pragma unroll
        for (int dir = 0; dir < 2; ++dir) {
            const float* wa = p.rg_a_w + ((size_t)((l * 2 + dir) * 4 + n) * 64) * 64 + e;
            const float* wi = p.rg_i_w + ((size_t)((l * 2 + dir) * 4 + n) * 64) * 64 + e;
            float za = p.rg_a_b[(l * 2 + dir) * 256 + c], zi = p.rg_i_b[(l * 2 + dir) * 256 + c];
#pragma unroll 8
            for (int d = 0; d < 64; ++d) { const float xv = xl[n * 64 + d]; za += xv * wa[d * 64]; zi += xv * wi[d * 64]; }
            const float r = 1.f / (1.f + expf(-za)), ig = 1.f / (1.f + expf(-zi));
            const float lam = p.rg_lambda[(l * 2 + dir) * 256 + c];
            const float sp = log1pf(expf(-lam));
            const float log_a = -8.f * r * sp;
            const float a = expf(log_a);
            const float bb = sqrtf(-expm1f(2.f * log_a)) * (ig * acc);
            AB[((size_t)R * 2 + dir) * 512 + c] = a;
            AB[((size_t)R * 2 + dir) * 512 + 256 + c] = bb;
        }
    }
}
DEV void ph_rg2(const Params& p) {
    const float* AB = (const float*)(p.ws + OFF_Y);
    float* H = (float*)(p.ws + OFF_X2);
    const int gid = bid_() * 256 + tid_();
    if (gid >= 4096) return;
    const int c = gid & 255, b = (gid >> 8) & 7, dir = gid >> 11;
    float h = 0.f;
    float* Hd = H + (size_t)dir * NTOK * 256;
    for (int seg = 0; seg < 2; ++seg) {
        const int L = seg == 0 ? CTX : S, base = seg == 0 ? NLAT + b * CTX : b * S;
#pragma unroll 8
        for (int s = 0; s < L; ++s) {
            const int tt = dir == 0 ? s : L - 1 - s;
            const size_t R = (size_t)base + tt;
            const float a = AB[(R * 2 + dir) * 512 + c], bb = AB[(R * 2 + dir) * 512 + 256 + c];
            h = a * h + bb;
            Hd[R * 256 + c] = h;
        }
    }
}
DEV void ph_rg3(const Params& p, int nrows) {
    const float* H = (const float*)(p.ws + OFF_X2);
    const bf16_t* P = (const bf16_t*)(p.ws + OFF_P);
    bf16_t* X1 = (bf16_t*)(p.ws + OFF_X1);
    const int c = tid_();
    for (int R = bid_(); R < nrows; R += gridDim.x) {
        const float hs = H[(size_t)R * 256 + c] + H[(size_t)NTOK * 256 + (size_t)R * 256 + c];
        const float gt = bf2f(P[(size_t)R * PWS + COL_GATE + c]);
        X1[(size_t)R * D + c] = f2bf(hs * gelu_tanh(gt));
    }
}

DEV void attn_naive_task(const Params& p, int l, int R, int hh, float* s_sc, int* s_vi, float* s_q) {
    const int lane = tid_() & 63;
    const bool isctx = R >= NLAT;
    const int b = isctx ? (R - NLAT) / CTX : R / S, tt = isctx ? (R - NLAT) % CTX : R % S;
    const bool na = hh < 6; const int h = na ? hh : hh - 6, kvh = h / 3;
    const bf16_t* P = (const bf16_t*)(p.ws + OFF_P);
    s_q[lane] = bf2f(P[(size_t)R * PWS + (na ? COL_NAQ : COL_GQ) + h * 64 + lane]);
    asm volatile("s_waitcnt lgkmcnt(0)" ::: "memory");
    int nloc = 0, r = 0, c = 0, rs = 0, cs = 0, j0 = 0;
    if (!isctx) {
        if (na) { r = tt >> 6; c = tt & 63; rs = min(max(r - 4, 0), 120); cs = min(max(c - 8, 0), 48); nloc = 128; }
        else { j0 = max(0, tt - 128); const int j1 = min(S - 1, tt + 128); nloc = j1 - j0 + 1; }
    }
    const int ntot = nloc + CTX;
    const int kcol = na ? COL_NAK + h * 64 : COL_GK + kvh * 64;
    float mx = -INFINITY;
    for (int k = lane; k < ntot; k += 64) {
        size_t krow; float bias = 0.f; int vi;
        if (k < nloc) {
            int tok;
            if (na) { const int ri = k >> 4, cj = k & 15; tok = (rs + ri) * 64 + cs + cj; bias = p.na_rpb[((size_t)(l * 6 + h) * 15 + (rs + ri - r + 7)) * 31 + (cs + cj - c + 15)]; }
            else tok = j0 + k;
            krow = (size_t)b * S + tok; vi = tok;
        } else { const int kc = k - nloc; krow = (size_t)NLAT + b * CTX + kc; vi = -1 - kc; }
        const bf16_t* kp = P + krow * PWS + kcol;
        float acc = 0.f;
#pragma unroll
        for (int d8 = 0; d8 < 8; ++d8) {
            const uint4 v = *(const uint4*)(kp + d8 * 8);
            acc += s_q[d8 * 8 + 0] * __uint_as_float(v.x << 16) + s_q[d8 * 8 + 1] * __uint_as_float(v.x & 0xffff0000u);
            acc += s_q[d8 * 8 + 2] * __uint_as_float(v.y << 16) + s_q[d8 * 8 + 3] * __uint_as_float(v.y & 0xffff0000u);
            acc += s_q[d8 * 8 + 4] * __uint_as_float(v.z << 16) + s_q[d8 * 8 + 5] * __uint_as_float(v.z & 0xffff0000u);
            acc += s_q[d8 * 8 + 6] * __uint_as_float(v.w << 16) + s_q[d8 * 8 + 7] * __uint_as_float(v.w & 0xffff0000u);
        }
        const float sv = acc + bias;
        s_sc[k] = sv; s_vi[k] = vi; mx = fmaxf(mx, sv);
    }
    mx = wave_max(mx);
    float sinkv = 0.f;
    if (!na) { sinkv = p.gqa_sink[l * 6 + h]; mx = fmaxf(mx, sinkv); }
    asm volatile("s_waitcnt lgkmcnt(0)" ::: "memory");
    float sum = 0.f;
    for (int k = lane; k < ntot; k += 64) { const float e = __expf(s_sc[k] - mx); s_sc[k] = e; sum += e; }
    sum = wave_sum(sum);
    if (!na) sum += __expf(sinkv - mx);
    asm volatile("s_waitcnt lgkmcnt(0)" ::: "memory");
    const bf16_t* vt_lat = na ? (const bf16_t*)(p.ws + OFF_NAVT) + (size_t)((b * 6 + h) * 64 + lane) * S : (const bf16_t*)(p.ws + OFF_GVT) + (size_t)((b * 2 + kvh) * 64 + lane) * S;
    const bf16_t* vt_ctx = na ? (const bf16_t*)(p.ws + OFF_NAVTC) + (size_t)((b * 6 + h) * 64 + lane) * CTX : (const bf16_t*)(p.ws + OFF_GVTC) + (size_t)((b * 2 + kvh) * 64 + lane) * CTX;
    float o = 0.f;
    for (int k = 0; k < ntot; ++k) { const int vi = s_vi[k]; const float pv = s_sc[k]; const bf16_t vv = vi >= 0 ? vt_lat[vi] : vt_ctx[-1 - vi]; o += pv * bf2f(vv); }
    o /= sum;
    ((bf16_t*)(p.ws + OFF_X1))[(size_t)R * D + (na ? 256 : 640) + h * 64 + lane] = f2bf(o);
    asm volatile("s_waitcnt lgkmcnt(0)" ::: "memory");
}
DEV void ph_attn_naive(const Params& p, int l, int nrows, unsigned char* smem) {
    const int w = tid_() >> 6;
    float* s_sc = (float*)smem + w * 528; int* s_vi = (int*)(smem + 4 * 528 * 4) + w * 528; float* s_q = (float*)(smem + 8 * 528 * 4) + w * 64;
    const long ntask = (long)nrows * 12;
    for (long tk = (long)bid_() * 4 + w; tk < ntask; tk += (long)gridDim.x * 4) {
        const int R = (int)(tk / 12), hh = (int)(tk % 12);
        attn_naive_task(p, l, R, hh, s_sc, s_vi, s_q);
    }
}

constexpr float LOG2E = 1.4426950408889634f;
struct AttnState { f32x4 o0, o1, o2, o3; float m, lsum; };
DEV bf16x8 ld16(const bf16_t* p) { return *(const bf16x8*)p; }
DEV bf16x8 ld8x2(const bf16_t* p0, const bf16_t* p1) {
    const uint2 a = *(const uint2*)p0, b = *(const uint2*)p1;
    union { uint4 u; bf16x8 v; } c; c.u = make_uint4(a.x, a.y, b.x, b.y); return c.v;
}
DEV void attn_pair(const bf16_t* k0, const bf16_t* k1, const bf16_t* v0, const bf16_t* v1, size_t vs16, const bf16x8& q0, const bf16x8& q1, f32x4 b0, f32x4 b1, AttnState& st) {
    const bf16x8 a00 = ld16(k0), a01 = ld16(k0 + 32), a10 = ld16(k1), a11 = ld16(k1 + 32);
    const bf16x8 vt0 = ld8x2(v0, v1), vt1 = ld8x2(v0 + vs16, v1 + vs16), vt2 = ld8x2(v0 + 2 * vs16, v1 + 2 * vs16), vt3 = ld8x2(v0 + 3 * vs16, v1 + 3 * vs16);
    const f32x4 z = {0.f, 0.f, 0.f, 0.f};
    f32x4 s0 = __builtin_amdgcn_mfma_f32_16x16x32_bf16(a00, q0, z, 0, 0, 0); s0 = __builtin_amdgcn_mfma_f32_16x16x32_bf16(a01, q1, s0, 0, 0, 0);
    f32x4 s1 = __builtin_amdgcn_mfma_f32_16x16x32_bf16(a10, q0, z, 0, 0, 0); s1 = __builtin_amdgcn_mfma_f32_16x16x32_bf16(a11, q1, s1, 0, 0, 0);
    s0 = s0 * LOG2E + b0; s1 = s1 * LOG2E + b1;
    float mx = fmaxf(fmaxf(fmaxf(s0[0], s0[1]), fmaxf(s0[2], s0[3])), fmaxf(fmaxf(s1[0], s1[1]), fmaxf(s1[2], s1[3])));
    mx = fmaxf(mx, __shfl_xor(mx, 16)); mx = fmaxf(mx, __shfl_xor(mx, 32));
    const float mn = fmaxf(st.m, mx);
    const float ms = (mn == -INFINITY) ? 0.f : mn;
    const float alpha = __builtin_amdgcn_exp2f(st.m - ms);
    f32x4 p0, p1;
#pragma unroll
    for (int j = 0; j < 4; ++j) { p0[j] = __builtin_amdgcn_exp2f(s0[j] - ms); p1[j] = __builtin_amdgcn_exp2f(s1[j] - ms); }
    st.lsum = st.lsum * alpha + ((p0[0] + p0[1]) + (p0[2] + p0[3])) + ((p1[0] + p1[1]) + (p1[2] + p1[3]));
    st.o0 = st.o0 * alpha; st.o1 = st.o1 * alpha; st.o2 = st.o2 * alpha; st.o3 = st.o3 * alpha;
    union { uint4 u; bf16x8 v; } pt; pt.u = make_uint4(pk2(p0[0], p0[1]), pk2(p0[2], p0[3]), pk2(p1[0], p1[1]), pk2(p1[2], p1[3]));
    st.o0 = __builtin_amdgcn_mfma_f32_16x16x32_bf16(vt0, pt.v, st.o0, 0, 0, 0);
    st.o1 = __builtin_amdgcn_mfma_f32_16x16x32_bf16(vt1, pt.v, st.o1, 0, 0, 0);
    st.o2 = __builtin_amdgcn_mfma_f32_16x16x32_bf16(vt2, pt.v, st.o2, 0, 0, 0);
    st.o3 = __builtin_amdgcn_mfma_f32_16x16x32_bf16(vt3, pt.v, st.o3, 0, 0, 0);
    st.m = mn;
}
DEV void attn_ctx_keys(const Params& p, int b, int kcol, const bf16_t* vtc  , const bf16x8& q0, const bf16x8& q1, AttnState& st, int lane) {
    const bf16_t* P = (const bf16_t*)(p.ws + OFF_P);
    const bf16_t* kb = P + (size_t)(NLAT + b * CTX + (lane & 15)) * PWS + kcol + (lane >> 4) * 8;
    const bf16_t* vb = vtc + (size_t)(lane & 15) * CTX + (lane >> 4) * 4;
    const f32x4 z = {0.f, 0.f, 0.f, 0.f};
#pragma unroll
    for (int pp = 0; pp < 8; ++pp) attn_pair(kb + (size_t)(pp * 32) * PWS, kb + (size_t)(pp * 32 + 16) * PWS, vb + pp * 32, vb + pp * 32 + 16, (size_t)16 * CTX, q0, q1, z, z, st);
}
DEV void attn_store(const Params& p, AttnState& st, int R0, int ocol, int lane, float sink2  ) {
    float l = st.lsum; l += __shfl_xor(l, 16); l += __shfl_xor(l, 32);
    float sc;
    if (sink2 != -INFINITY) { const float mf = fmaxf(st.m, sink2); const float al = __builtin_amdgcn_exp2f(st.m - mf); l = l * al + __builtin_amdgcn_exp2f(sink2 - mf); sc = al / l; }
    else sc = 1.f / l;
    bf16_t* o = (bf16_t*)(p.ws + OFF_X1) + (size_t)(R0 + (lane & 15)) * D + ocol + (lane >> 4) * 4;
    uint2 w;
    w.x = pk2(st.o0[0] * sc, st.o0[1] * sc); w.y = pk2(st.o0[2] * sc, st.o0[3] * sc); *(uint2*)(o) = w;
    w.x = pk2(st.o1[0] * sc, st.o1[1] * sc); w.y = pk2(st.o1[2] * sc, st.o1[3] * sc); *(uint2*)(o + 16) = w;
    w.x = pk2(st.o2[0] * sc, st.o2[1] * sc); w.y = pk2(st.o2[2] * sc, st.o2[3] * sc); *(uint2*)(o + 32) = w;
    w.x = pk2(st.o3[0] * sc, st.o3[1] * sc); w.y = pk2(st.o3[2] * sc, st.o3[3] * sc); *(uint2*)(o + 48) = w;
}
DEV void attn_init(AttnState& st) { const f32x4 z = {0.f, 0.f, 0.f, 0.f}; st.o0 = z; st.o1 = z; st.o2 = z; st.o3 = z; st.m = -INFINITY; st.lsum = 0.f; }

constexpr int NTASK_NA = NB * 6 * 128 * 4, NTASK_GQ = NB * 6 * 512, NTASK_CTX = NB * 12 * 16;
DEV void attn_task(const Params& p, int l, int tk, const float* rpb2  ) {
    const int lane = tid_() & 63, g = lane >> 4, fr = lane & 15;
    const bf16_t* P = (const bf16_t*)(p.ws + OFF_P);
    AttnState st; attn_init(st);
    if (tk < NTASK_NA) {
        const int seg = tk & 3, r = (tk >> 2) & 127, hb = tk >> 9, h = hb % 6, b = hb / 6;
        const int R0 = b * S + r * 64 + seg * 16;
        const bf16_t* qp = P + (size_t)(R0 + fr) * PWS + COL_NAQ + h * 64 + g * 8;
        const bf16x8 q0 = ld16(qp), q1 = ld16(qp + 32);
        const int rs = min(max(r - 4, 0), 120), ustart = min(max(seg * 16 - 8, 0), 32);
        const int qc = seg * 16 + fr, cs = min(max(qc - 8, 0), 48);
        int ci[8]; bool ok[8];
#pragma unroll
        for (int e = 0; e < 8; ++e) { const int kc = ustart + (e >> 2) * 16 + g * 4 + (e & 3); ok[e] = (kc >= cs) && (kc < cs + 16); ci[e] = min(max(kc - qc + 15, 0), 30); }
        const bf16_t* kbase = P + (size_t)(b * S + rs * 64 + ustart + fr) * PWS + COL_NAK + h * 64 + g * 8;
        const bf16_t* vbase = (const bf16_t*)(p.ws + OFF_NAVT) + (size_t)((b * 6 + h) * 64 + fr) * S + rs * 64 + ustart + g * 4;
#pragma unroll
        for (int ri = 0; ri < 8; ++ri) {
            const float* rb = rpb2 + (h * 15 + (rs + ri - r + 7)) * 31;
            f32x4 b0, b1;
#pragma unroll
            for (int j = 0; j < 4; ++j) { b0[j] = ok[j] ? rb[ci[j]] : -INFINITY; b1[j] = ok[4 + j] ? rb[ci[4 + j]] : -INFINITY; }
            attn_pair(kbase + (size_t)(ri * 64) * PWS, kbase + (size_t)(ri * 64 + 16) * PWS, vbase + ri * 64, vbase + ri * 64 + 16, (size_t)16 * S, q0, q1, b0, b1, st);
        }
        attn_ctx_keys(p, b, COL_NAK + h * 64, (const bf16_t*)(p.ws + OFF_NAVTC) + (size_t)(b * 6 + h) * 64 * CTX, q0, q1, st, lane);
        attn_store(p, st, R0, 256 + h * 64, lane, -INFINITY);
    } else if (tk < NTASK_NA + NTASK_GQ) {
        const int t2 = tk - NTASK_NA, qt = t2 & 511, hb = t2 >> 9, h = hb % 6, b = hb / 6, kvh = h / 3;
        const int q0i = qt * 16, R0 = b * S + q0i;
        const bf16_t* qp = P + (size_t)(R0 + fr) * PWS + COL_GQ + h * 64 + g * 8;
        const bf16x8 q0 = ld16(qp), q1 = ld16(qp + 32);
        const bf16_t* kcolp = P + COL_GK + kvh * 64 + g * 8;
        const bf16_t* vrow = (const bf16_t*)(p.ws + OFF_GVT) + (size_t)((b * 2 + kvh) * 64 + fr) * S + g * 4;
        const int qi = q0i + fr;
#pragma unroll
        for (int pp = 0; pp < 9; ++pp) {
            const int kb = q0i - 128 + pp * 32;
            if (kb + 32 <= 0 || kb >= S) continue;
            const int t0 = min(max(kb, 0), S - 16), t1 = min(max(kb + 16, 0), S - 16);
            f32x4 b0, b1;
#pragma unroll
            for (int j = 0; j < 4; ++j) {
                const int k0 = kb + g * 4 + j, k1 = k0 + 16;
                b0[j] = (k0 >= 0 && k0 < S && k0 >= qi - 128 && k0 <= qi + 128) ? 0.f : -INFINITY;
                b1[j] = (k1 >= 0 && k1 < S && k1 >= qi - 128 && k1 <= qi + 128) ? 0.f : -INFINITY;
            }
            const bf16_t* k0p = kcolp + (size_t)(b * S + t0 + fr) * PWS; const bf16_t* k1p = kcolp + (size_t)(b * S + t1 + fr) * PWS;
            attn_pair(k0p, k1p, vrow + t0, vrow + t1, (size_t)16 * S, q0, q1, b0, b1, st);
        }
        attn_ctx_keys(p, b, COL_GK + kvh * 64, (const bf16_t*)(p.ws + OFF_GVTC) + (size_t)(b * 2 + kvh) * 64 * CTX, q0, q1, st, lane);
        attn_store(p, st, R0, 640 + h * 64, lane, p.gqa_sink[l * 6 + h] * LOG2E);
    } else {
        const int t3 = tk - NTASK_NA - NTASK_GQ, qt = t3 & 15, hb = t3 >> 4, hh = hb % 12, b = hb / 12;
        const bool na = hh < 6; const int h = na ? hh : hh - 6, kvh = h / 3;
        const int R0 = NLAT + b * CTX + qt * 16;
        const bf16_t* qp = P + (size_t)(R0 + fr) * PWS + (na ? COL_NAQ : COL_GQ) + h * 64 + g * 8;
        const bf16x8 q0 = ld16(qp), q1 = ld16(qp + 32);
        if (na) attn_ctx_keys(p, b, COL_NAK + h * 64, (const bf16_t*)(p.ws + OFF_NAVTC) + (size_t)(b * 6 + h) * 64 * CTX, q0, q1, st, lane);
        else attn_ctx_keys(p, b, COL_GK + kvh * 64, (const bf16_t*)(p.ws + OFF_GVTC) + (size_t)(b * 2 + kvh) * 64 * CTX, q0, q1, st, lane);
        attn_store(p, st, R0, (na ? 256 : 640) + h * 64, lane, na ? -INFINITY : p.gqa_sink[l * 6 + h] * LOG2E);
    }
}
DEV void ph_attn(const Params& p, int l, float* rpb2  ) {
    for (int i = tid_(); i < 6 * 15 * 31; i += 256) rpb2[i] = p.na_rpb[(size_t)l * 6 * 15 * 31 + i] * LOG2E;
    __syncthreads();
    const int w = tid_() >> 6;
    const int ntask = NTASK_NA + NTASK_GQ + (l == 0 ? NTASK_CTX : 0);
    for (int tk = bid_() * 4 + w; tk < ntask; tk += gridDim.x * 4) attn_task(p, l, tk, rpb2);
}

DEV void outproj_item(const Params& p, int l, int rt, bf16_t* lds, float* stat  ) {
    const int t = tid_(), lane = t & 63, w = t >> 6, wm = w >> 1, wn = w & 1, fq = lane >> 4, fr = lane & 15;
    const bf16_t* A = (const bf16_t*)(p.ws + OFF_X1) + (size_t)(rt * 128 + (t >> 2)) * D + (t & 3) * 8;
    const bool isctx = rt >= 512;
    const float* g1 = modvec(p, l, rt * 128, 2);
#pragma unroll 1
    for (int pass = 0; pass < 4; ++pass) {
        const bf16_t* Bt = (const bf16_t*)(p.ws + OFF_WOUTT) + ((size_t)l * 1024 + pass * 256 + (t >> 2)) * 1024 + (t & 3) * 8;
        f32x4 acc[4][8]; zero_acc(acc);
        gemm_mainloop(A, A + 64 * D, Bt, 1024, 32, lds, acc);
#pragma unroll
        for (int mt = 0; mt < 4; ++mt) {
            const int rl = wm * 64 + mt * 16 + fr, R = rt * 128 + rl;
            const float* xin = (l == 0) ? (isctx ? p.ctx + (size_t)(R - NLAT) * D : p.x + (size_t)R * D) : xres_row(p, R);
            float* xo = xres_row(p, R);
            float s = 0.f, q = 0.f;
#pragma unroll
            for (int nt = 0; nt < 8; ++nt) {
                const int col = pass * 256 + wn * 128 + nt * 16 + fq * 4;
                const f32x4 xv = *(const f32x4*)(xin + col), gv = *(const f32x4*)(g1 + col);
                const f32x4 u = xv * ALPHA + gv * acc[mt][nt];
                *(f32x4*)(xo + col) = u;
                s += (u[0] + u[1]) + (u[2] + u[3]); q += (u[0] * u[0] + u[1] * u[1]) + (u[2] * u[2] + u[3] * u[3]);
            }
            s += __shfl_xor(s, 16); s += __shfl_xor(s, 32); q += __shfl_xor(q, 16); q += __shfl_xor(q, 32);
            if (fq == 0) { stat[((pass * 2 + wn) * 128 + rl) * 2] = s; stat[((pass * 2 + wn) * 128 + rl) * 2 + 1] = q; }
        }
    }
    __threadfence();
    __syncthreads();
    __builtin_amdgcn_fence(__ATOMIC_ACQUIRE, "agent");
    {
        const float* lg = p.ln1_g + l * D; const float* lb = p.ln1_b + l * D;
        const float* sh2 = modvec(p, l, rt * 128, 3); const float* sc2 = modvec(p, l, rt * 128, 4);
        bf16_t* X2 = (bf16_t*)(p.ws + OFF_X2);
        const bf16_t* WRh = (const bf16_t*)(p.ws + OFF_WR) + (size_t)(l * 2) * 48 * 1024 + (size_t)fr * 1024 + fq * 8;
        const bf16_t* WRl = WRh + 48 * 1024;
        float mean[2], rstd[2];
#pragma unroll
        for (int tm = 0; tm < 2; ++tm) {
            const int rl = w * 32 + tm * 16 + fr;
            float s = 0.f, q = 0.f;
#pragma unroll
            for (int i = 0; i < 8; ++i) { s += stat[(i * 128 + rl) * 2]; q += stat[(i * 128 + rl) * 2 + 1]; }
            mean[tm] = s * (1.f / D);
            rstd[tm] = rsqrtf(fmaxf(q * (1.f / D) - mean[tm] * mean[tm], 0.f) + LN_EPS);
        }
        f32x4 lacc[3][2];
#pragma unroll
        for (int a = 0; a < 3; ++a) { lacc[a][0] = (f32x4){0.f, 0.f, 0.f, 0.f}; lacc[a][1] = (f32x4){0.f, 0.f, 0.f, 0.f}; }
#pragma unroll 2
        for (int ks = 0; ks < 32; ++ks) {
            const int k = ks * 32 + fq * 8;
            const f32x4 g0 = *(const f32x4*)(lg + k), g1v = *(const f32x4*)(lg + k + 4), b0 = *(const f32x4*)(lb + k), b1 = *(const f32x4*)(lb + k + 4);
            const f32x4 s0 = *(const f32x4*)(sh2 + k), s1 = *(const f32x4*)(sh2 + k + 4), c0 = *(const f32x4*)(sc2 + k), c1 = *(const f32x4*)(sc2 + k + 4);
            bf16x8 hh[2], hl[2];
#pragma unroll
            for (int tm = 0; tm < 2; ++tm) {
                const int R = rt * 128 + w * 32 + tm * 16 + fr;
                float* xr = xres_row(p, R) + k;
                const f32x4 u0 = *(const f32x4*)xr, u1 = *(const f32x4*)(xr + 4);
                const f32x4 x0 = (u0 - mean[tm]) * rstd[tm] * g0 + b0, x1 = (u1 - mean[tm]) * rstd[tm] * g1v + b1;
                *(f32x4*)xr = x0; *(f32x4*)(xr + 4) = x1;
                const f32x4 h0 = x0 * (c0 + 1.f) + s0, h1 = x1 * (c1 + 1.f) + s1;
#pragma unroll
                for (int e = 0; e < 4; ++e) {
                    const bf16_t a = f2bf(h0[e]), b = f2bf(h1[e]);
                    hh[tm][e] = (short)a; hh[tm][4 + e] = (short)b;
                    hl[tm][e] = (short)f2bf(h0[e] - bf2f(a)); hl[tm][4 + e] = (short)f2bf(h1[e] - bf2f(b));
                }
                *(bf16x8*)(X2 + (size_t)R * D + k) = hh[tm];
            }
#pragma unroll
            for (int ft = 0; ft < 3; ++ft) {
                const bf16x8 wh = *(const bf16x8*)(WRh + (size_t)ft * 16 * 1024 + ks * 32), wl = *(const bf16x8*)(WRl + (size_t)ft * 16 * 1024 + ks * 32);
#pragma unroll
                for (int tm = 0; tm < 2; ++tm) {
                    lacc[ft][tm] = __builtin_amdgcn_mfma_f32_16x16x32_bf16(wh, hh[tm], lacc[ft][tm], 0, 0, 0);
                    lacc[ft][tm] = __builtin_amdgcn_mfma_f32_16x16x32_bf16(wl, hh[tm], lacc[ft][tm], 0, 0, 0);
                    lacc[ft][tm] = __builtin_amdgcn_mfma_f32_16x16x32_bf16(wh, hl[tm], lacc[ft][tm], 0, 0, 0);
                }
            }
        }
        float* lt = (float*)lds;
#pragma unroll
        for (int ft = 0; ft < 3; ++ft)
#pragma unroll
            for (int tm = 0; tm < 2; ++tm)
#pragma unroll
                for (int j = 0; j < 4; ++j) lt[(w * 32 + tm * 16 + fr) * 48 + ft * 16 + fq * 4 + j] = lacc[ft][tm][j];
        asm volatile("s_waitcnt lgkmcnt(0)" ::: "memory");
        if (lane < 32) {
            const int rl = w * 32 + lane, R = rt * 128 + rl;
            const float* lr = lt + rl * 48;
            int gi = 0; float gm = lr[0] + p.router_g_b[l * 4];
            float gl[4]; gl[0] = gm;
#pragma unroll
            for (int j = 1; j < 4; ++j) { gl[j] = lr[j] + p.router_g_b[l * 4 + j]; if (gl[j] > gm) { gm = gl[j]; gi = j; } }
            float gs = 0.f;
#pragma unroll
            for (int j = 0; j < 4; ++j) gs += expf(gl[j] - gm);
            const float ptop = 1.f / gs;
            int e0 = 0, e1 = 0; float m0 = -INFINITY, m1 = -INFINITY;
            for (int j = 0; j < 8; ++j) {
                const float v = lr[4 + gi * 8 + j] + p.router_e_b[l * 32 + gi * 8 + j];
                if (v > m0) { m1 = m0; e1 = e0; m0 = v; e0 = j; } else if (v > m1) { m1 = v; e1 = j; }
            }
            const float ex = expf(m1 - m0);
            const float w0 = ptop / (1.f + ex), w1 = ptop * ex / (1.f + ex);
            int* rte = (int*)(p.ws + OFF_RTE); float* rtw = (float*)(p.ws + OFF_RTW);
            unsigned* cnt = (unsigned*)(p.ws + OFF_CTL) + CW_CNT + l * 32;
            int* list = (int*)(p.ws + OFF_LIST);
            const int E0 = gi * 8 + e0, E1 = gi * 8 + e1;
            rte[R * 2] = E0; rte[R * 2 + 1] = E1; rtw[R * 2] = w0; rtw[R * 2 + 1] = w1;
            const unsigned p0 = atomicAdd(cnt + E0, 1u); list[(size_t)E0 * LISTCAP + p0] = R * 2;
            const unsigned p1 = atomicAdd(cnt + E1, 1u); list[(size_t)E1 * LISTCAP + p1] = R * 2 + 1;
        }
    }
}
DEV void ph_outproj(const Params& p, int l, bf16_t* lds, float* stat  ) {
    const int ntiles = (l == 0) ? 528 : 512;
    for (int rt = bid_(); rt < ntiles; rt += gridDim.x) { outproj_item(p, l, rt, lds, stat); __syncthreads(); }
}

DEV void moe_item(const Params& p, int l, int e, int j, int item, int cnt, bf16_t* lds) {
    const int t = tid_(), lane = t & 63, w = t >> 6, wm = w >> 1, wn = w & 1, fq = lane >> 4, fr = lane & 15;
    const int* list = (const int*)(p.ws + OFF_LIST) + (size_t)e * LISTCAP;
    const bf16_t* X2 = (const bf16_t*)(p.ws + OFF_X2);
    bf16_t* Hs = (bf16_t*)(p.ws + OFF_P) + (size_t)item * 128 * FF;
    const bf16_t *ap0, *ap1;
    { const int s0 = j * 128 + (t >> 2), s1 = s0 + 64;
      const int tok0 = s0 < cnt ? (list[s0] >> 1) : 0, tok1 = s1 < cnt ? (list[s1] >> 1) : 0;
      ap0 = X2 + (size_t)tok0 * D + (t & 3) * 8; ap1 = X2 + (size_t)tok1 * D + (t & 3) * 8; }
#pragma unroll 1
    for (int pass = 0; pass < 4; ++pass) {
        const bf16_t* Bt = (const bf16_t*)(p.ws + OFF_WGU) + ((size_t)e * 1024 + pass * 256 + (t >> 2)) * 1024 + (t & 3) * 8;
        f32x4 acc[4][8]; zero_acc(acc);
        gemm_mainloop(ap0, ap1, Bt, 1024, 32, lds, acc);
#pragma unroll
        for (int mt = 0; mt < 4; ++mt) {
            const int rl = wm * 64 + mt * 16 + fr;
#pragma unroll
            for (int nt = 0; nt < 4; ++nt) {
                const f32x4 gv = acc[mt][nt], uv = acc[mt][nt + 4];
                float hv[4];
#pragma unroll
                for (int jj = 0; jj < 4; ++jj) hv[jj] = gv[jj] / (1.f + __expf(-gv[jj])) * uv[jj];
                uint2 o; o.x = pk2(hv[0], hv[1]); o.y = pk2(hv[2], hv[3]);
                *(uint2*)(Hs + (size_t)rl * FF + pass * 128 + wn * 64 + nt * 16 + fq * 4) = o;
            }
        }
    }
    __threadfence();
    __syncthreads();
    __builtin_amdgcn_fence(__ATOMIC_ACQUIRE, "agent");
    const bf16_t* A = Hs + (size_t)(t >> 2) * FF + (t & 3) * 8;
    const float* rtw = (const float*)(p.ws + OFF_RTW);
    bf16_t* Y = (bf16_t*)(p.ws + OFF_Y);
#pragma unroll 1
    for (int pass = 0; pass < 4; ++pass) {
        const bf16_t* Bt = (const bf16_t*)(p.ws + OFF_WD) + ((size_t)e * 1024 + pass * 256 + (t >> 2)) * FF + (t & 3) * 8;
        f32x4 acc[4][8]; zero_acc(acc);
        gemm_mainloop(A, A + 64 * FF, Bt, FF, 16, lds, acc);
#pragma unroll
        for (int mt = 0; mt < 4; ++mt) {
            const int s = j * 128 + wm * 64 + mt * 16 + fr;
            if (s < cnt) {
                const int ent = list[s];
                const float gw = rtw[ent];
                bf16_t* yo = Y + (size_t)ent * D + pass * 256 + wn * 128 + fq * 4;
#pragma unroll
                for (int nt = 0; nt < 8; ++nt) { const f32x4 v = acc[mt][nt] * gw; uint2 o; o.x = pk2(v[0], v[1]); o.y = pk2(v[2], v[3]); *(uint2*)(yo + nt * 16) = o; }
            }
        }
    }
}
DEV void ph_moe(const Params& p, int l, bf16_t* lds, int* s_pref  , int* s_cnt  ) {
    const unsigned* cnt = (const unsigned*)(p.ws + OFF_CTL) + CW_CNT + l * 32;
    if (tid_() == 0) { int a = 0; for (int e = 0; e < 32; ++e) { const int c = (int)cnt[e]; s_cnt[e] = c; s_pref[e] = a; a += (c + 127) >> 7; } s_pref[32] = a; }
    __syncthreads();
    const int nitems = s_pref[32];
    for (int it = bid_(); it < nitems; it += gridDim.x) {
        int e = 0;
        while (e < 31 && it >= s_pref[e + 1]) ++e;
        moe_item(p, l, e, it - s_pref[e], it, s_cnt[e], lds);
        __syncthreads();
    }
}

namespace cg = cooperative_groups;
constexpr int SMEM_BYTES = GEMM_LDS_ELEMS * 2 + 8 * 128 * 2 * 4 + 512;
constexpr int NPHASE = 16;
__global__ void __launch_bounds__(256, 2) mega(Params p, int ph_lo, int ph_hi) {
    __shared__ __attribute__((aligned(16))) unsigned char smem[SMEM_BYTES];
    bf16_t* lds = (bf16_t*)smem;
    float* stat = (float*)(smem + GEMM_LDS_ELEMS * 2);
    int* s_pref = (int*)(smem + GEMM_LDS_ELEMS * 2 + 8 * 128 * 2 * 4); int* s_cnt = s_pref + 40;
    unsigned char* ws = p.ws;
#define IN(k) (ph_lo <= (k) && (k) < ph_hi)
#define SEAM(k) do { if (IN(k) && IN((k) + 1)) cg::this_grid().sync(); } while (0)
    if (IN(0)) {
        ph_mod(p, (float*)smem); __syncthreads();
        ph_rope(p);
        ph_routerw(p);
        ph_transpose(p.w_in, (bf16_t*)(ws + OFF_WINT), 1024, 2304, 0, 2, (size_t)1024 * 2304, (size_t)2304 * 1024, (float*)smem);
        ph_transpose(p.w_out, (bf16_t*)(ws + OFF_WOUTT), 1024, 1024, 0, 2, (size_t)1024 * 1024, (size_t)1024 * 1024, (float*)smem);
    }
    SEAM(0);
#pragma unroll 1
    for (int l = 0; l < 2; ++l) {
        const int pb = 1 + l * 7;
        if (IN(pb + 0)) { if (l == 0) ph_rowop<0>(p, 0, NTOK); else ph_rowop<1>(p, 1, NTOK); }
        SEAM(pb + 0);
        if (IN(pb + 1)) ph_inproj(p, l, lds);
        SEAM(pb + 1);
        if (IN(pb + 2)) {
            ph_rg1(p, l, (float*)smem); __syncthreads();
            ph_attn(p, l, (float*)smem); __syncthreads();
            ph_transpose(p.exp_w_gate + (size_t)l * NE * 1024 * 512, (bf16_t*)(ws + OFF_WGU), 1024, 512, 1, NE, (size_t)1024 * 512, (size_t)1024 * 1024, (float*)smem);
            ph_transpose(p.exp_w_up + (size_t)l * NE * 1024 * 512, (bf16_t*)(ws + OFF_WGU), 1024, 512, 2, NE, (size_t)1024 * 512, (size_t)1024 * 1024, (float*)smem);
            ph_transpose(p.exp_w_down + (size_t)l * NE * 512 * 1024, (bf16_t*)(ws + OFF_WD), 512, 1024, 0, NE, (size_t)512 * 1024, (size_t)1024 * 512, (float*)smem);
        }
        SEAM(pb + 2);
        if (IN(pb + 3)) ph_rg2(p);
        SEAM(pb + 3);
        if (IN(pb + 4)) ph_rg3(p, l == 0 ? NTOK : NLAT);
        SEAM(pb + 4);
        if (IN(pb + 5)) ph_outproj(p, l, lds, stat);
        SEAM(pb + 5);
        if (IN(pb + 6)) ph_moe(p, l, lds, s_pref, s_cnt);
        SEAM(pb + 6);
    }
    if (IN(NPHASE - 1)) ph_rowop<2>(p, 2, NLAT);
#undef IN
#undef SEAM
}

#ifndef ONE_LAUNCH
#define ONE_LAUNCH 1
#endif
extern "C" void kernel_launch(void* const* d_in, const int* in_sizes, int n_in, void* d_out, int out_size, void* d_ws, size_t ws_size, hipStream_t stream) {
    if (n_in != 28 || ws_size < WS_TOTAL || out_size != NLAT * D) { fprintf(stderr, "kernel_launch: unexpected shapes / workspace (%d inputs, ws %zu need %zu)\n", n_in, ws_size, (size_t)WS_TOTAL); return; }
    static int grid = 0;
    if (grid == 0) {
        int dev = 0, cus = 0, per_cu = 0;
        (void)hipGetDevice(&dev);
        (void)hipDeviceGetAttribute(&cus, hipDeviceAttributeMultiprocessorCount, dev);
        (void)hipOccupancyMaxActiveBlocksPerMultiprocessor(&per_cu, (const void*)mega, 256, 0);
        if (per_cu > 2) per_cu = 2;
        grid = cus * per_cu;
        if (grid <= 0) { fprintf(stderr, "kernel_launch: occupancy query gave %d blocks per CU on %d CUs\n", per_cu, cus); grid = -1; }
    }
    if (grid < 0) return;
    Params p{};
    const float** pp = (const float**)&p;
    for (int i = 0; i < 28; ++i) pp[i] = (const float*)d_in[i];
    p.out = (float*)d_out; p.ws = (unsigned char*)d_ws;
    (void)hipMemsetAsync((unsigned char*)d_ws + OFF_CTL, 0, CTL_BYTES, stream);
#if ONE_LAUNCH
    int lo = 0, hi = NPHASE;
    void* args[] = {(void*)&p, (void*)&lo, (void*)&hi};
    hipError_t e = hipLaunchCooperativeKernel((const void*)mega, dim3(grid), dim3(256), args, 0, stream);
    if (e != hipSuccess) fprintf(stderr, "kernel_launch: cooperative launch failed: %s (grid %d)\n", hipGetErrorString(e), grid);
#else
    for (int ph = 0; ph < NPHASE; ++ph) mega<<<grid, 256, 0, stream>>>(p, ph, ph + 1);
#endif
}
```

```cpp
#include <hip/hip_runtime.h>
#include <hip/hip_cooperative_groups.h>
#include <stdint.h>
#include <cstdio>

typedef unsigned short bf16_t;
typedef short bf16x8 __attribute__((ext_vector_type(8)));
typedef float f32x4 __attribute__((ext_vector_type(4)));

#define DEV __device__ __forceinline__

constexpr int D = 1024, NB = 8, S = 8192, CTX = 256;
constexpr int NLAT = NB * S, NCTX = NB * CTX, NTOK = NLAT + NCTX;
constexpr int PWS = 1792;
constexpr int COL_RGX = 0, COL_NAK = 256, COL_GK = 640, COL_GATE = 768, COL_NAQ = 1024, COL_GQ = 1408;
constexpr int NE = 32, FF = 512;
constexpr int LISTCAP = NTOK;
constexpr float ALPHA = 1.4142135623730951f;
constexpr float LN_EPS = 1e-5f;

constexpr size_t al256(size_t x) { return (x + 255) & ~(size_t)255; }
constexpr size_t OFF_CTL   = 0;
constexpr size_t CTL_BYTES = 4096;
constexpr size_t OFF_MOD   = OFF_CTL + CTL_BYTES;
constexpr size_t OFF_ROPE  = al256(OFF_MOD + (size_t)2 * 9 * 6144 * 4);
constexpr size_t OFF_RTE   = al256(OFF_ROPE + (size_t)2 * 128 * 16 * 4);
constexpr size_t OFF_RTW   = al256(OFF_RTE + (size_t)NTOK * 8);
constexpr size_t OFF_LIST  = al256(OFF_RTW + (size_t)NTOK * 8);
constexpr size_t OFF_WR    = al256(OFF_LIST + (size_t)NE * LISTCAP * 4);
constexpr size_t OFF_WRG   = al256(OFF_WR + (size_t)2 * 2 * 48 * 1024 * 2);
constexpr size_t OFF_RGC   = al256(OFF_WRG + (size_t)2 * 2 * 2 * 4 * 64 * 64 * 2);
constexpr size_t OFF_AGG   = al256(OFF_RGC + (size_t)2 * 2 * 3 * 256 * 4);
constexpr size_t OFF_WINT  = al256(OFF_AGG + (size_t)NB * 66 * 2 * 2 * 256 * 4);
constexpr size_t OFF_WOUTT = al256(OFF_WINT + (size_t)2 * 2304 * 1024 * 2);
constexpr size_t OFF_WGU   = al256(OFF_WOUTT + (size_t)2 * 1024 * 1024 * 2);
constexpr size_t OFF_WD    = al256(OFF_WGU + (size_t)NE * 1024 * 1024 * 2);
constexpr size_t OFF_XCTX  = al256(OFF_WD + (size_t)NE * 1024 * 512 * 2);
constexpr size_t OFF_X1    = al256(OFF_XCTX + (size_t)NCTX * D * 4);
constexpr size_t OFF_X2    = al256(OFF_X1 + (size_t)NTOK * D * 2);
constexpr size_t OFF_P     = al256(OFF_X2 + (size_t)NTOK * D * 2);
constexpr size_t OFF_NAVT  = al256(OFF_P + (size_t)NTOK * PWS * 2);
constexpr size_t OFF_NAVTC = al256(OFF_NAVT + (size_t)NB * 6 * 64 * S * 2);
constexpr size_t OFF_GVT   = al256(OFF_NAVTC + (size_t)NB * 6 * 64 * CTX * 2);
constexpr size_t OFF_GVTC  = al256(OFF_GVT + (size_t)NB * 2 * 64 * S * 2);
constexpr size_t OFF_Y     = al256(OFF_GVTC + (size_t)NB * 2 * 64 * CTX * 2);
constexpr size_t WS_TOTAL  = al256(OFF_Y + (size_t)2 * NTOK * D * 2);
constexpr int CW_CNT = 0;

struct Params {
    const float *x, *c, *ctx, *c_ctx, *w_ada, *b_ada, *w_in, *conv_w, *conv_b, *rg_a_w, *rg_a_b, *rg_i_w, *rg_i_b, *rg_lambda,
        *na_rpb, *gqa_sink, *w_out, *ln1_g, *ln1_b, *router_g_w, *router_g_b, *router_e_w, *router_e_b, *exp_w_gate, *exp_w_up,
        *exp_w_down, *ln2_g, *ln2_b;
    float* out;
    unsigned char* ws;
};

DEV const Params& kp_() { const void* q = (const void*)__builtin_amdgcn_kernarg_segment_ptr(); asm volatile("" : "+s"(q)); return *(const Params*)q; }
DEV int tid_() { int t = threadIdx.x; asm volatile("" : "+v"(t)); return t; }
DEV int bid_() { int b = blockIdx.x; asm volatile("" : "+s"(b)); return b; }
DEV float bf2f(bf16_t h) { return __uint_as_float((unsigned)h << 16); }
DEV bf16_t f2bf(float f) { unsigned u = __float_as_uint(f); u += 0x7fffu + ((u >> 16) & 1u); return (bf16_t)(u >> 16); }
DEV unsigned pk2(float lo, float hi) { return (unsigned)f2bf(lo) | ((unsigned)f2bf(hi) << 16); }
DEV float wave_sum(float v) {
#pragma unroll
    for (int o = 1; o < 64; o <<= 1) v += __shfl_xor(v, o);
    return v;
}
DEV float wave_max(float v) {
#pragma unroll
    for (int o = 1; o < 64; o <<= 1) v = fmaxf(v, __shfl_xor(v, o));
    return v;
}
DEV float sigmoidf_(float x) { return 1.f / (1.f + __expf(-x)); }
DEV float gelu_tanh(float x) {
    const float u = 0.7978845608028654f * (x + 0.044715f * x * x * x);
    const float t = 1.f - 2.f / (1.f + __expf(2.f * u));
    return 0.5f * x * (1.f + t);
}
DEV float* xres_row(const Params& p, int R) {
    return R < NLAT ? p.out + (size_t)R * D : (float*)(p.ws + OFF_XCTX) + (size_t)(R - NLAT) * D;
}
DEV const float* modvec(const Params& p, int l, int R, int seg) {
    const int b = R < NLAT ? R / S : 8;
    return (const float*)(p.ws + OFF_MOD) + ((size_t)(l * 9 + b) * 6 + seg) * 1024;
}

DEV void ph_mod(const Params& p, float* sc  ) {
    if (bid_() >= 48) return;
    for (int i = tid_(); i < 9 * 1024; i += 256) { const float v = (i < 8192) ? p.c[i] : p.c_ctx[i - 8192]; sc[i] = v / (1.f + expf(-v)); }
    __syncthreads();
    const int col = bid_() * 256 + tid_();
    const int l = col / 6144, j = col % 6144;
    const float* w = p.w_ada + (size_t)l * 1024 * 6144 + j;
    float a0 = 0, a1 = 0, a2 = 0, a3 = 0, a4 = 0, a5 = 0, a6 = 0, a7 = 0, a8 = 0;
    for (int k = 0; k < 1024; ++k) {
        const float wv = w[(size_t)k * 6144];
        a0 += sc[k] * wv; a1 += sc[1024 + k] * wv; a2 += sc[2048 + k] * wv; a3 += sc[3072 + k] * wv; a4 += sc[4096 + k] * wv;
        a5 += sc[5120 + k] * wv; a6 += sc[6144 + k] * wv; a7 += sc[7168 + k] * wv; a8 += sc[8192 + k] * wv;
    }
    const float bias = p.b_ada[l * 6144 + j];
    float* mod = (float*)(p.ws + OFF_MOD) + (size_t)l * 9 * 6144 + j;
    mod[0 * 6144] = a0 + bias; mod[1 * 6144] = a1 + bias; mod[2 * 6144] = a2 + bias; mod[3 * 6144] = a3 + bias; mod[4 * 6144] = a4 + bias;
    mod[5 * 6144] = a5 + bias; mod[6 * 6144] = a6 + bias; mod[7 * 6144] = a7 + bias; mod[8 * 6144] = a8 + bias;
}

DEV void sincos_red(float ang, float& sn, float& cs) {
    const float n = rintf(ang * 0.15915494309189535f);
    float r = fmaf(-n, 6.2831854820251465f, ang);
    r = fmaf(-n, -1.7484555e-07f, r);
    float sgn = 1.f;
    if (r > 1.5707963267948966f) { r = 3.14159265358979f - r; sgn = -1.f; }
    else if (r < -1.5707963267948966f) { r = -3.14159265358979f - r; sgn = -1.f; }
    const float r2 = r * r;
    float sp = -1.6059044e-10f; sp = fmaf(sp, r2, 2.5052108e-08f); sp = fmaf(sp, r2, -2.7557319e-06f); sp = fmaf(sp, r2, 1.9841270e-04f);
    sp = fmaf(sp, r2, -8.3333333e-03f); sp = fmaf(sp, r2, 1.6666667e-01f); sp = fmaf(sp * -1.f, r2, 1.f);
    sn = r * sp;
    float cp = -1.1470746e-11f; cp = fmaf(cp, r2, 2.0876757e-09f); cp = fmaf(cp, r2, -2.7557319e-07f); cp = fmaf(cp, r2, 2.4801587e-05f);
    cp = fmaf(cp, r2, -1.3888889e-03f); cp = fmaf(cp, r2, 4.1666667e-02f); cp = fmaf(cp, r2, -0.5f); cp = fmaf(cp, r2, 1.f);
    cs = sgn * cp;
}
DEV void ph_rope(const Params& p) {
    const int i = (bid_() - 48) * 256 + tid_();
    if (i < 0 || i >= 128 * 16) return;
    const int pos = i >> 4, q = i & 15;
    const float inv = exp2f(-(float)q * (13.287712379549449f / 16.f));
    float sn, cs; sincos_red((float)pos * inv, sn, cs);
    float* tab = (float*)(p.ws + OFF_ROPE);
    tab[i] = cs; tab[2048 + i] = sn;
}

DEV void ph_routerw(const Params& p) {
  for (int i = bid_() * 256 + tid_(); i < 2 * 48 * 1024; i += gridDim.x * 256) {
    const int l = i / (48 * 1024), f = (i / 1024) % 48, k = i & 1023;
    float w = 0.f;
    if (f < 4) w = p.router_g_w[((size_t)l * 1024 + k) * 4 + f]; else if (f < 36) w = p.router_e_w[((size_t)l * 1024 + k) * 32 + (f - 4)];
    const bf16_t hi = f2bf(w), lo = f2bf(w - bf2f(hi));
    bf16_t* WR = (bf16_t*)(p.ws + OFF_WR);
    WR[((size_t)(l * 2 + 0) * 48 + f) * 1024 + k] = hi;
    WR[((size_t)(l * 2 + 1) * 48 + f) * 1024 + k] = lo;
  }
}

DEV void ph_rgprep(const Params& p) {
    bf16_t* W = (bf16_t*)(p.ws + OFF_WRG);
    for (int i = bid_() * 256 + tid_(); i < 2 * 2 * 2 * 4 * 64 * 64; i += gridDim.x * 256) {
        const int d = i & 63, e = (i >> 6) & 63, n = (i >> 12) & 3, gate = (i >> 14) & 1, ld = i >> 15;
        const float* srcw = gate ? p.rg_i_w : p.rg_a_w;
        W[i] = f2bf(srcw[((size_t)(ld * 4 + n) * 64 + d) * 64 + e]);
    }
    float* C = (float*)(p.ws + OFF_RGC);
    for (int i = bid_() * 256 + tid_(); i < 2 * 2 * 256; i += gridDim.x * 256) {
        const int c = i & 255, ld = i >> 8;
        C[(ld * 3 + 0) * 256 + c] = p.rg_a_b[ld * 256 + c];
        C[(ld * 3 + 1) * 256 + c] = p.rg_i_b[ld * 256 + c];
        C[(ld * 3 + 2) * 256 + c] = -8.f * log1pf(expf(-p.rg_lambda[ld * 256 + c]));
    }
}

DEV int tr_row(int n, int mode) { return mode == 0 ? n : ((n >> 7) * 256 + ((n >> 6) & 1) * 128 + (n & 63) + (mode == 2 ? 64 : 0)); }
DEV void transpose_tile(const float* src, bf16_t* dst, int K, int N, int mode, int tile, float* lds) {
    const int ntn = N >> 6, kt = tile / ntn, nt = tile % ntn, k0 = kt * 64, n0 = nt * 64, t = tid_();
#pragma unroll
    for (int i = 0; i < 4; ++i) {
        const int r = (t >> 4) + 16 * i, c4 = (t & 15) * 4;
        const float4 v = *(const float4*)(src + (size_t)(k0 + r) * N + n0 + c4);
        lds[r * 65 + c4] = v.x; lds[r * 65 + c4 + 1] = v.y; lds[r * 65 + c4 + 2] = v.z; lds[r * 65 + c4 + 3] = v.w;
    }
    __syncthreads();
#pragma unroll
    for (int i = 0; i < 2; ++i) {
        const int n = (t >> 3) + 32 * i, kc = (t & 7) * 8;
        uint4 o;
        o.x = pk2(lds[(kc + 0) * 65 + n], lds[(kc + 1) * 65 + n]); o.y = pk2(lds[(kc + 2) * 65 + n], lds[(kc + 3) * 65 + n]);
        o.z = pk2(lds[(kc + 4) * 65 + n], lds[(kc + 5) * 65 + n]); o.w = pk2(lds[(kc + 6) * 65 + n], lds[(kc + 7) * 65 + n]);
        *(uint4*)(dst + (size_t)tr_row(n0 + n, mode) * K + k0 + kc) = o;
    }
    __syncthreads();
}
DEV void ph_transpose(const float* src, bf16_t* dst, int K, int N, int mode, int nmat, size_t sstride, size_t dstride, float* lds  ) {
    const int per = (K >> 6) * (N >> 6);
    for (int it = bid_(); it < nmat * per; it += gridDim.x) {
        const int m = it / per, tile = it % per;
        transpose_tile(src + (size_t)m * sstride, dst + (size_t)m * dstride, K, N, mode, tile, lds);
    }
}

template <int MODE> DEV void rowop(const Params& p, int l, int R) {
    const int lane = tid_() & 63;
    float4 v[4];
    if (MODE == 0) {
        const float* src = R < NLAT ? p.x + (size_t)R * D : p.ctx + (size_t)(R - NLAT) * D;
#pragma unroll
        for (int i = 0; i < 4; ++i) v[i] = *(const float4*)(src + i * 256 + lane * 4);
    } else {
        float* xr = xres_row(p, R);
        const float* g2 = modvec(p, l - 1, R, 5);
        const bf16_t* y0 = (const bf16_t*)(p.ws + OFF_Y) + (size_t)(2 * R) * D;
        const bf16_t* y1 = y0 + D;
        const float* lg = p.ln2_g + (l - 1) * D; const float* lb = p.ln2_b + (l - 1) * D;
        float s = 0.f;
#pragma unroll
        for (int i = 0; i < 4; ++i) {
            const int k = i * 256 + lane * 4;
            const float4 xv = *(const float4*)(xr + k); const float4 gv = *(const float4*)(g2 + k);
            const uint2 a = *(const uint2*)(y0 + k); const uint2 b = *(const uint2*)(y1 + k);
            float4 u;
            u.x = ALPHA * xv.x + gv.x * (bf2f((bf16_t)(a.x & 0xffff)) + bf2f((bf16_t)(b.x & 0xffff)));
            u.y = ALPHA * xv.y + gv.y * (bf2f((bf16_t)(a.x >> 16)) + bf2f((bf16_t)(b.x >> 16)));
            u.z = ALPHA * xv.z + gv.z * (bf2f((bf16_t)(a.y & 0xffff)) + bf2f((bf16_t)(b.y & 0xffff)));
            u.w = ALPHA * xv.w + gv.w * (bf2f((bf16_t)(a.y >> 16)) + bf2f((bf16_t)(b.y >> 16)));
            v[i] = u; s += (u.x + u.y) + (u.z + u.w);
        }
        const float mean = wave_sum(s) * (1.f / D);
        float q = 0.f;
#pragma unroll
        for (int i = 0; i < 4; ++i) { v[i].x -= mean; v[i].y -= mean; v[i].z -= mean; v[i].w -= mean; q += (v[i].x * v[i].x + v[i].y * v[i].y) + (v[i].z * v[i].z + v[i].w * v[i].w); }
        const float rstd = rsqrtf(wave_sum(q) * (1.f / D) + LN_EPS);
#pragma unroll
        for (int i = 0; i < 4; ++i) {
            const int k = i * 256 + lane * 4;
            const float4 gg = *(const float4*)(lg + k); const float4 bb = *(const float4*)(lb + k);
            v[i].x = v[i].x * rstd * gg.x + bb.x; v[i].y = v[i].y * rstd * gg.y + bb.y; v[i].z = v[i].z * rstd * gg.z + bb.z; v[i].w = v[i].w * rstd * gg.w + bb.w;
            *(float4*)(xr + k) = v[i];
        }
    }
    if (MODE != 2) {
        const float* sh = modvec(p, l, R, 0); const float* sc = modvec(p, l, R, 1);
        bf16_t* ha = (bf16_t*)(p.ws + OFF_X1) + (size_t)R * D;
#pragma unroll
        for (int i = 0; i < 4; ++i) {
            const int k = i * 256 + lane * 4;
            const float4 s4 = *(const float4*)(sh + k); const float4 c4 = *(const float4*)(sc + k);
            uint2 o; o.x = pk2(v[i].x * (1.f + c4.x) + s4.x, v[i].y * (1.f + c4.y) + s4.y); o.y = pk2(v[i].z * (1.f + c4.z) + s4.z, v[i].w * (1.f + c4.w) + s4.w);
            *(uint2*)(ha + k) = o;
        }
    }
}
template <int MODE> DEV void ph_rowop(const Params& p, int l, int nrows) {
    const int w = tid_() >> 6;
    for (int R = bid_() * 4 + w; R < nrows; R += gridDim.x * 4) rowop<MODE>(p, l, R);
}

constexpr int GEMM_LDS_ELEMS = 2 * (128 + 256) * 32;
DEV void gemm_mainloop(const bf16_t* a0, const bf16_t* a1, const bf16_t* bp, size_t ldb, int nk, bf16_t* lds, f32x4 (&acc)[4][8]) {
    const int t = tid_(), lane = t & 63, w = t >> 6, wm = w >> 1, wn = w & 1;
    const int wofs = (t >> 2) * 32 + (((t & 3) ^ ((0 - (t >> 4)) & 3)) * 8);
    const int pc = ((lane >> 4) ^ ((0 - ((lane & 15) >> 2)) & 3)) * 8;
    const int arow = (wm * 64 + (lane & 15)) * 32 + pc, brow = (128 + wn * 128 + (lane & 15)) * 32 + pc;
    const bf16_t* b1 = bp + (size_t)64 * ldb; const bf16_t* b2 = bp + (size_t)128 * ldb; const bf16_t* b3 = bp + (size_t)192 * ldb;
    uint4 ra0 = *(const uint4*)a0, ra1 = *(const uint4*)a1;
    uint4 rb0 = *(const uint4*)bp, rb1 = *(const uint4*)b1, rb2 = *(const uint4*)b2, rb3 = *(const uint4*)b3;
    __syncthreads();
    *(uint4*)(lds + wofs) = ra0; *(uint4*)(lds + wofs + 64 * 32) = ra1;
    *(uint4*)(lds + 128 * 32 + wofs) = rb0; *(uint4*)(lds + 192 * 32 + wofs) = rb1; *(uint4*)(lds + 256 * 32 + wofs) = rb2; *(uint4*)(lds + 320 * 32 + wofs) = rb3;
    __syncthreads();
    for (int kt = 0; kt < nk; ++kt) {
        const bf16_t* cur = lds + (kt & 1) * (384 * 32);
        bf16_t* nxt = lds + ((kt + 1) & 1) * (384 * 32);
        const bool more = kt + 1 < nk;
        if (more) {
            const int ko = (kt + 1) * 32;
            ra0 = *(const uint4*)(a0 + ko); ra1 = *(const uint4*)(a1 + ko);
            rb0 = *(const uint4*)(bp + ko); rb1 = *(const uint4*)(b1 + ko); rb2 = *(const uint4*)(b2 + ko); rb3 = *(const uint4*)(b3 + ko);
        }
        const bf16x8 af0 = *(const bf16x8*)(cur + arow), af1 = *(const bf16x8*)(cur + arow + 16 * 32), af2 = *(const bf16x8*)(cur + arow + 32 * 32), af3 = *(const bf16x8*)(cur + arow + 48 * 32);
#pragma unroll
        for (int nt = 0; nt < 8; ++nt) {
            const bf16x8 bfr = *(const bf16x8*)(cur + brow + nt * 16 * 32);
            acc[0][nt] = __builtin_amdgcn_mfma_f32_16x16x32_bf16(bfr, af0, acc[0][nt], 0, 0, 0);
            acc[1][nt] = __builtin_amdgcn_mfma_f32_16x16x32_bf16(bfr, af1, acc[1][nt], 0, 0, 0);
            acc[2][nt] = __builtin_amdgcn_mfma_f32_16x16x32_bf16(bfr, af2, acc[2][nt], 0, 0, 0);
            acc[3][nt] = __builtin_amdgcn_mfma_f32_16x16x32_bf16(bfr, af3, acc[3][nt], 0, 0, 0);
        }
        if (more) {
            *(uint4*)(nxt + wofs) = ra0; *(uint4*)(nxt + wofs + 64 * 32) = ra1;
            *(uint4*)(nxt + 128 * 32 + wofs) = rb0; *(uint4*)(nxt + 192 * 32 + wofs) = rb1; *(uint4*)(nxt + 256 * 32 + wofs) = rb2; *(uint4*)(nxt + 320 * 32 + wofs) = rb3;
        }
        __syncthreads();
    }
}
DEV void zero_acc(f32x4 (&acc)[4][8]) {
#pragma unroll
    for (int a = 0; a < 4; ++a)
#pragma unroll
        for (int b = 0; b < 8; ++b) acc[a][b] = (f32x4){0.f, 0.f, 0.f, 0.f};
}

DEV void inproj_item(const Params& p, int l, int rt, int pass, bf16_t* lds) {
    const int t = tid_(), lane = t & 63, w = t >> 6, wm = w >> 1, wn = w & 1;
    const bf16_t* A = (const bf16_t*)(p.ws + OFF_X1) + (size_t)(rt * 128 + (t >> 2)) * D + (t & 3) * 8;
    const bf16_t* Bt = (const bf16_t*)(p.ws + OFF_WINT) + ((size_t)l * 2304 + pass * 256 + (t >> 2)) * 1024 + (t & 3) * 8;
    f32x4 acc[4][8]; zero_acc(acc);
    gemm_mainloop(A, A + 64 * D, Bt, 1024, 32, lds, acc);
    bf16_t* P = (bf16_t*)(p.ws + OFF_P);
    const float* ctab = (const float*)(p.ws + OFF_ROPE); const float* stab = ctab + 2048;
    const bool isctx = rt >= 512;
    const int fq = lane >> 4, fr = lane & 15;
#pragma unroll
    for (int hci = 0; hci < 2; ++hci) {
        const int hc = pass * 4 + wn * 2 + hci;
        int type, dcol = 0, vh = 0;
        if (hc < 4) { type = 0; dcol = COL_RGX + hc * 64; }
        else if (hc < 10) { type = 0; dcol = COL_NAK + (hc - 4) * 64; }
        else if (hc < 16) { type = 4; vh = hc - 10; }
        else if (hc < 18) { type = 2; dcol = COL_GK + (hc - 16) * 64; }
        else if (hc < 20) { type = 5; vh = hc - 18; }
        else if (hc < 24) { type = 0; dcol = COL_GATE + (hc - 20) * 64; }
        else if (hc < 30) { type = 1; dcol = COL_NAQ + (hc - 24) * 64; }
        else { type = 3; dcol = COL_GQ + (hc - 30) * 64; }
#pragma unroll
        for (int mt = 0; mt < 4; ++mt) {
            const int R = rt * 128 + wm * 64 + mt * 16 + fr;
            f32x4 v0 = acc[mt][hci * 4 + 0], v1 = acc[mt][hci * 4 + 1], v2 = acc[mt][hci * 4 + 2], v3 = acc[mt][hci * 4 + 3];
            if ((type == 2 || type == 3) && !isctx) {
                const int tt = R & (S - 1), pr = tt >> 6, pc = tt & 63;
                const f32x4 cr = *(const f32x4*)(ctab + pr * 16 + fq * 4), sr = *(const f32x4*)(stab + pr * 16 + fq * 4);
                const f32x4 cc = *(const f32x4*)(ctab + pc * 16 + fq * 4), sc = *(const f32x4*)(stab + pc * 16 + fq * 4);
                const f32x4 o0 = v0 * cr - v1 * sr, o1 = v1 * cr + v0 * sr, o2 = v2 * cc - v3 * sc, o3 = v3 * cc + v2 * sc;
                v0 = o0; v1 = o1; v2 = o2; v3 = o3;
            }
            if (type == 1 || type == 3) { v0 = v0 * 0.125f; v1 = v1 * 0.125f; v2 = v2 * 0.125f; v3 = v3 * 0.125f; }
            if (type < 4) {
                bf16_t* o = P + (size_t)R * PWS + dcol + fq * 4;
                uint2 q;
                q.x = pk2(v0[0], v0[1]); q.y = pk2(v0[2], v0[3]); *(uint2*)(o) = q;
                q.x = pk2(v1[0], v1[1]); q.y = pk2(v1[2], v1[3]); *(uint2*)(o + 16) = q;
                q.x = pk2(v2[0], v2[1]); q.y = pk2(v2[2], v2[3]); *(uint2*)(o + 32) = q;
                q.x = pk2(v3[0], v3[1]); q.y = pk2(v3[2], v3[3]); *(uint2*)(o + 48) = q;
            } else {
                bf16_t* base; size_t dstride;
                if (!isctx) { const int b = R >> 13, tt = R & (S - 1);
                    base = (type == 4 ? (bf16_t*)(p.ws + OFF_NAVT) + (size_t)(b * 6 + vh) * 64 * S : (bf16_t*)(p.ws + OFF_GVT) + (size_t)(b * 2 + vh) * 64 * S) + tt; dstride = S; }
                else { const int cR = R - NLAT, b = cR >> 8, tt = cR & 255;
                    base = (type == 4 ? (bf16_t*)(p.ws + OFF_NAVTC) + (size_t)(b * 6 + vh) * 64 * CTX : (bf16_t*)(p.ws + OFF_GVTC) + (size_t)(b * 2 + vh) * 64 * CTX) + tt; dstride = CTX; }
#pragma unroll
                for (int j = 0; j < 4; ++j) {
                    base[(size_t)(0 * 16 + fq * 4 + j) * dstride] = f2bf(v0[j]);
                    base[(size_t)(1 * 16 + fq * 4 + j) * dstride] = f2bf(v1[j]);
                    base[(size_t)(2 * 16 + fq * 4 + j) * dstride] = f2bf(v2[j]);
                    base[(size_t)(3 * 16 + fq * 4 + j) * dstride] = f2bf(v3[j]);
                }
            }
        }
    }
}
DEV void ph_inproj(const Params& p, int l, bf16_t* lds) {
    const int nctxp = (l == 0) ? 9 : 5;
    const int nitems = 512 * 9 + 16 * nctxp;
    for (int it = bid_(); it < nitems; it += gridDim.x) {
        int rt, pass;
        if (it < 512 * 9) { rt = it / 9; pass = it % 9; } else { const int r = it - 512 * 9; rt = 512 + r / nctxp; pass = r % nctxp; }
        inproj_item(p, l, rt, pass, lds);
    }
}

DEV void ph_rg1(const Params& p, int l, float* xl  ) {
    const bf16_t* P = (const bf16_t*)(p.ws + OFF_P);
    float* AB = (float*)(p.ws + OFF_Y);
    const int c = tid_(), n = c >> 6, e = c & 63;
    for (int R = bid_(); R < NTOK; R += gridDim.x) {
        const bool isctx = R >= NLAT;
        const int L = isctx ? CTX : S, base = isctx ? NLAT + ((R - NLAT) / CTX) * CTX : (R / S) * S, tt = R - base;
        float acc = p.conv_b[l * 256 + c];
#pragma unroll
        for (int j = 0; j < 4; ++j) { const int ts = tt + j - 2; if (ts >= 0 && ts < L) acc += p.conv_w[(l * 4 + j) * 256 + c] * bf2f(P[(size_t)(base + ts) * PWS + COL_RGX + c]); }
        __syncthreads();
        xl[c] = acc;
        __syncthreads();
#pragma unroll
        for (int dir = 0; dir < 2; ++dir) {
            const float* wa = p.rg_a_w + ((size_t)((l * 2 + dir) * 4 + n) * 64) * 64 + e;
            const float* wi = p.rg_i_w + ((size_t)((l * 2 + dir) * 4 + n) * 64) * 64 + e;
            float za = p.rg_a_b[(l * 2 + dir) * 256 + c], zi = p.rg_i_b[(l * 2 + dir) * 256 + c];
#pragma unroll 8
            for (int d = 0; d < 64; ++d) { const float xv = xl[n * 64 + d]; za += xv * wa[d * 64]; zi += xv * wi[d * 64]; }
            const float r = 1.f / (1.f + expf(-za)), ig = 1.f / (1.f + expf(-zi));
            const float lam = p.rg_lambda[(l * 2 + dir) * 256 + c];
            const float sp = log1pf(expf(-lam));
            const float log_a = -8.f * r * sp;
            const float a = expf(log_a);
            const float bb = sqrtf(-expm1f(2.f * log_a)) * (ig * acc);
            AB[((size_t)R * 2 + dir) * 512 + c] = a;
            AB[((size_t)R * 2 + dir) * 512 + 256 + c] = bb;
        }
    }
}
DEV void ph_rg2(const Params& p) {
    const float* AB = (const float*)(p.ws + OFF_Y);
    float* H = (float*)(p.ws + OFF_X2);
    const int gid = bid_() * 256 + tid_();
    if (gid >= 4096) return;
    const int c = gid & 255, b = (gid >> 8) & 7, dir = gid >> 11;
    float h = 0.f;
    float* Hd = H + (size_t)dir * NTOK * 256;
    for (int seg = 0; seg < 2; ++seg) {
        const int L = seg == 0 ? CTX : S, base = seg == 0 ? NLAT + b * CTX : b * S;
#pragma unroll 8
        for (int s = 0; s < L; ++s) {
            const int tt = dir == 0 ? s : L - 1 - s;
            const size_t R = (size_t)base + tt;
            const float a = AB[(R * 2 + dir) * 512 + c], bb = AB[(R * 2 + dir) * 512 + 256 + c];
            h = a * h + bb;
            Hd[R * 256 + c] = h;
        }
    }
}
DEV void ph_rg3(const Params& p, int nrows) {
    const float* H = (const float*)(p.ws + OFF_X2);
    const bf16_t* P = (const bf16_t*)(p.ws + OFF_P);
    bf16_t* X1 = (bf16_t*)(p.ws + OFF_X1);
    const int c = tid_();
    for (int R = bid_(); R < nrows; R += gridDim.x) {
        const float hs = H[(size_t)R * 256 + c] + H[(size_t)NTOK * 256 + (size_t)R * 256 + c];
        const float gt = bf2f(P[(size_t)R * PWS + COL_GATE + c]);
        X1[(size_t)R * D + c] = f2bf(hs * gelu_tanh(gt));
    }
}

DEV void attn_naive_task(const Params& p, int l, int R, int hh, float* s_sc, int* s_vi, float* s_q) {
    const int lane = tid_() & 63;
    const bool isctx = R >= NLAT;
    const int b = isctx ? (R - NLAT) / CTX : R / S, tt = isctx ? (R - NLAT) % CTX : R % S;
    const bool na = hh < 6; const int h = na ? hh : hh - 6, kvh = h / 3;
    const bf16_t* P = (const bf16_t*)(p.ws + OFF_P);
    s_q[lane] = bf2f(P[(size_t)R * PWS + (na ? COL_NAQ : COL_GQ) + h * 64 + lane]);
    asm volatile("s_waitcnt lgkmcnt(0)" ::: "memory");
    int nloc = 0, r = 0, c = 0, rs = 0, cs = 0, j0 = 0;
    if (!isctx) {
        if (na) { r = tt >> 6; c = tt & 63; rs = min(max(r - 4, 0), 120); cs = min(max(c - 8, 0), 48); nloc = 128; }
        else { j0 = max(0, tt - 128); const int j1 = min(S - 1, tt + 128); nloc = j1 - j0 + 1; }
    }
    const int ntot = nloc + CTX;
    const int kcol = na ? COL_NAK + h * 64 : COL_GK + kvh * 64;
    float mx = -INFINITY;
    for (int k = lane; k < ntot; k += 64) {
        size_t krow; float bias = 0.f; int vi;
        if (k < nloc) {
            int tok;
            if (na) { const int ri = k >> 4, cj = k & 15; tok = (rs + ri) * 64 + cs + cj; bias = p.na_rpb[((size_t)(l * 6 + h) * 15 + (rs + ri - r + 7)) * 31 + (cs + cj - c + 15)]; }
            else tok = j0 + k;
            krow = (size_t)b * S + tok; vi = tok;
        } else { const int kc = k - nloc; krow = (size_t)NLAT + b * CTX + kc; vi = -1 - kc; }
        const bf16_t* kp = P + krow * PWS + kcol;
        float acc = 0.f;
#pragma unroll
        for (int d8 = 0; d8 < 8; ++d8) {
            const uint4 v = *(const uint4*)(kp + d8 * 8);
            acc += s_q[d8 * 8 + 0] * __uint_as_float(v.x << 16) + s_q[d8 * 8 + 1] * __uint_as_float(v.x & 0xffff0000u);
            acc += s_q[d8 * 8 + 2] * __uint_as_float(v.y << 16) + s_q[d8 * 8 + 3] * __uint_as_float(v.y & 0xffff0000u);
            acc += s_q[d8 * 8 + 4] * __uint_as_float(v.z << 16) + s_q[d8 * 8 + 5] * __uint_as_float(v.z & 0xffff0000u);
            acc += s_q[d8 * 8 + 6] * __uint_as_float(v.w << 16) + s_q[d8 * 8 + 7] * __uint_as_float(v.w & 0xffff0000u);
        }
        const float sv = acc + bias;
        s_sc[k] = sv; s_vi[k] = vi; mx = fmaxf(mx, sv);
    }
    mx = wave_max(mx);
    float sinkv = 0.f;
    if (!na) { sinkv = p.gqa_sink[l * 6 + h]; mx = fmaxf(mx, sinkv); }
    asm volatile("s_waitcnt lgkmcnt(0)" ::: "memory");
    float sum = 0.f;
    for (int k = lane; k < ntot; k += 64) { const float e = __expf(s_sc[k] - mx); s_sc[k] = e; sum += e; }
    sum = wave_sum(sum);
    if (!na) sum += __expf(sinkv - mx);
    asm volatile("s_waitcnt lgkmcnt(0)" ::: "memory");
    const bf16_t* vt_lat = na ? (const bf16_t*)(p.ws + OFF_NAVT) + (size_t)((b * 6 + h) * 64 + lane) * S : (const bf16_t*)(p.ws + OFF_GVT) + (size_t)((b * 2 + kvh) * 64 + lane) * S;
    const bf16_t* vt_ctx = na ? (const bf16_t*)(p.ws + OFF_NAVTC) + (size_t)((b * 6 + h) * 64 + lane) * CTX : (const bf16_t*)(p.ws + OFF_GVTC) + (size_t)((b * 2 + kvh) * 64 + lane) * CTX;
    float o = 0.f;
    for (int k = 0; k < ntot; ++k) { const int vi = s_vi[k]; const float pv = s_sc[k]; const bf16_t vv = vi >= 0 ? vt_lat[vi] : vt_ctx[-1 - vi]; o += pv * bf2f(vv); }
    o /= sum;
    ((bf16_t*)(p.ws + OFF_X1))[(size_t)R * D + (na ? 256 : 640) + h * 64 + lane] = f2bf(o);
    asm volatile("s_waitcnt lgkmcnt(0)" ::: "memory");
}
DEV void ph_attn_naive(const Params& p, int l, int nrows, unsigned char* smem) {
    const int w = tid_() >> 6;
    float* s_sc = (float*)smem + w * 528; int* s_vi = (int*)(smem + 4 * 528 * 4) + w * 528; float* s_q = (float*)(smem + 8 * 528 * 4) + w * 64;
    const long ntask = (long)nrows * 12;
    for (long tk = (long)bid_() * 4 + w; tk < ntask; tk += (long)gridDim.x * 4) {
        const int R = (int)(tk / 12), hh = (int)(tk % 12);
        attn_naive_task(p, l, R, hh, s_sc, s_vi, s_q);
    }
}

constexpr float LOG2E = 1.4426950408889634f;
struct AttnState { f32x4 o0, o1, o2, o3; float m, lsum; };
DEV bf16x8 ld16(const bf16_t* p) { return *(const bf16x8*)p; }
DEV bf16x8 ld8x2(const bf16_t* p0, const bf16_t* p1) {
    const uint2 a = *(const uint2*)p0, b = *(const uint2*)p1;
    union { uint4 u; bf16x8 v; } c; c.u = make_uint4(a.x, a.y, b.x, b.y); return c.v;
}
DEV void attn_pair(const bf16_t* k0, const bf16_t* k1, const bf16_t* v0, const bf16_t* v1, size_t vs16, const bf16x8& q0, const bf16x8& q1, f32x4 b0, f32x4 b1, AttnState& st) {
    const bf16x8 a00 = ld16(k0), a01 = ld16(k0 + 32), a10 = ld16(k1), a11 = ld16(k1 + 32);
    const bf16x8 vt0 = ld8x2(v0, v1), vt1 = ld8x2(v0 + vs16, v1 + vs16), vt2 = ld8x2(v0 + 2 * vs16, v1 + 2 * vs16), vt3 = ld8x2(v0 + 3 * vs16, v1 + 3 * vs16);
    const f32x4 z = {0.f, 0.f, 0.f, 0.f};
    f32x4 s0 = __builtin_amdgcn_mfma_f32_16x16x32_bf16(a00, q0, z, 0, 0, 0); s0 = __builtin_amdgcn_mfma_f32_16x16x32_bf16(a01, q1, s0, 0, 0, 0);
    f32x4 s1 = __builtin_amdgcn_mfma_f32_16x16x32_bf16(a10, q0, z, 0, 0, 0); s1 = __builtin_amdgcn_mfma_f32_16x16x32_bf16(a11, q1, s1, 0, 0, 0);
    s0 = s0 * LOG2E + b0; s1 = s1 * LOG2E + b1;
    float mx = fmaxf(fmaxf(fmaxf(s0[0], s0[1]), fmaxf(s0[2], s0[3])), fmaxf(fmaxf(s1[0], s1[1]), fmaxf(s1[2], s1[3])));
    mx = fmaxf(mx, __shfl_xor(mx, 16)); mx = fmaxf(mx, __shfl_xor(mx, 32));
    const float mn = fmaxf(st.m, mx);
    const float ms = (mn == -INFINITY) ? 0.f : mn;
    const float alpha = __builtin_amdgcn_exp2f(st.m - ms);
    f32x4 p0, p1;
#pragma unroll
    for (int j = 0; j < 4; ++j) { p0[j] = __builtin_amdgcn_exp2f(s0[j] - ms); p1[j] = __builtin_amdgcn_exp2f(s1[j] - ms); }
    st.lsum = st.lsum * alpha + ((p0[0] + p0[1]) + (p0[2] + p0[3])) + ((p1[0] + p1[1]) + (p1[2] + p1[3]));
    st.o0 = st.o0 * alpha; st.o1 = st.o1 * alpha; st.o2 = st.o2 * alpha; st.o3 = st.o3 * alpha;
    union { uint4 u; bf16x8 v; } pt; pt.u = make_uint4(pk2(p0[0], p0[1]), pk2(p0[2], p0[3]), pk2(p1[0], p1[1]), pk2(p1[2], p1[3]));
    st.o0 = __builtin_amdgcn_mfma_f32_16x16x32_bf16(vt0, pt.v, st.o0, 0, 0, 0);
    st.o1 = __builtin_amdgcn_mfma_f32_16x16x32_bf16(vt1, pt.v, st.o1, 0, 0, 0);
    st.o2 = __builtin_amdgcn_mfma_f32_16x16x32_bf16(vt2, pt.v, st.o2, 0, 0, 0);
    st.o3 = __builtin_amdgcn_mfma_f32_16x16x32_bf16(vt3, pt.v, st.o3, 0, 0, 0);
    st.m = mn;
}
DEV void attn_ctx_keys(const Params& p, int b, int kcol, const bf16_t* vtc  , const bf16x8& q0, const bf16x8& q1, AttnState& st, int lane) {
    const bf16_t* P = (const bf16_t*)(p.ws + OFF_P);
    const bf16_t* kb = P + (size_t)(NLAT + b * CTX + (lane & 15)) * PWS + kcol + (lane >> 4) * 8;
    const bf16_t* vb = vtc + (size_t)(lane & 15) * CTX + (lane >> 4) * 4;
    const f32x4 z = {0.f, 0.f, 0.f, 0.f};
#pragma unroll
    for (int pp = 0; pp < 8; ++pp) attn_pair(kb + (size_t)(pp * 32) * PWS, kb + (size_t)(pp * 32 + 16) * PWS, vb + pp * 32, vb + pp * 32 + 16, (size_t)16 * CTX, q0, q1, z, z, st);
}
DEV void attn_store(const Params& p, AttnState& st, int R0, int ocol, int lane, float sink2  ) {
    float l = st.lsum; l += __shfl_xor(l, 16); l += __shfl_xor(l, 32);
    float sc;
    if (sink2 != -INFINITY) { const float mf = fmaxf(st.m, sink2); const float al = __builtin_amdgcn_exp2f(st.m - mf); l = l * al + __builtin_amdgcn_exp2f(sink2 - mf); sc = al / l; }
    else sc = 1.f / l;
    bf16_t* o = (bf16_t*)(p.ws + OFF_X1) + (size_t)(R0 + (lane & 15)) * D + ocol + (lane >> 4) * 4;
    uint2 w;
    w.x = pk2(st.o0[0] * sc, st.o0[1] * sc); w.y = pk2(st.o0[2] * sc, st.o0[3] * sc); *(uint2*)(o) = w;
    w.x = pk2(st.o1[0] * sc, st.o1[1] * sc); w.y = pk2(st.o1[2] * sc, st.o1[3] * sc); *(uint2*)(o + 16) = w;
    w.x = pk2(st.o2[0] * sc, st.o2[1] * sc); w.y = pk2(st.o2[2] * sc, st.o2[3] * sc); *(uint2*)(o + 32) = w;
    w.x = pk2(st.o3[0] * sc, st.o3[1] * sc); w.y = pk2(st.o3[2] * sc, st.o3[3] * sc); *(uint2*)(o + 48) = w;
}
DEV void attn_init(AttnState& st) { const f32x4 z = {0.f, 0.f, 0.f, 0.f}; st.o0 = z; st.o1 = z; st.o2 = z; st.o3 = z; st.m = -INFINITY; st.lsum = 0.f; }

constexpr int NTASK_NA = NB * 6 * 128 * 4, NTASK_GQ = NB * 6 * 512, NTASK_CTX = NB * 12 * 16;
DEV void attn_task(const Params& p, int l, int tk, const float* rpb2  ) {
    const int lane = tid_() & 63, g = lane >> 4, fr = lane & 15;
    const bf16_t* P = (const bf16_t*)(p.ws + OFF_P);
    AttnState st; attn_init(st);
    if (tk < NTASK_NA) {
        const int seg = tk & 3, r = (tk >> 2) & 127, hb = tk >> 9, h = hb % 6, b = hb / 6;
        const int R0 = b * S + r * 64 + seg * 16;
        const bf16_t* qp = P + (size_t)(R0 + fr) * PWS + COL_NAQ + h * 64 + g * 8;
        const bf16x8 q0 = ld16(qp), q1 = ld16(qp + 32);
        const int rs = min(max(r - 4, 0), 120), ustart = min(max(seg * 16 - 8, 0), 32);
        const int qc = seg * 16 + fr, cs = min(max(qc - 8, 0), 48);
        int ci[8]; bool ok[8];
#pragma unroll
        for (int e = 0; e < 8; ++e) { const int kc = ustart + (e >> 2) * 16 + g * 4 + (e & 3); ok[e] = (kc >= cs) && (kc < cs + 16); ci[e] = min(max(kc - qc + 15, 0), 30); }
        const bf16_t* kbase = P + (size_t)(b * S + rs * 64 + ustart + fr) * PWS + COL_NAK + h * 64 + g * 8;
        const bf16_t* vbase = (const bf16_t*)(p.ws + OFF_NAVT) + (size_t)((b * 6 + h) * 64 + fr) * S + rs * 64 + ustart + g * 4;
#pragma unroll
        for (int ri = 0; ri < 8; ++ri) {
            const float* rb = rpb2 + (h * 15 + (rs + ri - r + 7)) * 31;
            f32x4 b0, b1;
#pragma unroll
            for (int j = 0; j < 4; ++j) { b0[j] = ok[j] ? rb[ci[j]] : -INFINITY; b1[j] = ok[4 + j] ? rb[ci[4 + j]] : -INFINITY; }
            attn_pair(kbase + (size_t)(ri * 64) * PWS, kbase + (size_t)(ri * 64 + 16) * PWS, vbase + ri * 64, vbase + ri * 64 + 16, (size_t)16 * S, q0, q1, b0, b1, st);
        }
        attn_ctx_keys(p, b, COL_NAK + h * 64, (const bf16_t*)(p.ws + OFF_NAVTC) + (size_t)(b * 6 + h) * 64 * CTX, q0, q1, st, lane);
        attn_store(p, st, R0, 256 + h * 64, lane, -INFINITY);
    } else if (tk < NTASK_NA + NTASK_GQ) {
        const int t2 = tk - NTASK_NA, qt = t2 & 511, hb = t2 >> 9, h = hb % 6, b = hb / 6, kvh = h / 3;
        const int q0i = qt * 16, R0 = b * S + q0i;
        const bf16_t* qp = P + (size_t)(R0 + fr) * PWS + COL_GQ + h * 64 + g * 8;
        const bf16x8 q0 = ld16(qp), q1 = ld16(qp + 32);
        const bf16_t* kcolp = P + COL_GK + kvh * 64 + g * 8;
        const bf16_t* vrow = (const bf16_t*)(p.ws + OFF_GVT) + (size_t)((b * 2 + kvh) * 64 + fr) * S + g * 4;
        const int qi = q0i + fr;
#pragma unroll
        for (int pp = 0; pp < 9; ++pp) {
            const int kb = q0i - 128 + pp * 32;
            if (kb + 32 <= 0 || kb >= S) continue;
            const int t0 = min(max(kb, 0), S - 16), t1 = min(max(kb + 16, 0), S - 16);
            f32x4 b0, b1;
#pragma unroll
            for (int j = 0; j < 4; ++j) {
                const int k0 = kb + g * 4 + j, k1 = k0 + 16;
                b0[j] = (k0 >= 0 && k0 < S && k0 >= qi - 128 && k0 <= qi + 128) ? 0.f : -INFINITY;
                b1[j] = (k1 >= 0 && k1 < S && k1 >= qi - 128 && k1 <= qi + 128) ? 0.f : -INFINITY;
            }
            const bf16_t* k0p = kcolp + (size_t)(b * S + t0 + fr) * PWS; const bf16_t* k1p = kcolp + (size_t)(b * S + t1 + fr) * PWS;
            attn_pair(k0p, k1p, vrow + t0, vrow + t1, (size_t)16 * S, q0, q1, b0, b1, st);
        }
        attn_ctx_keys(p, b, COL_GK + kvh * 64, (const bf16_t*)(p.ws + OFF_GVTC) + (size_t)(b * 2 + kvh) * 64 * CTX, q0, q1, st, lane);
        attn_store(p, st, R0, 640 + h * 64, lane, p.gqa_sink[l * 6 + h] * LOG2E);
    } else {
        const int t3 = tk - NTASK_NA - NTASK_GQ, qt = t3 & 15, hb = t3 >> 4, hh = hb % 12, b = hb / 12;
        const bool na = hh < 6; const int h = na ? hh : hh - 6, kvh = h / 3;
        const int R0 = NLAT + b * CTX + qt * 16;
        const bf16_t* qp = P + (size_t)(R0 + fr) * PWS + (na ? COL_NAQ : COL_GQ) + h * 64 + g * 8;
        const bf16x8 q0 = ld16(qp), q1 = ld16(qp + 32);
        if (na) attn_ctx_keys(p, b, COL_NAK + h * 64, (const bf16_t*)(p.ws + OFF_NAVTC) + (size_t)(b * 6 + h) * 64 * CTX, q0, q1, st, lane);
        else attn_ctx_keys(p, b, COL_GK + kvh * 64, (const bf16_t*)(p.ws + OFF_GVTC) + (size_t)(b * 2 + kvh) * 64 * CTX, q0, q1, st, lane);
        attn_store(p, st, R0, (na ? 256 : 640) + h * 64, lane, na ? -INFINITY : p.gqa_sink[l * 6 + h] * LOG2E);
    }
}
DEV void ph_attn(const Params& p, int l, float* rpb2  ) {
    for (int i = tid_(); i < 6 * 15 * 31; i += 256) rpb2[i] = p.na_rpb[(size_t)l * 6 * 15 * 31 + i] * LOG2E;
    __syncthreads();
    const int w = tid_() >> 6;
    const int ntask = NTASK_NA + NTASK_GQ + (l == 0 ? NTASK_CTX : 0);
    for (int tk = bid_() * 4 + w; tk < ntask; tk += gridDim.x * 4) attn_task(p, l, tk, rpb2);
}

template <int CTRL> DEV float dppf(float old, float v) { return __builtin_bit_cast(float, __builtin_amdgcn_update_dpp(__builtin_bit_cast(int, old), __builtin_bit_cast(int, v), CTRL, 0xf, 0xf, false)); }
template <bool FWD> DEV void row_scan(float& a, float& b) {
#define RG_STEP(SHR, SHL) { const float ap = FWD ? dppf<SHR>(1.f, a) : dppf<SHL>(1.f, a); const float bp = FWD ? dppf<SHR>(0.f, b) : dppf<SHL>(0.f, b); b = fmaf(a, bp, b); a = a * ap; }
    RG_STEP(0x111, 0x101) RG_STEP(0x112, 0x102) RG_STEP(0x114, 0x104) RG_STEP(0x118, 0x108)
#undef RG_STEP
}
DEV int rg_bwd_chunk(int pos) { return pos == 0 ? 1 : (pos == 1 ? 0 : 67 - pos); }
DEV void rg_coef(const f32x4& za, const f32x4& zi, const f32x4& ba, const f32x4& bi, const f32x4& spc, const f32x4& xv, f32x4& a, f32x4& b) {
#pragma unroll
    for (int j = 0; j < 4; ++j) {
        const float r = 1.f / (1.f + __expf(-(za[j] + ba[j])));
        const float ig = 1.f / (1.f + __expf(-(zi[j] + bi[j])));
        const float la = spc[j] * r;
        const float av = __expf(la);
        const float x2 = 2.f * la;
        float om = x2 * (1.f / 720.f) + (1.f / 120.f); om = om * x2 + (1.f / 24.f); om = om * x2 + (1.f / 6.f); om = om * x2 + 0.5f; om = om * x2 + 1.f; om = -x2 * om;
        if (x2 < -0.25f) om = 1.f - av * av;
        a[j] = av; b[j] = sqrtf(om) * (ig * xv[j]);
    }
}
template <bool FINAL> DEV void rg_item(const Params& p, int l, int rt, bf16_t* lds) {
    const int t = tid_(), lane = t & 63, n = t >> 6, g = lane >> 4, fr = lane & 15;
    const bf16_t* P = (const bf16_t*)(p.ws + OFF_P);
    const bool isctx = rt >= 512;
    const int b = isctx ? (rt - 512) >> 1 : rt >> 6, idx = isctx ? (rt - 512) & 1 : 2 + (rt & 63);
    const int L = isctx ? CTX : S, t0 = isctx ? idx * 128 : (idx - 2) * 128, seqbase = isctx ? NLAT + b * CTX : b * S;
    bf16_t* xl = lds + n * (128 * 64);
    {
        const int c = lane & 7, ch0 = n * 64 + c * 8;
        f32x4 cwa[4], cwb[4];
#pragma unroll
        for (int j = 0; j < 4; ++j) { cwa[j] = *(const f32x4*)(p.conv_w + (l * 4 + j) * 256 + ch0); cwb[j] = *(const f32x4*)(p.conv_w + (l * 4 + j) * 256 + ch0 + 4); }
        const f32x4 cba = *(const f32x4*)(p.conv_b + l * 256 + ch0), cbb = *(const f32x4*)(p.conv_b + l * 256 + ch0 + 4);
#pragma unroll 2
        for (int it = 0; it < 16; ++it) {
            const int tok = it * 8 + (lane >> 3), ts = t0 + tok;
            f32x4 acca = cba, accb = cbb;
#pragma unroll
            for (int j = 0; j < 4; ++j) {
                const int tj = ts + j - 2;
                if (tj >= 0 && tj < L) {
                    const uint4 v = *(const uint4*)(P + (size_t)(seqbase + tj) * PWS + COL_RGX + ch0);
                    const f32x4 xa = {__uint_as_float(v.x << 16), __uint_as_float(v.x & 0xffff0000u), __uint_as_float(v.y << 16), __uint_as_float(v.y & 0xffff0000u)};
                    const f32x4 xb = {__uint_as_float(v.z << 16), __uint_as_float(v.z & 0xffff0000u), __uint_as_float(v.w << 16), __uint_as_float(v.w & 0xffff0000u)};
                    acca = acca + cwa[j] * xa; accb = accb + cwb[j] * xb;
                }
            }
            uint4 o; o.x = pk2(acca[0], acca[1]); o.y = pk2(acca[2], acca[3]); o.z = pk2(accb[0], accb[1]); o.w = pk2(accb[2], accb[3]);
            *(uint4*)(xl + tok * 64 + ((c ^ ((tok >> 1) & 7)) * 8)) = o;
        }
    }
    asm volatile("s_waitcnt lgkmcnt(0)" ::: "memory");
    const bf16_t* W = (const bf16_t*)(p.ws + OFF_WRG) + (size_t)(l * 2) * 2 * 4 * 64 * 64;
    const float* C = (const float*)(p.ws + OFF_RGC) + (size_t)(l * 2) * 3 * 256;
    float* AGG = (float*)(p.ws + OFF_AGG) + (size_t)(b * 66) * 1024;
    const int swz = (fr >> 1) & 7;
#pragma unroll 1
    for (int ct = 0; ct < 4; ++ct) {
        const int ch = n * 64 + ct * 16 + g * 4;
        f32x4 hf0, hf1, hf2, hf3, hf4, hf5, hf6, hf7;
        const f32x4 z4 = {0.f, 0.f, 0.f, 0.f};
        hf0 = z4; hf1 = z4; hf2 = z4; hf3 = z4; hf4 = z4; hf5 = z4; hf6 = z4; hf7 = z4;
#pragma unroll
        for (int dir = 0; dir < 2; ++dir) {
            const bf16x8 wa0 = ld16(W + ((size_t)((dir * 2 + 0) * 4 + n) * 64 + ct * 16 + fr) * 64 + g * 8), wa1 = ld16(W + ((size_t)((dir * 2 + 0) * 4 + n) * 64 + ct * 16 + fr) * 64 + 32 + g * 8);
            const bf16x8 wi0 = ld16(W + ((size_t)((dir * 2 + 1) * 4 + n) * 64 + ct * 16 + fr) * 64 + g * 8), wi1 = ld16(W + ((size_t)((dir * 2 + 1) * 4 + n) * 64 + ct * 16 + fr) * 64 + 32 + g * 8);
            const f32x4 ba = *(const f32x4*)(C + (dir * 3 + 0) * 256 + ch), bi = *(const f32x4*)(C + (dir * 3 + 1) * 256 + ch), spc = *(const f32x4*)(C + (dir * 3 + 2) * 256 + ch);
            f32x4 hin = z4, atot = {1.f, 1.f, 1.f, 1.f};
            if (FINAL) {
                const int npre = dir == 0 ? idx : (idx == 1 ? 0 : (idx == 0 ? 1 : 67 - idx));
#pragma unroll 4
                for (int q = 0; q < npre; ++q) {
                    const int cq = dir == 0 ? q : rg_bwd_chunk(q);
                    const f32x4 A = *(const f32x4*)(AGG + (size_t)(cq * 2 + dir) * 512 + ch), B = *(const f32x4*)(AGG + (size_t)(cq * 2 + dir) * 512 + 256 + ch);
                    hin = A * hin + B;
                }
            }
#pragma unroll
            for (int s = 0; s < 8; ++s) {
                const int tt = dir == 0 ? s : 7 - s;
                const int row = tt * 16 + fr;
                const bf16x8 x0 = *(const bf16x8*)(xl + row * 64 + ((g ^ swz) * 8)), x1 = *(const bf16x8*)(xl + row * 64 + (((g | 4) ^ swz) * 8));
                f32x4 za = __builtin_amdgcn_mfma_f32_16x16x32_bf16(wa0, x0, z4, 0, 0, 0); za = __builtin_amdgcn_mfma_f32_16x16x32_bf16(wa1, x1, za, 0, 0, 0);
                f32x4 zi = __builtin_amdgcn_mfma_f32_16x16x32_bf16(wi0, x0, z4, 0, 0, 0); zi = __builtin_amdgcn_mfma_f32_16x16x32_bf16(wi1, x1, zi, 0, 0, 0);
                const uint2 xr = *(const uint2*)(xl + row * 64 + (((ct * 2 + (g >> 1)) ^ swz) * 8) + (g & 1) * 4);
                const f32x4 xv = {__uint_as_float(xr.x << 16), __uint_as_float(xr.x & 0xffff0000u), __uint_as_float(xr.y << 16), __uint_as_float(xr.y & 0xffff0000u)};
                f32x4 a, bb;
                rg_coef(za, zi, ba, bi, spc, xv, a, bb);
                f32x4 h;
#pragma unroll
                for (int j = 0; j < 4; ++j) {
                    float aj = a[j], bj = bb[j];
                    if (dir == 0) row_scan<true>(aj, bj); else row_scan<false>(aj, bj);
                    h[j] = fmaf(aj, hin[j], bj);
                    atot[j] *= aj;
                }
                const int src = (lane & 48) | (dir == 0 ? 15 : 0);
#pragma unroll
                for (int j = 0; j < 4; ++j) hin[j] = __shfl(h[j], src);
                if (FINAL) {
                    if (dir == 0) {
                        if (tt == 0) hf0 = h; else if (tt == 1) hf1 = h; else if (tt == 2) hf2 = h; else if (tt == 3) hf3 = h; else if (tt == 4) hf4 = h; else if (tt == 5) hf5 = h; else if (tt == 6) hf6 = h; else hf7 = h;
                    } else {
                        const f32x4 hfv = tt == 0 ? hf0 : tt == 1 ? hf1 : tt == 2 ? hf2 : tt == 3 ? hf3 : tt == 4 ? hf4 : tt == 5 ? hf5 : tt == 6 ? hf6 : hf7;
                        const size_t R = (size_t)seqbase + t0 + row;
                        const uint2 gr = *(const uint2*)(P + R * PWS + COL_GATE + ch);
                        const f32x4 hs = hfv + h;
                        uint2 o;
                        o.x = pk2(hs[0] * gelu_tanh(__uint_as_float(gr.x << 16)), hs[1] * gelu_tanh(__uint_as_float(gr.x & 0xffff0000u)));
                        o.y = pk2(hs[2] * gelu_tanh(__uint_as_float(gr.y << 16)), hs[3] * gelu_tanh(__uint_as_float(gr.y & 0xffff0000u)));
                        *(uint2*)((bf16_t*)(p.ws + OFF_X1) + R * D + ch) = o;
                    }
                }
            }
            if (!FINAL) {
                if (fr == (dir == 0 ? 15 : 0)) { *(f32x4*)(AGG + (size_t)(idx * 2 + dir) * 512 + ch) = atot; *(f32x4*)(AGG + (size_t)(idx * 2 + dir) * 512 + 256 + ch) = hin; }
            }
        }
    }
}
DEV void ph_rgagg(const Params& p, int l, bf16_t* lds) {
    for (int rt = bid_(); rt < 528; rt += gridDim.x) { rg_item<false>(p, l, rt, lds); __syncthreads(); }
}

DEV void outproj_item(const Params& p, int l, int rt, bf16_t* lds, float* stat  ) {
    const int t = tid_(), lane = t & 63, w = t >> 6, wm = w >> 1, wn = w & 1, fq = lane >> 4, fr = lane & 15;
    const bf16_t* A = (const bf16_t*)(p.ws + OFF_X1) + (size_t)(rt * 128 + (t >> 2)) * D + (t & 3) * 8;
    const bool isctx = rt >= 512;
    const float* g1 = modvec(p, l, rt * 128, 2);
    rg_item<true>(p, l, rt, lds);
    __threadfence();
    __syncthreads();
    __builtin_amdgcn_fence(__ATOMIC_ACQUIRE, "agent");
#pragma unroll 1
    for (int pass = 0; pass < 4; ++pass) {
        const bf16_t* Bt = (const bf16_t*)(p.ws + OFF_WOUTT) + ((size_t)l * 1024 + pass * 256 + (t >> 2)) * 1024 + (t & 3) * 8;
        f32x4 acc[4][8]; zero_acc(acc);
        gemm_mainloop(A, A + 64 * D, Bt, 1024, 32, lds, acc);
#pragma unroll
        for (int mt = 0; mt < 4; ++mt) {
            const int rl = wm * 64 + mt * 16 + fr, R = rt * 128 + rl;
            const float* xin = (l == 0) ? (isctx ? p.ctx + (size_t)(R - NLAT) * D : p.x + (size_t)R * D) : xres_row(p, R);
            float* xo = xres_row(p, R);
            float s = 0.f, q = 0.f;
#pragma unroll
            for (int nt = 0; nt < 8; ++nt) {
                const int col = pass * 256 + wn * 128 + nt * 16 + fq * 4;
                const f32x4 xv = *(const f32x4*)(xin + col), gv = *(const f32x4*)(g1 + col);
                const f32x4 u = xv * ALPHA + gv * acc[mt][nt];
                *(f32x4*)(xo + col) = u;
                s += (u[0] + u[1]) + (u[2] + u[3]); q += (u[0] * u[0] + u[1] * u[1]) + (u[2] * u[2] + u[3] * u[3]);
            }
            s += __shfl_xor(s, 16); s += __shfl_xor(s, 32); q += __shfl_xor(q, 16); q += __shfl_xor(q, 32);
            if (fq == 0) { stat[((pass * 2 + wn) * 128 + rl) * 2] = s; stat[((pass * 2 + wn) * 128 + rl) * 2 + 1] = q; }
        }
    }
    __threadfence();
    __syncthreads();
    __builtin_amdgcn_fence(__ATOMIC_ACQUIRE, "agent");
    {
        const float* lg = p.ln1_g + l * D; const float* lb = p.ln1_b + l * D;
        const float* sh2 = modvec(p, l, rt * 128, 3); const float* sc2 = modvec(p, l, rt * 128, 4);
        bf16_t* X2 = (bf16_t*)(p.ws + OFF_X2);
        const bf16_t* WRh = (const bf16_t*)(p.ws + OFF_WR) + (size_t)(l * 2) * 48 * 1024 + (size_t)fr * 1024 + fq * 8;
        const bf16_t* WRl = WRh + 48 * 1024;
        float mean[2], rstd[2];
#pragma unroll
        for (int tm = 0; tm < 2; ++tm) {
            const int rl = w * 32 + tm * 16 + fr;
            float s = 0.f, q = 0.f;
#pragma unroll
            for (int i = 0; i < 8; ++i) { s += stat[(i * 128 + rl) * 2]; q += stat[(i * 128 + rl) * 2 + 1]; }
            mean[tm] = s * (1.f / D);
            rstd[tm] = rsqrtf(fmaxf(q * (1.f / D) - mean[tm] * mean[tm], 0.f) + LN_EPS);
        }
        f32x4 lacc[3][2];
#pragma unroll
        for (int a = 0; a < 3; ++a) { lacc[a][0] = (f32x4){0.f, 0.f, 0.f, 0.f}; lacc[a][1] = (f32x4){0.f, 0.f, 0.f, 0.f}; }
#pragma unroll 2
        for (int ks = 0; ks < 32; ++ks) {
            const int k = ks * 32 + fq * 8;
            const f32x4 g0 = *(const f32x4*)(lg + k), g1v = *(const f32x4*)(lg + k + 4), b0 = *(const f32x4*)(lb + k), b1 = *(const f32x4*)(lb + k + 4);
            const f32x4 s0 = *(const f32x4*)(sh2 + k), s1 = *(const f32x4*)(sh2 + k + 4), c0 = *(const f32x4*)(sc2 + k), c1 = *(const f32x4*)(sc2 + k + 4);
            bf16x8 hh[2], hl[2];
#pragma unroll
            for (int tm = 0; tm < 2; ++tm) {
                const int R = rt * 128 + w * 32 + tm * 16 + fr;
                float* xr = xres_row(p, R) + k;
                const f32x4 u0 = *(const f32x4*)xr, u1 = *(const f32x4*)(xr + 4);
                const f32x4 x0 = (u0 - mean[tm]) * rstd[tm] * g0 + b0, x1 = (u1 - mean[tm]) * rstd[tm] * g1v + b1;
                *(f32x4*)xr = x0; *(f32x4*)(xr + 4) = x1;
                const f32x4 h0 = x0 * (c0 + 1.f) + s0, h1 = x1 * (c1 + 1.f) + s1;
#pragma unroll
                for (int e = 0; e < 4; ++e) {
                    const bf16_t a = f2bf(h0[e]), b = f2bf(h1[e]);
                    hh[tm][e] = (short)a; hh[tm][4 + e] = (short)b;
                    hl[tm][e] = (short)f2bf(h0[e] - bf2f(a)); hl[tm][4 + e] = (short)f2bf(h1[e] - bf2f(b));
                }
                *(bf16x8*)(X2 + (size_t)R * D + k) = hh[tm];
            }
#pragma unroll
            for (int ft = 0; ft < 3; ++ft) {
                const bf16x8 wh = *(const bf16x8*)(WRh + (size_t)ft * 16 * 1024 + ks * 32), wl = *(const bf16x8*)(WRl + (size_t)ft * 16 * 1024 + ks * 32);
#pragma unroll
                for (int tm = 0; tm < 2; ++tm) {
                    lacc[ft][tm] = __builtin_amdgcn_mfma_f32_16x16x32_bf16(wh, hh[tm], lacc[ft][tm], 0, 0, 0);
                    lacc[ft][tm] = __builtin_amdgcn_mfma_f32_16x16x32_bf16(wl, hh[tm], lacc[ft][tm], 0, 0, 0);
                    lacc[ft][tm] = __builtin_amdgcn_mfma_f32_16x16x32_bf16(wh, hl[tm], lacc[ft][tm], 0, 0, 0);
                }
            }
        }
        float* lt = (float*)lds;
#pragma unroll
        for (int ft = 0; ft < 3; ++ft)
#pragma unroll
            for (int tm = 0; tm < 2; ++tm)
#pragma unroll
                for (int j = 0; j < 4; ++j) lt[(w * 32 + tm * 16 + fr) * 48 + ft * 16 + fq * 4 + j] = lacc[ft][tm][j];
        asm volatile("s_waitcnt lgkmcnt(0)" ::: "memory");
        if (lane < 32) {
            const int rl = w * 32 + lane, R = rt * 128 + rl;
            const float* lr = lt + rl * 48;
            int gi = 0; float gm = lr[0] + p.router_g_b[l * 4];
            float gl[4]; gl[0] = gm;
#pragma unroll
            for (int j = 1; j < 4; ++j) { gl[j] = lr[j] + p.router_g_b[l * 4 + j]; if (gl[j] > gm) { gm = gl[j]; gi = j; } }
            float gs = 0.f;
#pragma unroll
            for (int j = 0; j < 4; ++j) gs += expf(gl[j] - gm);
            const float ptop = 1.f / gs;
            int e0 = 0, e1 = 0; float m0 = -INFINITY, m1 = -INFINITY;
            for (int j = 0; j < 8; ++j) {
                const float v = lr[4 + gi * 8 + j] + p.router_e_b[l * 32 + gi * 8 + j];
                if (v > m0) { m1 = m0; e1 = e0; m0 = v; e0 = j; } else if (v > m1) { m1 = v; e1 = j; }
            }
            const float ex = expf(m1 - m0);
            const float w0 = ptop / (1.f + ex), w1 = ptop * ex / (1.f + ex);
            int* rte = (int*)(p.ws + OFF_RTE); float* rtw = (float*)(p.ws + OFF_RTW);
            unsigned* cnt = (unsigned*)(p.ws + OFF_CTL) + CW_CNT + l * 32;
            int* list = (int*)(p.ws + OFF_LIST);
            const int E0 = gi * 8 + e0, E1 = gi * 8 + e1;
            rte[R * 2] = E0; rte[R * 2 + 1] = E1; rtw[R * 2] = w0; rtw[R * 2 + 1] = w1;
            const unsigned p0 = atomicAdd(cnt + E0, 1u); list[(size_t)E0 * LISTCAP + p0] = R * 2;
            const unsigned p1 = atomicAdd(cnt + E1, 1u); list[(size_t)E1 * LISTCAP + p1] = R * 2 + 1;
        }
    }
}
DEV void ph_outproj(const Params& p, int l, bf16_t* lds, float* stat  ) {
    const int ntiles = (l == 0) ? 528 : 512;
    for (int rt = bid_(); rt < ntiles; rt += gridDim.x) { outproj_item(p, l, rt, lds, stat); __syncthreads(); }
}

DEV void moe_item(const Params& p, int l, int e, int j, int item, int cnt, bf16_t* lds) {
    const int t = tid_(), lane = t & 63, w = t >> 6, wm = w >> 1, wn = w & 1, fq = lane >> 4, fr = lane & 15;
    const int* list = (const int*)(p.ws + OFF_LIST) + (size_t)e * LISTCAP;
    const bf16_t* X2 = (const bf16_t*)(p.ws + OFF_X2);
    bf16_t* Hs = (bf16_t*)(p.ws + OFF_P) + (size_t)item * 128 * FF;
    const bf16_t *ap0, *ap1;
    { const int s0 = j * 128 + (t >> 2), s1 = s0 + 64;
      const int tok0 = s0 < cnt ? (list[s0] >> 1) : 0, tok1 = s1 < cnt ? (list[s1] >> 1) : 0;
      ap0 = X2 + (size_t)tok0 * D + (t & 3) * 8; ap1 = X2 + (size_t)tok1 * D + (t & 3) * 8; }
#pragma unroll 1
    for (int pass = 0; pass < 4; ++pass) {
        const bf16_t* Bt = (const bf16_t*)(p.ws + OFF_WGU) + ((size_t)e * 1024 + pass * 256 + (t >> 2)) * 1024 + (t & 3) * 8;
        f32x4 acc[4][8]; zero_acc(acc);
        gemm_mainloop(ap0, ap1, Bt, 1024, 32, lds, acc);
#pragma unroll
        for (int mt = 0; mt < 4; ++mt) {
            const int rl = wm * 64 + mt * 16 + fr;
#pragma unroll
            for (int nt = 0; nt < 4; ++nt) {
                const f32x4 gv = acc[mt][nt], uv = acc[mt][nt + 4];
                float hv[4];
#pragma unroll
                for (int jj = 0; jj < 4; ++jj) hv[jj] = gv[jj] / (1.f + __expf(-gv[jj])) * uv[jj];
                uint2 o; o.x = pk2(hv[0], hv[1]); o.y = pk2(hv[2], hv[3]);
                *(uint2*)(Hs + (size_t)rl * FF + pass * 128 + wn * 64 + nt * 16 + fq * 4) = o;
            }
        }
    }
    __threadfence();
    __syncthreads();
    __builtin_amdgcn_fence(__ATOMIC_ACQUIRE, "agent");
    const bf16_t* A = Hs + (size_t)(t >> 2) * FF + (t & 3) * 8;
    const float* rtw = (const float*)(p.ws + OFF_RTW);
    bf16_t* Y = (bf16_t*)(p.ws + OFF_Y);
#pragma unroll 1
    for (int pass = 0; pass < 4; ++pass) {
        const bf16_t* Bt = (const bf16_t*)(p.ws + OFF_WD) + ((size_t)e * 1024 + pass * 256 + (t >> 2)) * FF + (t & 3) * 8;
        f32x4 acc[4][8]; zero_acc(acc);
        gemm_mainloop(A, A + 64 * FF, Bt, FF, 16, lds, acc);
#pragma unroll
        for (int mt = 0; mt < 4; ++mt) {
            const int s = j * 128 + wm * 64 + mt * 16 + fr;
            if (s < cnt) {
                const int ent = list[s];
                const float gw = rtw[ent];
                bf16_t* yo = Y + (size_t)ent * D + pass * 256 + wn * 128 + fq * 4;
#pragma unroll
                for (int nt = 0; nt < 8; ++nt) { const f32x4 v = acc[mt][nt] * gw; uint2 o; o.x = pk2(v[0], v[1]); o.y = pk2(v[2], v[3]); *(uint2*)(yo + nt * 16) = o; }
            }
        }
    }
}
DEV void ph_moe(const Params& p, int l, bf16_t* lds, int* s_pref  , int* s_cnt  ) {
    const unsigned* cnt = (const unsigned*)(p.ws + OFF_CTL) + CW_CNT + l * 32;
    if (tid_() == 0) { int a = 0; for (int e = 0; e < 32; ++e) { const int c = (int)cnt[e]; s_cnt[e] = c; s_pref[e] = a; a += (c + 127) >> 7; } s_pref[32] = a; }
    __syncthreads();
    const int nitems = s_pref[32];
    for (int it = bid_(); it < nitems; it += gridDim.x) {
        int e = 0;
        while (e < 31 && it >= s_pref[e + 1]) ++e;
        moe_item(p, l, e, it - s_pref[e], it, s_cnt[e], lds);
        __syncthreads();
    }
}

namespace cg = cooperative_groups;
constexpr int SMEM_BYTES = 65536;
constexpr int NPHASE = 12;
__global__ void __launch_bounds__(256, 2) mega(Params p, int ph_lo, int ph_hi) {
    __shared__ __attribute__((aligned(16))) unsigned char smem[SMEM_BYTES];
    bf16_t* lds = (bf16_t*)smem;
    float* stat = (float*)(smem + GEMM_LDS_ELEMS * 2);
    int* s_pref = (int*)(smem + GEMM_LDS_ELEMS * 2 + 8 * 128 * 2 * 4); int* s_cnt = s_pref + 40;

#define IN(k) (ph_lo <= (k) && (k) < ph_hi)
#define SEAM(k) do { if (IN(k) && IN((k) + 1)) cg::this_grid().sync(); } while (0)
    if (IN(0)) {
        ph_mod(kp_(), (float*)smem); __syncthreads();
        ph_rope(kp_());
        ph_routerw(kp_());
        ph_rgprep(kp_());
        ph_transpose(kp_().w_in, (bf16_t*)(kp_().ws + OFF_WINT), 1024, 2304, 0, 2, (size_t)1024 * 2304, (size_t)2304 * 1024, (float*)smem);
        ph_transpose(kp_().w_out, (bf16_t*)(kp_().ws + OFF_WOUTT), 1024, 1024, 0, 2, (size_t)1024 * 1024, (size_t)1024 * 1024, (float*)smem);
    }
    SEAM(0);
#pragma unroll 1
    for (int l = 0; l < 2; ++l) {
        const int pb = 1 + l * 5;
        if (IN(pb + 0)) { if (l == 0) ph_rowop<0>(kp_(), 0, NTOK); else ph_rowop<1>(kp_(), 1, NTOK); }
        SEAM(pb + 0);
        if (IN(pb + 1)) ph_inproj(kp_(), l, lds);
        SEAM(pb + 1);
        if (IN(pb + 2)) {
            ph_rgagg(kp_(), l, lds);
            ph_attn(kp_(), l, (float*)smem); __syncthreads();
            ph_transpose(kp_().exp_w_gate + (size_t)l * NE * 1024 * 512, (bf16_t*)(kp_().ws + OFF_WGU), 1024, 512, 1, NE, (size_t)1024 * 512, (size_t)1024 * 1024, (float*)smem);
            ph_transpose(kp_().exp_w_up + (size_t)l * NE * 1024 * 512, (bf16_t*)(kp_().ws + OFF_WGU), 1024, 512, 2, NE, (size_t)1024 * 512, (size_t)1024 * 1024, (float*)smem);
            ph_transpose(kp_().exp_w_down + (size_t)l * NE * 512 * 1024, (bf16_t*)(kp_().ws + OFF_WD), 512, 1024, 0, NE, (size_t)512 * 1024, (size_t)1024 * 512, (float*)smem);
        }
        SEAM(pb + 2);
        if (IN(pb + 3)) ph_outproj(kp_(), l, lds, stat);
        SEAM(pb + 3);
        if (IN(pb + 4)) ph_moe(kp_(), l, lds, s_pref, s_cnt);
        SEAM(pb + 4);
    }
    if (IN(NPHASE - 1)) ph_rowop<2>(kp_(), 2, NLAT);
#undef IN
#undef SEAM
}

#ifndef ONE_LAUNCH
#define ONE_LAUNCH 1
#endif
extern "C" void kernel_launch(void* const* d_in, const int* in_sizes, int n_in, void* d_out, int out_size, void* d_ws, size_t ws_size, hipStream_t stream) {
    if (n_in != 28 || ws_size < WS_TOTAL || out_size != NLAT * D) { fprintf(stderr, "kernel_launch: unexpected shapes / workspace (%d inputs, ws %zu need %zu)\n", n_in, ws_size, (size_t)WS_TOTAL); return; }
    static int grid = 0;
    if (grid == 0) {
        int dev = 0, cus = 0, per_cu = 0;
        (void)hipGetDevice(&dev);
        (void)hipDeviceGetAttribute(&cus, hipDeviceAttributeMultiprocessorCount, dev);
        (void)hipOccupancyMaxActiveBlocksPerMultiprocessor(&per_cu, (const void*)mega, 256, 0);
        if (per_cu > 2) per_cu = 2;
        grid = cus * per_cu;
        if (grid <= 0) { fprintf(stderr, "kernel_launch: occupancy query gave %d blocks per CU on %d CUs\n", per_cu, cus); grid = -1; }
    }
    if (grid < 0) return;
    Params p{};
    const float** pp = (const float**)&p;
    for (int i = 0; i < 28; ++i) pp[i] = (const float*)d_in[i];
    p.out = (float*)d_out; p.ws = (unsigned char*)d_ws;
    (void)hipMemsetAsync((unsigned char*)d_ws + OFF_CTL, 0, CTL_BYTES, stream);
#if ONE_LAUNCH
    int lo = 0, hi = NPHASE;
    void* args[] = {(void*)&p, (void*)&lo, (void*)&hi};
    hipError_t e = hipLaunchCooperativeKernel((const void*)mega, dim3(grid), dim3(256), args, 0, stream);
    if (e != hipSuccess) fprintf(stderr, "kernel_launch: cooperative launch failed: %s (grid %d)\n", hipGetErrorString(e), grid);
#else
    for (int ph = 0; ph < NPHASE; ++ph) mega<<<grid, 256, 0, stream>>>(p, ph, ph + 1);
#endif
}
```

```cpp
#include <hip/hip_runtime.h>
#include <hip/hip_cooperative_groups.h>
#include <stdint.h>
#include <cstdio>

typedef unsigned short bf16_t;
typedef short bf16x8 __attribute__((ext_vector_type(8)));
typedef float f32x4 __attribute__((ext_vector_type(4)));

#define DEV __device__ __forceinline__
#define PROBE_ID -1
#define PROBE_N 4

constexpr int D = 1024, NB = 8, S = 8192, CTX = 256;
constexpr int NLAT = NB * S, NCTX = NB * CTX, NTOK = NLAT + NCTX;
constexpr int PWS = 1792;
constexpr int COL_RGX = 0, COL_NAK = 256, COL_GK = 640, COL_GATE = 768, COL_NAQ = 1024, COL_GQ = 1408;
constexpr int NE = 32, FF = 512;
constexpr int LISTCAP = NTOK;
constexpr float ALPHA = 1.4142135623730951f;
constexpr float LN_EPS = 1e-5f;

constexpr size_t al256(size_t x) { return (x + 255) & ~(size_t)255; }
constexpr size_t OFF_CTL   = 0;
constexpr size_t CTL_BYTES = 4096;
constexpr size_t OFF_MOD   = OFF_CTL + CTL_BYTES;
constexpr size_t OFF_ROPE  = al256(OFF_MOD + (size_t)2 * 9 * 6144 * 4);
constexpr size_t OFF_RTE   = al256(OFF_ROPE + (size_t)2 * 128 * 16 * 4);
constexpr size_t OFF_RTW   = al256(OFF_RTE + (size_t)NTOK * 8);
constexpr size_t OFF_LIST  = al256(OFF_RTW + (size_t)NTOK * 8);
constexpr size_t OFF_WR    = al256(OFF_LIST + (size_t)NE * LISTCAP * 4);
constexpr size_t OFF_WRG   = al256(OFF_WR + (size_t)2 * 2 * 48 * 1024 * 2);
constexpr size_t OFF_RGC   = al256(OFF_WRG + (size_t)2 * 2 * 2 * 4 * 64 * 64 * 2);
constexpr size_t OFF_AGG   = al256(OFF_RGC + (size_t)2 * 2 * 3 * 256 * 4);
constexpr size_t OFF_WINT  = al256(OFF_AGG + (size_t)NB * 66 * 2 * 2 * 256 * 4);
constexpr size_t OFF_WOUTT = al256(OFF_WINT + (size_t)2 * 2304 * 1024 * 2);
constexpr size_t OFF_WGU   = al256(OFF_WOUTT + (size_t)2 * 1024 * 1024 * 2);
constexpr size_t OFF_WD    = al256(OFF_WGU + (size_t)NE * 1024 * 1024 * 2);
constexpr size_t OFF_XCTX  = al256(OFF_WD + (size_t)NE * 1024 * 512 * 2);
constexpr size_t OFF_X1    = al256(OFF_XCTX + (size_t)NCTX * D * 4);
constexpr size_t OFF_X2    = al256(OFF_X1 + (size_t)NTOK * D * 2);
constexpr size_t OFF_P     = al256(OFF_X2 + (size_t)NTOK * D * 2);
constexpr size_t OFF_NAVT  = al256(OFF_P + (size_t)NTOK * PWS * 2);
constexpr size_t OFF_NAVTC = al256(OFF_NAVT + (size_t)NB * 6 * 64 * S * 2);
constexpr size_t OFF_GVT   = al256(OFF_NAVTC + (size_t)NB * 6 * 64 * CTX * 2);
constexpr size_t OFF_GVTC  = al256(OFF_GVT + (size_t)NB * 2 * 64 * S * 2);
constexpr size_t OFF_Y     = al256(OFF_GVTC + (size_t)NB * 2 * 64 * CTX * 2);
constexpr size_t WS_TOTAL  = al256(OFF_Y + (size_t)2 * NTOK * D * 2);
constexpr int CW_CNT = 0;

struct Params {
    const float *x, *c, *ctx, *c_ctx, *w_ada, *b_ada, *w_in, *conv_w, *conv_b, *rg_a_w, *rg_a_b, *rg_i_w, *rg_i_b, *rg_lambda,
        *na_rpb, *gqa_sink, *w_out, *ln1_g, *ln1_b, *router_g_w, *router_g_b, *router_e_w, *router_e_b, *exp_w_gate, *exp_w_up,
        *exp_w_down, *ln2_g, *ln2_b;
    float* out;
    unsigned char* ws;
};

DEV const Params& kp_() { const void* q = (const void*)__builtin_amdgcn_kernarg_segment_ptr(); asm volatile("" : "+s"(q)); return *(const Params*)q; }
DEV int tid_() { int t = threadIdx.x; asm volatile("" : "+v"(t)); return t; }
DEV int bid_() { int b = blockIdx.x; asm volatile("" : "+s"(b)); return b; }
DEV float shx(float v, int m) { return __builtin_bit_cast(float, __builtin_amdgcn_ds_bpermute(((tid_() & 63) ^ m) << 2, __builtin_bit_cast(int, v))); }
DEV float shl_(float v, int src) { return __builtin_bit_cast(float, __builtin_amdgcn_ds_bpermute(src << 2, __builtin_bit_cast(int, v))); }
DEV float bf2f(bf16_t h) { return __uint_as_float((unsigned)h << 16); }
DEV bf16_t f2bf(float f) { unsigned u = __float_as_uint(f); u += 0x7fffu + ((u >> 16) & 1u); return (bf16_t)(u >> 16); }
DEV unsigned pk2(float lo, float hi) { return (unsigned)f2bf(lo) | ((unsigned)f2bf(hi) << 16); }
DEV float wave_sum(float v) {
#pragma unroll
    for (int o = 1; o < 64; o <<= 1) v += shx(v, o);
    return v;
}
DEV float wave_max(float v) {
#pragma unroll
    for (int o = 1; o < 64; o <<= 1) v = fmaxf(v, shx(v, o));
    return v;
}
DEV float sigmoidf_(float x) { return 1.f / (1.f + __expf(-x)); }
DEV float gelu_tanh(float x) {
    const float u = 0.7978845608028654f * (x + 0.044715f * x * x * x);
    const float t = 1.f - 2.f / (1.f + __expf(2.f * u));
    return 0.5f * x * (1.f + t);
}
DEV float* xres_row(const Params& p, int R) {
    return R < NLAT ? p.out + (size_t)R * D : (float*)(p.ws + OFF_XCTX) + (size_t)(R - NLAT) * D;
}
DEV const float* modvec(const Params& p, int l, int R, int seg) {
    const int b = R < NLAT ? R / S : 8;
    return (const float*)(p.ws + OFF_MOD) + ((size_t)(l * 9 + b) * 6 + seg) * 1024;
}

DEV void ph_mod(const Params& p, float* sc  ) {
    if (bid_() >= 48) return;
    for (int i = tid_(); i < 9 * 1024; i += 256) { const float v = (i < 8192) ? p.c[i] : p.c_ctx[i - 8192]; sc[i] = v / (1.f + expf(-v)); }
    __syncthreads();
    const int col = bid_() * 256 + tid_();
    const int l = col / 6144, j = col % 6144;
    const float* w = p.w_ada + (size_t)l * 1024 * 6144 + j;
    float a0 = 0, a1 = 0, a2 = 0, a3 = 0, a4 = 0, a5 = 0, a6 = 0, a7 = 0, a8 = 0;
    for (int k = 0; k < 1024; ++k) {
        const float wv = w[(size_t)k * 6144];
        a0 += sc[k] * wv; a1 += sc[1024 + k] * wv; a2 += sc[2048 + k] * wv; a3 += sc[3072 + k] * wv; a4 += sc[4096 + k] * wv;
        a5 += sc[5120 + k] * wv; a6 += sc[6144 + k] * wv; a7 += sc[7168 + k] * wv; a8 += sc[8192 + k] * wv;
    }
    const float bias = p.b_ada[l * 6144 + j];
    float* mod = (float*)(p.ws + OFF_MOD) + (size_t)l * 9 * 6144 + j;
    mod[0 * 6144] = a0 + bias; mod[1 * 6144] = a1 + bias; mod[2 * 6144] = a2 + bias; mod[3 * 6144] = a3 + bias; mod[4 * 6144] = a4 + bias;
    mod[5 * 6144] = a5 + bias; mod[6 * 6144] = a6 + bias; mod[7 * 6144] = a7 + bias; mod[8 * 6144] = a8 + bias;
}

DEV void sincos_red(float ang, float& sn, float& cs) {
    const float n = rintf(ang * 0.15915494309189535f);
    float r = fmaf(-n, 6.2831854820251465f, ang);
    r = fmaf(-n, -1.7484555e-07f, r);
    float sgn = 1.f;
    if (r > 1.5707963267948966f) { r = 3.14159265358979f - r; sgn = -1.f; }
    else if (r < -1.5707963267948966f) { r = -3.14159265358979f - r; sgn = -1.f; }
    const float r2 = r * r;
    float sp = -1.6059044e-10f; sp = fmaf(sp, r2, 2.5052108e-08f); sp = fmaf(sp, r2, -2.7557319e-06f); sp = fmaf(sp, r2, 1.9841270e-04f);
    sp = fmaf(sp, r2, -8.3333333e-03f); sp = fmaf(sp, r2, 1.6666667e-01f); sp = fmaf(sp * -1.f, r2, 1.f);
    sn = r * sp;
    float cp = -1.1470746e-11f; cp = fmaf(cp, r2, 2.0876757e-09f); cp = fmaf(cp, r2, -2.7557319e-07f); cp = fmaf(cp, r2, 2.4801587e-05f);
    cp = fmaf(cp, r2, -1.3888889e-03f); cp = fmaf(cp, r2, 4.1666667e-02f); cp = fmaf(cp, r2, -0.5f); cp = fmaf(cp, r2, 1.f);
    cs = sgn * cp;
}
DEV void ph_rope(const Params& p) {
    const int i = (bid_() - 48) * 256 + tid_();
    if (i < 0 || i >= 128 * 16) return;
    const int pos = i >> 4, q = i & 15;
    const float inv = exp2f(-(float)q * (13.287712379549449f / 16.f));
    float sn, cs; sincos_red((float)pos * inv, sn, cs);
    float* tab = (float*)(p.ws + OFF_ROPE);
    tab[i] = cs; tab[2048 + i] = sn;
}

DEV void ph_routerw(const Params& p) {
  for (int i = bid_() * 256 + tid_(); i < 2 * 48 * 1024; i += gridDim.x * 256) {
    const int l = i / (48 * 1024), f = (i / 1024) % 48, k = i & 1023;
    float w = 0.f;
    if (f < 4) w = p.router_g_w[((size_t)l * 1024 + k) * 4 + f]; else if (f < 36) w = p.router_e_w[((size_t)l * 1024 + k) * 32 + (f - 4)];
    const bf16_t hi = f2bf(w), lo = f2bf(w - bf2f(hi));
    bf16_t* WR = (bf16_t*)(p.ws + OFF_WR);
    WR[((size_t)(l * 2 + 0) * 48 + f) * 1024 + k] = hi;
    WR[((size_t)(l * 2 + 1) * 48 + f) * 1024 + k] = lo;
  }
}

DEV void ph_rgprep(const Params& p) {
    bf16_t* W = (bf16_t*)(p.ws + OFF_WRG);
    for (int i = bid_() * 256 + tid_(); i < 2 * 2 * 2 * 4 * 64 * 64; i += gridDim.x * 256) {
        const int d = i & 63, e = (i >> 6) & 63, n = (i >> 12) & 3, gate = (i >> 14) & 1, ld = i >> 15;
        const float* srcw = gate ? p.rg_i_w : p.rg_a_w;
        W[i] = f2bf(srcw[((size_t)(ld * 4 + n) * 64 + d) * 64 + e]);
    }
    float* C = (float*)(p.ws + OFF_RGC);
    for (int i = bid_() * 256 + tid_(); i < 2 * 2 * 256; i += gridDim.x * 256) {
        const int c = i & 255, ld = i >> 8;
        C[(ld * 3 + 0) * 256 + c] = p.rg_a_b[ld * 256 + c];
        C[(ld * 3 + 1) * 256 + c] = p.rg_i_b[ld * 256 + c];
        C[(ld * 3 + 2) * 256 + c] = -8.f * log1pf(expf(-p.rg_lambda[ld * 256 + c]));
    }
}

DEV int tr_row(int n, int mode) { return mode == 0 ? n : ((n >> 7) * 256 + ((n >> 6) & 1) * 128 + (n & 63) + (mode == 2 ? 64 : 0)); }
DEV void transpose_tile(const float* src, bf16_t* dst, int K, int N, int mode, int tile, float* lds) {
    const int ntn = N >> 6, kt = tile / ntn, nt = tile % ntn, k0 = kt * 64, n0 = nt * 64, t = tid_();
#pragma unroll
    for (int i = 0; i < 4; ++i) {
        const int r = (t >> 4) + 16 * i, c4 = (t & 15) * 4;
        const float4 v = *(const float4*)(src + (size_t)(k0 + r) * N + n0 + c4);
        lds[r * 65 + c4] = v.x; lds[r * 65 + c4 + 1] = v.y; lds[r * 65 + c4 + 2] = v.z; lds[r * 65 + c4 + 3] = v.w;
    }
    __syncthreads();
#pragma unroll
    for (int i = 0; i < 2; ++i) {
        const int n = (t >> 3) + 32 * i, kc = (t & 7) * 8;
        uint4 o;
        o.x = pk2(lds[(kc + 0) * 65 + n], lds[(kc + 1) * 65 + n]); o.y = pk2(lds[(kc + 2) * 65 + n], lds[(kc + 3) * 65 + n]);
        o.z = pk2(lds[(kc + 4) * 65 + n], lds[(kc + 5) * 65 + n]); o.w = pk2(lds[(kc + 6) * 65 + n], lds[(kc + 7) * 65 + n]);
        *(uint4*)(dst + (size_t)tr_row(n0 + n, mode) * K + k0 + kc) = o;
    }
    __syncthreads();
}
DEV void ph_transpose(const float* src, bf16_t* dst, int K, int N, int mode, int nmat, size_t sstride, size_t dstride, float* lds  ) {
    const int per = (K >> 6) * (N >> 6);
    for (int it = bid_(); it < nmat * per; it += gridDim.x) {
        const int m = it / per, tile = it % per;
        transpose_tile(src + (size_t)m * sstride, dst + (size_t)m * dstride, K, N, mode, tile, lds);
    }
}

template <int MODE> DEV void rowop(const Params& p, int l, int R) {
    const int lane = tid_() & 63;
    float4 v[4];
    if (MODE == 0) {
        const float* src = R < NLAT ? p.x + (size_t)R * D : p.ctx + (size_t)(R - NLAT) * D;
#pragma unroll
        for (int i = 0; i < 4; ++i) v[i] = *(const float4*)(src + i * 256 + lane * 4);
    } else {
        float* xr = xres_row(p, R);
        const float* g2 = modvec(p, l - 1, R, 5);
        const bf16_t* y0 = (const bf16_t*)(p.ws + OFF_Y) + (size_t)(2 * R) * D;
        const bf16_t* y1 = y0 + D;
        const float* lg = p.ln2_g + (l - 1) * D; const float* lb = p.ln2_b + (l - 1) * D;
        float s = 0.f;
#pragma unroll
        for (int i = 0; i < 4; ++i) {
            const int k = i * 256 + lane * 4;
            const float4 xv = *(const float4*)(xr + k); const float4 gv = *(const float4*)(g2 + k);
            const uint2 a = *(const uint2*)(y0 + k); const uint2 b = *(const uint2*)(y1 + k);
            float4 u;
            u.x = ALPHA * xv.x + gv.x * (bf2f((bf16_t)(a.x & 0xffff)) + bf2f((bf16_t)(b.x & 0xffff)));
            u.y = ALPHA * xv.y + gv.y * (bf2f((bf16_t)(a.x >> 16)) + bf2f((bf16_t)(b.x >> 16)));
            u.z = ALPHA * xv.z + gv.z * (bf2f((bf16_t)(a.y & 0xffff)) + bf2f((bf16_t)(b.y & 0xffff)));
            u.w = ALPHA * xv.w + gv.w * (bf2f((bf16_t)(a.y >> 16)) + bf2f((bf16_t)(b.y >> 16)));
            v[i] = u; s += (u.x + u.y) + (u.z + u.w);
        }
        const float mean = wave_sum(s) * (1.f / D);
        float q = 0.f;
#pragma unroll
        for (int i = 0; i < 4; ++i) { v[i].x -= mean; v[i].y -= mean; v[i].z -= mean; v[i].w -= mean; q += (v[i].x * v[i].x + v[i].y * v[i].y) + (v[i].z * v[i].z + v[i].w * v[i].w); }
        const float rstd = rsqrtf(wave_sum(q) * (1.f / D) + LN_EPS);
#pragma unroll
        for (int i = 0; i < 4; ++i) {
            const int k = i * 256 + lane * 4;
            const float4 gg = *(const float4*)(lg + k); const float4 bb = *(const float4*)(lb + k);
            v[i].x = v[i].x * rstd * gg.x + bb.x; v[i].y = v[i].y * rstd * gg.y + bb.y; v[i].z = v[i].z * rstd * gg.z + bb.z; v[i].w = v[i].w * rstd * gg.w + bb.w;
            *(float4*)(xr + k) = v[i];
        }
    }
    if (MODE != 2) {
        const float* sh = modvec(p, l, R, 0); const float* sc = modvec(p, l, R, 1);
        bf16_t* ha = (bf16_t*)(p.ws + OFF_X1) + (size_t)R * D;
#pragma unroll
        for (int i = 0; i < 4; ++i) {
            const int k = i * 256 + lane * 4;
            const float4 s4 = *(const float4*)(sh + k); const float4 c4 = *(const float4*)(sc + k);
            uint2 o; o.x = pk2(v[i].x * (1.f + c4.x) + s4.x, v[i].y * (1.f + c4.y) + s4.y); o.y = pk2(v[i].z * (1.f + c4.z) + s4.z, v[i].w * (1.f + c4.w) + s4.w);
            *(uint2*)(ha + k) = o;
        }
    }
}
template <int MODE> DEV void ph_rowop(const Params& p, int l, int nrows) {
    const int w = tid_() >> 6;
    for (int R = bid_() * 4 + w; R < nrows; R += gridDim.x * 4) rowop<MODE>(p, l, R);
}

constexpr int GEMM_STAGE_BYTES = 384 * 64;
constexpr int GEMM_NSTAGE = 3;
constexpr int GEMM_LDS_BYTES = GEMM_NSTAGE * GEMM_STAGE_BYTES;
#define LAS __attribute__((address_space(3)))
DEV int gemm_src_chunk(int t) { return ((t & 3) ^ ((0 - (t >> 4)) & 3)) * 8; }
DEV void gemm_mainloop(const bf16_t* Abase, unsigned ao0, unsigned ao1, const bf16_t* Bbase, unsigned bo, unsigned ldb, int nk, bf16_t* lds, f32x4 (&acc)[4][8]) {
    const int t = tid_(), lane = t & 63, w = __builtin_amdgcn_readfirstlane(t >> 6), wm = w >> 1, wn = w & 1;
    LAS unsigned char* L = (LAS unsigned char*)lds;
    const int pc = ((lane >> 4) ^ ((0 - ((lane & 15) >> 2)) & 3)) * 16;
    const int arow = (wm * 64 + (lane & 15)) * 64 + pc, brow = (128 + wn * 128 + (lane & 15)) * 64 + pc;
    const char* Ab = (const char*)Abase; const char* B0 = (const char*)Bbase; const char* B1 = B0 + (size_t)ldb * 128; const char* B2 = B0 + (size_t)ldb * 256; const char* B3 = B0 + (size_t)ldb * 384;
#define GEMM_ISSUE(slot, ko) do { LAS unsigned* d_ = (LAS unsigned*)(L + (slot) * GEMM_STAGE_BYTES + w * 1024); \
        __builtin_amdgcn_global_load_lds((const unsigned*)(Ab + (ao0 + (ko) * 2u)), d_, 16, 0, 0); \
        __builtin_amdgcn_global_load_lds((const unsigned*)(Ab + (ao1 + (ko) * 2u)), d_ + 1024, 16, 0, 0); \
        __builtin_amdgcn_global_load_lds((const unsigned*)(B0 + (bo + (ko) * 2u)), d_ + 2048, 16, 0, 0); \
        __builtin_amdgcn_global_load_lds((const unsigned*)(B1 + (bo + (ko) * 2u)), d_ + 3072, 16, 0, 0); \
        __builtin_amdgcn_global_load_lds((const unsigned*)(B2 + (bo + (ko) * 2u)), d_ + 4096, 16, 0, 0); \
        __builtin_amdgcn_global_load_lds((const unsigned*)(B3 + (bo + (ko) * 2u)), d_ + 5120, 16, 0, 0); } while (0)
    asm volatile("s_waitcnt vmcnt(0)" ::: "memory");
    __builtin_amdgcn_s_barrier();
    asm volatile("" ::: "memory");
    GEMM_ISSUE(0, 0);
    if (nk > 1) GEMM_ISSUE(1, 32);
    int cs = 0, is = 2;
    for (int kt = 0; kt < nk; ++kt) {
        if (kt + 1 < nk) asm volatile("s_waitcnt vmcnt(6)" ::: "memory"); else asm volatile("s_waitcnt vmcnt(0)" ::: "memory");
        __builtin_amdgcn_s_barrier();
        asm volatile("" ::: "memory");
        if (kt + 2 < nk) GEMM_ISSUE(is, (kt + 2) * 32);
        const LAS unsigned char* cur = L + cs * GEMM_STAGE_BYTES;
        const bf16x8 af0 = *(const LAS bf16x8*)(cur + arow), af1 = *(const LAS bf16x8*)(cur + arow + 16 * 64), af2 = *(const LAS bf16x8*)(cur + arow + 32 * 64), af3 = *(const LAS bf16x8*)(cur + arow + 48 * 64);
        bf16x8 bq0 = *(const LAS bf16x8*)(cur + brow), bq1 = *(const LAS bf16x8*)(cur + brow + 16 * 64);
#pragma unroll
        for (int nt = 0; nt < 8; ++nt) {
            const bf16x8 bfr = bq0; bq0 = bq1;
            if (nt + 2 < 8) bq1 = *(const LAS bf16x8*)(cur + brow + (nt + 2) * 16 * 64);
            acc[0][nt] = __builtin_amdgcn_mfma_f32_16x16x32_bf16(bfr, af0, acc[0][nt], 0, 0, 0);
            acc[1][nt] = __builtin_amdgcn_mfma_f32_16x16x32_bf16(bfr, af1, acc[1][nt], 0, 0, 0);
            acc[2][nt] = __builtin_amdgcn_mfma_f32_16x16x32_bf16(bfr, af2, acc[2][nt], 0, 0, 0);
            acc[3][nt] = __builtin_amdgcn_mfma_f32_16x16x32_bf16(bfr, af3, acc[3][nt], 0, 0, 0);
        }
        cs = cs == 2 ? 0 : cs + 1; is = is == 2 ? 0 : is + 1;
    }
#undef GEMM_ISSUE
}
DEV void zero_acc(f32x4 (&acc)[4][8]) {
#pragma unroll
    for (int a = 0; a < 4; ++a)
#pragma unroll
        for (int b = 0; b < 8; ++b) acc[a][b] = (f32x4){0.f, 0.f, 0.f, 0.f};
}

DEV void inproj_item(const Params& p_, int l, int rt, int pass, bf16_t* lds) {
    const Params& p = kp_();
    const int t = tid_(), lane = t & 63, w = t >> 6, wm = w >> 1, wn = w & 1;
    const bf16_t* A = (const bf16_t*)(p.ws + OFF_X1) + (size_t)(rt * 128) * D;
    const bf16_t* Bt = (const bf16_t*)(p.ws + OFF_WINT) + ((size_t)l * 2304 + pass * 256) * 1024;
    const unsigned toff = (unsigned)(((t >> 2) * 1024 + gemm_src_chunk(t)) * 2);
    f32x4 acc[4][8]; zero_acc(acc);
    gemm_mainloop(A, toff, toff + 64 * D * 2, Bt, toff, 1024, 32, lds, acc);
    bf16_t* P = (bf16_t*)(p.ws + OFF_P);
    const float* ctab = (const float*)(p.ws + OFF_ROPE); const float* stab = ctab + 2048;
    const bool isctx = rt >= 512;
    const int fq = lane >> 4, fr = lane & 15;
#pragma unroll
    for (int hci = 0; hci < 2; ++hci) {
        const int hc = pass * 4 + wn * 2 + hci;
        int type, dcol = 0, vh = 0;
        if (hc < 4) { type = 0; dcol = COL_RGX + hc * 64; }
        else if (hc < 10) { type = 0; dcol = COL_NAK + (hc - 4) * 64; }
        else if (hc < 16) { type = 4; vh = hc - 10; }
        else if (hc < 18) { type = 2; dcol = COL_GK + (hc - 16) * 64; }
        else if (hc < 20) { type = 5; vh = hc - 18; }
        else if (hc < 24) { type = 0; dcol = COL_GATE + (hc - 20) * 64; }
        else if (hc < 30) { type = 1; dcol = COL_NAQ + (hc - 24) * 64; }
        else { type = 3; dcol = COL_GQ + (hc - 30) * 64; }
#pragma unroll
        for (int mt = 0; mt < 4; ++mt) {
            const int R = rt * 128 + wm * 64 + mt * 16 + fr;
            f32x4 v0 = acc[mt][hci * 4 + 0], v1 = acc[mt][hci * 4 + 1], v2 = acc[mt][hci * 4 + 2], v3 = acc[mt][hci * 4 + 3];
            if ((type == 2 || type == 3) && !isctx) {
                const int tt = R & (S - 1), pr = tt >> 6, pc = tt & 63;
                const f32x4 cr = *(const f32x4*)(ctab + pr * 16 + fq * 4), sr = *(const f32x4*)(stab + pr * 16 + fq * 4);
                const f32x4 cc = *(const f32x4*)(ctab + pc * 16 + fq * 4), sc = *(const f32x4*)(stab + pc * 16 + fq * 4);
                const f32x4 o0 = v0 * cr - v1 * sr, o1 = v1 * cr + v0 * sr, o2 = v2 * cc - v3 * sc, o3 = v3 * cc + v2 * sc;
                v0 = o0; v1 = o1; v2 = o2; v3 = o3;
            }
            if (type == 1 || type == 3) { v0 = v0 * 0.125f; v1 = v1 * 0.125f; v2 = v2 * 0.125f; v3 = v3 * 0.125f; }
            if (type < 4) {
                bf16_t* o = P + (size_t)R * PWS + dcol + fq * 4;
                uint2 q;
                q.x = pk2(v0[0], v0[1]); q.y = pk2(v0[2], v0[3]); *(uint2*)(o) = q;
                q.x = pk2(v1[0], v1[1]); q.y = pk2(v1[2], v1[3]); *(uint2*)(o + 16) = q;
                q.x = pk2(v2[0], v2[1]); q.y = pk2(v2[2], v2[3]); *(uint2*)(o + 32) = q;
                q.x = pk2(v3[0], v3[1]); q.y = pk2(v3[2], v3[3]); *(uint2*)(o + 48) = q;
            } else {
                bf16_t* base; size_t dstride;
                if (!isctx) { const int b = R >> 13, tt = R & (S - 1);
                    base = (type == 4 ? (bf16_t*)(p.ws + OFF_NAVT) + (size_t)(b * 6 + vh) * 64 * S : (bf16_t*)(p.ws + OFF_GVT) + (size_t)(b * 2 + vh) * 64 * S) + tt; dstride = S; }
                else { const int cR = R - NLAT, b = cR >> 8, tt = cR & 255;
                    base = (type == 4 ? (bf16_t*)(p.ws + OFF_NAVTC) + (size_t)(b * 6 + vh) * 64 * CTX : (bf16_t*)(p.ws + OFF_GVTC) + (size_t)(b * 2 + vh) * 64 * CTX) + tt; dstride = CTX; }
#pragma unroll
                for (int j = 0; j < 4; ++j) {
                    base[(size_t)(0 * 16 + fq * 4 + j) * dstride] = f2bf(v0[j]);
                    base[(size_t)(1 * 16 + fq * 4 + j) * dstride] = f2bf(v1[j]);
                    base[(size_t)(2 * 16 + fq * 4 + j) * dstride] = f2bf(v2[j]);
                    base[(size_t)(3 * 16 + fq * 4 + j) * dstride] = f2bf(v3[j]);
                }
            }
        }
    }
}
DEV void ph_inproj(const Params& p, int l, bf16_t* lds) {
    const int nctxp = (l == 0) ? 9 : 5;
    const int nitems = 512 * 9 + 16 * nctxp;
    for (int it0 = bid_(); it0 < nitems * ((PROBE_ID) == 3 ? PROBE_N : 1); it0 += gridDim.x) {
        const int it = it0 % nitems;
        int rt, pass;
        if (it < 512 * 9) { rt = it / 9; pass = it % 9; } else { const int r = it - 512 * 9; rt = 512 + r / nctxp; pass = r % nctxp; }
        inproj_item(p, l, rt, pass, lds);
    }
}

DEV void ph_rg1(const Params& p, int l, float* xl  ) {
    const bf16_t* P = (const bf16_t*)(p.ws + OFF_P);
    float* AB = (float*)(p.ws + OFF_Y);
    const int c = tid_(), n = c >> 6, e = c & 63;
    for (int R = bid_(); R < NTOK; R += gridDim.x) {
        const bool isctx = R >= NLAT;
        const int L = isctx ? CTX : S, base = isctx ? NLAT + ((R - NLAT) / CTX) * CTX : (R / S) * S, tt = R - base;
        float acc = p.conv_b[l * 256 + c];
#pragma unroll
        for (int j = 0; j < 4; ++j) { const int ts = tt + j - 2; if (ts >= 0 && ts < L) acc += p.conv_w[(l * 4 + j) * 256 + c] * bf2f(P[(size_t)(base + ts) * PWS + COL_RGX + c]); }
        __syncthreads();
        xl[c] = acc;
        __syncthreads();
#pragma unroll
        for (int dir = 0; dir < 2; ++dir) {
            const float* wa = p.rg_a_w + ((size_t)((l * 2 + dir) * 4 + n) * 64) * 64 + e;
            const float* wi = p.rg_i_w + ((size_t)((l * 2 + dir) * 4 + n) * 64) * 64 + e;
            float za = p.rg_a_b[(l * 2 + dir) * 256 + c], zi = p.rg_i_b[(l * 2 + dir) * 256 + c];
#pragma unroll 8
            for (int d = 0; d < 64; ++d) { const float xv = xl[n * 64 + d]; za += xv * wa[d * 64]; zi += xv * wi[d * 64]; }
            const float r = 1.f / (1.f + expf(-za)), ig = 1.f / (1.f + expf(-zi));
            const float lam = p.rg_lambda[(l * 2 + dir) * 256 + c];
            const float sp = log1pf(expf(-lam));
            const float log_a = -8.f * r * sp;
            const float a = expf(log_a);
            const float bb = sqrtf(-expm1f(2.f * log_a)) * (ig * acc);
            AB[((size_t)R * 2 + dir) * 512 + c] = a;
            AB[((size_t)R * 2 + dir) * 512 + 256 + c] = bb;
        }
    }
}
DEV void ph_rg2(const Params& p) {
    const float* AB = (const float*)(p.ws + OFF_Y);
    float* H = (float*)(p.ws + OFF_X2);
    const int gid = bid_() * 256 + tid_();
    if (gid >= 4096) return;
    const int c = gid & 255, b = (gid >> 8) & 7, dir = gid >> 11;
    float h = 0.f;
    float* Hd = H + (size_t)dir * NTOK * 256;
    for (int seg = 0; seg < 2; ++seg) {
        const int L = seg == 0 ? CTX : S, base = seg == 0 ? NLAT + b * CTX : b * S;
#pragma unroll 8
        for (int s = 0; s < L; ++s) {
            const int tt = dir == 0 ? s : L - 1 - s;
            const size_t R = (size_t)base + tt;
            const float a = AB[(R * 2 + dir) * 512 + c], bb = AB[(R * 2 + dir) * 512 + 256 + c];
            h = a * h + bb;
            Hd[R * 256 + c] = h;
        }
    }
}
DEV void ph_rg3(const Params& p, int nrows) {
    const float* H = (const float*)(p.ws + OFF_X2);
    const bf16_t* P = (const bf16_t*)(p.ws + OFF_P);
    bf16_t* X1 = (bf16_t*)(p.ws + OFF_X1);
    const int c = tid_();
    for (int R = bid_(); R < nrows; R += gridDim.x) {
        const float hs = H[(size_t)R * 256 + c] + H[(size_t)NTOK * 256 + (size_t)R * 256 + c];
        const float gt = bf2f(P[(size_t)R * PWS + COL_GATE + c]);
        X1[(size_t)R * D + c] = f2bf(hs * gelu_tanh(gt));
    }
}

DEV void attn_naive_task(const Params& p, int l, int R, int hh, float* s_sc, int* s_vi, float* s_q) {
    const int lane = tid_() & 63;
    const bool isctx = R >= NLAT;
    const int b = isctx ? (R - NLAT) / CTX : R / S, tt = isctx ? (R - NLAT) % CTX : R % S;
    const bool na = hh < 6; const int h = na ? hh : hh - 6, kvh = h / 3;
    const bf16_t* P = (const bf16_t*)(p.ws + OFF_P);
    s_q[lane] = bf2f(P[(size_t)R * PWS + (na ? COL_NAQ : COL_GQ) + h * 64 + lane]);
    asm volatile("s_waitcnt lgkmcnt(0)" ::: "memory");
    int nloc = 0, r = 0, c = 0, rs = 0, cs = 0, j0 = 0;
    if (!isctx) {
        if (na) { r = tt >> 6; c = tt & 63; rs = min(max(r - 4, 0), 120); cs = min(max(c - 8, 0), 48); nloc = 128; }
        else { j0 = max(0, tt - 128); const int j1 = min(S - 1, tt + 128); nloc = j1 - j0 + 1; }
    }
    const int ntot = nloc + CTX;
    const int kcol = na ? COL_NAK + h * 64 : COL_GK + kvh * 64;
    float mx = -INFINITY;
    for (int k = lane; k < ntot; k += 64) {
        size_t krow; float bias = 0.f; int vi;
        if (k < nloc) {
            int tok;
            if (na) { const int ri = k >> 4, cj = k & 15; tok = (rs + ri) * 64 + cs + cj; bias = p.na_rpb[((size_t)(l * 6 + h) * 15 + (rs + ri - r + 7)) * 31 + (cs + cj - c + 15)]; }
            else tok = j0 + k;
            krow = (size_t)b * S + tok; vi = tok;
        } else { const int kc = k - nloc; krow = (size_t)NLAT + b * CTX + kc; vi = -1 - kc; }
        const bf16_t* kp = P + krow * PWS + kcol;
        float acc = 0.f;
#pragma unroll
        for (int d8 = 0; d8 < 8; ++d8) {
            const uint4 v = *(const uint4*)(kp + d8 * 8);
            acc += s_q[d8 * 8 + 0] * __uint_as_float(v.x << 16) + s_q[d8 * 8 + 1] * __uint_as_float(v.x & 0xffff0000u);
            acc += s_q[d8 * 8 + 2] * __uint_as_float(v.y << 16) + s_q[d8 * 8 + 3] * __uint_as_float(v.y & 0xffff0000u);
            acc += s_q[d8 * 8 + 4] * __uint_as_float(v.z << 16) + s_q[d8 * 8 + 5] * __uint_as_float(v.z & 0xffff0000u);
            acc += s_q[d8 * 8 + 6] * __uint_as_float(v.w << 16) + s_q[d8 * 8 + 7] * __uint_as_float(v.w & 0xffff0000u);
        }
        const float sv = acc + bias;
        s_sc[k] = sv; s_vi[k] = vi; mx = fmaxf(mx, sv);
    }
    mx = wave_max(mx);
    float sinkv = 0.f;
    if (!na) { sinkv = p.gqa_sink[l * 6 + h]; mx = fmaxf(mx, sinkv); }
    asm volatile("s_waitcnt lgkmcnt(0)" ::: "memory");
    float sum = 0.f;
    for (int k = lane; k < ntot; k += 64) { const float e = __expf(s_sc[k] - mx); s_sc[k] = e; sum += e; }
    sum = wave_sum(sum);
    if (!na) sum += __expf(sinkv - mx);
    asm volatile("s_waitcnt lgkmcnt(0)" ::: "memory");
    const bf16_t* vt_lat = na ? (const bf16_t*)(p.ws + OFF_NAVT) + (size_t)((b * 6 + h) * 64 + lane) * S : (const bf16_t*)(p.ws + OFF_GVT) + (size_t)((b * 2 + kvh) * 64 + lane) * S;
    const bf16_t* vt_ctx = na ? (const bf16_t*)(p.ws + OFF_NAVTC) + (size_t)((b * 6 + h) * 64 + lane) * CTX : (const bf16_t*)(p.ws + OFF_GVTC) + (size_t)((b * 2 + kvh) * 64 + lane) * CTX;
    float o = 0.f;
    for (int k = 0; k < ntot; ++k) { const int vi = s_vi[k]; const float pv = s_sc[k]; const bf16_t vv = vi >= 0 ? vt_lat[vi] : vt_ctx[-1 - vi]; o += pv * bf2f(vv); }
    o /= sum;
    ((bf16_t*)(p.ws + OFF_X1))[(size_t)R * D + (na ? 256 : 640) + h * 64 + lane] = f2bf(o);
    asm volatile("s_waitcnt lgkmcnt(0)" ::: "memory");
}
DEV void ph_attn_naive(const Params& p, int l, int nrows, unsigned char* smem) {
    const int w = tid_() >> 6;
    float* s_sc = (float*)smem + w * 528; int* s_vi = (int*)(smem + 4 * 528 * 4) + w * 528; float* s_q = (float*)(smem + 8 * 528 * 4) + w * 64;
    const long ntask = (long)nrows * 12;
    for (long tk = (long)bid_() * 4 + w; tk < ntask; tk += (long)gridDim.x * 4) {
        const int R = (int)(tk / 12), hh = (int)(tk % 12);
        attn_naive_task(p, l, R, hh, s_sc, s_vi, s_q);
    }
}

constexpr float LOG2E = 1.4426950408889634f;
struct AttnState { f32x4 o0, o1, o2, o3; float m, lsum; };
DEV bf16x8 ld16(const bf16_t* p) { return *(const bf16x8*)p; }
DEV bf16x8 ld8x2(const bf16_t* p0, const bf16_t* p1) {
    const uint2 a = *(const uint2*)p0, b = *(const uint2*)p1;
    union { uint4 u; bf16x8 v; } c; c.u = make_uint4(a.x, a.y, b.x, b.y); return c.v;
}
DEV void attn_pair(const bf16_t* k0, const bf16_t* k1, const bf16_t* v0, const bf16_t* v1, size_t vs16, const bf16x8& q0, const bf16x8& q1, f32x4 b0, f32x4 b1, AttnState& st) {
    const bf16x8 a00 = ld16(k0), a01 = ld16(k0 + 32), a10 = ld16(k1), a11 = ld16(k1 + 32);
    const bf16x8 vt0 = ld8x2(v0, v1), vt1 = ld8x2(v0 + vs16, v1 + vs16), vt2 = ld8x2(v0 + 2 * vs16, v1 + 2 * vs16), vt3 = ld8x2(v0 + 3 * vs16, v1 + 3 * vs16);
    const f32x4 z = {0.f, 0.f, 0.f, 0.f};
    f32x4 s0 = __builtin_amdgcn_mfma_f32_16x16x32_bf16(a00, q0, z, 0, 0, 0); s0 = __builtin_amdgcn_mfma_f32_16x16x32_bf16(a01, q1, s0, 0, 0, 0);
    f32x4 s1 = __builtin_amdgcn_mfma_f32_16x16x32_bf16(a10, q0, z, 0, 0, 0); s1 = __builtin_amdgcn_mfma_f32_16x16x32_bf16(a11, q1, s1, 0, 0, 0);
    s0 = s0 * LOG2E + b0; s1 = s1 * LOG2E + b1;
    float mx = fmaxf(fmaxf(fmaxf(s0[0], s0[1]), fmaxf(s0[2], s0[3])), fmaxf(fmaxf(s1[0], s1[1]), fmaxf(s1[2], s1[3])));
    mx = fmaxf(mx, shx(mx, 16)); mx = fmaxf(mx, shx(mx, 32));
    const float mn = fmaxf(st.m, mx);
    const float ms = (mn == -INFINITY) ? 0.f : mn;
    const float alpha = __builtin_amdgcn_exp2f(st.m - ms);
    f32x4 p0, p1;
#pragma unroll
    for (int j = 0; j < 4; ++j) { p0[j] = __builtin_amdgcn_exp2f(s0[j] - ms); p1[j] = __builtin_amdgcn_exp2f(s1[j] - ms); }
    st.lsum = st.lsum * alpha + ((p0[0] + p0[1]) + (p0[2] + p0[3])) + ((p1[0] + p1[1]) + (p1[2] + p1[3]));
    st.o0 = st.o0 * alpha; st.o1 = st.o1 * alpha; st.o2 = st.o2 * alpha; st.o3 = st.o3 * alpha;
    union { uint4 u; bf16x8 v; } pt; pt.u = make_uint4(pk2(p0[0], p0[1]), pk2(p0[2], p0[3]), pk2(p1[0], p1[1]), pk2(p1[2], p1[3]));
    st.o0 = __builtin_amdgcn_mfma_f32_16x16x32_bf16(vt0, pt.v, st.o0, 0, 0, 0);
    st.o1 = __builtin_amdgcn_mfma_f32_16x16x32_bf16(vt1, pt.v, st.o1, 0, 0, 0);
    st.o2 = __builtin_amdgcn_mfma_f32_16x16x32_bf16(vt2, pt.v, st.o2, 0, 0, 0);
    st.o3 = __builtin_amdgcn_mfma_f32_16x16x32_bf16(vt3, pt.v, st.o3, 0, 0, 0);
    st.m = mn;
}
DEV void attn_ctx_keys(const Params& p, int b, int kcol, const bf16_t* vtc  , const bf16x8& q0, const bf16x8& q1, AttnState& st, int lane) {
    const bf16_t* P = (const bf16_t*)(p.ws + OFF_P);
    const bf16_t* kb = P + (size_t)(NLAT + b * CTX + (lane & 15)) * PWS + kcol + (lane >> 4) * 8;
    const bf16_t* vb = vtc + (size_t)(lane & 15) * CTX + (lane >> 4) * 4;
    const f32x4 z = {0.f, 0.f, 0.f, 0.f};
#pragma unroll
    for (int pp = 0; pp < 8; ++pp) attn_pair(kb + (size_t)(pp * 32) * PWS, kb + (size_t)(pp * 32 + 16) * PWS, vb + pp * 32, vb + pp * 32 + 16, (size_t)16 * CTX, q0, q1, z, z, st);
}
DEV void attn_store(const Params& p, AttnState& st, int R0, int ocol, int lane, float sink2  ) {
    float l = st.lsum; l += shx(l, 16); l += shx(l, 32);
    float sc;
    if (sink2 != -INFINITY) { const float mf = fmaxf(st.m, sink2); const float al = __builtin_amdgcn_exp2f(st.m - mf); l = l * al + __builtin_amdgcn_exp2f(sink2 - mf); sc = al / l; }
    else sc = 1.f / l;
    bf16_t* o = (bf16_t*)(p.ws + OFF_X1) + (size_t)(R0 + (lane & 15)) * D + ocol + (lane >> 4) * 4;
    uint2 w;
    w.x = pk2(st.o0[0] * sc, st.o0[1] * sc); w.y = pk2(st.o0[2] * sc, st.o0[3] * sc); *(uint2*)(o) = w;
    w.x = pk2(st.o1[0] * sc, st.o1[1] * sc); w.y = pk2(st.o1[2] * sc, st.o1[3] * sc); *(uint2*)(o + 16) = w;
    w.x = pk2(st.o2[0] * sc, st.o2[1] * sc); w.y = pk2(st.o2[2] * sc, st.o2[3] * sc); *(uint2*)(o + 32) = w;
    w.x = pk2(st.o3[0] * sc, st.o3[1] * sc); w.y = pk2(st.o3[2] * sc, st.o3[3] * sc); *(uint2*)(o + 48) = w;
}
DEV void attn_init(AttnState& st) { const f32x4 z = {0.f, 0.f, 0.f, 0.f}; st.o0 = z; st.o1 = z; st.o2 = z; st.o3 = z; st.m = -INFINITY; st.lsum = 0.f; }

constexpr int NTASK_NA = NB * 6 * 128 * 4, NTASK_GQ = NB * 6 * 512, NTASK_CTX = NB * 12 * 16;
DEV void attn_task(const Params& p, int l, int tk, const float* rpb2  ) {
    const int lane = tid_() & 63, g = lane >> 4, fr = lane & 15;
    const bf16_t* P = (const bf16_t*)(p.ws + OFF_P);
    AttnState st; attn_init(st);
    if (tk < NTASK_NA) {
        const int seg = tk & 3, r = (tk >> 2) & 127, hb = tk >> 9, h = hb % 6, b = hb / 6;
        const int R0 = b * S + r * 64 + seg * 16;
        const bf16_t* qp = P + (size_t)(R0 + fr) * PWS + COL_NAQ + h * 64 + g * 8;
        const bf16x8 q0 = ld16(qp), q1 = ld16(qp + 32);
        const int rs = min(max(r - 4, 0), 120), ustart = min(max(seg * 16 - 8, 0), 32);
        const int qc = seg * 16 + fr, cs = min(max(qc - 8, 0), 48);
        int ci[8]; bool ok[8];
#pragma unroll
        for (int e = 0; e < 8; ++e) { const int kc = ustart + (e >> 2) * 16 + g * 4 + (e & 3); ok[e] = (kc >= cs) && (kc < cs + 16); ci[e] = min(max(kc - qc + 15, 0), 30); }
        const bf16_t* kbase = P + (size_t)(b * S + rs * 64 + ustart + fr) * PWS + COL_NAK + h * 64 + g * 8;
        const bf16_t* vbase = (const bf16_t*)(p.ws + OFF_NAVT) + (size_t)((b * 6 + h) * 64 + fr) * S + rs * 64 + ustart + g * 4;
#pragma unroll
        for (int ri = 0; ri < 8; ++ri) {
            const float* rb = rpb2 + (h * 15 + (rs + ri - r + 7)) * 31;
            f32x4 b0, b1;
#pragma unroll
            for (int j = 0; j < 4; ++j) { b0[j] = ok[j] ? rb[ci[j]] : -INFINITY; b1[j] = ok[4 + j] ? rb[ci[4 + j]] : -INFINITY; }
            attn_pair(kbase + (size_t)(ri * 64) * PWS, kbase + (size_t)(ri * 64 + 16) * PWS, vbase + ri * 64, vbase + ri * 64 + 16, (size_t)16 * S, q0, q1, b0, b1, st);
        }
        attn_ctx_keys(p, b, COL_NAK + h * 64, (const bf16_t*)(p.ws + OFF_NAVTC) + (size_t)(b * 6 + h) * 64 * CTX, q0, q1, st, lane);
        attn_store(p, st, R0, 256 + h * 64, lane, -INFINITY);
    } else if (tk < NTASK_NA + NTASK_GQ) {
        const int t2 = tk - NTASK_NA, qt = t2 & 511, hb = t2 >> 9, h = hb % 6, b = hb / 6, kvh = h / 3;
        const int q0i = qt * 16, R0 = b * S + q0i;
        const bf16_t* qp = P + (size_t)(R0 + fr) * PWS + COL_GQ + h * 64 + g * 8;
        const bf16x8 q0 = ld16(qp), q1 = ld16(qp + 32);
        const bf16_t* kcolp = P + COL_GK + kvh * 64 + g * 8;
        const bf16_t* vrow = (const bf16_t*)(p.ws + OFF_GVT) + (size_t)((b * 2 + kvh) * 64 + fr) * S + g * 4;
        const int qi = q0i + fr;
#pragma unroll
        for (int pp = 0; pp < 9; ++pp) {
            const int kb = q0i - 128 + pp * 32;
            if (kb + 32 <= 0 || kb >= S) continue;
            const int t0 = min(max(kb, 0), S - 16), t1 = min(max(kb + 16, 0), S - 16);
            f32x4 b0, b1;
#pragma unroll
            for (int j = 0; j < 4; ++j) {
                const int k0 = kb + g * 4 + j, k1 = k0 + 16;
                b0[j] = (k0 >= 0 && k0 < S && k0 >= qi - 128 && k0 <= qi + 128) ? 0.f : -INFINITY;
                b1[j] = (k1 >= 0 && k1 < S && k1 >= qi - 128 && k1 <= qi + 128) ? 0.f : -INFINITY;
            }
            const bf16_t* k0p = kcolp + (size_t)(b * S + t0 + fr) * PWS; const bf16_t* k1p = kcolp + (size_t)(b * S + t1 + fr) * PWS;
            attn_pair(k0p, k1p, vrow + t0, vrow + t1, (size_t)16 * S, q0, q1, b0, b1, st);
        }
        attn_ctx_keys(p, b, COL_GK + kvh * 64, (const bf16_t*)(p.ws + OFF_GVTC) + (size_t)(b * 2 + kvh) * 64 * CTX, q0, q1, st, lane);
        attn_store(p, st, R0, 640 + h * 64, lane, p.gqa_sink[l * 6 + h] * LOG2E);
    } else {
        const int t3 = tk - NTASK_NA - NTASK_GQ, qt = t3 & 15, hb = t3 >> 4, hh = hb % 12, b = hb / 12;
        const bool na = hh < 6; const int h = na ? hh : hh - 6, kvh = h / 3;
        const int R0 = NLAT + b * CTX + qt * 16;
        const bf16_t* qp = P + (size_t)(R0 + fr) * PWS + (na ? COL_NAQ : COL_GQ) + h * 64 + g * 8;
        const bf16x8 q0 = ld16(qp), q1 = ld16(qp + 32);
        if (na) attn_ctx_keys(p, b, COL_NAK + h * 64, (const bf16_t*)(p.ws + OFF_NAVTC) + (size_t)(b * 6 + h) * 64 * CTX, q0, q1, st, lane);
        else attn_ctx_keys(p, b, COL_GK + kvh * 64, (const bf16_t*)(p.ws + OFF_GVTC) + (size_t)(b * 2 + kvh) * 64 * CTX, q0, q1, st, lane);
        attn_store(p, st, R0, (na ? 256 : 640) + h * 64, lane, na ? -INFINITY : p.gqa_sink[l * 6 + h] * LOG2E);
    }
}
DEV void ph_attn(const Params& p, int l, float* rpb2  ) {
    for (int i = tid_(); i < 6 * 15 * 31; i += 256) rpb2[i] = p.na_rpb[(size_t)l * 6 * 15 * 31 + i] * LOG2E;
    __syncthreads();
    const int w = tid_() >> 6;
    const int ntask = NTASK_NA + NTASK_GQ + (l == 0 ? NTASK_CTX : 0);
    for (int tk = bid_() * 4 + w; tk < ntask; tk += gridDim.x * 4) attn_task(p, l, tk, rpb2);
}

template <int CTRL> DEV float dppf(float old, float v) { return __builtin_bit_cast(float, __builtin_amdgcn_update_dpp(__builtin_bit_cast(int, old), __builtin_bit_cast(int, v), CTRL, 0xf, 0xf, false)); }
template <bool FWD> DEV void row_scan(float& a, float& b) {
#define RG_STEP(SHR, SHL) { const float ap = FWD ? dppf<SHR>(1.f, a) : dppf<SHL>(1.f, a); const float bp = FWD ? dppf<SHR>(0.f, b) : dppf<SHL>(0.f, b); b = fmaf(a, bp, b); a = a * ap; }
    RG_STEP(0x111, 0x101) RG_STEP(0x112, 0x102) RG_STEP(0x114, 0x104) RG_STEP(0x118, 0x108)
#undef RG_STEP
}
DEV int rg_bwd_chunk(int pos) { return pos == 0 ? 1 : (pos == 1 ? 0 : 67 - pos); }
DEV void rg_coef(const f32x4& za, const f32x4& zi, const f32x4& ba, const f32x4& bi, const f32x4& spc, const f32x4& xv, f32x4& a, f32x4& b) {
#pragma unroll
    for (int j = 0; j < 4; ++j) {
        const float r = 1.f / (1.f + __expf(-(za[j] + ba[j])));
        const float ig = 1.f / (1.f + __expf(-(zi[j] + bi[j])));
        const float la = spc[j] * r;
        const float av = __expf(la);
        const float x2 = 2.f * la;
        float om = x2 * (1.f / 720.f) + (1.f / 120.f); om = om * x2 + (1.f / 24.f); om = om * x2 + (1.f / 6.f); om = om * x2 + 0.5f; om = om * x2 + 1.f; om = -x2 * om;
        if (x2 < -0.25f) om = 1.f - av * av;
        a[j] = av; b[j] = sqrtf(om) * (ig * xv[j]);
    }
}
template <bool FINAL> DEV void rg_item(const Params& p, int l, int rt, bf16_t* lds) {
    const int t = tid_(), lane = t & 63, n = t >> 6, g = lane >> 4, fr = lane & 15;
    const bf16_t* P = (const bf16_t*)(p.ws + OFF_P);
    const bool isctx = rt >= 512;
    const int b = isctx ? (rt - 512) >> 1 : rt >> 6, idx = isctx ? (rt - 512) & 1 : 2 + (rt & 63);
    const int L = isctx ? CTX : S, t0 = isctx ? idx * 128 : (idx - 2) * 128, seqbase = isctx ? NLAT + b * CTX : b * S;
    bf16_t* xl = lds + n * (128 * 64);
    {
        const int c = lane & 7, ch0 = n * 64 + c * 8;
        f32x4 cwa[4], cwb[4];
#pragma unroll
        for (int j = 0; j < 4; ++j) { cwa[j] = *(const f32x4*)(p.conv_w + (l * 4 + j) * 256 + ch0); cwb[j] = *(const f32x4*)(p.conv_w + (l * 4 + j) * 256 + ch0 + 4); }
        const f32x4 cba = *(const f32x4*)(p.conv_b + l * 256 + ch0), cbb = *(const f32x4*)(p.conv_b + l * 256 + ch0 + 4);
#pragma unroll 2
        for (int it = 0; it < 16; ++it) {
            const int tok = it * 8 + (lane >> 3), ts = t0 + tok;
            f32x4 acca = cba, accb = cbb;
#pragma unroll
            for (int j = 0; j < 4; ++j) {
                const int tj = ts + j - 2;
                if (tj >= 0 && tj < L) {
                    const uint4 v = *(const uint4*)(P + (size_t)(seqbase + tj) * PWS + COL_RGX + ch0);
                    const f32x4 xa = {__uint_as_float(v.x << 16), __uint_as_float(v.x & 0xffff0000u), __uint_as_float(v.y << 16), __uint_as_float(v.y & 0xffff0000u)};
                    const f32x4 xb = {__uint_as_float(v.z << 16), __uint_as_float(v.z & 0xffff0000u), __uint_as_float(v.w << 16), __uint_as_float(v.w & 0xffff0000u)};
                    acca = acca + cwa[j] * xa; accb = accb + cwb[j] * xb;
                }
            }
            uint4 o; o.x = pk2(acca[0], acca[1]); o.y = pk2(acca[2], acca[3]); o.z = pk2(accb[0], accb[1]); o.w = pk2(accb[2], accb[3]);
            *(uint4*)(xl + tok * 64 + ((c ^ ((tok >> 1) & 7)) * 8)) = o;
        }
    }
    asm volatile("s_waitcnt lgkmcnt(0)" ::: "memory");
    const bf16_t* W = (const bf16_t*)(p.ws + OFF_WRG) + (size_t)(l * 2) * 2 * 4 * 64 * 64;
    const float* C = (const float*)(p.ws + OFF_RGC) + (size_t)(l * 2) * 3 * 256;
    float* AGG = (float*)(p.ws + OFF_AGG) + (size_t)(b * 66) * 1024;
    const int swz = (fr >> 1) & 7;
#pragma unroll 1
    for (int ct = 0; ct < 4; ++ct) {
        const int ch = n * 64 + ct * 16 + g * 4;
        f32x4 hf0, hf1, hf2, hf3, hf4, hf5, hf6, hf7;
        const f32x4 z4 = {0.f, 0.f, 0.f, 0.f};
        hf0 = z4; hf1 = z4; hf2 = z4; hf3 = z4; hf4 = z4; hf5 = z4; hf6 = z4; hf7 = z4;
#pragma unroll
        for (int dir = 0; dir < 2; ++dir) {
            const bf16x8 wa0 = ld16(W + ((size_t)((dir * 2 + 0) * 4 + n) * 64 + ct * 16 + fr) * 64 + g * 8), wa1 = ld16(W + ((size_t)((dir * 2 + 0) * 4 + n) * 64 + ct * 16 + fr) * 64 + 32 + g * 8);
            const bf16x8 wi0 = ld16(W + ((size_t)((dir * 2 + 1) * 4 + n) * 64 + ct * 16 + fr) * 64 + g * 8), wi1 = ld16(W + ((size_t)((dir * 2 + 1) * 4 + n) * 64 + ct * 16 + fr) * 64 + 32 + g * 8);
            const f32x4 ba = *(const f32x4*)(C + (dir * 3 + 0) * 256 + ch), bi = *(const f32x4*)(C + (dir * 3 + 1) * 256 + ch), spc = *(const f32x4*)(C + (dir * 3 + 2) * 256 + ch);
            f32x4 hin = z4, atot = {1.f, 1.f, 1.f, 1.f};
            if (FINAL) {
                const int npre = dir == 0 ? idx : (idx == 1 ? 0 : (idx == 0 ? 1 : 67 - idx));
#pragma unroll 4
                for (int q = 0; q < npre; ++q) {
                    const int cq = dir == 0 ? q : rg_bwd_chunk(q);
                    const f32x4 A = *(const f32x4*)(AGG + (size_t)(cq * 2 + dir) * 512 + ch), B = *(const f32x4*)(AGG + (size_t)(cq * 2 + dir) * 512 + 256 + ch);
                    hin = A * hin + B;
                }
            }
#pragma unroll
            for (int s = 0; s < 8; ++s) {
                const int tt = dir == 0 ? s : 7 - s;
                const int row = tt * 16 + fr;
                const bf16x8 x0 = *(const bf16x8*)(xl + row * 64 + ((g ^ swz) * 8)), x1 = *(const bf16x8*)(xl + row * 64 + (((g | 4) ^ swz) * 8));
                f32x4 za = __builtin_amdgcn_mfma_f32_16x16x32_bf16(wa0, x0, z4, 0, 0, 0); za = __builtin_amdgcn_mfma_f32_16x16x32_bf16(wa1, x1, za, 0, 0, 0);
                f32x4 zi = __builtin_amdgcn_mfma_f32_16x16x32_bf16(wi0, x0, z4, 0, 0, 0); zi = __builtin_amdgcn_mfma_f32_16x16x32_bf16(wi1, x1, zi, 0, 0, 0);
                const uint2 xr = *(const uint2*)(xl + row * 64 + (((ct * 2 + (g >> 1)) ^ swz) * 8) + (g & 1) * 4);
                const f32x4 xv = {__uint_as_float(xr.x << 16), __uint_as_float(xr.x & 0xffff0000u), __uint_as_float(xr.y << 16), __uint_as_float(xr.y & 0xffff0000u)};
                f32x4 a, bb;
                rg_coef(za, zi, ba, bi, spc, xv, a, bb);
                f32x4 h;
#pragma unroll
                for (int j = 0; j < 4; ++j) {
                    float aj = a[j], bj = bb[j];
                    if (dir == 0) row_scan<true>(aj, bj); else row_scan<false>(aj, bj);
                    h[j] = fmaf(aj, hin[j], bj);
                    atot[j] *= aj;
                }
                const int src = (lane & 48) | (dir == 0 ? 15 : 0);
#pragma unroll
                for (int j = 0; j < 4; ++j) hin[j] = shl_(h[j], src);
                if (FINAL) {
                    if (dir == 0) {
                        if (tt == 0) hf0 = h; else if (tt == 1) hf1 = h; else if (tt == 2) hf2 = h; else if (tt == 3) hf3 = h; else if (tt == 4) hf4 = h; else if (tt == 5) hf5 = h; else if (tt == 6) hf6 = h; else hf7 = h;
                    } else {
                        const f32x4 hfv = tt == 0 ? hf0 : tt == 1 ? hf1 : tt == 2 ? hf2 : tt == 3 ? hf3 : tt == 4 ? hf4 : tt == 5 ? hf5 : tt == 6 ? hf6 : hf7;
                        const size_t R = (size_t)seqbase + t0 + row;
                        const uint2 gr = *(const uint2*)(P + R * PWS + COL_GATE + ch);
                        const f32x4 hs = hfv + h;
                        uint2 o;
                        o.x = pk2(hs[0] * gelu_tanh(__uint_as_float(gr.x << 16)), hs[1] * gelu_tanh(__uint_as_float(gr.x & 0xffff0000u)));
                        o.y = pk2(hs[2] * gelu_tanh(__uint_as_float(gr.y << 16)), hs[3] * gelu_tanh(__uint_as_float(gr.y & 0xffff0000u)));
                        *(uint2*)((bf16_t*)(p.ws + OFF_X1) + R * D + ch) = o;
                    }
                }
            }
            if (!FINAL) {
                if (fr == (dir == 0 ? 15 : 0)) { *(f32x4*)(AGG + (size_t)(idx * 2 + dir) * 512 + ch) = atot; *(f32x4*)(AGG + (size_t)(idx * 2 + dir) * 512 + 256 + ch) = hin; }
            }
        }
    }
}
DEV void ph_rgagg(const Params& p, int l, bf16_t* lds) {
    for (int rt = bid_(); rt < 528; rt += gridDim.x) { rg_item<false>(p, l, rt, lds); __syncthreads(); }
}

DEV void outproj_item(const Params& p_, int l, int rt, bf16_t* lds, float* stat  ) {
    const Params& p = kp_();
    const int t = tid_(), lane = t & 63, w = t >> 6, wm = w >> 1, wn = w & 1, fq = lane >> 4, fr = lane & 15;
    const bf16_t* A = (const bf16_t*)(p.ws + OFF_X1) + (size_t)(rt * 128) * D;
    const bool isctx = rt >= 512;
    const float* g1 = modvec(p, l, rt * 128, 2);
    rg_item<true>(p, l, rt, lds);
    __threadfence();
    __syncthreads();
    __builtin_amdgcn_fence(__ATOMIC_ACQUIRE, "agent");
#pragma unroll 1
    for (int pass = 0; pass < 4; ++pass) {
        const bf16_t* Bt = (const bf16_t*)(p.ws + OFF_WOUTT) + ((size_t)l * 1024 + pass * 256) * 1024;
        const unsigned toff = (unsigned)(((tid_() >> 2) * 1024 + gemm_src_chunk(tid_())) * 2);
        f32x4 acc[4][8]; zero_acc(acc);
        gemm_mainloop(A, toff, toff + 64 * D * 2, Bt, toff, 1024, 32, lds, acc);
#pragma unroll
        for (int mt = 0; mt < 4; ++mt) {
            const int rl = wm * 64 + mt * 16 + fr, R = rt * 128 + rl;
            const float* xin = (l == 0) ? (isctx ? p.ctx + (size_t)(R - NLAT) * D : p.x + (size_t)R * D) : xres_row(p, R);
            float* xo = xres_row(p, R);
            float s = 0.f, q = 0.f;
#pragma unroll
            for (int nt = 0; nt < 8; ++nt) {
                const int col = pass * 256 + wn * 128 + nt * 16 + fq * 4;
                const f32x4 xv = *(const f32x4*)(xin + col), gv = *(const f32x4*)(g1 + col);
                const f32x4 u = xv * ALPHA + gv * acc[mt][nt];
                *(f32x4*)(xo + col) = u;
                s += (u[0] + u[1]) + (u[2] + u[3]); q += (u[0] * u[0] + u[1] * u[1]) + (u[2] * u[2] + u[3] * u[3]);
            }
            s += shx(s, 16); s += shx(s, 32); q += shx(q, 16); q += shx(q, 32);
            if (fq == 0) { float* sp = stat + (wn * 128 + rl) * 2; if (pass == 0) { sp[0] = s; sp[1] = q; } else { sp[0] += s; sp[1] += q; } }
        }
    }
    __threadfence();
    __syncthreads();
    __builtin_amdgcn_fence(__ATOMIC_ACQUIRE, "agent");
    {
        const float* lg = p.ln1_g + l * D; const float* lb = p.ln1_b + l * D;
        const float* sh2 = modvec(p, l, rt * 128, 3); const float* sc2 = modvec(p, l, rt * 128, 4);
        bf16_t* X2 = (bf16_t*)(p.ws + OFF_X2);
        const bf16_t* WRh = (const bf16_t*)(p.ws + OFF_WR) + (size_t)(l * 2) * 48 * 1024 + (size_t)fr * 1024 + fq * 8;
        const bf16_t* WRl = WRh + 48 * 1024;
        float mean[2], rstd[2];
#pragma unroll
        for (int tm = 0; tm < 2; ++tm) {
            const int rl = w * 32 + tm * 16 + fr;
            float s = 0.f, q = 0.f;
#pragma unroll
            for (int i = 0; i < 2; ++i) { s += stat[(i * 128 + rl) * 2]; q += stat[(i * 128 + rl) * 2 + 1]; }
            mean[tm] = s * (1.f / D);
            rstd[tm] = rsqrtf(fmaxf(q * (1.f / D) - mean[tm] * mean[tm], 0.f) + LN_EPS);
        }
        f32x4 lacc[3][2];
#pragma unroll
        for (int a = 0; a < 3; ++a) { lacc[a][0] = (f32x4){0.f, 0.f, 0.f, 0.f}; lacc[a][1] = (f32x4){0.f, 0.f, 0.f, 0.f}; }
#pragma unroll 2
        for (int ks = 0; ks < 32; ++ks) {
            const int k = ks * 32 + fq * 8;
            const f32x4 g0 = *(const f32x4*)(lg + k), g1v = *(const f32x4*)(lg + k + 4), b0 = *(const f32x4*)(lb + k), b1 = *(const f32x4*)(lb + k + 4);
            const f32x4 s0 = *(const f32x4*)(sh2 + k), s1 = *(const f32x4*)(sh2 + k + 4), c0 = *(const f32x4*)(sc2 + k), c1 = *(const f32x4*)(sc2 + k + 4);
            bf16x8 hh[2], hl[2];
#pragma unroll
            for (int tm = 0; tm < 2; ++tm) {
                const int R = rt * 128 + w * 32 + tm * 16 + fr;
                float* xr = xres_row(p, R) + k;
                const f32x4 u0 = *(const f32x4*)xr, u1 = *(const f32x4*)(xr + 4);
                const f32x4 x0 = (u0 - mean[tm]) * rstd[tm] * g0 + b0, x1 = (u1 - mean[tm]) * rstd[tm] * g1v + b1;
                *(f32x4*)xr = x0; *(f32x4*)(xr + 4) = x1;
                const f32x4 h0 = x0 * (c0 + 1.f) + s0, h1 = x1 * (c1 + 1.f) + s1;
#pragma unroll
                for (int e = 0; e < 4; ++e) {
                    const bf16_t a = f2bf(h0[e]), b = f2bf(h1[e]);
                    hh[tm][e] = (short)a; hh[tm][4 + e] = (short)b;
                    hl[tm][e] = (short)f2bf(h0[e] - bf2f(a)); hl[tm][4 + e] = (short)f2bf(h1[e] - bf2f(b));
                }
                *(bf16x8*)(X2 + (size_t)R * D + k) = hh[tm];
            }
#pragma unroll
            for (int ft = 0; ft < 3; ++ft) {
                const bf16x8 wh = *(const bf16x8*)(WRh + (size_t)ft * 16 * 1024 + ks * 32), wl = *(const bf16x8*)(WRl + (size_t)ft * 16 * 1024 + ks * 32);
#pragma unroll
                for (int tm = 0; tm < 2; ++tm) {
                    lacc[ft][tm] = __builtin_amdgcn_mfma_f32_16x16x32_bf16(wh, hh[tm], lacc[ft][tm], 0, 0, 0);
                    lacc[ft][tm] = __builtin_amdgcn_mfma_f32_16x16x32_bf16(wl, hh[tm], lacc[ft][tm], 0, 0, 0);
                    lacc[ft][tm] = __builtin_amdgcn_mfma_f32_16x16x32_bf16(wh, hl[tm], lacc[ft][tm], 0, 0, 0);
                }
            }
        }
        float* lt = (float*)lds;
#pragma unroll
        for (int ft = 0; ft < 3; ++ft)
#pragma unroll
            for (int tm = 0; tm < 2; ++tm)
#pragma unroll
                for (int j = 0; j < 4; ++j) lt[(w * 32 + tm * 16 + fr) * 48 + ft * 16 + fq * 4 + j] = lacc[ft][tm][j];
        asm volatile("s_waitcnt lgkmcnt(0)" ::: "memory");
        if (lane < 32) {
            const int rl = w * 32 + lane, R = rt * 128 + rl;
            const float* lr = lt + rl * 48;
            int gi = 0; float gm = lr[0] + p.router_g_b[l * 4];
            float gl[4]; gl[0] = gm;
#pragma unroll
            for (int j = 1; j < 4; ++j) { gl[j] = lr[j] + p.router_g_b[l * 4 + j]; if (gl[j] > gm) { gm = gl[j]; gi = j; } }
            float gs = 0.f;
#pragma unroll
            for (int j = 0; j < 4; ++j) gs += expf(gl[j] - gm);
            const float ptop = 1.f / gs;
            int e0 = 0, e1 = 0; float m0 = -INFINITY, m1 = -INFINITY;
            for (int j = 0; j < 8; ++j) {
                const float v = lr[4 + gi * 8 + j] + p.router_e_b[l * 32 + gi * 8 + j];
                if (v > m0) { m1 = m0; e1 = e0; m0 = v; e0 = j; } else if (v > m1) { m1 = v; e1 = j; }
            }
            const float ex = expf(m1 - m0);
            const float w0 = ptop / (1.f + ex), w1 = ptop * ex / (1.f + ex);
            int* rte = (int*)(p.ws + OFF_RTE); float* rtw = (float*)(p.ws + OFF_RTW);
            unsigned* cnt = (unsigned*)(p.ws + OFF_CTL) + CW_CNT + l * 32;
            int* list = (int*)(p.ws + OFF_LIST);
            const int E0 = gi * 8 + e0, E1 = gi * 8 + e1;
            rte[R * 2] = E0; rte[R * 2 + 1] = E1; rtw[R * 2] = w0; rtw[R * 2 + 1] = w1;
            const unsigned p0 = atomicAdd(cnt + E0, 1u); list[(size_t)E0 * LISTCAP + p0] = R * 2;
            const unsigned p1 = atomicAdd(cnt + E1, 1u); list[(size_t)E1 * LISTCAP + p1] = R * 2 + 1;
        }
    }
}
DEV void ph_outproj(const Params& p, int l, bf16_t* lds, float* stat  ) {
    const int ntiles = (l == 0) ? 528 : 512;
    for (int rt = bid_(); rt < ntiles; rt += gridDim.x) { outproj_item(p, l, rt, lds, stat); __syncthreads(); }
}

DEV void moe_item(const Params& p_, int l, int e, int j, int item, int cnt, bf16_t* lds) {
    const Params& p = kp_();
    const int t = tid_(), lane = t & 63, w = t >> 6, wm = w >> 1, wn = w & 1, fq = lane >> 4, fr = lane & 15;
    const int* list = (const int*)(p.ws + OFF_LIST) + (size_t)e * LISTCAP;
    const bf16_t* X2 = (const bf16_t*)(p.ws + OFF_X2);
    bf16_t* Hs = (bf16_t*)(p.ws + OFF_P) + (size_t)item * 128 * FF;
    unsigned ao0, ao1;
    { const int s0 = j * 128 + (t >> 2), s1 = s0 + 64;
      const int tok0 = s0 < cnt ? (list[s0] >> 1) : 0, tok1 = s1 < cnt ? (list[s1] >> 1) : 0;
      ao0 = (unsigned)((tok0 * D + gemm_src_chunk(t)) * 2); ao1 = (unsigned)((tok1 * D + gemm_src_chunk(t)) * 2); }
#pragma unroll 1
    for (int pass = 0; pass < 4; ++pass) {
        const bf16_t* Bt = (const bf16_t*)(p.ws + OFF_WGU) + ((size_t)e * 1024 + pass * 256) * 1024;
        f32x4 acc[4][8]; zero_acc(acc);
        gemm_mainloop(X2, ao0, ao1, Bt, (unsigned)(((tid_() >> 2) * 1024 + gemm_src_chunk(tid_())) * 2), 1024, 32, lds, acc);
#pragma unroll
        for (int mt = 0; mt < 4; ++mt) {
            const int rl = wm * 64 + mt * 16 + fr;
#pragma unroll
            for (int nt = 0; nt < 4; ++nt) {
                const f32x4 gv = acc[mt][nt], uv = acc[mt][nt + 4];
                float hv[4];
#pragma unroll
                for (int jj = 0; jj < 4; ++jj) hv[jj] = gv[jj] / (1.f + __expf(-gv[jj])) * uv[jj];
                uint2 o; o.x = pk2(hv[0], hv[1]); o.y = pk2(hv[2], hv[3]);
                *(uint2*)(Hs + (size_t)rl * FF + pass * 128 + wn * 64 + nt * 16 + fq * 4) = o;
            }
        }
    }
    __threadfence();
    __syncthreads();
    __builtin_amdgcn_fence(__ATOMIC_ACQUIRE, "agent");
    const unsigned hoff = (unsigned)(((t >> 2) * FF + gemm_src_chunk(t)) * 2);
    const float* rtw = (const float*)(p.ws + OFF_RTW);
    bf16_t* Y = (bf16_t*)(p.ws + OFF_Y);
#pragma unroll 1
    for (int pass = 0; pass < 4; ++pass) {
        const bf16_t* Bt = (const bf16_t*)(p.ws + OFF_WD) + ((size_t)e * 1024 + pass * 256) * FF;
        f32x4 acc[4][8]; zero_acc(acc);
        gemm_mainloop(Hs, hoff, hoff + 64 * FF * 2, Bt, hoff, FF, 16, lds, acc);
#pragma unroll
        for (int mt = 0; mt < 4; ++mt) {
            const int s = j * 128 + wm * 64 + mt * 16 + fr;
            if (s < cnt) {
                const int ent = list[s];
                const float gw = rtw[ent];
                bf16_t* yo = Y + (size_t)ent * D + pass * 256 + wn * 128 + fq * 4;
#pragma unroll
                for (int nt = 0; nt < 8; ++nt) { const f32x4 v = acc[mt][nt] * gw; uint2 o; o.x = pk2(v[0], v[1]); o.y = pk2(v[2], v[3]); *(uint2*)(yo + nt * 16) = o; }
            }
        }
    }
}
DEV void ph_moe(const Params& p, int l, bf16_t* lds, int* s_pref  , int* s_cnt  ) {
    const unsigned* cnt = (const unsigned*)(p.ws + OFF_CTL) + CW_CNT + l * 32;
    if (tid_() == 0) { int a = 0; for (int e = 0; e < 32; ++e) { const int c = (int)cnt[e]; s_cnt[e] = c; s_pref[e] = a; a += (c + 127) >> 7; } s_pref[32] = a; }
    __syncthreads();
    const int nitems = s_pref[32];
    for (int it = bid_(); it < nitems; it += gridDim.x) {
        int e = 0;
        while (e < 31 && it >= s_pref[e + 1]) ++e;
        moe_item(p, l, e, it - s_pref[e], it, s_cnt[e], lds);
        __syncthreads();
    }
}

namespace cg = cooperative_groups;
#define REP(id) for (int rep_ = 0; rep_ < ((PROBE_ID) == (id) ? PROBE_N : 1); ++rep_)
constexpr int SMEM_STAT = GEMM_LDS_BYTES;
constexpr int SMEM_BYTES = GEMM_LDS_BYTES + 2048 + 512;
constexpr int NPHASE = 12;
__global__ void __launch_bounds__(256, 2) mega(Params p, int ph_lo, int ph_hi) {
    extern __shared__ __attribute__((aligned(16))) unsigned char smem[];
    bf16_t* lds = (bf16_t*)smem;
    float* stat = (float*)(smem + SMEM_STAT);
    int* s_pref = (int*)(smem + SMEM_STAT + 2048); int* s_cnt = s_pref + 40;
#define IN(k) (ph_lo <= (k) && (k) < ph_hi)
#define SEAM(k) do { if (IN(k) && IN((k) + 1)) cg::this_grid().sync(); } while (0)
    if (IN(0)) {
        REP(0) { ph_mod(kp_(), (float*)smem); __syncthreads(); }
        ph_rope(kp_());
        ph_routerw(kp_());
        ph_rgprep(kp_());
        REP(1) ph_transpose(kp_().w_in, (bf16_t*)(kp_().ws + OFF_WINT), 1024, 2304, 0, 2, (size_t)1024 * 2304, (size_t)2304 * 1024, (float*)smem);
        ph_transpose(kp_().w_out, (bf16_t*)(kp_().ws + OFF_WOUTT), 1024, 1024, 0, 2, (size_t)1024 * 1024, (size_t)1024 * 1024, (float*)smem);
    }
    SEAM(0);
#define LAYER_BODY(l, pb) { \
        if (IN(pb + 0)) { if (l == 0) { REP(2) ph_rowop<0>(kp_(), 0, NTOK); } else ph_rowop<1>(kp_(), 1, NTOK); } \
        SEAM(pb + 0); \
        if (IN(pb + 1)) { ph_inproj(kp_(), l, lds); } \
        SEAM(pb + 1); \
        if (IN(pb + 2)) { \
            REP(4) ph_rgagg(kp_(), l, lds); \
            REP(5) { ph_attn(kp_(), l, (float*)smem); __syncthreads(); } \
            REP(6) { \
            ph_transpose(kp_().exp_w_gate + (size_t)l * NE * 1024 * 512, (bf16_t*)(kp_().ws + OFF_WGU), 1024, 512, 1, NE, (size_t)1024 * 512, (size_t)1024 * 1024, (float*)smem); \
            ph_transpose(kp_().exp_w_up + (size_t)l * NE * 1024 * 512, (bf16_t*)(kp_().ws + OFF_WGU), 1024, 512, 2, NE, (size_t)1024 * 512, (size_t)1024 * 1024, (float*)smem); \
            ph_transpose(kp_().exp_w_down + (size_t)l * NE * 512 * 1024, (bf16_t*)(kp_().ws + OFF_WD), 512, 1024, 0, NE, (size_t)512 * 1024, (size_t)1024 * 512, (float*)smem); \
            } \
        } \
        SEAM(pb + 2); \
        if (IN(pb + 3)) ph_outproj(kp_(), l, lds, stat); \
        SEAM(pb + 3); \
        if (IN(pb + 4)) { REP(7) { ph_moe(kp_(), l, lds, s_pref, s_cnt); __syncthreads(); } } \
        SEAM(pb + 4); \
    }
    LAYER_BODY(0, 1)
    LAYER_BODY(1, 6)
#undef LAYER_BODY
    if (IN(NPHASE - 1)) ph_rowop<2>(kp_(), 2, NLAT);
#undef IN
#undef SEAM
}

#ifndef ONE_LAUNCH
#define ONE_LAUNCH 1
#endif
extern "C" void kernel_launch(void* const* d_in, const int* in_sizes, int n_in, void* d_out, int out_size, void* d_ws, size_t ws_size, hipStream_t stream) {
    if (n_in != 28 || ws_size < WS_TOTAL || out_size != NLAT * D) { fprintf(stderr, "kernel_launch: unexpected shapes / workspace (%d inputs, ws %zu need %zu)\n", n_in, ws_size, (size_t)WS_TOTAL); return; }
    static int grid = 0;
    if (grid == 0) {
        int dev = 0, cus = 0, per_cu = 0;
        (void)hipGetDevice(&dev);
        (void)hipDeviceGetAttribute(&cus, hipDeviceAttributeMultiprocessorCount, dev);
        (void)hipFuncSetAttribute((const void*)mega, hipFuncAttributeMaxDynamicSharedMemorySize, SMEM_BYTES);
        (void)hipOccupancyMaxActiveBlocksPerMultiprocessor(&per_cu, (const void*)mega, 256, SMEM_BYTES);
        if (per_cu > 2) per_cu = 2;
        grid = cus * per_cu;
        if (grid <= 0) { fprintf(stderr, "kernel_launch: occupancy query gave %d blocks per CU on %d CUs\n", per_cu, cus); grid = -1; }
    }
    if (grid < 0) return;
    Params p{};
    const float** pp = (const float**)&p;
    for (int i = 0; i < 28; ++i) pp[i] = (const float*)d_in[i];
    p.out = (float*)d_out; p.ws = (unsigned char*)d_ws;
    (void)hipMemsetAsync((unsigned char*)d_ws + OFF_CTL, 0, CTL_BYTES, stream);
#if ONE_LAUNCH
    int lo = 0, hi = NPHASE;
    void* args[] = {(void*)&p, (void*)&lo, (void*)&hi};
    hipError_t e = hipLaunchCooperativeKernel((const void*)mega, dim3(grid), dim3(256), args, SMEM_BYTES, stream);
    if (e != hipSuccess) fprintf(stderr, "kernel_launch: cooperative launch failed: %s (grid %d)\n", hipGetErrorString(e), grid);
#else
    for (int ph = 0; ph < NPHASE; ++ph) mega<<<grid, 256, SMEM_BYTES, stream>>>(p, ph, ph + 1);
#endif
}
```

```cpp
#include <hip/hip_runtime.h>
#include <hip/hip_cooperative_groups.h>
#include <stdint.h>
#include <cstdio>

typedef unsigned short bf16_t;
typedef short bf16x8 __attribute__((ext_vector_type(8)));
typedef float f32x4 __attribute__((ext_vector_type(4)));

#define DEV __device__ __forceinline__
#define PROBE_ID -1
#define PROBE_N 4

constexpr int D = 1024, NB = 8, S = 8192, CTX = 256;
constexpr int NLAT = NB * S, NCTX = NB * CTX, NTOK = NLAT + NCTX;
constexpr int PWS = 1280;
constexpr int COL_RGX = 0, COL_GATE = 256, COL_NAQ = 512, COL_GQ = 896;
constexpr int KVT = 1024;
constexpr int NE = 32, FF = 512;
constexpr int LISTCAP = NTOK;
constexpr float ALPHA = 1.4142135623730951f;
constexpr float LN_EPS = 1e-5f;

constexpr size_t al256(size_t x) { return (x + 255) & ~(size_t)255; }
constexpr size_t OFF_CTL   = 0;
constexpr size_t CTL_BYTES = 4096 + 16384;
constexpr size_t OFF_MOD   = OFF_CTL + CTL_BYTES;
constexpr size_t OFF_ROPE  = al256(OFF_MOD + (size_t)2 * 9 * 6144 * 4);
constexpr size_t OFF_RTE   = al256(OFF_ROPE + (size_t)2 * 128 * 16 * 4);
constexpr size_t OFF_RTW   = al256(OFF_RTE + (size_t)NTOK * 8);
constexpr size_t OFF_LIST  = al256(OFF_RTW + (size_t)NTOK * 8);
constexpr size_t OFF_WR    = al256(OFF_LIST + (size_t)NE * LISTCAP * 4);
constexpr size_t OFF_WRG   = al256(OFF_WR + (size_t)2 * 2 * 48 * 1024 * 2);
constexpr size_t OFF_RGC   = al256(OFF_WRG + (size_t)2 * 2 * 2 * 4 * 64 * 64 * 2);
constexpr size_t OFF_AGG   = al256(OFF_RGC + (size_t)2 * 2 * 3 * 256 * 4);
constexpr size_t OFF_WINT  = al256(OFF_AGG + (size_t)NB * 66 * 2 * 2 * 256 * 4);
constexpr size_t OFF_WOUTT = al256(OFF_WINT + (size_t)2 * 2304 * 1024 * 2);
constexpr size_t OFF_WGU   = al256(OFF_WOUTT + (size_t)2 * 1024 * 1024 * 2);
constexpr size_t OFF_WD    = al256(OFF_WGU + (size_t)NE * 1024 * 1024 * 2);
constexpr size_t OFF_XCTX  = al256(OFF_WD + (size_t)NE * 1024 * 512 * 2);
constexpr size_t OFF_X1    = al256(OFF_XCTX + (size_t)NCTX * D * 4);
constexpr size_t OFF_X2    = al256(OFF_X1 + (size_t)NTOK * D * 2);
constexpr size_t OFF_P     = al256(OFF_X2 + (size_t)NTOK * D * 2);
constexpr size_t OFF_NAKF  = al256(OFF_P + (size_t)NTOK * PWS * 2);
constexpr size_t OFF_NAVF  = al256(OFF_NAKF + (size_t)NB * 6 * 512 * KVT * 2);
constexpr size_t OFF_GKF   = al256(OFF_NAVF + (size_t)NB * 6 * 512 * KVT * 2);
constexpr size_t OFF_GVF   = al256(OFF_GKF + (size_t)NB * 2 * 512 * KVT * 2);
constexpr size_t OFF_NAKFC = al256(OFF_GVF + (size_t)NB * 2 * 512 * KVT * 2);
constexpr size_t OFF_NAVFC = al256(OFF_NAKFC + (size_t)NB * 6 * 16 * KVT * 2);
constexpr size_t OFF_GKFC  = al256(OFF_NAVFC + (size_t)NB * 6 * 16 * KVT * 2);
constexpr size_t OFF_GVFC  = al256(OFF_GKFC + (size_t)NB * 2 * 16 * KVT * 2);
constexpr size_t OFF_Y     = al256(OFF_GVFC + (size_t)NB * 2 * 16 * KVT * 2);
constexpr size_t WS_TOTAL  = al256(OFF_Y + (size_t)2 * NTOK * D * 2);
constexpr int CW_CNT = 0;

struct Params {
    const float *x, *c, *ctx, *c_ctx, *w_ada, *b_ada, *w_in, *conv_w, *conv_b, *rg_a_w, *rg_a_b, *rg_i_w, *rg_i_b, *rg_lambda,
        *na_rpb, *gqa_sink, *w_out, *ln1_g, *ln1_b, *router_g_w, *router_g_b, *router_e_w, *router_e_b, *exp_w_gate, *exp_w_up,
        *exp_w_down, *ln2_g, *ln2_b;
    float* out;
    unsigned char* ws;
};

DEV const Params& kp_() { const void* q = (const void*)__builtin_amdgcn_kernarg_segment_ptr(); asm volatile("" : "+s"(q)); return *(const Params*)q; }
DEV int tid_() { int t = threadIdx.x; asm volatile("" : "+v"(t)); return t; }
DEV int bid_() { int b = blockIdx.x; asm volatile("" : "+s"(b)); return b; }
DEV float shx(float v, int m) { return __builtin_bit_cast(float, __builtin_amdgcn_ds_bpermute(((tid_() & 63) ^ m) << 2, __builtin_bit_cast(int, v))); }
DEV float shl_(float v, int src) { return __builtin_bit_cast(float, __builtin_amdgcn_ds_bpermute(src << 2, __builtin_bit_cast(int, v))); }
DEV float bf2f(bf16_t h) { return __uint_as_float((unsigned)h << 16); }
DEV bf16_t f2bf(float f) { unsigned u = __float_as_uint(f); u += 0x7fffu + ((u >> 16) & 1u); return (bf16_t)(u >> 16); }
DEV unsigned pk2(float lo, float hi) { return (unsigned)f2bf(lo) | ((unsigned)f2bf(hi) << 16); }
DEV float wave_sum(float v) {
#pragma unroll
    for (int o = 1; o < 64; o <<= 1) v += shx(v, o);
    return v;
}
DEV float wave_max(float v) {
#pragma unroll
    for (int o = 1; o < 64; o <<= 1) v = fmaxf(v, shx(v, o));
    return v;
}
DEV float sigmoidf_(float x) { return 1.f / (1.f + __expf(-x)); }
DEV float gelu_tanh(float x) {
    const float u = 0.7978845608028654f * (x + 0.044715f * x * x * x);
    const float t = 1.f - 2.f / (1.f + __expf(2.f * u));
    return 0.5f * x * (1.f + t);
}
DEV float* xres_row(const Params& p, int R) {
    return R < NLAT ? p.out + (size_t)R * D : (float*)(p.ws + OFF_XCTX) + (size_t)(R - NLAT) * D;
}
DEV const float* modvec(const Params& p, int l, int R, int seg) {
    const int b = R < NLAT ? R / S : 8;
    return (const float*)(p.ws + OFF_MOD) + ((size_t)(l * 9 + b) * 6 + seg) * 1024;
}

DEV void ph_mod(const Params& p, float* sc  ) {
    if (bid_() >= 48) return;
    for (int i = tid_(); i < 9 * 1024; i += 256) { const float v = (i < 8192) ? p.c[i] : p.c_ctx[i - 8192]; sc[i] = v / (1.f + expf(-v)); }
    __syncthreads();
    const int col = bid_() * 256 + tid_();
    const int l = col / 6144, j = col % 6144;
    const float* w = p.w_ada + (size_t)l * 1024 * 6144 + j;
    float a0 = 0, a1 = 0, a2 = 0, a3 = 0, a4 = 0, a5 = 0, a6 = 0, a7 = 0, a8 = 0;
    for (int k = 0; k < 1024; ++k) {
        const float wv = w[(size_t)k * 6144];
        a0 += sc[k] * wv; a1 += sc[1024 + k] * wv; a2 += sc[2048 + k] * wv; a3 += sc[3072 + k] * wv; a4 += sc[4096 + k] * wv;
        a5 += sc[5120 + k] * wv; a6 += sc[6144 + k] * wv; a7 += sc[7168 + k] * wv; a8 += sc[8192 + k] * wv;
    }
    const float bias = p.b_ada[l * 6144 + j];
    float* mod = (float*)(p.ws + OFF_MOD) + (size_t)l * 9 * 6144 + j;
    mod[0 * 6144] = a0 + bias; mod[1 * 6144] = a1 + bias; mod[2 * 6144] = a2 + bias; mod[3 * 6144] = a3 + bias; mod[4 * 6144] = a4 + bias;
    mod[5 * 6144] = a5 + bias; mod[6 * 6144] = a6 + bias; mod[7 * 6144] = a7 + bias; mod[8 * 6144] = a8 + bias;
}

DEV void sincos_red(float ang, float& sn, float& cs) {
    const float n = rintf(ang * 0.15915494309189535f);
    float r = fmaf(-n, 6.2831854820251465f, ang);
    r = fmaf(-n, -1.7484555e-07f, r);
    float sgn = 1.f;
    if (r > 1.5707963267948966f) { r = 3.14159265358979f - r; sgn = -1.f; }
    else if (r < -1.5707963267948966f) { r = -3.14159265358979f - r; sgn = -1.f; }
    const float r2 = r * r;
    float sp = -1.6059044e-10f; sp = fmaf(sp, r2, 2.5052108e-08f); sp = fmaf(sp, r2, -2.7557319e-06f); sp = fmaf(sp, r2, 1.9841270e-04f);
    sp = fmaf(sp, r2, -8.3333333e-03f); sp = fmaf(sp, r2, 1.6666667e-01f); sp = fmaf(sp * -1.f, r2, 1.f);
    sn = r * sp;
    float cp = -1.1470746e-11f; cp = fmaf(cp, r2, 2.0876757e-09f); cp = fmaf(cp, r2, -2.7557319e-07f); cp = fmaf(cp, r2, 2.4801587e-05f);
    cp = fmaf(cp, r2, -1.3888889e-03f); cp = fmaf(cp, r2, 4.1666667e-02f); cp = fmaf(cp, r2, -0.5f); cp = fmaf(cp, r2, 1.f);
    cs = sgn * cp;
}
DEV void ph_rope(const Params& p) {
    const int i = (bid_() - 48) * 256 + tid_();
    if (i < 0 || i >= 128 * 16) return;
    const int pos = i >> 4, q = i & 15;
    const float inv = exp2f(-(float)q * (13.287712379549449f / 16.f));
    float sn, cs; sincos_red((float)pos * inv, sn, cs);
    float* tab = (float*)(p.ws + OFF_ROPE);
    tab[i] = cs; tab[2048 + i] = sn;
}

DEV void ph_routerw(const Params& p) {
  for (int i = bid_() * 256 + tid_(); i < 2 * 48 * 1024; i += gridDim.x * 256) {
    const int l = i / (48 * 1024), f = (i / 1024) % 48, k = i & 1023;
    float w = 0.f;
    if (f < 4) w = p.router_g_w[((size_t)l * 1024 + k) * 4 + f]; else if (f < 36) w = p.router_e_w[((size_t)l * 1024 + k) * 32 + (f - 4)];
    const bf16_t hi = f2bf(w), lo = f2bf(w - bf2f(hi));
    bf16_t* WR = (bf16_t*)(p.ws + OFF_WR);
    WR[((size_t)(l * 2 + 0) * 48 + f) * 1024 + k] = hi;
    WR[((size_t)(l * 2 + 1) * 48 + f) * 1024 + k] = lo;
  }
}

DEV void ph_rgprep(const Params& p) {
    bf16_t* W = (bf16_t*)(p.ws + OFF_WRG);
    for (int i = bid_() * 256 + tid_(); i < 2 * 2 * 2 * 4 * 64 * 64; i += gridDim.x * 256) {
        const int d = i & 63, e = (i >> 6) & 63, n = (i >> 12) & 3, gate = (i >> 14) & 1, ld = i >> 15;
        const float* srcw = gate ? p.rg_i_w : p.rg_a_w;
        W[i] = f2bf(srcw[((size_t)(ld * 4 + n) * 64 + d) * 64 + e]);
    }
    float* C = (float*)(p.ws + OFF_RGC);
    for (int i = bid_() * 256 + tid_(); i < 2 * 2 * 256; i += gridDim.x * 256) {
        const int c = i & 255, ld = i >> 8;
        C[(ld * 3 + 0) * 256 + c] = p.rg_a_b[ld * 256 + c];
        C[(ld * 3 + 1) * 256 + c] = p.rg_i_b[ld * 256 + c];
        C[(ld * 3 + 2) * 256 + c] = -8.f * log1pf(expf(-p.rg_lambda[ld * 256 + c]));
    }
}

DEV int tr_row(int n, int mode) { return mode == 0 ? n : ((n >> 7) * 256 + ((n >> 6) & 1) * 128 + (n & 63) + (mode == 2 ? 64 : 0)); }
DEV void transpose_tile(const float* src, bf16_t* dst, int K, int N, int mode, int tile, float* lds) {
    const int ntn = N >> 6, kt = tile / ntn, nt = tile % ntn, k0 = kt * 64, n0 = nt * 64, t = tid_();
#pragma unroll
    for (int i = 0; i < 4; ++i) {
        const int r = (t >> 4) + 16 * i, c4 = (t & 15) * 4;
        const float4 v = *(const float4*)(src + (size_t)(k0 + r) * N + n0 + c4);
        lds[r * 65 + c4] = v.x; lds[r * 65 + c4 + 1] = v.y; lds[r * 65 + c4 + 2] = v.z; lds[r * 65 + c4 + 3] = v.w;
    }
    __syncthreads();
#pragma unroll
    for (int i = 0; i < 2; ++i) {
        const int n = (t >> 3) + 32 * i, kc = (t & 7) * 8;
        uint4 o;
        o.x = pk2(lds[(kc + 0) * 65 + n], lds[(kc + 1) * 65 + n]); o.y = pk2(lds[(kc + 2) * 65 + n], lds[(kc + 3) * 65 + n]);
        o.z = pk2(lds[(kc + 4) * 65 + n], lds[(kc + 5) * 65 + n]); o.w = pk2(lds[(kc + 6) * 65 + n], lds[(kc + 7) * 65 + n]);
        *(uint4*)(dst + (size_t)tr_row(n0 + n, mode) * K + k0 + kc) = o;
    }
    __syncthreads();
}
DEV void ph_transpose(const float* src, bf16_t* dst, int K, int N, int mode, int nmat, size_t sstride, size_t dstride, float* lds  ) {
    const int per = (K >> 6) * (N >> 6);
    for (int it = bid_(); it < nmat * per; it += gridDim.x) {
        const int m = it / per, tile = it % per;
        transpose_tile(src + (size_t)m * sstride, dst + (size_t)m * dstride, K, N, mode, tile, lds);
    }
}

template <int MODE> DEV void rowop(const Params& p, int l, int R) {
    const int lane = tid_() & 63;
    float4 v[4];
    if (MODE == 0) {
        const float* src = R < NLAT ? p.x + (size_t)R * D : p.ctx + (size_t)(R - NLAT) * D;
#pragma unroll
        for (int i = 0; i < 4; ++i) v[i] = *(const float4*)(src + i * 256 + lane * 4);
    } else {
        float* xr = xres_row(p, R);
        const float* g2 = modvec(p, l - 1, R, 5);
        const bf16_t* y0 = (const bf16_t*)(p.ws + OFF_Y) + (size_t)(2 * R) * D;
        const bf16_t* y1 = y0 + D;
        const float* lg = p.ln2_g + (l - 1) * D; const float* lb = p.ln2_b + (l - 1) * D;
        float s = 0.f;
#pragma unroll
        for (int i = 0; i < 4; ++i) {
            const int k = i * 256 + lane * 4;
            const float4 xv = *(const float4*)(xr + k); const float4 gv = *(const float4*)(g2 + k);
            const uint2 a = *(const uint2*)(y0 + k); const uint2 b = *(const uint2*)(y1 + k);
            float4 u;
            u.x = ALPHA * xv.x + gv.x * (bf2f((bf16_t)(a.x & 0xffff)) + bf2f((bf16_t)(b.x & 0xffff)));
            u.y = ALPHA * xv.y + gv.y * (bf2f((bf16_t)(a.x >> 16)) + bf2f((bf16_t)(b.x >> 16)));
            u.z = ALPHA * xv.z + gv.z * (bf2f((bf16_t)(a.y & 0xffff)) + bf2f((bf16_t)(b.y & 0xffff)));
            u.w = ALPHA * xv.w + gv.w * (bf2f((bf16_t)(a.y >> 16)) + bf2f((bf16_t)(b.y >> 16)));
            v[i] = u; s += (u.x + u.y) + (u.z + u.w);
        }
        const float mean = wave_sum(s) * (1.f / D);
        float q = 0.f;
#pragma unroll
        for (int i = 0; i < 4; ++i) { v[i].x -= mean; v[i].y -= mean; v[i].z -= mean; v[i].w -= mean; q += (v[i].x * v[i].x + v[i].y * v[i].y) + (v[i].z * v[i].z + v[i].w * v[i].w); }
        const float rstd = rsqrtf(wave_sum(q) * (1.f / D) + LN_EPS);
#pragma unroll
        for (int i = 0; i < 4; ++i) {
            const int k = i * 256 + lane * 4;
            const float4 gg = *(const float4*)(lg + k); const float4 bb = *(const float4*)(lb + k);
            v[i].x = v[i].x * rstd * gg.x + bb.x; v[i].y = v[i].y * rstd * gg.y + bb.y; v[i].z = v[i].z * rstd * gg.z + bb.z; v[i].w = v[i].w * rstd * gg.w + bb.w;
            *(float4*)(xr + k) = v[i];
        }
    }
    if (MODE != 2) {
        const float* sh = modvec(p, l, R, 0); const float* sc = modvec(p, l, R, 1);
        bf16_t* ha = (bf16_t*)(p.ws + OFF_X1) + (size_t)R * D;
#pragma unroll
        for (int i = 0; i < 4; ++i) {
            const int k = i * 256 + lane * 4;
            const float4 s4 = *(const float4*)(sh + k); const float4 c4 = *(const float4*)(sc + k);
            uint2 o; o.x = pk2(v[i].x * (1.f + c4.x) + s4.x, v[i].y * (1.f + c4.y) + s4.y); o.y = pk2(v[i].z * (1.f + c4.z) + s4.z, v[i].w * (1.f + c4.w) + s4.w);
            *(uint2*)(ha + k) = o;
        }
    }
}
template <int MODE> DEV void ph_rowop(const Params& p, int l, int nrows) {
    const int w = tid_() >> 6;
    for (int R = bid_() * 4 + w; R < nrows; R += gridDim.x * 4) rowop<MODE>(p, l, R);
}

constexpr int GEMM_STAGE_BYTES = 384 * 64;
constexpr int GEMM_NSTAGE = 3;
constexpr int GEMM_LDS_BYTES = GEMM_NSTAGE * GEMM_STAGE_BYTES;
#define LAS __attribute__((address_space(3)))
DEV int gemm_src_chunk(int t) { return ((t & 3) ^ ((0 - (t >> 4)) & 3)) * 8; }
DEV void gemm_mainloop(const bf16_t* Abase, unsigned ao0, unsigned ao1, const bf16_t* Bbase, unsigned bo, unsigned ldb, int nk, bf16_t* lds, f32x4 (&acc)[4][8]) {
    const int t = tid_(), lane = t & 63, w = __builtin_amdgcn_readfirstlane(t >> 6), wm = w >> 1, wn = w & 1;
    LAS unsigned char* L = (LAS unsigned char*)lds;
    const int pc = ((lane >> 4) ^ ((0 - ((lane & 15) >> 2)) & 3)) * 16;
    const int arow = (wm * 64 + (lane & 15)) * 64 + pc, brow = (128 + wn * 128 + (lane & 15)) * 64 + pc;
    const char* Ab = (const char*)Abase; const char* B0 = (const char*)Bbase; const char* B1 = B0 + (size_t)ldb * 128; const char* B2 = B0 + (size_t)ldb * 256; const char* B3 = B0 + (size_t)ldb * 384;
#define GEMM_ISSUE(slot, ko) do { LAS unsigned* d_ = (LAS unsigned*)(L + (slot) * GEMM_STAGE_BYTES + w * 1024); \
        __builtin_amdgcn_global_load_lds((const unsigned*)(Ab + (ao0 + (ko) * 2u)), d_, 16, 0, 0); \
        __builtin_amdgcn_global_load_lds((const unsigned*)(Ab + (ao1 + (ko) * 2u)), d_ + 1024, 16, 0, 0); \
        __builtin_amdgcn_global_load_lds((const unsigned*)(B0 + (bo + (ko) * 2u)), d_ + 2048, 16, 0, 0); \
        __builtin_amdgcn_global_load_lds((const unsigned*)(B1 + (bo + (ko) * 2u)), d_ + 3072, 16, 0, 0); \
        __builtin_amdgcn_global_load_lds((const unsigned*)(B2 + (bo + (ko) * 2u)), d_ + 4096, 16, 0, 0); \
        __builtin_amdgcn_global_load_lds((const unsigned*)(B3 + (bo + (ko) * 2u)), d_ + 5120, 16, 0, 0); } while (0)
    asm volatile("s_waitcnt vmcnt(0)" ::: "memory");
    __builtin_amdgcn_s_barrier();
    asm volatile("" ::: "memory");
    GEMM_ISSUE(0, 0);
    if (nk > 1) GEMM_ISSUE(1, 32);
    int cs = 0, is = 2;
    for (int kt = 0; kt < nk; ++kt) {
        if (kt + 1 < nk) asm volatile("s_waitcnt vmcnt(6)" ::: "memory"); else asm volatile("s_waitcnt vmcnt(0)" ::: "memory");
        __builtin_amdgcn_s_barrier();
        asm volatile("" ::: "memory");
        if (kt + 2 < nk) GEMM_ISSUE(is, (kt + 2) * 32);
        const LAS unsigned char* cur = L + cs * GEMM_STAGE_BYTES;
        const bf16x8 af0 = *(const LAS bf16x8*)(cur + arow), af1 = *(const LAS bf16x8*)(cur + arow + 16 * 64), af2 = *(const LAS bf16x8*)(cur + arow + 32 * 64), af3 = *(const LAS bf16x8*)(cur + arow + 48 * 64);
        bf16x8 bq0 = *(const LAS bf16x8*)(cur + brow), bq1 = *(const LAS bf16x8*)(cur + brow + 16 * 64);
#pragma unroll
        for (int nt = 0; nt < 8; ++nt) {
            const bf16x8 bfr = bq0; bq0 = bq1;
            if (nt + 2 < 8) bq1 = *(const LAS bf16x8*)(cur + brow + (nt + 2) * 16 * 64);
            acc[0][nt] = __builtin_amdgcn_mfma_f32_16x16x32_bf16(bfr, af0, acc[0][nt], 0, 0, 0);
            acc[1][nt] = __builtin_amdgcn_mfma_f32_16x16x32_bf16(bfr, af1, acc[1][nt], 0, 0, 0);
            acc[2][nt] = __builtin_amdgcn_mfma_f32_16x16x32_bf16(bfr, af2, acc[2][nt], 0, 0, 0);
            acc[3][nt] = __builtin_amdgcn_mfma_f32_16x16x32_bf16(bfr, af3, acc[3][nt], 0, 0, 0);
        }
        cs = cs == 2 ? 0 : cs + 1; is = is == 2 ? 0 : is + 1;
    }
#undef GEMM_ISSUE
}
DEV void zero_acc(f32x4 (&acc)[4][8]) {
#pragma unroll
    for (int a = 0; a < 4; ++a)
#pragma unroll
        for (int b = 0; b < 8; ++b) acc[a][b] = (f32x4){0.f, 0.f, 0.f, 0.f};
}

DEV void inproj_item(const Params& p_, int l, int rt, int pass, bf16_t* lds) {
    const Params& p = kp_();
    const int t = tid_(), lane = t & 63, w = t >> 6, wm = w >> 1, wn = w & 1;
    const bf16_t* A = (const bf16_t*)(p.ws + OFF_X1) + (size_t)(rt * 128) * D;
    const bf16_t* Bt = (const bf16_t*)(p.ws + OFF_WINT) + ((size_t)l * 2304 + pass * 256) * 1024;
    const unsigned toff = (unsigned)(((t >> 2) * 1024 + gemm_src_chunk(t)) * 2);
    f32x4 acc[4][8]; zero_acc(acc);
    gemm_mainloop(A, toff, toff + 64 * D * 2, Bt, toff, 1024, 32, lds, acc);
    bf16_t* P = (bf16_t*)(p.ws + OFF_P);
    const float* ctab = (const float*)(p.ws + OFF_ROPE); const float* stab = ctab + 2048;
    const bool isctx = rt >= 512;
    const int fq = lane >> 4, fr = lane & 15;
#pragma unroll
    for (int hci = 0; hci < 2; ++hci) {
        const int hc = pass * 4 + wn * 2 + hci;
        int type, dcol = 0, vh = 0;
        if (hc < 4) { type = 0; dcol = COL_RGX + hc * 64; }
        else if (hc < 10) { type = 4; vh = hc - 4; }
        else if (hc < 16) { type = 5; vh = hc - 10; }
        else if (hc < 18) { type = 6; vh = hc - 16; }
        else if (hc < 20) { type = 7; vh = hc - 18; }
        else if (hc < 24) { type = 0; dcol = COL_GATE + (hc - 20) * 64; }
        else if (hc < 30) { type = 1; dcol = COL_NAQ + (hc - 24) * 64; }
        else { type = 3; dcol = COL_GQ + (hc - 30) * 64; }
#pragma unroll
        for (int mt = 0; mt < 4; ++mt) {
            const int R = rt * 128 + wm * 64 + mt * 16 + fr;
            f32x4 v0 = acc[mt][hci * 4 + 0], v1 = acc[mt][hci * 4 + 1], v2 = acc[mt][hci * 4 + 2], v3 = acc[mt][hci * 4 + 3];
            if ((type == 3 || type == 6) && !isctx) {
                const int tt = R & (S - 1), pr = tt >> 6, pc = tt & 63;
                const f32x4 cr = *(const f32x4*)(ctab + pr * 16 + fq * 4), sr = *(const f32x4*)(stab + pr * 16 + fq * 4);
                const f32x4 cc = *(const f32x4*)(ctab + pc * 16 + fq * 4), sc = *(const f32x4*)(stab + pc * 16 + fq * 4);
                const f32x4 o0 = v0 * cr - v1 * sr, o1 = v1 * cr + v0 * sr, o2 = v2 * cc - v3 * sc, o3 = v3 * cc + v2 * sc;
                v0 = o0; v1 = o1; v2 = o2; v3 = o3;
            }
            if (type == 1 || type == 3) { v0 = v0 * 0.125f; v1 = v1 * 0.125f; v2 = v2 * 0.125f; v3 = v3 * 0.125f; }
            if (type < 4) {
                bf16_t* o = P + (size_t)R * PWS + dcol + fq * 4;
                uint2 q;
                q.x = pk2(v0[0], v0[1]); q.y = pk2(v0[2], v0[3]); *(uint2*)(o) = q;
                q.x = pk2(v1[0], v1[1]); q.y = pk2(v1[2], v1[3]); *(uint2*)(o + 16) = q;
                q.x = pk2(v2[0], v2[1]); q.y = pk2(v2[2], v2[3]); *(uint2*)(o + 32) = q;
                q.x = pk2(v3[0], v3[1]); q.y = pk2(v3[2], v3[3]); *(uint2*)(o + 48) = q;
            } else {
                const bool na = type < 6, isk = (type == 4 || type == 6);
                bf16_t* tb;
                if (!isctx) { const int b = R >> 13, tile = (R & (S - 1)) >> 4;
                    tb = (bf16_t*)(p.ws + (na ? (isk ? OFF_NAKF : OFF_NAVF) : (isk ? OFF_GKF : OFF_GVF))) + ((size_t)(b * (na ? 6 : 2) + vh) * 512 + tile) * KVT; }
                else { const int cR = R - NLAT, b = cR >> 8, tile = (cR & 255) >> 4;
                    tb = (bf16_t*)(p.ws + (na ? (isk ? OFF_NAKFC : OFF_NAVFC) : (isk ? OFF_GKFC : OFF_GVFC))) + ((size_t)(b * (na ? 6 : 2) + vh) * 16 + tile) * KVT; }
                if (isk) {
                    bf16_t* o = tb + ((fq >> 1) * 16 + fr) * 8 + (fq & 1) * 4;
                    uint2 q;
                    q.x = pk2(v0[0], v0[1]); q.y = pk2(v0[2], v0[3]); *(uint2*)(o) = q;
                    q.x = pk2(v1[0], v1[1]); q.y = pk2(v1[2], v1[3]); *(uint2*)(o + 2 * 16 * 8) = q;
                    q.x = pk2(v2[0], v2[1]); q.y = pk2(v2[2], v2[3]); *(uint2*)(o + 512) = q;
                    q.x = pk2(v3[0], v3[1]); q.y = pk2(v3[2], v3[3]); *(uint2*)(o + 512 + 2 * 16 * 8) = q;
                } else {
                    bf16_t* o = tb + ((fr >> 2) * 16 + fq * 4) * 8 + (fr & 3);
#pragma unroll
                    for (int j = 0; j < 4; ++j) {
                        o[j * 8] = f2bf(v0[j]); o[j * 8 + 4] = f2bf(v1[j]); o[512 + j * 8] = f2bf(v2[j]); o[512 + j * 8 + 4] = f2bf(v3[j]);
                    }
                }
            }
        }
    }
}
DEV void ph_inproj(const Params& p, int l, bf16_t* lds) {
    const int nctxp = (l == 0) ? 9 : 5;
    const int nx = gridDim.x >> 3, xcd = bid_() & 7, j = bid_() >> 3;
    const int nloc = 64 * 9 + 2 * nctxp;
    if (bid_() >= nx * 8) return;
    for (int i0 = j; i0 < nloc * ((PROBE_ID) == 3 ? PROBE_N : 1); i0 += nx) {
        const int i = i0 % nloc;
        int rt, pass;
        if (i < 64 * 9) { rt = xcd * 64 + i / 9; pass = i % 9; } else { const int r = i - 64 * 9; rt = 512 + 2 * xcd + r / nctxp; pass = r % nctxp; }
        inproj_item(p, l, rt, pass, lds);
    }
}

constexpr float LOG2E = 1.4426950408889634f;
struct AttnState { f32x4 o0, o1, o2, o3; float m, lsum; };
struct KVFrag { bf16x8 k00, k01, k10, k11, v0, v1, v2, v3; };
DEV bf16x8 ld16(const bf16_t* p) { return *(const bf16x8*)p; }
DEV bf16x8 lohi(const uint4& a, const uint4& b, int hi) { union { uint4 u; bf16x8 v; } c; c.u = hi ? make_uint4(a.z, a.w, b.z, b.w) : make_uint4(a.x, a.y, b.x, b.y); return c.v; }
DEV void kv_load(const bf16_t* kt0, const bf16_t* kt1, const bf16_t* vt0, const bf16_t* vt1, KVFrag& f) {
    f.k00 = ld16(kt0); f.k01 = ld16(kt0 + 512); f.k10 = ld16(kt1); f.k11 = ld16(kt1 + 512);
    const uint4 a0 = *(const uint4*)vt0, a1 = *(const uint4*)(vt0 + 512), b0 = *(const uint4*)vt1, b1 = *(const uint4*)(vt1 + 512);
    f.v0 = lohi(a0, b0, 0); f.v1 = lohi(a0, b0, 1); f.v2 = lohi(a1, b1, 0); f.v3 = lohi(a1, b1, 1);
}
DEV void attn_apply(const KVFrag& f, const bf16x8& q0, const bf16x8& q1, f32x4 b0, f32x4 b1, AttnState& st) {
    const f32x4 z = {0.f, 0.f, 0.f, 0.f};
    f32x4 s0 = __builtin_amdgcn_mfma_f32_16x16x32_bf16(f.k00, q0, z, 0, 0, 0); s0 = __builtin_amdgcn_mfma_f32_16x16x32_bf16(f.k01, q1, s0, 0, 0, 0);
    f32x4 s1 = __builtin_amdgcn_mfma_f32_16x16x32_bf16(f.k10, q0, z, 0, 0, 0); s1 = __builtin_amdgcn_mfma_f32_16x16x32_bf16(f.k11, q1, s1, 0, 0, 0);
    s0 = s0 * LOG2E + b0; s1 = s1 * LOG2E + b1;
    float mx = fmaxf(fmaxf(fmaxf(s0[0], s0[1]), fmaxf(s0[2], s0[3])), fmaxf(fmaxf(s1[0], s1[1]), fmaxf(s1[2], s1[3])));
    mx = fmaxf(mx, shx(mx, 16)); mx = fmaxf(mx, shx(mx, 32));
    const float mn = fmaxf(st.m, mx);
    const float ms = (mn == -INFINITY) ? 0.f : mn;
    const float alpha = __builtin_amdgcn_exp2f(st.m - ms);
    f32x4 p0, p1;
#pragma unroll
    for (int j = 0; j < 4; ++j) { p0[j] = __builtin_amdgcn_exp2f(s0[j] - ms); p1[j] = __builtin_amdgcn_exp2f(s1[j] - ms); }
    st.lsum = st.lsum * alpha + ((p0[0] + p0[1]) + (p0[2] + p0[3])) + ((p1[0] + p1[1]) + (p1[2] + p1[3]));
    st.o0 = st.o0 * alpha; st.o1 = st.o1 * alpha; st.o2 = st.o2 * alpha; st.o3 = st.o3 * alpha;
    union { uint4 u; bf16x8 v; } pt; pt.u = make_uint4(pk2(p0[0], p0[1]), pk2(p0[2], p0[3]), pk2(p1[0], p1[1]), pk2(p1[2], p1[3]));
    st.o0 = __builtin_amdgcn_mfma_f32_16x16x32_bf16(f.v0, pt.v, st.o0, 0, 0, 0);
    st.o1 = __builtin_amdgcn_mfma_f32_16x16x32_bf16(f.v1, pt.v, st.o1, 0, 0, 0);
    st.o2 = __builtin_amdgcn_mfma_f32_16x16x32_bf16(f.v2, pt.v, st.o2, 0, 0, 0);
    st.o3 = __builtin_amdgcn_mfma_f32_16x16x32_bf16(f.v3, pt.v, st.o3, 0, 0, 0);
    st.m = mn;
}
DEV void attn_init(AttnState& st) { const f32x4 z = {0.f, 0.f, 0.f, 0.f}; st.o0 = z; st.o1 = z; st.o2 = z; st.o3 = z; st.m = -INFINITY; st.lsum = 0.f; }
DEV void attn_store(AttnState& st, bf16_t* orow, float sink2  ) {
    float l = st.lsum; l += shx(l, 16); l += shx(l, 32);
    float sc;
    if (sink2 != -INFINITY) { const float mf = fmaxf(st.m, sink2); const float al = __builtin_amdgcn_exp2f(st.m - mf); l = l * al + __builtin_amdgcn_exp2f(sink2 - mf); sc = al / l; }
    else sc = 1.f / l;
    uint2 w;
    w.x = pk2(st.o0[0] * sc, st.o0[1] * sc); w.y = pk2(st.o0[2] * sc, st.o0[3] * sc); *(uint2*)(orow) = w;
    w.x = pk2(st.o1[0] * sc, st.o1[1] * sc); w.y = pk2(st.o1[2] * sc, st.o1[3] * sc); *(uint2*)(orow + 16) = w;
    w.x = pk2(st.o2[0] * sc, st.o2[1] * sc); w.y = pk2(st.o2[2] * sc, st.o2[3] * sc); *(uint2*)(orow + 32) = w;
    w.x = pk2(st.o3[0] * sc, st.o3[1] * sc); w.y = pk2(st.o3[2] * sc, st.o3[3] * sc); *(uint2*)(orow + 48) = w;
}

constexpr int NTASK_NA = NB * 6 * 128 * 4, NTASK_GQ = NB * 2 * 512, NTASK_CNA = NB * 6 * 16, NTASK_CGQ = NB * 2 * 16;
DEV void attn_task(const Params& p, int l, int tk, const float* rpb2  ) {
    const int lane = tid_() & 63, g = lane >> 4, fr = lane & 15;
    const bf16_t* P = (const bf16_t*)(p.ws + OFF_P);
    bf16_t* X1 = (bf16_t*)(p.ws + OFF_X1);
    const f32x4 z4 = {0.f, 0.f, 0.f, 0.f};
    KVFrag f;
    if (tk < NTASK_NA) {
        const int qtile = tk & 3, r = (tk >> 2) & 127, hb = tk >> 9, h = hb % 6, b = hb / 6;
        const int qc = qtile == 0 ? (fr < 8 ? fr : 48 + fr) : 8 + (qtile - 1) * 16 + fr;
        const int ct0 = qtile == 0 ? 0 : qtile - 1, ct1 = qtile == 0 ? 3 : qtile;
        const int R = b * S + r * 64 + qc;
        const bf16_t* qp = P + (size_t)R * PWS + COL_NAQ + h * 64 + g * 8;
        const bf16x8 q0 = ld16(qp), q1 = ld16(qp + 32);
        const int rs = min(max(r - 4, 0), 120), cs = min(max(qc - 8, 0), 48);
        int ci[8]; bool ok[8];
#pragma unroll
        for (int e = 0; e < 8; ++e) { const int kc = ((e >> 2) ? ct1 : ct0) * 16 + g * 4 + (e & 3); ok[e] = (kc >= cs) && (kc < cs + 16); ci[e] = min(max(kc - qc + 15, 0), 30); }
        const bf16_t* kf = (const bf16_t*)(p.ws + OFF_NAKF) + ((size_t)(b * 6 + h) * 512 + rs * 4) * KVT + lane * 8;
        const bf16_t* vf = (const bf16_t*)(p.ws + OFF_NAVF) + ((size_t)(b * 6 + h) * 512 + rs * 4) * KVT + lane * 8;
        AttnState st; attn_init(st);
#pragma unroll
        for (int ri = 0; ri < 8; ++ri) {
            const float* rb = rpb2 + (h * 15 + (rs + ri - r + 7)) * 31;
            f32x4 b0, b1;
#pragma unroll
            for (int j = 0; j < 4; ++j) { b0[j] = ok[j] ? rb[ci[j]] : -INFINITY; b1[j] = ok[4 + j] ? rb[ci[4 + j]] : -INFINITY; }
            kv_load(kf + (size_t)(ri * 4 + ct0) * KVT, kf + (size_t)(ri * 4 + ct1) * KVT, vf + (size_t)(ri * 4 + ct0) * KVT, vf + (size_t)(ri * 4 + ct1) * KVT, f);
            attn_apply(f, q0, q1, b0, b1, st);
        }
        const bf16_t* kc_ = (const bf16_t*)(p.ws + OFF_NAKFC) + (size_t)(b * 6 + h) * 16 * KVT + lane * 8;
        const bf16_t* vc_ = (const bf16_t*)(p.ws + OFF_NAVFC) + (size_t)(b * 6 + h) * 16 * KVT + lane * 8;
#pragma unroll
        for (int pp = 0; pp < 8; ++pp) { kv_load(kc_ + (size_t)(2 * pp) * KVT, kc_ + (size_t)(2 * pp + 1) * KVT, vc_ + (size_t)(2 * pp) * KVT, vc_ + (size_t)(2 * pp + 1) * KVT, f); attn_apply(f, q0, q1, z4, z4, st); }
        attn_store(st, X1 + (size_t)R * D + 256 + h * 64 + g * 4, -INFINITY);
    } else if (tk < NTASK_NA + NTASK_GQ + NTASK_CNA + NTASK_CGQ && (tk < NTASK_NA + NTASK_GQ || tk >= NTASK_NA + NTASK_GQ + NTASK_CNA)) {
        const bool lat = tk < NTASK_NA + NTASK_GQ;
        const int t2 = lat ? tk - NTASK_NA : tk - (NTASK_NA + NTASK_GQ + NTASK_CNA);
        const int qt = lat ? (t2 & 511) : (t2 & 15), hb = lat ? (t2 >> 9) : (t2 >> 4), kvh = hb & 1, b = hb >> 1;
        const int q0i = qt * 16, R = (lat ? b * S : NLAT + b * CTX) + q0i + fr;
        const bf16_t* qp = P + (size_t)R * PWS + COL_GQ + kvh * 192 + g * 8;
        const bf16x8 qa0 = ld16(qp), qa1 = ld16(qp + 32), qb0 = ld16(qp + 64), qb1 = ld16(qp + 96), qc0 = ld16(qp + 128), qc1 = ld16(qp + 160);
        AttnState sa, sb, sc; attn_init(sa); attn_init(sb); attn_init(sc);
        const bf16_t* kf = (const bf16_t*)(p.ws + OFF_GKF) + (size_t)(b * 2 + kvh) * 512 * KVT + lane * 8;
        const bf16_t* vf = (const bf16_t*)(p.ws + OFF_GVF) + (size_t)(b * 2 + kvh) * 512 * KVT + lane * 8;
        const bf16_t* kc_ = (const bf16_t*)(p.ws + OFF_GKFC) + (size_t)(b * 2 + kvh) * 16 * KVT + lane * 8;
        const bf16_t* vc_ = (const bf16_t*)(p.ws + OFF_GVFC) + (size_t)(b * 2 + kvh) * 16 * KVT + lane * 8;
        const int qi = q0i + fr;
#define GQ_LOAD(i, F) do { const int i_ = (i); if (i_ < 9) { const int kt_ = (q0i - 128 + i_ * 32) >> 4; const int ta_ = min(max(kt_, 0), 511), tb_ = min(max(kt_ + 1, 0), 511); \
            kv_load(kf + (size_t)ta_ * KVT, kf + (size_t)tb_ * KVT, vf + (size_t)ta_ * KVT, vf + (size_t)tb_ * KVT, F); } \
        else { const int c_ = (i_ - 9) * 2; kv_load(kc_ + (size_t)c_ * KVT, kc_ + (size_t)(c_ + 1) * KVT, vc_ + (size_t)c_ * KVT, vc_ + (size_t)(c_ + 1) * KVT, F); } } while (0)
#define GQ_APPLY(i, F) do { const int i_ = (i); f32x4 b0_ = z4, b1_ = z4; if (i_ < 9) { const int kb_ = q0i - 128 + i_ * 32; _Pragma("unroll") for (int j = 0; j < 4; ++j) { const int k0_ = kb_ + g * 4 + j, k1_ = k0_ + 16; \
                b0_[j] = (k0_ >= 0 && k0_ < S && k0_ >= qi - 128 && k0_ <= qi + 128) ? 0.f : -INFINITY; b1_[j] = (k1_ >= 0 && k1_ < S && k1_ >= qi - 128 && k1_ <= qi + 128) ? 0.f : -INFINITY; } } \
            attn_apply(F, qa0, qa1, b0_, b1_, sa); attn_apply(F, qb0, qb1, b0_, b1_, sb); attn_apply(F, qc0, qc1, b0_, b1_, sc); } while (0)
        KVFrag f2;
        const int i0 = lat ? 0 : 9;
        GQ_LOAD(i0, f);
#pragma unroll 1
        for (int i = i0; i < 17; i += 2) {
            if (i + 1 < 17) GQ_LOAD(i + 1, f2);
            GQ_APPLY(i, f);
            if (i + 1 < 17) { if (i + 2 < 17) GQ_LOAD(i + 2, f); GQ_APPLY(i + 1, f2); }
        }
#undef GQ_LOAD
#undef GQ_APPLY
        bf16_t* o = X1 + (size_t)R * D + 640 + kvh * 192 + g * 4;
        attn_store(sa, o, p.gqa_sink[l * 6 + kvh * 3 + 0] * LOG2E); attn_store(sb, o + 64, p.gqa_sink[l * 6 + kvh * 3 + 1] * LOG2E); attn_store(sc, o + 128, p.gqa_sink[l * 6 + kvh * 3 + 2] * LOG2E);
    } else {
        const int t3 = tk - NTASK_NA - NTASK_GQ, qt = t3 & 15, hb = t3 >> 4, h = hb % 6, b = hb / 6;
        const int R = NLAT + b * CTX + qt * 16 + fr;
        const bf16_t* qp = P + (size_t)R * PWS + COL_NAQ + h * 64 + g * 8;
        const bf16x8 q0 = ld16(qp), q1 = ld16(qp + 32);
        AttnState st; attn_init(st);
        const bf16_t* kc_ = (const bf16_t*)(p.ws + OFF_NAKFC) + (size_t)(b * 6 + h) * 16 * KVT + lane * 8;
        const bf16_t* vc_ = (const bf16_t*)(p.ws + OFF_NAVFC) + (size_t)(b * 6 + h) * 16 * KVT + lane * 8;
#pragma unroll
        for (int pp = 0; pp < 8; ++pp) { kv_load(kc_ + (size_t)(2 * pp) * KVT, kc_ + (size_t)(2 * pp + 1) * KVT, vc_ + (size_t)(2 * pp) * KVT, vc_ + (size_t)(2 * pp + 1) * KVT, f); attn_apply(f, q0, q1, z4, z4, st); }
        attn_store(st, X1 + (size_t)R * D + 256 + h * 64 + g * 4, -INFINITY);
    }
}
DEV void ph_attn(const Params& p, int l, float* rpb2  ) {
    for (int i = tid_(); i < 6 * 15 * 31; i += 256) rpb2[i] = p.na_rpb[(size_t)l * 6 * 15 * 31 + i] * LOG2E;
    __syncthreads();
    const int w = tid_() >> 6;
    const int ntask = NTASK_NA + NTASK_GQ + (l == 0 ? NTASK_CNA + NTASK_CGQ : 0);
    for (int tk0 = bid_() * 4 + w; tk0 < ntask; tk0 += gridDim.x * 4) {
        const int tk = tk0 < NTASK_GQ ? NTASK_NA + tk0 : (tk0 < NTASK_GQ + NTASK_NA ? tk0 - NTASK_GQ : tk0);
        attn_task(p, l, tk, rpb2);
    }
}

template <int CTRL> DEV float dppf(float old, float v) { return __builtin_bit_cast(float, __builtin_amdgcn_update_dpp(__builtin_bit_cast(int, old), __builtin_bit_cast(int, v), CTRL, 0xf, 0xf, false)); }
template <bool FWD> DEV void row_scan(float& a, float& b) {
#define RG_STEP(SHR, SHL) { const float ap = FWD ? dppf<SHR>(1.f, a) : dppf<SHL>(1.f, a); const float bp = FWD ? dppf<SHR>(0.f, b) : dppf<SHL>(0.f, b); b = fmaf(a, bp, b); a = a * ap; }
    RG_STEP(0x111, 0x101) RG_STEP(0x112, 0x102) RG_STEP(0x114, 0x104) RG_STEP(0x118, 0x108)
#undef RG_STEP
}
DEV int rg_bwd_chunk(int pos) { return pos == 0 ? 1 : (pos == 1 ? 0 : 67 - pos); }
DEV void rg_coef(const f32x4& za, const f32x4& zi, const f32x4& ba, const f32x4& bi, const f32x4& spc, const f32x4& xv, f32x4& a, f32x4& b) {
#pragma unroll
    for (int j = 0; j < 4; ++j) {
        const float r = 1.f / (1.f + __expf(-(za[j] + ba[j])));
        const float ig = 1.f / (1.f + __expf(-(zi[j] + bi[j])));
        const float la = spc[j] * r;
        const float av = __expf(la);
        const float x2 = 2.f * la;
        float om = x2 * (1.f / 720.f) + (1.f / 120.f); om = om * x2 + (1.f / 24.f); om = om * x2 + (1.f / 6.f); om = om * x2 + 0.5f; om = om * x2 + 1.f; om = -x2 * om;
        if (x2 < -0.25f) om = 1.f - av * av;
        a[j] = av; b[j] = sqrtf(om) * (ig * xv[j]);
    }
}
template <bool FINAL> DEV void rg_item(const Params& p, int l, int rt, bf16_t* lds) {
    const int t = tid_(), lane = t & 63, n = t >> 6, g = lane >> 4, fr = lane & 15;
    const bf16_t* P = (const bf16_t*)(p.ws + OFF_P);
    const bool isctx = rt >= 512;
    const int b = isctx ? (rt - 512) >> 1 : rt >> 6, idx = isctx ? (rt - 512) & 1 : 2 + (rt & 63);
    const int L = isctx ? CTX : S, t0 = isctx ? idx * 128 : (idx - 2) * 128, seqbase = isctx ? NLAT + b * CTX : b * S;
    bf16_t* xl = lds + n * (128 * 64);
    {
        const int c = lane & 7, ch0 = n * 64 + c * 8;
        f32x4 cwa[4], cwb[4];
#pragma unroll
        for (int j = 0; j < 4; ++j) { cwa[j] = *(const f32x4*)(p.conv_w + (l * 4 + j) * 256 + ch0); cwb[j] = *(const f32x4*)(p.conv_w + (l * 4 + j) * 256 + ch0 + 4); }
        const f32x4 cba = *(const f32x4*)(p.conv_b + l * 256 + ch0), cbb = *(const f32x4*)(p.conv_b + l * 256 + ch0 + 4);
#pragma unroll 2
        for (int it = 0; it < 16; ++it) {
            const int tok = it * 8 + (lane >> 3), ts = t0 + tok;
            f32x4 acca = cba, accb = cbb;
#pragma unroll
            for (int j = 0; j < 4; ++j) {
                const int tj = ts + j - 2;
                if (tj >= 0 && tj < L) {
                    const uint4 v = *(const uint4*)(P + (size_t)(seqbase + tj) * PWS + COL_RGX + ch0);
                    const f32x4 xa = {__uint_as_float(v.x << 16), __uint_as_float(v.x & 0xffff0000u), __uint_as_float(v.y << 16), __uint_as_float(v.y & 0xffff0000u)};
                    const f32x4 xb = {__uint_as_float(v.z << 16), __uint_as_float(v.z & 0xffff0000u), __uint_as_float(v.w << 16), __uint_as_float(v.w & 0xffff0000u)};
                    acca = acca + cwa[j] * xa; accb = accb + cwb[j] * xb;
                }
            }
            uint4 o; o.x = pk2(acca[0], acca[1]); o.y = pk2(acca[2], acca[3]); o.z = pk2(accb[0], accb[1]); o.w = pk2(accb[2], accb[3]);
            *(uint4*)(xl + tok * 64 + ((c ^ ((tok >> 1) & 7)) * 8)) = o;
        }
    }
    asm volatile("s_waitcnt lgkmcnt(0)" ::: "memory");
    const bf16_t* W = (const bf16_t*)(p.ws + OFF_WRG) + (size_t)(l * 2) * 2 * 4 * 64 * 64;
    const float* C = (const float*)(p.ws + OFF_RGC) + (size_t)(l * 2) * 3 * 256;
    float* AGG = (float*)(p.ws + OFF_AGG) + (size_t)(b * 66) * 1024;
    const int swz = (fr >> 1) & 7;
#pragma unroll 1
    for (int ct = 0; ct < 4; ++ct) {
        const int ch = n * 64 + ct * 16 + g * 4;
        f32x4 hf0, hf1, hf2, hf3, hf4, hf5, hf6, hf7;
        const f32x4 z4 = {0.f, 0.f, 0.f, 0.f};
        hf0 = z4; hf1 = z4; hf2 = z4; hf3 = z4; hf4 = z4; hf5 = z4; hf6 = z4; hf7 = z4;
#pragma unroll
        for (int dir = 0; dir < 2; ++dir) {
            const bf16x8 wa0 = ld16(W + ((size_t)((dir * 2 + 0) * 4 + n) * 64 + ct * 16 + fr) * 64 + g * 8), wa1 = ld16(W + ((size_t)((dir * 2 + 0) * 4 + n) * 64 + ct * 16 + fr) * 64 + 32 + g * 8);
            const bf16x8 wi0 = ld16(W + ((size_t)((dir * 2 + 1) * 4 + n) * 64 + ct * 16 + fr) * 64 + g * 8), wi1 = ld16(W + ((size_t)((dir * 2 + 1) * 4 + n) * 64 + ct * 16 + fr) * 64 + 32 + g * 8);
            const f32x4 ba = *(const f32x4*)(C + (dir * 3 + 0) * 256 + ch), bi = *(const f32x4*)(C + (dir * 3 + 1) * 256 + ch), spc = *(const f32x4*)(C + (dir * 3 + 2) * 256 + ch);
            f32x4 hin = z4, atot = {1.f, 1.f, 1.f, 1.f};
            if (FINAL) {
                const int npre = dir == 0 ? idx : (idx == 1 ? 0 : (idx == 0 ? 1 : 67 - idx));
#pragma unroll 4
                for (int q = 0; q < npre; ++q) {
                    const int cq = dir == 0 ? q : rg_bwd_chunk(q);
                    const f32x4 A = *(const f32x4*)(AGG + (size_t)(cq * 2 + dir) * 512 + ch), B = *(const f32x4*)(AGG + (size_t)(cq * 2 + dir) * 512 + 256 + ch);
                    hin = A * hin + B;
                }
            }
#pragma unroll
            for (int s = 0; s < 8; ++s) {
                const int tt = dir == 0 ? s : 7 - s;
                const int row = tt * 16 + fr;
                const bf16x8 x0 = *(const bf16x8*)(xl + row * 64 + ((g ^ swz) * 8)), x1 = *(const bf16x8*)(xl + row * 64 + (((g | 4) ^ swz) * 8));
                f32x4 za = __builtin_amdgcn_mfma_f32_16x16x32_bf16(wa0, x0, z4, 0, 0, 0); za = __builtin_amdgcn_mfma_f32_16x16x32_bf16(wa1, x1, za, 0, 0, 0);
                f32x4 zi = __builtin_amdgcn_mfma_f32_16x16x32_bf16(wi0, x0, z4, 0, 0, 0); zi = __builtin_amdgcn_mfma_f32_16x16x32_bf16(wi1, x1, zi, 0, 0, 0);
                const uint2 xr = *(const uint2*)(xl + row * 64 + (((ct * 2 + (g >> 1)) ^ swz) * 8) + (g & 1) * 4);
                const f32x4 xv = {__uint_as_float(xr.x << 16), __uint_as_float(xr.x & 0xffff0000u), __uint_as_float(xr.y << 16), __uint_as_float(xr.y & 0xffff0000u)};
                f32x4 a, bb;
                rg_coef(za, zi, ba, bi, spc, xv, a, bb);
                f32x4 h;
#pragma unroll
                for (int j = 0; j < 4; ++j) {
                    float aj = a[j], bj = bb[j];
                    if (dir == 0) row_scan<true>(aj, bj); else row_scan<false>(aj, bj);
                    h[j] = fmaf(aj, hin[j], bj);
                    atot[j] *= aj;
                }
                const int src = (lane & 48) | (dir == 0 ? 15 : 0);
#pragma unroll
                for (int j = 0; j < 4; ++j) hin[j] = shl_(h[j], src);
                if (FINAL) {
                    if (dir == 0) {
                        if (tt == 0) hf0 = h; else if (tt == 1) hf1 = h; else if (tt == 2) hf2 = h; else if (tt == 3) hf3 = h; else if (tt == 4) hf4 = h; else if (tt == 5) hf5 = h; else if (tt == 6) hf6 = h; else hf7 = h;
                    } else {
                        const f32x4 hfv = tt == 0 ? hf0 : tt == 1 ? hf1 : tt == 2 ? hf2 : tt == 3 ? hf3 : tt == 4 ? hf4 : tt == 5 ? hf5 : tt == 6 ? hf6 : hf7;
                        const size_t R = (size_t)seqbase + t0 + row;
                        const uint2 gr = *(const uint2*)(P + R * PWS + COL_GATE + ch);
                        const f32x4 hs = hfv + h;
                        uint2 o;
                        o.x = pk2(hs[0] * gelu_tanh(__uint_as_float(gr.x << 16)), hs[1] * gelu_tanh(__uint_as_float(gr.x & 0xffff0000u)));
                        o.y = pk2(hs[2] * gelu_tanh(__uint_as_float(gr.y << 16)), hs[3] * gelu_tanh(__uint_as_float(gr.y & 0xffff0000u)));
                        *(uint2*)((bf16_t*)(p.ws + OFF_X1) + R * D + ch) = o;
                    }
                }
            }
            if (!FINAL) {
                if (fr == (dir == 0 ? 15 : 0)) { *(f32x4*)(AGG + (size_t)(idx * 2 + dir) * 512 + ch) = atot; *(f32x4*)(AGG + (size_t)(idx * 2 + dir) * 512 + 256 + ch) = hin; }
            }
        }
    }
}
DEV void ph_rgagg(const Params& p, int l, bf16_t* lds) {
    for (int rt = bid_(); rt < 528; rt += gridDim.x) { rg_item<false>(p, l, rt, lds); __syncthreads(); }
}

DEV void outproj_item(const Params& p_, int l, int rt, bf16_t* lds, float* stat  ) {
    const Params& p = kp_();
    const int t = tid_(), lane = t & 63, w = t >> 6, wm = w >> 1, wn = w & 1, fq = lane >> 4, fr = lane & 15;
    const bf16_t* A = (const bf16_t*)(p.ws + OFF_X1) + (size_t)(rt * 128) * D;
    const bool isctx = rt >= 512;
    const float* g1 = modvec(p, l, rt * 128, 2);
    rg_item<true>(p, l, rt, lds);
    __threadfence();
    __syncthreads();
    __builtin_amdgcn_fence(__ATOMIC_ACQUIRE, "agent");
#pragma unroll 1
    for (int pass = 0; pass < 4; ++pass) {
        const bf16_t* Bt = (const bf16_t*)(p.ws + OFF_WOUTT) + ((size_t)l * 1024 + pass * 256) * 1024;
        const unsigned toff = (unsigned)(((tid_() >> 2) * 1024 + gemm_src_chunk(tid_())) * 2);
        f32x4 acc[4][8]; zero_acc(acc);
        gemm_mainloop(A, toff, toff + 64 * D * 2, Bt, toff, 1024, 32, lds, acc);
#pragma unroll
        for (int mt = 0; mt < 4; ++mt) {
            const int rl = wm * 64 + mt * 16 + fr, R = rt * 128 + rl;
            const float* xin = (l == 0) ? (isctx ? p.ctx + (size_t)(R - NLAT) * D : p.x + (size_t)R * D) : xres_row(p, R);
            float* xo = xres_row(p, R);
            float s = 0.f, q = 0.f;
#pragma unroll
            for (int nt = 0; nt < 8; ++nt) {
                const int col = pass * 256 + wn * 128 + nt * 16 + fq * 4;
                const f32x4 xv = *(const f32x4*)(xin + col), gv = *(const f32x4*)(g1 + col);
                const f32x4 u = xv * ALPHA + gv * acc[mt][nt];
                *(f32x4*)(xo + col) = u;
                s += (u[0] + u[1]) + (u[2] + u[3]); q += (u[0] * u[0] + u[1] * u[1]) + (u[2] * u[2] + u[3] * u[3]);
            }
            s += shx(s, 16); s += shx(s, 32); q += shx(q, 16); q += shx(q, 32);
            if (fq == 0) { float* sp = stat + (wn * 128 + rl) * 2; if (pass == 0) { sp[0] = s; sp[1] = q; } else { sp[0] += s; sp[1] += q; } }
        }
    }
    __threadfence();
    __syncthreads();
    __builtin_amdgcn_fence(__ATOMIC_ACQUIRE, "agent");
    {
        const float* lg = p.ln1_g + l * D; const float* lb = p.ln1_b + l * D;
        const float* sh2 = modvec(p, l, rt * 128, 3); const float* sc2 = modvec(p, l, rt * 128, 4);
        bf16_t* X2 = (bf16_t*)(p.ws + OFF_X2);
        const bf16_t* WRh = (const bf16_t*)(p.ws + OFF_WR) + (size_t)(l * 2) * 48 * 1024 + (size_t)fr * 1024 + fq * 8;
        const bf16_t* WRl = WRh + 48 * 1024;
        float mean[2], rstd[2];
#pragma unroll
        for (int tm = 0; tm < 2; ++tm) {
            const int rl = w * 32 + tm * 16 + fr;
            float s = 0.f, q = 0.f;
#pragma unroll
            for (int i = 0; i < 2; ++i) { s += stat[(i * 128 + rl) * 2]; q += stat[(i * 128 + rl) * 2 + 1]; }
            mean[tm] = s * (1.f / D);
            rstd[tm] = rsqrtf(fmaxf(q * (1.f / D) - mean[tm] * mean[tm], 0.f) + LN_EPS);
        }
        f32x4 lacc[3][2];
#pragma unroll
        for (int a = 0; a < 3; ++a) { lacc[a][0] = (f32x4){0.f, 0.f, 0.f, 0.f}; lacc[a][1] = (f32x4){0.f, 0.f, 0.f, 0.f}; }
#pragma unroll 2
        for (int ks = 0; ks < 32; ++ks) {
            const int k = ks * 32 + fq * 8;
            const f32x4 g0 = *(const f32x4*)(lg + k), g1v = *(const f32x4*)(lg + k + 4), b0 = *(const f32x4*)(lb + k), b1 = *(const f32x4*)(lb + k + 4);
            const f32x4 s0 = *(const f32x4*)(sh2 + k), s1 = *(const f32x4*)(sh2 + k + 4), c0 = *(const f32x4*)(sc2 + k), c1 = *(const f32x4*)(sc2 + k + 4);
            bf16x8 hh[2], hl[2];
#pragma unroll
            for (int tm = 0; tm < 2; ++tm) {
                const int R = rt * 128 + w * 32 + tm * 16 + fr;
                float* xr = xres_row(p, R) + k;
                const f32x4 u0 = *(const f32x4*)xr, u1 = *(const f32x4*)(xr + 4);
                const f32x4 x0 = (u0 - mean[tm]) * rstd[tm] * g0 + b0, x1 = (u1 - mean[tm]) * rstd[tm] * g1v + b1;
                *(f32x4*)xr = x0; *(f32x4*)(xr + 4) = x1;
                const f32x4 h0 = x0 * (c0 + 1.f) + s0, h1 = x1 * (c1 + 1.f) + s1;
#pragma unroll
                for (int e = 0; e < 4; ++e) {
                    const bf16_t a = f2bf(h0[e]), b = f2bf(h1[e]);
                    hh[tm][e] = (short)a; hh[tm][4 + e] = (short)b;
                    hl[tm][e] = (short)f2bf(h0[e] - bf2f(a)); hl[tm][4 + e] = (short)f2bf(h1[e] - bf2f(b));
                }
                *(bf16x8*)(X2 + (size_t)R * D + k) = hh[tm];
            }
#pragma unroll
            for (int ft = 0; ft < 3; ++ft) {
                const bf16x8 wh = *(const bf16x8*)(WRh + (size_t)ft * 16 * 1024 + ks * 32), wl = *(const bf16x8*)(WRl + (size_t)ft * 16 * 1024 + ks * 32);
#pragma unroll
                for (int tm = 0; tm < 2; ++tm) {
                    lacc[ft][tm] = __builtin_amdgcn_mfma_f32_16x16x32_bf16(wh, hh[tm], lacc[ft][tm], 0, 0, 0);
                    lacc[ft][tm] = __builtin_amdgcn_mfma_f32_16x16x32_bf16(wl, hh[tm], lacc[ft][tm], 0, 0, 0);
                    lacc[ft][tm] = __builtin_amdgcn_mfma_f32_16x16x32_bf16(wh, hl[tm], lacc[ft][tm], 0, 0, 0);
                }
            }
        }
        float* lt = (float*)lds;
#pragma unroll
        for (int ft = 0; ft < 3; ++ft)
#pragma unroll
            for (int tm = 0; tm < 2; ++tm)
#pragma unroll
                for (int j = 0; j < 4; ++j) lt[(w * 32 + tm * 16 + fr) * 48 + ft * 16 + fq * 4 + j] = lacc[ft][tm][j];
        asm volatile("s_waitcnt lgkmcnt(0)" ::: "memory");
        if (lane < 32) {
            const int rl = w * 32 + lane, R = rt * 128 + rl;
            const float* lr = lt + rl * 48;
            int gi = 0; float gm = lr[0] + p.router_g_b[l * 4];
            float gl[4]; gl[0] = gm;
#pragma unroll
            for (int j = 1; j < 4; ++j) { gl[j] = lr[j] + p.router_g_b[l * 4 + j]; if (gl[j] > gm) { gm = gl[j]; gi = j; } }
            float gs = 0.f;
#pragma unroll
            for (int j = 0; j < 4; ++j) gs += expf(gl[j] - gm);
            const float ptop = 1.f / gs;
            int e0 = 0, e1 = 0; float m0 = -INFINITY, m1 = -INFINITY;
            for (int j = 0; j < 8; ++j) {
                const float v = lr[4 + gi * 8 + j] + p.router_e_b[l * 32 + gi * 8 + j];
                if (v > m0) { m1 = m0; e1 = e0; m0 = v; e0 = j; } else if (v > m1) { m1 = v; e1 = j; }
            }
            const float ex = expf(m1 - m0);
            const float w0 = ptop / (1.f + ex), w1 = ptop * ex / (1.f + ex);
            int* rte = (int*)(p.ws + OFF_RTE); float* rtw = (float*)(p.ws + OFF_RTW);
            unsigned* cnt = (unsigned*)(p.ws + OFF_CTL) + CW_CNT + l * 32;
            int* list = (int*)(p.ws + OFF_LIST);
            const int E0 = gi * 8 + e0, E1 = gi * 8 + e1;
            rte[R * 2] = E0; rte[R * 2 + 1] = E1; rtw[R * 2] = w0; rtw[R * 2 + 1] = w1;
            const unsigned p0 = atomicAdd(cnt + E0, 1u); list[(size_t)E0 * LISTCAP + p0] = R * 2;
            const unsigned p1 = atomicAdd(cnt + E1, 1u); list[(size_t)E1 * LISTCAP + p1] = R * 2 + 1;
        }
    }
}
DEV void ph_outproj(const Params& p, int l, bf16_t* lds, float* stat  ) {
    const int ntiles = (l == 0) ? 528 : 512;
    for (int rt = bid_(); rt < ntiles; rt += gridDim.x) { outproj_item(p, l, rt, lds, stat); __syncthreads(); }
}

DEV void moe_item(const Params& p_, int l, int e, int j, int item, int cnt, bf16_t* lds) {
    const Params& p = kp_();
    const int t = tid_(), lane = t & 63, w = t >> 6, wm = w >> 1, wn = w & 1, fq = lane >> 4, fr = lane & 15;
    const int* list = (const int*)(p.ws + OFF_LIST) + (size_t)e * LISTCAP;
    const bf16_t* X2 = (const bf16_t*)(p.ws + OFF_X2);
    bf16_t* Hs = (bf16_t*)(p.ws + OFF_P) + (size_t)item * 128 * FF;
    unsigned ao0, ao1;
    { const int s0 = j * 128 + (t >> 2), s1 = s0 + 64;
      const int tok0 = s0 < cnt ? (list[s0] >> 1) : 0, tok1 = s1 < cnt ? (list[s1] >> 1) : 0;
      ao0 = (unsigned)((tok0 * D + gemm_src_chunk(t)) * 2); ao1 = (unsigned)((tok1 * D + gemm_src_chunk(t)) * 2); }
#pragma unroll 1
    for (int pass = 0; pass < 4; ++pass) {
        const bf16_t* Bt = (const bf16_t*)(p.ws + OFF_WGU) + ((size_t)e * 1024 + pass * 256) * 1024;
        f32x4 acc[4][8]; zero_acc(acc);
        gemm_mainloop(X2, ao0, ao1, Bt, (unsigned)(((tid_() >> 2) * 1024 + gemm_src_chunk(tid_())) * 2), 1024, 32, lds, acc);
#pragma unroll
        for (int mt = 0; mt < 4; ++mt) {
            const int rl = wm * 64 + mt * 16 + fr;
#pragma unroll
            for (int nt = 0; nt < 4; ++nt) {
                const f32x4 gv = acc[mt][nt], uv = acc[mt][nt + 4];
                float hv[4];
#pragma unroll
                for (int jj = 0; jj < 4; ++jj) hv[jj] = gv[jj] / (1.f + __expf(-gv[jj])) * uv[jj];
                uint2 o; o.x = pk2(hv[0], hv[1]); o.y = pk2(hv[2], hv[3]);
                *(uint2*)(Hs + (size_t)rl * FF + pass * 128 + wn * 64 + nt * 16 + fq * 4) = o;
            }
        }
    }
    __threadfence();
    __syncthreads();
    __builtin_amdgcn_fence(__ATOMIC_ACQUIRE, "agent");
    const unsigned hoff = (unsigned)(((t >> 2) * FF + gemm_src_chunk(t)) * 2);
    const float* rtw = (const float*)(p.ws + OFF_RTW);
    bf16_t* Y = (bf16_t*)(p.ws + OFF_Y);
#pragma unroll 1
    for (int pass = 0; pass < 4; ++pass) {
        const bf16_t* Bt = (const bf16_t*)(p.ws + OFF_WD) + ((size_t)e * 1024 + pass * 256) * FF;
        f32x4 acc[4][8]; zero_acc(acc);
        gemm_mainloop(Hs, hoff, hoff + 64 * FF * 2, Bt, hoff, FF, 16, lds, acc);
#pragma unroll
        for (int mt = 0; mt < 4; ++mt) {
            const int s = j * 128 + wm * 64 + mt * 16 + fr;
            if (s < cnt) {
                const int ent = list[s];
                const float gw = rtw[ent];
                bf16_t* yo = Y + (size_t)ent * D + pass * 256 + wn * 128 + fq * 4;
#pragma unroll
                for (int nt = 0; nt < 8; ++nt) { const f32x4 v = acc[mt][nt] * gw; uint2 o; o.x = pk2(v[0], v[1]); o.y = pk2(v[2], v[3]); *(uint2*)(yo + nt * 16) = o; }
            }
        }
    }
}
DEV void ph_moe(const Params& p, int l, bf16_t* lds, int* s_pref  , int* s_cnt  ) {
    const unsigned* cnt = (const unsigned*)(p.ws + OFF_CTL) + CW_CNT + l * 32;
    if (tid_() == 0) { int a = 0; for (int e = 0; e < 32; ++e) { const int c = (int)cnt[e]; s_cnt[e] = c; s_pref[e] = a; a += (c + 127) >> 7; } s_pref[32] = a; }
    __syncthreads();
    const int nx = gridDim.x >> 3, xcd = bid_() & 7, j = bid_() >> 3;
    if (bid_() < nx * 8) {
        const int n0 = (s_cnt[xcd] + 127) >> 7, n1 = (s_cnt[xcd + 8] + 127) >> 7, n2 = (s_cnt[xcd + 16] + 127) >> 7, n3 = (s_cnt[xcd + 24] + 127) >> 7;
        const int nloc = n0 + n1 + n2 + n3;
        for (int i = j; i < nloc; i += nx) {
            int e, jb;
            if (i < n0) { e = xcd; jb = i; } else if (i < n0 + n1) { e = xcd + 8; jb = i - n0; } else if (i < n0 + n1 + n2) { e = xcd + 16; jb = i - n0 - n1; } else { e = xcd + 24; jb = i - n0 - n1 - n2; }
            moe_item(p, l, e, jb, s_pref[e] + jb, s_cnt[e], lds);
            __syncthreads();
        }
    }
}

#define XB_TMO      128
#define XB_XCNT(j)  (256  + 64 * (j))
#define XB_XSUB(j)  (1280 + 64 * (j))
#define XB_XGEN(j)  (2304 + 64 * (j))
#define XB_TOP      3328
#define XB_TOPGEN   3392
#define XCD_BAR_WORDS 3456
#define XB_SPIN_CAP (1u << 20)
DEV unsigned xb_ld(unsigned* p) { return __hip_atomic_load(p, __ATOMIC_RELAXED, __HIP_MEMORY_SCOPE_AGENT); }
DEV unsigned xb_add(unsigned* p, unsigned v) { return __hip_atomic_fetch_add(p, v, __ATOMIC_RELAXED, __HIP_MEMORY_SCOPE_AGENT); }
DEV unsigned xb_xcc_id() { return (unsigned)__builtin_amdgcn_s_getreg((3 << 11) | 20) & 0xFu; }
#define XB_SPIN(cond, bar) do { unsigned _sp = 0; while (cond) { __builtin_amdgcn_s_sleep(1); \
    if ((++_sp & 255u) == 0u) { if (xb_ld(&(bar)[XB_TMO])) break; if (_sp > XB_SPIN_CAP) { atomicAdd(&(bar)[XB_TMO], 1u); break; } } } } while (0)
struct XcdBarrier { unsigned* bar; unsigned x; volatile LAS unsigned* st; };
DEV XcdBarrier xcd_barrier_post(unsigned* bar, volatile LAS unsigned* st) {
    XcdBarrier b; b.bar = bar; b.x = xb_xcc_id(); b.st = st;
    if (tid_() == 0) (void)xb_add(&bar[XB_XCNT(b.x)], 1u);
    return b;
}
DEV void xcd_barrier_complete(unsigned* bar, unsigned x, unsigned& nloc, unsigned& nx) {
    const unsigned G = gridDim.x * gridDim.y * gridDim.z;
    unsigned sum, cnt, mine, sp = 0u;
    for (;;) {
        sum = 0u; cnt = 0u; mine = 0u;
#pragma unroll
        for (unsigned j = 0; j < 16; ++j) { const unsigned c = xb_ld(&bar[XB_XCNT(j)]); sum += c; cnt += (c > 0u) ? 1u : 0u; mine = (j == x) ? c : mine; }
        if (sum == G) break;
        __builtin_amdgcn_s_sleep(1);
        if ((++sp & 255u) == 0u) { if (xb_ld(&bar[XB_TMO])) break; if (sp > XB_SPIN_CAP) { atomicAdd(&bar[XB_TMO], 1u); break; } }
    }
    nloc = mine > 0u ? mine : 1u; nx = cnt > 0u ? cnt : 1u;
}
DEV void xcd_barrier(const XcdBarrier& b) {
    asm volatile("s_waitcnt vmcnt(0)" ::: "memory");
    __syncthreads();
    if (tid_() == 0) {
        unsigned* bar = b.bar;
        __builtin_amdgcn_s_waitcnt(0);
        unsigned nloc = b.st[0], nx = b.st[1];
        if (nloc == 0u) { xcd_barrier_complete(bar, b.x, nloc, nx); b.st[0] = nloc; b.st[1] = nx; }
        const unsigned old = xb_add(&bar[XB_XSUB(b.x)], 1u);
        const unsigned gen = old / nloc;
        if (old + 1u == (gen + 1u) * nloc) {
            __builtin_amdgcn_fence(__ATOMIC_RELEASE, "agent");
            asm volatile("s_waitcnt vmcnt(0)" ::: "memory");
            const unsigned og = xb_add(&bar[XB_TOP], 1u);
            const unsigned tg = og / nx;
            if (og + 1u == (tg + 1u) * nx) xb_add(&bar[XB_TOPGEN], 1u);
            else XB_SPIN(xb_ld(&bar[XB_TOPGEN]) == tg, bar);
            __builtin_amdgcn_fence(__ATOMIC_ACQUIRE, "agent");
            xb_add(&bar[XB_XGEN(b.x)], 1u);
            asm volatile("s_waitcnt vmcnt(0)" ::: "memory");
        } else {
            XB_SPIN(xb_ld(&bar[XB_XGEN(b.x)]) == gen, bar);
            __builtin_amdgcn_fence(__ATOMIC_ACQUIRE, "agent");
            asm volatile("s_waitcnt vmcnt(0)" ::: "memory");
        }
    }
    __syncthreads();
}

namespace cg = cooperative_groups;
#define REP(id) for (int rep_ = 0; rep_ < ((PROBE_ID) == (id) ? PROBE_N : 1); ++rep_)
constexpr int SMEM_STAT = GEMM_LDS_BYTES;
constexpr int SMEM_BYTES = GEMM_LDS_BYTES + 2048 + 512;
constexpr int NPHASE = 12;
__global__ void __launch_bounds__(256, 2) mega(Params p, int ph_lo, int ph_hi) {
    extern __shared__ __attribute__((aligned(16))) unsigned char smem[];
    bf16_t* lds = (bf16_t*)smem;
    float* stat = (float*)(smem + SMEM_STAT);
    int* s_pref = (int*)(smem + SMEM_STAT + 2048); int* s_cnt = s_pref + 40;
    volatile LAS unsigned* bst = (volatile LAS unsigned*)(LAS unsigned char*)(smem + SMEM_STAT + 2048 + 400);
    if (tid_() < 2) bst[tid_()] = 0u;
    __syncthreads();
    (void)xcd_barrier_post((unsigned*)(kp_().ws + OFF_CTL + 4096), bst);
#define GRID_BAR() do { XcdBarrier xb_; xb_.bar = (unsigned*)(kp_().ws + OFF_CTL + 4096); xb_.x = xb_xcc_id(); \
        xb_.st = (volatile LAS unsigned*)(LAS unsigned char*)(smem + SMEM_STAT + 2048 + 400); xcd_barrier(xb_); } while (0)
#define IN(k) (ph_lo <= (k) && (k) < ph_hi)
#define SEAM(k) do { if (IN(k) && IN((k) + 1)) { if ((k) == 0) cg::this_grid().sync(); else GRID_BAR(); } } while (0)
    if (IN(0)) {
        REP(0) { ph_mod(kp_(), (float*)smem); __syncthreads(); }
        ph_rope(kp_());
        ph_routerw(kp_());
        ph_rgprep(kp_());
        REP(1) ph_transpose(kp_().w_in, (bf16_t*)(kp_().ws + OFF_WINT), 1024, 2304, 0, 2, (size_t)1024 * 2304, (size_t)2304 * 1024, (float*)smem);
        ph_transpose(kp_().w_out, (bf16_t*)(kp_().ws + OFF_WOUTT), 1024, 1024, 0, 2, (size_t)1024 * 1024, (size_t)1024 * 1024, (float*)smem);
    }
    SEAM(0);
#define LAYER_BODY(l, pb) { \
        if (IN(pb + 0)) { if (l == 0) { REP(2) ph_rowop<0>(kp_(), 0, NTOK); } else ph_rowop<1>(kp_(), 1, NTOK); } \
        SEAM(pb + 0); \
        if (IN(pb + 1)) { ph_inproj(kp_(), l, lds); } \
        SEAM(pb + 1); \
        if (IN(pb + 2)) { \
            REP(4) ph_rgagg(kp_(), l, lds); \
            REP(5) { ph_attn(kp_(), l, (float*)smem); __syncthreads(); } \
            REP(6) { \
            ph_transpose(kp_().exp_w_gate + (size_t)l * NE * 1024 * 512, (bf16_t*)(kp_().ws + OFF_WGU), 1024, 512, 1, NE, (size_t)1024 * 512, (size_t)1024 * 1024, (float*)smem); \
            ph_transpose(kp_().exp_w_up + (size_t)l * NE * 1024 * 512, (bf16_t*)(kp_().ws + OFF_WGU), 1024, 512, 2, NE, (size_t)1024 * 512, (size_t)1024 * 1024, (float*)smem); \
            ph_transpose(kp_().exp_w_down + (size_t)l * NE * 512 * 1024, (bf16_t*)(kp_().ws + OFF_WD), 512, 1024, 0, NE, (size_t)512 * 1024, (size_t)1024 * 512, (float*)smem); \
            } \
        } \
        SEAM(pb + 2); \
        if (IN(pb + 3)) ph_outproj(kp_(), l, lds, stat); \
        SEAM(pb + 3); \
        if (IN(pb + 4)) { REP(7) { ph_moe(kp_(), l, lds, s_pref, s_cnt); __syncthreads(); } } \
        SEAM(pb + 4); \
    }
    LAYER_BODY(0, 1)
    LAYER_BODY(1, 6)
#undef LAYER_BODY
    if (IN(NPHASE - 1)) ph_rowop<2>(kp_(), 2, NLAT);
#undef IN
#undef SEAM
}

#ifndef ONE_LAUNCH
#define ONE_LAUNCH 1
#endif
extern "C" void kernel_launch(void* const* d_in, const int* in_sizes, int n_in, void* d_out, int out_size, void* d_ws, size_t ws_size, hipStream_t stream) {
    if (n_in != 28 || ws_size < WS_TOTAL || out_size != NLAT * D) { fprintf(stderr, "kernel_launch: unexpected shapes / workspace (%d inputs, ws %zu need %zu)\n", n_in, ws_size, (size_t)WS_TOTAL); return; }
    static int grid = 0;
    if (grid == 0) {
        int dev = 0, cus = 0, per_cu = 0;
        (void)hipGetDevice(&dev);
        (void)hipDeviceGetAttribute(&cus, hipDeviceAttributeMultiprocessorCount, dev);
        (void)hipFuncSetAttribute((const void*)mega, hipFuncAttributeMaxDynamicSharedMemorySize, SMEM_BYTES);
        (void)hipOccupancyMaxActiveBlocksPerMultiprocessor(&per_cu, (const void*)mega, 256, SMEM_BYTES);
        if (per_cu > 2) per_cu = 2;
        grid = cus * per_cu;
        if (grid <= 0) { fprintf(stderr, "kernel_launch: occupancy query gave %d blocks per CU on %d CUs\n", per_cu, cus); grid = -1; }
    }
    if (grid < 0) return;
    Params p{};
    const float** pp = (const float**)&p;
    for (int i = 0; i < 28; ++i) pp[i] = (const float*)d_in[i];
    p.out = (float*)d_out; p.ws = (unsigned char*)d_ws;
    (void)hipMemsetAsync((unsigned char*)d_ws + OFF_CTL, 0, CTL_BYTES, stream);
#if ONE_LAUNCH
    int lo = 0, hi = NPHASE;
    void* args[] = {(void*)&p, (void*)&lo, (void*)&hi};
    hipError_t e = hipLaunchCooperativeKernel((const void*)mega, dim3(grid), dim3(256), args, SMEM_BYTES, stream);
    if (e != hipSuccess) fprintf(stderr, "kernel_launch: cooperative launch failed: %s (grid %d)\n", hipGetErrorString(e), grid);
#else
    for (int ph = 0; ph < NPHASE; ++ph) mega<<<grid, 256, SMEM_BYTES, stream>>>(p, ph, ph + 1);
#endif
}
```

```cpp
#include <hip/hip_runtime.h>
#include <hip/hip_cooperative_groups.h>
#include <stdint.h>
#include <cstdio>

typedef unsigned short bf16_t;
typedef short bf16x8 __attribute__((ext_vector_type(8)));
typedef float f32x4 __attribute__((ext_vector_type(4)));

#define DEV __device__ __forceinline__
#define PROBE_ID -1
#define PROBE_N 4

constexpr int D = 1024, NB = 8, S = 8192, CTX = 256;
constexpr int NLAT = NB * S, NCTX = NB * CTX, NTOK = NLAT + NCTX;
constexpr int PWS = 1280;
constexpr int COL_RGX = 0, COL_GATE = 256, COL_NAQ = 512, COL_GQ = 896;
constexpr int KVT = 1024;
constexpr int NE = 32, FF = 512;
constexpr int LISTCAP = NTOK;
constexpr float ALPHA = 1.4142135623730951f;
constexpr float LN_EPS = 1e-5f;

constexpr size_t al256(size_t x) { return (x + 255) & ~(size_t)255; }
constexpr size_t OFF_CTL   = 0;
constexpr size_t CTL_BYTES = 4096 + 16384;
constexpr size_t OFF_MOD   = OFF_CTL + CTL_BYTES;
constexpr size_t OFF_ROPE  = al256(OFF_MOD + (size_t)2 * 9 * 6144 * 4);
constexpr size_t OFF_RTE   = al256(OFF_ROPE + (size_t)2 * 128 * 16 * 4);
constexpr size_t OFF_RTW   = al256(OFF_RTE + (size_t)NTOK * 8);
constexpr size_t OFF_LIST  = al256(OFF_RTW + (size_t)NTOK * 8);
constexpr size_t OFF_WR    = al256(OFF_LIST + (size_t)NE * LISTCAP * 4);
constexpr size_t OFF_WRG   = al256(OFF_WR + (size_t)2 * 2 * 48 * 1024 * 2);
constexpr size_t OFF_RGC   = al256(OFF_WRG + (size_t)2 * 2 * 2 * 4 * 64 * 64 * 2);
constexpr size_t OFF_AGG   = al256(OFF_RGC + (size_t)2 * 2 * 3 * 256 * 4);
constexpr size_t OFF_WINT  = al256(OFF_AGG + (size_t)NB * 66 * 2 * 2 * 256 * 4);
constexpr size_t OFF_WOUTT = al256(OFF_WINT + (size_t)2 * 2304 * 1024 * 2);
constexpr size_t OFF_WGU   = al256(OFF_WOUTT + (size_t)2 * 1024 * 1024 * 2);
constexpr size_t OFF_WD    = al256(OFF_WGU + (size_t)NE * 1024 * 1024 * 2);
constexpr size_t OFF_XCTX  = al256(OFF_WD + (size_t)NE * 1024 * 512 * 2);
constexpr size_t OFF_X1    = al256(OFF_XCTX + (size_t)NCTX * D * 4);
constexpr size_t OFF_X2    = al256(OFF_X1 + (size_t)NTOK * D * 2);
constexpr size_t OFF_P     = al256(OFF_X2 + (size_t)NTOK * D * 2);
constexpr size_t OFF_NAKF  = al256(OFF_P + (size_t)NTOK * PWS * 2);
constexpr size_t OFF_NAVF  = al256(OFF_NAKF + (size_t)NB * 6 * 512 * KVT * 2);
constexpr size_t OFF_GKF   = al256(OFF_NAVF + (size_t)NB * 6 * 512 * KVT * 2);
constexpr size_t OFF_GVF   = al256(OFF_GKF + (size_t)NB * 2 * 512 * KVT * 2);
constexpr size_t OFF_NAKFC = al256(OFF_GVF + (size_t)NB * 2 * 512 * KVT * 2);
constexpr size_t OFF_NAVFC = al256(OFF_NAKFC + (size_t)NB * 6 * 16 * KVT * 2);
constexpr size_t OFF_GKFC  = al256(OFF_NAVFC + (size_t)NB * 6 * 16 * KVT * 2);
constexpr size_t OFF_GVFC  = al256(OFF_GKFC + (size_t)NB * 2 * 16 * KVT * 2);
constexpr size_t OFF_Y     = al256(OFF_GVFC + (size_t)NB * 2 * 16 * KVT * 2);
constexpr size_t WS_TOTAL  = al256(OFF_Y + (size_t)2 * NTOK * D * 2);
constexpr int CW_CNT = 0;

struct Params {
    const float *x, *c, *ctx, *c_ctx, *w_ada, *b_ada, *w_in, *conv_w, *conv_b, *rg_a_w, *rg_a_b, *rg_i_w, *rg_i_b, *rg_lambda,
        *na_rpb, *gqa_sink, *w_out, *ln1_g, *ln1_b, *router_g_w, *router_g_b, *router_e_w, *router_e_b, *exp_w_gate, *exp_w_up,
        *exp_w_down, *ln2_g, *ln2_b;
    float* out;
    unsigned char* ws;
};

DEV const Params& kp_() { const void* q = (const void*)__builtin_amdgcn_kernarg_segment_ptr(); asm volatile("" : "+s"(q)); return *(const Params*)q; }
DEV int tid_() { int t = threadIdx.x; asm volatile("" : "+v"(t)); return t; }
DEV int bid_() { int b = blockIdx.x; asm volatile("" : "+s"(b)); return b; }
DEV float shx(float v, int m) { return __builtin_bit_cast(float, __builtin_amdgcn_ds_bpermute(((tid_() & 63) ^ m) << 2, __builtin_bit_cast(int, v))); }
DEV float shl_(float v, int src) { return __builtin_bit_cast(float, __builtin_amdgcn_ds_bpermute(src << 2, __builtin_bit_cast(int, v))); }
DEV float bf2f(bf16_t h) { return __uint_as_float((unsigned)h << 16); }
DEV bf16_t f2bf(float f) { unsigned u = __float_as_uint(f); u += 0x7fffu + ((u >> 16) & 1u); return (bf16_t)(u >> 16); }
DEV unsigned pk2(float lo, float hi) { return (unsigned)f2bf(lo) | ((unsigned)f2bf(hi) << 16); }
DEV float wave_sum(float v) {
#pragma unroll
    for (int o = 1; o < 64; o <<= 1) v += shx(v, o);
    return v;
}
DEV float wave_max(float v) {
#pragma unroll
    for (int o = 1; o < 64; o <<= 1) v = fmaxf(v, shx(v, o));
    return v;
}
DEV float sigmoidf_(float x) { return 1.f / (1.f + __expf(-x)); }
DEV float gelu_tanh(float x) {
    const float u = 0.7978845608028654f * (x + 0.044715f * x * x * x);
    const float t = 1.f - 2.f / (1.f + __expf(2.f * u));
    return 0.5f * x * (1.f + t);
}
DEV float* xres_row(const Params& p, int R) {
    return R < NLAT ? p.out + (size_t)R * D : (float*)(p.ws + OFF_XCTX) + (size_t)(R - NLAT) * D;
}
DEV const float* modvec(const Params& p, int l, int R, int seg) {
    const int b = R < NLAT ? R / S : 8;
    return (const float*)(p.ws + OFF_MOD) + ((size_t)(l * 9 + b) * 6 + seg) * 1024;
}

DEV void ph_mod(const Params& p, float* sc  ) {
    if (bid_() >= 48) return;
    for (int i = tid_(); i < 9 * 1024; i += 256) { const float v = (i < 8192) ? p.c[i] : p.c_ctx[i - 8192]; sc[i] = v / (1.f + expf(-v)); }
    __syncthreads();
    const int col = bid_() * 256 + tid_();
    const int l = col / 6144, j = col % 6144;
    const float* w = p.w_ada + (size_t)l * 1024 * 6144 + j;
    float a0 = 0, a1 = 0, a2 = 0, a3 = 0, a4 = 0, a5 = 0, a6 = 0, a7 = 0, a8 = 0;
    for (int k = 0; k < 1024; ++k) {
        const float wv = w[(size_t)k * 6144];
        a0 += sc[k] * wv; a1 += sc[1024 + k] * wv; a2 += sc[2048 + k] * wv; a3 += sc[3072 + k] * wv; a4 += sc[4096 + k] * wv;
        a5 += sc[5120 + k] * wv; a6 += sc[6144 + k] * wv; a7 += sc[7168 + k] * wv; a8 += sc[8192 + k] * wv;
    }
    const float bias = p.b_ada[l * 6144 + j];
    float* mod = (float*)(p.ws + OFF_MOD) + (size_t)l * 9 * 6144 + j;
    mod[0 * 6144] = a0 + bias; mod[1 * 6144] = a1 + bias; mod[2 * 6144] = a2 + bias; mod[3 * 6144] = a3 + bias; mod[4 * 6144] = a4 + bias;
    mod[5 * 6144] = a5 + bias; mod[6 * 6144] = a6 + bias; mod[7 * 6144] = a7 + bias; mod[8 * 6144] = a8 + bias;
}

DEV void sincos_red(float ang, float& sn, float& cs) {
    const float n = rintf(ang * 0.15915494309189535f);
    float r = fmaf(-n, 6.2831854820251465f, ang);
    r = fmaf(-n, -1.7484555e-07f, r);
    float sgn = 1.f;
    if (r > 1.5707963267948966f) { r = 3.14159265358979f - r; sgn = -1.f; }
    else if (r < -1.5707963267948966f) { r = -3.14159265358979f - r; sgn = -1.f; }
    const float r2 = r * r;
    float sp = -1.6059044e-10f; sp = fmaf(sp, r2, 2.5052108e-08f); sp = fmaf(sp, r2, -2.7557319e-06f); sp = fmaf(sp, r2, 1.9841270e-04f);
    sp = fmaf(sp, r2, -8.3333333e-03f); sp = fmaf(sp, r2, 1.6666667e-01f); sp = fmaf(sp * -1.f, r2, 1.f);
    sn = r * sp;
    float cp = -1.1470746e-11f; cp = fmaf(cp, r2, 2.0876757e-09f); cp = fmaf(cp, r2, -2.7557319e-07f); cp = fmaf(cp, r2, 2.4801587e-05f);
    cp = fmaf(cp, r2, -1.3888889e-03f); cp = fmaf(cp, r2, 4.1666667e-02f); cp = fmaf(cp, r2, -0.5f); cp = fmaf(cp, r2, 1.f);
    cs = sgn * cp;
}
DEV void ph_rope(const Params& p) {
    const int i = (bid_() - 48) * 256 + tid_();
    if (i < 0 || i >= 128 * 16) return;
    const int pos = i >> 4, q = i & 15;
    const float inv = exp2f(-(float)q * (13.287712379549449f / 16.f));
    float sn, cs; sincos_red((float)pos * inv, sn, cs);
    float* tab = (float*)(p.ws + OFF_ROPE);
    tab[i] = cs; tab[2048 + i] = sn;
}

DEV void ph_routerw(const Params& p) {
  for (int i = bid_() * 256 + tid_(); i < 2 * 48 * 1024; i += gridDim.x * 256) {
    const int l = i / (48 * 1024), f = (i / 1024) % 48, k = i & 1023;
    float w = 0.f;
    if (f < 4) w = p.router_g_w[((size_t)l * 1024 + k) * 4 + f]; else if (f < 36) w = p.router_e_w[((size_t)l * 1024 + k) * 32 + (f - 4)];
    const bf16_t hi = f2bf(w), lo = f2bf(w - bf2f(hi));
    bf16_t* WR = (bf16_t*)(p.ws + OFF_WR);
    WR[((size_t)(l * 2 + 0) * 48 + f) * 1024 + k] = hi;
    WR[((size_t)(l * 2 + 1) * 48 + f) * 1024 + k] = lo;
  }
}

DEV void ph_rgprep(const Params& p) {
    bf16_t* W = (bf16_t*)(p.ws + OFF_WRG);
    for (int i = bid_() * 256 + tid_(); i < 2 * 2 * 2 * 4 * 64 * 64; i += gridDim.x * 256) {
        const int d = i & 63, e = (i >> 6) & 63, n = (i >> 12) & 3, gate = (i >> 14) & 1, ld = i >> 15;
        const float* srcw = gate ? p.rg_i_w : p.rg_a_w;
        W[i] = f2bf(srcw[((size_t)(ld * 4 + n) * 64 + d) * 64 + e]);
    }
    float* C = (float*)(p.ws + OFF_RGC);
    for (int i = bid_() * 256 + tid_(); i < 2 * 2 * 256; i += gridDim.x * 256) {
        const int c = i & 255, ld = i >> 8;
        C[(ld * 3 + 0) * 256 + c] = p.rg_a_b[ld * 256 + c];
        C[(ld * 3 + 1) * 256 + c] = p.rg_i_b[ld * 256 + c];
        C[(ld * 3 + 2) * 256 + c] = -8.f * log1pf(expf(-p.rg_lambda[ld * 256 + c]));
    }
}

DEV int tr_row(int n, int mode) { return mode == 0 ? n : ((n >> 7) * 256 + ((n >> 6) & 1) * 128 + (n & 63) + (mode == 2 ? 64 : 0)); }
DEV void transpose_tile(const float* src, bf16_t* dst, int K, int N, int mode, int tile, float* lds) {
    const int ntn = N >> 6, kt = tile / ntn, nt = tile % ntn, k0 = kt * 64, n0 = nt * 64, t = tid_();
#pragma unroll
    for (int i = 0; i < 4; ++i) {
        const int r = (t >> 4) + 16 * i, c4 = (t & 15) * 4;
        const float4 v = *(const float4*)(src + (size_t)(k0 + r) * N + n0 + c4);
        lds[r * 65 + c4] = v.x; lds[r * 65 + c4 + 1] = v.y; lds[r * 65 + c4 + 2] = v.z; lds[r * 65 + c4 + 3] = v.w;
    }
    __syncthreads();
#pragma unroll
    for (int i = 0; i < 2; ++i) {
        const int n = (t >> 3) + 32 * i, kc = (t & 7) * 8;
        uint4 o;
        o.x = pk2(lds[(kc + 0) * 65 + n], lds[(kc + 1) * 65 + n]); o.y = pk2(lds[(kc + 2) * 65 + n], lds[(kc + 3) * 65 + n]);
        o.z = pk2(lds[(kc + 4) * 65 + n], lds[(kc + 5) * 65 + n]); o.w = pk2(lds[(kc + 6) * 65 + n], lds[(kc + 7) * 65 + n]);
        *(uint4*)(dst + (size_t)tr_row(n0 + n, mode) * K + k0 + kc) = o;
    }
    __syncthreads();
}
DEV void ph_transpose(const float* src, bf16_t* dst, int K, int N, int mode, int nmat, size_t sstride, size_t dstride, float* lds  ) {
    const int per = (K >> 6) * (N >> 6);
    for (int it = bid_(); it < nmat * per; it += gridDim.x) {
        const int m = it / per, tile = it % per;
        transpose_tile(src + (size_t)m * sstride, dst + (size_t)m * dstride, K, N, mode, tile, lds);
    }
}

template <int MODE> DEV void rowop(const Params& p, int l, int R) {
    const int lane = tid_() & 63;
    float4 v[4];
    if (MODE == 0) {
        const float* src = R < NLAT ? p.x + (size_t)R * D : p.ctx + (size_t)(R - NLAT) * D;
#pragma unroll
        for (int i = 0; i < 4; ++i) v[i] = *(const float4*)(src + i * 256 + lane * 4);
    } else {
        float* xr = xres_row(p, R);
        const float* g2 = modvec(p, l - 1, R, 5);
        const bf16_t* y0 = (const bf16_t*)(p.ws + OFF_Y) + (size_t)(2 * R) * D;
        const bf16_t* y1 = y0 + D;
        const float* lg = p.ln2_g + (l - 1) * D; const float* lb = p.ln2_b + (l - 1) * D;
        float s = 0.f;
#pragma unroll
        for (int i = 0; i < 4; ++i) {
            const int k = i * 256 + lane * 4;
            const float4 xv = *(const float4*)(xr + k); const float4 gv = *(const float4*)(g2 + k);
            const uint2 a = *(const uint2*)(y0 + k); const uint2 b = *(const uint2*)(y1 + k);
            float4 u;
            u.x = ALPHA * xv.x + gv.x * (bf2f((bf16_t)(a.x & 0xffff)) + bf2f((bf16_t)(b.x & 0xffff)));
            u.y = ALPHA * xv.y + gv.y * (bf2f((bf16_t)(a.x >> 16)) + bf2f((bf16_t)(b.x >> 16)));
            u.z = ALPHA * xv.z + gv.z * (bf2f((bf16_t)(a.y & 0xffff)) + bf2f((bf16_t)(b.y & 0xffff)));
            u.w = ALPHA * xv.w + gv.w * (bf2f((bf16_t)(a.y >> 16)) + bf2f((bf16_t)(b.y >> 16)));
            v[i] = u; s += (u.x + u.y) + (u.z + u.w);
        }
        const float mean = wave_sum(s) * (1.f / D);
        float q = 0.f;
#pragma unroll
        for (int i = 0; i < 4; ++i) { v[i].x -= mean; v[i].y -= mean; v[i].z -= mean; v[i].w -= mean; q += (v[i].x * v[i].x + v[i].y * v[i].y) + (v[i].z * v[i].z + v[i].w * v[i].w); }
        const float rstd = rsqrtf(wave_sum(q) * (1.f / D) + LN_EPS);
#pragma unroll
        for (int i = 0; i < 4; ++i) {
            const int k = i * 256 + lane * 4;
            const float4 gg = *(const float4*)(lg + k); const float4 bb = *(const float4*)(lb + k);
            v[i].x = v[i].x * rstd * gg.x + bb.x; v[i].y = v[i].y * rstd * gg.y + bb.y; v[i].z = v[i].z * rstd * gg.z + bb.z; v[i].w = v[i].w * rstd * gg.w + bb.w;
            *(float4*)(xr + k) = v[i];
        }
    }
    if (MODE != 2) {
        const float* sh = modvec(p, l, R, 0); const float* sc = modvec(p, l, R, 1);
        bf16_t* ha = (bf16_t*)(p.ws + OFF_X1) + (size_t)R * D;
#pragma unroll
        for (int i = 0; i < 4; ++i) {
            const int k = i * 256 + lane * 4;
            const float4 s4 = *(const float4*)(sh + k); const float4 c4 = *(const float4*)(sc + k);
            uint2 o; o.x = pk2(v[i].x * (1.f + c4.x) + s4.x, v[i].y * (1.f + c4.y) + s4.y); o.y = pk2(v[i].z * (1.f + c4.z) + s4.z, v[i].w * (1.f + c4.w) + s4.w);
            *(uint2*)(ha + k) = o;
        }
    }
}
template <int MODE> DEV void ph_rowop(const Params& p, int l, int nrows) {
    const int w = tid_() >> 6;
    for (int R = bid_() * 4 + w; R < nrows; R += gridDim.x * 4) rowop<MODE>(p, l, R);
}

constexpr int GEMM_STAGE_BYTES = 384 * 64;
constexpr int GEMM_NSTAGE = 3;
constexpr int GEMM_LDS_BYTES = GEMM_NSTAGE * GEMM_STAGE_BYTES;
#define LAS __attribute__((address_space(3)))
DEV int gemm_src_chunk(int t) { return ((t & 3) ^ ((0 - (t >> 4)) & 3)) * 8; }
DEV void gemm_mainloop(const bf16_t* Abase, unsigned ao0, unsigned ao1, const bf16_t* Bbase, unsigned bo, unsigned ldb, int nk, bf16_t* lds, f32x4 (&acc)[4][8]) {
    const int t = tid_(), lane = t & 63, w = __builtin_amdgcn_readfirstlane(t >> 6), wm = w >> 1, wn = w & 1;
    LAS unsigned char* L = (LAS unsigned char*)lds;
    const int pc = ((lane >> 4) ^ ((0 - ((lane & 15) >> 2)) & 3)) * 16;
    const int arow = (wm * 64 + (lane & 15)) * 64 + pc, brow = (128 + wn * 128 + (lane & 15)) * 64 + pc;
    const char* Ab = (const char*)Abase; const char* B0 = (const char*)Bbase; const char* B1 = B0 + (size_t)ldb * 128; const char* B2 = B0 + (size_t)ldb * 256; const char* B3 = B0 + (size_t)ldb * 384;
#define GEMM_ISSUE(slot, ko) do { LAS unsigned* d_ = (LAS unsigned*)(L + (slot) * GEMM_STAGE_BYTES + w * 1024); \
        __builtin_amdgcn_global_load_lds((const unsigned*)(Ab + (ao0 + (ko) * 2u)), d_, 16, 0, 0); \
        __builtin_amdgcn_global_load_lds((const unsigned*)(Ab + (ao1 + (ko) * 2u)), d_ + 1024, 16, 0, 0); \
        __builtin_amdgcn_global_load_lds((const unsigned*)(B0 + (bo + (ko) * 2u)), d_ + 2048, 16, 0, 0); \
        __builtin_amdgcn_global_load_lds((const unsigned*)(B1 + (bo + (ko) * 2u)), d_ + 3072, 16, 0, 0); \
        __builtin_amdgcn_global_load_lds((const unsigned*)(B2 + (bo + (ko) * 2u)), d_ + 4096, 16, 0, 0); \
        __builtin_amdgcn_global_load_lds((const unsigned*)(B3 + (bo + (ko) * 2u)), d_ + 5120, 16, 0, 0); } while (0)
    asm volatile("s_waitcnt vmcnt(0)" ::: "memory");
    __builtin_amdgcn_s_barrier();
    asm volatile("" ::: "memory");
    GEMM_ISSUE(0, 0);
    if (nk > 1) GEMM_ISSUE(1, 32);
    int cs = 0, is = 2;
    for (int kt = 0; kt < nk; ++kt) {
        if (kt + 1 < nk) asm volatile("s_waitcnt vmcnt(6)" ::: "memory"); else asm volatile("s_waitcnt vmcnt(0)" ::: "memory");
        __builtin_amdgcn_s_barrier();
        asm volatile("" ::: "memory");
        if (kt + 2 < nk) GEMM_ISSUE(is, (kt + 2) * 32);
        const LAS unsigned char* cur = L + cs * GEMM_STAGE_BYTES;
        const bf16x8 af0 = *(const LAS bf16x8*)(cur + arow), af1 = *(const LAS bf16x8*)(cur + arow + 16 * 64), af2 = *(const LAS bf16x8*)(cur + arow + 32 * 64), af3 = *(const LAS bf16x8*)(cur + arow + 48 * 64);
        bf16x8 bq0 = *(const LAS bf16x8*)(cur + brow), bq1 = *(const LAS bf16x8*)(cur + brow + 16 * 64);
#pragma unroll
        for (int nt = 0; nt < 8; ++nt) {
            const bf16x8 bfr = bq0; bq0 = bq1;
            if (nt + 2 < 8) bq1 = *(const LAS bf16x8*)(cur + brow + (nt + 2) * 16 * 64);
            acc[0][nt] = __builtin_amdgcn_mfma_f32_16x16x32_bf16(bfr, af0, acc[0][nt], 0, 0, 0);
            acc[1][nt] = __builtin_amdgcn_mfma_f32_16x16x32_bf16(bfr, af1, acc[1][nt], 0, 0, 0);
            acc[2][nt] = __builtin_amdgcn_mfma_f32_16x16x32_bf16(bfr, af2, acc[2][nt], 0, 0, 0);
            acc[3][nt] = __builtin_amdgcn_mfma_f32_16x16x32_bf16(bfr, af3, acc[3][nt], 0, 0, 0);
        }
        cs = cs == 2 ? 0 : cs + 1; is = is == 2 ? 0 : is + 1;
    }
#undef GEMM_ISSUE
}
DEV void zero_acc(f32x4 (&acc)[4][8]) {
#pragma unroll
    for (int a = 0; a < 4; ++a)
#pragma unroll
        for (int b = 0; b < 8; ++b) acc[a][b] = (f32x4){0.f, 0.f, 0.f, 0.f};
}

DEV void inproj_item(const Params& p_, int l, int rt, int pass, bf16_t* lds) {
    const Params& p = kp_();
    const int t = tid_(), lane = t & 63, w = t >> 6, wm = w >> 1, wn = w & 1;
    const bf16_t* A = (const bf16_t*)(p.ws + OFF_X1) + (size_t)(rt * 128) * D;
    const bf16_t* Bt = (const bf16_t*)(p.ws + OFF_WINT) + ((size_t)l * 2304 + pass * 256) * 1024;
    const unsigned toff = (unsigned)(((t >> 2) * 1024 + gemm_src_chunk(t)) * 2);
    f32x4 acc[4][8]; zero_acc(acc);
    gemm_mainloop(A, toff, toff + 64 * D * 2, Bt, toff, 1024, 32, lds, acc);
    bf16_t* P = (bf16_t*)(p.ws + OFF_P);
    const float* ctab = (const float*)(p.ws + OFF_ROPE); const float* stab = ctab + 2048;
    const bool isctx = rt >= 512;
    const int fq = lane >> 4, fr = lane & 15;
#pragma unroll
    for (int hci = 0; hci < 2; ++hci) {
        const int hc = pass * 4 + wn * 2 + hci;
        int type, dcol = 0, vh = 0;
        if (hc < 4) { type = 0; dcol = COL_RGX + hc * 64; }
        else if (hc < 10) { type = 4; vh = hc - 4; }
        else if (hc < 16) { type = 5; vh = hc - 10; }
        else if (hc < 18) { type = 6; vh = hc - 16; }
        else if (hc < 20) { type = 7; vh = hc - 18; }
        else if (hc < 24) { type = 0; dcol = COL_GATE + (hc - 20) * 64; }
        else if (hc < 30) { type = 1; dcol = COL_NAQ + (hc - 24) * 64; }
        else { type = 3; dcol = COL_GQ + (hc - 30) * 64; }
#pragma unroll
        for (int mt = 0; mt < 4; ++mt) {
            const int R = rt * 128 + wm * 64 + mt * 16 + fr;
            f32x4 v0 = acc[mt][hci * 4 + 0], v1 = acc[mt][hci * 4 + 1], v2 = acc[mt][hci * 4 + 2], v3 = acc[mt][hci * 4 + 3];
            if ((type == 3 || type == 6) && !isctx) {
                const int tt = R & (S - 1), pr = tt >> 6, pc = tt & 63;
                const f32x4 cr = *(const f32x4*)(ctab + pr * 16 + fq * 4), sr = *(const f32x4*)(stab + pr * 16 + fq * 4);
                const f32x4 cc = *(const f32x4*)(ctab + pc * 16 + fq * 4), sc = *(const f32x4*)(stab + pc * 16 + fq * 4);
                const f32x4 o0 = v0 * cr - v1 * sr, o1 = v1 * cr + v0 * sr, o2 = v2 * cc - v3 * sc, o3 = v3 * cc + v2 * sc;
                v0 = o0; v1 = o1; v2 = o2; v3 = o3;
            }
            if (type == 1 || type == 3) { v0 = v0 * 0.125f; v1 = v1 * 0.125f; v2 = v2 * 0.125f; v3 = v3 * 0.125f; }
            if (type < 4) {
                bf16_t* o = P + (size_t)R * PWS + dcol + fq * 4;
                uint2 q;
                q.x = pk2(v0[0], v0[1]); q.y = pk2(v0[2], v0[3]); *(uint2*)(o) = q;
                q.x = pk2(v1[0], v1[1]); q.y = pk2(v1[2], v1[3]); *(uint2*)(o + 16) = q;
                q.x = pk2(v2[0], v2[1]); q.y = pk2(v2[2], v2[3]); *(uint2*)(o + 32) = q;
                q.x = pk2(v3[0], v3[1]); q.y = pk2(v3[2], v3[3]); *(uint2*)(o + 48) = q;
            } else {
                const bool na = type < 6, isk = (type == 4 || type == 6);
                bf16_t* tb;
                if (!isctx) { const int b = R >> 13, tile = (R & (S - 1)) >> 4;
                    tb = (bf16_t*)(p.ws + (na ? (isk ? OFF_NAKF : OFF_NAVF) : (isk ? OFF_GKF : OFF_GVF))) + ((size_t)(b * (na ? 6 : 2) + vh) * 512 + tile) * KVT; }
                else { const int cR = R - NLAT, b = cR >> 8, tile = (cR & 255) >> 4;
                    tb = (bf16_t*)(p.ws + (na ? (isk ? OFF_NAKFC : OFF_NAVFC) : (isk ? OFF_GKFC : OFF_GVFC))) + ((size_t)(b * (na ? 6 : 2) + vh) * 16 + tile) * KVT; }
                if (isk) {
                    bf16_t* o = tb + ((fq >> 1) * 16 + fr) * 8 + (fq & 1) * 4;
                    uint2 q;
                    q.x = pk2(v0[0], v0[1]); q.y = pk2(v0[2], v0[3]); *(uint2*)(o) = q;
                    q.x = pk2(v1[0], v1[1]); q.y = pk2(v1[2], v1[3]); *(uint2*)(o + 2 * 16 * 8) = q;
                    q.x = pk2(v2[0], v2[1]); q.y = pk2(v2[2], v2[3]); *(uint2*)(o + 512) = q;
                    q.x = pk2(v3[0], v3[1]); q.y = pk2(v3[2], v3[3]); *(uint2*)(o + 512 + 2 * 16 * 8) = q;
                } else {
                    bf16_t* o = tb + ((fr >> 2) * 16 + fq * 4) * 8 + (fr & 3);
#pragma unroll
                    for (int j = 0; j < 4; ++j) {
                        o[j * 8] = f2bf(v0[j]); o[j * 8 + 4] = f2bf(v1[j]); o[512 + j * 8] = f2bf(v2[j]); o[512 + j * 8 + 4] = f2bf(v3[j]);
                    }
                }
            }
        }
    }
}
DEV void ph_inproj(const Params& p, int l, bf16_t* lds) {
    const int nctxp = (l == 0) ? 9 : 5;
    const int nx = gridDim.x >> 3, xcd = bid_() & 7, j = bid_() >> 3;
    const int nloc = 64 * 9 + 2 * nctxp;
    if (bid_() >= nx * 8) return;
    for (int i0 = j; i0 < nloc * ((PROBE_ID) == 3 ? PROBE_N : 1); i0 += nx) {
        const int i = i0 % nloc;
        int rt, pass;
        if (i < 64 * 9) { rt = xcd * 64 + i / 9; pass = i % 9; } else { const int r = i - 64 * 9; rt = 512 + 2 * xcd + r / nctxp; pass = r % nctxp; }
        inproj_item(p, l, rt, pass, lds);
    }
}

constexpr float LOG2E = 1.4426950408889634f;
struct AttnState { f32x4 o0, o1, o2, o3; float m, lsum; };
struct KVFrag { bf16x8 k00, k01, k10, k11, v0, v1, v2, v3; };
DEV bf16x8 ld16(const bf16_t* p) { return *(const bf16x8*)p; }
DEV bf16x8 lohi(const uint4& a, const uint4& b, int hi) { union { uint4 u; bf16x8 v; } c; c.u = hi ? make_uint4(a.z, a.w, b.z, b.w) : make_uint4(a.x, a.y, b.x, b.y); return c.v; }
DEV void kv_load(const bf16_t* kt0, const bf16_t* kt1, const bf16_t* vt0, const bf16_t* vt1, KVFrag& f) {
    f.k00 = ld16(kt0); f.k01 = ld16(kt0 + 512); f.k10 = ld16(kt1); f.k11 = ld16(kt1 + 512);
    const uint4 a0 = *(const uint4*)vt0, a1 = *(const uint4*)(vt0 + 512), b0 = *(const uint4*)vt1, b1 = *(const uint4*)(vt1 + 512);
    f.v0 = lohi(a0, b0, 0); f.v1 = lohi(a0, b0, 1); f.v2 = lohi(a1, b1, 0); f.v3 = lohi(a1, b1, 1);
}
DEV void attn_apply(const KVFrag& f, const bf16x8& q0, const bf16x8& q1, f32x4 b0, f32x4 b1, AttnState& st) {
    const f32x4 z = {0.f, 0.f, 0.f, 0.f};
    f32x4 s0 = __builtin_amdgcn_mfma_f32_16x16x32_bf16(f.k00, q0, z, 0, 0, 0); s0 = __builtin_amdgcn_mfma_f32_16x16x32_bf16(f.k01, q1, s0, 0, 0, 0);
    f32x4 s1 = __builtin_amdgcn_mfma_f32_16x16x32_bf16(f.k10, q0, z, 0, 0, 0); s1 = __builtin_amdgcn_mfma_f32_16x16x32_bf16(f.k11, q1, s1, 0, 0, 0);
    s0 = s0 * LOG2E + b0; s1 = s1 * LOG2E + b1;
    float mx = fmaxf(fmaxf(fmaxf(s0[0], s0[1]), fmaxf(s0[2], s0[3])), fmaxf(fmaxf(s1[0], s1[1]), fmaxf(s1[2], s1[3])));
    mx = fmaxf(mx, shx(mx, 16)); mx = fmaxf(mx, shx(mx, 32));
    const float mn = fmaxf(st.m, mx);
    const float ms = (mn == -INFINITY) ? 0.f : mn;
    const float alpha = __builtin_amdgcn_exp2f(st.m - ms);
    f32x4 p0, p1;
#pragma unroll
    for (int j = 0; j < 4; ++j) { p0[j] = __builtin_amdgcn_exp2f(s0[j] - ms); p1[j] = __builtin_amdgcn_exp2f(s1[j] - ms); }
    st.lsum = st.lsum * alpha + ((p0[0] + p0[1]) + (p0[2] + p0[3])) + ((p1[0] + p1[1]) + (p1[2] + p1[3]));
    st.o0 = st.o0 * alpha; st.o1 = st.o1 * alpha; st.o2 = st.o2 * alpha; st.o3 = st.o3 * alpha;
    union { uint4 u; bf16x8 v; } pt; pt.u = make_uint4(pk2(p0[0], p0[1]), pk2(p0[2], p0[3]), pk2(p1[0], p1[1]), pk2(p1[2], p1[3]));
    st.o0 = __builtin_amdgcn_mfma_f32_16x16x32_bf16(f.v0, pt.v, st.o0, 0, 0, 0);
    st.o1 = __builtin_amdgcn_mfma_f32_16x16x32_bf16(f.v1, pt.v, st.o1, 0, 0, 0);
    st.o2 = __builtin_amdgcn_mfma_f32_16x16x32_bf16(f.v2, pt.v, st.o2, 0, 0, 0);
    st.o3 = __builtin_amdgcn_mfma_f32_16x16x32_bf16(f.v3, pt.v, st.o3, 0, 0, 0);
    st.m = mn;
}
DEV void attn_init(AttnState& st) { const f32x4 z = {0.f, 0.f, 0.f, 0.f}; st.o0 = z; st.o1 = z; st.o2 = z; st.o3 = z; st.m = -INFINITY; st.lsum = 0.f; }
DEV void attn_store(AttnState& st, bf16_t* orow, float sink2  ) {
    float l = st.lsum; l += shx(l, 16); l += shx(l, 32);
    float sc;
    if (sink2 != -INFINITY) { const float mf = fmaxf(st.m, sink2); const float al = __builtin_amdgcn_exp2f(st.m - mf); l = l * al + __builtin_amdgcn_exp2f(sink2 - mf); sc = al / l; }
    else sc = 1.f / l;
    uint2 w;
    w.x = pk2(st.o0[0] * sc, st.o0[1] * sc); w.y = pk2(st.o0[2] * sc, st.o0[3] * sc); *(uint2*)(orow) = w;
    w.x = pk2(st.o1[0] * sc, st.o1[1] * sc); w.y = pk2(st.o1[2] * sc, st.o1[3] * sc); *(uint2*)(orow + 16) = w;
    w.x = pk2(st.o2[0] * sc, st.o2[1] * sc); w.y = pk2(st.o2[2] * sc, st.o2[3] * sc); *(uint2*)(orow + 32) = w;
    w.x = pk2(st.o3[0] * sc, st.o3[1] * sc); w.y = pk2(st.o3[2] * sc, st.o3[3] * sc); *(uint2*)(orow + 48) = w;
}

constexpr int NTASK_NA = NB * 6 * 128 * 4, NTASK_GQ = NB * 2 * 512, NTASK_CNA = NB * 6 * 16, NTASK_CGQ = NB * 2 * 16;
DEV void attn_task(const Params& p, int l, int tk, const float* rpb2  ) {
    const int lane = tid_() & 63, g = lane >> 4, fr = lane & 15;
    const bf16_t* P = (const bf16_t*)(p.ws + OFF_P);
    bf16_t* X1 = (bf16_t*)(p.ws + OFF_X1);
    const f32x4 z4 = {0.f, 0.f, 0.f, 0.f};
    KVFrag f;
    if (tk < NTASK_NA) {
        const int qtile = tk & 3, r = (tk >> 2) & 127, hb = tk >> 9, h = hb % 6, b = hb / 6;
        const int qc = qtile == 0 ? (fr < 8 ? fr : 48 + fr) : 8 + (qtile - 1) * 16 + fr;
        const int ct0 = qtile == 0 ? 0 : qtile - 1, ct1 = qtile == 0 ? 3 : qtile;
        const int R = b * S + r * 64 + qc;
        const bf16_t* qp = P + (size_t)R * PWS + COL_NAQ + h * 64 + g * 8;
        const bf16x8 q0 = ld16(qp), q1 = ld16(qp + 32);
        const int rs = min(max(r - 4, 0), 120), cs = min(max(qc - 8, 0), 48);
        int ci[8]; bool ok[8];
#pragma unroll
        for (int e = 0; e < 8; ++e) { const int kc = ((e >> 2) ? ct1 : ct0) * 16 + g * 4 + (e & 3); ok[e] = (kc >= cs) && (kc < cs + 16); ci[e] = min(max(kc - qc + 15, 0), 30); }
        const bf16_t* kf = (const bf16_t*)(p.ws + OFF_NAKF) + ((size_t)(b * 6 + h) * 512 + rs * 4) * KVT + lane * 8;
        const bf16_t* vf = (const bf16_t*)(p.ws + OFF_NAVF) + ((size_t)(b * 6 + h) * 512 + rs * 4) * KVT + lane * 8;
        AttnState st; attn_init(st);
#pragma unroll
        for (int ri = 0; ri < 8; ++ri) {
            const float* rb = rpb2 + (h * 15 + (rs + ri - r + 7)) * 31;
            f32x4 b0, b1;
#pragma unroll
            for (int j = 0; j < 4; ++j) { b0[j] = ok[j] ? rb[ci[j]] : -INFINITY; b1[j] = ok[4 + j] ? rb[ci[4 + j]] : -INFINITY; }
            kv_load(kf + (size_t)(ri * 4 + ct0) * KVT, kf + (size_t)(ri * 4 + ct1) * KVT, vf + (size_t)(ri * 4 + ct0) * KVT, vf + (size_t)(ri * 4 + ct1) * KVT, f);
            attn_apply(f, q0, q1, b0, b1, st);
        }
        const bf16_t* kc_ = (const bf16_t*)(p.ws + OFF_NAKFC) + (size_t)(b * 6 + h) * 16 * KVT + lane * 8;
        const bf16_t* vc_ = (const bf16_t*)(p.ws + OFF_NAVFC) + (size_t)(b * 6 + h) * 16 * KVT + lane * 8;
#pragma unroll
        for (int pp = 0; pp < 8; ++pp) { kv_load(kc_ + (size_t)(2 * pp) * KVT, kc_ + (size_t)(2 * pp + 1) * KVT, vc_ + (size_t)(2 * pp) * KVT, vc_ + (size_t)(2 * pp + 1) * KVT, f); attn_apply(f, q0, q1, z4, z4, st); }
        attn_store(st, X1 + (size_t)R * D + 256 + h * 64 + g * 4, -INFINITY);
    } else if (tk < NTASK_NA + NTASK_GQ + NTASK_CNA + NTASK_CGQ && (tk < NTASK_NA + NTASK_GQ || tk >= NTASK_NA + NTASK_GQ + NTASK_CNA)) {
        const bool lat = tk < NTASK_NA + NTASK_GQ;
        const int t2 = lat ? tk - NTASK_NA : tk - (NTASK_NA + NTASK_GQ + NTASK_CNA);
        const int qt = lat ? (t2 & 511) : (t2 & 15), hb = lat ? (t2 >> 9) : (t2 >> 4), kvh = hb & 1, b = hb >> 1;
        const int q0i = qt * 16, R = (lat ? b * S : NLAT + b * CTX) + q0i + fr;
        const bf16_t* qp = P + (size_t)R * PWS + COL_GQ + kvh * 192 + g * 8;
        const bf16x8 qa0 = ld16(qp), qa1 = ld16(qp + 32), qb0 = ld16(qp + 64), qb1 = ld16(qp + 96), qc0 = ld16(qp + 128), qc1 = ld16(qp + 160);
        AttnState sa, sb, sc; attn_init(sa); attn_init(sb); attn_init(sc);
        const bf16_t* kf = (const bf16_t*)(p.ws + OFF_GKF) + (size_t)(b * 2 + kvh) * 512 * KVT + lane * 8;
        const bf16_t* vf = (const bf16_t*)(p.ws + OFF_GVF) + (size_t)(b * 2 + kvh) * 512 * KVT + lane * 8;
        const bf16_t* kc_ = (const bf16_t*)(p.ws + OFF_GKFC) + (size_t)(b * 2 + kvh) * 16 * KVT + lane * 8;
        const bf16_t* vc_ = (const bf16_t*)(p.ws + OFF_GVFC) + (size_t)(b * 2 + kvh) * 16 * KVT + lane * 8;
        const int qi = q0i + fr;
#define GQ_LOAD(i, F) do { const int i_ = (i); if (i_ < 9) { const int kt_ = (q0i - 128 + i_ * 32) >> 4; const int ta_ = min(max(kt_, 0), 511), tb_ = min(max(kt_ + 1, 0), 511); \
            kv_load(kf + (size_t)ta_ * KVT, kf + (size_t)tb_ * KVT, vf + (size_t)ta_ * KVT, vf + (size_t)tb_ * KVT, F); } \
        else { const int c_ = (i_ - 9) * 2; kv_load(kc_ + (size_t)c_ * KVT, kc_ + (size_t)(c_ + 1) * KVT, vc_ + (size_t)c_ * KVT, vc_ + (size_t)(c_ + 1) * KVT, F); } } while (0)
#define GQ_APPLY(i, F) do { const int i_ = (i); f32x4 b0_ = z4, b1_ = z4; if (i_ < 9) { const int kb_ = q0i - 128 + i_ * 32; _Pragma("unroll") for (int j = 0; j < 4; ++j) { const int k0_ = kb_ + g * 4 + j, k1_ = k0_ + 16; \
                b0_[j] = (k0_ >= 0 && k0_ < S && k0_ >= qi - 128 && k0_ <= qi + 128) ? 0.f : -INFINITY; b1_[j] = (k1_ >= 0 && k1_ < S && k1_ >= qi - 128 && k1_ <= qi + 128) ? 0.f : -INFINITY; } } \
            attn_apply(F, qa0, qa1, b0_, b1_, sa); attn_apply(F, qb0, qb1, b0_, b1_, sb); attn_apply(F, qc0, qc1, b0_, b1_, sc); } while (0)
        KVFrag f2;
        const int i0 = lat ? 0 : 9;
        GQ_LOAD(i0, f);
#pragma unroll 1
        for (int i = i0; i < 17; i += 2) {
            if (i + 1 < 17) GQ_LOAD(i + 1, f2);
            GQ_APPLY(i, f);
            if (i + 1 < 17) { if (i + 2 < 17) GQ_LOAD(i + 2, f); GQ_APPLY(i + 1, f2); }
        }
#undef GQ_LOAD
#undef GQ_APPLY
        bf16_t* o = X1 + (size_t)R * D + 640 + kvh * 192 + g * 4;
        attn_store(sa, o, p.gqa_sink[l * 6 + kvh * 3 + 0] * LOG2E); attn_store(sb, o + 64, p.gqa_sink[l * 6 + kvh * 3 + 1] * LOG2E); attn_store(sc, o + 128, p.gqa_sink[l * 6 + kvh * 3 + 2] * LOG2E);
    } else {
        const int t3 = tk - NTASK_NA - NTASK_GQ, qt = t3 & 15, hb = t3 >> 4, h = hb % 6, b = hb / 6;
        const int R = NLAT + b * CTX + qt * 16 + fr;
        const bf16_t* qp = P + (size_t)R * PWS + COL_NAQ + h * 64 + g * 8;
        const bf16x8 q0 = ld16(qp), q1 = ld16(qp + 32);
        AttnState st; attn_init(st);
        const bf16_t* kc_ = (const bf16_t*)(p.ws + OFF_NAKFC) + (size_t)(b * 6 + h) * 16 * KVT + lane * 8;
        const bf16_t* vc_ = (const bf16_t*)(p.ws + OFF_NAVFC) + (size_t)(b * 6 + h) * 16 * KVT + lane * 8;
#pragma unroll
        for (int pp = 0; pp < 8; ++pp) { kv_load(kc_ + (size_t)(2 * pp) * KVT, kc_ + (size_t)(2 * pp + 1) * KVT, vc_ + (size_t)(2 * pp) * KVT, vc_ + (size_t)(2 * pp + 1) * KVT, f); attn_apply(f, q0, q1, z4, z4, st); }
        attn_store(st, X1 + (size_t)R * D + 256 + h * 64 + g * 4, -INFINITY);
    }
}
DEV void ph_attn(const Params& p, int l, float* rpb2  ) {
    for (int i = tid_(); i < 6 * 15 * 31; i += 256) rpb2[i] = p.na_rpb[(size_t)l * 6 * 15 * 31 + i] * LOG2E;
    __syncthreads();
    const int w = tid_() >> 6;
    const int ntask = NTASK_NA + NTASK_GQ + (l == 0 ? NTASK_CNA + NTASK_CGQ : 0);
    for (int tk0 = bid_() * 4 + w; tk0 < ntask; tk0 += gridDim.x * 4) {
        const int tk = tk0 < NTASK_GQ ? NTASK_NA + tk0 : (tk0 < NTASK_GQ + NTASK_NA ? tk0 - NTASK_GQ : tk0);
        attn_task(p, l, tk, rpb2);
    }
}

template <int CTRL> DEV float dppf(float old, float v) { return __builtin_bit_cast(float, __builtin_amdgcn_update_dpp(__builtin_bit_cast(int, old), __builtin_bit_cast(int, v), CTRL, 0xf, 0xf, false)); }
template <bool FWD> DEV void row_scan(float& a, float& b) {
#define RG_STEP(SHR, SHL) { const float ap = FWD ? dppf<SHR>(1.f, a) : dppf<SHL>(1.f, a); const float bp = FWD ? dppf<SHR>(0.f, b) : dppf<SHL>(0.f, b); b = fmaf(a, bp, b); a = a * ap; }
    RG_STEP(0x111, 0x101) RG_STEP(0x112, 0x102) RG_STEP(0x114, 0x104) RG_STEP(0x118, 0x108)
#undef RG_STEP
}
DEV int rg_bwd_chunk(int pos) { return pos == 0 ? 1 : (pos == 1 ? 0 : 67 - pos); }
DEV void rg_coef(const f32x4& za, const f32x4& zi, const f32x4& ba, const f32x4& bi, const f32x4& spc, const f32x4& xv, f32x4& a, f32x4& b) {
#pragma unroll
    for (int j = 0; j < 4; ++j) {
        const float r = 1.f / (1.f + __expf(-(za[j] + ba[j])));
        const float ig = 1.f / (1.f + __expf(-(zi[j] + bi[j])));
        const float la = spc[j] * r;
        const float av = __expf(la);
        const float x2 = 2.f * la;
        float om = x2 * (1.f / 720.f) + (1.f / 120.f); om = om * x2 + (1.f / 24.f); om = om * x2 + (1.f / 6.f); om = om * x2 + 0.5f; om = om * x2 + 1.f; om = -x2 * om;
        if (x2 < -0.25f) om = 1.f - av * av;
        a[j] = av; b[j] = sqrtf(om) * (ig * xv[j]);
    }
}
template <bool FINAL> DEV void rg_item(const Params& p, int l, int rt, bf16_t* lds) {
    const int t = tid_(), lane = t & 63, n = t >> 6, g = lane >> 4, fr = lane & 15;
    const bf16_t* P = (const bf16_t*)(p.ws + OFF_P);
    const bool isctx = rt >= 512;
    const int b = isctx ? (rt - 512) >> 1 : rt >> 6, idx = isctx ? (rt - 512) & 1 : 2 + (rt & 63);
    const int L = isctx ? CTX : S, t0 = isctx ? idx * 128 : (idx - 2) * 128, seqbase = isctx ? NLAT + b * CTX : b * S;
    bf16_t* xl = lds + n * (128 * 64);
    {
        const int c = lane & 7, ch0 = n * 64 + c * 8;
        f32x4 cwa[4], cwb[4];
#pragma unroll
        for (int j = 0; j < 4; ++j) { cwa[j] = *(const f32x4*)(p.conv_w + (l * 4 + j) * 256 + ch0); cwb[j] = *(const f32x4*)(p.conv_w + (l * 4 + j) * 256 + ch0 + 4); }
        const f32x4 cba = *(const f32x4*)(p.conv_b + l * 256 + ch0), cbb = *(const f32x4*)(p.conv_b + l * 256 + ch0 + 4);
#pragma unroll 2
        for (int it = 0; it < 16; ++it) {
            const int tok = it * 8 + (lane >> 3), ts = t0 + tok;
            f32x4 acca = cba, accb = cbb;
#pragma unroll
            for (int j = 0; j < 4; ++j) {
                const int tj = ts + j - 2;
                if (tj >= 0 && tj < L) {
                    const uint4 v = *(const uint4*)(P + (size_t)(seqbase + tj) * PWS + COL_RGX + ch0);
                    const f32x4 xa = {__uint_as_float(v.x << 16), __uint_as_float(v.x & 0xffff0000u), __uint_as_float(v.y << 16), __uint_as_float(v.y & 0xffff0000u)};
                    const f32x4 xb = {__uint_as_float(v.z << 16), __uint_as_float(v.z & 0xffff0000u), __uint_as_float(v.w << 16), __uint_as_float(v.w & 0xffff0000u)};
                    acca = acca + cwa[j] * xa; accb = accb + cwb[j] * xb;
                }
            }
            uint4 o; o.x = pk2(acca[0], acca[1]); o.y = pk2(acca[2], acca[3]); o.z = pk2(accb[0], accb[1]); o.w = pk2(accb[2], accb[3]);
            *(uint4*)(xl + tok * 64 + ((c ^ ((tok >> 1) & 7)) * 8)) = o;
        }
    }
    asm volatile("s_waitcnt lgkmcnt(0)" ::: "memory");
    const bf16_t* W = (const bf16_t*)(p.ws + OFF_WRG) + (size_t)(l * 2) * 2 * 4 * 64 * 64;
    const float* C = (const float*)(p.ws + OFF_RGC) + (size_t)(l * 2) * 3 * 256;
    float* AGG = (float*)(p.ws + OFF_AGG) + (size_t)(b * 66) * 1024;
    const int swz = (fr >> 1) & 7;
#pragma unroll 1
    for (int ct = 0; ct < 4; ++ct) {
        const int ch = n * 64 + ct * 16 + g * 4;
        f32x4 hf0, hf1, hf2, hf3, hf4, hf5, hf6, hf7;
        const f32x4 z4 = {0.f, 0.f, 0.f, 0.f};
        hf0 = z4; hf1 = z4; hf2 = z4; hf3 = z4; hf4 = z4; hf5 = z4; hf6 = z4; hf7 = z4;
#pragma unroll
        for (int dir = 0; dir < 2; ++dir) {
            const bf16x8 wa0 = ld16(W + ((size_t)((dir * 2 + 0) * 4 + n) * 64 + ct * 16 + fr) * 64 + g * 8), wa1 = ld16(W + ((size_t)((dir * 2 + 0) * 4 + n) * 64 + ct * 16 + fr) * 64 + 32 + g * 8);
            const bf16x8 wi0 = ld16(W + ((size_t)((dir * 2 + 1) * 4 + n) * 64 + ct * 16 + fr) * 64 + g * 8), wi1 = ld16(W + ((size_t)((dir * 2 + 1) * 4 + n) * 64 + ct * 16 + fr) * 64 + 32 + g * 8);
            const f32x4 ba = *(const f32x4*)(C + (dir * 3 + 0) * 256 + ch), bi = *(const f32x4*)(C + (dir * 3 + 1) * 256 + ch), spc = *(const f32x4*)(C + (dir * 3 + 2) * 256 + ch);
            f32x4 hin = z4, atot = {1.f, 1.f, 1.f, 1.f};
            if (FINAL) {
                const int npre = dir == 0 ? idx : (idx == 1 ? 0 : (idx == 0 ? 1 : 67 - idx));
#pragma unroll 4
                for (int q = 0; q < npre; ++q) {
                    const int cq = dir == 0 ? q : rg_bwd_chunk(q);
                    const f32x4 A = *(const f32x4*)(AGG + (size_t)(cq * 2 + dir) * 512 + ch), B = *(const f32x4*)(AGG + (size_t)(cq * 2 + dir) * 512 + 256 + ch);
                    hin = A * hin + B;
                }
            }
#pragma unroll
            for (int s = 0; s < 8; ++s) {
                const int tt = dir == 0 ? s : 7 - s;
                const int row = tt * 16 + fr;
                const bf16x8 x0 = *(const bf16x8*)(xl + row * 64 + ((g ^ swz) * 8)), x1 = *(const bf16x8*)(xl + row * 64 + (((g | 4) ^ swz) * 8));
                f32x4 za = __builtin_amdgcn_mfma_f32_16x16x32_bf16(wa0, x0, z4, 0, 0, 0); za = __builtin_amdgcn_mfma_f32_16x16x32_bf16(wa1, x1, za, 0, 0, 0);
                f32x4 zi = __builtin_amdgcn_mfma_f32_16x16x32_bf16(wi0, x0, z4, 0, 0, 0); zi = __builtin_amdgcn_mfma_f32_16x16x32_bf16(wi1, x1, zi, 0, 0, 0);
                const uint2 xr = *(const uint2*)(xl + row * 64 + (((ct * 2 + (g >> 1)) ^ swz) * 8) + (g & 1) * 4);
                const f32x4 xv = {__uint_as_float(xr.x << 16), __uint_as_float(xr.x & 0xffff0000u), __uint_as_float(xr.y << 16), __uint_as_float(xr.y & 0xffff0000u)};
                f32x4 a, bb;
                rg_coef(za, zi, ba, bi, spc, xv, a, bb);
                f32x4 h;
#pragma unroll
                for (int j = 0; j < 4; ++j) {
                    float aj = a[j], bj = bb[j];
                    if (dir == 0) row_scan<true>(aj, bj); else row_scan<false>(aj, bj);
                    h[j] = fmaf(aj, hin[j], bj);
                    atot[j] *= aj;
                }
                const int src = (lane & 48) | (dir == 0 ? 15 : 0);
#pragma unroll
                for (int j = 0; j < 4; ++j) hin[j] = shl_(h[j], src);
                if (FINAL) {
                    if (dir == 0) {
                        if (tt == 0) hf0 = h; else if (tt == 1) hf1 = h; else if (tt == 2) hf2 = h; else if (tt == 3) hf3 = h; else if (tt == 4) hf4 = h; else if (tt == 5) hf5 = h; else if (tt == 6) hf6 = h; else hf7 = h;
                    } else {
                        const f32x4 hfv = tt == 0 ? hf0 : tt == 1 ? hf1 : tt == 2 ? hf2 : tt == 3 ? hf3 : tt == 4 ? hf4 : tt == 5 ? hf5 : tt == 6 ? hf6 : hf7;
                        const size_t R = (size_t)seqbase + t0 + row;
                        const uint2 gr = *(const uint2*)(P + R * PWS + COL_GATE + ch);
                        const f32x4 hs = hfv + h;
                        uint2 o;
                        o.x = pk2(hs[0] * gelu_tanh(__uint_as_float(gr.x << 16)), hs[1] * gelu_tanh(__uint_as_float(gr.x & 0xffff0000u)));
                        o.y = pk2(hs[2] * gelu_tanh(__uint_as_float(gr.y << 16)), hs[3] * gelu_tanh(__uint_as_float(gr.y & 0xffff0000u)));
                        *(uint2*)((bf16_t*)(p.ws + OFF_X1) + R * D + ch) = o;
                    }
                }
            }
            if (!FINAL) {
                if (fr == (dir == 0 ? 15 : 0)) { *(f32x4*)(AGG + (size_t)(idx * 2 + dir) * 512 + ch) = atot; *(f32x4*)(AGG + (size_t)(idx * 2 + dir) * 512 + 256 + ch) = hin; }
            }
        }
    }
}
DEV void ph_rgagg(const Params& p, int l, bf16_t* lds) {
    for (int rt = bid_(); rt < 528; rt += gridDim.x) { rg_item<false>(p, l, rt, lds); __syncthreads(); }
}

DEV void outproj_item(const Params& p_, int l, int rt, bf16_t* lds, float* stat  ) {
    const Params& p = kp_();
    const int t = tid_(), lane = t & 63, w = t >> 6, wm = w >> 1, wn = w & 1, fq = lane >> 4, fr = lane & 15;
    const bf16_t* A = (const bf16_t*)(p.ws + OFF_X1) + (size_t)(rt * 128) * D;
    const bool isctx = rt >= 512;
    const float* g1 = modvec(p, l, rt * 128, 2);
    rg_item<true>(p, l, rt, lds);
    __threadfence();
    __syncthreads();
    __builtin_amdgcn_fence(__ATOMIC_ACQUIRE, "agent");
#pragma unroll 1
    for (int pass = 0; pass < 4; ++pass) {
        const bf16_t* Bt = (const bf16_t*)(p.ws + OFF_WOUTT) + ((size_t)l * 1024 + pass * 256) * 1024;
        const unsigned toff = (unsigned)(((tid_() >> 2) * 1024 + gemm_src_chunk(tid_())) * 2);
        f32x4 acc[4][8]; zero_acc(acc);
        gemm_mainloop(A, toff, toff + 64 * D * 2, Bt, toff, 1024, 32, lds, acc);
#pragma unroll
        for (int mt = 0; mt < 4; ++mt) {
            const int rl = wm * 64 + mt * 16 + fr, R = rt * 128 + rl;
            const float* xin = (l == 0) ? (isctx ? p.ctx + (size_t)(R - NLAT) * D : p.x + (size_t)R * D) : xres_row(p, R);
            float* xo = xres_row(p, R);
            float s = 0.f, q = 0.f;
#pragma unroll
            for (int nt = 0; nt < 8; ++nt) {
                const int col = pass * 256 + wn * 128 + nt * 16 + fq * 4;
                const f32x4 xv = *(const f32x4*)(xin + col), gv = *(const f32x4*)(g1 + col);
                const f32x4 u = xv * ALPHA + gv * acc[mt][nt];
                *(f32x4*)(xo + col) = u;
                s += (u[0] + u[1]) + (u[2] + u[3]); q += (u[0] * u[0] + u[1] * u[1]) + (u[2] * u[2] + u[3] * u[3]);
            }
            s += shx(s, 16); s += shx(s, 32); q += shx(q, 16); q += shx(q, 32);
            if (fq == 0) { float* sp = stat + (wn * 128 + rl) * 2; if (pass == 0) { sp[0] = s; sp[1] = q; } else { sp[0] += s; sp[1] += q; } }
        }
    }
    __threadfence();
    __syncthreads();
    __builtin_amdgcn_fence(__ATOMIC_ACQUIRE, "agent");
    {
        const float* lg = p.ln1_g + l * D; const float* lb = p.ln1_b + l * D;
        const float* sh2 = modvec(p, l, rt * 128, 3); const float* sc2 = modvec(p, l, rt * 128, 4);
        bf16_t* X2 = (bf16_t*)(p.ws + OFF_X2);
        const bf16_t* WRh = (const bf16_t*)(p.ws + OFF_WR) + (size_t)(l * 2) * 48 * 1024 + (size_t)fr * 1024 + fq * 8;
        const bf16_t* WRl = WRh + 48 * 1024;
        float mean[2], rstd[2];
#pragma unroll
        for (int tm = 0; tm < 2; ++tm) {
            const int rl = w * 32 + tm * 16 + fr;
            float s = 0.f, q = 0.f;
#pragma unroll
            for (int i = 0; i < 2; ++i) { s += stat[(i * 128 + rl) * 2]; q += stat[(i * 128 + rl) * 2 + 1]; }
            mean[tm] = s * (1.f / D);
            rstd[tm] = rsqrtf(fmaxf(q * (1.f / D) - mean[tm] * mean[tm], 0.f) + LN_EPS);
        }
        f32x4 lacc[3][2];
#pragma unroll
        for (int a = 0; a < 3; ++a) { lacc[a][0] = (f32x4){0.f, 0.f, 0.f, 0.f}; lacc[a][1] = (f32x4){0.f, 0.f, 0.f, 0.f}; }
#pragma unroll 2
        for (int ks = 0; ks < 32; ++ks) {
            const int k = ks * 32 + fq * 8;
            const f32x4 g0 = *(const f32x4*)(lg + k), g1v = *(const f32x4*)(lg + k + 4), b0 = *(const f32x4*)(lb + k), b1 = *(const f32x4*)(lb + k + 4);
            const f32x4 s0 = *(const f32x4*)(sh2 + k), s1 = *(const f32x4*)(sh2 + k + 4), c0 = *(const f32x4*)(sc2 + k), c1 = *(const f32x4*)(sc2 + k + 4);
            bf16x8 hh[2], hl[2];
#pragma unroll
            for (int tm = 0; tm < 2; ++tm) {
                const int R = rt * 128 + w * 32 + tm * 16 + fr;
                float* xr = xres_row(p, R) + k;
                const f32x4 u0 = *(const f32x4*)xr, u1 = *(const f32x4*)(xr + 4);
                const f32x4 x0 = (u0 - mean[tm]) * rstd[tm] * g0 + b0, x1 = (u1 - mean[tm]) * rstd[tm] * g1v + b1;
                *(f32x4*)xr = x0; *(f32x4*)(xr + 4) = x1;
                const f32x4 h0 = x0 * (c0 + 1.f) + s0, h1 = x1 * (c1 + 1.f) + s1;
#pragma unroll
                for (int e = 0; e < 4; ++e) {
                    const bf16_t a = f2bf(h0[e]), b = f2bf(h1[e]);
                    hh[tm][e] = (short)a; hh[tm][4 + e] = (short)b;
                    hl[tm][e] = (short)f2bf(h0[e] - bf2f(a)); hl[tm][4 + e] = (short)f2bf(h1[e] - bf2f(b));
                }
                *(bf16x8*)(X2 + (size_t)R * D + k) = hh[tm];
            }
#pragma unroll
            for (int ft = 0; ft < 3; ++ft) {
                const bf16x8 wh = *(const bf16x8*)(WRh + (size_t)ft * 16 * 1024 + ks * 32), wl = *(const bf16x8*)(WRl + (size_t)ft * 16 * 1024 + ks * 32);
#pragma unroll
                for (int tm = 0; tm < 2; ++tm) {
                    lacc[ft][tm] = __builtin_amdgcn_mfma_f32_16x16x32_bf16(wh, hh[tm], lacc[ft][tm], 0, 0, 0);
                    lacc[ft][tm] = __builtin_amdgcn_mfma_f32_16x16x32_bf16(wl, hh[tm], lacc[ft][tm], 0, 0, 0);
                    lacc[ft][tm] = __builtin_amdgcn_mfma_f32_16x16x32_bf16(wh, hl[tm], lacc[ft][tm], 0, 0, 0);
                }
            }
        }
        float* lt = (float*)lds;
#pragma unroll
        for (int ft = 0; ft < 3; ++ft)
#pragma unroll
            for (int tm = 0; tm < 2; ++tm)
#pragma unroll
                for (int j = 0; j < 4; ++j) lt[(w * 32 + tm * 16 + fr) * 48 + ft * 16 + fq * 4 + j] = lacc[ft][tm][j];
        asm volatile("s_waitcnt lgkmcnt(0)" ::: "memory");
        if (lane < 32) {
            const int rl = w * 32 + lane, R = rt * 128 + rl;
            const float* lr = lt + rl * 48;
            int gi = 0; float gm = lr[0] + p.router_g_b[l * 4];
            float gl[4]; gl[0] = gm;
#pragma unroll
            for (int j = 1; j < 4; ++j) { gl[j] = lr[j] + p.router_g_b[l * 4 + j]; if (gl[j] > gm) { gm = gl[j]; gi = j; } }
            float gs = 0.f;
#pragma unroll
            for (int j = 0; j < 4; ++j) gs += expf(gl[j] - gm);
            const float ptop = 1.f / gs;
            int e0 = 0, e1 = 0; float m0 = -INFINITY, m1 = -INFINITY;
            for (int j = 0; j < 8; ++j) {
                const float v = lr[4 + gi * 8 + j] + p.router_e_b[l * 32 + gi * 8 + j];
                if (v > m0) { m1 = m0; e1 = e0; m0 = v; e0 = j; } else if (v > m1) { m1 = v; e1 = j; }
            }
            const float ex = expf(m1 - m0);
            const float w0 = ptop / (1.f + ex), w1 = ptop * ex / (1.f + ex);
            int* rte = (int*)(p.ws + OFF_RTE); float* rtw = (float*)(p.ws + OFF_RTW);
            unsigned* cnt = (unsigned*)(p.ws + OFF_CTL) + CW_CNT + l * 32;
            int* list = (int*)(p.ws + OFF_LIST);
            const int E0 = gi * 8 + e0, E1 = gi * 8 + e1;
            rte[R * 2] = E0; rte[R * 2 + 1] = E1; rtw[R * 2] = w0; rtw[R * 2 + 1] = w1;
            const unsigned p0 = atomicAdd(cnt + E0, 1u); list[(size_t)E0 * LISTCAP + p0] = R * 2;
            const unsigned p1 = atomicAdd(cnt + E1, 1u); list[(size_t)E1 * LISTCAP + p1] = R * 2 + 1;
        }
    }
}
DEV void ph_outproj(const Params& p, int l, bf16_t* lds, float* stat  ) {
    const int ntiles = (l == 0) ? 528 : 512;
    for (int rt = bid_(); rt < ntiles; rt += gridDim.x) { outproj_item(p, l, rt, lds, stat); __syncthreads(); }
}

DEV void moe1_item(const Params& p_, int l, int e, int jb, int pass, int item, int cnt, bf16_t* lds) {
    const Params& p = kp_();
    const int t = tid_(), lane = t & 63, w = t >> 6, wm = w >> 1, wn = w & 1, fq = lane >> 4, fr = lane & 15;
    const int* list = (const int*)(p.ws + OFF_LIST) + (size_t)e * LISTCAP;
    const bf16_t* X2 = (const bf16_t*)(p.ws + OFF_X2);
    bf16_t* Hs = (bf16_t*)(p.ws + OFF_P) + (size_t)item * 128 * FF;
    unsigned ao0, ao1;
    { const int s0 = jb * 128 + (t >> 2), s1 = s0 + 64;
      const int tok0 = s0 < cnt ? (list[s0] >> 1) : 0, tok1 = s1 < cnt ? (list[s1] >> 1) : 0;
      ao0 = (unsigned)((tok0 * D + gemm_src_chunk(t)) * 2); ao1 = (unsigned)((tok1 * D + gemm_src_chunk(t)) * 2); }
    const bf16_t* Bt = (const bf16_t*)(p.ws + OFF_WGU) + ((size_t)e * 1024 + pass * 256) * 1024;
    f32x4 acc[4][8]; zero_acc(acc);
    gemm_mainloop(X2, ao0, ao1, Bt, (unsigned)(((t >> 2) * 1024 + gemm_src_chunk(t)) * 2), 1024, 32, lds, acc);
#pragma unroll
    for (int mt = 0; mt < 4; ++mt) {
        const int rl = wm * 64 + mt * 16 + fr;
#pragma unroll
        for (int nt = 0; nt < 4; ++nt) {
            const f32x4 gv = acc[mt][nt], uv = acc[mt][nt + 4];
            float hv[4];
#pragma unroll
            for (int jj = 0; jj < 4; ++jj) hv[jj] = gv[jj] / (1.f + __expf(-gv[jj])) * uv[jj];
            uint2 o; o.x = pk2(hv[0], hv[1]); o.y = pk2(hv[2], hv[3]);
            *(uint2*)(Hs + (size_t)rl * FF + pass * 128 + wn * 64 + nt * 16 + fq * 4) = o;
        }
    }
}
DEV void moe2_item(const Params& p_, int l, int e, int jb, int pass, int item, int cnt, bf16_t* lds) {
    const Params& p = kp_();
    const int t = tid_(), lane = t & 63, w = t >> 6, wm = w >> 1, wn = w & 1, fq = lane >> 4, fr = lane & 15;
    const int* list = (const int*)(p.ws + OFF_LIST) + (size_t)e * LISTCAP;
    const bf16_t* Hs = (const bf16_t*)(p.ws + OFF_P) + (size_t)item * 128 * FF;
    const unsigned hoff = (unsigned)(((t >> 2) * FF + gemm_src_chunk(t)) * 2);
    const float* rtw = (const float*)(p.ws + OFF_RTW);
    bf16_t* Y = (bf16_t*)(p.ws + OFF_Y);
    const bf16_t* Bt = (const bf16_t*)(p.ws + OFF_WD) + ((size_t)e * 1024 + pass * 256) * FF;
    f32x4 acc[4][8]; zero_acc(acc);
    gemm_mainloop(Hs, hoff, hoff + 64 * FF * 2, Bt, hoff, FF, 16, lds, acc);
#pragma unroll
    for (int mt = 0; mt < 4; ++mt) {
        const int s = jb * 128 + wm * 64 + mt * 16 + fr;
        if (s < cnt) {
            const int ent = list[s];
            const float gw = rtw[ent];
            bf16_t* yo = Y + (size_t)ent * D + pass * 256 + wn * 128 + fq * 4;
#pragma unroll
            for (int nt = 0; nt < 8; ++nt) { const f32x4 v = acc[mt][nt] * gw; uint2 o; o.x = pk2(v[0], v[1]); o.y = pk2(v[2], v[3]); *(uint2*)(yo + nt * 16) = o; }
        }
    }
}
template <int STAGE> DEV void ph_moe(const Params& p, int l, bf16_t* lds, int* s_pref  , int* s_cnt  ) {
    const unsigned* cnt = (const unsigned*)(p.ws + OFF_CTL) + CW_CNT + l * 32;
    if (tid_() == 0) { int a = 0; for (int e = 0; e < 32; ++e) { const int c = (int)cnt[e]; s_cnt[e] = c; s_pref[e] = a; a += (c + 127) >> 7; } s_pref[32] = a; }
    __syncthreads();
    const int nx = gridDim.x >> 3, xcd = bid_() & 7, j = bid_() >> 3;
    if (bid_() < nx * 8) {
        const int n0 = (s_cnt[xcd] + 127) >> 7, n1 = (s_cnt[xcd + 8] + 127) >> 7, n2 = (s_cnt[xcd + 16] + 127) >> 7, n3 = (s_cnt[xcd + 24] + 127) >> 7;
        const int nloc = (n0 + n1 + n2 + n3) * 4;
        for (int i = j; i < nloc; i += nx) {
            const int pass = i & 3, ib = i >> 2;
            int e, jb;
            if (ib < n0) { e = xcd; jb = ib; } else if (ib < n0 + n1) { e = xcd + 8; jb = ib - n0; } else if (ib < n0 + n1 + n2) { e = xcd + 16; jb = ib - n0 - n1; } else { e = xcd + 24; jb = ib - n0 - n1 - n2; }
            if (STAGE == 1) moe1_item(p, l, e, jb, pass, s_pref[e] + jb, s_cnt[e], lds); else moe2_item(p, l, e, jb, pass, s_pref[e] + jb, s_cnt[e], lds);
        }
    }
    __syncthreads();
}

#define XB_TMO      128
#define XB_XCNT(j)  (256  + 64 * (j))
#define XB_XSUB(j)  (1280 + 64 * (j))
#define XB_XGEN(j)  (2304 + 64 * (j))
#define XB_TOP      3328
#define XB_TOPGEN   3392
#define XCD_BAR_WORDS 3456
#define XB_SPIN_CAP (1u << 20)
DEV unsigned xb_ld(unsigned* p) { return __hip_atomic_load(p, __ATOMIC_RELAXED, __HIP_MEMORY_SCOPE_AGENT); }
DEV unsigned xb_add(unsigned* p, unsigned v) { return __hip_atomic_fetch_add(p, v, __ATOMIC_RELAXED, __HIP_MEMORY_SCOPE_AGENT); }
DEV unsigned xb_xcc_id() { return (unsigned)__builtin_amdgcn_s_getreg((3 << 11) | 20) & 0xFu; }
#define XB_SPIN(cond, bar) do { unsigned _sp = 0; while (cond) { __builtin_amdgcn_s_sleep(1); \
    if ((++_sp & 255u) == 0u) { if (xb_ld(&(bar)[XB_TMO])) break; if (_sp > XB_SPIN_CAP) { atomicAdd(&(bar)[XB_TMO], 1u); break; } } } } while (0)
struct XcdBarrier { unsigned* bar; unsigned x; volatile LAS unsigned* st; };
DEV XcdBarrier xcd_barrier_post(unsigned* bar, volatile LAS unsigned* st) {
    XcdBarrier b; b.bar = bar; b.x = xb_xcc_id(); b.st = st;
    if (tid_() == 0) (void)xb_add(&bar[XB_XCNT(b.x)], 1u);
    return b;
}
DEV void xcd_barrier_complete(unsigned* bar, unsigned x, unsigned& nloc, unsigned& nx) {
    const unsigned G = gridDim.x * gridDim.y * gridDim.z;
    unsigned sum, cnt, mine, sp = 0u;
    for (;;) {
        sum = 0u; cnt = 0u; mine = 0u;
#pragma unroll
        for (unsigned j = 0; j < 16; ++j) { const unsigned c = xb_ld(&bar[XB_XCNT(j)]); sum += c; cnt += (c > 0u) ? 1u : 0u; mine = (j == x) ? c : mine; }
        if (sum == G) break;
        __builtin_amdgcn_s_sleep(1);
        if ((++sp & 255u) == 0u) { if (xb_ld(&bar[XB_TMO])) break; if (sp > XB_SPIN_CAP) { atomicAdd(&bar[XB_TMO], 1u); break; } }
    }
    nloc = mine > 0u ? mine : 1u; nx = cnt > 0u ? cnt : 1u;
}
DEV void xcd_barrier(const XcdBarrier& b) {
    asm volatile("s_waitcnt vmcnt(0)" ::: "memory");
    __syncthreads();
    if (tid_() == 0) {
        unsigned* bar = b.bar;
        __builtin_amdgcn_s_waitcnt(0);
        unsigned nloc = b.st[0], nx = b.st[1];
        if (nloc == 0u) { xcd_barrier_complete(bar, b.x, nloc, nx); b.st[0] = nloc; b.st[1] = nx; }
        const unsigned old = xb_add(&bar[XB_XSUB(b.x)], 1u);
        const unsigned gen = old / nloc;
        if (old + 1u == (gen + 1u) * nloc) {
            __builtin_amdgcn_fence(__ATOMIC_RELEASE, "agent");
            asm volatile("s_waitcnt vmcnt(0)" ::: "memory");
            const unsigned og = xb_add(&bar[XB_TOP], 1u);
            const unsigned tg = og / nx;
            if (og + 1u == (tg + 1u) * nx) xb_add(&bar[XB_TOPGEN], 1u);
            else XB_SPIN(xb_ld(&bar[XB_TOPGEN]) == tg, bar);
            __builtin_amdgcn_fence(__ATOMIC_ACQUIRE, "agent");
            xb_add(&bar[XB_XGEN(b.x)], 1u);
            asm volatile("s_waitcnt vmcnt(0)" ::: "memory");
        } else {
            XB_SPIN(xb_ld(&bar[XB_XGEN(b.x)]) == gen, bar);
            __builtin_amdgcn_fence(__ATOMIC_ACQUIRE, "agent");
            asm volatile("s_waitcnt vmcnt(0)" ::: "memory");
        }
    }
    __syncthreads();
}

namespace cg = cooperative_groups;
#define REP(id) for (int rep_ = 0; rep_ < ((PROBE_ID) == (id) ? PROBE_N : 1); ++rep_)
constexpr int SMEM_STAT = GEMM_LDS_BYTES;
constexpr int SMEM_BYTES = GEMM_LDS_BYTES + 2048 + 512;
constexpr int NPHASE = 14;
__global__ void __launch_bounds__(256, 2) mega(Params p, int ph_lo, int ph_hi) {
    extern __shared__ __attribute__((aligned(16))) unsigned char smem[];
    bf16_t* lds = (bf16_t*)smem;
    float* stat = (float*)(smem + SMEM_STAT);
    int* s_pref = (int*)(smem + SMEM_STAT + 2048); int* s_cnt = s_pref + 40;
    volatile LAS unsigned* bst = (volatile LAS unsigned*)(LAS unsigned char*)(smem + SMEM_STAT + 2048 + 400);
    if (tid_() < 2) bst[tid_()] = 0u;
    __syncthreads();
    (void)xcd_barrier_post((unsigned*)(kp_().ws + OFF_CTL + 4096), bst);
#define GRID_BAR() do { XcdBarrier xb_; xb_.bar = (unsigned*)(kp_().ws + OFF_CTL + 4096); xb_.x = xb_xcc_id(); \
        xb_.st = (volatile LAS unsigned*)(LAS unsigned char*)(smem + SMEM_STAT + 2048 + 400); xcd_barrier(xb_); } while (0)
#define IN(k) (ph_lo <= (k) && (k) < ph_hi)
#define SEAM(k) do { if (IN(k) && IN((k) + 1)) { if ((k) == 0) cg::this_grid().sync(); else GRID_BAR(); } } while (0)
    if (IN(0)) {
        REP(0) { ph_mod(kp_(), (float*)smem); __syncthreads(); }
        ph_rope(kp_());
        ph_routerw(kp_());
        ph_rgprep(kp_());
        REP(1) ph_transpose(kp_().w_in, (bf16_t*)(kp_().ws + OFF_WINT), 1024, 2304, 0, 2, (size_t)1024 * 2304, (size_t)2304 * 1024, (float*)smem);
        ph_transpose(kp_().w_out, (bf16_t*)(kp_().ws + OFF_WOUTT), 1024, 1024, 0, 2, (size_t)1024 * 1024, (size_t)1024 * 1024, (float*)smem);
    }
    SEAM(0);
#define LAYER_BODY(l, pb) { \
        if (IN(pb + 0)) { if (l == 0) { REP(2) ph_rowop<0>(kp_(), 0, NTOK); } else ph_rowop<1>(kp_(), 1, NTOK); } \
        SEAM(pb + 0); \
        if (IN(pb + 1)) { ph_inproj(kp_(), l, lds); } \
        SEAM(pb + 1); \
        if (IN(pb + 2)) { \
            REP(4) ph_rgagg(kp_(), l, lds); \
            REP(5) { ph_attn(kp_(), l, (float*)smem); __syncthreads(); } \
            REP(6) { \
            ph_transpose(kp_().exp_w_gate + (size_t)l * NE * 1024 * 512, (bf16_t*)(kp_().ws + OFF_WGU), 1024, 512, 1, NE, (size_t)1024 * 512, (size_t)1024 * 1024, (float*)smem); \
            ph_transpose(kp_().exp_w_up + (size_t)l * NE * 1024 * 512, (bf16_t*)(kp_().ws + OFF_WGU), 1024, 512, 2, NE, (size_t)1024 * 512, (size_t)1024 * 1024, (float*)smem); \
            ph_transpose(kp_().exp_w_down + (size_t)l * NE * 512 * 1024, (bf16_t*)(kp_().ws + OFF_WD), 512, 1024, 0, NE, (size_t)512 * 1024, (size_t)1024 * 512, (float*)smem); \
            } \
        } \
        SEAM(pb + 2); \
        if (IN(pb + 3)) ph_outproj(kp_(), l, lds, stat); \
        SEAM(pb + 3); \
        if (IN(pb + 4)) { REP(7) { ph_moe<1>(kp_(), l, lds, s_pref, s_cnt); } } \
        SEAM(pb + 4); \
        if (IN(pb + 5)) { REP(8) { ph_moe<2>(kp_(), l, lds, s_pref, s_cnt); } } \
        SEAM(pb + 5); \
    }
    LAYER_BODY(0, 1)
    LAYER_BODY(1, 7)
#undef LAYER_BODY
    if (IN(NPHASE - 1)) ph_rowop<2>(kp_(), 2, NLAT);
#undef IN
#undef SEAM
}

#ifndef ONE_LAUNCH
#define ONE_LAUNCH 1
#endif
extern "C" void kernel_launch(void* const* d_in, const int* in_sizes, int n_in, void* d_out, int out_size, void* d_ws, size_t ws_size, hipStream_t stream) {
    if (n_in != 28 || ws_size < WS_TOTAL || out_size != NLAT * D) { fprintf(stderr, "kernel_launch: unexpected shapes / workspace (%d inputs, ws %zu need %zu)\n", n_in, ws_size, (size_t)WS_TOTAL); return; }
    static int grid = 0;
    if (grid == 0) {
        int dev = 0, cus = 0, per_cu = 0;
        (void)hipGetDevice(&dev);
        (void)hipDeviceGetAttribute(&cus, hipDeviceAttributeMultiprocessorCount, dev);
        (void)hipFuncSetAttribute((const void*)mega, hipFuncAttributeMaxDynamicSharedMemorySize, SMEM_BYTES);
        (void)hipOccupancyMaxActiveBlocksPerMultiprocessor(&per_cu, (const void*)mega, 256, SMEM_BYTES);
        if (per_cu > 2) per_cu = 2;
        grid = cus * per_cu;
        if (grid <= 0) { fprintf(stderr, "kernel_launch: occupancy query gave %d blocks per CU on %d CUs\n", per_cu, cus); grid = -1; }
    }
    if (grid < 0) return;
    Params p{};
    const float** pp = (const float**)&p;
    for (int i = 0; i < 28; ++i) pp[i] = (const float*)d_in[i];
    p.out = (float*)d_out; p.ws = (unsigned char*)d_ws;
    (void)hipMemsetAsync((unsigned char*)d_ws + OFF_CTL, 0, CTL_BYTES, stream);
#if ONE_LAUNCH
    int lo = 0, hi = NPHASE;
    void* args[] = {(void*)&p, (void*)&lo, (void*)&hi};
    hipError_t e = hipLaunchCooperativeKernel((const void*)mega, dim3(grid), dim3(256), args, SMEM_BYTES, stream);
    if (e != hipSuccess) fprintf(stderr, "kernel_launch: cooperative launch failed: %s (grid %d)\n", hipGetErrorString(e), grid);
#else
    for (int ph = 0; ph < NPHASE; ++ph) mega<<<grid, 256, SMEM_BYTES, stream>>>(p, ph, ph + 1);
#endif
}
```

```cpp
#include <hip/hip_runtime.h>
#include <hip/hip_cooperative_groups.h>
#include <stdint.h>
#include <cstdio>

typedef unsigned short bf16_t;
typedef short bf16x8 __attribute__((ext_vector_type(8)));
typedef float f32x4 __attribute__((ext_vector_type(4)));

#define DEV __device__ __forceinline__
#define PROBE_ID -1
#define PROBE_N 4

constexpr int D = 1024, NB = 8, S = 8192, CTX = 256;
constexpr int NLAT = NB * S, NCTX = NB * CTX, NTOK = NLAT + NCTX;
constexpr int PWS = 1280;
constexpr int COL_RGX = 0, COL_GATE = 256, COL_NAQ = 512, COL_GQ = 896;
constexpr int KVT = 1024;
constexpr int NE = 32, FF = 512;
constexpr int LISTCAP = NTOK;
constexpr float ALPHA = 1.4142135623730951f;
constexpr float LN_EPS = 1e-5f;

constexpr size_t al256(size_t x) { return (x + 255) & ~(size_t)255; }
constexpr size_t OFF_CTL   = 0;
constexpr size_t CTL_BYTES = 4096 + 16384;
constexpr size_t OFF_MOD   = OFF_CTL + CTL_BYTES;
constexpr size_t OFF_ROPE  = al256(OFF_MOD + (size_t)2 * 9 * 6144 * 4);
constexpr size_t OFF_RTE   = al256(OFF_ROPE + (size_t)2 * 128 * 16 * 4);
constexpr size_t OFF_RTW   = al256(OFF_RTE + (size_t)NTOK * 8);
constexpr size_t OFF_LIST  = al256(OFF_RTW + (size_t)NTOK * 8);
constexpr size_t OFF_WR    = al256(OFF_LIST + (size_t)NE * LISTCAP * 4);
constexpr size_t OFF_WRG   = al256(OFF_WR + (size_t)2 * 2 * 48 * 1024 * 2);
constexpr size_t OFF_RGC   = al256(OFF_WRG + (size_t)2 * 2 * 2 * 4 * 64 * 64 * 2);
constexpr size_t OFF_AGG   = al256(OFF_RGC + (size_t)2 * 2 * 3 * 256 * 4);
constexpr size_t OFF_WINT  = al256(OFF_AGG + (size_t)NB * 66 * 2 * 2 * 256 * 4);
constexpr size_t OFF_WOUTT = al256(OFF_WINT + (size_t)2 * 2304 * 1024 * 2);
constexpr size_t OFF_WGU   = al256(OFF_WOUTT + (size_t)2 * 1024 * 1024 * 2);
constexpr size_t OFF_WD    = al256(OFF_WGU + (size_t)NE * 1024 * 1024 * 2);
constexpr size_t OFF_XCTX  = al256(OFF_WD + (size_t)NE * 1024 * 512 * 2);
constexpr size_t OFF_X1    = al256(OFF_XCTX + (size_t)NCTX * D * 4);
constexpr size_t OFF_X2    = al256(OFF_X1 + (size_t)NTOK * D * 2);
constexpr size_t OFF_P     = al256(OFF_X2 + (size_t)NTOK * D * 2);
constexpr size_t OFF_NAKF  = al256(OFF_P + (size_t)NTOK * PWS * 2);
constexpr size_t OFF_NAVF  = al256(OFF_NAKF + (size_t)NB * 6 * 512 * KVT * 2);
constexpr size_t OFF_GKF   = al256(OFF_NAVF + (size_t)NB * 6 * 512 * KVT * 2);
constexpr size_t OFF_GVF   = al256(OFF_GKF + (size_t)NB * 2 * 512 * KVT * 2);
constexpr size_t OFF_NAKFC = al256(OFF_GVF + (size_t)NB * 2 * 512 * KVT * 2);
constexpr size_t OFF_NAVFC = al256(OFF_NAKFC + (size_t)NB * 6 * 16 * KVT * 2);
constexpr size_t OFF_GKFC  = al256(OFF_NAVFC + (size_t)NB * 6 * 16 * KVT * 2);
constexpr size_t OFF_GVFC  = al256(OFF_GKFC + (size_t)NB * 2 * 16 * KVT * 2);
constexpr size_t OFF_Y     = al256(OFF_GVFC + (size_t)NB * 2 * 16 * KVT * 2);
constexpr size_t WS_TOTAL  = al256(OFF_Y + (size_t)2 * NTOK * D * 2);
constexpr int CW_CNT = 0;

struct Params {
    const float *x, *c, *ctx, *c_ctx, *w_ada, *b_ada, *w_in, *conv_w, *conv_b, *rg_a_w, *rg_a_b, *rg_i_w, *rg_i_b, *rg_lambda,
        *na_rpb, *gqa_sink, *w_out, *ln1_g, *ln1_b, *router_g_w, *router_g_b, *router_e_w, *router_e_b, *exp_w_gate, *exp_w_up,
        *exp_w_down, *ln2_g, *ln2_b;
    float* out;
    unsigned char* ws;
};

DEV const Params& kp_() { const void* q = (const void*)__builtin_amdgcn_kernarg_segment_ptr(); asm volatile("" : "+s"(q)); return *(const Params*)q; }
DEV int tid_() { int t = threadIdx.x; asm volatile("" : "+v"(t)); return t; }
DEV int bid_() { int b = blockIdx.x; asm volatile("" : "+s"(b)); return b; }
DEV float shx(float v, int m) { return __builtin_bit_cast(float, __builtin_amdgcn_ds_bpermute(((tid_() & 63) ^ m) << 2, __builtin_bit_cast(int, v))); }
DEV float shl_(float v, int src) { return __builtin_bit_cast(float, __builtin_amdgcn_ds_bpermute(src << 2, __builtin_bit_cast(int, v))); }
DEV float bf2f(bf16_t h) { return __uint_as_float((unsigned)h << 16); }
DEV bf16_t f2bf(float f) { unsigned u = __float_as_uint(f); u += 0x7fffu + ((u >> 16) & 1u); return (bf16_t)(u >> 16); }
DEV unsigned pk2(float lo, float hi) { return (unsigned)f2bf(lo) | ((unsigned)f2bf(hi) << 16); }
DEV float wave_sum(float v) {
#pragma unroll
    for (int o = 1; o < 64; o <<= 1) v += shx(v, o);
    return v;
}
DEV float wave_max(float v) {
#pragma unroll
    for (int o = 1; o < 64; o <<= 1) v = fmaxf(v, shx(v, o));
    return v;
}
DEV float sigmoidf_(float x) { return 1.f / (1.f + __expf(-x)); }
DEV float gelu_tanh(float x) {
    const float u = 0.7978845608028654f * (x + 0.044715f * x * x * x);
    const float t = 1.f - 2.f / (1.f + __expf(2.f * u));
    return 0.5f * x * (1.f + t);
}
DEV float* xres_row(const Params& p, int R) {
    return R < NLAT ? p.out + (size_t)R * D : (float*)(p.ws + OFF_XCTX) + (size_t)(R - NLAT) * D;
}
DEV const float* modvec(const Params& p, int l, int R, int seg) {
    const int b = R < NLAT ? R / S : 8;
    return (const float*)(p.ws + OFF_MOD) + ((size_t)(l * 9 + b) * 6 + seg) * 1024;
}

DEV void ph_mod(const Params& p, float* sc  ) {
    if (bid_() >= 48) return;
    for (int i = tid_(); i < 9 * 1024; i += 256) { const float v = (i < 8192) ? p.c[i] : p.c_ctx[i - 8192]; sc[i] = v / (1.f + expf(-v)); }
    __syncthreads();
    const int col = bid_() * 256 + tid_();
    const int l = col / 6144, j = col % 6144;
    const float* w = p.w_ada + (size_t)l * 1024 * 6144 + j;
    float a0 = 0, a1 = 0, a2 = 0, a3 = 0, a4 = 0, a5 = 0, a6 = 0, a7 = 0, a8 = 0;
    for (int k = 0; k < 1024; ++k) {
        const float wv = w[(size_t)k * 6144];
        a0 += sc[k] * wv; a1 += sc[1024 + k] * wv; a2 += sc[2048 + k] * wv; a3 += sc[3072 + k] * wv; a4 += sc[4096 + k] * wv;
        a5 += sc[5120 + k] * wv; a6 += sc[6144 + k] * wv; a7 += sc[7168 + k] * wv; a8 += sc[8192 + k] * wv;
    }
    const float bias = p.b_ada[l * 6144 + j];
    float* mod = (float*)(p.ws + OFF_MOD) + (size_t)l * 9 * 6144 + j;
    mod[0 * 6144] = a0 + bias; mod[1 * 6144] = a1 + bias; mod[2 * 6144] = a2 + bias; mod[3 * 6144] = a3 + bias; mod[4 * 6144] = a4 + bias;
    mod[5 * 6144] = a5 + bias; mod[6 * 6144] = a6 + bias; mod[7 * 6144] = a7 + bias; mod[8 * 6144] = a8 + bias;
}

DEV void sincos_red(float ang, float& sn, float& cs) {
    const float n = rintf(ang * 0.15915494309189535f);
    float r = fmaf(-n, 6.2831854820251465f, ang);
    r = fmaf(-n, -1.7484555e-07f, r);
    float sgn = 1.f;
    if (r > 1.5707963267948966f) { r = 3.14159265358979f - r; sgn = -1.f; }
    else if (r < -1.5707963267948966f) { r = -3.14159265358979f - r; sgn = -1.f; }
    const float r2 = r * r;
    float sp = -1.6059044e-10f; sp = fmaf(sp, r2, 2.5052108e-08f); sp = fmaf(sp, r2, -2.7557319e-06f); sp = fmaf(sp, r2, 1.9841270e-04f);
    sp = fmaf(sp, r2, -8.3333333e-03f); sp = fmaf(sp, r2, 1.6666667e-01f); sp = fmaf(sp * -1.f, r2, 1.f);
    sn = r * sp;
    float cp = -1.1470746e-11f; cp = fmaf(cp, r2, 2.0876757e-09f); cp = fmaf(cp, r2, -2.7557319e-07f); cp = fmaf(cp, r2, 2.4801587e-05f);
    cp = fmaf(cp, r2, -1.3888889e-03f); cp = fmaf(cp, r2, 4.1666667e-02f); cp = fmaf(cp, r2, -0.5f); cp = fmaf(cp, r2, 1.f);
    cs = sgn * cp;
}
DEV void ph_rope(const Params& p) {
    const int i = (bid_() - 48) * 256 + tid_();
    if (i < 0 || i >= 128 * 16) return;
    const int pos = i >> 4, q = i & 15;
    const float inv = exp2f(-(float)q * (13.287712379549449f / 16.f));
    float sn, cs; sincos_red((float)pos * inv, sn, cs);
    float* tab = (float*)(p.ws + OFF_ROPE);
    tab[i] = cs; tab[2048 + i] = sn;
}

DEV void ph_routerw(const Params& p) {
  for (int i = bid_() * 256 + tid_(); i < 2 * 48 * 1024; i += gridDim.x * 256) {
    const int l = i / (48 * 1024), f = (i / 1024) % 48, k = i & 1023;
    float w = 0.f;
    if (f < 4) w = p.router_g_w[((size_t)l * 1024 + k) * 4 + f]; else if (f < 36) w = p.router_e_w[((size_t)l * 1024 + k) * 32 + (f - 4)];
    const bf16_t hi = f2bf(w), lo = f2bf(w - bf2f(hi));
    bf16_t* WR = (bf16_t*)(p.ws + OFF_WR);
    WR[((size_t)(l * 2 + 0) * 48 + f) * 1024 + k] = hi;
    WR[((size_t)(l * 2 + 1) * 48 + f) * 1024 + k] = lo;
  }
}

DEV void ph_rgprep(const Params& p) {
    bf16_t* W = (bf16_t*)(p.ws + OFF_WRG);
    for (int i = bid_() * 256 + tid_(); i < 2 * 2 * 2 * 4 * 64 * 64; i += gridDim.x * 256) {
        const int d = i & 63, e = (i >> 6) & 63, n = (i >> 12) & 3, gate = (i >> 14) & 1, ld = i >> 15;
        const float* srcw = gate ? p.rg_i_w : p.rg_a_w;
        W[i] = f2bf(srcw[((size_t)(ld * 4 + n) * 64 + d) * 64 + e]);
    }
    float* C = (float*)(p.ws + OFF_RGC);
    for (int i = bid_() * 256 + tid_(); i < 2 * 2 * 256; i += gridDim.x * 256) {
        const int c = i & 255, ld = i >> 8;
        C[(ld * 3 + 0) * 256 + c] = p.rg_a_b[ld * 256 + c];
        C[(ld * 3 + 1) * 256 + c] = p.rg_i_b[ld * 256 + c];
        C[(ld * 3 + 2) * 256 + c] = -8.f * log1pf(expf(-p.rg_lambda[ld * 256 + c]));
    }
}

DEV int tr_row(int n, int mode) { return mode == 0 ? n : ((n >> 7) * 256 + ((n >> 6) & 1) * 128 + (n & 63) + (mode == 2 ? 64 : 0)); }
DEV void transpose_tile(const float* src, bf16_t* dst, int K, int N, int mode, int tile, float* lds) {
    const int ntn = N >> 6, kt = tile / ntn, nt = tile % ntn, k0 = kt * 64, n0 = nt * 64, t = tid_();
#pragma unroll
    for (int i = 0; i < 4; ++i) {
        const int r = (t >> 4) + 16 * i, c4 = (t & 15) * 4;
        const float4 v = *(const float4*)(src + (size_t)(k0 + r) * N + n0 + c4);
        lds[r * 65 + c4] = v.x; lds[r * 65 + c4 + 1] = v.y; lds[r * 65 + c4 + 2] = v.z; lds[r * 65 + c4 + 3] = v.w;
    }
    __syncthreads();
#pragma unroll
    for (int i = 0; i < 2; ++i) {
        const int n = (t >> 3) + 32 * i, kc = (t & 7) * 8;
        uint4 o;
        o.x = pk2(lds[(kc + 0) * 65 + n], lds[(kc + 1) * 65 + n]); o.y = pk2(lds[(kc + 2) * 65 + n], lds[(kc + 3) * 65 + n]);
        o.z = pk2(lds[(kc + 4) * 65 + n], lds[(kc + 5) * 65 + n]); o.w = pk2(lds[(kc + 6) * 65 + n], lds[(kc + 7) * 65 + n]);
        *(uint4*)(dst + (size_t)tr_row(n0 + n, mode) * K + k0 + kc) = o;
    }
    __syncthreads();
}
DEV void ph_transpose(const float* src, bf16_t* dst, int K, int N, int mode, int nmat, size_t sstride, size_t dstride, float* lds  ) {
    const int per = (K >> 6) * (N >> 6);
    for (int it = bid_(); it < nmat * per; it += gridDim.x) {
        const int m = it / per, tile = it % per;
        transpose_tile(src + (size_t)m * sstride, dst + (size_t)m * dstride, K, N, mode, tile, lds);
    }
}

template <int MODE> DEV void rowop(const Params& p, int l, int R) {
    const int lane = tid_() & 63;
    float4 v[4];
    if (MODE == 0) {
        const float* src = R < NLAT ? p.x + (size_t)R * D : p.ctx + (size_t)(R - NLAT) * D;
#pragma unroll
        for (int i = 0; i < 4; ++i) v[i] = *(const float4*)(src + i * 256 + lane * 4);
    } else {
        float* xr = xres_row(p, R);
        const float* g2 = modvec(p, l - 1, R, 5);
        const bf16_t* y0 = (const bf16_t*)(p.ws + OFF_Y) + (size_t)(2 * R) * D;
        const bf16_t* y1 = y0 + D;
        const float* lg = p.ln2_g + (l - 1) * D; const float* lb = p.ln2_b + (l - 1) * D;
        float s = 0.f;
#pragma unroll
        for (int i = 0; i < 4; ++i) {
            const int k = i * 256 + lane * 4;
            const float4 xv = *(const float4*)(xr + k); const float4 gv = *(const float4*)(g2 + k);
            const uint2 a = *(const uint2*)(y0 + k); const uint2 b = *(const uint2*)(y1 + k);
            float4 u;
            u.x = ALPHA * xv.x + gv.x * (bf2f((bf16_t)(a.x & 0xffff)) + bf2f((bf16_t)(b.x & 0xffff)));
            u.y = ALPHA * xv.y + gv.y * (bf2f((bf16_t)(a.x >> 16)) + bf2f((bf16_t)(b.x >> 16)));
            u.z = ALPHA * xv.z + gv.z * (bf2f((bf16_t)(a.y & 0xffff)) + bf2f((bf16_t)(b.y & 0xffff)));
            u.w = ALPHA * xv.w + gv.w * (bf2f((bf16_t)(a.y >> 16)) + bf2f((bf16_t)(b.y >> 16)));
            v[i] = u; s += (u.x + u.y) + (u.z + u.w);
        }
        const float mean = wave_sum(s) * (1.f / D);
        float q = 0.f;
#pragma unroll
        for (int i = 0; i < 4; ++i) { v[i].x -= mean; v[i].y -= mean; v[i].z -= mean; v[i].w -= mean; q += (v[i].x * v[i].x + v[i].y * v[i].y) + (v[i].z * v[i].z + v[i].w * v[i].w); }
        const float rstd = rsqrtf(wave_sum(q) * (1.f / D) + LN_EPS);
#pragma unroll
        for (int i = 0; i < 4; ++i) {
            const int k = i * 256 + lane * 4;
            const float4 gg = *(const float4*)(lg + k); const float4 bb = *(const float4*)(lb + k);
            v[i].x = v[i].x * rstd * gg.x + bb.x; v[i].y = v[i].y * rstd * gg.y + bb.y; v[i].z = v[i].z * rstd * gg.z + bb.z; v[i].w = v[i].w * rstd * gg.w + bb.w;
            *(float4*)(xr + k) = v[i];
        }
    }
    if (MODE != 2) {
        const float* sh = modvec(p, l, R, 0); const float* sc = modvec(p, l, R, 1);
        bf16_t* ha = (bf16_t*)(p.ws + OFF_X1) + (size_t)R * D;
#pragma unroll
        for (int i = 0; i < 4; ++i) {
            const int k = i * 256 + lane * 4;
            const float4 s4 = *(const float4*)(sh + k); const float4 c4 = *(const float4*)(sc + k);
            uint2 o; o.x = pk2(v[i].x * (1.f + c4.x) + s4.x, v[i].y * (1.f + c4.y) + s4.y); o.y = pk2(v[i].z * (1.f + c4.z) + s4.z, v[i].w * (1.f + c4.w) + s4.w);
            *(uint2*)(ha + k) = o;
        }
    }
}
template <int MODE> DEV void ph_rowop(const Params& p, int l, int nrows) {
    const int w = tid_() >> 6;
    for (int R = bid_() * 4 + w; R < nrows; R += gridDim.x * 4) rowop<MODE>(p, l, R);
}

constexpr int GEMM_STAGE_BYTES = 384 * 64;
constexpr int GEMM_NSTAGE = 3;
constexpr int GEMM_LDS_BYTES = GEMM_NSTAGE * GEMM_STAGE_BYTES;
#define LAS __attribute__((address_space(3)))
DEV int gemm_src_chunk(int t) { return ((t & 3) ^ ((0 - (t >> 4)) & 3)) * 8; }
DEV void gemm_mainloop(const bf16_t* Abase, unsigned ao0, unsigned ao1, const bf16_t* Bbase, unsigned bo, unsigned ldb, int nk, bf16_t* lds, f32x4 (&acc)[4][8]) {
    const int t = tid_(), lane = t & 63, w = __builtin_amdgcn_readfirstlane(t >> 6), wm = w >> 1, wn = w & 1;
    LAS unsigned char* L = (LAS unsigned char*)lds;
    const int pc = ((lane >> 4) ^ ((0 - ((lane & 15) >> 2)) & 3)) * 16;
    const int arow = (wm * 64 + (lane & 15)) * 64 + pc, brow = (128 + wn * 128 + (lane & 15)) * 64 + pc;
    const char* Ab = (const char*)Abase; const char* B0 = (const char*)Bbase; const char* B1 = B0 + (size_t)ldb * 128; const char* B2 = B0 + (size_t)ldb * 256; const char* B3 = B0 + (size_t)ldb * 384;
#define GEMM_ISSUE(slot, ko) do { LAS unsigned* d_ = (LAS unsigned*)(L + (slot) * GEMM_STAGE_BYTES + w * 1024); \
        __builtin_amdgcn_global_load_lds((const unsigned*)(Ab + (ao0 + (ko) * 2u)), d_, 16, 0, 0); \
        __builtin_amdgcn_global_load_lds((const unsigned*)(Ab + (ao1 + (ko) * 2u)), d_ + 1024, 16, 0, 0); \
        __builtin_amdgcn_global_load_lds((const unsigned*)(B0 + (bo + (ko) * 2u)), d_ + 2048, 16, 0, 0); \
        __builtin_amdgcn_global_load_lds((const unsigned*)(B1 + (bo + (ko) * 2u)), d_ + 3072, 16, 0, 0); \
        __builtin_amdgcn_global_load_lds((const unsigned*)(B2 + (bo + (ko) * 2u)), d_ + 4096, 16, 0, 0); \
        __builtin_amdgcn_global_load_lds((const unsigned*)(B3 + (bo + (ko) * 2u)), d_ + 5120, 16, 0, 0); } while (0)
    asm volatile("s_waitcnt vmcnt(0)" ::: "memory");
    __builtin_amdgcn_s_barrier();
    asm volatile("" ::: "memory");
    GEMM_ISSUE(0, 0);
    if (nk > 1) GEMM_ISSUE(1, 32);
    int cs = 0, is = 2;
    for (int kt = 0; kt < nk; ++kt) {
        if (kt + 1 < nk) asm volatile("s_waitcnt vmcnt(6)" ::: "memory"); else asm volatile("s_waitcnt vmcnt(0)" ::: "memory");
        __builtin_amdgcn_s_barrier();
        asm volatile("" ::: "memory");
        if (kt + 2 < nk) GEMM_ISSUE(is, (kt + 2) * 32);
        const LAS unsigned char* cur = L + cs * GEMM_STAGE_BYTES;
        const bf16x8 af0 = *(const LAS bf16x8*)(cur + arow), af1 = *(const LAS bf16x8*)(cur + arow + 16 * 64), af2 = *(const LAS bf16x8*)(cur + arow + 32 * 64), af3 = *(const LAS bf16x8*)(cur + arow + 48 * 64);
        bf16x8 bq0 = *(const LAS bf16x8*)(cur + brow), bq1 = *(const LAS bf16x8*)(cur + brow + 16 * 64);
#pragma unroll
        for (int nt = 0; nt < 8; ++nt) {
            const bf16x8 bfr = bq0; bq0 = bq1;
            if (nt + 2 < 8) bq1 = *(const LAS bf16x8*)(cur + brow + (nt + 2) * 16 * 64);
            acc[0][nt] = __builtin_amdgcn_mfma_f32_16x16x32_bf16(bfr, af0, acc[0][nt], 0, 0, 0);
            acc[1][nt] = __builtin_amdgcn_mfma_f32_16x16x32_bf16(bfr, af1, acc[1][nt], 0, 0, 0);
            acc[2][nt] = __builtin_amdgcn_mfma_f32_16x16x32_bf16(bfr, af2, acc[2][nt], 0, 0, 0);
            acc[3][nt] = __builtin_amdgcn_mfma_f32_16x16x32_bf16(bfr, af3, acc[3][nt], 0, 0, 0);
        }
        cs = cs == 2 ? 0 : cs + 1; is = is == 2 ? 0 : is + 1;
    }
#undef GEMM_ISSUE
}
DEV void zero_acc(f32x4 (&acc)[4][8]) {
#pragma unroll
    for (int a = 0; a < 4; ++a)
#pragma unroll
        for (int b = 0; b < 8; ++b) acc[a][b] = (f32x4){0.f, 0.f, 0.f, 0.f};
}

DEV void inproj_item(const Params& p_, int l, int rt, int pass, bf16_t* lds) {
    const Params& p = kp_();
    const int t = tid_(), lane = t & 63, w = t >> 6, wm = w >> 1, wn = w & 1;
    const bf16_t* A = (const bf16_t*)(p.ws + OFF_X1) + (size_t)(rt * 128) * D;
    const bf16_t* Bt = (const bf16_t*)(p.ws + OFF_WINT) + ((size_t)l * 2304 + pass * 256) * 1024;
    const unsigned toff = (unsigned)(((t >> 2) * 1024 + gemm_src_chunk(t)) * 2);
    f32x4 acc[4][8]; zero_acc(acc);
    gemm_mainloop(A, toff, toff + 64 * D * 2, Bt, toff, 1024, 32, lds, acc);
    bf16_t* P = (bf16_t*)(p.ws + OFF_P);
    const float* ctab = (const float*)(p.ws + OFF_ROPE); const float* stab = ctab + 2048;
    const bool isctx = rt >= 512;
    const int fq = lane >> 4, fr = lane & 15;
#pragma unroll
    for (int hci = 0; hci < 2; ++hci) {
        const int hc = pass * 4 + wn * 2 + hci;
        int type, dcol = 0, vh = 0;
        if (hc < 4) { type = 0; dcol = COL_RGX + hc * 64; }
        else if (hc < 10) { type = 4; vh = hc - 4; }
        else if (hc < 16) { type = 5; vh = hc - 10; }
        else if (hc < 18) { type = 6; vh = hc - 16; }
        else if (hc < 20) { type = 7; vh = hc - 18; }
        else if (hc < 24) { type = 0; dcol = COL_GATE + (hc - 20) * 64; }
        else if (hc < 30) { type = 1; dcol = COL_NAQ + (hc - 24) * 64; }
        else { type = 3; dcol = COL_GQ + (hc - 30) * 64; }
#pragma unroll
        for (int mt = 0; mt < 4; ++mt) {
            const int R = rt * 128 + wm * 64 + mt * 16 + fr;
            f32x4 v0 = acc[mt][hci * 4 + 0], v1 = acc[mt][hci * 4 + 1], v2 = acc[mt][hci * 4 + 2], v3 = acc[mt][hci * 4 + 3];
            if ((type == 3 || type == 6) && !isctx) {
                const int tt = R & (S - 1), pr = tt >> 6, pc = tt & 63;
                const f32x4 cr = *(const f32x4*)(ctab + pr * 16 + fq * 4), sr = *(const f32x4*)(stab + pr * 16 + fq * 4);
                const f32x4 cc = *(const f32x4*)(ctab + pc * 16 + fq * 4), sc = *(const f32x4*)(stab + pc * 16 + fq * 4);
                const f32x4 o0 = v0 * cr - v1 * sr, o1 = v1 * cr + v0 * sr, o2 = v2 * cc - v3 * sc, o3 = v3 * cc + v2 * sc;
                v0 = o0; v1 = o1; v2 = o2; v3 = o3;
            }
            if (type == 1 || type == 3) { v0 = v0 * 0.125f; v1 = v1 * 0.125f; v2 = v2 * 0.125f; v3 = v3 * 0.125f; }
            if (type < 4) {
                bf16_t* o = P + (size_t)R * PWS + dcol + fq * 4;
                uint2 q;
                q.x = pk2(v0[0], v0[1]); q.y = pk2(v0[2], v0[3]); *(uint2*)(o) = q;
                q.x = pk2(v1[0], v1[1]); q.y = pk2(v1[2], v1[3]); *(uint2*)(o + 16) = q;
                q.x = pk2(v2[0], v2[1]); q.y = pk2(v2[2], v2[3]); *(uint2*)(o + 32) = q;
                q.x = pk2(v3[0], v3[1]); q.y = pk2(v3[2], v3[3]); *(uint2*)(o + 48) = q;
            } else {
                const bool na = type < 6, isk = (type == 4 || type == 6);
                bf16_t* tb;
                if (!isctx) { const int b = R >> 13, tile = (R & (S - 1)) >> 4;
                    tb = (bf16_t*)(p.ws + (na ? (isk ? OFF_NAKF : OFF_NAVF) : (isk ? OFF_GKF : OFF_GVF))) + ((size_t)(b * (na ? 6 : 2) + vh) * 512 + tile) * KVT; }
                else { const int cR = R - NLAT, b = cR >> 8, tile = (cR & 255) >> 4;
                    tb = (bf16_t*)(p.ws + (na ? (isk ? OFF_NAKFC : OFF_NAVFC) : (isk ? OFF_GKFC : OFF_GVFC))) + ((size_t)(b * (na ? 6 : 2) + vh) * 16 + tile) * KVT; }
                if (isk) {
                    bf16_t* o = tb + ((fq >> 1) * 16 + fr) * 8 + (fq & 1) * 4;
                    uint2 q;
                    q.x = pk2(v0[0], v0[1]); q.y = pk2(v0[2], v0[3]); *(uint2*)(o) = q;
                    q.x = pk2(v1[0], v1[1]); q.y = pk2(v1[2], v1[3]); *(uint2*)(o + 2 * 16 * 8) = q;
                    q.x = pk2(v2[0], v2[1]); q.y = pk2(v2[2], v2[3]); *(uint2*)(o + 512) = q;
                    q.x = pk2(v3[0], v3[1]); q.y = pk2(v3[2], v3[3]); *(uint2*)(o + 512 + 2 * 16 * 8) = q;
                } else {
                    bf16_t* o = tb + ((fr >> 2) * 16 + fq * 4) * 8 + (fr & 3);
#pragma unroll
                    for (int j = 0; j < 4; ++j) {
                        o[j * 8] = f2bf(v0[j]); o[j * 8 + 4] = f2bf(v1[j]); o[512 + j * 8] = f2bf(v2[j]); o[512 + j * 8 + 4] = f2bf(v3[j]);
                    }
                }
            }
        }
    }
}
DEV void ph_inproj(const Params& p, int l, bf16_t* lds) {
    const int nctxp = (l == 0) ? 9 : 5;
    const int nx = gridDim.x >> 3, xcd = bid_() & 7, j = bid_() >> 3;
    const int nloc = 64 * 9 + 2 * nctxp;
    if (bid_() >= nx * 8) return;
    for (int i0 = j; i0 < nloc * ((PROBE_ID) == 3 ? PROBE_N : 1); i0 += nx) {
        const int i = i0 % nloc;
        int rt, pass;
        if (i < 64 * 9) { rt = xcd * 64 + i / 9; pass = i % 9; } else { const int r = i - 64 * 9; rt = 512 + 2 * xcd + r / nctxp; pass = r % nctxp; }
        inproj_item(p, l, rt, pass, lds);
    }
}

constexpr float LOG2E = 1.4426950408889634f;
struct AttnState { f32x4 o0, o1, o2, o3; float m, lsum; };
struct KVFrag { bf16x8 k00, k01, k10, k11, v0, v1, v2, v3; };
DEV bf16x8 ld16(const bf16_t* p) { return *(const bf16x8*)p; }
DEV bf16x8 lohi(const uint4& a, const uint4& b, int hi) { union { uint4 u; bf16x8 v; } c; c.u = hi ? make_uint4(a.z, a.w, b.z, b.w) : make_uint4(a.x, a.y, b.x, b.y); return c.v; }
DEV void kv_load(const bf16_t* kt0, const bf16_t* kt1, const bf16_t* vt0, const bf16_t* vt1, KVFrag& f) {
    f.k00 = ld16(kt0); f.k01 = ld16(kt0 + 512); f.k10 = ld16(kt1); f.k11 = ld16(kt1 + 512);
    const uint4 a0 = *(const uint4*)vt0, a1 = *(const uint4*)(vt0 + 512), b0 = *(const uint4*)vt1, b1 = *(const uint4*)(vt1 + 512);
    f.v0 = lohi(a0, b0, 0); f.v1 = lohi(a0, b0, 1); f.v2 = lohi(a1, b1, 0); f.v3 = lohi(a1, b1, 1);
}
DEV void attn_apply(const KVFrag& f, const bf16x8& q0, const bf16x8& q1, f32x4 b0, f32x4 b1, AttnState& st) {
    const f32x4 z = {0.f, 0.f, 0.f, 0.f};
    f32x4 s0 = __builtin_amdgcn_mfma_f32_16x16x32_bf16(f.k00, q0, z, 0, 0, 0); s0 = __builtin_amdgcn_mfma_f32_16x16x32_bf16(f.k01, q1, s0, 0, 0, 0);
    f32x4 s1 = __builtin_amdgcn_mfma_f32_16x16x32_bf16(f.k10, q0, z, 0, 0, 0); s1 = __builtin_amdgcn_mfma_f32_16x16x32_bf16(f.k11, q1, s1, 0, 0, 0);
    s0 = s0 * LOG2E + b0; s1 = s1 * LOG2E + b1;
    float mx = fmaxf(fmaxf(fmaxf(s0[0], s0[1]), fmaxf(s0[2], s0[3])), fmaxf(fmaxf(s1[0], s1[1]), fmaxf(s1[2], s1[3])));
    mx = fmaxf(mx, shx(mx, 16)); mx = fmaxf(mx, shx(mx, 32));
    const float mn = fmaxf(st.m, mx);
    const float ms = (mn == -INFINITY) ? 0.f : mn;
    const float alpha = __builtin_amdgcn_exp2f(st.m - ms);
    f32x4 p0, p1;
#pragma unroll
    for (int j = 0; j < 4; ++j) { p0[j] = __builtin_amdgcn_exp2f(s0[j] - ms); p1[j] = __builtin_amdgcn_exp2f(s1[j] - ms); }
    st.lsum = st.lsum * alpha + ((p0[0] + p0[1]) + (p0[2] + p0[3])) + ((p1[0] + p1[1]) + (p1[2] + p1[3]));
    st.o0 = st.o0 * alpha; st.o1 = st.o1 * alpha; st.o2 = st.o2 * alpha; st.o3 = st.o3 * alpha;
    union { uint4 u; bf16x8 v; } pt; pt.u = make_uint4(pk2(p0[0], p0[1]), pk2(p0[2], p0[3]), pk2(p1[0], p1[1]), pk2(p1[2], p1[3]));
    st.o0 = __builtin_amdgcn_mfma_f32_16x16x32_bf16(f.v0, pt.v, st.o0, 0, 0, 0);
    st.o1 = __builtin_amdgcn_mfma_f32_16x16x32_bf16(f.v1, pt.v, st.o1, 0, 0, 0);
    st.o2 = __builtin_amdgcn_mfma_f32_16x16x32_bf16(f.v2, pt.v, st.o2, 0, 0, 0);
    st.o3 = __builtin_amdgcn_mfma_f32_16x16x32_bf16(f.v3, pt.v, st.o3, 0, 0, 0);
    st.m = mn;
}
DEV void attn_init(AttnState& st) { const f32x4 z = {0.f, 0.f, 0.f, 0.f}; st.o0 = z; st.o1 = z; st.o2 = z; st.o3 = z; st.m = -INFINITY; st.lsum = 0.f; }
DEV void attn_store(AttnState& st, bf16_t* orow, float sink2  ) {
    float l = st.lsum; l += shx(l, 16); l += shx(l, 32);
    float sc;
    if (sink2 != -INFINITY) { const float mf = fmaxf(st.m, sink2); const float al = __builtin_amdgcn_exp2f(st.m - mf); l = l * al + __builtin_amdgcn_exp2f(sink2 - mf); sc = al / l; }
    else sc = 1.f / l;
    uint2 w;
    w.x = pk2(st.o0[0] * sc, st.o0[1] * sc); w.y = pk2(st.o0[2] * sc, st.o0[3] * sc); *(uint2*)(orow) = w;
    w.x = pk2(st.o1[0] * sc, st.o1[1] * sc); w.y = pk2(st.o1[2] * sc, st.o1[3] * sc); *(uint2*)(orow + 16) = w;
    w.x = pk2(st.o2[0] * sc, st.o2[1] * sc); w.y = pk2(st.o2[2] * sc, st.o2[3] * sc); *(uint2*)(orow + 32) = w;
    w.x = pk2(st.o3[0] * sc, st.o3[1] * sc); w.y = pk2(st.o3[2] * sc, st.o3[3] * sc); *(uint2*)(orow + 48) = w;
}

constexpr int NTASK_NA = NB * 6 * 128 * 4, NTASK_GQ = NB * 2 * 512, NTASK_CNA = NB * 6 * 16, NTASK_CGQ = NB * 2 * 16;
DEV void attn_task(const Params& p, int l, int tk, const float* rpb2  ) {
    const int lane = tid_() & 63, g = lane >> 4, fr = lane & 15;
    const bf16_t* P = (const bf16_t*)(p.ws + OFF_P);
    bf16_t* X1 = (bf16_t*)(p.ws + OFF_X1);
    const f32x4 z4 = {0.f, 0.f, 0.f, 0.f};
    KVFrag f;
    if (tk < NTASK_NA) {
        const int qtile = tk & 3, r = (tk >> 2) & 127, hb = tk >> 9, h = hb % 6, b = hb / 6;
        const int qc = qtile == 0 ? (fr < 8 ? fr : 48 + fr) : 8 + (qtile - 1) * 16 + fr;
        const int ct0 = qtile == 0 ? 0 : qtile - 1, ct1 = qtile == 0 ? 3 : qtile;
        const int R = b * S + r * 64 + qc;
        const bf16_t* qp = P + (size_t)R * PWS + COL_NAQ + h * 64 + g * 8;
        const bf16x8 q0 = ld16(qp), q1 = ld16(qp + 32);
        const int rs = min(max(r - 4, 0), 120), cs = min(max(qc - 8, 0), 48);
        int ci[8]; bool ok[8];
#pragma unroll
        for (int e = 0; e < 8; ++e) { const int kc = ((e >> 2) ? ct1 : ct0) * 16 + g * 4 + (e & 3); ok[e] = (kc >= cs) && (kc < cs + 16); ci[e] = min(max(kc - qc + 15, 0), 30); }
        const bf16_t* kf = (const bf16_t*)(p.ws + OFF_NAKF) + ((size_t)(b * 6 + h) * 512 + rs * 4) * KVT + lane * 8;
        const bf16_t* vf = (const bf16_t*)(p.ws + OFF_NAVF) + ((size_t)(b * 6 + h) * 512 + rs * 4) * KVT + lane * 8;
        AttnState st; attn_init(st);
#pragma unroll
        for (int ri = 0; ri < 8; ++ri) {
            const float* rb = rpb2 + (h * 15 + (rs + ri - r + 7)) * 31;
            f32x4 b0, b1;
#pragma unroll
            for (int j = 0; j < 4; ++j) { b0[j] = ok[j] ? rb[ci[j]] : -INFINITY; b1[j] = ok[4 + j] ? rb[ci[4 + j]] : -INFINITY; }
            kv_load(kf + (size_t)(ri * 4 + ct0) * KVT, kf + (size_t)(ri * 4 + ct1) * KVT, vf + (size_t)(ri * 4 + ct0) * KVT, vf + (size_t)(ri * 4 + ct1) * KVT, f);
            attn_apply(f, q0, q1, b0, b1, st);
        }
        const bf16_t* kc_ = (const bf16_t*)(p.ws + OFF_NAKFC) + (size_t)(b * 6 + h) * 16 * KVT + lane * 8;
        const bf16_t* vc_ = (const bf16_t*)(p.ws + OFF_NAVFC) + (size_t)(b * 6 + h) * 16 * KVT + lane * 8;
#pragma unroll
        for (int pp = 0; pp < 8; ++pp) { kv_load(kc_ + (size_t)(2 * pp) * KVT, kc_ + (size_t)(2 * pp + 1) * KVT, vc_ + (size_t)(2 * pp) * KVT, vc_ + (size_t)(2 * pp + 1) * KVT, f); attn_apply(f, q0, q1, z4, z4, st); }
        attn_store(st, X1 + (size_t)R * D + 256 + h * 64 + g * 4, -INFINITY);
    } else if (tk < NTASK_NA + NTASK_GQ + NTASK_CNA + NTASK_CGQ && (tk < NTASK_NA + NTASK_GQ || tk >= NTASK_NA + NTASK_GQ + NTASK_CNA)) {
        const bool lat = tk < NTASK_NA + NTASK_GQ;
        const int t2 = lat ? tk - NTASK_NA : tk - (NTASK_NA + NTASK_GQ + NTASK_CNA);
        const int qt = lat ? (t2 & 511) : (t2 & 15), hb = lat ? (t2 >> 9) : (t2 >> 4), kvh = hb & 1, b = hb >> 1;
        const int q0i = qt * 16, R = (lat ? b * S : NLAT + b * CTX) + q0i + fr;
        const bf16_t* qp = P + (size_t)R * PWS + COL_GQ + kvh * 192 + g * 8;
        const bf16x8 qa0 = ld16(qp), qa1 = ld16(qp + 32), qb0 = ld16(qp + 64), qb1 = ld16(qp + 96), qc0 = ld16(qp + 128), qc1 = ld16(qp + 160);
        AttnState sa, sb, sc; attn_init(sa); attn_init(sb); attn_init(sc);
        const bf16_t* kf = (const bf16_t*)(p.ws + OFF_GKF) + (size_t)(b * 2 + kvh) * 512 * KVT + lane * 8;
        const bf16_t* vf = (const bf16_t*)(p.ws + OFF_GVF) + (size_t)(b * 2 + kvh) * 512 * KVT + lane * 8;
        const bf16_t* kc_ = (const bf16_t*)(p.ws + OFF_GKFC) + (size_t)(b * 2 + kvh) * 16 * KVT + lane * 8;
        const bf16_t* vc_ = (const bf16_t*)(p.ws + OFF_GVFC) + (size_t)(b * 2 + kvh) * 16 * KVT + lane * 8;
        const int qi = q0i + fr;
#define GQ_LOAD(i, F) do { const int i_ = (i); if (i_ < 9) { const int kt_ = (q0i - 128 + i_ * 32) >> 4; const int ta_ = min(max(kt_, 0), 511), tb_ = min(max(kt_ + 1, 0), 511); \
            kv_load(kf + (size_t)ta_ * KVT, kf + (size_t)tb_ * KVT, vf + (size_t)ta_ * KVT, vf + (size_t)tb_ * KVT, F); } \
        else { const int c_ = (i_ - 9) * 2; kv_load(kc_ + (size_t)c_ * KVT, kc_ + (size_t)(c_ + 1) * KVT, vc_ + (size_t)c_ * KVT, vc_ + (size_t)(c_ + 1) * KVT, F); } } while (0)
#define GQ_APPLY(i, F) do { const int i_ = (i); f32x4 b0_ = z4, b1_ = z4; if (i_ < 9) { const int kb_ = q0i - 128 + i_ * 32; _Pragma("unroll") for (int j = 0; j < 4; ++j) { const int k0_ = kb_ + g * 4 + j, k1_ = k0_ + 16; \
                b0_[j] = (k0_ >= 0 && k0_ < S && k0_ >= qi - 128 && k0_ <= qi + 128) ? 0.f : -INFINITY; b1_[j] = (k1_ >= 0 && k1_ < S && k1_ >= qi - 128 && k1_ <= qi + 128) ? 0.f : -INFINITY; } } \
            attn_apply(F, qa0, qa1, b0_, b1_, sa); attn_apply(F, qb0, qb1, b0_, b1_, sb); attn_apply(F, qc0, qc1, b0_, b1_, sc); } while (0)
        KVFrag f2;
        const int i0 = lat ? 0 : 9;
        GQ_LOAD(i0, f);
#pragma unroll 1
        for (int i = i0; i < 17; i += 2) {
            if (i + 1 < 17) GQ_LOAD(i + 1, f2);
            GQ_APPLY(i, f);
            if (i + 1 < 17) { if (i + 2 < 17) GQ_LOAD(i + 2, f); GQ_APPLY(i + 1, f2); }
        }
#undef GQ_LOAD
#undef GQ_APPLY
        bf16_t* o = X1 + (size_t)R * D + 640 + kvh * 192 + g * 4;
        attn_store(sa, o, p.gqa_sink[l * 6 + kvh * 3 + 0] * LOG2E); attn_store(sb, o + 64, p.gqa_sink[l * 6 + kvh * 3 + 1] * LOG2E); attn_store(sc, o + 128, p.gqa_sink[l * 6 + kvh * 3 + 2] * LOG2E);
    } else {
        const int t3 = tk - NTASK_NA - NTASK_GQ, qt = t3 & 15, hb = t3 >> 4, h = hb % 6, b = hb / 6;
        const int R = NLAT + b * CTX + qt * 16 + fr;
        const bf16_t* qp = P + (size_t)R * PWS + COL_NAQ + h * 64 + g * 8;
        const bf16x8 q0 = ld16(qp), q1 = ld16(qp + 32);
        AttnState st; attn_init(st);
        const bf16_t* kc_ = (const bf16_t*)(p.ws + OFF_NAKFC) + (size_t)(b * 6 + h) * 16 * KVT + lane * 8;
        const bf16_t* vc_ = (const bf16_t*)(p.ws + OFF_NAVFC) + (size_t)(b * 6 + h) * 16 * KVT + lane * 8;
#pragma unroll
        for (int pp = 0; pp < 8; ++pp) { kv_load(kc_ + (size_t)(2 * pp) * KVT, kc_ + (size_t)(2 * pp + 1) * KVT, vc_ + (size_t)(2 * pp) * KVT, vc_ + (size_t)(2 * pp + 1) * KVT, f); attn_apply(f, q0, q1, z4, z4, st); }
        attn_store(st, X1 + (size_t)R * D + 256 + h * 64 + g * 4, -INFINITY);
    }
}
DEV void ph_attn(const Params& p, int l, float* rpb2  ) {
    for (int i = tid_(); i < 6 * 15 * 31; i += 256) rpb2[i] = p.na_rpb[(size_t)l * 6 * 15 * 31 + i] * LOG2E;
    __syncthreads();
    const int w = tid_() >> 6;
    const int ntask = NTASK_NA + NTASK_GQ + (l == 0 ? NTASK_CNA + NTASK_CGQ : 0);
    for (int tk0 = bid_() * 4 + w; tk0 < ntask; tk0 += gridDim.x * 4) {
        const int tk = tk0 < NTASK_GQ ? NTASK_NA + tk0 : (tk0 < NTASK_GQ + NTASK_NA ? tk0 - NTASK_GQ : tk0);
        attn_task(p, l, tk, rpb2);
    }
}

template <int CTRL> DEV float dppf(float old, float v) { return __builtin_bit_cast(float, __builtin_amdgcn_update_dpp(__builtin_bit_cast(int, old), __builtin_bit_cast(int, v), CTRL, 0xf, 0xf, false)); }
template <bool FWD> DEV void row_scan(float& a, float& b) {
#define RG_STEP(SHR, SHL) { const float ap = FWD ? dppf<SHR>(1.f, a) : dppf<SHL>(1.f, a); const float bp = FWD ? dppf<SHR>(0.f, b) : dppf<SHL>(0.f, b); b = fmaf(a, bp, b); a = a * ap; }
    RG_STEP(0x111, 0x101) RG_STEP(0x112, 0x102) RG_STEP(0x114, 0x104) RG_STEP(0x118, 0x108)
#undef RG_STEP
}
DEV int rg_bwd_chunk(int pos) { return pos == 0 ? 1 : (pos == 1 ? 0 : 67 - pos); }
DEV void rg_coef(const f32x4& za, const f32x4& zi, const f32x4& ba, const f32x4& bi, const f32x4& spc, const f32x4& xv, f32x4& a, f32x4& b) {
#pragma unroll
    for (int j = 0; j < 4; ++j) {
        const float r = 1.f / (1.f + __expf(-(za[j] + ba[j])));
        const float ig = 1.f / (1.f + __expf(-(zi[j] + bi[j])));
        const float la = spc[j] * r;
        const float av = __expf(la);
        const float x2 = 2.f * la;
        float om = x2 * (1.f / 720.f) + (1.f / 120.f); om = om * x2 + (1.f / 24.f); om = om * x2 + (1.f / 6.f); om = om * x2 + 0.5f; om = om * x2 + 1.f; om = -x2 * om;
        if (x2 < -0.25f) om = 1.f - av * av;
        a[j] = av; b[j] = sqrtf(om) * (ig * xv[j]);
    }
}
DEV void rg_item(const Params& p, int l, int rt, bf16_t* lds) {
    const int t = tid_(), lane = t & 63, n = t >> 6, g = lane >> 4, fr = lane & 15;
    const bf16_t* P = (const bf16_t*)(p.ws + OFF_P);
    const bool isctx = rt >= 512;
    const int b = isctx ? (rt - 512) >> 1 : rt >> 6, idx = isctx ? (rt - 512) & 1 : 2 + (rt & 63);
    const int L = isctx ? CTX : S, t0 = isctx ? idx * 128 : (idx - 2) * 128, seqbase = isctx ? NLAT + b * CTX : b * S;
    bf16_t* xl = lds + n * (128 * 64);
    {
        const int c = lane & 7, ch0 = n * 64 + c * 8;
        f32x4 cwa[4], cwb[4];
#pragma unroll
        for (int j = 0; j < 4; ++j) { cwa[j] = *(const f32x4*)(p.conv_w + (l * 4 + j) * 256 + ch0); cwb[j] = *(const f32x4*)(p.conv_w + (l * 4 + j) * 256 + ch0 + 4); }
        const f32x4 cba = *(const f32x4*)(p.conv_b + l * 256 + ch0), cbb = *(const f32x4*)(p.conv_b + l * 256 + ch0 + 4);
#pragma unroll 2
        for (int it = 0; it < 16; ++it) {
            const int tok = it * 8 + (lane >> 3), ts = t0 + tok;
            f32x4 acca = cba, accb = cbb;
#pragma unroll
            for (int j = 0; j < 4; ++j) {
                const int tj = ts + j - 2;
                if (tj >= 0 && tj < L) {
                    const uint4 v = *(const uint4*)(P + (size_t)(seqbase + tj) * PWS + COL_RGX + ch0);
                    const f32x4 xa = {__uint_as_float(v.x << 16), __uint_as_float(v.x & 0xffff0000u), __uint_as_float(v.y << 16), __uint_as_float(v.y & 0xffff0000u)};
                    const f32x4 xb = {__uint_as_float(v.z << 16), __uint_as_float(v.z & 0xffff0000u), __uint_as_float(v.w << 16), __uint_as_float(v.w & 0xffff0000u)};
                    acca = acca + cwa[j] * xa; accb = accb + cwb[j] * xb;
                }
            }
            uint4 o; o.x = pk2(acca[0], acca[1]); o.y = pk2(acca[2], acca[3]); o.z = pk2(accb[0], accb[1]); o.w = pk2(accb[2], accb[3]);
            *(uint4*)(xl + tok * 64 + ((c ^ ((tok >> 1) & 7)) * 8)) = o;
        }
    }
    asm volatile("s_waitcnt lgkmcnt(0)" ::: "memory");
    const bf16_t* W = (const bf16_t*)(p.ws + OFF_WRG) + (size_t)(l * 2) * 2 * 4 * 64 * 64;
    const float* C = (const float*)(p.ws + OFF_RGC) + (size_t)(l * 2) * 3 * 256;
    float* AGG = (float*)(p.ws + OFF_AGG) + (size_t)(b * 66) * 1024;
    const int swz = (fr >> 1) & 7;
#pragma unroll 1
    for (int ct = 0; ct < 4; ++ct) {
        const int ch = n * 64 + ct * 16 + g * 4;
        const f32x4 z4 = {0.f, 0.f, 0.f, 0.f};
#pragma unroll
        for (int dir = 0; dir < 2; ++dir) {
            const bf16x8 wa0 = ld16(W + ((size_t)((dir * 2 + 0) * 4 + n) * 64 + ct * 16 + fr) * 64 + g * 8), wa1 = ld16(W + ((size_t)((dir * 2 + 0) * 4 + n) * 64 + ct * 16 + fr) * 64 + 32 + g * 8);
            const bf16x8 wi0 = ld16(W + ((size_t)((dir * 2 + 1) * 4 + n) * 64 + ct * 16 + fr) * 64 + g * 8), wi1 = ld16(W + ((size_t)((dir * 2 + 1) * 4 + n) * 64 + ct * 16 + fr) * 64 + 32 + g * 8);
            const f32x4 ba = *(const f32x4*)(C + (dir * 3 + 0) * 256 + ch), bi = *(const f32x4*)(C + (dir * 3 + 1) * 256 + ch), spc = *(const f32x4*)(C + (dir * 3 + 2) * 256 + ch);
            f32x4 hin = z4, apre = {1.f, 1.f, 1.f, 1.f};
#pragma unroll
            for (int s = 0; s < 8; ++s) {
                const int tt = dir == 0 ? s : 7 - s;
                const int row = tt * 16 + fr;
                const bf16x8 x0 = *(const bf16x8*)(xl + row * 64 + ((g ^ swz) * 8)), x1 = *(const bf16x8*)(xl + row * 64 + (((g | 4) ^ swz) * 8));
                f32x4 za = __builtin_amdgcn_mfma_f32_16x16x32_bf16(wa0, x0, z4, 0, 0, 0); za = __builtin_amdgcn_mfma_f32_16x16x32_bf16(wa1, x1, za, 0, 0, 0);
                f32x4 zi = __builtin_amdgcn_mfma_f32_16x16x32_bf16(wi0, x0, z4, 0, 0, 0); zi = __builtin_amdgcn_mfma_f32_16x16x32_bf16(wi1, x1, zi, 0, 0, 0);
                const uint2 xr = *(const uint2*)(xl + row * 64 + (((ct * 2 + (g >> 1)) ^ swz) * 8) + (g & 1) * 4);
                const f32x4 xv = {__uint_as_float(xr.x << 16), __uint_as_float(xr.x & 0xffff0000u), __uint_as_float(xr.y << 16), __uint_as_float(xr.y & 0xffff0000u)};
                f32x4 a, bb;
                rg_coef(za, zi, ba, bi, spc, xv, a, bb);
                f32x4 h, ac;
#pragma unroll
                for (int j = 0; j < 4; ++j) {
                    float aj = a[j], bj = bb[j];
                    if (dir == 0) row_scan<true>(aj, bj); else row_scan<false>(aj, bj);
                    h[j] = fmaf(aj, hin[j], bj);
                    ac[j] = aj * apre[j];
                }
                {
                    bf16_t* xo = (bf16_t*)(p.ws + OFF_X2) + ((size_t)seqbase + t0 + row) * D + dir * 512 + ch;
                    uint2 o; o.x = pk2(ac[0], ac[1]); o.y = pk2(ac[2], ac[3]); *(uint2*)xo = o;
                    o.x = pk2(h[0], h[1]); o.y = pk2(h[2], h[3]); *(uint2*)(xo + 256) = o;
                }
                const int src = (lane & 48) | (dir == 0 ? 15 : 0);
#pragma unroll
                for (int j = 0; j < 4; ++j) { hin[j] = shl_(h[j], src); apre[j] = shl_(ac[j], src); }
            }
            if (fr == 0) { *(f32x4*)(AGG + (size_t)(idx * 2 + dir) * 512 + ch) = apre; *(f32x4*)(AGG + (size_t)(idx * 2 + dir) * 512 + 256 + ch) = hin; }
        }
    }
}
DEV void rg_final(const Params& p, int l, int rt) {
    const int t = tid_(), cg4 = (t & 63) * 4, tp = t >> 6;
    const bool isctx = rt >= 512;
    const int b = isctx ? (rt - 512) >> 1 : rt >> 6, idx = isctx ? (rt - 512) & 1 : 2 + (rt & 63);
    const float* AGG = (const float*)(p.ws + OFF_AGG) + (size_t)(b * 66) * 1024;
    f32x4 hf = {0.f, 0.f, 0.f, 0.f}, hb = {0.f, 0.f, 0.f, 0.f};
    {
#pragma unroll 4
        for (int q = 0; q < idx; ++q) { const f32x4 A = *(const f32x4*)(AGG + (size_t)(q * 2) * 512 + cg4), B = *(const f32x4*)(AGG + (size_t)(q * 2) * 512 + 256 + cg4); hf = A * hf + B; }
        const int npre = idx == 1 ? 0 : (idx == 0 ? 1 : 67 - idx);
#pragma unroll 4
        for (int q = 0; q < npre; ++q) { const int cq = rg_bwd_chunk(q); const f32x4 A = *(const f32x4*)(AGG + (size_t)(cq * 2 + 1) * 512 + cg4), B = *(const f32x4*)(AGG + (size_t)(cq * 2 + 1) * 512 + 256 + cg4); hb = A * hb + B; }
    }
    const bf16_t* X2 = (const bf16_t*)(p.ws + OFF_X2); const bf16_t* P = (const bf16_t*)(p.ws + OFF_P); bf16_t* X1 = (bf16_t*)(p.ws + OFF_X1);
#pragma unroll 4
    for (int i = 0; i < 32; ++i) {
        const size_t R = (size_t)rt * 128 + i * 4 + tp;
        const uint2 af = *(const uint2*)(X2 + R * D + cg4), bf = *(const uint2*)(X2 + R * D + 256 + cg4), ab = *(const uint2*)(X2 + R * D + 512 + cg4), bb = *(const uint2*)(X2 + R * D + 768 + cg4);
        const uint2 gr = *(const uint2*)(P + R * PWS + COL_GATE + cg4);
#define BLO(u) __uint_as_float((u) << 16)
#define BHI(u) __uint_as_float((u) & 0xffff0000u)
        const float h0 = (BLO(af.x) * hf[0] + BLO(bf.x)) + (BLO(ab.x) * hb[0] + BLO(bb.x));
        const float h1 = (BHI(af.x) * hf[1] + BHI(bf.x)) + (BHI(ab.x) * hb[1] + BHI(bb.x));
        const float h2 = (BLO(af.y) * hf[2] + BLO(bf.y)) + (BLO(ab.y) * hb[2] + BLO(bb.y));
        const float h3 = (BHI(af.y) * hf[3] + BHI(bf.y)) + (BHI(ab.y) * hb[3] + BHI(bb.y));
        uint2 o; o.x = pk2(h0 * gelu_tanh(BLO(gr.x)), h1 * gelu_tanh(BHI(gr.x))); o.y = pk2(h2 * gelu_tanh(BLO(gr.y)), h3 * gelu_tanh(BHI(gr.y)));
#undef BLO
#undef BHI
        *(uint2*)(X1 + R * D + cg4) = o;
    }
}
DEV void ph_rgagg(const Params& p, int l, bf16_t* lds) {
    for (int rt = bid_(); rt < 528; rt += gridDim.x) { rg_item(p, l, rt, lds); __syncthreads(); }
}

DEV void outproj_item(const Params& p_, int l, int rt, bf16_t* lds, float* stat  ) {
    const Params& p = kp_();
    const int t = tid_(), lane = t & 63, w = t >> 6, wm = w >> 1, wn = w & 1, fq = lane >> 4, fr = lane & 15;
    const bf16_t* A = (const bf16_t*)(p.ws + OFF_X1) + (size_t)(rt * 128) * D;
    const bool isctx = rt >= 512;
    const float* g1 = modvec(p, l, rt * 128, 2);
    rg_final(p, l, rt);
    __threadfence();
    __syncthreads();
    __builtin_amdgcn_fence(__ATOMIC_ACQUIRE, "agent");
#pragma unroll 1
    for (int pass = 0; pass < 4; ++pass) {
        const bf16_t* Bt = (const bf16_t*)(p.ws + OFF_WOUTT) + ((size_t)l * 1024 + pass * 256) * 1024;
        const unsigned toff = (unsigned)(((tid_() >> 2) * 1024 + gemm_src_chunk(tid_())) * 2);
        f32x4 acc[4][8]; zero_acc(acc);
        gemm_mainloop(A, toff, toff + 64 * D * 2, Bt, toff, 1024, 32, lds, acc);
#pragma unroll
        for (int mt = 0; mt < 4; ++mt) {
            const int rl = wm * 64 + mt * 16 + fr, R = rt * 128 + rl;
            const float* xin = (l == 0) ? (isctx ? p.ctx + (size_t)(R - NLAT) * D : p.x + (size_t)R * D) : xres_row(p, R);
            float* xo = xres_row(p, R);
            float s = 0.f, q = 0.f;
#pragma unroll
            for (int nt = 0; nt < 8; ++nt) {
                const int col = pass * 256 + wn * 128 + nt * 16 + fq * 4;
                const f32x4 xv = *(const f32x4*)(xin + col), gv = *(const f32x4*)(g1 + col);
                const f32x4 u = xv * ALPHA + gv * acc[mt][nt];
                *(f32x4*)(xo + col) = u;
                s += (u[0] + u[1]) + (u[2] + u[3]); q += (u[0] * u[0] + u[1] * u[1]) + (u[2] * u[2] + u[3] * u[3]);
            }
            s += shx(s, 16); s += shx(s, 32); q += shx(q, 16); q += shx(q, 32);
            if (fq == 0) { float* sp = stat + (wn * 128 + rl) * 2; if (pass == 0) { sp[0] = s; sp[1] = q; } else { sp[0] += s; sp[1] += q; } }
        }
    }
    __threadfence();
    __syncthreads();
    __builtin_amdgcn_fence(__ATOMIC_ACQUIRE, "agent");
    {
        const float* lg = p.ln1_g + l * D; const float* lb = p.ln1_b + l * D;
        const float* sh2 = modvec(p, l, rt * 128, 3); const float* sc2 = modvec(p, l, rt * 128, 4);
        bf16_t* X2 = (bf16_t*)(p.ws + OFF_X2);
        const bf16_t* WRh = (const bf16_t*)(p.ws + OFF_WR) + (size_t)(l * 2) * 48 * 1024 + (size_t)fr * 1024 + fq * 8;
        const bf16_t* WRl = WRh + 48 * 1024;
        float mean[2], rstd[2];
#pragma unroll
        for (int tm = 0; tm < 2; ++tm) {
            const int rl = w * 32 + tm * 16 + fr;
            float s = 0.f, q = 0.f;
#pragma unroll
            for (int i = 0; i < 2; ++i) { s += stat[(i * 128 + rl) * 2]; q += stat[(i * 128 + rl) * 2 + 1]; }
            mean[tm] = s * (1.f / D);
            rstd[tm] = rsqrtf(fmaxf(q * (1.f / D) - mean[tm] * mean[tm], 0.f) + LN_EPS);
        }
        f32x4 lacc[3][2];
#pragma unroll
        for (int a = 0; a < 3; ++a) { lacc[a][0] = (f32x4){0.f, 0.f, 0.f, 0.f}; lacc[a][1] = (f32x4){0.f, 0.f, 0.f, 0.f}; }
#pragma unroll 2
        for (int ks = 0; ks < 32; ++ks) {
            const int k = ks * 32 + fq * 8;
            const f32x4 g0 = *(const f32x4*)(lg + k), g1v = *(const f32x4*)(lg + k + 4), b0 = *(const f32x4*)(lb + k), b1 = *(const f32x4*)(lb + k + 4);
            const f32x4 s0 = *(const f32x4*)(sh2 + k), s1 = *(const f32x4*)(sh2 + k + 4), c0 = *(const f32x4*)(sc2 + k), c1 = *(const f32x4*)(sc2 + k + 4);
            bf16x8 hh[2], hl[2];
#pragma unroll
            for (int tm = 0; tm < 2; ++tm) {
                const int R = rt * 128 + w * 32 + tm * 16 + fr;
                float* xr = xres_row(p, R) + k;
                const f32x4 u0 = *(const f32x4*)xr, u1 = *(const f32x4*)(xr + 4);
                const f32x4 x0 = (u0 - mean[tm]) * rstd[tm] * g0 + b0, x1 = (u1 - mean[tm]) * rstd[tm] * g1v + b1;
                *(f32x4*)xr = x0; *(f32x4*)(xr + 4) = x1;
                const f32x4 h0 = x0 * (c0 + 1.f) + s0, h1 = x1 * (c1 + 1.f) + s1;
#pragma unroll
                for (int e = 0; e < 4; ++e) {
                    const bf16_t a = f2bf(h0[e]), b = f2bf(h1[e]);
                    hh[tm][e] = (short)a; hh[tm][4 + e] = (short)b;
                    hl[tm][e] = (short)f2bf(h0[e] - bf2f(a)); hl[tm][4 + e] = (short)f2bf(h1[e] - bf2f(b));
                }
                *(bf16x8*)(X2 + (size_t)R * D + k) = hh[tm];
            }
#pragma unroll
            for (int ft = 0; ft < 3; ++ft) {
                const bf16x8 wh = *(const bf16x8*)(WRh + (size_t)ft * 16 * 1024 + ks * 32), wl = *(const bf16x8*)(WRl + (size_t)ft * 16 * 1024 + ks * 32);
#pragma unroll
                for (int tm = 0; tm < 2; ++tm) {
                    lacc[ft][tm] = __builtin_amdgcn_mfma_f32_16x16x32_bf16(wh, hh[tm], lacc[ft][tm], 0, 0, 0);
                    lacc[ft][tm] = __builtin_amdgcn_mfma_f32_16x16x32_bf16(wl, hh[tm], lacc[ft][tm], 0, 0, 0);
                    lacc[ft][tm] = __builtin_amdgcn_mfma_f32_16x16x32_bf16(wh, hl[tm], lacc[ft][tm], 0, 0, 0);
                }
            }
        }
        float* lt = (float*)lds;
#pragma unroll
        for (int ft = 0; ft < 3; ++ft)
#pragma unroll
            for (int tm = 0; tm < 2; ++tm)
#pragma unroll
                for (int j = 0; j < 4; ++j) lt[(w * 32 + tm * 16 + fr) * 48 + ft * 16 + fq * 4 + j] = lacc[ft][tm][j];
        asm volatile("s_waitcnt lgkmcnt(0)" ::: "memory");
        if (lane < 32) {
            const int rl = w * 32 + lane, R = rt * 128 + rl;
            const float* lr = lt + rl * 48;
            int gi = 0; float gm = lr[0] + p.router_g_b[l * 4];
            float gl[4]; gl[0] = gm;
#pragma unroll
            for (int j = 1; j < 4; ++j) { gl[j] = lr[j] + p.router_g_b[l * 4 + j]; if (gl[j] > gm) { gm = gl[j]; gi = j; } }
            float gs = 0.f;
#pragma unroll
            for (int j = 0; j < 4; ++j) gs += expf(gl[j] - gm);
            const float ptop = 1.f / gs;
            int e0 = 0, e1 = 0; float m0 = -INFINITY, m1 = -INFINITY;
            for (int j = 0; j < 8; ++j) {
                const float v = lr[4 + gi * 8 + j] + p.router_e_b[l * 32 + gi * 8 + j];
                if (v > m0) { m1 = m0; e1 = e0; m0 = v; e0 = j; } else if (v > m1) { m1 = v; e1 = j; }
            }
            const float ex = expf(m1 - m0);
            const float w0 = ptop / (1.f + ex), w1 = ptop * ex / (1.f + ex);
            int* rte = (int*)(p.ws + OFF_RTE); float* rtw = (float*)(p.ws + OFF_RTW);
            unsigned* cnt = (unsigned*)(p.ws + OFF_CTL) + CW_CNT + l * 32;
            int* list = (int*)(p.ws + OFF_LIST);
            const int E0 = gi * 8 + e0, E1 = gi * 8 + e1;
            rte[R * 2] = E0; rte[R * 2 + 1] = E1; rtw[R * 2] = w0; rtw[R * 2 + 1] = w1;
            const unsigned p0 = atomicAdd(cnt + E0, 1u); list[(size_t)E0 * LISTCAP + p0] = R * 2;
            const unsigned p1 = atomicAdd(cnt + E1, 1u); list[(size_t)E1 * LISTCAP + p1] = R * 2 + 1;
        }
    }
}
DEV void ph_outproj(const Params& p, int l, bf16_t* lds, float* stat  ) {
    const int ntiles = (l == 0) ? 528 : 512;
    for (int rt = bid_(); rt < ntiles; rt += gridDim.x) { outproj_item(p, l, rt, lds, stat); __syncthreads(); }
}

DEV void moe1_item(const Params& p_, int l, int e, int jb, int pass, int item, int cnt, bf16_t* lds) {
    const Params& p = kp_();
    const int t = tid_(), lane = t & 63, w = t >> 6, wm = w >> 1, wn = w & 1, fq = lane >> 4, fr = lane & 15;
    const int* list = (const int*)(p.ws + OFF_LIST) + (size_t)e * LISTCAP;
    const bf16_t* X2 = (const bf16_t*)(p.ws + OFF_X2);
    bf16_t* Hs = (bf16_t*)(p.ws + OFF_P) + (size_t)item * 128 * FF;
    unsigned ao0, ao1;
    { const int s0 = jb * 128 + (t >> 2), s1 = s0 + 64;
      const int tok0 = s0 < cnt ? (list[s0] >> 1) : 0, tok1 = s1 < cnt ? (list[s1] >> 1) : 0;
      ao0 = (unsigned)((tok0 * D + gemm_src_chunk(t)) * 2); ao1 = (unsigned)((tok1 * D + gemm_src_chunk(t)) * 2); }
    const bf16_t* Bt = (const bf16_t*)(p.ws + OFF_WGU) + ((size_t)e * 1024 + pass * 256) * 1024;
    f32x4 acc[4][8]; zero_acc(acc);
    gemm_mainloop(X2, ao0, ao1, Bt, (unsigned)(((t >> 2) * 1024 + gemm_src_chunk(t)) * 2), 1024, 32, lds, acc);
#pragma unroll
    for (int mt = 0; mt < 4; ++mt) {
        const int rl = wm * 64 + mt * 16 + fr;
#pragma unroll
        for (int nt = 0; nt < 4; ++nt) {
            const f32x4 gv = acc[mt][nt], uv = acc[mt][nt + 4];
            float hv[4];
#pragma unroll
            for (int jj = 0; jj < 4; ++jj) hv[jj] = gv[jj] / (1.f + __expf(-gv[jj])) * uv[jj];
            uint2 o; o.x = pk2(hv[0], hv[1]); o.y = pk2(hv[2], hv[3]);
            *(uint2*)(Hs + (size_t)rl * FF + pass * 128 + wn * 64 + nt * 16 + fq * 4) = o;
        }
    }
}
DEV void moe2_item(const Params& p_, int l, int e, int jb, int pass, int item, int cnt, bf16_t* lds) {
    const Params& p = kp_();
    const int t = tid_(), lane = t & 63, w = t >> 6, wm = w >> 1, wn = w & 1, fq = lane >> 4, fr = lane & 15;
    const int* list = (const int*)(p.ws + OFF_LIST) + (size_t)e * LISTCAP;
    const bf16_t* Hs = (const bf16_t*)(p.ws + OFF_P) + (size_t)item * 128 * FF;
    const unsigned hoff = (unsigned)(((t >> 2) * FF + gemm_src_chunk(t)) * 2);
    const float* rtw = (const float*)(p.ws + OFF_RTW);
    bf16_t* Y = (bf16_t*)(p.ws + OFF_Y);
    const bf16_t* Bt = (const bf16_t*)(p.ws + OFF_WD) + ((size_t)e * 1024 + pass * 256) * FF;
    f32x4 acc[4][8]; zero_acc(acc);
    gemm_mainloop(Hs, hoff, hoff + 64 * FF * 2, Bt, hoff, FF, 16, lds, acc);
#pragma unroll
    for (int mt = 0; mt < 4; ++mt) {
        const int s = jb * 128 + wm * 64 + mt * 16 + fr;
        if (s < cnt) {
            const int ent = list[s];
            const float gw = rtw[ent];
            bf16_t* yo = Y + (size_t)ent * D + pass * 256 + wn * 128 + fq * 4;
#pragma unroll
            for (int nt = 0; nt < 8; ++nt) { const f32x4 v = acc[mt][nt] * gw; uint2 o; o.x = pk2(v[0], v[1]); o.y = pk2(v[2], v[3]); *(uint2*)(yo + nt * 16) = o; }
        }
    }
}
template <int STAGE> DEV void ph_moe(const Params& p, int l, bf16_t* lds, int* s_pref  , int* s_cnt  ) {
    const unsigned* cnt = (const unsigned*)(p.ws + OFF_CTL) + CW_CNT + l * 32;
    if (tid_() == 0) { int a = 0; for (int e = 0; e < 32; ++e) { const int c = (int)cnt[e]; s_cnt[e] = c; s_pref[e] = a; a += (c + 127) >> 7; } s_pref[32] = a; }
    __syncthreads();
    const int nx = gridDim.x >> 3, xcd = bid_() & 7, j = bid_() >> 3;
    if (bid_() < nx * 8) {
        const int n0 = (s_cnt[xcd] + 127) >> 7, n1 = (s_cnt[xcd + 8] + 127) >> 7, n2 = (s_cnt[xcd + 16] + 127) >> 7, n3 = (s_cnt[xcd + 24] + 127) >> 7;
        const int nloc = (n0 + n1 + n2 + n3) * 4;
        for (int i = j; i < nloc; i += nx) {
            const int pass = i & 3, ib = i >> 2;
            int e, jb;
            if (ib < n0) { e = xcd; jb = ib; } else if (ib < n0 + n1) { e = xcd + 8; jb = ib - n0; } else if (ib < n0 + n1 + n2) { e = xcd + 16; jb = ib - n0 - n1; } else { e = xcd + 24; jb = ib - n0 - n1 - n2; }
            if (STAGE == 1) moe1_item(p, l, e, jb, pass, s_pref[e] + jb, s_cnt[e], lds); else moe2_item(p, l, e, jb, pass, s_pref[e] + jb, s_cnt[e], lds);
        }
    }
    __syncthreads();
}

#define XB_TMO      128
#define XB_XCNT(j)  (256  + 64 * (j))
#define XB_XSUB(j)  (1280 + 64 * (j))
#define XB_XGEN(j)  (2304 + 64 * (j))
#define XB_TOP      3328
#define XB_TOPGEN   3392
#define XCD_BAR_WORDS 3456
#define XB_SPIN_CAP (1u << 20)
DEV unsigned xb_ld(unsigned* p) { return __hip_atomic_load(p, __ATOMIC_RELAXED, __HIP_MEMORY_SCOPE_AGENT); }
DEV unsigned xb_add(unsigned* p, unsigned v) { return __hip_atomic_fetch_add(p, v, __ATOMIC_RELAXED, __HIP_MEMORY_SCOPE_AGENT); }
DEV unsigned xb_xcc_id() { return (unsigned)__builtin_amdgcn_s_getreg((3 << 11) | 20) & 0xFu; }
#define XB_SPIN(cond, bar) do { unsigned _sp = 0; while (cond) { __builtin_amdgcn_s_sleep(1); \
    if ((++_sp & 255u) == 0u) { if (xb_ld(&(bar)[XB_TMO])) break; if (_sp > XB_SPIN_CAP) { atomicAdd(&(bar)[XB_TMO], 1u); break; } } } } while (0)
struct XcdBarrier { unsigned* bar; unsigned x; volatile LAS unsigned* st; };
DEV XcdBarrier xcd_barrier_post(unsigned* bar, volatile LAS unsigned* st) {
    XcdBarrier b; b.bar = bar; b.x = xb_xcc_id(); b.st = st;
    if (tid_() == 0) (void)xb_add(&bar[XB_XCNT(b.x)], 1u);
    return b;
}
DEV void xcd_barrier_complete(unsigned* bar, unsigned x, unsigned& nloc, unsigned& nx) {
    const unsigned G = gridDim.x * gridDim.y * gridDim.z;
    unsigned sum, cnt, mine, sp = 0u;
    for (;;) {
        sum = 0u; cnt = 0u; mine = 0u;
#pragma unroll
        for (unsigned j = 0; j < 16; ++j) { const unsigned c = xb_ld(&bar[XB_XCNT(j)]); sum += c; cnt += (c > 0u) ? 1u : 0u; mine = (j == x) ? c : mine; }
        if (sum == G) break;
        __builtin_amdgcn_s_sleep(1);
        if ((++sp & 255u) == 0u) { if (xb_ld(&bar[XB_TMO])) break; if (sp > XB_SPIN_CAP) { atomicAdd(&bar[XB_TMO], 1u); break; } }
    }
    nloc = mine > 0u ? mine : 1u; nx = cnt > 0u ? cnt : 1u;
}
DEV void xcd_barrier(const XcdBarrier& b) {
    asm volatile("s_waitcnt vmcnt(0)" ::: "memory");
    __syncthreads();
    if (tid_() == 0) {
        unsigned* bar = b.bar;
        __builtin_amdgcn_s_waitcnt(0);
        unsigned nloc = b.st[0], nx = b.st[1];
        if (nloc == 0u) { xcd_barrier_complete(bar, b.x, nloc, nx); b.st[0] = nloc; b.st[1] = nx; }
        const unsigned old = xb_add(&bar[XB_XSUB(b.x)], 1u);
        const unsigned gen = old / nloc;
        if (old + 1u == (gen + 1u) * nloc) {
            __builtin_amdgcn_fence(__ATOMIC_RELEASE, "agent");
            asm volatile("s_waitcnt vmcnt(0)" ::: "memory");
            const unsigned og = xb_add(&bar[XB_TOP], 1u);
            const unsigned tg = og / nx;
            if (og + 1u == (tg + 1u) * nx) xb_add(&bar[XB_TOPGEN], 1u);
            else XB_SPIN(xb_ld(&bar[XB_TOPGEN]) == tg, bar);
            __builtin_amdgcn_fence(__ATOMIC_ACQUIRE, "agent");
            xb_add(&bar[XB_XGEN(b.x)], 1u);
            asm volatile("s_waitcnt vmcnt(0)" ::: "memory");
        } else {
            XB_SPIN(xb_ld(&bar[XB_XGEN(b.x)]) == gen, bar);
            __builtin_amdgcn_fence(__ATOMIC_ACQUIRE, "agent");
            asm volatile("s_waitcnt vmcnt(0)" ::: "memory");
        }
    }
    __syncthreads();
}

namespace cg = cooperative_groups;
#define REP(id) for (int rep_ = 0; rep_ < ((PROBE_ID) == (id) ? PROBE_N : 1); ++rep_)
constexpr int SMEM_STAT = GEMM_LDS_BYTES;
constexpr int SMEM_BYTES = GEMM_LDS_BYTES + 2048 + 512;
constexpr int NPHASE = 14;
__global__ void __launch_bounds__(256, 2) mega(Params p, int ph_lo, int ph_hi) {
    extern __shared__ __attribute__((aligned(16))) unsigned char smem[];
    bf16_t* lds = (bf16_t*)smem;
    float* stat = (float*)(smem + SMEM_STAT);
    int* s_pref = (int*)(smem + SMEM_STAT + 2048); int* s_cnt = s_pref + 40;
    volatile LAS unsigned* bst = (volatile LAS unsigned*)(LAS unsigned char*)(smem + SMEM_STAT + 2048 + 400);
    if (tid_() < 2) bst[tid_()] = 0u;
    __syncthreads();
    (void)xcd_barrier_post((unsigned*)(kp_().ws + OFF_CTL + 4096), bst);
#define GRID_BAR() do { XcdBarrier xb_; xb_.bar = (unsigned*)(kp_().ws + OFF_CTL + 4096); xb_.x = xb_xcc_id(); \
        xb_.st = (volatile LAS unsigned*)(LAS unsigned char*)(smem + SMEM_STAT + 2048 + 400); xcd_barrier(xb_); } while (0)
#define IN(k) (ph_lo <= (k) && (k) < ph_hi)
#define SEAM(k) do { if (IN(k) && IN((k) + 1)) { if ((k) == 0) cg::this_grid().sync(); else GRID_BAR(); } } while (0)
    if (IN(0)) {
        REP(0) { ph_mod(kp_(), (float*)smem); __syncthreads(); }
        ph_rope(kp_());
        ph_routerw(kp_());
        ph_rgprep(kp_());
        REP(1) ph_transpose(kp_().w_in, (bf16_t*)(kp_().ws + OFF_WINT), 1024, 2304, 0, 2, (size_t)1024 * 2304, (size_t)2304 * 1024, (float*)smem);
        ph_transpose(kp_().w_out, (bf16_t*)(kp_().ws + OFF_WOUTT), 1024, 1024, 0, 2, (size_t)1024 * 1024, (size_t)1024 * 1024, (float*)smem);
    }
    SEAM(0);
#define LAYER_BODY(l, pb) { \
        if (IN(pb + 0)) { if (l == 0) { REP(2) ph_rowop<0>(kp_(), 0, NTOK); } else ph_rowop<1>(kp_(), 1, NTOK); } \
        SEAM(pb + 0); \
        if (IN(pb + 1)) { ph_inproj(kp_(), l, lds); } \
        SEAM(pb + 1); \
        if (IN(pb + 2)) { \
            REP(4) ph_rgagg(kp_(), l, lds); \
            REP(5) { ph_attn(kp_(), l, (float*)smem); __syncthreads(); } \
            REP(6) { \
            ph_transpose(kp_().exp_w_gate + (size_t)l * NE * 1024 * 512, (bf16_t*)(kp_().ws + OFF_WGU), 1024, 512, 1, NE, (size_t)1024 * 512, (size_t)1024 * 1024, (float*)smem); \
            ph_transpose(kp_().exp_w_up + (size_t)l * NE * 1024 * 512, (bf16_t*)(kp_().ws + OFF_WGU), 1024, 512, 2, NE, (size_t)1024 * 512, (size_t)1024 * 1024, (float*)smem); \
            ph_transpose(kp_().exp_w_down + (size_t)l * NE * 512 * 1024, (bf16_t*)(kp_().ws + OFF_WD), 512, 1024, 0, NE, (size_t)512 * 1024, (size_t)1024 * 512, (float*)smem); \
            } \
        } \
        SEAM(pb + 2); \
        if (IN(pb + 3)) ph_outproj(kp_(), l, lds, stat); \
        SEAM(pb + 3); \
        if (IN(pb + 4)) { REP(7) { ph_moe<1>(kp_(), l, lds, s_pref, s_cnt); } } \
        SEAM(pb + 4); \
        if (IN(pb + 5)) { REP(8) { ph_moe<2>(kp_(), l, lds, s_pref, s_cnt); } } \
        SEAM(pb + 5); \
    }
    LAYER_BODY(0, 1)
    LAYER_BODY(1, 7)
#undef LAYER_BODY
    if (IN(NPHASE - 1)) ph_rowop<2>(kp_(), 2, NLAT);
#undef IN
#undef SEAM
}

#ifndef ONE_LAUNCH
#define ONE_LAUNCH 1
#endif
extern "C" void kernel_launch(void* const* d_in, const int* in_sizes, int n_in, void* d_out, int out_size, void* d_ws, size_t ws_size, hipStream_t stream) {
    if (n_in != 28 || ws_size < WS_TOTAL || out_size != NLAT * D) { fprintf(stderr, "kernel_launch: unexpected shapes / workspace (%d inputs, ws %zu need %zu)\n", n_in, ws_size, (size_t)WS_TOTAL); return; }
    static int grid = 0;
    if (grid == 0) {
        int dev = 0, cus = 0, per_cu = 0;
        (void)hipGetDevice(&dev);
        (void)hipDeviceGetAttribute(&cus, hipDeviceAttributeMultiprocessorCount, dev);
        (void)hipFuncSetAttribute((const void*)mega, hipFuncAttributeMaxDynamicSharedMemorySize, SMEM_BYTES);
        (void)hipOccupancyMaxActiveBlocksPerMultiprocessor(&per_cu, (const void*)mega, 256, SMEM_BYTES);
        if (per_cu > 2) per_cu = 2;
        grid = cus * per_cu;
        if (grid <= 0) { fprintf(stderr, "kernel_launch: occupancy query gave %d blocks per CU on %d CUs\n", per_cu, cus); grid = -1; }
    }
    if (grid < 0) return;
    Params p{};
    const float** pp = (const float**)&p;
    for (int i = 0; i < 28; ++i) pp[i] = (const float*)d_in[i];
    p.out = (float*)d_out; p.ws = (unsigned char*)d_ws;
    (void)hipMemsetAsync((unsigned char*)d_ws + OFF_CTL, 0, CTL_BYTES, stream);
#if ONE_LAUNCH
    int lo = 0, hi = NPHASE;
    void* args[] = {(void*)&p, (void*)&lo, (void*)&hi};
    hipError_t e = hipLaunchCooperativeKernel((const void*)mega, dim3(grid), dim3(256), args, SMEM_BYTES, stream);
    if (e != hipSuccess) fprintf(stderr, "kernel_launch: cooperative launch failed: %s (grid %d)\n", hipGetErrorString(e), grid);
#else
    for (int ph = 0; ph < NPHASE; ++ph) mega<<<grid, 256, SMEM_BYTES, stream>>>(p, ph, ph + 1);
#endif
}
```

```cpp
#include <hip/hip_runtime.h>
#include <hip/hip_cooperative_groups.h>
#include <stdint.h>
#include <cstdio>

typedef unsigned short bf16_t;
typedef short bf16x8 __attribute__((ext_vector_type(8)));
typedef float f32x4 __attribute__((ext_vector_type(4)));

#define DEV __device__ __forceinline__
#define PROBE_ID -1
#define PROBE_N 4

constexpr int D = 1024, NB = 8, S = 8192, CTX = 256;
constexpr int NLAT = NB * S, NCTX = NB * CTX, NTOK = NLAT + NCTX;
constexpr int PWS = 1280;
constexpr int COL_RGX = 0, COL_GATE = 256, COL_NAQ = 512, COL_GQ = 896;
constexpr int KVT = 1024;
constexpr int NE = 32, FF = 512;
constexpr int LISTCAP = NTOK;
constexpr float ALPHA = 1.4142135623730951f;
constexpr float LN_EPS = 1e-5f;

constexpr size_t al256(size_t x) { return (x + 255) & ~(size_t)255; }
constexpr size_t OFF_CTL   = 0;
constexpr size_t CTL_BYTES = 4096 + 16384;
constexpr size_t OFF_MOD   = OFF_CTL + CTL_BYTES;
constexpr size_t OFF_ROPE  = al256(OFF_MOD + (size_t)2 * 9 * 6144 * 4);
constexpr size_t OFF_RTE   = al256(OFF_ROPE + (size_t)2 * 128 * 16 * 4);
constexpr size_t OFF_RTW   = al256(OFF_RTE + (size_t)NTOK * 8);
constexpr size_t OFF_LIST  = al256(OFF_RTW + (size_t)NTOK * 8);
constexpr size_t OFF_WR    = al256(OFF_LIST + (size_t)NE * LISTCAP * 4);
constexpr size_t OFF_WRG   = al256(OFF_WR + (size_t)2 * 2 * 48 * 1024 * 2);
constexpr size_t OFF_RGC   = al256(OFF_WRG + (size_t)2 * 2 * 2 * 4 * 64 * 64 * 2);
constexpr size_t OFF_AGG   = al256(OFF_RGC + (size_t)2 * 2 * 3 * 256 * 4);
constexpr size_t OFF_WINT  = al256(OFF_AGG + (size_t)NB * 66 * 2 * 2 * 256 * 4);
constexpr size_t OFF_WOUTT = al256(OFF_WINT + (size_t)2 * 2304 * 1024 * 2);
constexpr size_t OFF_WGU   = al256(OFF_WOUTT + (size_t)2 * 1024 * 1024 * 2);
constexpr size_t OFF_WD    = al256(OFF_WGU + (size_t)NE * 1024 * 1024 * 2);
constexpr size_t OFF_XCTX  = al256(OFF_WD + (size_t)NE * 1024 * 512 * 2);
constexpr size_t OFF_X1    = al256(OFF_XCTX + (size_t)NCTX * D * 4);
constexpr size_t OFF_X2    = al256(OFF_X1 + (size_t)NTOK * D * 2);
constexpr size_t OFF_P     = al256(OFF_X2 + (size_t)NTOK * D * 2);
constexpr size_t OFF_NAKF  = al256(OFF_P + (size_t)NTOK * PWS * 2);
constexpr size_t OFF_NAVF  = al256(OFF_NAKF + (size_t)NB * 6 * 512 * KVT * 2);
constexpr size_t OFF_GKF   = al256(OFF_NAVF + (size_t)NB * 6 * 512 * KVT * 2);
constexpr size_t OFF_GVF   = al256(OFF_GKF + (size_t)NB * 2 * 512 * KVT * 2);
constexpr size_t OFF_NAKFC = al256(OFF_GVF + (size_t)NB * 2 * 512 * KVT * 2);
constexpr size_t OFF_NAVFC = al256(OFF_NAKFC + (size_t)NB * 6 * 16 * KVT * 2);
constexpr size_t OFF_GKFC  = al256(OFF_NAVFC + (size_t)NB * 6 * 16 * KVT * 2);
constexpr size_t OFF_GVFC  = al256(OFF_GKFC + (size_t)NB * 2 * 16 * KVT * 2);
constexpr size_t OFF_Y     = al256(OFF_GVFC + (size_t)NB * 2 * 16 * KVT * 2);
constexpr size_t WS_TOTAL  = al256(OFF_Y + (size_t)2 * NTOK * D * 2);
constexpr int CW_CNT = 0;

struct Params {
    const float *x, *c, *ctx, *c_ctx, *w_ada, *b_ada, *w_in, *conv_w, *conv_b, *rg_a_w, *rg_a_b, *rg_i_w, *rg_i_b, *rg_lambda,
        *na_rpb, *gqa_sink, *w_out, *ln1_g, *ln1_b, *router_g_w, *router_g_b, *router_e_w, *router_e_b, *exp_w_gate, *exp_w_up,
        *exp_w_down, *ln2_g, *ln2_b;
    float* out;
    unsigned char* ws;
};

DEV const Params& kp_() { const void* q = (const void*)__builtin_amdgcn_kernarg_segment_ptr(); asm volatile("" : "+s"(q)); return *(const Params*)q; }
DEV int tid_() { int t = threadIdx.x; asm volatile("" : "+v"(t)); return t; }
DEV int bid_() { int b = blockIdx.x; asm volatile("" : "+s"(b)); return b; }
DEV float shx(float v, int m) { return __builtin_bit_cast(float, __builtin_amdgcn_ds_bpermute(((tid_() & 63) ^ m) << 2, __builtin_bit_cast(int, v))); }
DEV float shl_(float v, int src) { return __builtin_bit_cast(float, __builtin_amdgcn_ds_bpermute(src << 2, __builtin_bit_cast(int, v))); }
DEV float bf2f(bf16_t h) { return __uint_as_float((unsigned)h << 16); }
DEV bf16_t f2bf(float f) { unsigned u = __float_as_uint(f); u += 0x7fffu + ((u >> 16) & 1u); return (bf16_t)(u >> 16); }
DEV unsigned pk2(float lo, float hi) { return (unsigned)f2bf(lo) | ((unsigned)f2bf(hi) << 16); }
DEV float wave_sum(float v) {
#pragma unroll
    for (int o = 1; o < 64; o <<= 1) v += shx(v, o);
    return v;
}
DEV float wave_max(float v) {
#pragma unroll
    for (int o = 1; o < 64; o <<= 1) v = fmaxf(v, shx(v, o));
    return v;
}
DEV float sigmoidf_(float x) { return 1.f / (1.f + __expf(-x)); }
DEV float gelu_tanh(float x) {
    const float u = 0.7978845608028654f * (x + 0.044715f * x * x * x);
    const float t = 1.f - 2.f / (1.f + __expf(2.f * u));
    return 0.5f * x * (1.f + t);
}
DEV float* xres_row(const Params& p, int R) {
    return R < NLAT ? p.out + (size_t)R * D : (float*)(p.ws + OFF_XCTX) + (size_t)(R - NLAT) * D;
}
DEV const float* modvec(const Params& p, int l, int R, int seg) {
    const int b = R < NLAT ? R / S : 8;
    return (const float*)(p.ws + OFF_MOD) + ((size_t)(l * 9 + b) * 6 + seg) * 1024;
}

DEV void ph_mod(const Params& p, float* sc  ) {
    if (bid_() >= 192) return;
    for (int i = tid_(); i < 9 * 1024; i += 256) { const float v = (i < 8192) ? p.c[i] : p.c_ctx[i - 8192]; sc[i] = v / (1.f + expf(-v)); }
    __syncthreads();
    const int lane = tid_() & 63, w = tid_() >> 6;
    const int col = bid_() * 64 + lane;
    const int l = col / 6144, j = col % 6144;
    const float* wp = p.w_ada + (size_t)l * 1024 * 6144 + j + (size_t)(w * 256) * 6144;
    const float* s = sc + w * 256;
    float a0 = 0, a1 = 0, a2 = 0, a3 = 0, a4 = 0, a5 = 0, a6 = 0, a7 = 0, a8 = 0;
#pragma unroll 8
    for (int k = 0; k < 256; ++k) {
        const float wv = wp[(size_t)k * 6144];
        a0 += s[k] * wv; a1 += s[1024 + k] * wv; a2 += s[2048 + k] * wv; a3 += s[3072 + k] * wv; a4 += s[4096 + k] * wv;
        a5 += s[5120 + k] * wv; a6 += s[6144 + k] * wv; a7 += s[7168 + k] * wv; a8 += s[8192 + k] * wv;
    }
    __syncthreads();
    float* red = sc + 9 * 1024;
    red[(w * 9 + 0) * 64 + lane] = a0; red[(w * 9 + 1) * 64 + lane] = a1; red[(w * 9 + 2) * 64 + lane] = a2; red[(w * 9 + 3) * 64 + lane] = a3; red[(w * 9 + 4) * 64 + lane] = a4;
    red[(w * 9 + 5) * 64 + lane] = a5; red[(w * 9 + 6) * 64 + lane] = a6; red[(w * 9 + 7) * 64 + lane] = a7; red[(w * 9 + 8) * 64 + lane] = a8;
    __syncthreads();
    if (w == 0) {
        const float bias = p.b_ada[l * 6144 + j];
        float* mod = (float*)(p.ws + OFF_MOD) + (size_t)l * 9 * 6144 + j;
#pragma unroll
        for (int r = 0; r < 9; ++r) mod[r * 6144] = ((red[(0 * 9 + r) * 64 + lane] + red[(1 * 9 + r) * 64 + lane]) + (red[(2 * 9 + r) * 64 + lane] + red[(3 * 9 + r) * 64 + lane])) + bias;
    }
}

DEV void sincos_red(float ang, float& sn, float& cs) {
    const float n = rintf(ang * 0.15915494309189535f);
    float r = fmaf(-n, 6.2831854820251465f, ang);
    r = fmaf(-n, -1.7484555e-07f, r);
    float sgn = 1.f;
    if (r > 1.5707963267948966f) { r = 3.14159265358979f - r; sgn = -1.f; }
    else if (r < -1.5707963267948966f) { r = -3.14159265358979f - r; sgn = -1.f; }
    const float r2 = r * r;
    float sp = -1.6059044e-10f; sp = fmaf(sp, r2, 2.5052108e-08f); sp = fmaf(sp, r2, -2.7557319e-06f); sp = fmaf(sp, r2, 1.9841270e-04f);
    sp = fmaf(sp, r2, -8.3333333e-03f); sp = fmaf(sp, r2, 1.6666667e-01f); sp = fmaf(sp * -1.f, r2, 1.f);
    sn = r * sp;
    float cp = -1.1470746e-11f; cp = fmaf(cp, r2, 2.0876757e-09f); cp = fmaf(cp, r2, -2.7557319e-07f); cp = fmaf(cp, r2, 2.4801587e-05f);
    cp = fmaf(cp, r2, -1.3888889e-03f); cp = fmaf(cp, r2, 4.1666667e-02f); cp = fmaf(cp, r2, -0.5f); cp = fmaf(cp, r2, 1.f);
    cs = sgn * cp;
}
DEV void ph_rope(const Params& p) {
    const int i = (bid_() - 192) * 256 + tid_();
    if (i < 0 || i >= 128 * 16) return;
    const int pos = i >> 4, q = i & 15;
    const float inv = exp2f(-(float)q * (13.287712379549449f / 16.f));
    float sn, cs; sincos_red((float)pos * inv, sn, cs);
    float* tab = (float*)(p.ws + OFF_ROPE);
    tab[i] = cs; tab[2048 + i] = sn;
}

DEV void ph_routerw(const Params& p) {
  for (int i = bid_() * 256 + tid_(); i < 2 * 48 * 1024; i += gridDim.x * 256) {
    const int l = i / (48 * 1024), f = (i / 1024) % 48, k = i & 1023;
    float w = 0.f;
    if (f < 4) w = p.router_g_w[((size_t)l * 1024 + k) * 4 + f]; else if (f < 36) w = p.router_e_w[((size_t)l * 1024 + k) * 32 + (f - 4)];
    const bf16_t hi = f2bf(w), lo = f2bf(w - bf2f(hi));
    bf16_t* WR = (bf16_t*)(p.ws + OFF_WR);
    WR[((size_t)(l * 2 + 0) * 48 + f) * 1024 + k] = hi;
    WR[((size_t)(l * 2 + 1) * 48 + f) * 1024 + k] = lo;
  }
}

DEV void ph_rgprep(const Params& p) {
    bf16_t* W = (bf16_t*)(p.ws + OFF_WRG);
    for (int i = bid_() * 256 + tid_(); i < 2 * 2 * 2 * 4 * 64 * 64; i += gridDim.x * 256) {
        const int d = i & 63, e = (i >> 6) & 63, n = (i >> 12) & 3, gate = (i >> 14) & 1, ld = i >> 15;
        const float* srcw = gate ? p.rg_i_w : p.rg_a_w;
        W[i] = f2bf(srcw[((size_t)(ld * 4 + n) * 64 + d) * 64 + e]);
    }
    float* C = (float*)(p.ws + OFF_RGC);
    for (int i = bid_() * 256 + tid_(); i < 2 * 2 * 256; i += gridDim.x * 256) {
        const int c = i & 255, ld = i >> 8;
        C[(ld * 3 + 0) * 256 + c] = p.rg_a_b[ld * 256 + c];
        C[(ld * 3 + 1) * 256 + c] = p.rg_i_b[ld * 256 + c];
        C[(ld * 3 + 2) * 256 + c] = -8.f * log1pf(expf(-p.rg_lambda[ld * 256 + c]));
    }
}

DEV int tr_row(int n, int mode) { return mode == 0 ? n : ((n >> 7) * 256 + ((n >> 6) & 1) * 128 + (n & 63) + (mode == 2 ? 64 : 0)); }
DEV void transpose_tile(const float* src, bf16_t* dst, int K, int N, int mode, int tile, float* lds) {
    const int ntn = N >> 6, kt = tile / ntn, nt = tile % ntn, k0 = kt * 64, n0 = nt * 64, t = tid_();
#pragma unroll
    for (int i = 0; i < 4; ++i) {
        const int r = (t >> 4) + 16 * i, c4 = (t & 15) * 4;
        const float4 v = *(const float4*)(src + (size_t)(k0 + r) * N + n0 + c4);
        lds[r * 65 + c4] = v.x; lds[r * 65 + c4 + 1] = v.y; lds[r * 65 + c4 + 2] = v.z; lds[r * 65 + c4 + 3] = v.w;
    }
    __syncthreads();
#pragma unroll
    for (int i = 0; i < 2; ++i) {
        const int n = (t >> 3) + 32 * i, kc = (t & 7) * 8;
        uint4 o;
        o.x = pk2(lds[(kc + 0) * 65 + n], lds[(kc + 1) * 65 + n]); o.y = pk2(lds[(kc + 2) * 65 + n], lds[(kc + 3) * 65 + n]);
        o.z = pk2(lds[(kc + 4) * 65 + n], lds[(kc + 5) * 65 + n]); o.w = pk2(lds[(kc + 6) * 65 + n], lds[(kc + 7) * 65 + n]);
        *(uint4*)(dst + (size_t)tr_row(n0 + n, mode) * K + k0 + kc) = o;
    }
    __syncthreads();
}
DEV void ph_transpose(const float* src, bf16_t* dst, int K, int N, int mode, int nmat, size_t sstride, size_t dstride, float* lds  ) {
    const int per = (K >> 6) * (N >> 6);
    for (int it = bid_(); it < nmat * per; it += gridDim.x) {
        const int m = it / per, tile = it % per;
        transpose_tile(src + (size_t)m * sstride, dst + (size_t)m * dstride, K, N, mode, tile, lds);
    }
}

template <int MODE, bool WX> DEV void rowop(const Params& p, int l, int R) {
    const int lane = tid_() & 63;
    float4 v[4];
    if (MODE == 0) {
        const float* src = R < NLAT ? p.x + (size_t)R * D : p.ctx + (size_t)(R - NLAT) * D;
#pragma unroll
        for (int i = 0; i < 4; ++i) v[i] = *(const float4*)(src + i * 256 + lane * 4);
    } else {
        float* xr = xres_row(p, R);
        const float* g2 = modvec(p, l - 1, R, 5);
        const bf16_t* y0 = (const bf16_t*)(p.ws + OFF_Y) + (size_t)(2 * R) * D;
        const bf16_t* y1 = y0 + D;
        const float* lg = p.ln2_g + (l - 1) * D; const float* lb = p.ln2_b + (l - 1) * D;
        float s = 0.f;
#pragma unroll
        for (int i = 0; i < 4; ++i) {
            const int k = i * 256 + lane * 4;
            const float4 xv = *(const float4*)(xr + k); const float4 gv = *(const float4*)(g2 + k);
            const uint2 a = *(const uint2*)(y0 + k); const uint2 b = *(const uint2*)(y1 + k);
            float4 u;
            u.x = ALPHA * xv.x + gv.x * (bf2f((bf16_t)(a.x & 0xffff)) + bf2f((bf16_t)(b.x & 0xffff)));
            u.y = ALPHA * xv.y + gv.y * (bf2f((bf16_t)(a.x >> 16)) + bf2f((bf16_t)(b.x >> 16)));
            u.z = ALPHA * xv.z + gv.z * (bf2f((bf16_t)(a.y & 0xffff)) + bf2f((bf16_t)(b.y & 0xffff)));
            u.w = ALPHA * xv.w + gv.w * (bf2f((bf16_t)(a.y >> 16)) + bf2f((bf16_t)(b.y >> 16)));
            v[i] = u; s += (u.x + u.y) + (u.z + u.w);
        }
        const float mean = wave_sum(s) * (1.f / D);
        float q = 0.f;
#pragma unroll
        for (int i = 0; i < 4; ++i) { v[i].x -= mean; v[i].y -= mean; v[i].z -= mean; v[i].w -= mean; q += (v[i].x * v[i].x + v[i].y * v[i].y) + (v[i].z * v[i].z + v[i].w * v[i].w); }
        const float rstd = rsqrtf(wave_sum(q) * (1.f / D) + LN_EPS);
#pragma unroll
        for (int i = 0; i < 4; ++i) {
            const int k = i * 256 + lane * 4;
            const float4 gg = *(const float4*)(lg + k); const float4 bb = *(const float4*)(lb + k);
            v[i].x = v[i].x * rstd * gg.x + bb.x; v[i].y = v[i].y * rstd * gg.y + bb.y; v[i].z = v[i].z * rstd * gg.z + bb.z; v[i].w = v[i].w * rstd * gg.w + bb.w;
            if (WX) *(float4*)(xr + k) = v[i];
        }
    }
    if (MODE != 2) {
        const float* sh = modvec(p, l, R, 0); const float* sc = modvec(p, l, R, 1);
        bf16_t* ha = (bf16_t*)(p.ws + OFF_X1) + (size_t)R * D;
#pragma unroll
        for (int i = 0; i < 4; ++i) {
            const int k = i * 256 + lane * 4;
            const float4 s4 = *(const float4*)(sh + k); const float4 c4 = *(const float4*)(sc + k);
            uint2 o; o.x = pk2(v[i].x * (1.f + c4.x) + s4.x, v[i].y * (1.f + c4.y) + s4.y); o.y = pk2(v[i].z * (1.f + c4.z) + s4.z, v[i].w * (1.f + c4.w) + s4.w);
            *(uint2*)(ha + k) = o;
        }
    }
}
template <int MODE> DEV void ph_rowop(const Params& p, int l, int nrows) {
    const int w = tid_() >> 6;
    for (int R = bid_() * 4 + w; R < nrows; R += gridDim.x * 4) rowop<MODE, true>(p, l, R);
}
constexpr int CW_Q = 64;
DEV int q_pull(unsigned* ctr, int* slot) {
    if (tid_() == 0) *slot = (int)atomicAdd(ctr, 1u);
    __syncthreads();
    const int v = *(volatile int*)slot;
    __syncthreads();
    return v;
}

constexpr int GEMM_STAGE_BYTES = 384 * 64;
constexpr int GEMM_NSTAGE = 3;
constexpr int GEMM_LDS_BYTES = GEMM_NSTAGE * GEMM_STAGE_BYTES;
#define LAS __attribute__((address_space(3)))
DEV int gemm_src_chunk(int t) { return ((t & 3) ^ ((0 - (t >> 4)) & 3)) * 8; }
DEV void gemm_mainloop(const bf16_t* Abase, unsigned ao0, unsigned ao1, const bf16_t* Bbase, unsigned bo, unsigned ldb, int nk, bf16_t* lds, f32x4 (&acc)[4][8]) {
    const int t = tid_(), lane = t & 63, w = __builtin_amdgcn_readfirstlane(t >> 6), wm = w >> 1, wn = w & 1;
    LAS unsigned char* L = (LAS unsigned char*)lds;
    const int pc = ((lane >> 4) ^ ((0 - ((lane & 15) >> 2)) & 3)) * 16;
    const int arow = (wm * 64 + (lane & 15)) * 64 + pc, brow = (128 + wn * 128 + (lane & 15)) * 64 + pc;
    const char* Ab = (const char*)Abase; const char* B0 = (const char*)Bbase; const char* B1 = B0 + (size_t)ldb * 128; const char* B2 = B0 + (size_t)ldb * 256; const char* B3 = B0 + (size_t)ldb * 384;
#define GEMM_ISSUE(slot, ko) do { LAS unsigned* d_ = (LAS unsigned*)(L + (slot) * GEMM_STAGE_BYTES + w * 1024); \
        __builtin_amdgcn_global_load_lds((const unsigned*)(Ab + (ao0 + (ko) * 2u)), d_, 16, 0, 0); \
        __builtin_amdgcn_global_load_lds((const unsigned*)(Ab + (ao1 + (ko) * 2u)), d_ + 1024, 16, 0, 0); \
        __builtin_amdgcn_global_load_lds((const unsigned*)(B0 + (bo + (ko) * 2u)), d_ + 2048, 16, 0, 0); \
        __builtin_amdgcn_global_load_lds((const unsigned*)(B1 + (bo + (ko) * 2u)), d_ + 3072, 16, 0, 0); \
        __builtin_amdgcn_global_load_lds((const unsigned*)(B2 + (bo + (ko) * 2u)), d_ + 4096, 16, 0, 0); \
        __builtin_amdgcn_global_load_lds((const unsigned*)(B3 + (bo + (ko) * 2u)), d_ + 5120, 16, 0, 0); } while (0)
    asm volatile("s_waitcnt vmcnt(0)" ::: "memory");
    __builtin_amdgcn_s_barrier();
    asm volatile("" ::: "memory");
    GEMM_ISSUE(0, 0);
    if (nk > 1) GEMM_ISSUE(1, 32);
    int cs = 0, is = 2;
    for (int kt = 0; kt < nk; ++kt) {
        if (kt + 1 < nk) asm volatile("s_waitcnt vmcnt(6)" ::: "memory"); else asm volatile("s_waitcnt vmcnt(0)" ::: "memory");
        __builtin_amdgcn_s_barrier();
        asm volatile("" ::: "memory");
        if (kt + 2 < nk) GEMM_ISSUE(is, (kt + 2) * 32);
        const LAS unsigned char* cur = L + cs * GEMM_STAGE_BYTES;
        const bf16x8 af0 = *(const LAS bf16x8*)(cur + arow), af1 = *(const LAS bf16x8*)(cur + arow + 16 * 64), af2 = *(const LAS bf16x8*)(cur + arow + 32 * 64), af3 = *(const LAS bf16x8*)(cur + arow + 48 * 64);
        bf16x8 bq0 = *(const LAS bf16x8*)(cur + brow), bq1 = *(const LAS bf16x8*)(cur + brow + 16 * 64);
#pragma unroll
        for (int nt = 0; nt < 8; ++nt) {
            const bf16x8 bfr = bq0; bq0 = bq1;
            if (nt + 2 < 8) bq1 = *(const LAS bf16x8*)(cur + brow + (nt + 2) * 16 * 64);
            acc[0][nt] = __builtin_amdgcn_mfma_f32_16x16x32_bf16(bfr, af0, acc[0][nt], 0, 0, 0);
            acc[1][nt] = __builtin_amdgcn_mfma_f32_16x16x32_bf16(bfr, af1, acc[1][nt], 0, 0, 0);
            acc[2][nt] = __builtin_amdgcn_mfma_f32_16x16x32_bf16(bfr, af2, acc[2][nt], 0, 0, 0);
            acc[3][nt] = __builtin_amdgcn_mfma_f32_16x16x32_bf16(bfr, af3, acc[3][nt], 0, 0, 0);
        }
        cs = cs == 2 ? 0 : cs + 1; is = is == 2 ? 0 : is + 1;
    }
#undef GEMM_ISSUE
}
DEV void zero_acc(f32x4 (&acc)[4][8]) {
#pragma unroll
    for (int a = 0; a < 4; ++a)
#pragma unroll
        for (int b = 0; b < 8; ++b) acc[a][b] = (f32x4){0.f, 0.f, 0.f, 0.f};
}

DEV void inproj_item(const Params& p_, int l, int rt, int pass, bf16_t* lds) {
    const Params& p = kp_();
    const int t = tid_(), lane = t & 63, w = t >> 6, wm = w >> 1, wn = w & 1;
    const bf16_t* A = (const bf16_t*)(p.ws + OFF_X1) + (size_t)(rt * 128) * D;
    const bf16_t* Bt = (const bf16_t*)(p.ws + OFF_WINT) + ((size_t)l * 2304 + pass * 256) * 1024;
    const unsigned toff = (unsigned)(((t >> 2) * 1024 + gemm_src_chunk(t)) * 2);
    f32x4 acc[4][8]; zero_acc(acc);
    gemm_mainloop(A, toff, toff + 64 * D * 2, Bt, toff, 1024, 32, lds, acc);
    bf16_t* P = (bf16_t*)(p.ws + OFF_P);
    const float* ctab = (const float*)(p.ws + OFF_ROPE); const float* stab = ctab + 2048;
    const bool isctx = rt >= 512;
    const int fq = lane >> 4, fr = lane & 15;
#pragma unroll
    for (int hci = 0; hci < 2; ++hci) {
        const int hc = pass * 4 + wn * 2 + hci;
        int type, dcol = 0, vh = 0;
        if (hc < 4) { type = 0; dcol = COL_RGX + hc * 64; }
        else if (hc < 10) { type = 4; vh = hc - 4; }
        else if (hc < 16) { type = 5; vh = hc - 10; }
        else if (hc < 18) { type = 6; vh = hc - 16; }
        else if (hc < 20) { type = 7; vh = hc - 18; }
        else if (hc < 24) { type = 0; dcol = COL_GATE + (hc - 20) * 64; }
        else if (hc < 30) { type = 1; dcol = COL_NAQ + (hc - 24) * 64; }
        else { type = 3; dcol = COL_GQ + (hc - 30) * 64; }
#pragma unroll
        for (int mt = 0; mt < 4; ++mt) {
            const int R = rt * 128 + wm * 64 + mt * 16 + fr;
            f32x4 v0 = acc[mt][hci * 4 + 0], v1 = acc[mt][hci * 4 + 1], v2 = acc[mt][hci * 4 + 2], v3 = acc[mt][hci * 4 + 3];
            if ((type == 3 || type == 6) && !isctx) {
                const int tt = R & (S - 1), pr = tt >> 6, pc = tt & 63;
                const f32x4 cr = *(const f32x4*)(ctab + pr * 16 + fq * 4), sr = *(const f32x4*)(stab + pr * 16 + fq * 4);
                const f32x4 cc = *(const f32x4*)(ctab + pc * 16 + fq * 4), sc = *(const f32x4*)(stab + pc * 16 + fq * 4);
                const f32x4 o0 = v0 * cr - v1 * sr, o1 = v1 * cr + v0 * sr, o2 = v2 * cc - v3 * sc, o3 = v3 * cc + v2 * sc;
                v0 = o0; v1 = o1; v2 = o2; v3 = o3;
            }
            if (type == 1 || type == 3) { v0 = v0 * 0.125f; v1 = v1 * 0.125f; v2 = v2 * 0.125f; v3 = v3 * 0.125f; }
            if (type < 4) {
                bf16_t* o = P + (size_t)R * PWS + dcol + fq * 4;
                uint2 q;
                q.x = pk2(v0[0], v0[1]); q.y = pk2(v0[2], v0[3]); *(uint2*)(o) = q;
                q.x = pk2(v1[0], v1[1]); q.y = pk2(v1[2], v1[3]); *(uint2*)(o + 16) = q;
                q.x = pk2(v2[0], v2[1]); q.y = pk2(v2[2], v2[3]); *(uint2*)(o + 32) = q;
                q.x = pk2(v3[0], v3[1]); q.y = pk2(v3[2], v3[3]); *(uint2*)(o + 48) = q;
            } else {
                const bool na = type < 6, isk = (type == 4 || type == 6);
                bf16_t* tb;
                if (!isctx) { const int b = R >> 13, tile = (R & (S - 1)) >> 4;
                    tb = (bf16_t*)(p.ws + (na ? (isk ? OFF_NAKF : OFF_NAVF) : (isk ? OFF_GKF : OFF_GVF))) + ((size_t)(b * (na ? 6 : 2) + vh) * 512 + tile) * KVT; }
                else { const int cR = R - NLAT, b = cR >> 8, tile = (cR & 255) >> 4;
                    tb = (bf16_t*)(p.ws + (na ? (isk ? OFF_NAKFC : OFF_NAVFC) : (isk ? OFF_GKFC : OFF_GVFC))) + ((size_t)(b * (na ? 6 : 2) + vh) * 16 + tile) * KVT; }
                if (isk) {
                    bf16_t* o = tb + ((fq >> 1) * 16 + fr) * 8 + (fq & 1) * 4;
                    uint2 q;
                    q.x = pk2(v0[0], v0[1]); q.y = pk2(v0[2], v0[3]); *(uint2*)(o) = q;
                    q.x = pk2(v1[0], v1[1]); q.y = pk2(v1[2], v1[3]); *(uint2*)(o + 2 * 16 * 8) = q;
                    q.x = pk2(v2[0], v2[1]); q.y = pk2(v2[2], v2[3]); *(uint2*)(o + 512) = q;
                    q.x = pk2(v3[0], v3[1]); q.y = pk2(v3[2], v3[3]); *(uint2*)(o + 512 + 2 * 16 * 8) = q;
                } else {
                    bf16_t* o = tb + ((fr >> 2) * 16 + fq * 4) * 8 + (fr & 3);
#pragma unroll
                    for (int j = 0; j < 4; ++j) {
                        o[j * 8] = f2bf(v0[j]); o[j * 8 + 4] = f2bf(v1[j]); o[512 + j * 8] = f2bf(v2[j]); o[512 + j * 8 + 4] = f2bf(v3[j]);
                    }
                }
            }
        }
    }
}
DEV void ph_inproj(const Params& p, int l, bf16_t* lds) {
    const int nctxp = (l == 0) ? 9 : 5;
    const int nx = gridDim.x >> 3, xcd = bid_() & 7, j = bid_() >> 3;
    const int nloc = 64 * 9 + 2 * nctxp;
    if (bid_() >= nx * 8) return;
    for (int i0 = j; i0 < nloc * ((PROBE_ID) == 3 ? PROBE_N : 1); i0 += nx) {
        const int i = i0 % nloc;
        int rt, pass;
        if (i < 64 * 9) { rt = xcd * 64 + i / 9; pass = i % 9; } else { const int r = i - 64 * 9; rt = 512 + 2 * xcd + r / nctxp; pass = r % nctxp; }
        inproj_item(p, l, rt, pass, lds);
    }
}

constexpr float LOG2E = 1.4426950408889634f;
struct AttnState { f32x4 o0, o1, o2, o3; float m, lsum; };
struct KVFrag { bf16x8 k00, k01, k10, k11, v0, v1, v2, v3; };
DEV bf16x8 ld16(const bf16_t* p) { return *(const bf16x8*)p; }
DEV bf16x8 lohi(const uint4& a, const uint4& b, int hi) { union { uint4 u; bf16x8 v; } c; c.u = hi ? make_uint4(a.z, a.w, b.z, b.w) : make_uint4(a.x, a.y, b.x, b.y); return c.v; }
DEV void kv_load(const bf16_t* kt0, const bf16_t* kt1, const bf16_t* vt0, const bf16_t* vt1, KVFrag& f) {
    f.k00 = ld16(kt0); f.k01 = ld16(kt0 + 512); f.k10 = ld16(kt1); f.k11 = ld16(kt1 + 512);
    const uint4 a0 = *(const uint4*)vt0, a1 = *(const uint4*)(vt0 + 512), b0 = *(const uint4*)vt1, b1 = *(const uint4*)(vt1 + 512);
    f.v0 = lohi(a0, b0, 0); f.v1 = lohi(a0, b0, 1); f.v2 = lohi(a1, b1, 0); f.v3 = lohi(a1, b1, 1);
}
DEV void attn_apply(const KVFrag& f, const bf16x8& q0, const bf16x8& q1, f32x4 b0, f32x4 b1, AttnState& st) {
    const f32x4 z = {0.f, 0.f, 0.f, 0.f};
    f32x4 s0 = __builtin_amdgcn_mfma_f32_16x16x32_bf16(f.k00, q0, z, 0, 0, 0); s0 = __builtin_amdgcn_mfma_f32_16x16x32_bf16(f.k01, q1, s0, 0, 0, 0);
    f32x4 s1 = __builtin_amdgcn_mfma_f32_16x16x32_bf16(f.k10, q0, z, 0, 0, 0); s1 = __builtin_amdgcn_mfma_f32_16x16x32_bf16(f.k11, q1, s1, 0, 0, 0);
    s0 = s0 * LOG2E + b0; s1 = s1 * LOG2E + b1;
    float mx = fmaxf(fmaxf(fmaxf(s0[0], s0[1]), fmaxf(s0[2], s0[3])), fmaxf(fmaxf(s1[0], s1[1]), fmaxf(s1[2], s1[3])));
    mx = fmaxf(mx, shx(mx, 16)); mx = fmaxf(mx, shx(mx, 32));
    const float mn = fmaxf(st.m, mx);
    const float ms = (mn == -INFINITY) ? 0.f : mn;
    const float alpha = __builtin_amdgcn_exp2f(st.m - ms);
    f32x4 p0, p1;
#pragma unroll
    for (int j = 0; j < 4; ++j) { p0[j] = __builtin_amdgcn_exp2f(s0[j] - ms); p1[j] = __builtin_amdgcn_exp2f(s1[j] - ms); }
    st.lsum = st.lsum * alpha + ((p0[0] + p0[1]) + (p0[2] + p0[3])) + ((p1[0] + p1[1]) + (p1[2] + p1[3]));
    st.o0 = st.o0 * alpha; st.o1 = st.o1 * alpha; st.o2 = st.o2 * alpha; st.o3 = st.o3 * alpha;
    union { uint4 u; bf16x8 v; } pt; pt.u = make_uint4(pk2(p0[0], p0[1]), pk2(p0[2], p0[3]), pk2(p1[0], p1[1]), pk2(p1[2], p1[3]));
    st.o0 = __builtin_amdgcn_mfma_f32_16x16x32_bf16(f.v0, pt.v, st.o0, 0, 0, 0);
    st.o1 = __builtin_amdgcn_mfma_f32_16x16x32_bf16(f.v1, pt.v, st.o1, 0, 0, 0);
    st.o2 = __builtin_amdgcn_mfma_f32_16x16x32_bf16(f.v2, pt.v, st.o2, 0, 0, 0);
    st.o3 = __builtin_amdgcn_mfma_f32_16x16x32_bf16(f.v3, pt.v, st.o3, 0, 0, 0);
    st.m = mn;
}
DEV void attn_init(AttnState& st) { const f32x4 z = {0.f, 0.f, 0.f, 0.f}; st.o0 = z; st.o1 = z; st.o2 = z; st.o3 = z; st.m = -INFINITY; st.lsum = 0.f; }
DEV void attn_store(AttnState& st, bf16_t* orow, float sink2  ) {
    float l = st.lsum; l += shx(l, 16); l += shx(l, 32);
    float sc;
    if (sink2 != -INFINITY) { const float mf = fmaxf(st.m, sink2); const float al = __builtin_amdgcn_exp2f(st.m - mf); l = l * al + __builtin_amdgcn_exp2f(sink2 - mf); sc = al / l; }
    else sc = 1.f / l;
    uint2 w;
    w.x = pk2(st.o0[0] * sc, st.o0[1] * sc); w.y = pk2(st.o0[2] * sc, st.o0[3] * sc); *(uint2*)(orow) = w;
    w.x = pk2(st.o1[0] * sc, st.o1[1] * sc); w.y = pk2(st.o1[2] * sc, st.o1[3] * sc); *(uint2*)(orow + 16) = w;
    w.x = pk2(st.o2[0] * sc, st.o2[1] * sc); w.y = pk2(st.o2[2] * sc, st.o2[3] * sc); *(uint2*)(orow + 32) = w;
    w.x = pk2(st.o3[0] * sc, st.o3[1] * sc); w.y = pk2(st.o3[2] * sc, st.o3[3] * sc); *(uint2*)(orow + 48) = w;
}

constexpr int NTASK_NA = NB * 6 * 128 * 4, NTASK_GQ = NB * 2 * 512, NTASK_CNA = NB * 6 * 16, NTASK_CGQ = NB * 2 * 16;
DEV void attn_task(const Params& p, int l, int tk, const float* rpb2  ) {
    const int lane = tid_() & 63, g = lane >> 4, fr = lane & 15;
    const bf16_t* P = (const bf16_t*)(p.ws + OFF_P);
    bf16_t* X1 = (bf16_t*)(p.ws + OFF_X1);
    const f32x4 z4 = {0.f, 0.f, 0.f, 0.f};
    KVFrag f;
    if (tk < NTASK_NA) {
        const int qtile = tk & 3, r = (tk >> 2) & 127, hb = tk >> 9, h = hb % 6, b = hb / 6;
        const int qc = qtile == 0 ? (fr < 8 ? fr : 48 + fr) : 8 + (qtile - 1) * 16 + fr;
        const int ct0 = qtile == 0 ? 0 : qtile - 1, ct1 = qtile == 0 ? 3 : qtile;
        const int R = b * S + r * 64 + qc;
        const bf16_t* qp = P + (size_t)R * PWS + COL_NAQ + h * 64 + g * 8;
        const bf16x8 q0 = ld16(qp), q1 = ld16(qp + 32);
        const int rs = min(max(r - 4, 0), 120), cs = min(max(qc - 8, 0), 48);
        int ci[8]; bool ok[8];
#pragma unroll
        for (int e = 0; e < 8; ++e) { const int kc = ((e >> 2) ? ct1 : ct0) * 16 + g * 4 + (e & 3); ok[e] = (kc >= cs) && (kc < cs + 16); ci[e] = min(max(kc - qc + 15, 0), 30); }
        const bf16_t* kf = (const bf16_t*)(p.ws + OFF_NAKF) + ((size_t)(b * 6 + h) * 512 + rs * 4) * KVT + lane * 8;
        const bf16_t* vf = (const bf16_t*)(p.ws + OFF_NAVF) + ((size_t)(b * 6 + h) * 512 + rs * 4) * KVT + lane * 8;
        AttnState st; attn_init(st);
#pragma unroll
        for (int ri = 0; ri < 8; ++ri) {
            const float* rb = rpb2 + (h * 15 + (rs + ri - r + 7)) * 31;
            f32x4 b0, b1;
#pragma unroll
            for (int j = 0; j < 4; ++j) { b0[j] = ok[j] ? rb[ci[j]] : -INFINITY; b1[j] = ok[4 + j] ? rb[ci[4 + j]] : -INFINITY; }
            kv_load(kf + (size_t)(ri * 4 + ct0) * KVT, kf + (size_t)(ri * 4 + ct1) * KVT, vf + (size_t)(ri * 4 + ct0) * KVT, vf + (size_t)(ri * 4 + ct1) * KVT, f);
            attn_apply(f, q0, q1, b0, b1, st);
        }
        const bf16_t* kc_ = (const bf16_t*)(p.ws + OFF_NAKFC) + (size_t)(b * 6 + h) * 16 * KVT + lane * 8;
        const bf16_t* vc_ = (const bf16_t*)(p.ws + OFF_NAVFC) + (size_t)(b * 6 + h) * 16 * KVT + lane * 8;
#pragma unroll
        for (int pp = 0; pp < 8; ++pp) { kv_load(kc_ + (size_t)(2 * pp) * KVT, kc_ + (size_t)(2 * pp + 1) * KVT, vc_ + (size_t)(2 * pp) * KVT, vc_ + (size_t)(2 * pp + 1) * KVT, f); attn_apply(f, q0, q1, z4, z4, st); }
        attn_store(st, X1 + (size_t)R * D + 256 + h * 64 + g * 4, -INFINITY);
    } else if (tk < NTASK_NA + NTASK_GQ + NTASK_CNA + NTASK_CGQ && (tk < NTASK_NA + NTASK_GQ || tk >= NTASK_NA + NTASK_GQ + NTASK_CNA)) {
        const bool lat = tk < NTASK_NA + NTASK_GQ;
        const int t2 = lat ? tk - NTASK_NA : tk - (NTASK_NA + NTASK_GQ + NTASK_CNA);
        const int qt = lat ? (t2 & 511) : (t2 & 15), hb = lat ? (t2 >> 9) : (t2 >> 4), kvh = hb & 1, b = hb >> 1;
        const int q0i = qt * 16, R = (lat ? b * S : NLAT + b * CTX) + q0i + fr;
        const bf16_t* qp = P + (size_t)R * PWS + COL_GQ + kvh * 192 + g * 8;
        const bf16x8 qa0 = ld16(qp), qa1 = ld16(qp + 32), qb0 = ld16(qp + 64), qb1 = ld16(qp + 96), qc0 = ld16(qp + 128), qc1 = ld16(qp + 160);
        AttnState sa, sb, sc; attn_init(sa); attn_init(sb); attn_init(sc);
        const bf16_t* kf = (const bf16_t*)(p.ws + OFF_GKF) + (size_t)(b * 2 + kvh) * 512 * KVT + lane * 8;
        const bf16_t* vf = (const bf16_t*)(p.ws + OFF_GVF) + (size_t)(b * 2 + kvh) * 512 * KVT + lane * 8;
        const bf16_t* kc_ = (const bf16_t*)(p.ws + OFF_GKFC) + (size_t)(b * 2 + kvh) * 16 * KVT + lane * 8;
        const bf16_t* vc_ = (const bf16_t*)(p.ws + OFF_GVFC) + (size_t)(b * 2 + kvh) * 16 * KVT + lane * 8;
        const int qi = q0i + fr;
#define GQ_LOAD(i, F) do { const int i_ = (i); if (i_ < 9) { const int kt_ = (q0i - 128 + i_ * 32) >> 4; const int ta_ = min(max(kt_, 0), 511), tb_ = min(max(kt_ + 1, 0), 511); \
            kv_load(kf + (size_t)ta_ * KVT, kf + (size_t)tb_ * KVT, vf + (size_t)ta_ * KVT, vf + (size_t)tb_ * KVT, F); } \
        else { const int c_ = (i_ - 9) * 2; kv_load(kc_ + (size_t)c_ * KVT, kc_ + (size_t)(c_ + 1) * KVT, vc_ + (size_t)c_ * KVT, vc_ + (size_t)(c_ + 1) * KVT, F); } } while (0)
#define GQ_APPLY(i, F) do { const int i_ = (i); f32x4 b0_ = z4, b1_ = z4; if (i_ < 9) { const int kb_ = q0i - 128 + i_ * 32; _Pragma("unroll") for (int j = 0; j < 4; ++j) { const int k0_ = kb_ + g * 4 + j, k1_ = k0_ + 16; \
                b0_[j] = (k0_ >= 0 && k0_ < S && k0_ >= qi - 128 && k0_ <= qi + 128) ? 0.f : -INFINITY; b1_[j] = (k1_ >= 0 && k1_ < S && k1_ >= qi - 128 && k1_ <= qi + 128) ? 0.f : -INFINITY; } } \
            attn_apply(F, qa0, qa1, b0_, b1_, sa); attn_apply(F, qb0, qb1, b0_, b1_, sb); attn_apply(F, qc0, qc1, b0_, b1_, sc); } while (0)
        KVFrag f2;
        const int i0 = lat ? 0 : 9;
        GQ_LOAD(i0, f);
#pragma unroll 1
        for (int i = i0; i < 17; i += 2) {
            if (i + 1 < 17) GQ_LOAD(i + 1, f2);
            GQ_APPLY(i, f);
            if (i + 1 < 17) { if (i + 2 < 17) GQ_LOAD(i + 2, f); GQ_APPLY(i + 1, f2); }
        }
#undef GQ_LOAD
#undef GQ_APPLY
        bf16_t* o = X1 + (size_t)R * D + 640 + kvh * 192 + g * 4;
        attn_store(sa, o, p.gqa_sink[l * 6 + kvh * 3 + 0] * LOG2E); attn_store(sb, o + 64, p.gqa_sink[l * 6 + kvh * 3 + 1] * LOG2E); attn_store(sc, o + 128, p.gqa_sink[l * 6 + kvh * 3 + 2] * LOG2E);
    } else {
        const int t3 = tk - NTASK_NA - NTASK_GQ, qt = t3 & 15, hb = t3 >> 4, h = hb % 6, b = hb / 6;
        const int R = NLAT + b * CTX + qt * 16 + fr;
        const bf16_t* qp = P + (size_t)R * PWS + COL_NAQ + h * 64 + g * 8;
        const bf16x8 q0 = ld16(qp), q1 = ld16(qp + 32);
        AttnState st; attn_init(st);
        const bf16_t* kc_ = (const bf16_t*)(p.ws + OFF_NAKFC) + (size_t)(b * 6 + h) * 16 * KVT + lane * 8;
        const bf16_t* vc_ = (const bf16_t*)(p.ws + OFF_NAVFC) + (size_t)(b * 6 + h) * 16 * KVT + lane * 8;
#pragma unroll
        for (int pp = 0; pp < 8; ++pp) { kv_load(kc_ + (size_t)(2 * pp) * KVT, kc_ + (size_t)(2 * pp + 1) * KVT, vc_ + (size_t)(2 * pp) * KVT, vc_ + (size_t)(2 * pp + 1) * KVT, f); attn_apply(f, q0, q1, z4, z4, st); }
        attn_store(st, X1 + (size_t)R * D + 256 + h * 64 + g * 4, -INFINITY);
    }
}
DEV void ph_attn(const Params& p, int l, float* rpb2  ) {
    for (int i = tid_(); i < 6 * 15 * 31; i += 256) rpb2[i] = p.na_rpb[(size_t)l * 6 * 15 * 31 + i] * LOG2E;
    __syncthreads();
    const int w = tid_() >> 6;
    const int ntask = NTASK_NA + NTASK_GQ + (l == 0 ? NTASK_CNA + NTASK_CGQ : 0);
    for (int tk0 = bid_() * 4 + w; tk0 < ntask; tk0 += gridDim.x * 4) {
        const int tk = tk0 < NTASK_GQ ? NTASK_NA + tk0 : (tk0 < NTASK_GQ + NTASK_NA ? tk0 - NTASK_GQ : tk0);
        attn_task(p, l, tk, rpb2);
    }
}

template <int CTRL> DEV float dppf(float old, float v) { return __builtin_bit_cast(float, __builtin_amdgcn_update_dpp(__builtin_bit_cast(int, old), __builtin_bit_cast(int, v), CTRL, 0xf, 0xf, false)); }
template <bool FWD> DEV void row_scan(float& a, float& b) {
#define RG_STEP(SHR, SHL) { const float ap = FWD ? dppf<SHR>(1.f, a) : dppf<SHL>(1.f, a); const float bp = FWD ? dppf<SHR>(0.f, b) : dppf<SHL>(0.f, b); b = fmaf(a, bp, b); a = a * ap; }
    RG_STEP(0x111, 0x101) RG_STEP(0x112, 0x102) RG_STEP(0x114, 0x104) RG_STEP(0x118, 0x108)
#undef RG_STEP
}
DEV int rg_bwd_chunk(int pos) { return pos == 0 ? 1 : (pos == 1 ? 0 : 67 - pos); }
DEV void rg_coef(const f32x4& za, const f32x4& zi, const f32x4& ba, const f32x4& bi, const f32x4& spc, const f32x4& xv, f32x4& a, f32x4& b) {
#pragma unroll
    for (int j = 0; j < 4; ++j) {
        const float r = 1.f / (1.f + __expf(-(za[j] + ba[j])));
        const float ig = 1.f / (1.f + __expf(-(zi[j] + bi[j])));
        const float la = spc[j] * r;
        const float av = __expf(la);
        const float x2 = 2.f * la;
        float om = x2 * (1.f / 720.f) + (1.f / 120.f); om = om * x2 + (1.f / 24.f); om = om * x2 + (1.f / 6.f); om = om * x2 + 0.5f; om = om * x2 + 1.f; om = -x2 * om;
        if (x2 < -0.25f) om = 1.f - av * av;
        a[j] = av; b[j] = sqrtf(om) * (ig * xv[j]);
    }
}
DEV void rg_item(const Params& p, int l, int rt, bf16_t* lds) {
    const int t = tid_(), lane = t & 63, n = t >> 6, g = lane >> 4, fr = lane & 15;
    const bf16_t* P = (const bf16_t*)(p.ws + OFF_P);
    const bool isctx = rt >= 512;
    const int b = isctx ? (rt - 512) >> 1 : rt >> 6, idx = isctx ? (rt - 512) & 1 : 2 + (rt & 63);
    const int L = isctx ? CTX : S, t0 = isctx ? idx * 128 : (idx - 2) * 128, seqbase = isctx ? NLAT + b * CTX : b * S;
    bf16_t* xl = lds + n * (128 * 64);
    {
        const int c = lane & 7, ch0 = n * 64 + c * 8;
        f32x4 cwa[4], cwb[4];
#pragma unroll
        for (int j = 0; j < 4; ++j) { cwa[j] = *(const f32x4*)(p.conv_w + (l * 4 + j) * 256 + ch0); cwb[j] = *(const f32x4*)(p.conv_w + (l * 4 + j) * 256 + ch0 + 4); }
        const f32x4 cba = *(const f32x4*)(p.conv_b + l * 256 + ch0), cbb = *(const f32x4*)(p.conv_b + l * 256 + ch0 + 4);
#pragma unroll 2
        for (int it = 0; it < 16; ++it) {
            const int tok = it * 8 + (lane >> 3), ts = t0 + tok;
            f32x4 acca = cba, accb = cbb;
#pragma unroll
            for (int j = 0; j < 4; ++j) {
                const int tj = ts + j - 2;
                if (tj >= 0 && tj < L) {
                    const uint4 v = *(const uint4*)(P + (size_t)(seqbase + tj) * PWS + COL_RGX + ch0);
                    const f32x4 xa = {__uint_as_float(v.x << 16), __uint_as_float(v.x & 0xffff0000u), __uint_as_float(v.y << 16), __uint_as_float(v.y & 0xffff0000u)};
                    const f32x4 xb = {__uint_as_float(v.z << 16), __uint_as_float(v.z & 0xffff0000u), __uint_as_float(v.w << 16), __uint_as_float(v.w & 0xffff0000u)};
                    acca = acca + cwa[j] * xa; accb = accb + cwb[j] * xb;
                }
            }
            uint4 o; o.x = pk2(acca[0], acca[1]); o.y = pk2(acca[2], acca[3]); o.z = pk2(accb[0], accb[1]); o.w = pk2(accb[2], accb[3]);
            *(uint4*)(xl + tok * 64 + ((c ^ ((tok >> 1) & 7)) * 8)) = o;
        }
    }
    asm volatile("s_waitcnt lgkmcnt(0)" ::: "memory");
    const bf16_t* W = (const bf16_t*)(p.ws + OFF_WRG) + (size_t)(l * 2) * 2 * 4 * 64 * 64;
    const float* C = (const float*)(p.ws + OFF_RGC) + (size_t)(l * 2) * 3 * 256;
    float* AGG = (float*)(p.ws + OFF_AGG) + (size_t)(b * 66) * 1024;
    const int swz = (fr >> 1) & 7;
#pragma unroll 1
    for (int ct = 0; ct < 4; ++ct) {
        const int ch = n * 64 + ct * 16 + g * 4;
        const f32x4 z4 = {0.f, 0.f, 0.f, 0.f};
#pragma unroll
        for (int dir = 0; dir < 2; ++dir) {
            const bf16x8 wa0 = ld16(W + ((size_t)((dir * 2 + 0) * 4 + n) * 64 + ct * 16 + fr) * 64 + g * 8), wa1 = ld16(W + ((size_t)((dir * 2 + 0) * 4 + n) * 64 + ct * 16 + fr) * 64 + 32 + g * 8);
            const bf16x8 wi0 = ld16(W + ((size_t)((dir * 2 + 1) * 4 + n) * 64 + ct * 16 + fr) * 64 + g * 8), wi1 = ld16(W + ((size_t)((dir * 2 + 1) * 4 + n) * 64 + ct * 16 + fr) * 64 + 32 + g * 8);
            const f32x4 ba = *(const f32x4*)(C + (dir * 3 + 0) * 256 + ch), bi = *(const f32x4*)(C + (dir * 3 + 1) * 256 + ch), spc = *(const f32x4*)(C + (dir * 3 + 2) * 256 + ch);
            f32x4 hin = z4, apre = {1.f, 1.f, 1.f, 1.f};
#pragma unroll
            for (int s = 0; s < 8; ++s) {
                const int tt = dir == 0 ? s : 7 - s;
                const int row = tt * 16 + fr;
                const bf16x8 x0 = *(const bf16x8*)(xl + row * 64 + ((g ^ swz) * 8)), x1 = *(const bf16x8*)(xl + row * 64 + (((g | 4) ^ swz) * 8));
                f32x4 za = __builtin_amdgcn_mfma_f32_16x16x32_bf16(wa0, x0, z4, 0, 0, 0); za = __builtin_amdgcn_mfma_f32_16x16x32_bf16(wa1, x1, za, 0, 0, 0);
                f32x4 zi = __builtin_amdgcn_mfma_f32_16x16x32_bf16(wi0, x0, z4, 0, 0, 0); zi = __builtin_amdgcn_mfma_f32_16x16x32_bf16(wi1, x1, zi, 0, 0, 0);
                const uint2 xr = *(const uint2*)(xl + row * 64 + (((ct * 2 + (g >> 1)) ^ swz) * 8) + (g & 1) * 4);
                const f32x4 xv = {__uint_as_float(xr.x << 16), __uint_as_float(xr.x & 0xffff0000u), __uint_as_float(xr.y << 16), __uint_as_float(xr.y & 0xffff0000u)};
                f32x4 a, bb;
                rg_coef(za, zi, ba, bi, spc, xv, a, bb);
                f32x4 h, ac;
#pragma unroll
                for (int j = 0; j < 4; ++j) {
                    float aj = a[j], bj = bb[j];
                    if (dir == 0) row_scan<true>(aj, bj); else row_scan<false>(aj, bj);
                    h[j] = fmaf(aj, hin[j], bj);
                    ac[j] = aj * apre[j];
                }
                {
                    bf16_t* xo = (bf16_t*)(p.ws + OFF_X2) + ((size_t)seqbase + t0 + row) * D + dir * 512 + ch;
                    uint2 o; o.x = pk2(ac[0], ac[1]); o.y = pk2(ac[2], ac[3]); *(uint2*)xo = o;
                    o.x = pk2(h[0], h[1]); o.y = pk2(h[2], h[3]); *(uint2*)(xo + 256) = o;
                }
                const int src = (lane & 48) | (dir == 0 ? 15 : 0);
#pragma unroll
                for (int j = 0; j < 4; ++j) { hin[j] = shl_(h[j], src); apre[j] = shl_(ac[j], src); }
            }
            if (fr == 0) { *(f32x4*)(AGG + (size_t)(idx * 2 + dir) * 512 + ch) = apre; *(f32x4*)(AGG + (size_t)(idx * 2 + dir) * 512 + 256 + ch) = hin; }
        }
    }
}
DEV void rg_final(const Params& p, int l, int rt) {
    const int t = tid_(), cg4 = (t & 63) * 4, tp = t >> 6;
    const bool isctx = rt >= 512;
    const int b = isctx ? (rt - 512) >> 1 : rt >> 6, idx = isctx ? (rt - 512) & 1 : 2 + (rt & 63);
    const float* AGG = (const float*)(p.ws + OFF_AGG) + (size_t)(b * 66) * 1024;
    f32x4 hf = {0.f, 0.f, 0.f, 0.f}, hb = {0.f, 0.f, 0.f, 0.f};
    {
#pragma unroll 4
        for (int q = 0; q < idx; ++q) { const f32x4 A = *(const f32x4*)(AGG + (size_t)(q * 2) * 512 + cg4), B = *(const f32x4*)(AGG + (size_t)(q * 2) * 512 + 256 + cg4); hf = A * hf + B; }
        const int npre = idx == 1 ? 0 : (idx == 0 ? 1 : 67 - idx);
#pragma unroll 4
        for (int q = 0; q < npre; ++q) { const int cq = rg_bwd_chunk(q); const f32x4 A = *(const f32x4*)(AGG + (size_t)(cq * 2 + 1) * 512 + cg4), B = *(const f32x4*)(AGG + (size_t)(cq * 2 + 1) * 512 + 256 + cg4); hb = A * hb + B; }
    }
    const bf16_t* X2 = (const bf16_t*)(p.ws + OFF_X2); const bf16_t* P = (const bf16_t*)(p.ws + OFF_P); bf16_t* X1 = (bf16_t*)(p.ws + OFF_X1);
#pragma unroll 4
    for (int i = 0; i < 32; ++i) {
        const size_t R = (size_t)rt * 128 + i * 4 + tp;
        const uint2 af = *(const uint2*)(X2 + R * D + cg4), bf = *(const uint2*)(X2 + R * D + 256 + cg4), ab = *(const uint2*)(X2 + R * D + 512 + cg4), bb = *(const uint2*)(X2 + R * D + 768 + cg4);
        const uint2 gr = *(const uint2*)(P + R * PWS + COL_GATE + cg4);
#define BLO(u) __uint_as_float((u) << 16)
#define BHI(u) __uint_as_float((u) & 0xffff0000u)
        const float h0 = (BLO(af.x) * hf[0] + BLO(bf.x)) + (BLO(ab.x) * hb[0] + BLO(bb.x));
        const float h1 = (BHI(af.x) * hf[1] + BHI(bf.x)) + (BHI(ab.x) * hb[1] + BHI(bb.x));
        const float h2 = (BLO(af.y) * hf[2] + BLO(bf.y)) + (BLO(ab.y) * hb[2] + BLO(bb.y));
        const float h3 = (BHI(af.y) * hf[3] + BHI(bf.y)) + (BHI(ab.y) * hb[3] + BHI(bb.y));
        uint2 o; o.x = pk2(h0 * gelu_tanh(BLO(gr.x)), h1 * gelu_tanh(BHI(gr.x))); o.y = pk2(h2 * gelu_tanh(BLO(gr.y)), h3 * gelu_tanh(BHI(gr.y)));
#undef BLO
#undef BHI
        *(uint2*)(X1 + R * D + cg4) = o;
    }
}
DEV void ph_rgagg(const Params& p, int l, bf16_t* lds) {
    for (int rt = bid_(); rt < 528; rt += gridDim.x) { rg_item(p, l, rt, lds); __syncthreads(); }
}

DEV void outproj_item(const Params& p_, int l, int rt, bf16_t* lds, float* stat  ) {
    const Params& p = kp_();
    const int t = tid_(), lane = t & 63, w = t >> 6, wm = w >> 1, wn = w & 1, fq = lane >> 4, fr = lane & 15;
    const bf16_t* A = (const bf16_t*)(p.ws + OFF_X1) + (size_t)(rt * 128) * D;
    const bool isctx = rt >= 512;
    const float* g1 = modvec(p, l, rt * 128, 2);
    rg_final(p, l, rt);
    __threadfence();
    __syncthreads();
    __builtin_amdgcn_fence(__ATOMIC_ACQUIRE, "agent");
#pragma unroll 1
    for (int pass = 0; pass < 4; ++pass) {
        const bf16_t* Bt = (const bf16_t*)(p.ws + OFF_WOUTT) + ((size_t)l * 1024 + pass * 256) * 1024;
        const unsigned toff = (unsigned)(((tid_() >> 2) * 1024 + gemm_src_chunk(tid_())) * 2);
        f32x4 acc[4][8]; zero_acc(acc);
        gemm_mainloop(A, toff, toff + 64 * D * 2, Bt, toff, 1024, 32, lds, acc);
#pragma unroll
        for (int mt = 0; mt < 4; ++mt) {
            const int rl = wm * 64 + mt * 16 + fr, R = rt * 128 + rl;
            const float* xin = (l == 0) ? (isctx ? p.ctx + (size_t)(R - NLAT) * D : p.x + (size_t)R * D) : xres_row(p, R);
            float* xo = xres_row(p, R);
            float s = 0.f, q = 0.f;
#pragma unroll
            for (int nt = 0; nt < 8; ++nt) {
                const int col = pass * 256 + wn * 128 + nt * 16 + fq * 4;
                const f32x4 xv = *(const f32x4*)(xin + col), gv = *(const f32x4*)(g1 + col);
                const f32x4 u = xv * ALPHA + gv * acc[mt][nt];
                *(f32x4*)(xo + col) = u;
                s += (u[0] + u[1]) + (u[2] + u[3]); q += (u[0] * u[0] + u[1] * u[1]) + (u[2] * u[2] + u[3] * u[3]);
            }
            s += shx(s, 16); s += shx(s, 32); q += shx(q, 16); q += shx(q, 32);
            if (fq == 0) { float* sp = stat + (wn * 128 + rl) * 2; if (pass == 0) { sp[0] = s; sp[1] = q; } else { sp[0] += s; sp[1] += q; } }
        }
    }
    __threadfence();
    __syncthreads();
    __builtin_amdgcn_fence(__ATOMIC_ACQUIRE, "agent");
    {
        const float* lg = p.ln1_g + l * D; const float* lb = p.ln1_b + l * D;
        const float* sh2 = modvec(p, l, rt * 128, 3); const float* sc2 = modvec(p, l, rt * 128, 4);
        bf16_t* X2 = (bf16_t*)(p.ws + OFF_X2);
        const bf16_t* WRh = (const bf16_t*)(p.ws + OFF_WR) + (size_t)(l * 2) * 48 * 1024 + (size_t)fr * 1024 + fq * 8;
        const bf16_t* WRl = WRh + 48 * 1024;
        float mean[2], rstd[2];
#pragma unroll
        for (int tm = 0; tm < 2; ++tm) {
            const int rl = w * 32 + tm * 16 + fr;
            float s = 0.f, q = 0.f;
#pragma unroll
            for (int i = 0; i < 2; ++i) { s += stat[(i * 128 + rl) * 2]; q += stat[(i * 128 + rl) * 2 + 1]; }
            mean[tm] = s * (1.f / D);
            rstd[tm] = rsqrtf(fmaxf(q * (1.f / D) - mean[tm] * mean[tm], 0.f) + LN_EPS);
        }
        f32x4 lacc[3][2];
#pragma unroll
        for (int a = 0; a < 3; ++a) { lacc[a][0] = (f32x4){0.f, 0.f, 0.f, 0.f}; lacc[a][1] = (f32x4){0.f, 0.f, 0.f, 0.f}; }
#pragma unroll 2
        for (int ks = 0; ks < 32; ++ks) {
            const int k = ks * 32 + fq * 8;
            const f32x4 g0 = *(const f32x4*)(lg + k), g1v = *(const f32x4*)(lg + k + 4), b0 = *(const f32x4*)(lb + k), b1 = *(const f32x4*)(lb + k + 4);
            const f32x4 s0 = *(const f32x4*)(sh2 + k), s1 = *(const f32x4*)(sh2 + k + 4), c0 = *(const f32x4*)(sc2 + k), c1 = *(const f32x4*)(sc2 + k + 4);
            bf16x8 hh[2], hl[2];
#pragma unroll
            for (int tm = 0; tm < 2; ++tm) {
                const int R = rt * 128 + w * 32 + tm * 16 + fr;
                float* xr = xres_row(p, R) + k;
                const f32x4 u0 = *(const f32x4*)xr, u1 = *(const f32x4*)(xr + 4);
                const f32x4 x0 = (u0 - mean[tm]) * rstd[tm] * g0 + b0, x1 = (u1 - mean[tm]) * rstd[tm] * g1v + b1;
                *(f32x4*)xr = x0; *(f32x4*)(xr + 4) = x1;
                const f32x4 h0 = x0 * (c0 + 1.f) + s0, h1 = x1 * (c1 + 1.f) + s1;
#pragma unroll
                for (int e = 0; e < 4; ++e) {
                    const bf16_t a = f2bf(h0[e]), b = f2bf(h1[e]);
                    hh[tm][e] = (short)a; hh[tm][4 + e] = (short)b;
                    hl[tm][e] = (short)f2bf(h0[e] - bf2f(a)); hl[tm][4 + e] = (short)f2bf(h1[e] - bf2f(b));
                }
                *(bf16x8*)(X2 + (size_t)R * D + k) = hh[tm];
            }
#pragma unroll
            for (int ft = 0; ft < 3; ++ft) {
                const bf16x8 wh = *(const bf16x8*)(WRh + (size_t)ft * 16 * 1024 + ks * 32), wl = *(const bf16x8*)(WRl + (size_t)ft * 16 * 1024 + ks * 32);
#pragma unroll
                for (int tm = 0; tm < 2; ++tm) {
                    lacc[ft][tm] = __builtin_amdgcn_mfma_f32_16x16x32_bf16(wh, hh[tm], lacc[ft][tm], 0, 0, 0);
                    lacc[ft][tm] = __builtin_amdgcn_mfma_f32_16x16x32_bf16(wl, hh[tm], lacc[ft][tm], 0, 0, 0);
                    lacc[ft][tm] = __builtin_amdgcn_mfma_f32_16x16x32_bf16(wh, hl[tm], lacc[ft][tm], 0, 0, 0);
                }
            }
        }
        float* lt = (float*)lds;
#pragma unroll
        for (int ft = 0; ft < 3; ++ft)
#pragma unroll
            for (int tm = 0; tm < 2; ++tm)
#pragma unroll
                for (int j = 0; j < 4; ++j) lt[(w * 32 + tm * 16 + fr) * 48 + ft * 16 + fq * 4 + j] = lacc[ft][tm][j];
        asm volatile("s_waitcnt lgkmcnt(0)" ::: "memory");
        if (lane < 32) {
            const int rl = w * 32 + lane, R = rt * 128 + rl;
            const float* lr = lt + rl * 48;
            int gi = 0; float gm = lr[0] + p.router_g_b[l * 4];
            float gl[4]; gl[0] = gm;
#pragma unroll
            for (int j = 1; j < 4; ++j) { gl[j] = lr[j] + p.router_g_b[l * 4 + j]; if (gl[j] > gm) { gm = gl[j]; gi = j; } }
            float gs = 0.f;
#pragma unroll
            for (int j = 0; j < 4; ++j) gs += expf(gl[j] - gm);
            const float ptop = 1.f / gs;
            int e0 = 0, e1 = 0; float m0 = -INFINITY, m1 = -INFINITY;
            for (int j = 0; j < 8; ++j) {
                const float v = lr[4 + gi * 8 + j] + p.router_e_b[l * 32 + gi * 8 + j];
                if (v > m0) { m1 = m0; e1 = e0; m0 = v; e0 = j; } else if (v > m1) { m1 = v; e1 = j; }
            }
            const float ex = expf(m1 - m0);
            const float w0 = ptop / (1.f + ex), w1 = ptop * ex / (1.f + ex);
            int* rte = (int*)(p.ws + OFF_RTE); float* rtw = (float*)(p.ws + OFF_RTW);
            unsigned* cnt = (unsigned*)(p.ws + OFF_CTL) + CW_CNT + l * 32;
            int* list = (int*)(p.ws + OFF_LIST);
            const int E0 = gi * 8 + e0, E1 = gi * 8 + e1;
            rte[R * 2] = E0; rte[R * 2 + 1] = E1; rtw[R * 2] = w0; rtw[R * 2 + 1] = w1;
            const unsigned p0 = atomicAdd(cnt + E0, 1u); list[(size_t)E0 * LISTCAP + p0] = R * 2;
            const unsigned p1 = atomicAdd(cnt + E1, 1u); list[(size_t)E1 * LISTCAP + p1] = R * 2 + 1;
        }
    }
}
DEV void ph_outproj(const Params& p, int l, bf16_t* lds, float* stat  ) {
    for (int rt = bid_(); rt < 512; rt += gridDim.x) { outproj_item(p, l, rt, lds, stat); __syncthreads(); }
}

DEV void moe1_item(const Params& p_, int l, int e, int jb, int pass, int item, int cnt, bf16_t* lds) {
    const Params& p = kp_();
    const int t = tid_(), lane = t & 63, w = t >> 6, wm = w >> 1, wn = w & 1, fq = lane >> 4, fr = lane & 15;
    const int* list = (const int*)(p.ws + OFF_LIST) + (size_t)e * LISTCAP;
    const bf16_t* X2 = (const bf16_t*)(p.ws + OFF_X2);
    bf16_t* Hs = (bf16_t*)(p.ws + OFF_P) + (size_t)item * 128 * FF;
    unsigned ao0, ao1;
    { const int s0 = jb * 128 + (t >> 2), s1 = s0 + 64;
      const int tok0 = s0 < cnt ? (list[s0] >> 1) : 0, tok1 = s1 < cnt ? (list[s1] >> 1) : 0;
      ao0 = (unsigned)((tok0 * D + gemm_src_chunk(t)) * 2); ao1 = (unsigned)((tok1 * D + gemm_src_chunk(t)) * 2); }
    const bf16_t* Bt = (const bf16_t*)(p.ws + OFF_WGU) + ((size_t)e * 1024 + pass * 256) * 1024;
    f32x4 acc[4][8]; zero_acc(acc);
    gemm_mainloop(X2, ao0, ao1, Bt, (unsigned)(((t >> 2) * 1024 + gemm_src_chunk(t)) * 2), 1024, 32, lds, acc);
#pragma unroll
    for (int mt = 0; mt < 4; ++mt) {
        const int rl = wm * 64 + mt * 16 + fr;
#pragma unroll
        for (int nt = 0; nt < 4; ++nt) {
            const f32x4 gv = acc[mt][nt], uv = acc[mt][nt + 4];
            float hv[4];
#pragma unroll
            for (int jj = 0; jj < 4; ++jj) hv[jj] = gv[jj] / (1.f + __expf(-gv[jj])) * uv[jj];
            uint2 o; o.x = pk2(hv[0], hv[1]); o.y = pk2(hv[2], hv[3]);
            *(uint2*)(Hs + (size_t)rl * FF + pass * 128 + wn * 64 + nt * 16 + fq * 4) = o;
        }
    }
}
DEV void moe2_item(const Params& p_, int l, int e, int jb, int pass, int item, int cnt, bf16_t* lds) {
    const Params& p = kp_();
    const int t = tid_(), lane = t & 63, w = t >> 6, wm = w >> 1, wn = w & 1, fq = lane >> 4, fr = lane & 15;
    const int* list = (const int*)(p.ws + OFF_LIST) + (size_t)e * LISTCAP;
    const bf16_t* Hs = (const bf16_t*)(p.ws + OFF_P) + (size_t)item * 128 * FF;
    const unsigned hoff = (unsigned)(((t >> 2) * FF + gemm_src_chunk(t)) * 2);
    const float* rtw = (const float*)(p.ws + OFF_RTW);
    bf16_t* Y = (bf16_t*)(p.ws + OFF_Y);
    const bf16_t* Bt = (const bf16_t*)(p.ws + OFF_WD) + ((size_t)e * 1024 + pass * 256) * FF;
    f32x4 acc[4][8]; zero_acc(acc);
    gemm_mainloop(Hs, hoff, hoff + 64 * FF * 2, Bt, hoff, FF, 16, lds, acc);
#pragma unroll
    for (int mt = 0; mt < 4; ++mt) {
        const int s = jb * 128 + wm * 64 + mt * 16 + fr;
        if (s < cnt) {
            const int ent = list[s];
            const float gw = rtw[ent];
            bf16_t* yo = Y + (size_t)ent * D + pass * 256 + wn * 128 + fq * 4;
#pragma unroll
            for (int nt = 0; nt < 8; ++nt) { const f32x4 v = acc[mt][nt] * gw; uint2 o; o.x = pk2(v[0], v[1]); o.y = pk2(v[2], v[3]); *(uint2*)(yo + nt * 16) = o; }
        }
    }
}
template <int STAGE> DEV void ph_moe(const Params& p, int l, bf16_t* lds, int* s_pref  , int* s_cnt  ) {
    const unsigned* cnt = (const unsigned*)(p.ws + OFF_CTL) + CW_CNT + l * 32;
    if (tid_() == 0) { int a = 0; for (int e = 0; e < 32; ++e) { const int c = (int)cnt[e]; s_cnt[e] = c; s_pref[e] = a; a += (c + 127) >> 7; } s_pref[32] = a; }
    __syncthreads();
    const int nx = gridDim.x >> 3, xcd = bid_() & 7, j = bid_() >> 3;
    if (bid_() < nx * 8) {
        const int n0 = (s_cnt[xcd] + 127) >> 7, n1 = (s_cnt[xcd + 8] + 127) >> 7, n2 = (s_cnt[xcd + 16] + 127) >> 7, n3 = (s_cnt[xcd + 24] + 127) >> 7;
        const int nloc = (n0 + n1 + n2 + n3) * 4;
        for (int i = j; i < nloc; i += nx) {
            const int pass = i & 3, ib = i >> 2;
            int e, jb;
            if (ib < n0) { e = xcd; jb = ib; } else if (ib < n0 + n1) { e = xcd + 8; jb = ib - n0; } else if (ib < n0 + n1 + n2) { e = xcd + 16; jb = ib - n0 - n1; } else { e = xcd + 24; jb = ib - n0 - n1 - n2; }
            if (STAGE == 1) moe1_item(p, l, e, jb, pass, s_pref[e] + jb, s_cnt[e], lds); else moe2_item(p, l, e, jb, pass, s_pref[e] + jb, s_cnt[e], lds);
        }
    }
    __syncthreads();
}

DEV void ph_rowin(const Params& p, int l, bf16_t* lds, int* slot, int ph) {
    const int np = l == 0 ? 9 : 5, nci = 16 * np, ntot = nci + 1024;
    unsigned* ctr = (unsigned*)(p.ws + OFF_CTL) + CW_Q + ph * 8;
    const int w = tid_() >> 6;
    for (;;) {
        const int it = q_pull(ctr, slot);
        if (it >= ntot) break;
        if (it < nci) {
            const int rt = 512 + it / np, pass = it % np;
            for (int r = w; r < 128; r += 4) { if (l == 0) rowop<0, true>(p, 0, rt * 128 + r); else rowop<1, false>(p, 1, rt * 128 + r); }
            __threadfence();
            __syncthreads();
            __builtin_amdgcn_fence(__ATOMIC_ACQUIRE, "agent");
            inproj_item(p, l, rt, pass, lds);
        } else {
            const int r0 = (it - nci) * 64;
            for (int r = w; r < 64; r += 4) { if (l == 0) rowop<0, true>(p, 0, r0 + r); else rowop<1, true>(p, 1, r0 + r); }
        }
    }
}
DEV void ph_inproj2(const Params& p, int l, bf16_t* lds, int* slot, int ph) {
    const int xcd = bid_() & 7;
    unsigned* ctr = (unsigned*)(p.ws + OFF_CTL) + CW_Q + ph * 8 + xcd;
    const int ntot = 2 + 576 + (l == 0 ? 32 : 0);
    for (;;) {
        const int it = q_pull(ctr, slot);
        if (it >= ntot) break;
        if (it < 2) { rg_item(p, l, 512 + 2 * xcd + it, lds); }
        else if (it < 578) { const int i = it - 2; inproj_item(p, l, xcd * 64 + i / 9, i % 9, lds); }
        else { const int i = it - 578, w = tid_() >> 6;
            const int tk = i < 24 ? NTASK_NA + NTASK_GQ + (xcd * 24 + i) * 4 + w : NTASK_NA + NTASK_GQ + NTASK_CNA + (xcd * 8 + (i - 24)) * 4 + w;
            attn_task(p, l, tk, (const float*)lds); }
    }
}
DEV void ph_mixer(const Params& p, int l, bf16_t* lds, float* stat, int* slot, int ph) {
    const int xcd = bid_() & 7;
    unsigned* ctr = (unsigned*)(p.ws + OFF_CTL) + CW_Q + ph * 8 + xcd;
    const int n0 = l == 0 ? 2 : 0, n1 = n0 + 64, n2 = n1 + 256, n3 = n2 + 768, ntot = n3 + 192;
    bool rpb_ok = false;
    float* rpb2 = (float*)lds;
    for (;;) {
        const int it = q_pull(ctr, slot);
        if (it >= ntot) break;
        if (it < n0) { outproj_item(p, l, 512 + 2 * xcd + it, lds, stat); rpb_ok = false; }
        else if (it < n1) { rg_item(p, l, xcd * 64 + (it - n0), lds); rpb_ok = false; }
        else if (it < n3) {
            if (!rpb_ok) { for (int i = tid_(); i < 6 * 15 * 31; i += 256) rpb2[i] = p.na_rpb[(size_t)l * 6 * 15 * 31 + i] * LOG2E; __syncthreads(); rpb_ok = true; }
            const int w = tid_() >> 6;
            int tk;
            if (it < n2) { const int i = it - n1; tk = NTASK_NA + (2 * xcd + (i >> 7)) * 512 + (i & 127) * 4 + w; }
            else { const int i = it - n2; tk = (6 * xcd + (i >> 7)) * 512 + (i & 127) * 4 + w; }
            attn_task(p, l, tk, rpb2);
        } else {
            rpb_ok = false;
            const int gi = xcd * 192 + (it - n3);
#pragma unroll 1
            for (int k = 0; k < 8; ++k) {
                const int T = gi * 8 + k, kind = T >> 12, Tl = T & 4095, e = Tl >> 7, tile = Tl & 127;
                if (kind == 0) transpose_tile(p.exp_w_gate + ((size_t)l * NE + e) * 1024 * 512, (bf16_t*)(p.ws + OFF_WGU) + (size_t)e * 1024 * 1024, 1024, 512, 1, tile, (float*)lds);
                else if (kind == 1) transpose_tile(p.exp_w_up + ((size_t)l * NE + e) * 1024 * 512, (bf16_t*)(p.ws + OFF_WGU) + (size_t)e * 1024 * 1024, 1024, 512, 2, tile, (float*)lds);
                else transpose_tile(p.exp_w_down + ((size_t)l * NE + e) * 512 * 1024, (bf16_t*)(p.ws + OFF_WD) + (size_t)e * 1024 * 512, 512, 1024, 0, tile, (float*)lds);
            }
        }
    }
}

#define XB_TMO      128
#define XB_XCNT(j)  (256  + 64 * (j))
#define XB_XSUB(j)  (1280 + 64 * (j))
#define XB_XGEN(j)  (2304 + 64 * (j))
#define XB_TOP      3328
#define XB_TOPGEN   3392
#define XCD_BAR_WORDS 3456
#define XB_SPIN_CAP (1u << 20)
DEV unsigned xb_ld(unsigned* p) { return __hip_atomic_load(p, __ATOMIC_RELAXED, __HIP_MEMORY_SCOPE_AGENT); }
DEV unsigned xb_add(unsigned* p, unsigned v) { return __hip_atomic_fetch_add(p, v, __ATOMIC_RELAXED, __HIP_MEMORY_SCOPE_AGENT); }
DEV unsigned xb_xcc_id() { return (unsigned)__builtin_amdgcn_s_getreg((3 << 11) | 20) & 0xFu; }
#define XB_SPIN(cond, bar) do { unsigned _sp = 0; while (cond) { __builtin_amdgcn_s_sleep(1); \
    if ((++_sp & 255u) == 0u) { if (xb_ld(&(bar)[XB_TMO])) break; if (_sp > XB_SPIN_CAP) { atomicAdd(&(bar)[XB_TMO], 1u); break; } } } } while (0)
struct XcdBarrier { unsigned* bar; unsigned x; volatile LAS unsigned* st; };
DEV XcdBarrier xcd_barrier_post(unsigned* bar, volatile LAS unsigned* st) {
    XcdBarrier b; b.bar = bar; b.x = xb_xcc_id(); b.st = st;
    if (tid_() == 0) (void)xb_add(&bar[XB_XCNT(b.x)], 1u);
    return b;
}
DEV void xcd_barrier_complete(unsigned* bar, unsigned x, unsigned& nloc, unsigned& nx) {
    const unsigned G = gridDim.x * gridDim.y * gridDim.z;
    unsigned sum, cnt, mine, sp = 0u;
    for (;;) {
        sum = 0u; cnt = 0u; mine = 0u;
#pragma unroll
        for (unsigned j = 0; j < 16; ++j) { const unsigned c = xb_ld(&bar[XB_XCNT(j)]); sum += c; cnt += (c > 0u) ? 1u : 0u; mine = (j == x) ? c : mine; }
        if (sum == G) break;
        __builtin_amdgcn_s_sleep(1);
        if ((++sp & 255u) == 0u) { if (xb_ld(&bar[XB_TMO])) break; if (sp > XB_SPIN_CAP) { atomicAdd(&bar[XB_TMO], 1u); break; } }
    }
    nloc = mine > 0u ? mine : 1u; nx = cnt > 0u ? cnt : 1u;
}
DEV void xcd_barrier(const XcdBarrier& b) {
    asm volatile("s_waitcnt vmcnt(0)" ::: "memory");
    __syncthreads();
    if (tid_() == 0) {
        unsigned* bar = b.bar;
        __builtin_amdgcn_s_waitcnt(0);
        unsigned nloc = b.st[0], nx = b.st[1];
        if (nloc == 0u) { xcd_barrier_complete(bar, b.x, nloc, nx); b.st[0] = nloc; b.st[1] = nx; }
        const unsigned old = xb_add(&bar[XB_XSUB(b.x)], 1u);
        const unsigned gen = old / nloc;
        if (old + 1u == (gen + 1u) * nloc) {
            __builtin_amdgcn_fence(__ATOMIC_RELEASE, "agent");
            asm volatile("s_waitcnt vmcnt(0)" ::: "memory");
            const unsigned og = xb_add(&bar[XB_TOP], 1u);
            const unsigned tg = og / nx;
            if (og + 1u == (tg + 1u) * nx) xb_add(&bar[XB_TOPGEN], 1u);
            else XB_SPIN(xb_ld(&bar[XB_TOPGEN]) == tg, bar);
            __builtin_amdgcn_fence(__ATOMIC_ACQUIRE, "agent");
            xb_add(&bar[XB_XGEN(b.x)], 1u);
            asm volatile("s_waitcnt vmcnt(0)" ::: "memory");
        } else {
            XB_SPIN(xb_ld(&bar[XB_XGEN(b.x)]) == gen, bar);
            __builtin_amdgcn_fence(__ATOMIC_ACQUIRE, "agent");
            asm volatile("s_waitcnt vmcnt(0)" ::: "memory");
        }
    }
    __syncthreads();
}

namespace cg = cooperative_groups;
#define REP(id) for (int rep_ = 0; rep_ < ((PROBE_ID) == (id) ? PROBE_N : 1); ++rep_)
constexpr int SMEM_STAT = GEMM_LDS_BYTES;
constexpr int SMEM_BYTES = GEMM_LDS_BYTES + 2048 + 512;
constexpr int NPHASE = 14;
__global__ void __launch_bounds__(256, 2) mega(Params p, int ph_lo, int ph_hi) {
    extern __shared__ __attribute__((aligned(16))) unsigned char smem[];
    bf16_t* lds = (bf16_t*)smem;
    float* stat = (float*)(smem + SMEM_STAT);
    int* s_pref = (int*)(smem + SMEM_STAT + 2048); int* s_cnt = s_pref + 40;
    int* qslot = (int*)(smem + SMEM_STAT + 2048 + 416);
    volatile LAS unsigned* bst = (volatile LAS unsigned*)(LAS unsigned char*)(smem + SMEM_STAT + 2048 + 400);
    if (tid_() < 2) bst[tid_()] = 0u;
    __syncthreads();
    (void)xcd_barrier_post((unsigned*)(kp_().ws + OFF_CTL + 4096), bst);
#define GRID_BAR() do { XcdBarrier xb_; xb_.bar = (unsigned*)(kp_().ws + OFF_CTL + 4096); xb_.x = xb_xcc_id(); \
        xb_.st = (volatile LAS unsigned*)(LAS unsigned char*)(smem + SMEM_STAT + 2048 + 400); xcd_barrier(xb_); } while (0)
#define IN(k) (ph_lo <= (k) && (k) < ph_hi)
#define SEAM(k) do { if (IN(k) && IN((k) + 1)) { if ((k) == 0) cg::this_grid().sync(); else GRID_BAR(); } } while (0)
    if (IN(0)) {
        REP(0) { ph_mod(kp_(), (float*)smem); __syncthreads(); }
        ph_rope(kp_());
        ph_routerw(kp_());
        ph_rgprep(kp_());
        REP(1) ph_transpose(kp_().w_in, (bf16_t*)(kp_().ws + OFF_WINT), 1024, 2304, 0, 2, (size_t)1024 * 2304, (size_t)2304 * 1024, (float*)smem);
        ph_transpose(kp_().w_out, (bf16_t*)(kp_().ws + OFF_WOUTT), 1024, 1024, 0, 2, (size_t)1024 * 1024, (size_t)1024 * 1024, (float*)smem);
    }
    SEAM(0);
#define LAYER_BODY(l, pb) { \
        if (IN(pb + 0)) ph_rowin(kp_(), l, lds, qslot, pb + 0); \
        SEAM(pb + 0); \
        if (IN(pb + 1)) ph_inproj2(kp_(), l, lds, qslot, pb + 1); \
        SEAM(pb + 1); \
        if (IN(pb + 2)) ph_mixer(kp_(), l, lds, stat, qslot, pb + 2); \
        SEAM(pb + 2); \
        if (IN(pb + 3)) ph_outproj(kp_(), l, lds, stat); \
        SEAM(pb + 3); \
        if (IN(pb + 4)) { REP(7) { ph_moe<1>(kp_(), l, lds, s_pref, s_cnt); } } \
        SEAM(pb + 4); \
        if (IN(pb + 5)) { REP(8) { ph_moe<2>(kp_(), l, lds, s_pref, s_cnt); } } \
        SEAM(pb + 5); \
    }
    LAYER_BODY(0, 1)
    LAYER_BODY(1, 7)
#undef LAYER_BODY
    if (IN(NPHASE - 1)) ph_rowop<2>(kp_(), 2, NLAT);
#undef IN
#undef SEAM
}

#ifndef ONE_LAUNCH
#define ONE_LAUNCH 1
#endif
extern "C" void kernel_launch(void* const* d_in, const int* in_sizes, int n_in, void* d_out, int out_size, void* d_ws, size_t ws_size, hipStream_t stream) {
    if (n_in != 28 || ws_size < WS_TOTAL || out_size != NLAT * D) { fprintf(stderr, "kernel_launch: unexpected shapes / workspace (%d inputs, ws %zu need %zu)\n", n_in, ws_size, (size_t)WS_TOTAL); return; }
    static int grid = 0;
    if (grid == 0) {
        int dev = 0, cus = 0, per_cu = 0;
        (void)hipGetDevice(&dev);
        (void)hipDeviceGetAttribute(&cus, hipDeviceAttributeMultiprocessorCount, dev);
        (void)hipFuncSetAttribute((const void*)mega, hipFuncAttributeMaxDynamicSharedMemorySize, SMEM_BYTES);
        (void)hipOccupancyMaxActiveBlocksPerMultiprocessor(&per_cu, (const void*)mega, 256, SMEM_BYTES);
        if (per_cu > 2) per_cu = 2;
        grid = cus * per_cu;
        if (grid <= 0) { fprintf(stderr, "kernel_launch: occupancy query gave %d blocks per CU on %d CUs\n", per_cu, cus); grid = -1; }
    }
    if (grid < 0) return;
    Params p{};
    const float** pp = (const float**)&p;
    for (int i = 0; i < 28; ++i) pp[i] = (const float*)d_in[i];
    p.out = (float*)d_out; p.ws = (unsigned char*)d_ws;
    (void)hipMemsetAsync((unsigned char*)d_ws + OFF_CTL, 0, CTL_BYTES, stream);
#if ONE_LAUNCH
    int lo = 0, hi = NPHASE;
    void* args[] = {(void*)&p, (void*)&lo, (void*)&hi};
    hipError_t e = hipLaunchCooperativeKernel((const void*)mega, dim3(grid), dim3(256), args, SMEM_BYTES, stream);
    if (e != hipSuccess) fprintf(stderr, "kernel_launch: cooperative launch failed: %s (grid %d)\n", hipGetErrorString(e), grid);
#else
    for (int ph = 0; ph < NPHASE; ++ph) mega<<<grid, 256, SMEM_BYTES, stream>>>(p, ph, ph + 1);
#endif
}
```

```cpp
#include <hip/hip_runtime.h>
#include <hip/hip_cooperative_groups.h>
#include <stdint.h>
#include <cstdio>

typedef unsigned short bf16_t;
typedef short bf16x8 __attribute__((ext_vector_type(8)));
typedef float f32x4 __attribute__((ext_vector_type(4)));

#define DEV __device__ __forceinline__
#define PROBE_ID -1
#define PROBE_N 4
#define PROBE_TS -1

constexpr int D = 1024, NB = 8, S = 8192, CTX = 256;
constexpr int NLAT = NB * S, NCTX = NB * CTX, NTOK = NLAT + NCTX;
constexpr int PWS = 1280;
constexpr int COL_RGX = 0, COL_GATE = 256, COL_NAQ = 512, COL_GQ = 896;
constexpr int KVT = 1024;
constexpr int NE = 32, FF = 512;
constexpr int LISTCAP = NTOK;
constexpr float ALPHA = 1.4142135623730951f;
constexpr float LN_EPS = 1e-5f;

constexpr size_t al256(size_t x) { return (x + 255) & ~(size_t)255; }
constexpr size_t OFF_CTL   = 0;
constexpr size_t CTL_BYTES = 4096 + 16384;
constexpr size_t OFF_MOD   = OFF_CTL + CTL_BYTES;
constexpr size_t OFF_ROPE  = al256(OFF_MOD + (size_t)2 * 9 * 6144 * 4);
constexpr size_t OFF_RTE   = al256(OFF_ROPE + (size_t)2 * 128 * 16 * 4);
constexpr size_t OFF_RTW   = al256(OFF_RTE + (size_t)NTOK * 8);
constexpr size_t OFF_LIST  = al256(OFF_RTW + (size_t)NTOK * 8);
constexpr size_t OFF_WR    = al256(OFF_LIST + (size_t)NE * LISTCAP * 4);
constexpr size_t OFF_WRG   = al256(OFF_WR + (size_t)2 * 2 * 48 * 1024 * 2);
constexpr size_t OFF_RGC   = al256(OFF_WRG + (size_t)2 * 2 * 2 * 4 * 64 * 64 * 2);
constexpr size_t OFF_AGG   = al256(OFF_RGC + (size_t)2 * 2 * 3 * 256 * 4);
constexpr size_t OFF_WINT  = al256(OFF_AGG + (size_t)NB * 66 * 2 * 2 * 256 * 4);
constexpr size_t OFF_WOUTT = al256(OFF_WINT + (size_t)2 * 2304 * 1024 * 2);
constexpr size_t OFF_WGU   = al256(OFF_WOUTT + (size_t)2 * 1024 * 1024 * 2);
constexpr size_t OFF_WD    = al256(OFF_WGU + (size_t)NE * 1024 * 1024 * 2);
constexpr size_t OFF_XCTX  = al256(OFF_WD + (size_t)NE * 1024 * 512 * 2);
constexpr size_t OFF_X1    = al256(OFF_XCTX + (size_t)NCTX * D * 4);
constexpr size_t OFF_X2    = al256(OFF_X1 + (size_t)NTOK * D * 2);
constexpr size_t OFF_P     = al256(OFF_X2 + (size_t)NTOK * D * 2);
constexpr size_t OFF_NAKF  = al256(OFF_P + (size_t)NTOK * PWS * 2);
constexpr size_t OFF_NAVF  = al256(OFF_NAKF + (size_t)NB * 6 * 512 * KVT * 2);
constexpr size_t OFF_GKF   = al256(OFF_NAVF + (size_t)NB * 6 * 512 * KVT * 2);
constexpr size_t OFF_GVF   = al256(OFF_GKF + (size_t)NB * 2 * 512 * KVT * 2);
constexpr size_t OFF_NAKFC = al256(OFF_GVF + (size_t)NB * 2 * 512 * KVT * 2);
constexpr size_t OFF_NAVFC = al256(OFF_NAKFC + (size_t)NB * 6 * 16 * KVT * 2);
constexpr size_t OFF_GKFC  = al256(OFF_NAVFC + (size_t)NB * 6 * 16 * KVT * 2);
constexpr size_t OFF_GVFC  = al256(OFF_GKFC + (size_t)NB * 2 * 16 * KVT * 2);
constexpr size_t OFF_Y     = al256(OFF_GVFC + (size_t)NB * 2 * 16 * KVT * 2);
constexpr size_t WS_TOTAL  = al256(OFF_Y + (size_t)2 * NTOK * D * 2);
constexpr int CW_CNT = 0;

struct Params {
    const float *x, *c, *ctx, *c_ctx, *w_ada, *b_ada, *w_in, *conv_w, *conv_b, *rg_a_w, *rg_a_b, *rg_i_w, *rg_i_b, *rg_lambda,
        *na_rpb, *gqa_sink, *w_out, *ln1_g, *ln1_b, *router_g_w, *router_g_b, *router_e_w, *router_e_b, *exp_w_gate, *exp_w_up,
        *exp_w_down, *ln2_g, *ln2_b;
    float* out;
    unsigned char* ws;
};

DEV const Params& kp_() { const void* q = (const void*)__builtin_amdgcn_kernarg_segment_ptr(); asm volatile("" : "+s"(q)); return *(const Params*)q; }
DEV int tid_() { int t = threadIdx.x; asm volatile("" : "+v"(t)); return t; }
DEV int bid_() { int b = blockIdx.x; asm volatile("" : "+s"(b)); return b; }
DEV float shx(float v, int m) { return __builtin_bit_cast(float, __builtin_amdgcn_ds_bpermute(((tid_() & 63) ^ m) << 2, __builtin_bit_cast(int, v))); }
DEV float shl_(float v, int src) { return __builtin_bit_cast(float, __builtin_amdgcn_ds_bpermute(src << 2, __builtin_bit_cast(int, v))); }
DEV float bf2f(bf16_t h) { return __uint_as_float((unsigned)h << 16); }
DEV bf16_t f2bf(float f) { unsigned u = __float_as_uint(f); u += 0x7fffu + ((u >> 16) & 1u); return (bf16_t)(u >> 16); }
DEV unsigned pk2(float lo, float hi) { return (unsigned)f2bf(lo) | ((unsigned)f2bf(hi) << 16); }
DEV float wave_sum(float v) {
#pragma unroll
    for (int o = 1; o < 64; o <<= 1) v += shx(v, o);
    return v;
}
DEV float wave_max(float v) {
#pragma unroll
    for (int o = 1; o < 64; o <<= 1) v = fmaxf(v, shx(v, o));
    return v;
}
DEV float sigmoidf_(float x) { return 1.f / (1.f + __expf(-x)); }
DEV float gelu_tanh(float x) {
    const float u = 0.7978845608028654f * (x + 0.044715f * x * x * x);
    const float t = 1.f - 2.f / (1.f + __expf(2.f * u));
    return 0.5f * x * (1.f + t);
}
DEV float* xres_row(const Params& p, int R) {
    return R < NLAT ? p.out + (size_t)R * D : (float*)(p.ws + OFF_XCTX) + (size_t)(R - NLAT) * D;
}
DEV const float* modvec(const Params& p, int l, int R, int seg) {
    const int b = R < NLAT ? R / S : 8;
    return (const float*)(p.ws + OFF_MOD) + ((size_t)(l * 9 + b) * 6 + seg) * 1024;
}

DEV void ph_mod(const Params& p, float* sc  ) {
    if (bid_() >= 192) return;
    for (int i = tid_(); i < 9 * 1024; i += 256) { const float v = (i < 8192) ? p.c[i] : p.c_ctx[i - 8192]; sc[i] = v / (1.f + expf(-v)); }
    __syncthreads();
    const int lane = tid_() & 63, w = tid_() >> 6;
    const int col = bid_() * 64 + lane;
    const int l = col / 6144, j = col % 6144;
    const float* wp = p.w_ada + (size_t)l * 1024 * 6144 + j + (size_t)(w * 256) * 6144;
    const float* s = sc + w * 256;
    float a0 = 0, a1 = 0, a2 = 0, a3 = 0, a4 = 0, a5 = 0, a6 = 0, a7 = 0, a8 = 0;
#pragma unroll 8
    for (int k = 0; k < 256; ++k) {
        const float wv = wp[(size_t)k * 6144];
        a0 += s[k] * wv; a1 += s[1024 + k] * wv; a2 += s[2048 + k] * wv; a3 += s[3072 + k] * wv; a4 += s[4096 + k] * wv;
        a5 += s[5120 + k] * wv; a6 += s[6144 + k] * wv; a7 += s[7168 + k] * wv; a8 += s[8192 + k] * wv;
    }
    __syncthreads();
    float* red = sc + 9 * 1024;
    red[(w * 9 + 0) * 64 + lane] = a0; red[(w * 9 + 1) * 64 + lane] = a1; red[(w * 9 + 2) * 64 + lane] = a2; red[(w * 9 + 3) * 64 + lane] = a3; red[(w * 9 + 4) * 64 + lane] = a4;
    red[(w * 9 + 5) * 64 + lane] = a5; red[(w * 9 + 6) * 64 + lane] = a6; red[(w * 9 + 7) * 64 + lane] = a7; red[(w * 9 + 8) * 64 + lane] = a8;
    __syncthreads();
    if (w == 0) {
        const float bias = p.b_ada[l * 6144 + j];
        float* mod = (float*)(p.ws + OFF_MOD) + (size_t)l * 9 * 6144 + j;
#pragma unroll
        for (int r = 0; r < 9; ++r) mod[r * 6144] = ((red[(0 * 9 + r) * 64 + lane] + red[(1 * 9 + r) * 64 + lane]) + (red[(2 * 9 + r) * 64 + lane] + red[(3 * 9 + r) * 64 + lane])) + bias;
    }
}

DEV void sincos_red(float ang, float& sn, float& cs) {
    const float n = rintf(ang * 0.15915494309189535f);
    float r = fmaf(-n, 6.2831854820251465f, ang);
    r = fmaf(-n, -1.7484555e-07f, r);
    float sgn = 1.f;
    if (r > 1.5707963267948966f) { r = 3.14159265358979f - r; sgn = -1.f; }
    else if (r < -1.5707963267948966f) { r = -3.14159265358979f - r; sgn = -1.f; }
    const float r2 = r * r;
    float sp = -1.6059044e-10f; sp = fmaf(sp, r2, 2.5052108e-08f); sp = fmaf(sp, r2, -2.7557319e-06f); sp = fmaf(sp, r2, 1.9841270e-04f);
    sp = fmaf(sp, r2, -8.3333333e-03f); sp = fmaf(sp, r2, 1.6666667e-01f); sp = fmaf(sp * -1.f, r2, 1.f);
    sn = r * sp;
    float cp = -1.1470746e-11f; cp = fmaf(cp, r2, 2.0876757e-09f); cp = fmaf(cp, r2, -2.7557319e-07f); cp = fmaf(cp, r2, 2.4801587e-05f);
    cp = fmaf(cp, r2, -1.3888889e-03f); cp = fmaf(cp, r2, 4.1666667e-02f); cp = fmaf(cp, r2, -0.5f); cp = fmaf(cp, r2, 1.f);
    cs = sgn * cp;
}
DEV void ph_rope(const Params& p) {
    const int i = (bid_() - 192) * 256 + tid_();
    if (i < 0 || i >= 128 * 16) return;
    const int pos = i >> 4, q = i & 15;
    const float inv = exp2f(-(float)q * (13.287712379549449f / 16.f));
    float sn, cs; sincos_red((float)pos * inv, sn, cs);
    float* tab = (float*)(p.ws + OFF_ROPE);
    tab[i] = cs; tab[2048 + i] = sn;
}

DEV void ph_routerw(const Params& p) {
  for (int i = bid_() * 256 + tid_(); i < 2 * 48 * 1024; i += gridDim.x * 256) {
    const int l = i / (48 * 1024), f = (i / 1024) % 48, k = i & 1023;
    float w = 0.f;
    if (f < 4) w = p.router_g_w[((size_t)l * 1024 + k) * 4 + f]; else if (f < 36) w = p.router_e_w[((size_t)l * 1024 + k) * 32 + (f - 4)];
    const bf16_t hi = f2bf(w), lo = f2bf(w - bf2f(hi));
    bf16_t* WR = (bf16_t*)(p.ws + OFF_WR);
    WR[((size_t)(l * 2 + 0) * 48 + f) * 1024 + k] = hi;
    WR[((size_t)(l * 2 + 1) * 48 + f) * 1024 + k] = lo;
  }
}

DEV void ph_rgprep(const Params& p) {
    bf16_t* W = (bf16_t*)(p.ws + OFF_WRG);
    for (int i = bid_() * 256 + tid_(); i < 2 * 2 * 2 * 4 * 64 * 64; i += gridDim.x * 256) {
        const int d = i & 63, e = (i >> 6) & 63, n = (i >> 12) & 3, gate = (i >> 14) & 1, ld = i >> 15;
        const float* srcw = gate ? p.rg_i_w : p.rg_a_w;
        W[i] = f2bf(srcw[((size_t)(ld * 4 + n) * 64 + d) * 64 + e]);
    }
    float* C = (float*)(p.ws + OFF_RGC);
    for (int i = bid_() * 256 + tid_(); i < 2 * 2 * 256; i += gridDim.x * 256) {
        const int c = i & 255, ld = i >> 8;
        C[(ld * 3 + 0) * 256 + c] = p.rg_a_b[ld * 256 + c];
        C[(ld * 3 + 1) * 256 + c] = p.rg_i_b[ld * 256 + c];
        C[(ld * 3 + 2) * 256 + c] = -8.f * log1pf(expf(-p.rg_lambda[ld * 256 + c]));
    }
}

DEV int tr_row(int n, int mode) { return mode == 0 ? n : ((n >> 7) * 256 + ((n >> 6) & 1) * 128 + (n & 63) + (mode == 2 ? 64 : 0)); }
DEV void transpose_tile(const float* src, bf16_t* dst, int K, int N, int mode, int tile, float* lds) {
    const int ntn = N >> 6, kt = tile / ntn, nt = tile % ntn, k0 = kt * 64, n0 = nt * 64, t = tid_();
#pragma unroll
    for (int i = 0; i < 4; ++i) {
        const int r = (t >> 4) + 16 * i, c4 = (t & 15) * 4;
        const float4 v = *(const float4*)(src + (size_t)(k0 + r) * N + n0 + c4);
        lds[r * 65 + c4] = v.x; lds[r * 65 + c4 + 1] = v.y; lds[r * 65 + c4 + 2] = v.z; lds[r * 65 + c4 + 3] = v.w;
    }
    __syncthreads();
#pragma unroll
    for (int i = 0; i < 2; ++i) {
        const int n = (t >> 3) + 32 * i, kc = (t & 7) * 8;
        uint4 o;
        o.x = pk2(lds[(kc + 0) * 65 + n], lds[(kc + 1) * 65 + n]); o.y = pk2(lds[(kc + 2) * 65 + n], lds[(kc + 3) * 65 + n]);
        o.z = pk2(lds[(kc + 4) * 65 + n], lds[(kc + 5) * 65 + n]); o.w = pk2(lds[(kc + 6) * 65 + n], lds[(kc + 7) * 65 + n]);
        *(uint4*)(dst + (size_t)tr_row(n0 + n, mode) * K + k0 + kc) = o;
    }
    __syncthreads();
}
DEV void ph_transpose(const float* src, bf16_t* dst, int K, int N, int mode, int nmat, size_t sstride, size_t dstride, float* lds  ) {
    const int per = (K >> 6) * (N >> 6);
    for (int it = bid_(); it < nmat * per; it += gridDim.x) {
        const int m = it / per, tile = it % per;
        transpose_tile(src + (size_t)m * sstride, dst + (size_t)m * dstride, K, N, mode, tile, lds);
    }
}

template <int MODE, bool WX> DEV void rowop(const Params& p, int l, int R) {
    const int lane = tid_() & 63;
    float4 v[4];
    if (MODE == 0) {
        const float* src = R < NLAT ? p.x + (size_t)R * D : p.ctx + (size_t)(R - NLAT) * D;
#pragma unroll
        for (int i = 0; i < 4; ++i) v[i] = *(const float4*)(src + i * 256 + lane * 4);
    } else {
        float* xr = xres_row(p, R);
        const float* g2 = modvec(p, l - 1, R, 5);
        const bf16_t* y0 = (const bf16_t*)(p.ws + OFF_Y) + (size_t)(2 * R) * D;
        const bf16_t* y1 = y0 + D;
        const float* lg = p.ln2_g + (l - 1) * D; const float* lb = p.ln2_b + (l - 1) * D;
        float s = 0.f;
#pragma unroll
        for (int i = 0; i < 4; ++i) {
            const int k = i * 256 + lane * 4;
            const float4 xv = *(const float4*)(xr + k); const float4 gv = *(const float4*)(g2 + k);
            const uint2 a = *(const uint2*)(y0 + k); const uint2 b = *(const uint2*)(y1 + k);
            float4 u;
            u.x = ALPHA * xv.x + gv.x * (bf2f((bf16_t)(a.x & 0xffff)) + bf2f((bf16_t)(b.x & 0xffff)));
            u.y = ALPHA * xv.y + gv.y * (bf2f((bf16_t)(a.x >> 16)) + bf2f((bf16_t)(b.x >> 16)));
            u.z = ALPHA * xv.z + gv.z * (bf2f((bf16_t)(a.y & 0xffff)) + bf2f((bf16_t)(b.y & 0xffff)));
            u.w = ALPHA * xv.w + gv.w * (bf2f((bf16_t)(a.y >> 16)) + bf2f((bf16_t)(b.y >> 16)));
            v[i] = u; s += (u.x + u.y) + (u.z + u.w);
        }
        const float mean = wave_sum(s) * (1.f / D);
        float q = 0.f;
#pragma unroll
        for (int i = 0; i < 4; ++i) { v[i].x -= mean; v[i].y -= mean; v[i].z -= mean; v[i].w -= mean; q += (v[i].x * v[i].x + v[i].y * v[i].y) + (v[i].z * v[i].z + v[i].w * v[i].w); }
        const float rstd = rsqrtf(wave_sum(q) * (1.f / D) + LN_EPS);
#pragma unroll
        for (int i = 0; i < 4; ++i) {
            const int k = i * 256 + lane * 4;
            const float4 gg = *(const float4*)(lg + k); const float4 bb = *(const float4*)(lb + k);
            v[i].x = v[i].x * rstd * gg.x + bb.x; v[i].y = v[i].y * rstd * gg.y + bb.y; v[i].z = v[i].z * rstd * gg.z + bb.z; v[i].w = v[i].w * rstd * gg.w + bb.w;
            if (WX) *(float4*)(xr + k) = v[i];
        }
    }
    if (MODE != 2) {
        const float* sh = modvec(p, l, R, 0); const float* sc = modvec(p, l, R, 1);
        bf16_t* ha = (bf16_t*)(p.ws + OFF_X1) + (size_t)R * D;
#pragma unroll
        for (int i = 0; i < 4; ++i) {
            const int k = i * 256 + lane * 4;
            const float4 s4 = *(const float4*)(sh + k); const float4 c4 = *(const float4*)(sc + k);
            uint2 o; o.x = pk2(v[i].x * (1.f + c4.x) + s4.x, v[i].y * (1.f + c4.y) + s4.y); o.y = pk2(v[i].z * (1.f + c4.z) + s4.z, v[i].w * (1.f + c4.w) + s4.w);
            *(uint2*)(ha + k) = o;
        }
    }
}
template <int MODE> DEV void ph_rowop(const Params& p, int l, int nrows) {
    const int w = tid_() >> 6;
    for (int R = bid_() * 4 + w; R < nrows; R += gridDim.x * 4) rowop<MODE, true>(p, l, R);
}
constexpr int CW_Q = 64;
DEV int q_pull(unsigned* ctr, int* slot) {
    if (tid_() == 0) *slot = (int)atomicAdd(ctr, 1u);
    __syncthreads();
    const int v = *(volatile int*)slot;
    __syncthreads();
    return v;
}

constexpr int GEMM_STAGE_BYTES = 384 * 64;
constexpr int GEMM_NSTAGE = 3;
constexpr int GEMM_LDS_BYTES = GEMM_NSTAGE * GEMM_STAGE_BYTES;
#define LAS __attribute__((address_space(3)))
DEV int gemm_src_chunk(int t) { return ((t & 3) ^ ((0 - (t >> 4)) & 3)) * 8; }
DEV void gemm_mainloop(const bf16_t* Abase, unsigned ao0, unsigned ao1, const bf16_t* Bbase, unsigned bo, unsigned ldb, int nk, bf16_t* lds, f32x4 (&acc)[4][8]) {
    const int t = tid_(), lane = t & 63, w = __builtin_amdgcn_readfirstlane(t >> 6), wm = w >> 1, wn = w & 1;
    LAS unsigned char* L = (LAS unsigned char*)lds;
    const int pc = ((lane >> 4) ^ ((0 - ((lane & 15) >> 2)) & 3)) * 16;
    const int arow = (wm * 64 + (lane & 15)) * 64 + pc, brow = (128 + wn * 128 + (lane & 15)) * 64 + pc;
    const char* Ab = (const char*)Abase; const char* B0 = (const char*)Bbase; const char* B1 = B0 + (size_t)ldb * 128; const char* B2 = B0 + (size_t)ldb * 256; const char* B3 = B0 + (size_t)ldb * 384;
#define GEMM_ISSUE(slot, ko) do { LAS unsigned* d_ = (LAS unsigned*)(L + (slot) * GEMM_STAGE_BYTES + w * 1024); \
        __builtin_amdgcn_global_load_lds((const unsigned*)(Ab + (ao0 + (ko) * 2u)), d_, 16, 0, 0); \
        __builtin_amdgcn_global_load_lds((const unsigned*)(Ab + (ao1 + (ko) * 2u)), d_ + 1024, 16, 0, 0); \
        __builtin_amdgcn_global_load_lds((const unsigned*)(B0 + (bo + (ko) * 2u)), d_ + 2048, 16, 0, 0); \
        __builtin_amdgcn_global_load_lds((const unsigned*)(B1 + (bo + (ko) * 2u)), d_ + 3072, 16, 0, 0); \
        __builtin_amdgcn_global_load_lds((const unsigned*)(B2 + (bo + (ko) * 2u)), d_ + 4096, 16, 0, 0); \
        __builtin_amdgcn_global_load_lds((const unsigned*)(B3 + (bo + (ko) * 2u)), d_ + 5120, 16, 0, 0); } while (0)
    asm volatile("s_waitcnt vmcnt(0)" ::: "memory");
    __builtin_amdgcn_s_barrier();
    asm volatile("" ::: "memory");
    GEMM_ISSUE(0, 0);
    if (nk > 1) GEMM_ISSUE(1, 32);
    int cs = 0, is = 2;
    for (int kt = 0; kt < nk; ++kt) {
        if (kt + 1 < nk) asm volatile("s_waitcnt vmcnt(6)" ::: "memory"); else asm volatile("s_waitcnt vmcnt(0)" ::: "memory");
        __builtin_amdgcn_s_barrier();
        asm volatile("" ::: "memory");
        if (kt + 2 < nk) GEMM_ISSUE(is, (kt + 2) * 32);
        const LAS unsigned char* cur = L + cs * GEMM_STAGE_BYTES;
        const bf16x8 af0 = *(const LAS bf16x8*)(cur + arow), af1 = *(const LAS bf16x8*)(cur + arow + 16 * 64), af2 = *(const LAS bf16x8*)(cur + arow + 32 * 64), af3 = *(const LAS bf16x8*)(cur + arow + 48 * 64);
        bf16x8 bq0 = *(const LAS bf16x8*)(cur + brow), bq1 = *(const LAS bf16x8*)(cur + brow + 16 * 64);
#pragma unroll
        for (int nt = 0; nt < 8; ++nt) {
            const bf16x8 bfr = bq0; bq0 = bq1;
            if (nt + 2 < 8) bq1 = *(const LAS bf16x8*)(cur + brow + (nt + 2) * 16 * 64);
            acc[0][nt] = __builtin_amdgcn_mfma_f32_16x16x32_bf16(bfr, af0, acc[0][nt], 0, 0, 0);
            acc[1][nt] = __builtin_amdgcn_mfma_f32_16x16x32_bf16(bfr, af1, acc[1][nt], 0, 0, 0);
            acc[2][nt] = __builtin_amdgcn_mfma_f32_16x16x32_bf16(bfr, af2, acc[2][nt], 0, 0, 0);
            acc[3][nt] = __builtin_amdgcn_mfma_f32_16x16x32_bf16(bfr, af3, acc[3][nt], 0, 0, 0);
        }
        cs = cs == 2 ? 0 : cs + 1; is = is == 2 ? 0 : is + 1;
    }
#undef GEMM_ISSUE
}
DEV void zero_acc(f32x4 (&acc)[4][8]) {
#pragma unroll
    for (int a = 0; a < 4; ++a)
#pragma unroll
        for (int b = 0; b < 8; ++b) acc[a][b] = (f32x4){0.f, 0.f, 0.f, 0.f};
}

DEV void inproj_item(const Params& p_, int l, int rt, int pass, bf16_t* lds) {
    const Params& p = kp_();
    const int t = tid_(), lane = t & 63, w = t >> 6, wm = w >> 1, wn = w & 1;
    const bf16_t* A = (const bf16_t*)(p.ws + OFF_X1) + (size_t)(rt * 128) * D;
    const bf16_t* Bt = (const bf16_t*)(p.ws + OFF_WINT) + ((size_t)l * 2304 + pass * 256) * 1024;
    const unsigned toff = (unsigned)(((t >> 2) * 1024 + gemm_src_chunk(t)) * 2);
    f32x4 acc[4][8]; zero_acc(acc);
    gemm_mainloop(A, toff, toff + 64 * D * 2, Bt, toff, 1024, 32, lds, acc);
    bf16_t* P = (bf16_t*)(p.ws + OFF_P);
    const float* ctab = (const float*)(p.ws + OFF_ROPE); const float* stab = ctab + 2048;
    const bool isctx = rt >= 512;
    const int fq = lane >> 4, fr = lane & 15;
#pragma unroll
    for (int hci = 0; hci < 2; ++hci) {
        const int hc = pass * 4 + wn * 2 + hci;
        int type, dcol = 0, vh = 0;
        if (hc < 4) { type = 0; dcol = COL_RGX + hc * 64; }
        else if (hc < 10) { type = 4; vh = hc - 4; }
        else if (hc < 16) { type = 5; vh = hc - 10; }
        else if (hc < 18) { type = 6; vh = hc - 16; }
        else if (hc < 20) { type = 7; vh = hc - 18; }
        else if (hc < 24) { type = 0; dcol = COL_GATE + (hc - 20) * 64; }
        else if (hc < 30) { type = 1; dcol = COL_NAQ + (hc - 24) * 64; }
        else { type = 3; dcol = COL_GQ + (hc - 30) * 64; }
#pragma unroll
        for (int mt = 0; mt < 4; ++mt) {
            const int R = rt * 128 + wm * 64 + mt * 16 + fr;
            f32x4 v0 = acc[mt][hci * 4 + 0], v1 = acc[mt][hci * 4 + 1], v2 = acc[mt][hci * 4 + 2], v3 = acc[mt][hci * 4 + 3];
            if ((type == 3 || type == 6) && !isctx) {
                const int tt = R & (S - 1), pr = tt >> 6, pc = tt & 63;
                const f32x4 cr = *(const f32x4*)(ctab + pr * 16 + fq * 4), sr = *(const f32x4*)(stab + pr * 16 + fq * 4);
                const f32x4 cc = *(const f32x4*)(ctab + pc * 16 + fq * 4), sc = *(const f32x4*)(stab + pc * 16 + fq * 4);
                const f32x4 o0 = v0 * cr - v1 * sr, o1 = v1 * cr + v0 * sr, o2 = v2 * cc - v3 * sc, o3 = v3 * cc + v2 * sc;
                v0 = o0; v1 = o1; v2 = o2; v3 = o3;
            }
            if (type == 1 || type == 3) { v0 = v0 * 0.125f; v1 = v1 * 0.125f; v2 = v2 * 0.125f; v3 = v3 * 0.125f; }
            if (type < 4) {
                bf16_t* o = P + (size_t)R * PWS + dcol + fq * 4;
                uint2 q;
                q.x = pk2(v0[0], v0[1]); q.y = pk2(v0[2], v0[3]); *(uint2*)(o) = q;
                q.x = pk2(v1[0], v1[1]); q.y = pk2(v1[2], v1[3]); *(uint2*)(o + 16) = q;
                q.x = pk2(v2[0], v2[1]); q.y = pk2(v2[2], v2[3]); *(uint2*)(o + 32) = q;
                q.x = pk2(v3[0], v3[1]); q.y = pk2(v3[2], v3[3]); *(uint2*)(o + 48) = q;
            } else {
                const bool na = type < 6, isk = (type == 4 || type == 6);
                bf16_t* tb;
                if (!isctx) { const int b = R >> 13, tile = (R & (S - 1)) >> 4;
                    tb = (bf16_t*)(p.ws + (na ? (isk ? OFF_NAKF : OFF_NAVF) : (isk ? OFF_GKF : OFF_GVF))) + ((size_t)(b * (na ? 6 : 2) + vh) * 512 + tile) * KVT; }
                else { const int cR = R - NLAT, b = cR >> 8, tile = (cR & 255) >> 4;
                    tb = (bf16_t*)(p.ws + (na ? (isk ? OFF_NAKFC : OFF_NAVFC) : (isk ? OFF_GKFC : OFF_GVFC))) + ((size_t)(b * (na ? 6 : 2) + vh) * 16 + tile) * KVT; }
                if (isk) {
                    bf16_t* o = tb + ((fq >> 1) * 16 + fr) * 8 + (fq & 1) * 4;
                    uint2 q;
                    q.x = pk2(v0[0], v0[1]); q.y = pk2(v0[2], v0[3]); *(uint2*)(o) = q;
                    q.x = pk2(v1[0], v1[1]); q.y = pk2(v1[2], v1[3]); *(uint2*)(o + 2 * 16 * 8) = q;
                    q.x = pk2(v2[0], v2[1]); q.y = pk2(v2[2], v2[3]); *(uint2*)(o + 512) = q;
                    q.x = pk2(v3[0], v3[1]); q.y = pk2(v3[2], v3[3]); *(uint2*)(o + 512 + 2 * 16 * 8) = q;
                } else {
                    bf16_t* o = tb + ((fr >> 2) * 16 + fq * 4) * 8 + (fr & 3);
#pragma unroll
                    for (int j = 0; j < 4; ++j) {
                        o[j * 8] = f2bf(v0[j]); o[j * 8 + 4] = f2bf(v1[j]); o[512 + j * 8] = f2bf(v2[j]); o[512 + j * 8 + 4] = f2bf(v3[j]);
                    }
                }
            }
        }
    }
}
DEV void ph_inproj(const Params& p, int l, bf16_t* lds) {
    const int nctxp = (l == 0) ? 9 : 5;
    const int nx = gridDim.x >> 3, xcd = bid_() & 7, j = bid_() >> 3;
    const int nloc = 64 * 9 + 2 * nctxp;
    if (bid_() >= nx * 8) return;
    for (int i0 = j; i0 < nloc * ((PROBE_ID) == 3 ? PROBE_N : 1); i0 += nx) {
        const int i = i0 % nloc;
        int rt, pass;
        if (i < 64 * 9) { rt = xcd * 64 + i / 9; pass = i % 9; } else { const int r = i - 64 * 9; rt = 512 + 2 * xcd + r / nctxp; pass = r % nctxp; }
        inproj_item(p, l, rt, pass, lds);
    }
}

constexpr float LOG2E = 1.4426950408889634f;
struct AttnState { f32x4 o0, o1, o2, o3; float m, lsum; };
struct KVFrag { bf16x8 k00, k01, k10, k11, v0, v1, v2, v3; };
DEV bf16x8 ld16(const bf16_t* p) { return *(const bf16x8*)p; }
DEV bf16x8 lohi(const uint4& a, const uint4& b, int hi) { union { uint4 u; bf16x8 v; } c; c.u = hi ? make_uint4(a.z, a.w, b.z, b.w) : make_uint4(a.x, a.y, b.x, b.y); return c.v; }
DEV void kv_load(const bf16_t* kt0, const bf16_t* kt1, const bf16_t* vt0, const bf16_t* vt1, KVFrag& f) {
    f.k00 = ld16(kt0); f.k01 = ld16(kt0 + 512); f.k10 = ld16(kt1); f.k11 = ld16(kt1 + 512);
    const uint4 a0 = *(const uint4*)vt0, a1 = *(const uint4*)(vt0 + 512), b0 = *(const uint4*)vt1, b1 = *(const uint4*)(vt1 + 512);
    f.v0 = lohi(a0, b0, 0); f.v1 = lohi(a0, b0, 1); f.v2 = lohi(a1, b1, 0); f.v3 = lohi(a1, b1, 1);
}
DEV void attn_apply(const KVFrag& f, const bf16x8& q0, const bf16x8& q1, f32x4 b0, f32x4 b1, AttnState& st) {
    const f32x4 z = {0.f, 0.f, 0.f, 0.f};
    f32x4 s0 = __builtin_amdgcn_mfma_f32_16x16x32_bf16(f.k00, q0, z, 0, 0, 0); s0 = __builtin_amdgcn_mfma_f32_16x16x32_bf16(f.k01, q1, s0, 0, 0, 0);
    f32x4 s1 = __builtin_amdgcn_mfma_f32_16x16x32_bf16(f.k10, q0, z, 0, 0, 0); s1 = __builtin_amdgcn_mfma_f32_16x16x32_bf16(f.k11, q1, s1, 0, 0, 0);
    s0 = s0 * LOG2E + b0; s1 = s1 * LOG2E + b1;
    float mx = fmaxf(fmaxf(fmaxf(s0[0], s0[1]), fmaxf(s0[2], s0[3])), fmaxf(fmaxf(s1[0], s1[1]), fmaxf(s1[2], s1[3])));
    mx = fmaxf(mx, shx(mx, 16)); mx = fmaxf(mx, shx(mx, 32));
    const float mn = fmaxf(st.m, mx);
    const float ms = (mn == -INFINITY) ? 0.f : mn;
    const float alpha = __builtin_amdgcn_exp2f(st.m - ms);
    f32x4 p0, p1;
#pragma unroll
    for (int j = 0; j < 4; ++j) { p0[j] = __builtin_amdgcn_exp2f(s0[j] - ms); p1[j] = __builtin_amdgcn_exp2f(s1[j] - ms); }
    st.lsum = st.lsum * alpha + ((p0[0] + p0[1]) + (p0[2] + p0[3])) + ((p1[0] + p1[1]) + (p1[2] + p1[3]));
    st.o0 = st.o0 * alpha; st.o1 = st.o1 * alpha; st.o2 = st.o2 * alpha; st.o3 = st.o3 * alpha;
    union { uint4 u; bf16x8 v; } pt; pt.u = make_uint4(pk2(p0[0], p0[1]), pk2(p0[2], p0[3]), pk2(p1[0], p1[1]), pk2(p1[2], p1[3]));
    st.o0 = __builtin_amdgcn_mfma_f32_16x16x32_bf16(f.v0, pt.v, st.o0, 0, 0, 0);
    st.o1 = __builtin_amdgcn_mfma_f32_16x16x32_bf16(f.v1, pt.v, st.o1, 0, 0, 0);
    st.o2 = __builtin_amdgcn_mfma_f32_16x16x32_bf16(f.v2, pt.v, st.o2, 0, 0, 0);
    st.o3 = __builtin_amdgcn_mfma_f32_16x16x32_bf16(f.v3, pt.v, st.o3, 0, 0, 0);
    st.m = mn;
}
DEV void attn_init(AttnState& st) { const f32x4 z = {0.f, 0.f, 0.f, 0.f}; st.o0 = z; st.o1 = z; st.o2 = z; st.o3 = z; st.m = -INFINITY; st.lsum = 0.f; }
DEV void attn_store(AttnState& st, bf16_t* orow, float sink2  ) {
    float l = st.lsum; l += shx(l, 16); l += shx(l, 32);
    float sc;
    if (sink2 != -INFINITY) { const float mf = fmaxf(st.m, sink2); const float al = __builtin_amdgcn_exp2f(st.m - mf); l = l * al + __builtin_amdgcn_exp2f(sink2 - mf); sc = al / l; }
    else sc = 1.f / l;
    uint2 w;
    w.x = pk2(st.o0[0] * sc, st.o0[1] * sc); w.y = pk2(st.o0[2] * sc, st.o0[3] * sc); *(uint2*)(orow) = w;
    w.x = pk2(st.o1[0] * sc, st.o1[1] * sc); w.y = pk2(st.o1[2] * sc, st.o1[3] * sc); *(uint2*)(orow + 16) = w;
    w.x = pk2(st.o2[0] * sc, st.o2[1] * sc); w.y = pk2(st.o2[2] * sc, st.o2[3] * sc); *(uint2*)(orow + 32) = w;
    w.x = pk2(st.o3[0] * sc, st.o3[1] * sc); w.y = pk2(st.o3[2] * sc, st.o3[3] * sc); *(uint2*)(orow + 48) = w;
}

constexpr int NTASK_NA = NB * 6 * 128 * 4, NTASK_GQ = NB * 2 * 512, NTASK_CNA = NB * 6 * 16, NTASK_CGQ = NB * 2 * 16;
DEV void attn_task(const Params& p, int l, int tk, const float* rpb2  ) {
    const int lane = tid_() & 63, g = lane >> 4, fr = lane & 15;
    const bf16_t* P = (const bf16_t*)(p.ws + OFF_P);
    bf16_t* X1 = (bf16_t*)(p.ws + OFF_X1);
    const f32x4 z4 = {0.f, 0.f, 0.f, 0.f};
    KVFrag f;
    if (tk < NTASK_NA) {
        const int qtile = tk & 3, r = (tk >> 2) & 127, hb = tk >> 9, h = hb % 6, b = hb / 6;
        const int qc = qtile == 0 ? (fr < 8 ? fr : 48 + fr) : 8 + (qtile - 1) * 16 + fr;
        const int ct0 = qtile == 0 ? 0 : qtile - 1, ct1 = qtile == 0 ? 3 : qtile;
        const int R = b * S + r * 64 + qc;
        const bf16_t* qp = P + (size_t)R * PWS + COL_NAQ + h * 64 + g * 8;
        const bf16x8 q0 = ld16(qp), q1 = ld16(qp + 32);
        const int rs = min(max(r - 4, 0), 120), cs = min(max(qc - 8, 0), 48);
        int ci[8]; bool ok[8];
#pragma unroll
        for (int e = 0; e < 8; ++e) { const int kc = ((e >> 2) ? ct1 : ct0) * 16 + g * 4 + (e & 3); ok[e] = (kc >= cs) && (kc < cs + 16); ci[e] = min(max(kc - qc + 15, 0), 30); }
        const bf16_t* kf = (const bf16_t*)(p.ws + OFF_NAKF) + ((size_t)(b * 6 + h) * 512 + rs * 4) * KVT + lane * 8;
        const bf16_t* vf = (const bf16_t*)(p.ws + OFF_NAVF) + ((size_t)(b * 6 + h) * 512 + rs * 4) * KVT + lane * 8;
        AttnState st; attn_init(st);
#pragma unroll
        for (int ri = 0; ri < 8; ++ri) {
            const float* rb = rpb2 + (h * 15 + (rs + ri - r + 7)) * 31;
            f32x4 b0, b1;
#pragma unroll
            for (int j = 0; j < 4; ++j) { b0[j] = ok[j] ? rb[ci[j]] : -INFINITY; b1[j] = ok[4 + j] ? rb[ci[4 + j]] : -INFINITY; }
            kv_load(kf + (size_t)(ri * 4 + ct0) * KVT, kf + (size_t)(ri * 4 + ct1) * KVT, vf + (size_t)(ri * 4 + ct0) * KVT, vf + (size_t)(ri * 4 + ct1) * KVT, f);
            attn_apply(f, q0, q1, b0, b1, st);
        }
        const bf16_t* kc_ = (const bf16_t*)(p.ws + OFF_NAKFC) + (size_t)(b * 6 + h) * 16 * KVT + lane * 8;
        const bf16_t* vc_ = (const bf16_t*)(p.ws + OFF_NAVFC) + (size_t)(b * 6 + h) * 16 * KVT + lane * 8;
#pragma unroll
        for (int pp = 0; pp < 8; ++pp) { kv_load(kc_ + (size_t)(2 * pp) * KVT, kc_ + (size_t)(2 * pp + 1) * KVT, vc_ + (size_t)(2 * pp) * KVT, vc_ + (size_t)(2 * pp + 1) * KVT, f); attn_apply(f, q0, q1, z4, z4, st); }
        attn_store(st, X1 + (size_t)R * D + 256 + h * 64 + g * 4, -INFINITY);
    } else if (tk < NTASK_NA + NTASK_GQ + NTASK_CNA + NTASK_CGQ && (tk < NTASK_NA + NTASK_GQ || tk >= NTASK_NA + NTASK_GQ + NTASK_CNA)) {
        const bool lat = tk < NTASK_NA + NTASK_GQ;
        const int t2 = lat ? tk - NTASK_NA : tk - (NTASK_NA + NTASK_GQ + NTASK_CNA);
        const int qt = lat ? (t2 & 511) : (t2 & 15), hb = lat ? (t2 >> 9) : (t2 >> 4), kvh = hb & 1, b = hb >> 1;
        const int q0i = qt * 16, R = (lat ? b * S : NLAT + b * CTX) + q0i + fr;
        const bf16_t* qp = P + (size_t)R * PWS + COL_GQ + kvh * 192 + g * 8;
        const bf16x8 qa0 = ld16(qp), qa1 = ld16(qp + 32), qb0 = ld16(qp + 64), qb1 = ld16(qp + 96), qc0 = ld16(qp + 128), qc1 = ld16(qp + 160);
        AttnState sa, sb, sc; attn_init(sa); attn_init(sb); attn_init(sc);
        const bf16_t* kf = (const bf16_t*)(p.ws + OFF_GKF) + (size_t)(b * 2 + kvh) * 512 * KVT + lane * 8;
        const bf16_t* vf = (const bf16_t*)(p.ws + OFF_GVF) + (size_t)(b * 2 + kvh) * 512 * KVT + lane * 8;
        const bf16_t* kc_ = (const bf16_t*)(p.ws + OFF_GKFC) + (size_t)(b * 2 + kvh) * 16 * KVT + lane * 8;
        const bf16_t* vc_ = (const bf16_t*)(p.ws + OFF_GVFC) + (size_t)(b * 2 + kvh) * 16 * KVT + lane * 8;
        const int qi = q0i + fr;
#define GQ_LOAD(i, F) do { const int i_ = (i); if (i_ < 9) { const int kt_ = (q0i - 128 + i_ * 32) >> 4; const int ta_ = min(max(kt_, 0), 511), tb_ = min(max(kt_ + 1, 0), 511); \
            kv_load(kf + (size_t)ta_ * KVT, kf + (size_t)tb_ * KVT, vf + (size_t)ta_ * KVT, vf + (size_t)tb_ * KVT, F); } \
        else { const int c_ = (i_ - 9) * 2; kv_load(kc_ + (size_t)c_ * KVT, kc_ + (size_t)(c_ + 1) * KVT, vc_ + (size_t)c_ * KVT, vc_ + (size_t)(c_ + 1) * KVT, F); } } while (0)
#define GQ_APPLY(i, F) do { const int i_ = (i); f32x4 b0_ = z4, b1_ = z4; if (i_ < 9) { const int kb_ = q0i - 128 + i_ * 32; _Pragma("unroll") for (int j = 0; j < 4; ++j) { const int k0_ = kb_ + g * 4 + j, k1_ = k0_ + 16; \
                b0_[j] = (k0_ >= 0 && k0_ < S && k0_ >= qi - 128 && k0_ <= qi + 128) ? 0.f : -INFINITY; b1_[j] = (k1_ >= 0 && k1_ < S && k1_ >= qi - 128 && k1_ <= qi + 128) ? 0.f : -INFINITY; } } \
            attn_apply(F, qa0, qa1, b0_, b1_, sa); attn_apply(F, qb0, qb1, b0_, b1_, sb); attn_apply(F, qc0, qc1, b0_, b1_, sc); } while (0)
        KVFrag f2;
        const int i0 = lat ? 0 : 9;
        GQ_LOAD(i0, f);
#pragma unroll 1
        for (int i = i0; i < 17; i += 2) {
            if (i + 1 < 17) GQ_LOAD(i + 1, f2);
            GQ_APPLY(i, f);
            if (i + 1 < 17) { if (i + 2 < 17) GQ_LOAD(i + 2, f); GQ_APPLY(i + 1, f2); }
        }
#undef GQ_LOAD
#undef GQ_APPLY
        bf16_t* o = X1 + (size_t)R * D + 640 + kvh * 192 + g * 4;
        attn_store(sa, o, p.gqa_sink[l * 6 + kvh * 3 + 0] * LOG2E); attn_store(sb, o + 64, p.gqa_sink[l * 6 + kvh * 3 + 1] * LOG2E); attn_store(sc, o + 128, p.gqa_sink[l * 6 + kvh * 3 + 2] * LOG2E);
    } else {
        const int t3 = tk - NTASK_NA - NTASK_GQ, qt = t3 & 15, hb = t3 >> 4, h = hb % 6, b = hb / 6;
        const int R = NLAT + b * CTX + qt * 16 + fr;
        const bf16_t* qp = P + (size_t)R * PWS + COL_NAQ + h * 64 + g * 8;
        const bf16x8 q0 = ld16(qp), q1 = ld16(qp + 32);
        AttnState st; attn_init(st);
        const bf16_t* kc_ = (const bf16_t*)(p.ws + OFF_NAKFC) + (size_t)(b * 6 + h) * 16 * KVT + lane * 8;
        const bf16_t* vc_ = (const bf16_t*)(p.ws + OFF_NAVFC) + (size_t)(b * 6 + h) * 16 * KVT + lane * 8;
#pragma unroll
        for (int pp = 0; pp < 8; ++pp) { kv_load(kc_ + (size_t)(2 * pp) * KVT, kc_ + (size_t)(2 * pp + 1) * KVT, vc_ + (size_t)(2 * pp) * KVT, vc_ + (size_t)(2 * pp + 1) * KVT, f); attn_apply(f, q0, q1, z4, z4, st); }
        attn_store(st, X1 + (size_t)R * D + 256 + h * 64 + g * 4, -INFINITY);
    }
}
DEV void ph_attn(const Params& p, int l, float* rpb2  ) {
    for (int i = tid_(); i < 6 * 15 * 31; i += 256) rpb2[i] = p.na_rpb[(size_t)l * 6 * 15 * 31 + i] * LOG2E;
    __syncthreads();
    const int w = tid_() >> 6;
    const int ntask = NTASK_NA + NTASK_GQ + (l == 0 ? NTASK_CNA + NTASK_CGQ : 0);
    for (int tk0 = bid_() * 4 + w; tk0 < ntask; tk0 += gridDim.x * 4) {
        const int tk = tk0 < NTASK_GQ ? NTASK_NA + tk0 : (tk0 < NTASK_GQ + NTASK_NA ? tk0 - NTASK_GQ : tk0);
        attn_task(p, l, tk, rpb2);
    }
}

template <int CTRL> DEV float dppf(float old, float v) { return __builtin_bit_cast(float, __builtin_amdgcn_update_dpp(__builtin_bit_cast(int, old), __builtin_bit_cast(int, v), CTRL, 0xf, 0xf, false)); }
template <bool FWD> DEV void row_scan(float& a, float& b) {
#define RG_STEP(SHR, SHL) { const float ap = FWD ? dppf<SHR>(1.f, a) : dppf<SHL>(1.f, a); const float bp = FWD ? dppf<SHR>(0.f, b) : dppf<SHL>(0.f, b); b = fmaf(a, bp, b); a = a * ap; }
    RG_STEP(0x111, 0x101) RG_STEP(0x112, 0x102) RG_STEP(0x114, 0x104) RG_STEP(0x118, 0x108)
#undef RG_STEP
}
DEV int rg_bwd_chunk(int pos) { return pos == 0 ? 1 : (pos == 1 ? 0 : 67 - pos); }
DEV void rg_coef(const f32x4& za, const f32x4& zi, const f32x4& ba, const f32x4& bi, const f32x4& spc, const f32x4& xv, f32x4& a, f32x4& b) {
#pragma unroll
    for (int j = 0; j < 4; ++j) {
        const float r = 1.f / (1.f + __expf(-(za[j] + ba[j])));
        const float ig = 1.f / (1.f + __expf(-(zi[j] + bi[j])));
        const float la = spc[j] * r;
        const float av = __expf(la);
        const float x2 = 2.f * la;
        float om = x2 * (1.f / 720.f) + (1.f / 120.f); om = om * x2 + (1.f / 24.f); om = om * x2 + (1.f / 6.f); om = om * x2 + 0.5f; om = om * x2 + 1.f; om = -x2 * om;
        if (x2 < -0.25f) om = 1.f - av * av;
        a[j] = av; b[j] = sqrtf(om) * (ig * xv[j]);
    }
}
DEV void rg_item(const Params& p, int l, int rt, bf16_t* lds) {
    const int t = tid_(), lane = t & 63, n = t >> 6, g = lane >> 4, fr = lane & 15;
    const bf16_t* P = (const bf16_t*)(p.ws + OFF_P);
    const bool isctx = rt >= 512;
    const int b = isctx ? (rt - 512) >> 1 : rt >> 6, idx = isctx ? (rt - 512) & 1 : 2 + (rt & 63);
    const int L = isctx ? CTX : S, t0 = isctx ? idx * 128 : (idx - 2) * 128, seqbase = isctx ? NLAT + b * CTX : b * S;
    bf16_t* xl = lds + n * (128 * 64);
    {
        const int c = lane & 7, ch0 = n * 64 + c * 8;
        f32x4 cwa[4], cwb[4];
#pragma unroll
        for (int j = 0; j < 4; ++j) { cwa[j] = *(const f32x4*)(p.conv_w + (l * 4 + j) * 256 + ch0); cwb[j] = *(const f32x4*)(p.conv_w + (l * 4 + j) * 256 + ch0 + 4); }
        const f32x4 cba = *(const f32x4*)(p.conv_b + l * 256 + ch0), cbb = *(const f32x4*)(p.conv_b + l * 256 + ch0 + 4);
#pragma unroll 2
        for (int it = 0; it < 16; ++it) {
            const int tok = it * 8 + (lane >> 3), ts = t0 + tok;
            f32x4 acca = cba, accb = cbb;
#pragma unroll
            for (int j = 0; j < 4; ++j) {
                const int tj = ts + j - 2;
                if (tj >= 0 && tj < L) {
                    const uint4 v = *(const uint4*)(P + (size_t)(seqbase + tj) * PWS + COL_RGX + ch0);
                    const f32x4 xa = {__uint_as_float(v.x << 16), __uint_as_float(v.x & 0xffff0000u), __uint_as_float(v.y << 16), __uint_as_float(v.y & 0xffff0000u)};
                    const f32x4 xb = {__uint_as_float(v.z << 16), __uint_as_float(v.z & 0xffff0000u), __uint_as_float(v.w << 16), __uint_as_float(v.w & 0xffff0000u)};
                    acca = acca + cwa[j] * xa; accb = accb + cwb[j] * xb;
                }
            }
            uint4 o; o.x = pk2(acca[0], acca[1]); o.y = pk2(acca[2], acca[3]); o.z = pk2(accb[0], accb[1]); o.w = pk2(accb[2], accb[3]);
            *(uint4*)(xl + tok * 64 + ((c ^ ((tok >> 1) & 7)) * 8)) = o;
        }
    }
    asm volatile("s_waitcnt lgkmcnt(0)" ::: "memory");
    const bf16_t* W = (const bf16_t*)(p.ws + OFF_WRG) + (size_t)(l * 2) * 2 * 4 * 64 * 64;
    const float* C = (const float*)(p.ws + OFF_RGC) + (size_t)(l * 2) * 3 * 256;
    float* AGG = (float*)(p.ws + OFF_AGG) + (size_t)(b * 66) * 1024;
    const int swz = (fr >> 1) & 7;
#pragma unroll 1
    for (int ct = 0; ct < 4; ++ct) {
        const int ch = n * 64 + ct * 16 + g * 4;
        const f32x4 z4 = {0.f, 0.f, 0.f, 0.f};
#pragma unroll
        for (int dir = 0; dir < 2; ++dir) {
            const bf16x8 wa0 = ld16(W + ((size_t)((dir * 2 + 0) * 4 + n) * 64 + ct * 16 + fr) * 64 + g * 8), wa1 = ld16(W + ((size_t)((dir * 2 + 0) * 4 + n) * 64 + ct * 16 + fr) * 64 + 32 + g * 8);
            const bf16x8 wi0 = ld16(W + ((size_t)((dir * 2 + 1) * 4 + n) * 64 + ct * 16 + fr) * 64 + g * 8), wi1 = ld16(W + ((size_t)((dir * 2 + 1) * 4 + n) * 64 + ct * 16 + fr) * 64 + 32 + g * 8);
            const f32x4 ba = *(const f32x4*)(C + (dir * 3 + 0) * 256 + ch), bi = *(const f32x4*)(C + (dir * 3 + 1) * 256 + ch), spc = *(const f32x4*)(C + (dir * 3 + 2) * 256 + ch);
            f32x4 hin = z4, apre = {1.f, 1.f, 1.f, 1.f};
#pragma unroll
            for (int s = 0; s < 8; ++s) {
                const int tt = dir == 0 ? s : 7 - s;
                const int row = tt * 16 + fr;
                const bf16x8 x0 = *(const bf16x8*)(xl + row * 64 + ((g ^ swz) * 8)), x1 = *(const bf16x8*)(xl + row * 64 + (((g | 4) ^ swz) * 8));
                f32x4 za = __builtin_amdgcn_mfma_f32_16x16x32_bf16(wa0, x0, z4, 0, 0, 0); za = __builtin_amdgcn_mfma_f32_16x16x32_bf16(wa1, x1, za, 0, 0, 0);
                f32x4 zi = __builtin_amdgcn_mfma_f32_16x16x32_bf16(wi0, x0, z4, 0, 0, 0); zi = __builtin_amdgcn_mfma_f32_16x16x32_bf16(wi1, x1, zi, 0, 0, 0);
                const uint2 xr = *(const uint2*)(xl + row * 64 + (((ct * 2 + (g >> 1)) ^ swz) * 8) + (g & 1) * 4);
                const f32x4 xv = {__uint_as_float(xr.x << 16), __uint_as_float(xr.x & 0xffff0000u), __uint_as_float(xr.y << 16), __uint_as_float(xr.y & 0xffff0000u)};
                f32x4 a, bb;
                rg_coef(za, zi, ba, bi, spc, xv, a, bb);
                f32x4 h, ac;
#pragma unroll
                for (int j = 0; j < 4; ++j) {
                    float aj = a[j], bj = bb[j];
                    if (dir == 0) row_scan<true>(aj, bj); else row_scan<false>(aj, bj);
                    h[j] = fmaf(aj, hin[j], bj);
                    ac[j] = aj * apre[j];
                }
                {
                    bf16_t* xo = (bf16_t*)(p.ws + OFF_X2) + ((size_t)seqbase + t0 + row) * D + dir * 512 + ch;
                    uint2 o; o.x = pk2(ac[0], ac[1]); o.y = pk2(ac[2], ac[3]); *(uint2*)xo = o;
                    o.x = pk2(h[0], h[1]); o.y = pk2(h[2], h[3]); *(uint2*)(xo + 256) = o;
                }
                const int src = (lane & 48) | (dir == 0 ? 15 : 0);
#pragma unroll
                for (int j = 0; j < 4; ++j) { hin[j] = shl_(h[j], src); apre[j] = shl_(ac[j], src); }
            }
            if (fr == 0) { *(f32x4*)(AGG + (size_t)(idx * 2 + dir) * 512 + ch) = apre; *(f32x4*)(AGG + (size_t)(idx * 2 + dir) * 512 + 256 + ch) = hin; }
        }
    }
}
DEV void rg_final(const Params& p, int l, int rt, float* part  ) {
    const int t = tid_(), cg4 = (t & 63) * 4, tp = t >> 6;
    const bool isctx = rt >= 512;
    const int b = isctx ? (rt - 512) >> 1 : rt >> 6, idx = isctx ? (rt - 512) & 1 : 2 + (rt & 63);
    const float* AGG = (const float*)(p.ws + OFF_AGG) + (size_t)(b * 66) * 1024;
    f32x4 hf = {0.f, 0.f, 0.f, 0.f}, hb = {0.f, 0.f, 0.f, 0.f};
    {
        const int nf = idx, nb = idx == 1 ? 0 : (idx == 0 ? 1 : 67 - idx);
        const int qf = (nf + 3) >> 2, qb = (nb + 3) >> 2;
        f32x4 Af = {1.f, 1.f, 1.f, 1.f}, Bf = {0.f, 0.f, 0.f, 0.f}, Ab = Af, Bb = Bf;
#pragma unroll 4
        for (int q = tp * qf; q < min((tp + 1) * qf, nf); ++q) { const f32x4 A = *(const f32x4*)(AGG + (size_t)(q * 2) * 512 + cg4), B = *(const f32x4*)(AGG + (size_t)(q * 2) * 512 + 256 + cg4); Bf = A * Bf + B; Af = A * Af; }
#pragma unroll 4
        for (int q = tp * qb; q < min((tp + 1) * qb, nb); ++q) { const int cq = rg_bwd_chunk(q); const f32x4 A = *(const f32x4*)(AGG + (size_t)(cq * 2 + 1) * 512 + cg4), B = *(const f32x4*)(AGG + (size_t)(cq * 2 + 1) * 512 + 256 + cg4); Bb = A * Bb + B; Ab = A * Ab; }
        *(f32x4*)(part + ((tp * 2 + 0) * 2 + 0) * 256 + cg4) = Af; *(f32x4*)(part + ((tp * 2 + 0) * 2 + 1) * 256 + cg4) = Bf;
        *(f32x4*)(part + ((tp * 2 + 1) * 2 + 0) * 256 + cg4) = Ab; *(f32x4*)(part + ((tp * 2 + 1) * 2 + 1) * 256 + cg4) = Bb;
        __syncthreads();
#pragma unroll
        for (int k = 0; k < 4; ++k) {
            hf = *(const f32x4*)(part + ((k * 2 + 0) * 2 + 0) * 256 + cg4) * hf + *(const f32x4*)(part + ((k * 2 + 0) * 2 + 1) * 256 + cg4);
            hb = *(const f32x4*)(part + ((k * 2 + 1) * 2 + 0) * 256 + cg4) * hb + *(const f32x4*)(part + ((k * 2 + 1) * 2 + 1) * 256 + cg4);
        }
    }
    const bf16_t* X2 = (const bf16_t*)(p.ws + OFF_X2); const bf16_t* P = (const bf16_t*)(p.ws + OFF_P); bf16_t* X1 = (bf16_t*)(p.ws + OFF_X1);
#pragma unroll 4
    for (int i = 0; i < 32; ++i) {
        const size_t R = (size_t)rt * 128 + i * 4 + tp;
        const uint2 af = *(const uint2*)(X2 + R * D + cg4), bf = *(const uint2*)(X2 + R * D + 256 + cg4), ab = *(const uint2*)(X2 + R * D + 512 + cg4), bb = *(const uint2*)(X2 + R * D + 768 + cg4);
        const uint2 gr = *(const uint2*)(P + R * PWS + COL_GATE + cg4);
#define BLO(u) __uint_as_float((u) << 16)
#define BHI(u) __uint_as_float((u) & 0xffff0000u)
        const float h0 = (BLO(af.x) * hf[0] + BLO(bf.x)) + (BLO(ab.x) * hb[0] + BLO(bb.x));
        const float h1 = (BHI(af.x) * hf[1] + BHI(bf.x)) + (BHI(ab.x) * hb[1] + BHI(bb.x));
        const float h2 = (BLO(af.y) * hf[2] + BLO(bf.y)) + (BLO(ab.y) * hb[2] + BLO(bb.y));
        const float h3 = (BHI(af.y) * hf[3] + BHI(bf.y)) + (BHI(ab.y) * hb[3] + BHI(bb.y));
        uint2 o; o.x = pk2(h0 * gelu_tanh(BLO(gr.x)), h1 * gelu_tanh(BHI(gr.x))); o.y = pk2(h2 * gelu_tanh(BLO(gr.y)), h3 * gelu_tanh(BHI(gr.y)));
#undef BLO
#undef BHI
        *(uint2*)(X1 + R * D + cg4) = o;
    }
}
DEV void ph_rgagg(const Params& p, int l, bf16_t* lds) {
    for (int rt = bid_(); rt < 528; rt += gridDim.x) { rg_item(p, l, rt, lds); __syncthreads(); }
}

DEV void outproj_item(const Params& p_, int l, int rt, bf16_t* lds, float* stat  ) {
    const Params& p = kp_();
    const int t = tid_(), lane = t & 63, w = t >> 6, wm = w >> 1, wn = w & 1, fq = lane >> 4, fr = lane & 15;
    const bf16_t* A = (const bf16_t*)(p.ws + OFF_X1) + (size_t)(rt * 128) * D;
    const bool isctx = rt >= 512;
    const float* g1 = modvec(p, l, rt * 128, 2);
    __syncthreads();
    rg_final(p, l, rt, (float*)lds);
    asm volatile("s_waitcnt vmcnt(0)" ::: "memory");
    __syncthreads();
    __builtin_amdgcn_fence(__ATOMIC_ACQUIRE, "agent");
#pragma unroll 1
    for (int pass = 0; pass < 4; ++pass) {
        const bf16_t* Bt = (const bf16_t*)(p.ws + OFF_WOUTT) + ((size_t)l * 1024 + pass * 256) * 1024;
        const unsigned toff = (unsigned)(((tid_() >> 2) * 1024 + gemm_src_chunk(tid_())) * 2);
        f32x4 acc[4][8]; zero_acc(acc);
        gemm_mainloop(A, toff, toff + 64 * D * 2, Bt, toff, 1024, 32, lds, acc);
#pragma unroll
        for (int mt = 0; mt < 4; ++mt) {
            const int rl = wm * 64 + mt * 16 + fr, R = rt * 128 + rl;
            const float* xin = (l == 0) ? (isctx ? p.ctx + (size_t)(R - NLAT) * D : p.x + (size_t)R * D) : xres_row(p, R);
            float* xo = xres_row(p, R);
            float s = 0.f, q = 0.f;
#pragma unroll
            for (int nt = 0; nt < 8; ++nt) {
                const int col = pass * 256 + wn * 128 + nt * 16 + fq * 4;
                const f32x4 xv = *(const f32x4*)(xin + col), gv = *(const f32x4*)(g1 + col);
                const f32x4 u = xv * ALPHA + gv * acc[mt][nt];
                *(f32x4*)(xo + col) = u;
                s += (u[0] + u[1]) + (u[2] + u[3]); q += (u[0] * u[0] + u[1] * u[1]) + (u[2] * u[2] + u[3] * u[3]);
            }
            s += shx(s, 16); s += shx(s, 32); q += shx(q, 16); q += shx(q, 32);
            if (fq == 0) { float* sp = stat + (wn * 128 + rl) * 2; if (pass == 0) { sp[0] = s; sp[1] = q; } else { sp[0] += s; sp[1] += q; } }
        }
    }
    asm volatile("s_waitcnt vmcnt(0)" ::: "memory");
    __syncthreads();
    __builtin_amdgcn_fence(__ATOMIC_ACQUIRE, "agent");
    {
        bf16_t* X2 = (bf16_t*)(p.ws + OFF_X2);
        const bf16_t* WRh = (const bf16_t*)(p.ws + OFF_WR) + (size_t)(l * 2) * 48 * 1024 + (size_t)fr * 1024 + fq * 8;
        const bf16_t* WRl = WRh + 48 * 1024;
        float* vec = (float*)((unsigned char*)lds + 24576);
        {
            const float* lg = p.ln1_g + l * D; const float* lb = p.ln1_b + l * D;
            const float* sh2 = modvec(p, l, rt * 128, 3); const float* sc2 = modvec(p, l, rt * 128, 4);
            const int k4 = t * 4;
            *(f32x4*)(vec + k4) = *(const f32x4*)(lg + k4); *(f32x4*)(vec + 1024 + k4) = *(const f32x4*)(lb + k4);
            *(f32x4*)(vec + 2048 + k4) = *(const f32x4*)(sc2 + k4) + 1.f; *(f32x4*)(vec + 3072 + k4) = *(const f32x4*)(sh2 + k4);
        }
        float mean[2], rstd[2];
#pragma unroll
        for (int tm = 0; tm < 2; ++tm) {
            const int rl = w * 32 + tm * 16 + fr;
            float s = 0.f, q = 0.f;
#pragma unroll
            for (int i = 0; i < 2; ++i) { s += stat[(i * 128 + rl) * 2]; q += stat[(i * 128 + rl) * 2 + 1]; }
            mean[tm] = s * (1.f / D);
            rstd[tm] = rsqrtf(fmaxf(q * (1.f / D) - mean[tm] * mean[tm], 0.f) + LN_EPS);
        }
        __syncthreads();
        float* xr0 = xres_row(p, rt * 128 + w * 32 + fr) + fq * 8;
        float* xr1 = xres_row(p, rt * 128 + w * 32 + 16 + fr) + fq * 8;
        bf16_t* h20 = X2 + (size_t)(rt * 128 + w * 32 + fr) * D + fq * 8; bf16_t* h21 = h20 + (size_t)16 * D;
        f32x4 lacc[3][2];
#pragma unroll
        for (int a = 0; a < 3; ++a) { lacc[a][0] = (f32x4){0.f, 0.f, 0.f, 0.f}; lacc[a][1] = (f32x4){0.f, 0.f, 0.f, 0.f}; }
        f32x4 nu00 = *(const f32x4*)xr0, nu01 = *(const f32x4*)(xr0 + 4), nu10 = *(const f32x4*)xr1, nu11 = *(const f32x4*)(xr1 + 4);
        bf16x8 nwh0 = *(const bf16x8*)(WRh), nwh1 = *(const bf16x8*)(WRh + 16 * 1024), nwh2 = *(const bf16x8*)(WRh + 32 * 1024);
        bf16x8 nwl0 = *(const bf16x8*)(WRl), nwl1 = *(const bf16x8*)(WRl + 16 * 1024), nwl2 = *(const bf16x8*)(WRl + 32 * 1024);
#pragma unroll 2
        for (int ks = 0; ks < 32; ++ks) {
            const f32x4 u00 = nu00, u01 = nu01, u10 = nu10, u11 = nu11;
            const bf16x8 wh0 = nwh0, wh1 = nwh1, wh2 = nwh2, wl0 = nwl0, wl1 = nwl1, wl2 = nwl2;
            if (ks + 1 < 32) {
                const int ko = (ks + 1) * 32;
                nu00 = *(const f32x4*)(xr0 + ko); nu01 = *(const f32x4*)(xr0 + ko + 4); nu10 = *(const f32x4*)(xr1 + ko); nu11 = *(const f32x4*)(xr1 + ko + 4);
                nwh0 = *(const bf16x8*)(WRh + ko); nwh1 = *(const bf16x8*)(WRh + 16 * 1024 + ko); nwh2 = *(const bf16x8*)(WRh + 32 * 1024 + ko);
                nwl0 = *(const bf16x8*)(WRl + ko); nwl1 = *(const bf16x8*)(WRl + 16 * 1024 + ko); nwl2 = *(const bf16x8*)(WRl + 32 * 1024 + ko);
            }
            const int k = ks * 32 + fq * 8;
            const f32x4 g0 = *(const f32x4*)(vec + k), g1v = *(const f32x4*)(vec + k + 4), b0 = *(const f32x4*)(vec + 1024 + k), b1 = *(const f32x4*)(vec + 1024 + k + 4);
            const f32x4 c0 = *(const f32x4*)(vec + 2048 + k), c1 = *(const f32x4*)(vec + 2048 + k + 4), s0 = *(const f32x4*)(vec + 3072 + k), s1 = *(const f32x4*)(vec + 3072 + k + 4);
            bf16x8 hh0, hl0, hh1, hl1;
            {
                const f32x4 x0 = (u00 - mean[0]) * rstd[0] * g0 + b0, x1 = (u01 - mean[0]) * rstd[0] * g1v + b1;
                *(f32x4*)(xr0 + ks * 32) = x0; *(f32x4*)(xr0 + ks * 32 + 4) = x1;
                const f32x4 h0 = x0 * c0 + s0, h1 = x1 * c1 + s1;
#pragma unroll
                for (int e = 0; e < 4; ++e) { const bf16_t a = f2bf(h0[e]), b = f2bf(h1[e]); hh0[e] = (short)a; hh0[4 + e] = (short)b; hl0[e] = (short)f2bf(h0[e] - bf2f(a)); hl0[4 + e] = (short)f2bf(h1[e] - bf2f(b)); }
                *(bf16x8*)(h20 + ks * 32) = hh0;
            }
            {
                const f32x4 x0 = (u10 - mean[1]) * rstd[1] * g0 + b0, x1 = (u11 - mean[1]) * rstd[1] * g1v + b1;
                *(f32x4*)(xr1 + ks * 32) = x0; *(f32x4*)(xr1 + ks * 32 + 4) = x1;
                const f32x4 h0 = x0 * c0 + s0, h1 = x1 * c1 + s1;
#pragma unroll
                for (int e = 0; e < 4; ++e) { const bf16_t a = f2bf(h0[e]), b = f2bf(h1[e]); hh1[e] = (short)a; hh1[4 + e] = (short)b; hl1[e] = (short)f2bf(h0[e] - bf2f(a)); hl1[4 + e] = (short)f2bf(h1[e] - bf2f(b)); }
                *(bf16x8*)(h21 + ks * 32) = hh1;
            }
#define RT_MMA(ft, WH, WL) do { \
            lacc[ft][0] = __builtin_amdgcn_mfma_f32_16x16x32_bf16(WH, hh0, lacc[ft][0], 0, 0, 0); lacc[ft][0] = __builtin_amdgcn_mfma_f32_16x16x32_bf16(WL, hh0, lacc[ft][0], 0, 0, 0); lacc[ft][0] = __builtin_amdgcn_mfma_f32_16x16x32_bf16(WH, hl0, lacc[ft][0], 0, 0, 0); \
            lacc[ft][1] = __builtin_amdgcn_mfma_f32_16x16x32_bf16(WH, hh1, lacc[ft][1], 0, 0, 0); lacc[ft][1] = __builtin_amdgcn_mfma_f32_16x16x32_bf16(WL, hh1, lacc[ft][1], 0, 0, 0); lacc[ft][1] = __builtin_amdgcn_mfma_f32_16x16x32_bf16(WH, hl1, lacc[ft][1], 0, 0, 0); } while (0)
            RT_MMA(0, wh0, wl0); RT_MMA(1, wh1, wl1); RT_MMA(2, wh2, wl2);
#undef RT_MMA
        }
        __syncthreads();
        float* lt = (float*)lds;
        int* lcnt = (int*)((unsigned char*)lds + 24576); int* lbase = lcnt + 32;
        if (t < 32) lcnt[t] = 0;
#pragma unroll
        for (int ft = 0; ft < 3; ++ft)
#pragma unroll
            for (int tm = 0; tm < 2; ++tm)
#pragma unroll
                for (int j = 0; j < 4; ++j) lt[(w * 32 + tm * 16 + fr) * 48 + ft * 16 + fq * 4 + j] = lacc[ft][tm][j];
        __syncthreads();
        int E0 = 0, E1 = 0, r0 = 0, r1 = 0; float w0 = 0.f, w1 = 0.f;
        const int rl = w * 32 + (lane & 31), R = rt * 128 + rl;
        if (lane < 32) {
            const float* lr = lt + rl * 48;
            int gi = 0; float gm = lr[0] + p.router_g_b[l * 4];
            float gl[4]; gl[0] = gm;
#pragma unroll
            for (int j = 1; j < 4; ++j) { gl[j] = lr[j] + p.router_g_b[l * 4 + j]; if (gl[j] > gm) { gm = gl[j]; gi = j; } }
            float gs = 0.f;
#pragma unroll
            for (int j = 0; j < 4; ++j) gs += expf(gl[j] - gm);
            const float ptop = 1.f / gs;
            int e0 = 0, e1 = 0; float m0 = -INFINITY, m1 = -INFINITY;
            for (int j = 0; j < 8; ++j) {
                const float v = lr[4 + gi * 8 + j] + p.router_e_b[l * 32 + gi * 8 + j];
                if (v > m0) { m1 = m0; e1 = e0; m0 = v; e0 = j; } else if (v > m1) { m1 = v; e1 = j; }
            }
            const float ex = expf(m1 - m0);
            w0 = ptop / (1.f + ex); w1 = ptop * ex / (1.f + ex);
            E0 = gi * 8 + e0; E1 = gi * 8 + e1;
            r0 = atomicAdd(lcnt + E0, 1); r1 = atomicAdd(lcnt + E1, 1);
        }
        __syncthreads();
        if (t < 32) { const int c = lcnt[t]; lbase[t] = c ? (int)atomicAdd((unsigned*)(p.ws + OFF_CTL) + CW_CNT + l * 32 + t, (unsigned)c) : 0; }
        __syncthreads();
        if (lane < 32) {
            int* rte = (int*)(p.ws + OFF_RTE); float* rtw = (float*)(p.ws + OFF_RTW);
            int* list = (int*)(p.ws + OFF_LIST);
            rte[R * 2] = E0; rte[R * 2 + 1] = E1; rtw[R * 2] = w0; rtw[R * 2 + 1] = w1;
            list[(size_t)E0 * LISTCAP + lbase[E0] + r0] = R * 2;
            list[(size_t)E1 * LISTCAP + lbase[E1] + r1] = R * 2 + 1;
        }
    }
}
DEV void ph_outproj(const Params& p, int l, bf16_t* lds, float* stat  ) {
    for (int rt = bid_(); rt < 512; rt += gridDim.x) { outproj_item(p, l, rt, lds, stat); __syncthreads(); }
}

DEV void moe1_item(const Params& p_, int l, int e, int jb, int pass, int item, int cnt, bf16_t* lds) {
    const Params& p = kp_();
    const int t = tid_(), lane = t & 63, w = t >> 6, wm = w >> 1, wn = w & 1, fq = lane >> 4, fr = lane & 15;
    const int* list = (const int*)(p.ws + OFF_LIST) + (size_t)e * LISTCAP;
    const bf16_t* X2 = (const bf16_t*)(p.ws + OFF_X2);
    bf16_t* Hs = (bf16_t*)(p.ws + OFF_P) + (size_t)item * 128 * FF;
    unsigned ao0, ao1;
    { const int s0 = jb * 128 + (t >> 2), s1 = s0 + 64;
      const int tok0 = s0 < cnt ? (list[s0] >> 1) : 0, tok1 = s1 < cnt ? (list[s1] >> 1) : 0;
      ao0 = (unsigned)((tok0 * D + gemm_src_chunk(t)) * 2); ao1 = (unsigned)((tok1 * D + gemm_src_chunk(t)) * 2); }
    const bf16_t* Bt = (const bf16_t*)(p.ws + OFF_WGU) + ((size_t)e * 1024 + pass * 256) * 1024;
    f32x4 acc[4][8]; zero_acc(acc);
    gemm_mainloop(X2, ao0, ao1, Bt, (unsigned)(((t >> 2) * 1024 + gemm_src_chunk(t)) * 2), 1024, 32, lds, acc);
#pragma unroll
    for (int mt = 0; mt < 4; ++mt) {
        const int rl = wm * 64 + mt * 16 + fr;
#pragma unroll
        for (int nt = 0; nt < 4; ++nt) {
            const f32x4 gv = acc[mt][nt], uv = acc[mt][nt + 4];
            float hv[4];
#pragma unroll
            for (int jj = 0; jj < 4; ++jj) hv[jj] = gv[jj] / (1.f + __expf(-gv[jj])) * uv[jj];
            uint2 o; o.x = pk2(hv[0], hv[1]); o.y = pk2(hv[2], hv[3]);
            *(uint2*)(Hs + (size_t)rl * FF + pass * 128 + wn * 64 + nt * 16 + fq * 4) = o;
        }
    }
}
DEV void moe2_item(const Params& p_, int l, int e, int jb, int pass, int item, int cnt, bf16_t* lds) {
    const Params& p = kp_();
    const int t = tid_(), lane = t & 63, w = t >> 6, wm = w >> 1, wn = w & 1, fq = lane >> 4, fr = lane & 15;
    const int* list = (const int*)(p.ws + OFF_LIST) + (size_t)e * LISTCAP;
    const bf16_t* Hs = (const bf16_t*)(p.ws + OFF_P) + (size_t)item * 128 * FF;
    const unsigned hoff = (unsigned)(((t >> 2) * FF + gemm_src_chunk(t)) * 2);
    const float* rtw = (const float*)(p.ws + OFF_RTW);
    bf16_t* Y = (bf16_t*)(p.ws + OFF_Y);
    const bf16_t* Bt = (const bf16_t*)(p.ws + OFF_WD) + ((size_t)e * 1024 + pass * 256) * FF;
    f32x4 acc[4][8]; zero_acc(acc);
    gemm_mainloop(Hs, hoff, hoff + 64 * FF * 2, Bt, hoff, FF, 16, lds, acc);
#pragma unroll
    for (int mt = 0; mt < 4; ++mt) {
        const int s = jb * 128 + wm * 64 + mt * 16 + fr;
        if (s < cnt) {
            const int ent = list[s];
            const float gw = rtw[ent];
            bf16_t* yo = Y + (size_t)ent * D + pass * 256 + wn * 128 + fq * 4;
#pragma unroll
            for (int nt = 0; nt < 8; ++nt) { const f32x4 v = acc[mt][nt] * gw; uint2 o; o.x = pk2(v[0], v[1]); o.y = pk2(v[2], v[3]); *(uint2*)(yo + nt * 16) = o; }
        }
    }
}
template <int STAGE> DEV void ph_moe(const Params& p, int l, bf16_t* lds, int* s_pref  , int* s_cnt  ) {
    const unsigned* cnt = (const unsigned*)(p.ws + OFF_CTL) + CW_CNT + l * 32;
    if (tid_() == 0) { int a = 0; for (int e = 0; e < 32; ++e) { const int c = (int)cnt[e]; s_cnt[e] = c; s_pref[e] = a; a += (c + 127) >> 7; } s_pref[32] = a; }
    __syncthreads();
    const int nx = gridDim.x >> 3, xcd = bid_() & 7, j = bid_() >> 3;
    if (bid_() < nx * 8) {
        const int n0 = (s_cnt[xcd] + 127) >> 7, n1 = (s_cnt[xcd + 8] + 127) >> 7, n2 = (s_cnt[xcd + 16] + 127) >> 7, n3 = (s_cnt[xcd + 24] + 127) >> 7;
        const int nloc = (n0 + n1 + n2 + n3) * 4;
        for (int i = j; i < nloc; i += nx) {
            const int pass = i & 3, ib = i >> 2;
            int e, jb;
            if (ib < n0) { e = xcd; jb = ib; } else if (ib < n0 + n1) { e = xcd + 8; jb = ib - n0; } else if (ib < n0 + n1 + n2) { e = xcd + 16; jb = ib - n0 - n1; } else { e = xcd + 24; jb = ib - n0 - n1 - n2; }
            if (STAGE == 1) moe1_item(p, l, e, jb, pass, s_pref[e] + jb, s_cnt[e], lds); else moe2_item(p, l, e, jb, pass, s_pref[e] + jb, s_cnt[e], lds);
        }
    }
    __syncthreads();
}

DEV void ph_rowin(const Params& p, int l, bf16_t* lds, int* slot, int ph) {
    const int np = l == 0 ? 9 : 5, nci = 16 * np, ntot = nci + 1024;
    unsigned* ctr = (unsigned*)(p.ws + OFF_CTL) + CW_Q + ph * 8;
    const int w = tid_() >> 6;
    for (;;) {
        const int it = q_pull(ctr, slot);
        if (it >= ntot) break;
        if (it < nci) {
            const int rt = 512 + it / np, pass = it % np;
            for (int r = w; r < 128; r += 4) { if (l == 0) rowop<0, true>(p, 0, rt * 128 + r); else rowop<1, false>(p, 1, rt * 128 + r); }
            asm volatile("s_waitcnt vmcnt(0)" ::: "memory");
            __syncthreads();
            __builtin_amdgcn_fence(__ATOMIC_ACQUIRE, "agent");
            inproj_item(p, l, rt, pass, lds);
        } else {
            const int r0 = (it - nci) * 64;
            for (int r = w; r < 64; r += 4) { if (l == 0) rowop<0, true>(p, 0, r0 + r); else rowop<1, true>(p, 1, r0 + r); }
        }
    }
}
DEV void ph_inproj2(const Params& p, int l, bf16_t* lds, int* slot, int ph) {
    const int xcd = bid_() & 7;
    unsigned* ctr = (unsigned*)(p.ws + OFF_CTL) + CW_Q + ph * 8 + xcd;
    const int ntot = 2 + 576 + (l == 0 ? 32 : 0);
    for (;;) {
        const int it = q_pull(ctr, slot);
        if (it >= ntot) break;
        if (it < 2) { rg_item(p, l, 512 + 2 * xcd + it, lds); }
        else if (it < 578) { const int i = it - 2; inproj_item(p, l, xcd * 64 + i / 9, i % 9, lds); }
        else { const int i = it - 578, w = tid_() >> 6;
            const int tk = i < 24 ? NTASK_NA + NTASK_GQ + (xcd * 24 + i) * 4 + w : NTASK_NA + NTASK_GQ + NTASK_CNA + (xcd * 8 + (i - 24)) * 4 + w;
            attn_task(p, l, tk, (const float*)lds); }
    }
}
DEV void ph_mixer(const Params& p, int l, bf16_t* lds, float* stat, int* slot, int ph) {
    const int xcd = bid_() & 7;
    unsigned* ctr = (unsigned*)(p.ws + OFF_CTL) + CW_Q + ph * 8 + xcd;
    const int n0 = l == 0 ? 2 : 0, n1 = n0 + 64, n2 = n1 + 256, n3 = n2 + 768, ntot = n3 + 192;
    bool rpb_ok = false;
    float* rpb2 = (float*)lds;
    for (;;) {
        const int it = q_pull(ctr, slot);
        if (it >= ntot) break;
        if (it < n0) { outproj_item(p, l, 512 + 2 * xcd + it, lds, stat); rpb_ok = false; }
        else if (it < n1) { rg_item(p, l, xcd * 64 + (it - n0), lds); rpb_ok = false; }
        else if (it < n3) {
            if (!rpb_ok) { for (int i = tid_(); i < 6 * 15 * 31; i += 256) rpb2[i] = p.na_rpb[(size_t)l * 6 * 15 * 31 + i] * LOG2E; __syncthreads(); rpb_ok = true; }
            const int w = tid_() >> 6;
            int tk;
            if (it < n2) { const int i = it - n1; tk = NTASK_NA + (2 * xcd + (i >> 7)) * 512 + (i & 127) * 4 + w; }
            else { const int i = it - n2; tk = (6 * xcd + (i >> 7)) * 512 + (i & 127) * 4 + w; }
            attn_task(p, l, tk, rpb2);
        } else {
            rpb_ok = false;
            const int gi = xcd * 192 + (it - n3);
#pragma unroll 1
            for (int k = 0; k < 8; ++k) {
                const int T = gi * 8 + k, kind = T >> 12, Tl = T & 4095, e = Tl >> 7, tile = Tl & 127;
                if (kind == 0) transpose_tile(p.exp_w_gate + ((size_t)l * NE + e) * 1024 * 512, (bf16_t*)(p.ws + OFF_WGU) + (size_t)e * 1024 * 1024, 1024, 512, 1, tile, (float*)lds);
                else if (kind == 1) transpose_tile(p.exp_w_up + ((size_t)l * NE + e) * 1024 * 512, (bf16_t*)(p.ws + OFF_WGU) + (size_t)e * 1024 * 1024, 1024, 512, 2, tile, (float*)lds);
                else transpose_tile(p.exp_w_down + ((size_t)l * NE + e) * 512 * 1024, (bf16_t*)(p.ws + OFF_WD) + (size_t)e * 1024 * 512, 512, 1024, 0, tile, (float*)lds);
            }
        }
    }
}

#define XB_TMO      128
#define XB_XCNT(j)  (256  + 64 * (j))
#define XB_XSUB(j)  (1280 + 64 * (j))
#define XB_XGEN(j)  (2304 + 64 * (j))
#define XB_TOP      3328
#define XB_TOPGEN   3392
#define XCD_BAR_WORDS 3456
#define XB_SPIN_CAP (1u << 20)
DEV unsigned xb_ld(unsigned* p) { return __hip_atomic_load(p, __ATOMIC_RELAXED, __HIP_MEMORY_SCOPE_AGENT); }
DEV unsigned xb_add(unsigned* p, unsigned v) { return __hip_atomic_fetch_add(p, v, __ATOMIC_RELAXED, __HIP_MEMORY_SCOPE_AGENT); }
DEV unsigned xb_xcc_id() { return (unsigned)__builtin_amdgcn_s_getreg((3 << 11) | 20) & 0xFu; }
#define XB_SPIN(cond, bar) do { unsigned _sp = 0; while (cond) { __builtin_amdgcn_s_sleep(1); \
    if ((++_sp & 255u) == 0u) { if (xb_ld(&(bar)[XB_TMO])) break; if (_sp > XB_SPIN_CAP) { atomicAdd(&(bar)[XB_TMO], 1u); break; } } } } while (0)
struct XcdBarrier { unsigned* bar; unsigned x; volatile LAS unsigned* st; };
DEV XcdBarrier xcd_barrier_post(unsigned* bar, volatile LAS unsigned* st) {
    XcdBarrier b; b.bar = bar; b.x = xb_xcc_id(); b.st = st;
    if (tid_() == 0) (void)xb_add(&bar[XB_XCNT(b.x)], 1u);
    return b;
}
DEV void xcd_barrier_complete(unsigned* bar, unsigned x, unsigned& nloc, unsigned& nx) {
    const unsigned G = gridDim.x * gridDim.y * gridDim.z;
    unsigned sum, cnt, mine, sp = 0u;
    for (;;) {
        sum = 0u; cnt = 0u; mine = 0u;
#pragma unroll
        for (unsigned j = 0; j < 16; ++j) { const unsigned c = xb_ld(&bar[XB_XCNT(j)]); sum += c; cnt += (c > 0u) ? 1u : 0u; mine = (j == x) ? c : mine; }
        if (sum == G) break;
        __builtin_amdgcn_s_sleep(1);
        if ((++sp & 255u) == 0u) { if (xb_ld(&bar[XB_TMO])) break; if (sp > XB_SPIN_CAP) { atomicAdd(&bar[XB_TMO], 1u); break; } }
    }
    nloc = mine > 0u ? mine : 1u; nx = cnt > 0u ? cnt : 1u;
}
DEV void xcd_barrier(const XcdBarrier& b) {
    asm volatile("s_waitcnt vmcnt(0)" ::: "memory");
    __syncthreads();
    if (tid_() == 0) {
        unsigned* bar = b.bar;
        __builtin_amdgcn_s_waitcnt(0);
        unsigned nloc = b.st[0], nx = b.st[1];
        if (nloc == 0u) { xcd_barrier_complete(bar, b.x, nloc, nx); b.st[0] = nloc; b.st[1] = nx; }
        const unsigned old = xb_add(&bar[XB_XSUB(b.x)], 1u);
        const unsigned gen = old / nloc;
        if (old + 1u == (gen + 1u) * nloc) {
            __builtin_amdgcn_fence(__ATOMIC_RELEASE, "agent");
            asm volatile("s_waitcnt vmcnt(0)" ::: "memory");
            const unsigned og = xb_add(&bar[XB_TOP], 1u);
            const unsigned tg = og / nx;
            if (og + 1u == (tg + 1u) * nx) xb_add(&bar[XB_TOPGEN], 1u);
            else XB_SPIN(xb_ld(&bar[XB_TOPGEN]) == tg, bar);
            __builtin_amdgcn_fence(__ATOMIC_ACQUIRE, "agent");
            xb_add(&bar[XB_XGEN(b.x)], 1u);
            asm volatile("s_waitcnt vmcnt(0)" ::: "memory");
        } else {
            XB_SPIN(xb_ld(&bar[XB_XGEN(b.x)]) == gen, bar);
            __builtin_amdgcn_fence(__ATOMIC_ACQUIRE, "agent");
            asm volatile("s_waitcnt vmcnt(0)" ::: "memory");
        }
    }
    __syncthreads();
}

namespace cg = cooperative_groups;
#define REP(id) for (int rep_ = 0; rep_ < ((PROBE_ID) == (id) ? PROBE_N : 1); ++rep_)
constexpr int SMEM_STAT = GEMM_LDS_BYTES;
constexpr int SMEM_BYTES = GEMM_LDS_BYTES + 2048 + 512;
constexpr int NPHASE = 14;
__global__ void __launch_bounds__(256, 2) mega(Params p, int ph_lo, int ph_hi) {
    extern __shared__ __attribute__((aligned(16))) unsigned char smem[];
    bf16_t* lds = (bf16_t*)smem;
    float* stat = (float*)(smem + SMEM_STAT);
    int* s_pref = (int*)(smem + SMEM_STAT + 2048); int* s_cnt = s_pref + 40;
    int* qslot = (int*)(smem + SMEM_STAT + 2048 + 416);
    volatile LAS unsigned* bst = (volatile LAS unsigned*)(LAS unsigned char*)(smem + SMEM_STAT + 2048 + 400);
    if (tid_() < 2) bst[tid_()] = 0u;
    __syncthreads();
    (void)xcd_barrier_post((unsigned*)(kp_().ws + OFF_CTL + 4096), bst);
#define GRID_BAR() do { XcdBarrier xb_; xb_.bar = (unsigned*)(kp_().ws + OFF_CTL + 4096); xb_.x = xb_xcc_id(); \
        xb_.st = (volatile LAS unsigned*)(LAS unsigned char*)(smem + SMEM_STAT + 2048 + 400); xcd_barrier(xb_); } while (0)
#define IN(k) (ph_lo <= (k) && (k) < ph_hi)
#define STAMP(k) do { if ((PROBE_TS) >= 0 && bid_() == 0 && tid_() == 0) ((unsigned long long*)(kp_().ws + OFF_CTL + 2048))[k] = __builtin_amdgcn_s_memrealtime(); } while (0)
#define SEAM(k) do { if (IN(k) && IN((k) + 1)) { if ((k) == 0) cg::this_grid().sync(); else GRID_BAR(); } STAMP((k) + 1); } while (0)
    STAMP(0);
    if (IN(0)) {
        REP(0) { ph_mod(kp_(), (float*)smem); __syncthreads(); }
        ph_rope(kp_());
        ph_routerw(kp_());
        ph_rgprep(kp_());
        REP(1) ph_transpose(kp_().w_in, (bf16_t*)(kp_().ws + OFF_WINT), 1024, 2304, 0, 2, (size_t)1024 * 2304, (size_t)2304 * 1024, (float*)smem);
        ph_transpose(kp_().w_out, (bf16_t*)(kp_().ws + OFF_WOUTT), 1024, 1024, 0, 2, (size_t)1024 * 1024, (size_t)1024 * 1024, (float*)smem);
    }
    SEAM(0);
#define LAYER_BODY(l, pb) { \
        if (IN(pb + 0)) ph_rowin(kp_(), l, lds, qslot, pb + 0); \
        SEAM(pb + 0); \
        if (IN(pb + 1)) ph_inproj2(kp_(), l, lds, qslot, pb + 1); \
        SEAM(pb + 1); \
        if (IN(pb + 2)) ph_mixer(kp_(), l, lds, stat, qslot, pb + 2); \
        SEAM(pb + 2); \
        if (IN(pb + 3)) ph_outproj(kp_(), l, lds, stat); \
        SEAM(pb + 3); \
        if (IN(pb + 4)) { REP(7) { ph_moe<1>(kp_(), l, lds, s_pref, s_cnt); } } \
        SEAM(pb + 4); \
        if (IN(pb + 5)) { REP(8) { ph_moe<2>(kp_(), l, lds, s_pref, s_cnt); } } \
        SEAM(pb + 5); \
    }
    LAYER_BODY(0, 1)
    LAYER_BODY(1, 7)
#undef LAYER_BODY
    if (IN(NPHASE - 1)) ph_rowop<2>(kp_(), 2, NLAT);
    if ((PROBE_TS) >= 0 && bid_() == 0) {
        __syncthreads();
        if (tid_() == 0) {
            unsigned long long* ts = (unsigned long long*)(kp_().ws + OFF_CTL + 2048);
            const unsigned long long now = __builtin_amdgcn_s_memrealtime();
            if ((PROBE_TS) == NPHASE - 1) ts[NPHASE] = now;
            const unsigned long long dt = ts[(PROBE_TS) + 1] - ts[(PROBE_TS)];
            while (__builtin_amdgcn_s_memrealtime() - now < 4ull * dt) __builtin_amdgcn_s_sleep(8);
        }
    }
#undef IN
#undef SEAM
}

#ifndef ONE_LAUNCH
#define ONE_LAUNCH 1
#endif
extern "C" void kernel_launch(void* const* d_in, const int* in_sizes, int n_in, void* d_out, int out_size, void* d_ws, size_t ws_size, hipStream_t stream) {
    if (n_in != 28 || ws_size < WS_TOTAL || out_size != NLAT * D) { fprintf(stderr, "kernel_launch: unexpected shapes / workspace (%d inputs, ws %zu need %zu)\n", n_in, ws_size, (size_t)WS_TOTAL); return; }
    static int grid = 0;
    if (grid == 0) {
        int dev = 0, cus = 0, per_cu = 0;
        (void)hipGetDevice(&dev);
        (void)hipDeviceGetAttribute(&cus, hipDeviceAttributeMultiprocessorCount, dev);
        (void)hipFuncSetAttribute((const void*)mega, hipFuncAttributeMaxDynamicSharedMemorySize, SMEM_BYTES);
        (void)hipOccupancyMaxActiveBlocksPerMultiprocessor(&per_cu, (const void*)mega, 256, SMEM_BYTES);
        if (per_cu > 2) per_cu = 2;
        grid = cus * per_cu;
        if (grid <= 0) { fprintf(stderr, "kernel_launch: occupancy query gave %d blocks per CU on %d CUs\n", per_cu, cus); grid = -1; }
    }
    if (grid < 0) return;
    Params p{};
    const float** pp = (const float**)&p;
    for (int i = 0; i < 28; ++i) pp[i] = (const float*)d_in[i];
    p.out = (float*)d_out; p.ws = (unsigned char*)d_ws;
    (void)hipMemsetAsync((unsigned char*)d_ws + OFF_CTL, 0, CTL_BYTES, stream);
#if ONE_LAUNCH
    int lo = 0, hi = NPHASE;
    void* args[] = {(void*)&p, (void*)&lo, (void*)&hi};
    hipError_t e = hipLaunchCooperativeKernel((const void*)mega, dim3(grid), dim3(256), args, SMEM_BYTES, stream);
    if (e != hipSuccess) fprintf(stderr, "kernel_launch: cooperative launch failed: %s (grid %d)\n", hipGetErrorString(e), grid);
#else
    for (int ph = 0; ph < NPHASE; ++ph) mega<<<grid, 256, SMEM_BYTES, stream>>>(p, ph, ph + 1);
#endif
}
```

```cpp
#include <hip/hip_runtime.h>
#include <hip/hip_cooperative_groups.h>
#include <stdint.h>
#include <cstdio>

typedef unsigned short bf16_t;
typedef short bf16x8 __attribute__((ext_vector_type(8)));
typedef float f32x4 __attribute__((ext_vector_type(4)));

#define DEV __device__ __forceinline__
#define PROBE_ID -1
#define PROBE_N 4
#define PROBE_TS -1

constexpr int D = 1024, NB = 8, S = 8192, CTX = 256;
constexpr int NLAT = NB * S, NCTX = NB * CTX, NTOK = NLAT + NCTX;
constexpr int PWS = 1280;
constexpr int COL_RGX = 0, COL_GATE = 256, COL_NAQ = 512, COL_GQ = 896;
constexpr int KVT = 1024;
constexpr int NE = 32, FF = 512;
constexpr int LISTCAP = NTOK;
constexpr float ALPHA = 1.4142135623730951f;
constexpr float LN_EPS = 1e-5f;

constexpr size_t al256(size_t x) { return (x + 255) & ~(size_t)255; }
constexpr size_t OFF_CTL   = 0;
constexpr size_t CTL_BYTES = 4096 + 16384;
constexpr size_t OFF_MOD   = OFF_CTL + CTL_BYTES;
constexpr size_t OFF_ROPE  = al256(OFF_MOD + (size_t)2 * 9 * 6144 * 4);
constexpr size_t OFF_RTE   = al256(OFF_ROPE + (size_t)2 * 128 * 16 * 4);
constexpr size_t OFF_RTW   = al256(OFF_RTE + (size_t)NTOK * 8);
constexpr size_t OFF_LIST  = al256(OFF_RTW + (size_t)NTOK * 8);
constexpr size_t OFF_WR    = al256(OFF_LIST + (size_t)NE * LISTCAP * 4);
constexpr size_t OFF_WRG   = al256(OFF_WR + (size_t)2 * 2 * 48 * 1024 * 2);
constexpr size_t OFF_RGC   = al256(OFF_WRG + (size_t)2 * 2 * 2 * 4 * 64 * 64 * 2);
constexpr size_t OFF_AGG   = al256(OFF_RGC + (size_t)2 * 2 * 3 * 256 * 4);
constexpr size_t OFF_WINT  = al256(OFF_AGG + (size_t)NB * 66 * 2 * 2 * 256 * 4);
constexpr size_t OFF_WOUTT = al256(OFF_WINT + (size_t)2 * 2304 * 1024 * 2);
constexpr size_t OFF_WGU   = al256(OFF_WOUTT + (size_t)2 * 1024 * 1024 * 2);
constexpr size_t OFF_WD    = al256(OFF_WGU + (size_t)NE * 1024 * 1024 * 2);
constexpr size_t OFF_XCTX  = al256(OFF_WD + (size_t)NE * 1024 * 512 * 2);
constexpr size_t OFF_X1    = al256(OFF_XCTX + (size_t)NCTX * D * 4);
constexpr size_t OFF_X2    = al256(OFF_X1 + (size_t)NTOK * D * 2);
constexpr size_t OFF_P     = al256(OFF_X2 + (size_t)NTOK * D * 2);
constexpr size_t OFF_NAKF  = al256(OFF_P + (size_t)NTOK * PWS * 2);
constexpr size_t OFF_NAVF  = al256(OFF_NAKF + (size_t)NB * 6 * 512 * KVT * 2);
constexpr size_t OFF_GKF   = al256(OFF_NAVF + (size_t)NB * 6 * 512 * KVT * 2);
constexpr size_t OFF_GVF   = al256(OFF_GKF + (size_t)NB * 2 * 512 * KVT * 2);
constexpr size_t OFF_NAKFC = al256(OFF_GVF + (size_t)NB * 2 * 512 * KVT * 2);
constexpr size_t OFF_NAVFC = al256(OFF_NAKFC + (size_t)NB * 6 * 16 * KVT * 2);
constexpr size_t OFF_GKFC  = al256(OFF_NAVFC + (size_t)NB * 6 * 16 * KVT * 2);
constexpr size_t OFF_GVFC  = al256(OFF_GKFC + (size_t)NB * 2 * 16 * KVT * 2);
constexpr size_t OFF_Y     = al256(OFF_GVFC + (size_t)NB * 2 * 16 * KVT * 2);
constexpr size_t WS_TOTAL  = al256(OFF_Y + (size_t)2 * NTOK * D * 2);
constexpr int CW_CNT = 0;

struct Params {
    const float *x, *c, *ctx, *c_ctx, *w_ada, *b_ada, *w_in, *conv_w, *conv_b, *rg_a_w, *rg_a_b, *rg_i_w, *rg_i_b, *rg_lambda,
        *na_rpb, *gqa_sink, *w_out, *ln1_g, *ln1_b, *router_g_w, *router_g_b, *router_e_w, *router_e_b, *exp_w_gate, *exp_w_up,
        *exp_w_down, *ln2_g, *ln2_b;
    float* out;
    unsigned char* ws;
};

DEV const Params& kp_() { const void* q = (const void*)__builtin_amdgcn_kernarg_segment_ptr(); asm volatile("" : "+s"(q)); return *(const Params*)q; }
DEV int tid_() { int t = threadIdx.x; asm volatile("" : "+v"(t)); return t; }
DEV int bid_() { int b = blockIdx.x; asm volatile("" : "+s"(b)); return b; }
DEV float shx(float v, int m) { return __builtin_bit_cast(float, __builtin_amdgcn_ds_bpermute(((tid_() & 63) ^ m) << 2, __builtin_bit_cast(int, v))); }
DEV float shl_(float v, int src) { return __builtin_bit_cast(float, __builtin_amdgcn_ds_bpermute(src << 2, __builtin_bit_cast(int, v))); }
DEV float bf2f(bf16_t h) { return __uint_as_float((unsigned)h << 16); }
DEV bf16_t f2bf(float f) { unsigned u = __float_as_uint(f); u += 0x7fffu + ((u >> 16) & 1u); return (bf16_t)(u >> 16); }
DEV unsigned pk2(float lo, float hi) { return (unsigned)f2bf(lo) | ((unsigned)f2bf(hi) << 16); }
DEV float wave_sum(float v) {
#pragma unroll
    for (int o = 1; o < 64; o <<= 1) v += shx(v, o);
    return v;
}
DEV float wave_max(float v) {
#pragma unroll
    for (int o = 1; o < 64; o <<= 1) v = fmaxf(v, shx(v, o));
    return v;
}
DEV float sigmoidf_(float x) { return 1.f / (1.f + __expf(-x)); }
DEV float gelu_tanh(float x) {
    const float u = 0.7978845608028654f * (x + 0.044715f * x * x * x);
    const float t = 1.f - 2.f / (1.f + __expf(2.f * u));
    return 0.5f * x * (1.f + t);
}
DEV float* xres_row(const Params& p, int R) {
    return R < NLAT ? p.out + (size_t)R * D : (float*)(p.ws + OFF_XCTX) + (size_t)(R - NLAT) * D;
}
DEV const float* modvec(const Params& p, int l, int R, int seg) {
    const int b = R < NLAT ? R / S : 8;
    return (const float*)(p.ws + OFF_MOD) + ((size_t)(l * 9 + b) * 6 + seg) * 1024;
}

DEV void ph_mod(const Params& p, float* sc  ) {
    if (bid_() >= 192) return;
    for (int i = tid_(); i < 9 * 1024; i += 256) { const float v = (i < 8192) ? p.c[i] : p.c_ctx[i - 8192]; sc[i] = v / (1.f + expf(-v)); }
    __syncthreads();
    const int lane = tid_() & 63, w = tid_() >> 6;
    const int col = bid_() * 64 + lane;
    const int l = col / 6144, j = col % 6144;
    const float* wp = p.w_ada + (size_t)l * 1024 * 6144 + j + (size_t)(w * 256) * 6144;
    const float* s = sc + w * 256;
    float a0 = 0, a1 = 0, a2 = 0, a3 = 0, a4 = 0, a5 = 0, a6 = 0, a7 = 0, a8 = 0;
#pragma unroll 8
    for (int k = 0; k < 256; ++k) {
        const float wv = wp[(size_t)k * 6144];
        a0 += s[k] * wv; a1 += s[1024 + k] * wv; a2 += s[2048 + k] * wv; a3 += s[3072 + k] * wv; a4 += s[4096 + k] * wv;
        a5 += s[5120 + k] * wv; a6 += s[6144 + k] * wv; a7 += s[7168 + k] * wv; a8 += s[8192 + k] * wv;
    }
    __syncthreads();
    float* red = sc + 9 * 1024;
    red[(w * 9 + 0) * 64 + lane] = a0; red[(w * 9 + 1) * 64 + lane] = a1; red[(w * 9 + 2) * 64 + lane] = a2; red[(w * 9 + 3) * 64 + lane] = a3; red[(w * 9 + 4) * 64 + lane] = a4;
    red[(w * 9 + 5) * 64 + lane] = a5; red[(w * 9 + 6) * 64 + lane] = a6; red[(w * 9 + 7) * 64 + lane] = a7; red[(w * 9 + 8) * 64 + lane] = a8;
    __syncthreads();
    if (w == 0) {
        const float bias = p.b_ada[l * 6144 + j];
        float* mod = (float*)(p.ws + OFF_MOD) + (size_t)l * 9 * 6144 + j;
#pragma unroll
        for (int r = 0; r < 9; ++r) mod[r * 6144] = ((red[(0 * 9 + r) * 64 + lane] + red[(1 * 9 + r) * 64 + lane]) + (red[(2 * 9 + r) * 64 + lane] + red[(3 * 9 + r) * 64 + lane])) + bias;
    }
}

DEV void sincos_red(float ang, float& sn, float& cs) {
    const float n = rintf(ang * 0.15915494309189535f);
    float r = fmaf(-n, 6.2831854820251465f, ang);
    r = fmaf(-n, -1.7484555e-07f, r);
    float sgn = 1.f;
    if (r > 1.5707963267948966f) { r = 3.14159265358979f - r; sgn = -1.f; }
    else if (r < -1.5707963267948966f) { r = -3.14159265358979f - r; sgn = -1.f; }
    const float r2 = r * r;
    float sp = -1.6059044e-10f; sp = fmaf(sp, r2, 2.5052108e-08f); sp = fmaf(sp, r2, -2.7557319e-06f); sp = fmaf(sp, r2, 1.9841270e-04f);
    sp = fmaf(sp, r2, -8.3333333e-03f); sp = fmaf(sp, r2, 1.6666667e-01f); sp = fmaf(sp * -1.f, r2, 1.f);
    sn = r * sp;
    float cp = -1.1470746e-11f; cp = fmaf(cp, r2, 2.0876757e-09f); cp = fmaf(cp, r2, -2.7557319e-07f); cp = fmaf(cp, r2, 2.4801587e-05f);
    cp = fmaf(cp, r2, -1.3888889e-03f); cp = fmaf(cp, r2, 4.1666667e-02f); cp = fmaf(cp, r2, -0.5f); cp = fmaf(cp, r2, 1.f);
    cs = sgn * cp;
}
DEV void ph_rope(const Params& p) {
    const int i = (bid_() - 192) * 256 + tid_();
    if (i < 0 || i >= 128 * 16) return;
    const int pos = i >> 4, q = i & 15;
    const float inv = exp2f(-(float)q * (13.287712379549449f / 16.f));
    float sn, cs; sincos_red((float)pos * inv, sn, cs);
    float* tab = (float*)(p.ws + OFF_ROPE);
    tab[i] = cs; tab[2048 + i] = sn;
}

DEV void ph_routerw(const Params& p) {
  for (int i = bid_() * 256 + tid_(); i < 2 * 48 * 1024; i += gridDim.x * 256) {
    const int l = i / (48 * 1024), f = (i / 1024) % 48, k = i & 1023;
    float w = 0.f;
    if (f < 4) w = p.router_g_w[((size_t)l * 1024 + k) * 4 + f]; else if (f < 36) w = p.router_e_w[((size_t)l * 1024 + k) * 32 + (f - 4)];
    const bf16_t hi = f2bf(w), lo = f2bf(w - bf2f(hi));
    bf16_t* WR = (bf16_t*)(p.ws + OFF_WR);
    WR[((size_t)(l * 2 + 0) * 48 + f) * 1024 + k] = hi;
    WR[((size_t)(l * 2 + 1) * 48 + f) * 1024 + k] = lo;
  }
}

DEV void ph_rgprep(const Params& p) {
    bf16_t* W = (bf16_t*)(p.ws + OFF_WRG);
    for (int i = bid_() * 256 + tid_(); i < 2 * 2 * 2 * 4 * 64 * 64; i += gridDim.x * 256) {
        const int d = i & 63, e = (i >> 6) & 63, n = (i >> 12) & 3, gate = (i >> 14) & 1, ld = i >> 15;
        const float* srcw = gate ? p.rg_i_w : p.rg_a_w;
        W[i] = f2bf(srcw[((size_t)(ld * 4 + n) * 64 + d) * 64 + e]);
    }
    float* C = (float*)(p.ws + OFF_RGC);
    for (int i = bid_() * 256 + tid_(); i < 2 * 2 * 256; i += gridDim.x * 256) {
        const int c = i & 255, ld = i >> 8;
        C[(ld * 3 + 0) * 256 + c] = p.rg_a_b[ld * 256 + c];
        C[(ld * 3 + 1) * 256 + c] = p.rg_i_b[ld * 256 + c];
        C[(ld * 3 + 2) * 256 + c] = -8.f * log1pf(expf(-p.rg_lambda[ld * 256 + c]));
    }
}

DEV int tr_row(int n, int mode) { return mode == 0 ? n : ((n >> 7) * 256 + ((n >> 6) & 1) * 128 + (n & 63) + (mode == 2 ? 64 : 0)); }
DEV void transpose_tile(const float* src, bf16_t* dst, int K, int N, int mode, int tile, float* lds) {
    const int ntn = N >> 6, kt = tile / ntn, nt = tile % ntn, k0 = kt * 64, n0 = nt * 64, t = tid_();
#pragma unroll
    for (int i = 0; i < 4; ++i) {
        const int r = (t >> 4) + 16 * i, c4 = (t & 15) * 4;
        const float4 v = *(const float4*)(src + (size_t)(k0 + r) * N + n0 + c4);
        lds[r * 65 + c4] = v.x; lds[r * 65 + c4 + 1] = v.y; lds[r * 65 + c4 + 2] = v.z; lds[r * 65 + c4 + 3] = v.w;
    }
    __syncthreads();
#pragma unroll
    for (int i = 0; i < 2; ++i) {
        const int n = (t >> 3) + 32 * i, kc = (t & 7) * 8;
        uint4 o;
        o.x = pk2(lds[(kc + 0) * 65 + n], lds[(kc + 1) * 65 + n]); o.y = pk2(lds[(kc + 2) * 65 + n], lds[(kc + 3) * 65 + n]);
        o.z = pk2(lds[(kc + 4) * 65 + n], lds[(kc + 5) * 65 + n]); o.w = pk2(lds[(kc + 6) * 65 + n], lds[(kc + 7) * 65 + n]);
        *(uint4*)(dst + (size_t)tr_row(n0 + n, mode) * K + k0 + kc) = o;
    }
    __syncthreads();
}
DEV void ph_transpose(const float* src, bf16_t* dst, int K, int N, int mode, int nmat, size_t sstride, size_t dstride, float* lds  ) {
    const int per = (K >> 6) * (N >> 6);
    for (int it = bid_(); it < nmat * per; it += gridDim.x) {
        const int m = it / per, tile = it % per;
        transpose_tile(src + (size_t)m * sstride, dst + (size_t)m * dstride, K, N, mode, tile, lds);
    }
}

template <int MODE, bool WX> DEV void rowop(const Params& p, int l, int R) {
    const int lane = tid_() & 63;
    float4 v[2][4];
    float* xr[2] = {nullptr, nullptr};
    if (MODE == 0) {
#pragma unroll
        for (int r = 0; r < 2; ++r) {
            const int Rr = R + r;
            const float* src = Rr < NLAT ? p.x + (size_t)Rr * D : p.ctx + (size_t)(Rr - NLAT) * D;
#pragma unroll
            for (int i = 0; i < 4; ++i) v[r][i] = *(const float4*)(src + i * 256 + lane * 4);
        }
    } else {
        const float* g2 = modvec(p, l - 1, R, 5);
        const float* lg = p.ln2_g + (l - 1) * D; const float* lb = p.ln2_b + (l - 1) * D;
        float4 xv[2][4]; uint2 ya[2][4], yb[2][4];
#pragma unroll
        for (int r = 0; r < 2; ++r) {
            xr[r] = xres_row(p, R + r);
            const bf16_t* y0 = (const bf16_t*)(p.ws + OFF_Y) + (size_t)(2 * (R + r)) * D;
#pragma unroll
            for (int i = 0; i < 4; ++i) { const int k = i * 256 + lane * 4; xv[r][i] = *(const float4*)(xr[r] + k); ya[r][i] = *(const uint2*)(y0 + k); yb[r][i] = *(const uint2*)(y0 + D + k); }
        }
        float s[2] = {0.f, 0.f};
#pragma unroll
        for (int i = 0; i < 4; ++i) {
            const float4 gv = *(const float4*)(g2 + i * 256 + lane * 4);
#pragma unroll
            for (int r = 0; r < 2; ++r) {
                const uint2 a = ya[r][i], b = yb[r][i];
                float4 u;
                u.x = ALPHA * xv[r][i].x + gv.x * (bf2f((bf16_t)(a.x & 0xffff)) + bf2f((bf16_t)(b.x & 0xffff)));
                u.y = ALPHA * xv[r][i].y + gv.y * (bf2f((bf16_t)(a.x >> 16)) + bf2f((bf16_t)(b.x >> 16)));
                u.z = ALPHA * xv[r][i].z + gv.z * (bf2f((bf16_t)(a.y & 0xffff)) + bf2f((bf16_t)(b.y & 0xffff)));
                u.w = ALPHA * xv[r][i].w + gv.w * (bf2f((bf16_t)(a.y >> 16)) + bf2f((bf16_t)(b.y >> 16)));
                v[r][i] = u; s[r] += (u.x + u.y) + (u.z + u.w);
            }
        }
        float q[2] = {0.f, 0.f};
#pragma unroll
        for (int r = 0; r < 2; ++r) {
            const float mean = wave_sum(s[r]) * (1.f / D);
#pragma unroll
            for (int i = 0; i < 4; ++i) { v[r][i].x -= mean; v[r][i].y -= mean; v[r][i].z -= mean; v[r][i].w -= mean; q[r] += (v[r][i].x * v[r][i].x + v[r][i].y * v[r][i].y) + (v[r][i].z * v[r][i].z + v[r][i].w * v[r][i].w); }
        }
#pragma unroll
        for (int r = 0; r < 2; ++r) q[r] = rsqrtf(wave_sum(q[r]) * (1.f / D) + LN_EPS);
#pragma unroll
        for (int i = 0; i < 4; ++i) {
            const int k = i * 256 + lane * 4;
            const float4 gg = *(const float4*)(lg + k); const float4 bb = *(const float4*)(lb + k);
#pragma unroll
            for (int r = 0; r < 2; ++r) {
                v[r][i].x = v[r][i].x * q[r] * gg.x + bb.x; v[r][i].y = v[r][i].y * q[r] * gg.y + bb.y; v[r][i].z = v[r][i].z * q[r] * gg.z + bb.z; v[r][i].w = v[r][i].w * q[r] * gg.w + bb.w;
                if (WX) *(float4*)(xr[r] + k) = v[r][i];
            }
        }
    }
    if (MODE != 2) {
        const float* sh = modvec(p, l, R, 0); const float* sc = modvec(p, l, R, 1);
#pragma unroll
        for (int i = 0; i < 4; ++i) {
            const int k = i * 256 + lane * 4;
            const float4 s4 = *(const float4*)(sh + k); const float4 c4 = *(const float4*)(sc + k);
#pragma unroll
            for (int r = 0; r < 2; ++r) {
                bf16_t* ha = (bf16_t*)(p.ws + OFF_X1) + (size_t)(R + r) * D;
                uint2 o; o.x = pk2(v[r][i].x * (1.f + c4.x) + s4.x, v[r][i].y * (1.f + c4.y) + s4.y); o.y = pk2(v[r][i].z * (1.f + c4.z) + s4.z, v[r][i].w * (1.f + c4.w) + s4.w);
                *(uint2*)(ha + k) = o;
            }
        }
    }
}
template <int MODE> DEV void ph_rowop(const Params& p, int l, int nrows) {
    const int w = tid_() >> 6;
    for (int R = (bid_() * 4 + w) * 2; R < nrows; R += gridDim.x * 8) rowop<MODE, true>(p, l, R);
}
constexpr int CW_Q = 64;
DEV int q_publish(int nreg, int* slot) {
    __syncthreads();
    if (tid_() == 0) *slot = nreg;
    __syncthreads();
    return *(volatile int*)slot;
}
DEV int q_pull(unsigned* ctr, int* slot) {
    if (tid_() == 0) *slot = (int)atomicAdd(ctr, 1u);
    __syncthreads();
    const int v = *(volatile int*)slot;
    __syncthreads();
    return v;
}

constexpr int GEMM_STAGE_BYTES = 384 * 64;
constexpr int GEMM_NSTAGE = 3;
constexpr int GEMM_LDS_BYTES = GEMM_NSTAGE * GEMM_STAGE_BYTES;
#define LAS __attribute__((address_space(3)))
DEV int gemm_src_chunk(int t) { return ((t & 3) ^ ((0 - (t >> 4)) & 3)) * 8; }
DEV void gemm_mainloop(const bf16_t* Abase, unsigned ao0, unsigned ao1, const bf16_t* Bbase, unsigned bo, unsigned ldb, int nk, bf16_t* lds, f32x4 (&acc)[4][8]) {
    const int t = tid_(), lane = t & 63, w = __builtin_amdgcn_readfirstlane(t >> 6), wm = w >> 1, wn = w & 1;
    LAS unsigned char* L = (LAS unsigned char*)lds;
    const int pc = ((lane >> 4) ^ ((0 - ((lane & 15) >> 2)) & 3)) * 16;
    const int arow = (wm * 64 + (lane & 15)) * 64 + pc, brow = (128 + wn * 128 + (lane & 15)) * 64 + pc;
    const char* Ab = (const char*)Abase; const char* B0 = (const char*)Bbase; const char* B1 = B0 + (size_t)ldb * 128; const char* B2 = B0 + (size_t)ldb * 256; const char* B3 = B0 + (size_t)ldb * 384;
#define GEMM_ISSUE(slot, ko) do { LAS unsigned* d_ = (LAS unsigned*)(L + (slot) * GEMM_STAGE_BYTES + w * 1024); \
        __builtin_amdgcn_global_load_lds((const unsigned*)(Ab + (ao0 + (ko) * 2u)), d_, 16, 0, 0); \
        __builtin_amdgcn_global_load_lds((const unsigned*)(Ab + (ao1 + (ko) * 2u)), d_ + 1024, 16, 0, 0); \
        __builtin_amdgcn_global_load_lds((const unsigned*)(B0 + (bo + (ko) * 2u)), d_ + 2048, 16, 0, 0); \
        __builtin_amdgcn_global_load_lds((const unsigned*)(B1 + (bo + (ko) * 2u)), d_ + 3072, 16, 0, 0); \
        __builtin_amdgcn_global_load_lds((const unsigned*)(B2 + (bo + (ko) * 2u)), d_ + 4096, 16, 0, 0); \
        __builtin_amdgcn_global_load_lds((const unsigned*)(B3 + (bo + (ko) * 2u)), d_ + 5120, 16, 0, 0); } while (0)
    asm volatile("s_waitcnt vmcnt(0)" ::: "memory");
    __builtin_amdgcn_s_barrier();
    asm volatile("" ::: "memory");
    GEMM_ISSUE(0, 0);
    if (nk > 1) GEMM_ISSUE(1, 32);
    int cs = 0, is = 2;
    for (int kt = 0; kt < nk; ++kt) {
        if (kt + 1 < nk) asm volatile("s_waitcnt vmcnt(6)" ::: "memory"); else asm volatile("s_waitcnt vmcnt(0)" ::: "memory");
        __builtin_amdgcn_s_barrier();
        asm volatile("" ::: "memory");
        if (kt + 2 < nk) GEMM_ISSUE(is, (kt + 2) * 32);
        const LAS unsigned char* cur = L + cs * GEMM_STAGE_BYTES;
        const bf16x8 af0 = *(const LAS bf16x8*)(cur + arow), af1 = *(const LAS bf16x8*)(cur + arow + 16 * 64), af2 = *(const LAS bf16x8*)(cur + arow + 32 * 64), af3 = *(const LAS bf16x8*)(cur + arow + 48 * 64);
        bf16x8 bq0 = *(const LAS bf16x8*)(cur + brow), bq1 = *(const LAS bf16x8*)(cur + brow + 16 * 64);
#pragma unroll
        for (int nt = 0; nt < 8; ++nt) {
            const bf16x8 bfr = bq0; bq0 = bq1;
            if (nt + 2 < 8) bq1 = *(const LAS bf16x8*)(cur + brow + (nt + 2) * 16 * 64);
            acc[0][nt] = __builtin_amdgcn_mfma_f32_16x16x32_bf16(bfr, af0, acc[0][nt], 0, 0, 0);
            acc[1][nt] = __builtin_amdgcn_mfma_f32_16x16x32_bf16(bfr, af1, acc[1][nt], 0, 0, 0);
            acc[2][nt] = __builtin_amdgcn_mfma_f32_16x16x32_bf16(bfr, af2, acc[2][nt], 0, 0, 0);
            acc[3][nt] = __builtin_amdgcn_mfma_f32_16x16x32_bf16(bfr, af3, acc[3][nt], 0, 0, 0);
        }
        cs = cs == 2 ? 0 : cs + 1; is = is == 2 ? 0 : is + 1;
    }
#undef GEMM_ISSUE
}
DEV void zero_acc(f32x4 (&acc)[4][8]) {
#pragma unroll
    for (int a = 0; a < 4; ++a)
#pragma unroll
        for (int b = 0; b < 8; ++b) acc[a][b] = (f32x4){0.f, 0.f, 0.f, 0.f};
}

DEV void inproj_item(const Params& p_, int l, int rt, int pass, bf16_t* lds) {
    const Params& p = kp_();
    const int t = tid_(), lane = t & 63, w = t >> 6, wm = w >> 1, wn = w & 1;
    const bf16_t* A = (const bf16_t*)(p.ws + OFF_X1) + (size_t)(rt * 128) * D;
    const bf16_t* Bt = (const bf16_t*)(p.ws + OFF_WINT) + ((size_t)l * 2304 + pass * 256) * 1024;
    const unsigned toff = (unsigned)(((t >> 2) * 1024 + gemm_src_chunk(t)) * 2);
    f32x4 acc[4][8]; zero_acc(acc);
    gemm_mainloop(A, toff, toff + 64 * D * 2, Bt, toff, 1024, 32, lds, acc);
    bf16_t* P = (bf16_t*)(p.ws + OFF_P);
    const float* ctab = (const float*)(p.ws + OFF_ROPE); const float* stab = ctab + 2048;
    const bool isctx = rt >= 512;
    const int fq = lane >> 4, fr = lane & 15;
#pragma unroll
    for (int hci = 0; hci < 2; ++hci) {
        const int hc = pass * 4 + wn * 2 + hci;
        int type, dcol = 0, vh = 0;
        if (hc < 4) { type = 0; dcol = COL_RGX + hc * 64; }
        else if (hc < 10) { type = 4; vh = hc - 4; }
        else if (hc < 16) { type = 5; vh = hc - 10; }
        else if (hc < 18) { type = 6; vh = hc - 16; }
        else if (hc < 20) { type = 7; vh = hc - 18; }
        else if (hc < 24) { type = 0; dcol = COL_GATE + (hc - 20) * 64; }
        else if (hc < 30) { type = 1; dcol = COL_NAQ + (hc - 24) * 64; }
        else { type = 3; dcol = COL_GQ + (hc - 30) * 64; }
#pragma unroll
        for (int mt = 0; mt < 4; ++mt) {
            const int R = rt * 128 + wm * 64 + mt * 16 + fr;
            f32x4 v0 = acc[mt][hci * 4 + 0], v1 = acc[mt][hci * 4 + 1], v2 = acc[mt][hci * 4 + 2], v3 = acc[mt][hci * 4 + 3];
            if ((type == 3 || type == 6) && !isctx) {
                const int tt = R & (S - 1), pr = tt >> 6, pc = tt & 63;
                const f32x4 cr = *(const f32x4*)(ctab + pr * 16 + fq * 4), sr = *(const f32x4*)(stab + pr * 16 + fq * 4);
                const f32x4 cc = *(const f32x4*)(ctab + pc * 16 + fq * 4), sc = *(const f32x4*)(stab + pc * 16 + fq * 4);
                const f32x4 o0 = v0 * cr - v1 * sr, o1 = v1 * cr + v0 * sr, o2 = v2 * cc - v3 * sc, o3 = v3 * cc + v2 * sc;
                v0 = o0; v1 = o1; v2 = o2; v3 = o3;
            }
            if (type == 1 || type == 3) { v0 = v0 * 0.125f; v1 = v1 * 0.125f; v2 = v2 * 0.125f; v3 = v3 * 0.125f; }
            if (type < 4) {
                bf16_t* o = P + (size_t)R * PWS + dcol + fq * 4;
                uint2 q;
                q.x = pk2(v0[0], v0[1]); q.y = pk2(v0[2], v0[3]); *(uint2*)(o) = q;
                q.x = pk2(v1[0], v1[1]); q.y = pk2(v1[2], v1[3]); *(uint2*)(o + 16) = q;
                q.x = pk2(v2[0], v2[1]); q.y = pk2(v2[2], v2[3]); *(uint2*)(o + 32) = q;
                q.x = pk2(v3[0], v3[1]); q.y = pk2(v3[2], v3[3]); *(uint2*)(o + 48) = q;
            } else {
                const bool na = type < 6, isk = (type == 4 || type == 6);
                bf16_t* tb;
                if (!isctx) { const int b = R >> 13, tile = (R & (S - 1)) >> 4;
                    tb = (bf16_t*)(p.ws + (na ? (isk ? OFF_NAKF : OFF_NAVF) : (isk ? OFF_GKF : OFF_GVF))) + ((size_t)(b * (na ? 6 : 2) + vh) * 512 + tile) * KVT; }
                else { const int cR = R - NLAT, b = cR >> 8, tile = (cR & 255) >> 4;
                    tb = (bf16_t*)(p.ws + (na ? (isk ? OFF_NAKFC : OFF_NAVFC) : (isk ? OFF_GKFC : OFF_GVFC))) + ((size_t)(b * (na ? 6 : 2) + vh) * 16 + tile) * KVT; }
                if (isk) {
                    bf16_t* o = tb + ((fq >> 1) * 16 + fr) * 8 + (fq & 1) * 4;
                    uint2 q;
                    q.x = pk2(v0[0], v0[1]); q.y = pk2(v0[2], v0[3]); *(uint2*)(o) = q;
                    q.x = pk2(v1[0], v1[1]); q.y = pk2(v1[2], v1[3]); *(uint2*)(o + 2 * 16 * 8) = q;
                    q.x = pk2(v2[0], v2[1]); q.y = pk2(v2[2], v2[3]); *(uint2*)(o + 512) = q;
                    q.x = pk2(v3[0], v3[1]); q.y = pk2(v3[2], v3[3]); *(uint2*)(o + 512 + 2 * 16 * 8) = q;
                } else {
                    bf16_t* o = tb + ((fr >> 2) * 16 + fq * 4) * 8 + (fr & 3);
#pragma unroll
                    for (int j = 0; j < 4; ++j) {
                        o[j * 8] = f2bf(v0[j]); o[j * 8 + 4] = f2bf(v1[j]); o[512 + j * 8] = f2bf(v2[j]); o[512 + j * 8 + 4] = f2bf(v3[j]);
                    }
                }
            }
        }
    }
}
DEV void ph_inproj(const Params& p, int l, bf16_t* lds) {
    const int nctxp = (l == 0) ? 9 : 5;
    const int nx = gridDim.x >> 3, xcd = bid_() & 7, j = bid_() >> 3;
    const int nloc = 64 * 9 + 2 * nctxp;
    if (bid_() >= nx * 8) return;
    for (int i0 = j; i0 < nloc * ((PROBE_ID) == 3 ? PROBE_N : 1); i0 += nx) {
        const int i = i0 % nloc;
        int rt, pass;
        if (i < 64 * 9) { rt = xcd * 64 + i / 9; pass = i % 9; } else { const int r = i - 64 * 9; rt = 512 + 2 * xcd + r / nctxp; pass = r % nctxp; }
        inproj_item(p, l, rt, pass, lds);
    }
}

constexpr float LOG2E = 1.4426950408889634f;
struct AttnState { f32x4 o0, o1, o2, o3; float m, lsum; };
struct KVFrag { bf16x8 k00, k01, k10, k11, v0, v1, v2, v3; };
DEV bf16x8 ld16(const bf16_t* p) { return *(const bf16x8*)p; }
DEV bf16x8 lohi(const uint4& a, const uint4& b, int hi) { union { uint4 u; bf16x8 v; } c; c.u = hi ? make_uint4(a.z, a.w, b.z, b.w) : make_uint4(a.x, a.y, b.x, b.y); return c.v; }
DEV void kv_load(const bf16_t* kt0, const bf16_t* kt1, const bf16_t* vt0, const bf16_t* vt1, KVFrag& f) {
    f.k00 = ld16(kt0); f.k01 = ld16(kt0 + 512); f.k10 = ld16(kt1); f.k11 = ld16(kt1 + 512);
    const uint4 a0 = *(const uint4*)vt0, a1 = *(const uint4*)(vt0 + 512), b0 = *(const uint4*)vt1, b1 = *(const uint4*)(vt1 + 512);
    f.v0 = lohi(a0, b0, 0); f.v1 = lohi(a0, b0, 1); f.v2 = lohi(a1, b1, 0); f.v3 = lohi(a1, b1, 1);
}
DEV void attn_apply(const KVFrag& f, const bf16x8& q0, const bf16x8& q1, f32x4 b0, f32x4 b1, AttnState& st) {
    const f32x4 z = {0.f, 0.f, 0.f, 0.f};
    f32x4 s0 = __builtin_amdgcn_mfma_f32_16x16x32_bf16(f.k00, q0, z, 0, 0, 0); s0 = __builtin_amdgcn_mfma_f32_16x16x32_bf16(f.k01, q1, s0, 0, 0, 0);
    f32x4 s1 = __builtin_amdgcn_mfma_f32_16x16x32_bf16(f.k10, q0, z, 0, 0, 0); s1 = __builtin_amdgcn_mfma_f32_16x16x32_bf16(f.k11, q1, s1, 0, 0, 0);
    s0 = s0 * LOG2E + b0; s1 = s1 * LOG2E + b1;
    float mx = fmaxf(fmaxf(fmaxf(s0[0], s0[1]), fmaxf(s0[2], s0[3])), fmaxf(fmaxf(s1[0], s1[1]), fmaxf(s1[2], s1[3])));
    mx = fmaxf(mx, shx(mx, 16)); mx = fmaxf(mx, shx(mx, 32));
    const float mn = fmaxf(st.m, mx);
    const float ms = (mn == -INFINITY) ? 0.f : mn;
    const float alpha = __builtin_amdgcn_exp2f(st.m - ms);
    f32x4 p0, p1;
#pragma unroll
    for (int j = 0; j < 4; ++j) { p0[j] = __builtin_amdgcn_exp2f(s0[j] - ms); p1[j] = __builtin_amdgcn_exp2f(s1[j] - ms); }
    st.lsum = st.lsum * alpha + ((p0[0] + p0[1]) + (p0[2] + p0[3])) + ((p1[0] + p1[1]) + (p1[2] + p1[3]));
    st.o0 = st.o0 * alpha; st.o1 = st.o1 * alpha; st.o2 = st.o2 * alpha; st.o3 = st.o3 * alpha;
    union { uint4 u; bf16x8 v; } pt; pt.u = make_uint4(pk2(p0[0], p0[1]), pk2(p0[2], p0[3]), pk2(p1[0], p1[1]), pk2(p1[2], p1[3]));
    st.o0 = __builtin_amdgcn_mfma_f32_16x16x32_bf16(f.v0, pt.v, st.o0, 0, 0, 0);
    st.o1 = __builtin_amdgcn_mfma_f32_16x16x32_bf16(f.v1, pt.v, st.o1, 0, 0, 0);
    st.o2 = __builtin_amdgcn_mfma_f32_16x16x32_bf16(f.v2, pt.v, st.o2, 0, 0, 0);
    st.o3 = __builtin_amdgcn_mfma_f32_16x16x32_bf16(f.v3, pt.v, st.o3, 0, 0, 0);
    st.m = mn;
}
DEV void attn_init(AttnState& st) { const f32x4 z = {0.f, 0.f, 0.f, 0.f}; st.o0 = z; st.o1 = z; st.o2 = z; st.o3 = z; st.m = -INFINITY; st.lsum = 0.f; }
DEV void attn_store(AttnState& st, bf16_t* orow, float sink2  ) {
    float l = st.lsum; l += shx(l, 16); l += shx(l, 32);
    float sc;
    if (sink2 != -INFINITY) { const float mf = fmaxf(st.m, sink2); const float al = __builtin_amdgcn_exp2f(st.m - mf); l = l * al + __builtin_amdgcn_exp2f(sink2 - mf); sc = al / l; }
    else sc = 1.f / l;
    uint2 w;
    w.x = pk2(st.o0[0] * sc, st.o0[1] * sc); w.y = pk2(st.o0[2] * sc, st.o0[3] * sc); *(uint2*)(orow) = w;
    w.x = pk2(st.o1[0] * sc, st.o1[1] * sc); w.y = pk2(st.o1[2] * sc, st.o1[3] * sc); *(uint2*)(orow + 16) = w;
    w.x = pk2(st.o2[0] * sc, st.o2[1] * sc); w.y = pk2(st.o2[2] * sc, st.o2[3] * sc); *(uint2*)(orow + 32) = w;
    w.x = pk2(st.o3[0] * sc, st.o3[1] * sc); w.y = pk2(st.o3[2] * sc, st.o3[3] * sc); *(uint2*)(orow + 48) = w;
}

constexpr int NTASK_NA = NB * 6 * 128 * 4, NTASK_GQ = NB * 2 * 512, NTASK_CNA = NB * 6 * 16, NTASK_CGQ = NB * 2 * 16;
DEV void attn_task(const Params& p, int l, int tk, const float* rpb2  ) {
    const int lane = tid_() & 63, g = lane >> 4, fr = lane & 15;
    const bf16_t* P = (const bf16_t*)(p.ws + OFF_P);
    bf16_t* X1 = (bf16_t*)(p.ws + OFF_X1);
    const f32x4 z4 = {0.f, 0.f, 0.f, 0.f};
    KVFrag f;
    if (tk < NTASK_NA) {
        const int qtile = tk & 3, r = (tk >> 2) & 127, hb = tk >> 9, h = hb % 6, b = hb / 6;
        const int qc = qtile == 0 ? (fr < 8 ? fr : 48 + fr) : 8 + (qtile - 1) * 16 + fr;
        const int ct0 = qtile == 0 ? 0 : qtile - 1, ct1 = qtile == 0 ? 3 : qtile;
        const int R = b * S + r * 64 + qc;
        const bf16_t* qp = P + (size_t)R * PWS + COL_NAQ + h * 64 + g * 8;
        const bf16x8 q0 = ld16(qp), q1 = ld16(qp + 32);
        const int rs = min(max(r - 4, 0), 120), cs = min(max(qc - 8, 0), 48);
        int ci[8]; bool ok[8];
#pragma unroll
        for (int e = 0; e < 8; ++e) { const int kc = ((e >> 2) ? ct1 : ct0) * 16 + g * 4 + (e & 3); ok[e] = (kc >= cs) && (kc < cs + 16); ci[e] = min(max(kc - qc + 15, 0), 30); }
        const bf16_t* kf = (const bf16_t*)(p.ws + OFF_NAKF) + ((size_t)(b * 6 + h) * 512 + rs * 4) * KVT + lane * 8;
        const bf16_t* vf = (const bf16_t*)(p.ws + OFF_NAVF) + ((size_t)(b * 6 + h) * 512 + rs * 4) * KVT + lane * 8;
        AttnState st; attn_init(st);
#pragma unroll
        for (int ri = 0; ri < 8; ++ri) {
            const float* rb = rpb2 + (h * 15 + (rs + ri - r + 7)) * 31;
            f32x4 b0, b1;
#pragma unroll
            for (int j = 0; j < 4; ++j) { b0[j] = ok[j] ? rb[ci[j]] : -INFINITY; b1[j] = ok[4 + j] ? rb[ci[4 + j]] : -INFINITY; }
            kv_load(kf + (size_t)(ri * 4 + ct0) * KVT, kf + (size_t)(ri * 4 + ct1) * KVT, vf + (size_t)(ri * 4 + ct0) * KVT, vf + (size_t)(ri * 4 + ct1) * KVT, f);
            attn_apply(f, q0, q1, b0, b1, st);
        }
        const bf16_t* kc_ = (const bf16_t*)(p.ws + OFF_NAKFC) + (size_t)(b * 6 + h) * 16 * KVT + lane * 8;
        const bf16_t* vc_ = (const bf16_t*)(p.ws + OFF_NAVFC) + (size_t)(b * 6 + h) * 16 * KVT + lane * 8;
#pragma unroll
        for (int pp = 0; pp < 8; ++pp) { kv_load(kc_ + (size_t)(2 * pp) * KVT, kc_ + (size_t)(2 * pp + 1) * KVT, vc_ + (size_t)(2 * pp) * KVT, vc_ + (size_t)(2 * pp + 1) * KVT, f); attn_apply(f, q0, q1, z4, z4, st); }
        attn_store(st, X1 + (size_t)R * D + 256 + h * 64 + g * 4, -INFINITY);
    } else if (tk < NTASK_NA + NTASK_GQ + NTASK_CNA + NTASK_CGQ && (tk < NTASK_NA + NTASK_GQ || tk >= NTASK_NA + NTASK_GQ + NTASK_CNA)) {
        const bool lat = tk < NTASK_NA + NTASK_GQ;
        const int t2 = lat ? tk - NTASK_NA : tk - (NTASK_NA + NTASK_GQ + NTASK_CNA);
        const int qt = lat ? (t2 & 511) : (t2 & 15), hb = lat ? (t2 >> 9) : (t2 >> 4), kvh = hb & 1, b = hb >> 1;
        const int q0i = qt * 16, R = (lat ? b * S : NLAT + b * CTX) + q0i + fr;
        const bf16_t* qp = P + (size_t)R * PWS + COL_GQ + kvh * 192 + g * 8;
        const bf16x8 qa0 = ld16(qp), qa1 = ld16(qp + 32), qb0 = ld16(qp + 64), qb1 = ld16(qp + 96), qc0 = ld16(qp + 128), qc1 = ld16(qp + 160);
        AttnState sa, sb, sc; attn_init(sa); attn_init(sb); attn_init(sc);
        const bf16_t* kf = (const bf16_t*)(p.ws + OFF_GKF) + (size_t)(b * 2 + kvh) * 512 * KVT + lane * 8;
        const bf16_t* vf = (const bf16_t*)(p.ws + OFF_GVF) + (size_t)(b * 2 + kvh) * 512 * KVT + lane * 8;
        const bf16_t* kc_ = (const bf16_t*)(p.ws + OFF_GKFC) + (size_t)(b * 2 + kvh) * 16 * KVT + lane * 8;
        const bf16_t* vc_ = (const bf16_t*)(p.ws + OFF_GVFC) + (size_t)(b * 2 + kvh) * 16 * KVT + lane * 8;
        const int qi = q0i + fr;
#define GQ_LOAD(i, F) do { const int i_ = (i); if (i_ < 9) { const int kt_ = (q0i - 128 + i_ * 32) >> 4; const int ta_ = min(max(kt_, 0), 511), tb_ = min(max(kt_ + 1, 0), 511); \
            kv_load(kf + (size_t)ta_ * KVT, kf + (size_t)tb_ * KVT, vf + (size_t)ta_ * KVT, vf + (size_t)tb_ * KVT, F); } \
        else { const int c_ = (i_ - 9) * 2; kv_load(kc_ + (size_t)c_ * KVT, kc_ + (size_t)(c_ + 1) * KVT, vc_ + (size_t)c_ * KVT, vc_ + (size_t)(c_ + 1) * KVT, F); } } while (0)
#define GQ_APPLY(i, F) do { const int i_ = (i); f32x4 b0_ = z4, b1_ = z4; if (i_ < 9) { const int kb_ = q0i - 128 + i_ * 32; _Pragma("unroll") for (int j = 0; j < 4; ++j) { const int k0_ = kb_ + g * 4 + j, k1_ = k0_ + 16; \
                b0_[j] = (k0_ >= 0 && k0_ < S && k0_ >= qi - 128 && k0_ <= qi + 128) ? 0.f : -INFINITY; b1_[j] = (k1_ >= 0 && k1_ < S && k1_ >= qi - 128 && k1_ <= qi + 128) ? 0.f : -INFINITY; } } \
            attn_apply(F, qa0, qa1, b0_, b1_, sa); attn_apply(F, qb0, qb1, b0_, b1_, sb); attn_apply(F, qc0, qc1, b0_, b1_, sc); } while (0)
        KVFrag f2;
        const int i0 = lat ? 0 : 9;
        GQ_LOAD(i0, f);
#pragma unroll 1
        for (int i = i0; i < 17; i += 2) {
            if (i + 1 < 17) GQ_LOAD(i + 1, f2);
            GQ_APPLY(i, f);
            if (i + 1 < 17) { if (i + 2 < 17) GQ_LOAD(i + 2, f); GQ_APPLY(i + 1, f2); }
        }
#undef GQ_LOAD
#undef GQ_APPLY
        bf16_t* o = X1 + (size_t)R * D + 640 + kvh * 192 + g * 4;
        attn_store(sa, o, p.gqa_sink[l * 6 + kvh * 3 + 0] * LOG2E); attn_store(sb, o + 64, p.gqa_sink[l * 6 + kvh * 3 + 1] * LOG2E); attn_store(sc, o + 128, p.gqa_sink[l * 6 + kvh * 3 + 2] * LOG2E);
    } else {
        const int t3 = tk - NTASK_NA - NTASK_GQ, qt = t3 & 15, hb = t3 >> 4, h = hb % 6, b = hb / 6;
        const int R = NLAT + b * CTX + qt * 16 + fr;
        const bf16_t* qp = P + (size_t)R * PWS + COL_NAQ + h * 64 + g * 8;
        const bf16x8 q0 = ld16(qp), q1 = ld16(qp + 32);
        AttnState st; attn_init(st);
        const bf16_t* kc_ = (const bf16_t*)(p.ws + OFF_NAKFC) + (size_t)(b * 6 + h) * 16 * KVT + lane * 8;
        const bf16_t* vc_ = (const bf16_t*)(p.ws + OFF_NAVFC) + (size_t)(b * 6 + h) * 16 * KVT + lane * 8;
#pragma unroll
        for (int pp = 0; pp < 8; ++pp) { kv_load(kc_ + (size_t)(2 * pp) * KVT, kc_ + (size_t)(2 * pp + 1) * KVT, vc_ + (size_t)(2 * pp) * KVT, vc_ + (size_t)(2 * pp + 1) * KVT, f); attn_apply(f, q0, q1, z4, z4, st); }
        attn_store(st, X1 + (size_t)R * D + 256 + h * 64 + g * 4, -INFINITY);
    }
}
DEV void ph_attn(const Params& p, int l, float* rpb2  ) {
    for (int i = tid_(); i < 6 * 15 * 31; i += 256) rpb2[i] = p.na_rpb[(size_t)l * 6 * 15 * 31 + i] * LOG2E;
    __syncthreads();
    const int w = tid_() >> 6;
    const int ntask = NTASK_NA + NTASK_GQ + (l == 0 ? NTASK_CNA + NTASK_CGQ : 0);
    for (int tk0 = bid_() * 4 + w; tk0 < ntask; tk0 += gridDim.x * 4) {
        const int tk = tk0 < NTASK_GQ ? NTASK_NA + tk0 : (tk0 < NTASK_GQ + NTASK_NA ? tk0 - NTASK_GQ : tk0);
        attn_task(p, l, tk, rpb2);
    }
}

template <int CTRL> DEV float dppf(float old, float v) { return __builtin_bit_cast(float, __builtin_amdgcn_update_dpp(__builtin_bit_cast(int, old), __builtin_bit_cast(int, v), CTRL, 0xf, 0xf, false)); }
template <bool FWD> DEV void row_scan(float& a, float& b) {
#define RG_STEP(SHR, SHL) { const float ap = FWD ? dppf<SHR>(1.f, a) : dppf<SHL>(1.f, a); const float bp = FWD ? dppf<SHR>(0.f, b) : dppf<SHL>(0.f, b); b = fmaf(a, bp, b); a = a * ap; }
    RG_STEP(0x111, 0x101) RG_STEP(0x112, 0x102) RG_STEP(0x114, 0x104) RG_STEP(0x118, 0x108)
#undef RG_STEP
}
DEV int rg_bwd_chunk(int pos) { return pos == 0 ? 1 : (pos == 1 ? 0 : 67 - pos); }
DEV void rg_coef(const f32x4& za, const f32x4& zi, const f32x4& ba, const f32x4& bi, const f32x4& spc, const f32x4& xv, f32x4& a, f32x4& b) {
#pragma unroll
    for (int j = 0; j < 4; ++j) {
        const float r = 1.f / (1.f + __expf(-(za[j] + ba[j])));
        const float ig = 1.f / (1.f + __expf(-(zi[j] + bi[j])));
        const float la = spc[j] * r;
        const float av = __expf(la);
        const float x2 = 2.f * la;
        float om = x2 * (1.f / 720.f) + (1.f / 120.f); om = om * x2 + (1.f / 24.f); om = om * x2 + (1.f / 6.f); om = om * x2 + 0.5f; om = om * x2 + 1.f; om = -x2 * om;
        if (x2 < -0.25f) om = 1.f - av * av;
        a[j] = av; b[j] = sqrtf(om) * (ig * xv[j]);
    }
}
DEV void rg_item(const Params& p, int l, int rt, bf16_t* lds) {
    const int t = tid_(), lane = t & 63, n = t >> 6, g = lane >> 4, fr = lane & 15;
    const bf16_t* P = (const bf16_t*)(p.ws + OFF_P);
    const bool isctx = rt >= 512;
    const int b = isctx ? (rt - 512) >> 1 : rt >> 6, idx = isctx ? (rt - 512) & 1 : 2 + (rt & 63);
    const int L = isctx ? CTX : S, t0 = isctx ? idx * 128 : (idx - 2) * 128, seqbase = isctx ? NLAT + b * CTX : b * S;
    bf16_t* xl = lds + n * (128 * 64);
    {
        const int c = lane & 7, ch0 = n * 64 + c * 8;
        f32x4 cwa[4], cwb[4];
#pragma unroll
        for (int j = 0; j < 4; ++j) { cwa[j] = *(const f32x4*)(p.conv_w + (l * 4 + j) * 256 + ch0); cwb[j] = *(const f32x4*)(p.conv_w + (l * 4 + j) * 256 + ch0 + 4); }
        const f32x4 cba = *(const f32x4*)(p.conv_b + l * 256 + ch0), cbb = *(const f32x4*)(p.conv_b + l * 256 + ch0 + 4);
#pragma unroll 2
        for (int it = 0; it < 16; ++it) {
            const int tok = it * 8 + (lane >> 3), ts = t0 + tok;
            f32x4 acca = cba, accb = cbb;
#pragma unroll
            for (int j = 0; j < 4; ++j) {
                const int tj = ts + j - 2;
                if (tj >= 0 && tj < L) {
                    const uint4 v = *(const uint4*)(P + (size_t)(seqbase + tj) * PWS + COL_RGX + ch0);
                    const f32x4 xa = {__uint_as_float(v.x << 16), __uint_as_float(v.x & 0xffff0000u), __uint_as_float(v.y << 16), __uint_as_float(v.y & 0xffff0000u)};
                    const f32x4 xb = {__uint_as_float(v.z << 16), __uint_as_float(v.z & 0xffff0000u), __uint_as_float(v.w << 16), __uint_as_float(v.w & 0xffff0000u)};
                    acca = acca + cwa[j] * xa; accb = accb + cwb[j] * xb;
                }
            }
            uint4 o; o.x = pk2(acca[0], acca[1]); o.y = pk2(acca[2], acca[3]); o.z = pk2(accb[0], accb[1]); o.w = pk2(accb[2], accb[3]);
            *(uint4*)(xl + tok * 64 + ((c ^ ((tok >> 1) & 7)) * 8)) = o;
        }
    }
    asm volatile("s_waitcnt lgkmcnt(0)" ::: "memory");
    const bf16_t* W = (const bf16_t*)(p.ws + OFF_WRG) + (size_t)(l * 2) * 2 * 4 * 64 * 64;
    const float* C = (const float*)(p.ws + OFF_RGC) + (size_t)(l * 2) * 3 * 256;
    float* AGG = (float*)(p.ws + OFF_AGG) + (size_t)(b * 66) * 1024;
    const int swz = (fr >> 1) & 7;
#pragma unroll 1
    for (int ct = 0; ct < 4; ++ct) {
        const int ch = n * 64 + ct * 16 + g * 4;
        const f32x4 z4 = {0.f, 0.f, 0.f, 0.f};
#pragma unroll
        for (int dir = 0; dir < 2; ++dir) {
            const bf16x8 wa0 = ld16(W + ((size_t)((dir * 2 + 0) * 4 + n) * 64 + ct * 16 + fr) * 64 + g * 8), wa1 = ld16(W + ((size_t)((dir * 2 + 0) * 4 + n) * 64 + ct * 16 + fr) * 64 + 32 + g * 8);
            const bf16x8 wi0 = ld16(W + ((size_t)((dir * 2 + 1) * 4 + n) * 64 + ct * 16 + fr) * 64 + g * 8), wi1 = ld16(W + ((size_t)((dir * 2 + 1) * 4 + n) * 64 + ct * 16 + fr) * 64 + 32 + g * 8);
            const f32x4 ba = *(const f32x4*)(C + (dir * 3 + 0) * 256 + ch), bi = *(const f32x4*)(C + (dir * 3 + 1) * 256 + ch), spc = *(const f32x4*)(C + (dir * 3 + 2) * 256 + ch);
            f32x4 hin = z4, apre = {1.f, 1.f, 1.f, 1.f};
#pragma unroll
            for (int s = 0; s < 8; ++s) {
                const int tt = dir == 0 ? s : 7 - s;
                const int row = tt * 16 + fr;
                const bf16x8 x0 = *(const bf16x8*)(xl + row * 64 + ((g ^ swz) * 8)), x1 = *(const bf16x8*)(xl + row * 64 + (((g | 4) ^ swz) * 8));
                f32x4 za = __builtin_amdgcn_mfma_f32_16x16x32_bf16(wa0, x0, z4, 0, 0, 0); za = __builtin_amdgcn_mfma_f32_16x16x32_bf16(wa1, x1, za, 0, 0, 0);
                f32x4 zi = __builtin_amdgcn_mfma_f32_16x16x32_bf16(wi0, x0, z4, 0, 0, 0); zi = __builtin_amdgcn_mfma_f32_16x16x32_bf16(wi1, x1, zi, 0, 0, 0);
                const uint2 xr = *(const uint2*)(xl + row * 64 + (((ct * 2 + (g >> 1)) ^ swz) * 8) + (g & 1) * 4);
                const f32x4 xv = {__uint_as_float(xr.x << 16), __uint_as_float(xr.x & 0xffff0000u), __uint_as_float(xr.y << 16), __uint_as_float(xr.y & 0xffff0000u)};
                f32x4 a, bb;
                rg_coef(za, zi, ba, bi, spc, xv, a, bb);
                f32x4 h, ac;
#pragma unroll
                for (int j = 0; j < 4; ++j) {
                    float aj = a[j], bj = bb[j];
                    if (dir == 0) row_scan<true>(aj, bj); else row_scan<false>(aj, bj);
                    h[j] = fmaf(aj, hin[j], bj);
                    ac[j] = aj * apre[j];
                }
                {
                    bf16_t* xo = (bf16_t*)(p.ws + OFF_X2) + ((size_t)seqbase + t0 + row) * D + dir * 512 + ch;
                    uint2 o; o.x = pk2(ac[0], ac[1]); o.y = pk2(ac[2], ac[3]); *(uint2*)xo = o;
                    o.x = pk2(h[0], h[1]); o.y = pk2(h[2], h[3]); *(uint2*)(xo + 256) = o;
                }
                const int src = (lane & 48) | (dir == 0 ? 15 : 0);
#pragma unroll
                for (int j = 0; j < 4; ++j) { hin[j] = shl_(h[j], src); apre[j] = shl_(ac[j], src); }
            }
            if (fr == 0) { *(f32x4*)(AGG + (size_t)(idx * 2 + dir) * 512 + ch) = apre; *(f32x4*)(AGG + (size_t)(idx * 2 + dir) * 512 + 256 + ch) = hin; }
        }
    }
}
DEV void rg_final(const Params& p, int l, int rt, float* part  ) {
    const int t = tid_(), cg4 = (t & 63) * 4, tp = t >> 6;
    const bool isctx = rt >= 512;
    const int b = isctx ? (rt - 512) >> 1 : rt >> 6, idx = isctx ? (rt - 512) & 1 : 2 + (rt & 63);
    const float* AGG = (const float*)(p.ws + OFF_AGG) + (size_t)(b * 66) * 1024;
    f32x4 hf = {0.f, 0.f, 0.f, 0.f}, hb = {0.f, 0.f, 0.f, 0.f};
    {
        const int nf = idx, nb = idx == 1 ? 0 : (idx == 0 ? 1 : 67 - idx);
        const int qf = (nf + 3) >> 2, qb = (nb + 3) >> 2;
        f32x4 Af = {1.f, 1.f, 1.f, 1.f}, Bf = {0.f, 0.f, 0.f, 0.f}, Ab = Af, Bb = Bf;
#pragma unroll 4
        for (int q = tp * qf; q < min((tp + 1) * qf, nf); ++q) { const f32x4 A = *(const f32x4*)(AGG + (size_t)(q * 2) * 512 + cg4), B = *(const f32x4*)(AGG + (size_t)(q * 2) * 512 + 256 + cg4); Bf = A * Bf + B; Af = A * Af; }
#pragma unroll 4
        for (int q = tp * qb; q < min((tp + 1) * qb, nb); ++q) { const int cq = rg_bwd_chunk(q); const f32x4 A = *(const f32x4*)(AGG + (size_t)(cq * 2 + 1) * 512 + cg4), B = *(const f32x4*)(AGG + (size_t)(cq * 2 + 1) * 512 + 256 + cg4); Bb = A * Bb + B; Ab = A * Ab; }
        *(f32x4*)(part + ((tp * 2 + 0) * 2 + 0) * 256 + cg4) = Af; *(f32x4*)(part + ((tp * 2 + 0) * 2 + 1) * 256 + cg4) = Bf;
        *(f32x4*)(part + ((tp * 2 + 1) * 2 + 0) * 256 + cg4) = Ab; *(f32x4*)(part + ((tp * 2 + 1) * 2 + 1) * 256 + cg4) = Bb;
        __syncthreads();
#pragma unroll
        for (int k = 0; k < 4; ++k) {
            hf = *(const f32x4*)(part + ((k * 2 + 0) * 2 + 0) * 256 + cg4) * hf + *(const f32x4*)(part + ((k * 2 + 0) * 2 + 1) * 256 + cg4);
            hb = *(const f32x4*)(part + ((k * 2 + 1) * 2 + 0) * 256 + cg4) * hb + *(const f32x4*)(part + ((k * 2 + 1) * 2 + 1) * 256 + cg4);
        }
    }
    const bf16_t* X2 = (const bf16_t*)(p.ws + OFF_X2); const bf16_t* P = (const bf16_t*)(p.ws + OFF_P); bf16_t* X1 = (bf16_t*)(p.ws + OFF_X1);
#pragma unroll 4
    for (int i = 0; i < 32; ++i) {
        const size_t R = (size_t)rt * 128 + i * 4 + tp;
        const uint2 af = *(const uint2*)(X2 + R * D + cg4), bf = *(const uint2*)(X2 + R * D + 256 + cg4), ab = *(const uint2*)(X2 + R * D + 512 + cg4), bb = *(const uint2*)(X2 + R * D + 768 + cg4);
        const uint2 gr = *(const uint2*)(P + R * PWS + COL_GATE + cg4);
#define BLO(u) __uint_as_float((u) << 16)
#define BHI(u) __uint_as_float((u) & 0xffff0000u)
        const float h0 = (BLO(af.x) * hf[0] + BLO(bf.x)) + (BLO(ab.x) * hb[0] + BLO(bb.x));
        const float h1 = (BHI(af.x) * hf[1] + BHI(bf.x)) + (BHI(ab.x) * hb[1] + BHI(bb.x));
        const float h2 = (BLO(af.y) * hf[2] + BLO(bf.y)) + (BLO(ab.y) * hb[2] + BLO(bb.y));
        const float h3 = (BHI(af.y) * hf[3] + BHI(bf.y)) + (BHI(ab.y) * hb[3] + BHI(bb.y));
        uint2 o; o.x = pk2(h0 * gelu_tanh(BLO(gr.x)), h1 * gelu_tanh(BHI(gr.x))); o.y = pk2(h2 * gelu_tanh(BLO(gr.y)), h3 * gelu_tanh(BHI(gr.y)));
#undef BLO
#undef BHI
        *(uint2*)(X1 + R * D + cg4) = o;
    }
}
DEV void ph_rgagg(const Params& p, int l, bf16_t* lds) {
    for (int rt = bid_(); rt < 528; rt += gridDim.x) { rg_item(p, l, rt, lds); __syncthreads(); }
}

DEV void outproj_item(const Params& p_, int l, int rt, bf16_t* lds, float* stat  ) {
    const Params& p = kp_();
    const int t = tid_(), lane = t & 63, w = t >> 6, wm = w >> 1, wn = w & 1, fq = lane >> 4, fr = lane & 15;
    const bf16_t* A = (const bf16_t*)(p.ws + OFF_X1) + (size_t)(rt * 128) * D;
    const bool isctx = rt >= 512;
    const float* g1 = modvec(p, l, rt * 128, 2);
    __syncthreads();
    rg_final(p, l, rt, (float*)lds);
    asm volatile("s_waitcnt vmcnt(0)" ::: "memory");
    __syncthreads();
    __builtin_amdgcn_fence(__ATOMIC_ACQUIRE, "agent");
#pragma unroll 1
    for (int pass = 0; pass < 4; ++pass) {
        const bf16_t* Bt = (const bf16_t*)(p.ws + OFF_WOUTT) + ((size_t)l * 1024 + pass * 256) * 1024;
        const unsigned toff = (unsigned)(((tid_() >> 2) * 1024 + gemm_src_chunk(tid_())) * 2);
        f32x4 acc[4][8]; zero_acc(acc);
        gemm_mainloop(A, toff, toff + 64 * D * 2, Bt, toff, 1024, 32, lds, acc);
#pragma unroll
        for (int mt = 0; mt < 4; ++mt) {
            const int rl = wm * 64 + mt * 16 + fr, R = rt * 128 + rl;
            const float* xin = (l == 0) ? (isctx ? p.ctx + (size_t)(R - NLAT) * D : p.x + (size_t)R * D) : xres_row(p, R);
            float* xo = xres_row(p, R);
            float s = 0.f, q = 0.f;
#pragma unroll
            for (int nt = 0; nt < 8; ++nt) {
                const int col = pass * 256 + wn * 128 + nt * 16 + fq * 4;
                const f32x4 xv = *(const f32x4*)(xin + col), gv = *(const f32x4*)(g1 + col);
                const f32x4 u = xv * ALPHA + gv * acc[mt][nt];
                *(f32x4*)(xo + col) = u;
                s += (u[0] + u[1]) + (u[2] + u[3]); q += (u[0] * u[0] + u[1] * u[1]) + (u[2] * u[2] + u[3] * u[3]);
            }
            s += shx(s, 16); s += shx(s, 32); q += shx(q, 16); q += shx(q, 32);
            if (fq == 0) { float* sp = stat + (wn * 128 + rl) * 2; if (pass == 0) { sp[0] = s; sp[1] = q; } else { sp[0] += s; sp[1] += q; } }
        }
    }
    asm volatile("s_waitcnt vmcnt(0)" ::: "memory");
    __syncthreads();
    __builtin_amdgcn_fence(__ATOMIC_ACQUIRE, "agent");
    {
        bf16_t* X2 = (bf16_t*)(p.ws + OFF_X2);
        const bf16_t* WRh = (const bf16_t*)(p.ws + OFF_WR) + (size_t)(l * 2) * 48 * 1024 + (size_t)fr * 1024 + fq * 8;
        const bf16_t* WRl = WRh + 48 * 1024;
        float* vec = (float*)((unsigned char*)lds + 24576);
        {
            const float* lg = p.ln1_g + l * D; const float* lb = p.ln1_b + l * D;
            const float* sh2 = modvec(p, l, rt * 128, 3); const float* sc2 = modvec(p, l, rt * 128, 4);
            const int k4 = t * 4;
            *(f32x4*)(vec + k4) = *(const f32x4*)(lg + k4); *(f32x4*)(vec + 1024 + k4) = *(const f32x4*)(lb + k4);
            *(f32x4*)(vec + 2048 + k4) = *(const f32x4*)(sc2 + k4) + 1.f; *(f32x4*)(vec + 3072 + k4) = *(const f32x4*)(sh2 + k4);
        }
        float mean[2], rstd[2];
#pragma unroll
        for (int tm = 0; tm < 2; ++tm) {
            const int rl = w * 32 + tm * 16 + fr;
            float s = 0.f, q = 0.f;
#pragma unroll
            for (int i = 0; i < 2; ++i) { s += stat[(i * 128 + rl) * 2]; q += stat[(i * 128 + rl) * 2 + 1]; }
            mean[tm] = s * (1.f / D);
            rstd[tm] = rsqrtf(fmaxf(q * (1.f / D) - mean[tm] * mean[tm], 0.f) + LN_EPS);
        }
        __syncthreads();
        float* xr0 = xres_row(p, rt * 128 + w * 32 + fr) + fq * 8;
        float* xr1 = xres_row(p, rt * 128 + w * 32 + 16 + fr) + fq * 8;
        bf16_t* h20 = X2 + (size_t)(rt * 128 + w * 32 + fr) * D + fq * 8; bf16_t* h21 = h20 + (size_t)16 * D;
        f32x4 lacc[3][2];
#pragma unroll
        for (int a = 0; a < 3; ++a) { lacc[a][0] = (f32x4){0.f, 0.f, 0.f, 0.f}; lacc[a][1] = (f32x4){0.f, 0.f, 0.f, 0.f}; }
        f32x4 nu00 = *(const f32x4*)xr0, nu01 = *(const f32x4*)(xr0 + 4), nu10 = *(const f32x4*)xr1, nu11 = *(const f32x4*)(xr1 + 4);
        bf16x8 nwh0 = *(const bf16x8*)(WRh), nwh1 = *(const bf16x8*)(WRh + 16 * 1024), nwh2 = *(const bf16x8*)(WRh + 32 * 1024);
        bf16x8 nwl0 = *(const bf16x8*)(WRl), nwl1 = *(const bf16x8*)(WRl + 16 * 1024), nwl2 = *(const bf16x8*)(WRl + 32 * 1024);
#pragma unroll 2
        for (int ks = 0; ks < 32; ++ks) {
            const f32x4 u00 = nu00, u01 = nu01, u10 = nu10, u11 = nu11;
            const bf16x8 wh0 = nwh0, wh1 = nwh1, wh2 = nwh2, wl0 = nwl0, wl1 = nwl1, wl2 = nwl2;
            if (ks + 1 < 32) {
                const int ko = (ks + 1) * 32;
                nu00 = *(const f32x4*)(xr0 + ko); nu01 = *(const f32x4*)(xr0 + ko + 4); nu10 = *(const f32x4*)(xr1 + ko); nu11 = *(const f32x4*)(xr1 + ko + 4);
                nwh0 = *(const bf16x8*)(WRh + ko); nwh1 = *(const bf16x8*)(WRh + 16 * 1024 + ko); nwh2 = *(const bf16x8*)(WRh + 32 * 1024 + ko);
                nwl0 = *(const bf16x8*)(WRl + ko); nwl1 = *(const bf16x8*)(WRl + 16 * 1024 + ko); nwl2 = *(const bf16x8*)(WRl + 32 * 1024 + ko);
            }
            const int k = ks * 32 + fq * 8;
            const f32x4 g0 = *(const f32x4*)(vec + k), g1v = *(const f32x4*)(vec + k + 4), b0 = *(const f32x4*)(vec + 1024 + k), b1 = *(const f32x4*)(vec + 1024 + k + 4);
            const f32x4 c0 = *(const f32x4*)(vec + 2048 + k), c1 = *(const f32x4*)(vec + 2048 + k + 4), s0 = *(const f32x4*)(vec + 3072 + k), s1 = *(const f32x4*)(vec + 3072 + k + 4);
            bf16x8 hh0, hl0, hh1, hl1;
            {
                const f32x4 x0 = (u00 - mean[0]) * rstd[0] * g0 + b0, x1 = (u01 - mean[0]) * rstd[0] * g1v + b1;
                *(f32x4*)(xr0 + ks * 32) = x0; *(f32x4*)(xr0 + ks * 32 + 4) = x1;
                const f32x4 h0 = x0 * c0 + s0, h1 = x1 * c1 + s1;
#pragma unroll
                for (int e = 0; e < 4; ++e) { const bf16_t a = f2bf(h0[e]), b = f2bf(h1[e]); hh0[e] = (short)a; hh0[4 + e] = (short)b; hl0[e] = (short)f2bf(h0[e] - bf2f(a)); hl0[4 + e] = (short)f2bf(h1[e] - bf2f(b)); }
                *(bf16x8*)(h20 + ks * 32) = hh0;
            }
            {
                const f32x4 x0 = (u10 - mean[1]) * rstd[1] * g0 + b0, x1 = (u11 - mean[1]) * rstd[1] * g1v + b1;
                *(f32x4*)(xr1 + ks * 32) = x0; *(f32x4*)(xr1 + ks * 32 + 4) = x1;
                const f32x4 h0 = x0 * c0 + s0, h1 = x1 * c1 + s1;
#pragma unroll
                for (int e = 0; e < 4; ++e) { const bf16_t a = f2bf(h0[e]), b = f2bf(h1[e]); hh1[e] = (short)a; hh1[4 + e] = (short)b; hl1[e] = (short)f2bf(h0[e] - bf2f(a)); hl1[4 + e] = (short)f2bf(h1[e] - bf2f(b)); }
                *(bf16x8*)(h21 + ks * 32) = hh1;
            }
#define RT_MMA(ft, WH, WL) do { \
            lacc[ft][0] = __builtin_amdgcn_mfma_f32_16x16x32_bf16(WH, hh0, lacc[ft][0], 0, 0, 0); lacc[ft][0] = __builtin_amdgcn_mfma_f32_16x16x32_bf16(WL, hh0, lacc[ft][0], 0, 0, 0); lacc[ft][0] = __builtin_amdgcn_mfma_f32_16x16x32_bf16(WH, hl0, lacc[ft][0], 0, 0, 0); \
            lacc[ft][1] = __builtin_amdgcn_mfma_f32_16x16x32_bf16(WH, hh1, lacc[ft][1], 0, 0, 0); lacc[ft][1] = __builtin_amdgcn_mfma_f32_16x16x32_bf16(WL, hh1, lacc[ft][1], 0, 0, 0); lacc[ft][1] = __builtin_amdgcn_mfma_f32_16x16x32_bf16(WH, hl1, lacc[ft][1], 0, 0, 0); } while (0)
            RT_MMA(0, wh0, wl0); RT_MMA(1, wh1, wl1); RT_MMA(2, wh2, wl2);
#undef RT_MMA
        }
        __syncthreads();
        float* lt = (float*)lds;
        int* lcnt = (int*)((unsigned char*)lds + 24576); int* lbase = lcnt + 32;
        if (t < 32) lcnt[t] = 0;
#pragma unroll
        for (int ft = 0; ft < 3; ++ft)
#pragma unroll
            for (int tm = 0; tm < 2; ++tm)
#pragma unroll
                for (int j = 0; j < 4; ++j) lt[(w * 32 + tm * 16 + fr) * 48 + ft * 16 + fq * 4 + j] = lacc[ft][tm][j];
        __syncthreads();
        int E0 = 0, E1 = 0, r0 = 0, r1 = 0; float w0 = 0.f, w1 = 0.f;
        const int rl = w * 32 + (lane & 31), R = rt * 128 + rl;
        if (lane < 32) {
            const float* lr = lt + rl * 48;
            int gi = 0; float gm = lr[0] + p.router_g_b[l * 4];
            float gl[4]; gl[0] = gm;
#pragma unroll
            for (int j = 1; j < 4; ++j) { gl[j] = lr[j] + p.router_g_b[l * 4 + j]; if (gl[j] > gm) { gm = gl[j]; gi = j; } }
            float gs = 0.f;
#pragma unroll
            for (int j = 0; j < 4; ++j) gs += expf(gl[j] - gm);
            const float ptop = 1.f / gs;
            int e0 = 0, e1 = 0; float m0 = -INFINITY, m1 = -INFINITY;
            for (int j = 0; j < 8; ++j) {
                const float v = lr[4 + gi * 8 + j] + p.router_e_b[l * 32 + gi * 8 + j];
                if (v > m0) { m1 = m0; e1 = e0; m0 = v; e0 = j; } else if (v > m1) { m1 = v; e1 = j; }
            }
            const float ex = expf(m1 - m0);
            w0 = ptop / (1.f + ex); w1 = ptop * ex / (1.f + ex);
            E0 = gi * 8 + e0; E1 = gi * 8 + e1;
            r0 = atomicAdd(lcnt + E0, 1); r1 = atomicAdd(lcnt + E1, 1);
        }
        __syncthreads();
        if (t < 32) { const int c = lcnt[t]; lbase[t] = c ? (int)atomicAdd((unsigned*)(p.ws + OFF_CTL) + CW_CNT + l * 32 + t, (unsigned)c) : 0; }
        __syncthreads();
        if (lane < 32) {
            int* rte = (int*)(p.ws + OFF_RTE); float* rtw = (float*)(p.ws + OFF_RTW);
            int* list = (int*)(p.ws + OFF_LIST);
            rte[R * 2] = E0; rte[R * 2 + 1] = E1; rtw[R * 2] = w0; rtw[R * 2 + 1] = w1;
            list[(size_t)E0 * LISTCAP + lbase[E0] + r0] = R * 2;
            list[(size_t)E1 * LISTCAP + lbase[E1] + r1] = R * 2 + 1;
        }
    }
}
DEV void ph_outproj(const Params& p, int l, bf16_t* lds, float* stat  ) {
    for (int rt = bid_(); rt < 512; rt += gridDim.x) { outproj_item(p, l, rt, lds, stat); __syncthreads(); }
}

DEV void moe1_item(const Params& p_, int l, int e, int jb, int pass, int item, int cnt, bf16_t* lds) {
    const Params& p = kp_();
    const int t = tid_(), lane = t & 63, w = t >> 6, wm = w >> 1, wn = w & 1, fq = lane >> 4, fr = lane & 15;
    const int* list = (const int*)(p.ws + OFF_LIST) + (size_t)e * LISTCAP;
    const bf16_t* X2 = (const bf16_t*)(p.ws + OFF_X2);
    bf16_t* Hs = (bf16_t*)(p.ws + OFF_P) + (size_t)item * 128 * FF;
    unsigned ao0, ao1;
    { const int s0 = jb * 128 + (t >> 2), s1 = s0 + 64;
      const int tok0 = s0 < cnt ? (list[s0] >> 1) : 0, tok1 = s1 < cnt ? (list[s1] >> 1) : 0;
      ao0 = (unsigned)((tok0 * D + gemm_src_chunk(t)) * 2); ao1 = (unsigned)((tok1 * D + gemm_src_chunk(t)) * 2); }
    const bf16_t* Bt = (const bf16_t*)(p.ws + OFF_WGU) + ((size_t)e * 1024 + pass * 256) * 1024;
    f32x4 acc[4][8]; zero_acc(acc);
    gemm_mainloop(X2, ao0, ao1, Bt, (unsigned)(((t >> 2) * 1024 + gemm_src_chunk(t)) * 2), 1024, 32, lds, acc);
#pragma unroll
    for (int mt = 0; mt < 4; ++mt) {
        const int rl = wm * 64 + mt * 16 + fr;
#pragma unroll
        for (int nt = 0; nt < 4; ++nt) {
            const f32x4 gv = acc[mt][nt], uv = acc[mt][nt + 4];
            float hv[4];
#pragma unroll
            for (int jj = 0; jj < 4; ++jj) hv[jj] = gv[jj] / (1.f + __expf(-gv[jj])) * uv[jj];
            uint2 o; o.x = pk2(hv[0], hv[1]); o.y = pk2(hv[2], hv[3]);
            *(uint2*)(Hs + (size_t)rl * FF + pass * 128 + wn * 64 + nt * 16 + fq * 4) = o;
        }
    }
}
DEV void moe2_item(const Params& p_, int l, int e, int jb, int pass, int item, int cnt, bf16_t* lds) {
    const Params& p = kp_();
    const int t = tid_(), lane = t & 63, w = t >> 6, wm = w >> 1, wn = w & 1, fq = lane >> 4, fr = lane & 15;
    const int* list = (const int*)(p.ws + OFF_LIST) + (size_t)e * LISTCAP;
    const bf16_t* Hs = (const bf16_t*)(p.ws + OFF_P) + (size_t)item * 128 * FF;
    const unsigned hoff = (unsigned)(((t >> 2) * FF + gemm_src_chunk(t)) * 2);
    const float* rtw = (const float*)(p.ws + OFF_RTW);
    bf16_t* Y = (bf16_t*)(p.ws + OFF_Y);
    const bf16_t* Bt = (const bf16_t*)(p.ws + OFF_WD) + ((size_t)e * 1024 + pass * 256) * FF;
    f32x4 acc[4][8]; zero_acc(acc);
    gemm_mainloop(Hs, hoff, hoff + 64 * FF * 2, Bt, hoff, FF, 16, lds, acc);
#pragma unroll
    for (int mt = 0; mt < 4; ++mt) {
        const int s = jb * 128 + wm * 64 + mt * 16 + fr;
        if (s < cnt) {
            const int ent = list[s];
            const float gw = rtw[ent];
            bf16_t* yo = Y + (size_t)ent * D + pass * 256 + wn * 128 + fq * 4;
#pragma unroll
            for (int nt = 0; nt < 8; ++nt) { const f32x4 v = acc[mt][nt] * gw; uint2 o; o.x = pk2(v[0], v[1]); o.y = pk2(v[2], v[3]); *(uint2*)(yo + nt * 16) = o; }
        }
    }
}
template <int STAGE> DEV void ph_moe(const Params& p, int l, bf16_t* lds, int* s_pref  , int* s_cnt  ) {
    const unsigned* cnt = (const unsigned*)(p.ws + OFF_CTL) + CW_CNT + l * 32;
    if (tid_() == 0) { int a = 0; for (int e = 0; e < 32; ++e) { const int c = (int)cnt[e]; s_cnt[e] = c; s_pref[e] = a; a += (c + 127) >> 7; } s_pref[32] = a; }
    __syncthreads();
    const int nx = gridDim.x >> 3, xcd = bid_() & 7, j = bid_() >> 3;
    if (bid_() < nx * 8) {
        const int n0 = (s_cnt[xcd] + 127) >> 7, n1 = (s_cnt[xcd + 8] + 127) >> 7, n2 = (s_cnt[xcd + 16] + 127) >> 7, n3 = (s_cnt[xcd + 24] + 127) >> 7;
        const int nloc = (n0 + n1 + n2 + n3) * 4;
        for (int i = j; i < nloc; i += nx) {
            const int pass = i & 3, ib = i >> 2;
            int e, jb;
            if (ib < n0) { e = xcd; jb = ib; } else if (ib < n0 + n1) { e = xcd + 8; jb = ib - n0; } else if (ib < n0 + n1 + n2) { e = xcd + 16; jb = ib - n0 - n1; } else { e = xcd + 24; jb = ib - n0 - n1 - n2; }
            if (STAGE == 1) moe1_item(p, l, e, jb, pass, s_pref[e] + jb, s_cnt[e], lds); else moe2_item(p, l, e, jb, pass, s_pref[e] + jb, s_cnt[e], lds);
        }
    }
    __syncthreads();
}

DEV void ph_rowin(const Params& p, int l, bf16_t* lds, int* slot, int ph) {
    const int np = l == 0 ? 9 : 5, nci = 16 * np, ntot = nci + 1024;
    unsigned* ctr = (unsigned*)(p.ws + OFF_CTL) + CW_Q + ph * 8;
    const int w = tid_() >> 6;
    for (;;) {
        const int it = q_pull(ctr, slot);
        if (it >= ntot) break;
        if (it < nci) {
            const int rt = 512 + it / np, pass = it % np;
            for (int r = w * 2; r < 128; r += 8) { if (l == 0) rowop<0, true>(p, 0, rt * 128 + r); else rowop<1, false>(p, 1, rt * 128 + r); }
            asm volatile("s_waitcnt vmcnt(0)" ::: "memory");
            __syncthreads();
            __builtin_amdgcn_fence(__ATOMIC_ACQUIRE, "agent");
            inproj_item(p, l, rt, pass, lds);
        } else {
            const int r0 = (it - nci) * 64;
            for (int r = w * 2; r < 64; r += 8) { if (l == 0) rowop<0, true>(p, 0, r0 + r); else rowop<1, true>(p, 1, r0 + r); }
        }
    }
}
DEV void ph_inproj2(const Params& p, int l, bf16_t* lds, int* slot, int ph) {
    const int xcd = bid_() & 7;
    unsigned* ctr = (unsigned*)(p.ws + OFF_CTL) + CW_Q + ph * 8 + xcd;
    const int ntot = 2 + 576 + (l == 0 ? 32 : 0);
    int it = q_pull(ctr, slot);
    while (it < ntot) {
        int nreg = 0;
        if (tid_() == 0) nreg = (int)atomicAdd(ctr, 1u);
        if (it < 2) { rg_item(p, l, 512 + 2 * xcd + it, lds); }
        else if (it < 578) { const int i = it - 2; inproj_item(p, l, xcd * 64 + i / 9, i % 9, lds); }
        else { const int i = it - 578, w = tid_() >> 6;
            const int tk = i < 24 ? NTASK_NA + NTASK_GQ + (xcd * 24 + i) * 4 + w : NTASK_NA + NTASK_GQ + NTASK_CNA + (xcd * 8 + (i - 24)) * 4 + w;
            attn_task(p, l, tk, (const float*)lds); }
        it = q_publish(nreg, slot);
    }
}
DEV void ph_mixer(const Params& p, int l, bf16_t* lds, float* stat, int* slot, int ph) {
    const int xcd = bid_() & 7;
    unsigned* ctr = (unsigned*)(p.ws + OFF_CTL) + CW_Q + ph * 8 + xcd;
    const int n0 = l == 0 ? 2 : 0, n1 = n0 + 64, n2 = n1 + 256, n3 = n2 + 768, ntot = n3 + 192;
    bool rpb_ok = false;
    float* rpb2 = (float*)lds;
    int it = q_pull(ctr, slot);
    while (it < ntot) {
        int nreg = 0;
        if (tid_() == 0) nreg = (int)atomicAdd(ctr, 1u);
        if (it < n0) { outproj_item(p, l, 512 + 2 * xcd + it, lds, stat); rpb_ok = false; }
        else if (it < n1) { rg_item(p, l, xcd * 64 + (it - n0), lds); rpb_ok = false; }
        else if (it < n3) {
            if (!rpb_ok) { for (int i = tid_(); i < 6 * 15 * 31; i += 256) rpb2[i] = p.na_rpb[(size_t)l * 6 * 15 * 31 + i] * LOG2E; __syncthreads(); rpb_ok = true; }
            const int w = tid_() >> 6;
            int tk;
            if (it < n2) { const int i = it - n1; tk = NTASK_NA + (2 * xcd + (i >> 7)) * 512 + (i & 127) * 4 + w; }
            else { const int i = it - n2; tk = (6 * xcd + (i >> 7)) * 512 + (i & 127) * 4 + w; }
            attn_task(p, l, tk, rpb2);
        } else {
            rpb_ok = false;
            const int gi = xcd * 192 + (it - n3);
#pragma unroll 1
            for (int k = 0; k < 8; ++k) {
                const int T = gi * 8 + k, kind = T >> 12, Tl = T & 4095, e = Tl >> 7, tile = Tl & 127;
                if (kind == 0) transpose_tile(p.exp_w_gate + ((size_t)l * NE + e) * 1024 * 512, (bf16_t*)(p.ws + OFF_WGU) + (size_t)e * 1024 * 1024, 1024, 512, 1, tile, (float*)lds);
                else if (kind == 1) transpose_tile(p.exp_w_up + ((size_t)l * NE + e) * 1024 * 512, (bf16_t*)(p.ws + OFF_WGU) + (size_t)e * 1024 * 1024, 1024, 512, 2, tile, (float*)lds);
                else transpose_tile(p.exp_w_down + ((size_t)l * NE + e) * 512 * 1024, (bf16_t*)(p.ws + OFF_WD) + (size_t)e * 1024 * 512, 512, 1024, 0, tile, (float*)lds);
            }
        }
        it = q_publish(nreg, slot);
    }
}

#define XB_TMO      128
#define XB_XCNT(j)  (256  + 64 * (j))
#define XB_XSUB(j)  (1280 + 64 * (j))
#define XB_XGEN(j)  (2304 + 64 * (j))
#define XB_TOP      3328
#define XB_TOPGEN   3392
#define XCD_BAR_WORDS 3456
#define XB_SPIN_CAP (1u << 20)
DEV unsigned xb_ld(unsigned* p) { return __hip_atomic_load(p, __ATOMIC_RELAXED, __HIP_MEMORY_SCOPE_AGENT); }
DEV unsigned xb_add(unsigned* p, unsigned v) { return __hip_atomic_fetch_add(p, v, __ATOMIC_RELAXED, __HIP_MEMORY_SCOPE_AGENT); }
DEV unsigned xb_xcc_id() { return (unsigned)__builtin_amdgcn_s_getreg((3 << 11) | 20) & 0xFu; }
#define XB_SPIN(cond, bar) do { unsigned _sp = 0; while (cond) { __builtin_amdgcn_s_sleep(1); \
    if ((++_sp & 255u) == 0u) { if (xb_ld(&(bar)[XB_TMO])) break; if (_sp > XB_SPIN_CAP) { atomicAdd(&(bar)[XB_TMO], 1u); break; } } } } while (0)
struct XcdBarrier { unsigned* bar; unsigned x; volatile LAS unsigned* st; };
DEV XcdBarrier xcd_barrier_post(unsigned* bar, volatile LAS unsigned* st) {
    XcdBarrier b; b.bar = bar; b.x = xb_xcc_id(); b.st = st;
    if (tid_() == 0) (void)xb_add(&bar[XB_XCNT(b.x)], 1u);
    return b;
}
DEV void xcd_barrier_complete(unsigned* bar, unsigned x, unsigned& nloc, unsigned& nx) {
    const unsigned G = gridDim.x * gridDim.y * gridDim.z;
    unsigned sum, cnt, mine, sp = 0u;
    for (;;) {
        sum = 0u; cnt = 0u; mine = 0u;
#pragma unroll
        for (unsigned j = 0; j < 16; ++j) { const unsigned c = xb_ld(&bar[XB_XCNT(j)]); sum += c; cnt += (c > 0u) ? 1u : 0u; mine = (j == x) ? c : mine; }
        if (sum == G) break;
        __builtin_amdgcn_s_sleep(1);
        if ((++sp & 255u) == 0u) { if (xb_ld(&bar[XB_TMO])) break; if (sp > XB_SPIN_CAP) { atomicAdd(&bar[XB_TMO], 1u); break; } }
    }
    nloc = mine > 0u ? mine : 1u; nx = cnt > 0u ? cnt : 1u;
}
DEV void xcd_barrier(const XcdBarrier& b) {
    asm volatile("s_waitcnt vmcnt(0)" ::: "memory");
    __syncthreads();
    if (tid_() == 0) {
        unsigned* bar = b.bar;
        __builtin_amdgcn_s_waitcnt(0);
        unsigned nloc = b.st[0], nx = b.st[1];
        if (nloc == 0u) { xcd_barrier_complete(bar, b.x, nloc, nx); b.st[0] = nloc; b.st[1] = nx; }
        const unsigned old = xb_add(&bar[XB_XSUB(b.x)], 1u);
        const unsigned gen = old / nloc;
        if (old + 1u == (gen + 1u) * nloc) {
            __builtin_amdgcn_fence(__ATOMIC_RELEASE, "agent");
            asm volatile("s_waitcnt vmcnt(0)" ::: "memory");
            const unsigned og = xb_add(&bar[XB_TOP], 1u);
            const unsigned tg = og / nx;
            if (og + 1u == (tg + 1u) * nx) xb_add(&bar[XB_TOPGEN], 1u);
            else XB_SPIN(xb_ld(&bar[XB_TOPGEN]) == tg, bar);
            __builtin_amdgcn_fence(__ATOMIC_ACQUIRE, "agent");
            xb_add(&bar[XB_XGEN(b.x)], 1u);
            asm volatile("s_waitcnt vmcnt(0)" ::: "memory");
        } else {
            XB_SPIN(xb_ld(&bar[XB_XGEN(b.x)]) == gen, bar);
            __builtin_amdgcn_fence(__ATOMIC_ACQUIRE, "agent");
            asm volatile("s_waitcnt vmcnt(0)" ::: "memory");
        }
    }
    __syncthreads();
}

namespace cg = cooperative_groups;
#define REP(id) for (int rep_ = 0; rep_ < ((PROBE_ID) == (id) ? PROBE_N : 1); ++rep_)
constexpr int SMEM_STAT = GEMM_LDS_BYTES;
constexpr int SMEM_BYTES = GEMM_LDS_BYTES + 2048 + 512;
constexpr int NPHASE = 14;
__global__ void __launch_bounds__(256, 2) mega(Params p, int ph_lo, int ph_hi) {
    extern __shared__ __attribute__((aligned(16))) unsigned char smem[];
    bf16_t* lds = (bf16_t*)smem;
    float* stat = (float*)(smem + SMEM_STAT);
    int* s_pref = (int*)(smem + SMEM_STAT + 2048); int* s_cnt = s_pref + 40;
    int* qslot = (int*)(smem + SMEM_STAT + 2048 + 416);
    volatile LAS unsigned* bst = (volatile LAS unsigned*)(LAS unsigned char*)(smem + SMEM_STAT + 2048 + 400);
    if (tid_() < 2) bst[tid_()] = 0u;
    __syncthreads();
    (void)xcd_barrier_post((unsigned*)(kp_().ws + OFF_CTL + 4096), bst);
#define GRID_BAR() do { XcdBarrier xb_; xb_.bar = (unsigned*)(kp_().ws + OFF_CTL + 4096); xb_.x = xb_xcc_id(); \
        xb_.st = (volatile LAS unsigned*)(LAS unsigned char*)(smem + SMEM_STAT + 2048 + 400); xcd_barrier(xb_); } while (0)
#define IN(k) (ph_lo <= (k) && (k) < ph_hi)
#define STAMP(k) do { if ((PROBE_TS) >= 0 && bid_() == 0 && tid_() == 0) ((unsigned long long*)(kp_().ws + OFF_CTL + 2048))[k] = __builtin_amdgcn_s_memrealtime(); } while (0)
#define SEAM(k) do { if (IN(k) && IN((k) + 1)) { if ((k) == 0) cg::this_grid().sync(); else GRID_BAR(); } STAMP((k) + 1); } while (0)
    STAMP(0);
    if (IN(0)) {
        REP(0) { ph_mod(kp_(), (float*)smem); __syncthreads(); }
        ph_rope(kp_());
        ph_routerw(kp_());
        ph_rgprep(kp_());
        REP(1) ph_transpose(kp_().w_in, (bf16_t*)(kp_().ws + OFF_WINT), 1024, 2304, 0, 2, (size_t)1024 * 2304, (size_t)2304 * 1024, (float*)smem);
        ph_transpose(kp_().w_out, (bf16_t*)(kp_().ws + OFF_WOUTT), 1024, 1024, 0, 2, (size_t)1024 * 1024, (size_t)1024 * 1024, (float*)smem);
    }
    SEAM(0);
#define LAYER_BODY(l, pb) { \
        if (IN(pb + 0)) ph_rowin(kp_(), l, lds, qslot, pb + 0); \
        SEAM(pb + 0); \
        if (IN(pb + 1)) ph_inproj2(kp_(), l, lds, qslot, pb + 1); \
        SEAM(pb + 1); \
        if (IN(pb + 2)) ph_mixer(kp_(), l, lds, stat, qslot, pb + 2); \
        SEAM(pb + 2); \
        if (IN(pb + 3)) ph_outproj(kp_(), l, lds, stat); \
        SEAM(pb + 3); \
        if (IN(pb + 4)) { REP(7) { ph_moe<1>(kp_(), l, lds, s_pref, s_cnt); } } \
        SEAM(pb + 4); \
        if (IN(pb + 5)) { REP(8) { ph_moe<2>(kp_(), l, lds, s_pref, s_cnt); } } \
        SEAM(pb + 5); \
    }
    LAYER_BODY(0, 1)
    LAYER_BODY(1, 7)
#undef LAYER_BODY
    if (IN(NPHASE - 1)) ph_rowop<2>(kp_(), 2, NLAT);
    if ((PROBE_TS) >= 0 && bid_() == 0) {
        __syncthreads();
        if (tid_() == 0) {
            unsigned long long* ts = (unsigned long long*)(kp_().ws + OFF_CTL + 2048);
            const unsigned long long now = __builtin_amdgcn_s_memrealtime();
            if ((PROBE_TS) == NPHASE - 1) ts[NPHASE] = now;
            const unsigned long long dt = ts[(PROBE_TS) + 1] - ts[(PROBE_TS)];
            while (__builtin_amdgcn_s_memrealtime() - now < 4ull * dt) __builtin_amdgcn_s_sleep(8);
        }
    }
#undef IN
#undef SEAM
}

#ifndef ONE_LAUNCH
#define ONE_LAUNCH 1
#endif
extern "C" void kernel_launch(void* const* d_in, const int* in_sizes, int n_in, void* d_out, int out_size, void* d_ws, size_t ws_size, hipStream_t stream) {
    if (n_in != 28 || ws_size < WS_TOTAL || out_size != NLAT * D) { fprintf(stderr, "kernel_launch: unexpected shapes / workspace (%d inputs, ws %zu need %zu)\n", n_in, ws_size, (size_t)WS_TOTAL); return; }
    static int grid = 0;
    if (grid == 0) {
        int dev = 0, cus = 0, per_cu = 0;
        (void)hipGetDevice(&dev);
        (void)hipDeviceGetAttribute(&cus, hipDeviceAttributeMultiprocessorCount, dev);
        (void)hipFuncSetAttribute((const void*)mega, hipFuncAttributeMaxDynamicSharedMemorySize, SMEM_BYTES);
        (void)hipOccupancyMaxActiveBlocksPerMultiprocessor(&per_cu, (const void*)mega, 256, SMEM_BYTES);
        if (per_cu > 2) per_cu = 2;
        grid = cus * per_cu;
        if (grid <= 0) { fprintf(stderr, "kernel_launch: occupancy query gave %d blocks per CU on %d CUs\n", per_cu, cus); grid = -1; }
    }
    if (grid < 0) return;
    Params p{};
    const float** pp = (const float**)&p;
    for (int i = 0; i < 28; ++i) pp[i] = (const float*)d_in[i];
    p.out = (float*)d_out; p.ws = (unsigned char*)d_ws;
    (void)hipMemsetAsync((unsigned char*)d_ws + OFF_CTL, 0, CTL_BYTES, stream);
#if ONE_LAUNCH
    int lo = 0, hi = NPHASE;
    void* args[] = {(void*)&p, (void*)&lo, (void*)&hi};
    hipError_t e = hipLaunchCooperativeKernel((const void*)mega, dim3(grid), dim3(256), args, SMEM_BYTES, stream);
    if (e != hipSuccess) fprintf(stderr, "kernel_launch: cooperative launch failed: %s (grid %d)\n", hipGetErrorString(e), grid);
#else
    for (int ph = 0; ph < NPHASE; ++ph) mega<<<grid, 256, SMEM_BYTES, stream>>>(p, ph, ph + 1);
#endif
}
```

```cpp
#include <hip/hip_runtime.h>
#include <hip/hip_cooperative_groups.h>
#include <stdint.h>
#include <cstdio>

typedef unsigned short bf16_t;
typedef short bf16x8 __attribute__((ext_vector_type(8)));
typedef float f32x4 __attribute__((ext_vector_type(4)));

#define DEV __device__ __forceinline__
#define PROBE_ID -1
#define PROBE_N 4
#define PROBE_TS -1

constexpr int D = 1024, NB = 8, S = 8192, CTX = 256;
constexpr int NLAT = NB * S, NCTX = NB * CTX, NTOK = NLAT + NCTX;
constexpr int PWS = 1280;
constexpr int COL_RGX = 0, COL_GATE = 256, COL_NAQ = 512, COL_GQ = 896;
constexpr int KVT = 1024;
constexpr int NE = 32, FF = 512;
constexpr int LISTCAP = NTOK;
constexpr float ALPHA = 1.4142135623730951f;
constexpr float LN_EPS = 1e-5f;

constexpr size_t al256(size_t x) { return (x + 255) & ~(size_t)255; }
constexpr size_t OFF_CTL   = 0;
constexpr size_t CTL_BYTES = 4096 + 16384;
constexpr size_t OFF_MOD   = OFF_CTL + CTL_BYTES;
constexpr size_t OFF_ROPE  = al256(OFF_MOD + (size_t)2 * 9 * 6144 * 4);
constexpr size_t OFF_RTE   = al256(OFF_ROPE + (size_t)2 * 128 * 16 * 4);
constexpr size_t OFF_RTW   = al256(OFF_RTE + (size_t)NTOK * 8);
constexpr size_t OFF_LIST  = al256(OFF_RTW + (size_t)NTOK * 8);
constexpr size_t OFF_WR    = al256(OFF_LIST + (size_t)NE * LISTCAP * 4);
constexpr size_t OFF_WRG   = al256(OFF_WR + (size_t)2 * 2 * 48 * 1024 * 2);
constexpr size_t OFF_RGC   = al256(OFF_WRG + (size_t)2 * 2 * 2 * 4 * 64 * 64 * 2);
constexpr size_t OFF_AGG   = al256(OFF_RGC + (size_t)2 * 2 * 3 * 256 * 4);
constexpr size_t OFF_WINT  = al256(OFF_AGG + (size_t)NB * 66 * 2 * 2 * 256 * 4);
constexpr size_t OFF_WOUTT = al256(OFF_WINT + (size_t)2 * 2304 * 1024 * 2);
constexpr size_t OFF_WGU   = al256(OFF_WOUTT + (size_t)2 * 1024 * 1024 * 2);
constexpr size_t OFF_WD    = al256(OFF_WGU + (size_t)NE * 1024 * 1024 * 2);
constexpr size_t OFF_XCTX  = al256(OFF_WD + (size_t)NE * 1024 * 512 * 2);
constexpr size_t OFF_X1    = al256(OFF_XCTX + (size_t)NCTX * D * 4);
constexpr size_t OFF_X2    = al256(OFF_X1 + (size_t)NTOK * D * 2);
constexpr size_t OFF_P     = al256(OFF_X2 + (size_t)NTOK * D * 2);
constexpr size_t OFF_NAKF  = al256(OFF_P + (size_t)NTOK * PWS * 2);
constexpr size_t OFF_NAVF  = al256(OFF_NAKF + (size_t)NB * 6 * 512 * KVT * 2);
constexpr size_t OFF_GKF   = al256(OFF_NAVF + (size_t)NB * 6 * 512 * KVT * 2);
constexpr size_t OFF_GVF   = al256(OFF_GKF + (size_t)NB * 2 * 512 * KVT * 2);
constexpr size_t OFF_NAKFC = al256(OFF_GVF + (size_t)NB * 2 * 512 * KVT * 2);
constexpr size_t OFF_NAVFC = al256(OFF_NAKFC + (size_t)NB * 6 * 16 * KVT * 2);
constexpr size_t OFF_GKFC  = al256(OFF_NAVFC + (size_t)NB * 6 * 16 * KVT * 2);
constexpr size_t OFF_GVFC  = al256(OFF_GKFC + (size_t)NB * 2 * 16 * KVT * 2);
constexpr size_t OFF_Y     = al256(OFF_GVFC + (size_t)NB * 2 * 16 * KVT * 2);
constexpr size_t WS_TOTAL  = al256(OFF_Y + (size_t)2 * NTOK * D * 2);
constexpr int CW_CNT = 0;

struct Params {
    const float *x, *c, *ctx, *c_ctx, *w_ada, *b_ada, *w_in, *conv_w, *conv_b, *rg_a_w, *rg_a_b, *rg_i_w, *rg_i_b, *rg_lambda,
        *na_rpb, *gqa_sink, *w_out, *ln1_g, *ln1_b, *router_g_w, *router_g_b, *router_e_w, *router_e_b, *exp_w_gate, *exp_w_up,
        *exp_w_down, *ln2_g, *ln2_b;
    float* out;
    unsigned char* ws;
};

DEV const Params& kp_() { const void* q = (const void*)__builtin_amdgcn_kernarg_segment_ptr(); asm volatile("" : "+s"(q)); return *(const Params*)q; }
DEV int tid_() { int t = threadIdx.x; asm volatile("" : "+v"(t)); return t; }
DEV int bid_() { int b = blockIdx.x; asm volatile("" : "+s"(b)); return b; }
DEV float shx(float v, int m) { return __builtin_bit_cast(float, __builtin_amdgcn_ds_bpermute(((tid_() & 63) ^ m) << 2, __builtin_bit_cast(int, v))); }
DEV float shl_(float v, int src) { return __builtin_bit_cast(float, __builtin_amdgcn_ds_bpermute(src << 2, __builtin_bit_cast(int, v))); }
DEV float bf2f(bf16_t h) { return __uint_as_float((unsigned)h << 16); }
DEV bf16_t f2bf(float f) { unsigned r; asm("v_cvt_pk_bf16_f32 %0, %1, %1" : "=v"(r) : "v"(f)); return (bf16_t)(r & 0xffffu); }
DEV unsigned pk2(float lo, float hi) { unsigned r; asm("v_cvt_pk_bf16_f32 %0, %1, %2" : "=v"(r) : "v"(lo), "v"(hi)); return r; }
DEV float wave_sum(float v) {
#pragma unroll
    for (int o = 1; o < 64; o <<= 1) v += shx(v, o);
    return v;
}
DEV float wave_max(float v) {
#pragma unroll
    for (int o = 1; o < 64; o <<= 1) v = fmaxf(v, shx(v, o));
    return v;
}
DEV float sigmoidf_(float x) { return 1.f / (1.f + __expf(-x)); }
DEV float gelu_tanh(float x) {
    const float u = 0.7978845608028654f * (x + 0.044715f * x * x * x);
    const float t = 1.f - 2.f / (1.f + __expf(2.f * u));
    return 0.5f * x * (1.f + t);
}
DEV float* xres_row(const Params& p, int R) {
    return R < NLAT ? p.out + (size_t)R * D : (float*)(p.ws + OFF_XCTX) + (size_t)(R - NLAT) * D;
}
DEV const float* modvec(const Params& p, int l, int R, int seg) {
    const int b = R < NLAT ? R / S : 8;
    return (const float*)(p.ws + OFF_MOD) + ((size_t)(l * 9 + b) * 6 + seg) * 1024;
}

DEV void ph_mod(const Params& p, float* sc  ) {
    if (bid_() >= 192) return;
    for (int i = tid_(); i < 9 * 1024; i += 256) { const float v = (i < 8192) ? p.c[i] : p.c_ctx[i - 8192]; sc[i] = v / (1.f + expf(-v)); }
    __syncthreads();
    const int lane = tid_() & 63, w = tid_() >> 6;
    const int col = bid_() * 64 + lane;
    const int l = col / 6144, j = col % 6144;
    const float* wp = p.w_ada + (size_t)l * 1024 * 6144 + j + (size_t)(w * 256) * 6144;
    const float* s = sc + w * 256;
    float a0 = 0, a1 = 0, a2 = 0, a3 = 0, a4 = 0, a5 = 0, a6 = 0, a7 = 0, a8 = 0;
#pragma unroll 8
    for (int k = 0; k < 256; ++k) {
        const float wv = wp[(size_t)k * 6144];
        a0 += s[k] * wv; a1 += s[1024 + k] * wv; a2 += s[2048 + k] * wv; a3 += s[3072 + k] * wv; a4 += s[4096 + k] * wv;
        a5 += s[5120 + k] * wv; a6 += s[6144 + k] * wv; a7 += s[7168 + k] * wv; a8 += s[8192 + k] * wv;
    }
    __syncthreads();
    float* red = sc + 9 * 1024;
    red[(w * 9 + 0) * 64 + lane] = a0; red[(w * 9 + 1) * 64 + lane] = a1; red[(w * 9 + 2) * 64 + lane] = a2; red[(w * 9 + 3) * 64 + lane] = a3; red[(w * 9 + 4) * 64 + lane] = a4;
    red[(w * 9 + 5) * 64 + lane] = a5; red[(w * 9 + 6) * 64 + lane] = a6; red[(w * 9 + 7) * 64 + lane] = a7; red[(w * 9 + 8) * 64 + lane] = a8;
    __syncthreads();
    if (w == 0) {
        const float bias = p.b_ada[l * 6144 + j];
        float* mod = (float*)(p.ws + OFF_MOD) + (size_t)l * 9 * 6144 + j;
#pragma unroll
        for (int r = 0; r < 9; ++r) mod[r * 6144] = ((red[(0 * 9 + r) * 64 + lane] + red[(1 * 9 + r) * 64 + lane]) + (red[(2 * 9 + r) * 64 + lane] + red[(3 * 9 + r) * 64 + lane])) + bias;
    }
}

DEV void sincos_red(float ang, float& sn, float& cs) {
    const float n = rintf(ang * 0.15915494309189535f);
    float r = fmaf(-n, 6.2831854820251465f, ang);
    r = fmaf(-n, -1.7484555e-07f, r);
    float sgn = 1.f;
    if (r > 1.5707963267948966f) { r = 3.14159265358979f - r; sgn = -1.f; }
    else if (r < -1.5707963267948966f) { r = -3.14159265358979f - r; sgn = -1.f; }
    const float r2 = r * r;
    float sp = -1.6059044e-10f; sp = fmaf(sp, r2, 2.5052108e-08f); sp = fmaf(sp, r2, -2.7557319e-06f); sp = fmaf(sp, r2, 1.9841270e-04f);
    sp = fmaf(sp, r2, -8.3333333e-03f); sp = fmaf(sp, r2, 1.6666667e-01f); sp = fmaf(sp * -1.f, r2, 1.f);
    sn = r * sp;
    float cp = -1.1470746e-11f; cp = fmaf(cp, r2, 2.0876757e-09f); cp = fmaf(cp, r2, -2.7557319e-07f); cp = fmaf(cp, r2, 2.4801587e-05f);
    cp = fmaf(cp, r2, -1.3888889e-03f); cp = fmaf(cp, r2, 4.1666667e-02f); cp = fmaf(cp, r2, -0.5f); cp = fmaf(cp, r2, 1.f);
    cs = sgn * cp;
}
DEV void ph_rope(const Params& p) {
    const int i = (bid_() - 192) * 256 + tid_();
    if (i < 0 || i >= 128 * 16) return;
    const int pos = i >> 4, q = i & 15;
    const float inv = exp2f(-(float)q * (13.287712379549449f / 16.f));
    float sn, cs; sincos_red((float)pos * inv, sn, cs);
    float* tab = (float*)(p.ws + OFF_ROPE);
    tab[i] = cs; tab[2048 + i] = sn;
}

DEV void ph_routerw(const Params& p) {
  for (int i = bid_() * 256 + tid_(); i < 2 * 48 * 1024; i += gridDim.x * 256) {
    const int l = i / (48 * 1024), f = (i / 1024) % 48, k = i & 1023;
    float w = 0.f;
    if (f < 4) w = p.router_g_w[((size_t)l * 1024 + k) * 4 + f]; else if (f < 36) w = p.router_e_w[((size_t)l * 1024 + k) * 32 + (f - 4)];
    const bf16_t hi = f2bf(w), lo = f2bf(w - bf2f(hi));
    bf16_t* WR = (bf16_t*)(p.ws + OFF_WR);
    WR[((size_t)(l * 2 + 0) * 48 + f) * 1024 + k] = hi;
    WR[((size_t)(l * 2 + 1) * 48 + f) * 1024 + k] = lo;
  }
}

DEV void ph_rgprep(const Params& p) {
    bf16_t* W = (bf16_t*)(p.ws + OFF_WRG);
    for (int i = bid_() * 256 + tid_(); i < 2 * 2 * 2 * 4 * 64 * 64; i += gridDim.x * 256) {
        const int d = i & 63, e = (i >> 6) & 63, n = (i >> 12) & 3, gate = (i >> 14) & 1, ld = i >> 15;
        const float* srcw = gate ? p.rg_i_w : p.rg_a_w;
        W[i] = f2bf(srcw[((size_t)(ld * 4 + n) * 64 + d) * 64 + e]);
    }
    float* C = (float*)(p.ws + OFF_RGC);
    for (int i = bid_() * 256 + tid_(); i < 2 * 2 * 256; i += gridDim.x * 256) {
        const int c = i & 255, ld = i >> 8;
        C[(ld * 3 + 0) * 256 + c] = p.rg_a_b[ld * 256 + c];
        C[(ld * 3 + 1) * 256 + c] = p.rg_i_b[ld * 256 + c];
        C[(ld * 3 + 2) * 256 + c] = -8.f * log1pf(expf(-p.rg_lambda[ld * 256 + c]));
    }
}

DEV int tr_row(int n, int mode) { return mode == 0 ? n : ((n >> 7) * 256 + ((n >> 6) & 1) * 128 + (n & 63) + (mode == 2 ? 64 : 0)); }
DEV void transpose_tile(const float* src, bf16_t* dst, int K, int N, int mode, int tile, float* lds) {
    const int ntn = N >> 6, kt = tile / ntn, nt = tile % ntn, k0 = kt * 64, n0 = nt * 64, t = tid_();
#pragma unroll
    for (int i = 0; i < 4; ++i) {
        const int r = (t >> 4) + 16 * i, c4 = (t & 15) * 4;
        const float4 v = *(const float4*)(src + (size_t)(k0 + r) * N + n0 + c4);
        lds[r * 65 + c4] = v.x; lds[r * 65 + c4 + 1] = v.y; lds[r * 65 + c4 + 2] = v.z; lds[r * 65 + c4 + 3] = v.w;
    }
    __syncthreads();
#pragma unroll
    for (int i = 0; i < 2; ++i) {
        const int n = (t >> 3) + 32 * i, kc = (t & 7) * 8;
        uint4 o;
        o.x = pk2(lds[(kc + 0) * 65 + n], lds[(kc + 1) * 65 + n]); o.y = pk2(lds[(kc + 2) * 65 + n], lds[(kc + 3) * 65 + n]);
        o.z = pk2(lds[(kc + 4) * 65 + n], lds[(kc + 5) * 65 + n]); o.w = pk2(lds[(kc + 6) * 65 + n], lds[(kc + 7) * 65 + n]);
        *(uint4*)(dst + (size_t)tr_row(n0 + n, mode) * K + k0 + kc) = o;
    }
    __syncthreads();
}
DEV void ph_transpose(const float* src, bf16_t* dst, int K, int N, int mode, int nmat, size_t sstride, size_t dstride, float* lds  ) {
    const int per = (K >> 6) * (N >> 6);
    for (int it = bid_(); it < nmat * per; it += gridDim.x) {
        const int m = it / per, tile = it % per;
        transpose_tile(src + (size_t)m * sstride, dst + (size_t)m * dstride, K, N, mode, tile, lds);
    }
}

template <int MODE, bool WX> DEV void rowop(const Params& p, int l, int R) {
    const int lane = tid_() & 63;
    float4 v[2][4];
    float* xr[2] = {nullptr, nullptr};
    if (MODE == 0) {
#pragma unroll
        for (int r = 0; r < 2; ++r) {
            const int Rr = R + r;
            const float* src = Rr < NLAT ? p.x + (size_t)Rr * D : p.ctx + (size_t)(Rr - NLAT) * D;
#pragma unroll
            for (int i = 0; i < 4; ++i) v[r][i] = *(const float4*)(src + i * 256 + lane * 4);
        }
    } else {
        const float* g2 = modvec(p, l - 1, R, 5);
        const float* lg = p.ln2_g + (l - 1) * D; const float* lb = p.ln2_b + (l - 1) * D;
        float4 xv[2][4]; uint2 ya[2][4], yb[2][4];
#pragma unroll
        for (int r = 0; r < 2; ++r) {
            xr[r] = xres_row(p, R + r);
            const bf16_t* y0 = (const bf16_t*)(p.ws + OFF_Y) + (size_t)(2 * (R + r)) * D;
#pragma unroll
            for (int i = 0; i < 4; ++i) { const int k = i * 256 + lane * 4; xv[r][i] = *(const float4*)(xr[r] + k); ya[r][i] = *(const uint2*)(y0 + k); yb[r][i] = *(const uint2*)(y0 + D + k); }
        }
        float s[2] = {0.f, 0.f};
#pragma unroll
        for (int i = 0; i < 4; ++i) {
            const float4 gv = *(const float4*)(g2 + i * 256 + lane * 4);
#pragma unroll
            for (int r = 0; r < 2; ++r) {
                const uint2 a = ya[r][i], b = yb[r][i];
                float4 u;
                u.x = ALPHA * xv[r][i].x + gv.x * (bf2f((bf16_t)(a.x & 0xffff)) + bf2f((bf16_t)(b.x & 0xffff)));
                u.y = ALPHA * xv[r][i].y + gv.y * (bf2f((bf16_t)(a.x >> 16)) + bf2f((bf16_t)(b.x >> 16)));
                u.z = ALPHA * xv[r][i].z + gv.z * (bf2f((bf16_t)(a.y & 0xffff)) + bf2f((bf16_t)(b.y & 0xffff)));
                u.w = ALPHA * xv[r][i].w + gv.w * (bf2f((bf16_t)(a.y >> 16)) + bf2f((bf16_t)(b.y >> 16)));
                v[r][i] = u; s[r] += (u.x + u.y) + (u.z + u.w);
            }
        }
        float q[2] = {0.f, 0.f};
#pragma unroll
        for (int r = 0; r < 2; ++r) {
            const float mean = wave_sum(s[r]) * (1.f / D);
#pragma unroll
            for (int i = 0; i < 4; ++i) { v[r][i].x -= mean; v[r][i].y -= mean; v[r][i].z -= mean; v[r][i].w -= mean; q[r] += (v[r][i].x * v[r][i].x + v[r][i].y * v[r][i].y) + (v[r][i].z * v[r][i].z + v[r][i].w * v[r][i].w); }
        }
#pragma unroll
        for (int r = 0; r < 2; ++r) q[r] = rsqrtf(wave_sum(q[r]) * (1.f / D) + LN_EPS);
#pragma unroll
        for (int i = 0; i < 4; ++i) {
            const int k = i * 256 + lane * 4;
            const float4 gg = *(const float4*)(lg + k); const float4 bb = *(const float4*)(lb + k);
#pragma unroll
            for (int r = 0; r < 2; ++r) {
                v[r][i].x = v[r][i].x * q[r] * gg.x + bb.x; v[r][i].y = v[r][i].y * q[r] * gg.y + bb.y; v[r][i].z = v[r][i].z * q[r] * gg.z + bb.z; v[r][i].w = v[r][i].w * q[r] * gg.w + bb.w;
                if (WX) *(float4*)(xr[r] + k) = v[r][i];
            }
        }
    }
    if (MODE != 2) {
        const float* sh = modvec(p, l, R, 0); const float* sc = modvec(p, l, R, 1);
#pragma unroll
        for (int i = 0; i < 4; ++i) {
            const int k = i * 256 + lane * 4;
            const float4 s4 = *(const float4*)(sh + k); const float4 c4 = *(const float4*)(sc + k);
#pragma unroll
            for (int r = 0; r < 2; ++r) {
                bf16_t* ha = (bf16_t*)(p.ws + OFF_X1) + (size_t)(R + r) * D;
                uint2 o; o.x = pk2(v[r][i].x * (1.f + c4.x) + s4.x, v[r][i].y * (1.f + c4.y) + s4.y); o.y = pk2(v[r][i].z * (1.f + c4.z) + s4.z, v[r][i].w * (1.f + c4.w) + s4.w);
                *(uint2*)(ha + k) = o;
            }
        }
    }
}
template <int MODE> DEV void ph_rowop(const Params& p, int l, int nrows) {
    const int w = tid_() >> 6;
    for (int R = (bid_() * 4 + w) * 2; R < nrows; R += gridDim.x * 8) rowop<MODE, true>(p, l, R);
}
constexpr int CW_Q = 64;
DEV int q_publish(int nreg, int* slot) {
    __syncthreads();
    if (tid_() == 0) *slot = nreg;
    __syncthreads();
    return *(volatile int*)slot;
}
DEV int q_pull(unsigned* ctr, int* slot) {
    if (tid_() == 0) *slot = (int)atomicAdd(ctr, 1u);
    __syncthreads();
    const int v = *(volatile int*)slot;
    __syncthreads();
    return v;
}

constexpr int GEMM_STAGE_BYTES = 384 * 64;
constexpr int GEMM_NSTAGE = 3;
constexpr int GEMM_LDS_BYTES = GEMM_NSTAGE * GEMM_STAGE_BYTES;
#define LAS __attribute__((address_space(3)))
DEV int gemm_src_chunk(int t) { return ((t & 3) ^ ((0 - (t >> 4)) & 3)) * 8; }
DEV void gemm_mainloop(const bf16_t* Abase, unsigned ao0, unsigned ao1, const bf16_t* Bbase, unsigned bo, unsigned ldb, int nk, bf16_t* lds, f32x4 (&acc)[4][8]) {
    const int t = tid_(), lane = t & 63, w = __builtin_amdgcn_readfirstlane(t >> 6), wm = w >> 1, wn = w & 1;
    LAS unsigned char* L = (LAS unsigned char*)lds;
    const int pc = ((lane >> 4) ^ ((0 - ((lane & 15) >> 2)) & 3)) * 16;
    const int arow = (wm * 64 + (lane & 15)) * 64 + pc, brow = (128 + wn * 128 + (lane & 15)) * 64 + pc;
    const char* Ab = (const char*)Abase; const char* B0 = (const char*)Bbase; const char* B1 = B0 + (size_t)ldb * 128; const char* B2 = B0 + (size_t)ldb * 256; const char* B3 = B0 + (size_t)ldb * 384;
#define GEMM_ISSUE(slot, ko) do { LAS unsigned* d_ = (LAS unsigned*)(L + (slot) * GEMM_STAGE_BYTES + w * 1024); \
        __builtin_amdgcn_global_load_lds((const unsigned*)(Ab + (ao0 + (ko) * 2u)), d_, 16, 0, 0); \
        __builtin_amdgcn_global_load_lds((const unsigned*)(Ab + (ao1 + (ko) * 2u)), d_ + 1024, 16, 0, 0); \
        __builtin_amdgcn_global_load_lds((const unsigned*)(B0 + (bo + (ko) * 2u)), d_ + 2048, 16, 0, 0); \
        __builtin_amdgcn_global_load_lds((const unsigned*)(B1 + (bo + (ko) * 2u)), d_ + 3072, 16, 0, 0); \
        __builtin_amdgcn_global_load_lds((const unsigned*)(B2 + (bo + (ko) * 2u)), d_ + 4096, 16, 0, 0); \
        __builtin_amdgcn_global_load_lds((const unsigned*)(B3 + (bo + (ko) * 2u)), d_ + 5120, 16, 0, 0); } while (0)
    asm volatile("s_waitcnt vmcnt(0)" ::: "memory");
    __builtin_amdgcn_s_barrier();
    asm volatile("" ::: "memory");
    GEMM_ISSUE(0, 0);
    if (nk > 1) GEMM_ISSUE(1, 32);
    int cs = 0, is = 2;
    for (int kt = 0; kt < nk; ++kt) {
        if (kt + 1 < nk) asm volatile("s_waitcnt vmcnt(6)" ::: "memory"); else asm volatile("s_waitcnt vmcnt(0)" ::: "memory");
        __builtin_amdgcn_s_barrier();
        asm volatile("" ::: "memory");
        if (kt + 2 < nk) GEMM_ISSUE(is, (kt + 2) * 32);
        const LAS unsigned char* cur = L + cs * GEMM_STAGE_BYTES;
        const bf16x8 af0 = *(const LAS bf16x8*)(cur + arow), af1 = *(const LAS bf16x8*)(cur + arow + 16 * 64), af2 = *(const LAS bf16x8*)(cur + arow + 32 * 64), af3 = *(const LAS bf16x8*)(cur + arow + 48 * 64);
        bf16x8 bq0 = *(const LAS bf16x8*)(cur + brow), bq1 = *(const LAS bf16x8*)(cur + brow + 16 * 64);
#pragma unroll
        for (int nt = 0; nt < 8; ++nt) {
            const bf16x8 bfr = bq0; bq0 = bq1;
            if (nt + 2 < 8) bq1 = *(const LAS bf16x8*)(cur + brow + (nt + 2) * 16 * 64);
            acc[0][nt] = __builtin_amdgcn_mfma_f32_16x16x32_bf16(bfr, af0, acc[0][nt], 0, 0, 0);
            acc[1][nt] = __builtin_amdgcn_mfma_f32_16x16x32_bf16(bfr, af1, acc[1][nt], 0, 0, 0);
            acc[2][nt] = __builtin_amdgcn_mfma_f32_16x16x32_bf16(bfr, af2, acc[2][nt], 0, 0, 0);
            acc[3][nt] = __builtin_amdgcn_mfma_f32_16x16x32_bf16(bfr, af3, acc[3][nt], 0, 0, 0);
        }
        cs = cs == 2 ? 0 : cs + 1; is = is == 2 ? 0 : is + 1;
    }
#undef GEMM_ISSUE
}
DEV void zero_acc(f32x4 (&acc)[4][8]) {
#pragma unroll
    for (int a = 0; a < 4; ++a)
#pragma unroll
        for (int b = 0; b < 8; ++b) acc[a][b] = (f32x4){0.f, 0.f, 0.f, 0.f};
}

DEV void inproj_item(const Params& p_, int l, int rt, int pass, bf16_t* lds) {
    const Params& p = kp_();
    const int t = tid_(), lane = t & 63, w = t >> 6, wm = w >> 1, wn = w & 1;
    const bf16_t* A = (const bf16_t*)(p.ws + OFF_X1) + (size_t)(rt * 128) * D;
    const bf16_t* Bt = (const bf16_t*)(p.ws + OFF_WINT) + ((size_t)l * 2304 + pass * 256) * 1024;
    const unsigned toff = (unsigned)(((t >> 2) * 1024 + gemm_src_chunk(t)) * 2);
    f32x4 acc[4][8]; zero_acc(acc);
    gemm_mainloop(A, toff, toff + 64 * D * 2, Bt, toff, 1024, 32, lds, acc);
    bf16_t* P = (bf16_t*)(p.ws + OFF_P);
    const float* ctab = (const float*)(p.ws + OFF_ROPE); const float* stab = ctab + 2048;
    const bool isctx = rt >= 512;
    const int fq = lane >> 4, fr = lane & 15;
#pragma unroll
    for (int hci = 0; hci < 2; ++hci) {
        const int hc = pass * 4 + wn * 2 + hci;
        int type, dcol = 0, vh = 0;
        if (hc < 4) { type = 0; dcol = COL_RGX + hc * 64; }
        else if (hc < 10) { type = 4; vh = hc - 4; }
        else if (hc < 16) { type = 5; vh = hc - 10; }
        else if (hc < 18) { type = 6; vh = hc - 16; }
        else if (hc < 20) { type = 7; vh = hc - 18; }
        else if (hc < 24) { type = 0; dcol = COL_GATE + (hc - 20) * 64; }
        else if (hc < 30) { type = 1; dcol = COL_NAQ + (hc - 24) * 64; }
        else { type = 3; dcol = COL_GQ + (hc - 30) * 64; }
#pragma unroll
        for (int mt = 0; mt < 4; ++mt) {
            const int R = rt * 128 + wm * 64 + mt * 16 + fr;
            f32x4 v0 = acc[mt][hci * 4 + 0], v1 = acc[mt][hci * 4 + 1], v2 = acc[mt][hci * 4 + 2], v3 = acc[mt][hci * 4 + 3];
            if ((type == 3 || type == 6) && !isctx) {
                const int tt = R & (S - 1), pr = tt >> 6, pc = tt & 63;
                const f32x4 cr = *(const f32x4*)(ctab + pr * 16 + fq * 4), sr = *(const f32x4*)(stab + pr * 16 + fq * 4);
                const f32x4 cc = *(const f32x4*)(ctab + pc * 16 + fq * 4), sc = *(const f32x4*)(stab + pc * 16 + fq * 4);
                const f32x4 o0 = v0 * cr - v1 * sr, o1 = v1 * cr + v0 * sr, o2 = v2 * cc - v3 * sc, o3 = v3 * cc + v2 * sc;
                v0 = o0; v1 = o1; v2 = o2; v3 = o3;
            }
            if (type == 1 || type == 3) { const float qs = 0.125f * 1.4426950408889634f; v0 = v0 * qs; v1 = v1 * qs; v2 = v2 * qs; v3 = v3 * qs; }
            if (type < 4) {
                bf16_t* o = P + (size_t)R * PWS + dcol + fq * 4;
                uint2 q;
                q.x = pk2(v0[0], v0[1]); q.y = pk2(v0[2], v0[3]); *(uint2*)(o) = q;
                q.x = pk2(v1[0], v1[1]); q.y = pk2(v1[2], v1[3]); *(uint2*)(o + 16) = q;
                q.x = pk2(v2[0], v2[1]); q.y = pk2(v2[2], v2[3]); *(uint2*)(o + 32) = q;
                q.x = pk2(v3[0], v3[1]); q.y = pk2(v3[2], v3[3]); *(uint2*)(o + 48) = q;
            } else {
                const bool na = type < 6, isk = (type == 4 || type == 6);
                bf16_t* tb;
                if (!isctx) { const int b = R >> 13, tile = (R & (S - 1)) >> 4;
                    tb = (bf16_t*)(p.ws + (na ? (isk ? OFF_NAKF : OFF_NAVF) : (isk ? OFF_GKF : OFF_GVF))) + ((size_t)(b * (na ? 6 : 2) + vh) * 512 + tile) * KVT; }
                else { const int cR = R - NLAT, b = cR >> 8, tile = (cR & 255) >> 4;
                    tb = (bf16_t*)(p.ws + (na ? (isk ? OFF_NAKFC : OFF_NAVFC) : (isk ? OFF_GKFC : OFF_GVFC))) + ((size_t)(b * (na ? 6 : 2) + vh) * 16 + tile) * KVT; }
                if (isk) {
                    bf16_t* o = tb + ((fq >> 1) * 16 + fr) * 8 + (fq & 1) * 4;
                    uint2 q;
                    q.x = pk2(v0[0], v0[1]); q.y = pk2(v0[2], v0[3]); *(uint2*)(o) = q;
                    q.x = pk2(v1[0], v1[1]); q.y = pk2(v1[2], v1[3]); *(uint2*)(o + 2 * 16 * 8) = q;
                    q.x = pk2(v2[0], v2[1]); q.y = pk2(v2[2], v2[3]); *(uint2*)(o + 512) = q;
                    q.x = pk2(v3[0], v3[1]); q.y = pk2(v3[2], v3[3]); *(uint2*)(o + 512 + 2 * 16 * 8) = q;
                } else {
                    bf16_t* o = tb + ((fr >> 2) * 16 + fq * 4) * 8 + (fr & 3);
#pragma unroll
                    for (int j = 0; j < 4; ++j) {
                        o[j * 8] = f2bf(v0[j]); o[j * 8 + 4] = f2bf(v1[j]); o[512 + j * 8] = f2bf(v2[j]); o[512 + j * 8 + 4] = f2bf(v3[j]);
                    }
                }
            }
        }
    }
}
DEV void ph_inproj(const Params& p, int l, bf16_t* lds) {
    const int nctxp = (l == 0) ? 9 : 5;
    const int nx = gridDim.x >> 3, xcd = bid_() & 7, j = bid_() >> 3;
    const int nloc = 64 * 9 + 2 * nctxp;
    if (bid_() >= nx * 8) return;
    for (int i0 = j; i0 < nloc * ((PROBE_ID) == 3 ? PROBE_N : 1); i0 += nx) {
        const int i = i0 % nloc;
        int rt, pass;
        if (i < 64 * 9) { rt = xcd * 64 + i / 9; pass = i % 9; } else { const int r = i - 64 * 9; rt = 512 + 2 * xcd + r / nctxp; pass = r % nctxp; }
        inproj_item(p, l, rt, pass, lds);
    }
}

constexpr float LOG2E = 1.4426950408889634f;
struct AttnState { f32x4 o0, o1, o2, o3; float m, lsum; };
struct KVFrag { bf16x8 k00, k01, k10, k11, v0, v1, v2, v3; };
DEV bf16x8 ld16(const bf16_t* p) { return *(const bf16x8*)p; }
DEV bf16x8 lohi(const uint4& a, const uint4& b, int hi) { union { uint4 u; bf16x8 v; } c; c.u = hi ? make_uint4(a.z, a.w, b.z, b.w) : make_uint4(a.x, a.y, b.x, b.y); return c.v; }
DEV void kv_load(const bf16_t* kt0, const bf16_t* kt1, const bf16_t* vt0, const bf16_t* vt1, KVFrag& f) {
    f.k00 = ld16(kt0); f.k01 = ld16(kt0 + 512); f.k10 = ld16(kt1); f.k11 = ld16(kt1 + 512);
    const uint4 a0 = *(const uint4*)vt0, a1 = *(const uint4*)(vt0 + 512), b0 = *(const uint4*)vt1, b1 = *(const uint4*)(vt1 + 512);
    f.v0 = lohi(a0, b0, 0); f.v1 = lohi(a0, b0, 1); f.v2 = lohi(a1, b1, 0); f.v3 = lohi(a1, b1, 1);
}
template <bool HASB> DEV void attn_apply(const KVFrag& f, const bf16x8& q0, const bf16x8& q1, f32x4 b0, f32x4 b1, AttnState& st) {
    const f32x4 z = {0.f, 0.f, 0.f, 0.f};
    f32x4 s0 = __builtin_amdgcn_mfma_f32_16x16x32_bf16(f.k00, q0, z, 0, 0, 0); s0 = __builtin_amdgcn_mfma_f32_16x16x32_bf16(f.k01, q1, s0, 0, 0, 0);
    f32x4 s1 = __builtin_amdgcn_mfma_f32_16x16x32_bf16(f.k10, q0, z, 0, 0, 0); s1 = __builtin_amdgcn_mfma_f32_16x16x32_bf16(f.k11, q1, s1, 0, 0, 0);
    if (HASB) { s0 = s0 + b0; s1 = s1 + b1; }
    float mx = fmaxf(fmaxf(fmaxf(s0[0], s0[1]), fmaxf(s0[2], s0[3])), fmaxf(fmaxf(s1[0], s1[1]), fmaxf(s1[2], s1[3])));
    mx = fmaxf(mx, shx(mx, 16)); mx = fmaxf(mx, shx(mx, 32));
    if (__builtin_amdgcn_ballot_w64(mx > st.m + 8.f) != 0ull) {
        const float mn = fmaxf(st.m, mx);
        const float msn = (mn == -INFINITY) ? 0.f : mn;
        const float alpha = __builtin_amdgcn_exp2f(st.m - msn);
        st.lsum = st.lsum * alpha;
        st.o0 = st.o0 * alpha; st.o1 = st.o1 * alpha; st.o2 = st.o2 * alpha; st.o3 = st.o3 * alpha;
        st.m = mn;
    }
    const float ms = (st.m == -INFINITY) ? 0.f : st.m;
    f32x4 p0, p1;
#pragma unroll
    for (int j = 0; j < 4; ++j) { p0[j] = __builtin_amdgcn_exp2f(s0[j] - ms); p1[j] = __builtin_amdgcn_exp2f(s1[j] - ms); }
    st.lsum = st.lsum + ((p0[0] + p0[1]) + (p0[2] + p0[3])) + ((p1[0] + p1[1]) + (p1[2] + p1[3]));
    union { uint4 u; bf16x8 v; } pt; pt.u = make_uint4(pk2(p0[0], p0[1]), pk2(p0[2], p0[3]), pk2(p1[0], p1[1]), pk2(p1[2], p1[3]));
    st.o0 = __builtin_amdgcn_mfma_f32_16x16x32_bf16(f.v0, pt.v, st.o0, 0, 0, 0);
    st.o1 = __builtin_amdgcn_mfma_f32_16x16x32_bf16(f.v1, pt.v, st.o1, 0, 0, 0);
    st.o2 = __builtin_amdgcn_mfma_f32_16x16x32_bf16(f.v2, pt.v, st.o2, 0, 0, 0);
    st.o3 = __builtin_amdgcn_mfma_f32_16x16x32_bf16(f.v3, pt.v, st.o3, 0, 0, 0);
}
DEV void attn_init(AttnState& st) { const f32x4 z = {0.f, 0.f, 0.f, 0.f}; st.o0 = z; st.o1 = z; st.o2 = z; st.o3 = z; st.m = -INFINITY; st.lsum = 0.f; }
DEV void attn_store(AttnState& st, bf16_t* orow, float sink2  ) {
    float l = st.lsum; l += shx(l, 16); l += shx(l, 32);
    float sc;
    if (sink2 != -INFINITY) { const float mf = fmaxf(st.m, sink2); const float al = __builtin_amdgcn_exp2f(st.m - mf); l = l * al + __builtin_amdgcn_exp2f(sink2 - mf); sc = al / l; }
    else sc = 1.f / l;
    uint2 w;
    w.x = pk2(st.o0[0] * sc, st.o0[1] * sc); w.y = pk2(st.o0[2] * sc, st.o0[3] * sc); *(uint2*)(orow) = w;
    w.x = pk2(st.o1[0] * sc, st.o1[1] * sc); w.y = pk2(st.o1[2] * sc, st.o1[3] * sc); *(uint2*)(orow + 16) = w;
    w.x = pk2(st.o2[0] * sc, st.o2[1] * sc); w.y = pk2(st.o2[2] * sc, st.o2[3] * sc); *(uint2*)(orow + 32) = w;
    w.x = pk2(st.o3[0] * sc, st.o3[1] * sc); w.y = pk2(st.o3[2] * sc, st.o3[3] * sc); *(uint2*)(orow + 48) = w;
}

constexpr int NTASK_NA = NB * 6 * 128 * 4, NTASK_GQ = NB * 2 * 512, NTASK_CNA = NB * 6 * 16, NTASK_CGQ = NB * 2 * 16;
DEV void attn_task(const Params& p, int l, int tk, const float* rpb2  ) {
    const int lane = tid_() & 63, g = lane >> 4, fr = lane & 15;
    const bf16_t* P = (const bf16_t*)(p.ws + OFF_P);
    bf16_t* X1 = (bf16_t*)(p.ws + OFF_X1);
    const f32x4 z4 = {0.f, 0.f, 0.f, 0.f};
    KVFrag f;
    if (tk < NTASK_NA) {
        const int qtile = tk & 3, r = (tk >> 2) & 127, hb = tk >> 9, h = hb % 6, b = hb / 6;
        const int qc = qtile == 0 ? (fr < 8 ? fr : 48 + fr) : 8 + (qtile - 1) * 16 + fr;
        const int ct0 = qtile == 0 ? 0 : qtile - 1, ct1 = qtile == 0 ? 3 : qtile;
        const int R = b * S + r * 64 + qc;
        const bf16_t* qp = P + (size_t)R * PWS + COL_NAQ + h * 64 + g * 8;
        const bf16x8 q0 = ld16(qp), q1 = ld16(qp + 32);
        const int rs = min(max(r - 4, 0), 120), cs = min(max(qc - 8, 0), 48);
        int ci[8]; bool ok[8];
#pragma unroll
        for (int e = 0; e < 8; ++e) { const int kc = ((e >> 2) ? ct1 : ct0) * 16 + g * 4 + (e & 3); ok[e] = (kc >= cs) && (kc < cs + 16); ci[e] = min(max(kc - qc + 15, 0), 30); }
        const bf16_t* kf = (const bf16_t*)(p.ws + OFF_NAKF) + ((size_t)(b * 6 + h) * 512 + rs * 4) * KVT + lane * 8;
        const bf16_t* vf = (const bf16_t*)(p.ws + OFF_NAVF) + ((size_t)(b * 6 + h) * 512 + rs * 4) * KVT + lane * 8;
        AttnState st; attn_init(st);
#pragma unroll
        for (int ri = 0; ri < 8; ++ri) {
            const float* rb = rpb2 + (h * 15 + (rs + ri - r + 7)) * 31;
            f32x4 b0, b1;
#pragma unroll
            for (int j = 0; j < 4; ++j) { b0[j] = ok[j] ? rb[ci[j]] : -INFINITY; b1[j] = ok[4 + j] ? rb[ci[4 + j]] : -INFINITY; }
            kv_load(kf + (size_t)(ri * 4 + ct0) * KVT, kf + (size_t)(ri * 4 + ct1) * KVT, vf + (size_t)(ri * 4 + ct0) * KVT, vf + (size_t)(ri * 4 + ct1) * KVT, f);
            attn_apply<true>(f, q0, q1, b0, b1, st);
        }
        const bf16_t* kc_ = (const bf16_t*)(p.ws + OFF_NAKFC) + (size_t)(b * 6 + h) * 16 * KVT + lane * 8;
        const bf16_t* vc_ = (const bf16_t*)(p.ws + OFF_NAVFC) + (size_t)(b * 6 + h) * 16 * KVT + lane * 8;
#pragma unroll
        for (int pp = 0; pp < 8; ++pp) { kv_load(kc_ + (size_t)(2 * pp) * KVT, kc_ + (size_t)(2 * pp + 1) * KVT, vc_ + (size_t)(2 * pp) * KVT, vc_ + (size_t)(2 * pp + 1) * KVT, f); attn_apply<false>(f, q0, q1, z4, z4, st); }
        attn_store(st, X1 + (size_t)R * D + 256 + h * 64 + g * 4, -INFINITY);
    } else if (tk < NTASK_NA + NTASK_GQ + NTASK_CNA + NTASK_CGQ && (tk < NTASK_NA + NTASK_GQ || tk >= NTASK_NA + NTASK_GQ + NTASK_CNA)) {
        const bool lat = tk < NTASK_NA + NTASK_GQ;
        const int t2 = lat ? tk - NTASK_NA : tk - (NTASK_NA + NTASK_GQ + NTASK_CNA);
        const int qt = lat ? (t2 & 511) : (t2 & 15), hb = lat ? (t2 >> 9) : (t2 >> 4), kvh = hb & 1, b = hb >> 1;
        const int q0i = qt * 16, R = (lat ? b * S : NLAT + b * CTX) + q0i + fr;
        const bf16_t* qp = P + (size_t)R * PWS + COL_GQ + kvh * 192 + g * 8;
        const bf16x8 qa0 = ld16(qp), qa1 = ld16(qp + 32), qb0 = ld16(qp + 64), qb1 = ld16(qp + 96), qc0 = ld16(qp + 128), qc1 = ld16(qp + 160);
        AttnState sa, sb, sc; attn_init(sa); attn_init(sb); attn_init(sc);
        const bf16_t* kf = (const bf16_t*)(p.ws + OFF_GKF) + (size_t)(b * 2 + kvh) * 512 * KVT + lane * 8;
        const bf16_t* vf = (const bf16_t*)(p.ws + OFF_GVF) + (size_t)(b * 2 + kvh) * 512 * KVT + lane * 8;
        const bf16_t* kc_ = (const bf16_t*)(p.ws + OFF_GKFC) + (size_t)(b * 2 + kvh) * 16 * KVT + lane * 8;
        const bf16_t* vc_ = (const bf16_t*)(p.ws + OFF_GVFC) + (size_t)(b * 2 + kvh) * 16 * KVT + lane * 8;
        const int qi = q0i + fr;
#define GQ_LOAD(i, F) do { const int i_ = (i); if (i_ < 9) { const int kt_ = (q0i - 128 + i_ * 32) >> 4; const int ta_ = min(max(kt_, 0), 511), tb_ = min(max(kt_ + 1, 0), 511); \
            kv_load(kf + (size_t)ta_ * KVT, kf + (size_t)tb_ * KVT, vf + (size_t)ta_ * KVT, vf + (size_t)tb_ * KVT, F); } \
        else { const int c_ = (i_ - 9) * 2; kv_load(kc_ + (size_t)c_ * KVT, kc_ + (size_t)(c_ + 1) * KVT, vc_ + (size_t)c_ * KVT, vc_ + (size_t)(c_ + 1) * KVT, F); } } while (0)
#define GQ_APPLY(i, F) do { const int i_ = (i); f32x4 b0_ = z4, b1_ = z4; if (i_ < 9) { const int kb_ = q0i - 128 + i_ * 32; _Pragma("unroll") for (int j = 0; j < 4; ++j) { const int k0_ = kb_ + g * 4 + j, k1_ = k0_ + 16; \
                b0_[j] = (k0_ >= 0 && k0_ < S && k0_ >= qi - 128 && k0_ <= qi + 128) ? 0.f : -INFINITY; b1_[j] = (k1_ >= 0 && k1_ < S && k1_ >= qi - 128 && k1_ <= qi + 128) ? 0.f : -INFINITY; } } \
            if (i_ < 9) { attn_apply<true>(F, qa0, qa1, b0_, b1_, sa); attn_apply<true>(F, qb0, qb1, b0_, b1_, sb); attn_apply<true>(F, qc0, qc1, b0_, b1_, sc); } \
            else { attn_apply<false>(F, qa0, qa1, b0_, b1_, sa); attn_apply<false>(F, qb0, qb1, b0_, b1_, sb); attn_apply<false>(F, qc0, qc1, b0_, b1_, sc); } } while (0)
        KVFrag f2;
        const int i0 = lat ? 0 : 9;
        GQ_LOAD(i0, f);
#pragma unroll 1
        for (int i = i0; i < 17; i += 2) {
            if (i + 1 < 17) GQ_LOAD(i + 1, f2);
            GQ_APPLY(i, f);
            if (i + 1 < 17) { if (i + 2 < 17) GQ_LOAD(i + 2, f); GQ_APPLY(i + 1, f2); }
        }
#undef GQ_LOAD
#undef GQ_APPLY
        bf16_t* o = X1 + (size_t)R * D + 640 + kvh * 192 + g * 4;
        attn_store(sa, o, p.gqa_sink[l * 6 + kvh * 3 + 0] * LOG2E); attn_store(sb, o + 64, p.gqa_sink[l * 6 + kvh * 3 + 1] * LOG2E); attn_store(sc, o + 128, p.gqa_sink[l * 6 + kvh * 3 + 2] * LOG2E);
    } else {
        const int t3 = tk - NTASK_NA - NTASK_GQ, qt = t3 & 15, hb = t3 >> 4, h = hb % 6, b = hb / 6;
        const int R = NLAT + b * CTX + qt * 16 + fr;
        const bf16_t* qp = P + (size_t)R * PWS + COL_NAQ + h * 64 + g * 8;
        const bf16x8 q0 = ld16(qp), q1 = ld16(qp + 32);
        AttnState st; attn_init(st);
        const bf16_t* kc_ = (const bf16_t*)(p.ws + OFF_NAKFC) + (size_t)(b * 6 + h) * 16 * KVT + lane * 8;
        const bf16_t* vc_ = (const bf16_t*)(p.ws + OFF_NAVFC) + (size_t)(b * 6 + h) * 16 * KVT + lane * 8;
#pragma unroll
        for (int pp = 0; pp < 8; ++pp) { kv_load(kc_ + (size_t)(2 * pp) * KVT, kc_ + (size_t)(2 * pp + 1) * KVT, vc_ + (size_t)(2 * pp) * KVT, vc_ + (size_t)(2 * pp + 1) * KVT, f); attn_apply<false>(f, q0, q1, z4, z4, st); }
        attn_store(st, X1 + (size_t)R * D + 256 + h * 64 + g * 4, -INFINITY);
    }
}
DEV void ph_attn(const Params& p, int l, float* rpb2  ) {
    for (int i = tid_(); i < 6 * 15 * 31; i += 256) rpb2[i] = p.na_rpb[(size_t)l * 6 * 15 * 31 + i] * LOG2E;
    __syncthreads();
    const int w = tid_() >> 6;
    const int ntask = NTASK_NA + NTASK_GQ + (l == 0 ? NTASK_CNA + NTASK_CGQ : 0);
    for (int tk0 = bid_() * 4 + w; tk0 < ntask; tk0 += gridDim.x * 4) {
        const int tk = tk0 < NTASK_GQ ? NTASK_NA + tk0 : (tk0 < NTASK_GQ + NTASK_NA ? tk0 - NTASK_GQ : tk0);
        attn_task(p, l, tk, rpb2);
    }
}

template <int CTRL> DEV float dppf(float old, float v) { return __builtin_bit_cast(float, __builtin_amdgcn_update_dpp(__builtin_bit_cast(int, old), __builtin_bit_cast(int, v), CTRL, 0xf, 0xf, false)); }
template <bool FWD> DEV void row_scan(float& a, float& b) {
#define RG_STEP(SHR, SHL) { const float ap = FWD ? dppf<SHR>(1.f, a) : dppf<SHL>(1.f, a); const float bp = FWD ? dppf<SHR>(0.f, b) : dppf<SHL>(0.f, b); b = fmaf(a, bp, b); a = a * ap; }
    RG_STEP(0x111, 0x101) RG_STEP(0x112, 0x102) RG_STEP(0x114, 0x104) RG_STEP(0x118, 0x108)
#undef RG_STEP
}
DEV int rg_bwd_chunk(int pos) { return pos == 0 ? 1 : (pos == 1 ? 0 : 67 - pos); }
DEV void rg_coef(const f32x4& za, const f32x4& zi, const f32x4& ba, const f32x4& bi, const f32x4& spc, const f32x4& xv, f32x4& a, f32x4& b) {
#pragma unroll
    for (int j = 0; j < 4; ++j) {
        const float r = 1.f / (1.f + __expf(-(za[j] + ba[j])));
        const float ig = 1.f / (1.f + __expf(-(zi[j] + bi[j])));
        const float la = spc[j] * r;
        const float av = __expf(la);
        const float x2 = 2.f * la;
        float om = x2 * (1.f / 720.f) + (1.f / 120.f); om = om * x2 + (1.f / 24.f); om = om * x2 + (1.f / 6.f); om = om * x2 + 0.5f; om = om * x2 + 1.f; om = -x2 * om;
        if (x2 < -0.25f) om = 1.f - av * av;
        a[j] = av; b[j] = sqrtf(om) * (ig * xv[j]);
    }
}
DEV void rg_item(const Params& p, int l, int rt, bf16_t* lds) {
    const int t = tid_(), lane = t & 63, n = t >> 6, g = lane >> 4, fr = lane & 15;
    const bf16_t* P = (const bf16_t*)(p.ws + OFF_P);
    const bool isctx = rt >= 512;
    const int b = isctx ? (rt - 512) >> 1 : rt >> 6, idx = isctx ? (rt - 512) & 1 : 2 + (rt & 63);
    const int L = isctx ? CTX : S, t0 = isctx ? idx * 128 : (idx - 2) * 128, seqbase = isctx ? NLAT + b * CTX : b * S;
    bf16_t* xl = lds + n * (128 * 64);
    {
        const int c = lane & 7, ch0 = n * 64 + c * 8;
        f32x4 cwa[4], cwb[4];
#pragma unroll
        for (int j = 0; j < 4; ++j) { cwa[j] = *(const f32x4*)(p.conv_w + (l * 4 + j) * 256 + ch0); cwb[j] = *(const f32x4*)(p.conv_w + (l * 4 + j) * 256 + ch0 + 4); }
        const f32x4 cba = *(const f32x4*)(p.conv_b + l * 256 + ch0), cbb = *(const f32x4*)(p.conv_b + l * 256 + ch0 + 4);
#pragma unroll 2
        for (int it = 0; it < 16; ++it) {
            const int tok = it * 8 + (lane >> 3), ts = t0 + tok;
            f32x4 acca = cba, accb = cbb;
#pragma unroll
            for (int j = 0; j < 4; ++j) {
                const int tj = ts + j - 2;
                if (tj >= 0 && tj < L) {
                    const uint4 v = *(const uint4*)(P + (size_t)(seqbase + tj) * PWS + COL_RGX + ch0);
                    const f32x4 xa = {__uint_as_float(v.x << 16), __uint_as_float(v.x & 0xffff0000u), __uint_as_float(v.y << 16), __uint_as_float(v.y & 0xffff0000u)};
                    const f32x4 xb = {__uint_as_float(v.z << 16), __uint_as_float(v.z & 0xffff0000u), __uint_as_float(v.w << 16), __uint_as_float(v.w & 0xffff0000u)};
                    acca = acca + cwa[j] * xa; accb = accb + cwb[j] * xb;
                }
            }
            uint4 o; o.x = pk2(acca[0], acca[1]); o.y = pk2(acca[2], acca[3]); o.z = pk2(accb[0], accb[1]); o.w = pk2(accb[2], accb[3]);
            *(uint4*)(xl + tok * 64 + ((c ^ ((tok >> 1) & 7)) * 8)) = o;
        }
    }
    asm volatile("s_waitcnt lgkmcnt(0)" ::: "memory");
    const bf16_t* W = (const bf16_t*)(p.ws + OFF_WRG) + (size_t)(l * 2) * 2 * 4 * 64 * 64;
    const float* C = (const float*)(p.ws + OFF_RGC) + (size_t)(l * 2) * 3 * 256;
    float* AGG = (float*)(p.ws + OFF_AGG) + (size_t)(b * 66) * 1024;
    const int swz = (fr >> 1) & 7;
#pragma unroll 1
    for (int ct = 0; ct < 4; ++ct) {
        const int ch = n * 64 + ct * 16 + g * 4;
        const f32x4 z4 = {0.f, 0.f, 0.f, 0.f};
#pragma unroll
        for (int dir = 0; dir < 2; ++dir) {
            const bf16x8 wa0 = ld16(W + ((size_t)((dir * 2 + 0) * 4 + n) * 64 + ct * 16 + fr) * 64 + g * 8), wa1 = ld16(W + ((size_t)((dir * 2 + 0) * 4 + n) * 64 + ct * 16 + fr) * 64 + 32 + g * 8);
            const bf16x8 wi0 = ld16(W + ((size_t)((dir * 2 + 1) * 4 + n) * 64 + ct * 16 + fr) * 64 + g * 8), wi1 = ld16(W + ((size_t)((dir * 2 + 1) * 4 + n) * 64 + ct * 16 + fr) * 64 + 32 + g * 8);
            const f32x4 ba = *(const f32x4*)(C + (dir * 3 + 0) * 256 + ch), bi = *(const f32x4*)(C + (dir * 3 + 1) * 256 + ch), spc = *(const f32x4*)(C + (dir * 3 + 2) * 256 + ch);
            f32x4 hin = z4, apre = {1.f, 1.f, 1.f, 1.f};
#pragma unroll
            for (int s = 0; s < 8; ++s) {
                const int tt = dir == 0 ? s : 7 - s;
                const int row = tt * 16 + fr;
                const bf16x8 x0 = *(const bf16x8*)(xl + row * 64 + ((g ^ swz) * 8)), x1 = *(const bf16x8*)(xl + row * 64 + (((g | 4) ^ swz) * 8));
                f32x4 za = __builtin_amdgcn_mfma_f32_16x16x32_bf16(wa0, x0, z4, 0, 0, 0); za = __builtin_amdgcn_mfma_f32_16x16x32_bf16(wa1, x1, za, 0, 0, 0);
                f32x4 zi = __builtin_amdgcn_mfma_f32_16x16x32_bf16(wi0, x0, z4, 0, 0, 0); zi = __builtin_amdgcn_mfma_f32_16x16x32_bf16(wi1, x1, zi, 0, 0, 0);
                const uint2 xr = *(const uint2*)(xl + row * 64 + (((ct * 2 + (g >> 1)) ^ swz) * 8) + (g & 1) * 4);
                const f32x4 xv = {__uint_as_float(xr.x << 16), __uint_as_float(xr.x & 0xffff0000u), __uint_as_float(xr.y << 16), __uint_as_float(xr.y & 0xffff0000u)};
                f32x4 a, bb;
                rg_coef(za, zi, ba, bi, spc, xv, a, bb);
                f32x4 h, ac;
#pragma unroll
                for (int j = 0; j < 4; ++j) {
                    float aj = a[j], bj = bb[j];
                    if (dir == 0) row_scan<true>(aj, bj); else row_scan<false>(aj, bj);
                    h[j] = fmaf(aj, hin[j], bj);
                    ac[j] = aj * apre[j];
                }
                {
                    bf16_t* xo = (bf16_t*)(p.ws + OFF_X2) + ((size_t)seqbase + t0 + row) * D + dir * 512 + ch;
                    uint2 o; o.x = pk2(ac[0], ac[1]); o.y = pk2(ac[2], ac[3]); *(uint2*)xo = o;
                    o.x = pk2(h[0], h[1]); o.y = pk2(h[2], h[3]); *(uint2*)(xo + 256) = o;
                }
                const int src = (lane & 48) | (dir == 0 ? 15 : 0);
#pragma unroll
                for (int j = 0; j < 4; ++j) { hin[j] = shl_(h[j], src); apre[j] = shl_(ac[j], src); }
            }
            if (fr == 0) { *(f32x4*)(AGG + (size_t)(idx * 2 + dir) * 512 + ch) = apre; *(f32x4*)(AGG + (size_t)(idx * 2 + dir) * 512 + 256 + ch) = hin; }
        }
    }
}
DEV void rg_final(const Params& p, int l, int rt, float* part  ) {
    const int t = tid_(), cg4 = (t & 63) * 4, tp = t >> 6;
    const bool isctx = rt >= 512;
    const int b = isctx ? (rt - 512) >> 1 : rt >> 6, idx = isctx ? (rt - 512) & 1 : 2 + (rt & 63);
    const float* AGG = (const float*)(p.ws + OFF_AGG) + (size_t)(b * 66) * 1024;
    f32x4 hf = {0.f, 0.f, 0.f, 0.f}, hb = {0.f, 0.f, 0.f, 0.f};
    {
        const int nf = idx, nb = idx == 1 ? 0 : (idx == 0 ? 1 : 67 - idx);
        const int qf = (nf + 3) >> 2, qb = (nb + 3) >> 2;
        f32x4 Af = {1.f, 1.f, 1.f, 1.f}, Bf = {0.f, 0.f, 0.f, 0.f}, Ab = Af, Bb = Bf;
#pragma unroll 4
        for (int q = tp * qf; q < min((tp + 1) * qf, nf); ++q) { const f32x4 A = *(const f32x4*)(AGG + (size_t)(q * 2) * 512 + cg4), B = *(const f32x4*)(AGG + (size_t)(q * 2) * 512 + 256 + cg4); Bf = A * Bf + B; Af = A * Af; }
#pragma unroll 4
        for (int q = tp * qb; q < min((tp + 1) * qb, nb); ++q) { const int cq = rg_bwd_chunk(q); const f32x4 A = *(const f32x4*)(AGG + (size_t)(cq * 2 + 1) * 512 + cg4), B = *(const f32x4*)(AGG + (size_t)(cq * 2 + 1) * 512 + 256 + cg4); Bb = A * Bb + B; Ab = A * Ab; }
        *(f32x4*)(part + ((tp * 2 + 0) * 2 + 0) * 256 + cg4) = Af; *(f32x4*)(part + ((tp * 2 + 0) * 2 + 1) * 256 + cg4) = Bf;
        *(f32x4*)(part + ((tp * 2 + 1) * 2 + 0) * 256 + cg4) = Ab; *(f32x4*)(part + ((tp * 2 + 1) * 2 + 1) * 256 + cg4) = Bb;
        __syncthreads();
#pragma unroll
        for (int k = 0; k < 4; ++k) {
            hf = *(const f32x4*)(part + ((k * 2 + 0) * 2 + 0) * 256 + cg4) * hf + *(const f32x4*)(part + ((k * 2 + 0) * 2 + 1) * 256 + cg4);
            hb = *(const f32x4*)(part + ((k * 2 + 1) * 2 + 0) * 256 + cg4) * hb + *(const f32x4*)(part + ((k * 2 + 1) * 2 + 1) * 256 + cg4);
        }
    }
    const bf16_t* X2 = (const bf16_t*)(p.ws + OFF_X2); const bf16_t* P = (const bf16_t*)(p.ws + OFF_P); bf16_t* X1 = (bf16_t*)(p.ws + OFF_X1);
#pragma unroll 4
    for (int i = 0; i < 32; ++i) {
        const size_t R = (size_t)rt * 128 + i * 4 + tp;
        const uint2 af = *(const uint2*)(X2 + R * D + cg4), bf = *(const uint2*)(X2 + R * D + 256 + cg4), ab = *(const uint2*)(X2 + R * D + 512 + cg4), bb = *(const uint2*)(X2 + R * D + 768 + cg4);
        const uint2 gr = *(const uint2*)(P + R * PWS + COL_GATE + cg4);
#define BLO(u) __uint_as_float((u) << 16)
#define BHI(u) __uint_as_float((u) & 0xffff0000u)
        const float h0 = (BLO(af.x) * hf[0] + BLO(bf.x)) + (BLO(ab.x) * hb[0] + BLO(bb.x));
        const float h1 = (BHI(af.x) * hf[1] + BHI(bf.x)) + (BHI(ab.x) * hb[1] + BHI(bb.x));
        const float h2 = (BLO(af.y) * hf[2] + BLO(bf.y)) + (BLO(ab.y) * hb[2] + BLO(bb.y));
        const float h3 = (BHI(af.y) * hf[3] + BHI(bf.y)) + (BHI(ab.y) * hb[3] + BHI(bb.y));
        uint2 o; o.x = pk2(h0 * gelu_tanh(BLO(gr.x)), h1 * gelu_tanh(BHI(gr.x))); o.y = pk2(h2 * gelu_tanh(BLO(gr.y)), h3 * gelu_tanh(BHI(gr.y)));
#undef BLO
#undef BHI
        *(uint2*)(X1 + R * D + cg4) = o;
    }
}
DEV void ph_rgagg(const Params& p, int l, bf16_t* lds) {
    for (int rt = bid_(); rt < 528; rt += gridDim.x) { rg_item(p, l, rt, lds); __syncthreads(); }
}

DEV void outproj_item(const Params& p_, int l, int rt, bf16_t* lds, float* stat  ) {
    const Params& p = kp_();
    const int t = tid_(), lane = t & 63, w = t >> 6, wm = w >> 1, wn = w & 1, fq = lane >> 4, fr = lane & 15;
    const bf16_t* A = (const bf16_t*)(p.ws + OFF_X1) + (size_t)(rt * 128) * D;
    const bool isctx = rt >= 512;
    const float* g1 = modvec(p, l, rt * 128, 2);
    __syncthreads();
    rg_final(p, l, rt, (float*)lds);
    asm volatile("s_waitcnt vmcnt(0)" ::: "memory");
    __syncthreads();
    __builtin_amdgcn_fence(__ATOMIC_ACQUIRE, "agent");
#pragma unroll 1
    for (int pass = 0; pass < 4; ++pass) {
        const bf16_t* Bt = (const bf16_t*)(p.ws + OFF_WOUTT) + ((size_t)l * 1024 + pass * 256) * 1024;
        const unsigned toff = (unsigned)(((tid_() >> 2) * 1024 + gemm_src_chunk(tid_())) * 2);
        f32x4 acc[4][8]; zero_acc(acc);
        gemm_mainloop(A, toff, toff + 64 * D * 2, Bt, toff, 1024, 32, lds, acc);
#pragma unroll
        for (int mt = 0; mt < 4; ++mt) {
            const int rl = wm * 64 + mt * 16 + fr, R = rt * 128 + rl;
            const float* xin = (l == 0) ? (isctx ? p.ctx + (size_t)(R - NLAT) * D : p.x + (size_t)R * D) : xres_row(p, R);
            float* xo = xres_row(p, R);
            float s = 0.f, q = 0.f;
#pragma unroll
            for (int nt = 0; nt < 8; ++nt) {
                const int col = pass * 256 + wn * 128 + nt * 16 + fq * 4;
                const f32x4 xv = *(const f32x4*)(xin + col), gv = *(const f32x4*)(g1 + col);
                const f32x4 u = xv * ALPHA + gv * acc[mt][nt];
                *(f32x4*)(xo + col) = u;
                s += (u[0] + u[1]) + (u[2] + u[3]); q += (u[0] * u[0] + u[1] * u[1]) + (u[2] * u[2] + u[3] * u[3]);
            }
            s += shx(s, 16); s += shx(s, 32); q += shx(q, 16); q += shx(q, 32);
            if (fq == 0) { float* sp = stat + (wn * 128 + rl) * 2; if (pass == 0) { sp[0] = s; sp[1] = q; } else { sp[0] += s; sp[1] += q; } }
        }
    }
    asm volatile("s_waitcnt vmcnt(0)" ::: "memory");
    __syncthreads();
    __builtin_amdgcn_fence(__ATOMIC_ACQUIRE, "agent");
    {
        bf16_t* X2 = (bf16_t*)(p.ws + OFF_X2);
        const bf16_t* WRh = (const bf16_t*)(p.ws + OFF_WR) + (size_t)(l * 2) * 48 * 1024 + (size_t)fr * 1024 + fq * 8;
        const bf16_t* WRl = WRh + 48 * 1024;
        float* vec = (float*)((unsigned char*)lds + 24576);
        {
            const float* lg = p.ln1_g + l * D; const float* lb = p.ln1_b + l * D;
            const float* sh2 = modvec(p, l, rt * 128, 3); const float* sc2 = modvec(p, l, rt * 128, 4);
            const int k4 = t * 4;
            *(f32x4*)(vec + k4) = *(const f32x4*)(lg + k4); *(f32x4*)(vec + 1024 + k4) = *(const f32x4*)(lb + k4);
            *(f32x4*)(vec + 2048 + k4) = *(const f32x4*)(sc2 + k4) + 1.f; *(f32x4*)(vec + 3072 + k4) = *(const f32x4*)(sh2 + k4);
        }
        float mean[2], rstd[2];
#pragma unroll
        for (int tm = 0; tm < 2; ++tm) {
            const int rl = w * 32 + tm * 16 + fr;
            float s = 0.f, q = 0.f;
#pragma unroll
            for (int i = 0; i < 2; ++i) { s += stat[(i * 128 + rl) * 2]; q += stat[(i * 128 + rl) * 2 + 1]; }
            mean[tm] = s * (1.f / D);
            rstd[tm] = rsqrtf(fmaxf(q * (1.f / D) - mean[tm] * mean[tm], 0.f) + LN_EPS);
        }
        __syncthreads();
        float* xr0 = xres_row(p, rt * 128 + w * 32 + fr) + fq * 8;
        float* xr1 = xres_row(p, rt * 128 + w * 32 + 16 + fr) + fq * 8;
        bf16_t* h20 = X2 + (size_t)(rt * 128 + w * 32 + fr) * D + fq * 8; bf16_t* h21 = h20 + (size_t)16 * D;
        f32x4 lacc[3][2];
#pragma unroll
        for (int a = 0; a < 3; ++a) { lacc[a][0] = (f32x4){0.f, 0.f, 0.f, 0.f}; lacc[a][1] = (f32x4){0.f, 0.f, 0.f, 0.f}; }
        f32x4 nu00 = *(const f32x4*)xr0, nu01 = *(const f32x4*)(xr0 + 4), nu10 = *(const f32x4*)xr1, nu11 = *(const f32x4*)(xr1 + 4);
        bf16x8 nwh0 = *(const bf16x8*)(WRh), nwh1 = *(const bf16x8*)(WRh + 16 * 1024), nwh2 = *(const bf16x8*)(WRh + 32 * 1024);
        bf16x8 nwl0 = *(const bf16x8*)(WRl), nwl1 = *(const bf16x8*)(WRl + 16 * 1024), nwl2 = *(const bf16x8*)(WRl + 32 * 1024);
#pragma unroll 2
        for (int ks = 0; ks < 32; ++ks) {
            const f32x4 u00 = nu00, u01 = nu01, u10 = nu10, u11 = nu11;
            const bf16x8 wh0 = nwh0, wh1 = nwh1, wh2 = nwh2, wl0 = nwl0, wl1 = nwl1, wl2 = nwl2;
            if (ks + 1 < 32) {
                const int ko = (ks + 1) * 32;
                nu00 = *(const f32x4*)(xr0 + ko); nu01 = *(const f32x4*)(xr0 + ko + 4); nu10 = *(const f32x4*)(xr1 + ko); nu11 = *(const f32x4*)(xr1 + ko + 4);
                nwh0 = *(const bf16x8*)(WRh + ko); nwh1 = *(const bf16x8*)(WRh + 16 * 1024 + ko); nwh2 = *(const bf16x8*)(WRh + 32 * 1024 + ko);
                nwl0 = *(const bf16x8*)(WRl + ko); nwl1 = *(const bf16x8*)(WRl + 16 * 1024 + ko); nwl2 = *(const bf16x8*)(WRl + 32 * 1024 + ko);
            }
            const int k = ks * 32 + fq * 8;
            const f32x4 g0 = *(const f32x4*)(vec + k), g1v = *(const f32x4*)(vec + k + 4), b0 = *(const f32x4*)(vec + 1024 + k), b1 = *(const f32x4*)(vec + 1024 + k + 4);
            const f32x4 c0 = *(const f32x4*)(vec + 2048 + k), c1 = *(const f32x4*)(vec + 2048 + k + 4), s0 = *(const f32x4*)(vec + 3072 + k), s1 = *(const f32x4*)(vec + 3072 + k + 4);
            bf16x8 hh0, hl0, hh1, hl1;
            {
                const f32x4 x0 = (u00 - mean[0]) * rstd[0] * g0 + b0, x1 = (u01 - mean[0]) * rstd[0] * g1v + b1;
                *(f32x4*)(xr0 + ks * 32) = x0; *(f32x4*)(xr0 + ks * 32 + 4) = x1;
                const f32x4 h0 = x0 * c0 + s0, h1 = x1 * c1 + s1;
#pragma unroll
                for (int e = 0; e < 4; ++e) { const bf16_t a = f2bf(h0[e]), b = f2bf(h1[e]); hh0[e] = (short)a; hh0[4 + e] = (short)b; hl0[e] = (short)f2bf(h0[e] - bf2f(a)); hl0[4 + e] = (short)f2bf(h1[e] - bf2f(b)); }
                *(bf16x8*)(h20 + ks * 32) = hh0;
            }
            {
                const f32x4 x0 = (u10 - mean[1]) * rstd[1] * g0 + b0, x1 = (u11 - mean[1]) * rstd[1] * g1v + b1;
                *(f32x4*)(xr1 + ks * 32) = x0; *(f32x4*)(xr1 + ks * 32 + 4) = x1;
                const f32x4 h0 = x0 * c0 + s0, h1 = x1 * c1 + s1;
#pragma unroll
                for (int e = 0; e < 4; ++e) { const bf16_t a = f2bf(h0[e]), b = f2bf(h1[e]); hh1[e] = (short)a; hh1[4 + e] = (short)b; hl1[e] = (short)f2bf(h0[e] - bf2f(a)); hl1[4 + e] = (short)f2bf(h1[e] - bf2f(b)); }
                *(bf16x8*)(h21 + ks * 32) = hh1;
            }
#define RT_MMA(ft, WH, WL) do { \
            lacc[ft][0] = __builtin_amdgcn_mfma_f32_16x16x32_bf16(WH, hh0, lacc[ft][0], 0, 0, 0); lacc[ft][0] = __builtin_amdgcn_mfma_f32_16x16x32_bf16(WL, hh0, lacc[ft][0], 0, 0, 0); lacc[ft][0] = __builtin_amdgcn_mfma_f32_16x16x32_bf16(WH, hl0, lacc[ft][0], 0, 0, 0); \
            lacc[ft][1] = __builtin_amdgcn_mfma_f32_16x16x32_bf16(WH, hh1, lacc[ft][1], 0, 0, 0); lacc[ft][1] = __builtin_amdgcn_mfma_f32_16x16x32_bf16(WL, hh1, lacc[ft][1], 0, 0, 0); lacc[ft][1] = __builtin_amdgcn_mfma_f32_16x16x32_bf16(WH, hl1, lacc[ft][1], 0, 0, 0); } while (0)
            RT_MMA(0, wh0, wl0); RT_MMA(1, wh1, wl1); RT_MMA(2, wh2, wl2);
#undef RT_MMA
        }
        __syncthreads();
        float* lt = (float*)lds;
        int* lcnt = (int*)((unsigned char*)lds + 24576); int* lbase = lcnt + 32;
        if (t < 32) lcnt[t] = 0;
#pragma unroll
        for (int ft = 0; ft < 3; ++ft)
#pragma unroll
            for (int tm = 0; tm < 2; ++tm)
#pragma unroll
                for (int j = 0; j < 4; ++j) lt[(w * 32 + tm * 16 + fr) * 48 + ft * 16 + fq * 4 + j] = lacc[ft][tm][j];
        __syncthreads();
        int E0 = 0, E1 = 0, r0 = 0, r1 = 0; float w0 = 0.f, w1 = 0.f;
        const int rl = w * 32 + (lane & 31), R = rt * 128 + rl;
        if (lane < 32) {
            const float* lr = lt + rl * 48;
            int gi = 0; float gm = lr[0] + p.router_g_b[l * 4];
            float gl[4]; gl[0] = gm;
#pragma unroll
            for (int j = 1; j < 4; ++j) { gl[j] = lr[j] + p.router_g_b[l * 4 + j]; if (gl[j] > gm) { gm = gl[j]; gi = j; } }
            float gs = 0.f;
#pragma unroll
            for (int j = 0; j < 4; ++j) gs += expf(gl[j] - gm);
            const float ptop = 1.f / gs;
            int e0 = 0, e1 = 0; float m0 = -INFINITY, m1 = -INFINITY;
            for (int j = 0; j < 8; ++j) {
                const float v = lr[4 + gi * 8 + j] + p.router_e_b[l * 32 + gi * 8 + j];
                if (v > m0) { m1 = m0; e1 = e0; m0 = v; e0 = j; } else if (v > m1) { m1 = v; e1 = j; }
            }
            const float ex = expf(m1 - m0);
            w0 = ptop / (1.f + ex); w1 = ptop * ex / (1.f + ex);
            E0 = gi * 8 + e0; E1 = gi * 8 + e1;
            r0 = atomicAdd(lcnt + E0, 1); r1 = atomicAdd(lcnt + E1, 1);
        }
        __syncthreads();
        if (t < 32) { const int c = lcnt[t]; lbase[t] = c ? (int)atomicAdd((unsigned*)(p.ws + OFF_CTL) + CW_CNT + l * 32 + t, (unsigned)c) : 0; }
        __syncthreads();
        if (lane < 32) {
            int* rte = (int*)(p.ws + OFF_RTE); float* rtw = (float*)(p.ws + OFF_RTW);
            int* list = (int*)(p.ws + OFF_LIST);
            rte[R * 2] = E0; rte[R * 2 + 1] = E1; rtw[R * 2] = w0; rtw[R * 2 + 1] = w1;
            list[(size_t)E0 * LISTCAP + lbase[E0] + r0] = R * 2;
            list[(size_t)E1 * LISTCAP + lbase[E1] + r1] = R * 2 + 1;
        }
    }
}
DEV void ph_outproj(const Params& p, int l, bf16_t* lds, float* stat  ) {
    for (int rt = bid_(); rt < 512; rt += gridDim.x) { outproj_item(p, l, rt, lds, stat); __syncthreads(); }
}

DEV void moe1_item(const Params& p_, int l, int e, int jb, int pass, int item, int cnt, bf16_t* lds) {
    const Params& p = kp_();
    const int t = tid_(), lane = t & 63, w = t >> 6, wm = w >> 1, wn = w & 1, fq = lane >> 4, fr = lane & 15;
    const int* list = (const int*)(p.ws + OFF_LIST) + (size_t)e * LISTCAP;
    const bf16_t* X2 = (const bf16_t*)(p.ws + OFF_X2);
    bf16_t* Hs = (bf16_t*)(p.ws + OFF_P) + (size_t)item * 128 * FF;
    unsigned ao0, ao1;
    { const int s0 = jb * 128 + (t >> 2), s1 = s0 + 64;
      const int tok0 = s0 < cnt ? (list[s0] >> 1) : 0, tok1 = s1 < cnt ? (list[s1] >> 1) : 0;
      ao0 = (unsigned)((tok0 * D + gemm_src_chunk(t)) * 2); ao1 = (unsigned)((tok1 * D + gemm_src_chunk(t)) * 2); }
    const bf16_t* Bt = (const bf16_t*)(p.ws + OFF_WGU) + ((size_t)e * 1024 + pass * 256) * 1024;
    f32x4 acc[4][8]; zero_acc(acc);
    gemm_mainloop(X2, ao0, ao1, Bt, (unsigned)(((t >> 2) * 1024 + gemm_src_chunk(t)) * 2), 1024, 32, lds, acc);
#pragma unroll
    for (int mt = 0; mt < 4; ++mt) {
        const int rl = wm * 64 + mt * 16 + fr;
#pragma unroll
        for (int nt = 0; nt < 4; ++nt) {
            const f32x4 gv = acc[mt][nt], uv = acc[mt][nt + 4];
            float hv[4];
#pragma unroll
            for (int jj = 0; jj < 4; ++jj) hv[jj] = gv[jj] / (1.f + __expf(-gv[jj])) * uv[jj];
            uint2 o; o.x = pk2(hv[0], hv[1]); o.y = pk2(hv[2], hv[3]);
            *(uint2*)(Hs + (size_t)rl * FF + pass * 128 + wn * 64 + nt * 16 + fq * 4) = o;
        }
    }
}
DEV void moe2_item(const Params& p_, int l, int e, int jb, int pass, int item, int cnt, bf16_t* lds) {
    const Params& p = kp_();
    const int t = tid_(), lane = t & 63, w = t >> 6, wm = w >> 1, wn = w & 1, fq = lane >> 4, fr = lane & 15;
    const int* list = (const int*)(p.ws + OFF_LIST) + (size_t)e * LISTCAP;
    const bf16_t* Hs = (const bf16_t*)(p.ws + OFF_P) + (size_t)item * 128 * FF;
    const unsigned hoff = (unsigned)(((t >> 2) * FF + gemm_src_chunk(t)) * 2);
    const float* rtw = (const float*)(p.ws + OFF_RTW);
    bf16_t* Y = (bf16_t*)(p.ws + OFF_Y);
    const bf16_t* Bt = (const bf16_t*)(p.ws + OFF_WD) + ((size_t)e * 1024 + pass * 256) * FF;
    f32x4 acc[4][8]; zero_acc(acc);
    gemm_mainloop(Hs, hoff, hoff + 64 * FF * 2, Bt, hoff, FF, 16, lds, acc);
#pragma unroll
    for (int mt = 0; mt < 4; ++mt) {
        const int s = jb * 128 + wm * 64 + mt * 16 + fr;
        if (s < cnt) {
            const int ent = list[s];
            const float gw = rtw[ent];
            bf16_t* yo = Y + (size_t)ent * D + pass * 256 + wn * 128 + fq * 4;
#pragma unroll
            for (int nt = 0; nt < 8; ++nt) { const f32x4 v = acc[mt][nt] * gw; uint2 o; o.x = pk2(v[0], v[1]); o.y = pk2(v[2], v[3]); *(uint2*)(yo + nt * 16) = o; }
        }
    }
}
template <int STAGE> DEV void ph_moe(const Params& p, int l, bf16_t* lds, int* s_pref  , int* s_cnt  ) {
    const unsigned* cnt = (const unsigned*)(p.ws + OFF_CTL) + CW_CNT + l * 32;
    if (tid_() == 0) { int a = 0; for (int e = 0; e < 32; ++e) { const int c = (int)cnt[e]; s_cnt[e] = c; s_pref[e] = a; a += (c + 127) >> 7; } s_pref[32] = a; }
    __syncthreads();
    const int nx = gridDim.x >> 3, xcd = bid_() & 7, j = bid_() >> 3;
    if (bid_() < nx * 8) {
        const int n0 = (s_cnt[xcd] + 127) >> 7, n1 = (s_cnt[xcd + 8] + 127) >> 7, n2 = (s_cnt[xcd + 16] + 127) >> 7, n3 = (s_cnt[xcd + 24] + 127) >> 7;
        const int nloc = (n0 + n1 + n2 + n3) * 4;
        for (int i = j; i < nloc; i += nx) {
            const int pass = i & 3, ib = i >> 2;
            int e, jb;
            if (ib < n0) { e = xcd; jb = ib; } else if (ib < n0 + n1) { e = xcd + 8; jb = ib - n0; } else if (ib < n0 + n1 + n2) { e = xcd + 16; jb = ib - n0 - n1; } else { e = xcd + 24; jb = ib - n0 - n1 - n2; }
            if (STAGE == 1) moe1_item(p, l, e, jb, pass, s_pref[e] + jb, s_cnt[e], lds); else moe2_item(p, l, e, jb, pass, s_pref[e] + jb, s_cnt[e], lds);
        }
    }
    __syncthreads();
}

DEV void ph_rowin(const Params& p, int l, bf16_t* lds, int* slot, int ph) {
    const int np = l == 0 ? 9 : 5, nci = 16 * np, ntot = nci + 1024;
    unsigned* ctr = (unsigned*)(p.ws + OFF_CTL) + CW_Q + ph * 8;
    const int w = tid_() >> 6;
    for (;;) {
        const int it = q_pull(ctr, slot);
        if (it >= ntot) break;
        if (it < nci) {
            const int rt = 512 + it / np, pass = it % np;
            for (int r = w * 2; r < 128; r += 8) { if (l == 0) rowop<0, true>(p, 0, rt * 128 + r); else rowop<1, false>(p, 1, rt * 128 + r); }
            asm volatile("s_waitcnt vmcnt(0)" ::: "memory");
            __syncthreads();
            __builtin_amdgcn_fence(__ATOMIC_ACQUIRE, "agent");
            inproj_item(p, l, rt, pass, lds);
        } else {
            const int r0 = (it - nci) * 64;
            for (int r = w * 2; r < 64; r += 8) { if (l == 0) rowop<0, true>(p, 0, r0 + r); else rowop<1, true>(p, 1, r0 + r); }
        }
    }
}
DEV void ph_inproj2(const Params& p, int l, bf16_t* lds, int* slot, int ph) {
    const int xcd = bid_() & 7;
    unsigned* ctr = (unsigned*)(p.ws + OFF_CTL) + CW_Q + ph * 8 + xcd;
    const int ntot = 2 + 576 + (l == 0 ? 32 : 0);
    int it = q_pull(ctr, slot);
    while (it < ntot) {
        int nreg = 0;
        if (tid_() == 0) nreg = (int)atomicAdd(ctr, 1u);
        if (it < 2) { rg_item(p, l, 512 + 2 * xcd + it, lds); }
        else if (it < 578) { const int i = it - 2; inproj_item(p, l, xcd * 64 + i / 9, i % 9, lds); }
        else { const int i = it - 578, w = tid_() >> 6;
            const int tk = i < 24 ? NTASK_NA + NTASK_GQ + (xcd * 24 + i) * 4 + w : NTASK_NA + NTASK_GQ + NTASK_CNA + (xcd * 8 + (i - 24)) * 4 + w;
            attn_task(p, l, tk, (const float*)lds); }
        it = q_publish(nreg, slot);
    }
}
DEV void ph_mixer(const Params& p, int l, bf16_t* lds, float* stat, int* slot, int ph) {
    const int xcd = bid_() & 7;
    unsigned* ctr = (unsigned*)(p.ws + OFF_CTL) + CW_Q + ph * 8 + xcd;
    const int n0 = l == 0 ? 2 : 0, n1 = n0 + 64, n2 = n1 + 256, n3 = n2 + 768, ntot = n3 + 192;
    bool rpb_ok = false;
    float* rpb2 = (float*)lds;
    int it = q_pull(ctr, slot);
    while (it < ntot) {
        int nreg = 0;
        if (tid_() == 0) nreg = (int)atomicAdd(ctr, 1u);
        if (it < n0) { outproj_item(p, l, 512 + 2 * xcd + it, lds, stat); rpb_ok = false; }
        else if (it < n1) { rg_item(p, l, xcd * 64 + (it - n0), lds); rpb_ok = false; }
        else if (it < n3) {
            if (!rpb_ok) { for (int i = tid_(); i < 6 * 15 * 31; i += 256) rpb2[i] = p.na_rpb[(size_t)l * 6 * 15 * 31 + i] * LOG2E; __syncthreads(); rpb_ok = true; }
            const int w = tid_() >> 6;
            int tk;
            if (it < n2) { const int i = it - n1; tk = NTASK_NA + (2 * xcd + (i >> 7)) * 512 + (i & 127) * 4 + w; }
            else { const int i = it - n2; tk = (6 * xcd + (i >> 7)) * 512 + (i & 127) * 4 + w; }
            attn_task(p, l, tk, rpb2);
        } else {
            rpb_ok = false;
            const int gi = xcd * 192 + (it - n3);
#pragma unroll 1
            for (int k = 0; k < 8; ++k) {
                const int T = gi * 8 + k, kind = T >> 12, Tl = T & 4095, e = Tl >> 7, tile = Tl & 127;
                if (kind == 0) transpose_tile(p.exp_w_gate + ((size_t)l * NE + e) * 1024 * 512, (bf16_t*)(p.ws + OFF_WGU) + (size_t)e * 1024 * 1024, 1024, 512, 1, tile, (float*)lds);
                else if (kind == 1) transpose_tile(p.exp_w_up + ((size_t)l * NE + e) * 1024 * 512, (bf16_t*)(p.ws + OFF_WGU) + (size_t)e * 1024 * 1024, 1024, 512, 2, tile, (float*)lds);
                else transpose_tile(p.exp_w_down + ((size_t)l * NE + e) * 512 * 1024, (bf16_t*)(p.ws + OFF_WD) + (size_t)e * 1024 * 512, 512, 1024, 0, tile, (float*)lds);
            }
        }
        it = q_publish(nreg, slot);
    }
}

#define XB_TMO      128
#define XB_XCNT(j)  (256  + 64 * (j))
#define XB_XSUB(j)  (1280 + 64 * (j))
#define XB_XGEN(j)  (2304 + 64 * (j))
#define XB_TOP      3328
#define XB_TOPGEN   3392
#define XCD_BAR_WORDS 3456
#define XB_SPIN_CAP (1u << 20)
DEV unsigned xb_ld(unsigned* p) { return __hip_atomic_load(p, __ATOMIC_RELAXED, __HIP_MEMORY_SCOPE_AGENT); }
DEV unsigned xb_add(unsigned* p, unsigned v) { return __hip_atomic_fetch_add(p, v, __ATOMIC_RELAXED, __HIP_MEMORY_SCOPE_AGENT); }
DEV unsigned xb_xcc_id() { return (unsigned)__builtin_amdgcn_s_getreg((3 << 11) | 20) & 0xFu; }
#define XB_SPIN(cond, bar) do { unsigned _sp = 0; while (cond) { __builtin_amdgcn_s_sleep(1); \
    if ((++_sp & 255u) == 0u) { if (xb_ld(&(bar)[XB_TMO])) break; if (_sp > XB_SPIN_CAP) { atomicAdd(&(bar)[XB_TMO], 1u); break; } } } } while (0)
struct XcdBarrier { unsigned* bar; unsigned x; volatile LAS unsigned* st; };
DEV XcdBarrier xcd_barrier_post(unsigned* bar, volatile LAS unsigned* st) {
    XcdBarrier b; b.bar = bar; b.x = xb_xcc_id(); b.st = st;
    if (tid_() == 0) (void)xb_add(&bar[XB_XCNT(b.x)], 1u);
    return b;
}
DEV void xcd_barrier_complete(unsigned* bar, unsigned x, unsigned& nloc, unsigned& nx) {
    const unsigned G = gridDim.x * gridDim.y * gridDim.z;
    unsigned sum, cnt, mine, sp = 0u;
    for (;;) {
        sum = 0u; cnt = 0u; mine = 0u;
#pragma unroll
        for (unsigned j = 0; j < 16; ++j) { const unsigned c = xb_ld(&bar[XB_XCNT(j)]); sum += c; cnt += (c > 0u) ? 1u : 0u; mine = (j == x) ? c : mine; }
        if (sum == G) break;
        __builtin_amdgcn_s_sleep(1);
        if ((++sp & 255u) == 0u) { if (xb_ld(&bar[XB_TMO])) break; if (sp > XB_SPIN_CAP) { atomicAdd(&bar[XB_TMO], 1u); break; } }
    }
    nloc = mine > 0u ? mine : 1u; nx = cnt > 0u ? cnt : 1u;
}
DEV void xcd_barrier(const XcdBarrier& b) {
    asm volatile("s_waitcnt vmcnt(0)" ::: "memory");
    __syncthreads();
    if (tid_() == 0) {
        unsigned* bar = b.bar;
        __builtin_amdgcn_s_waitcnt(0);
        unsigned nloc = b.st[0], nx = b.st[1];
        if (nloc == 0u) { xcd_barrier_complete(bar, b.x, nloc, nx); b.st[0] = nloc; b.st[1] = nx; }
        const unsigned old = xb_add(&bar[XB_XSUB(b.x)], 1u);
        const unsigned gen = old / nloc;
        if (old + 1u == (gen + 1u) * nloc) {
            __builtin_amdgcn_fence(__ATOMIC_RELEASE, "agent");
            asm volatile("s_waitcnt vmcnt(0)" ::: "memory");
            const unsigned og = xb_add(&bar[XB_TOP], 1u);
            const unsigned tg = og / nx;
            if (og + 1u == (tg + 1u) * nx) xb_add(&bar[XB_TOPGEN], 1u);
            else XB_SPIN(xb_ld(&bar[XB_TOPGEN]) == tg, bar);
            __builtin_amdgcn_fence(__ATOMIC_ACQUIRE, "agent");
            xb_add(&bar[XB_XGEN(b.x)], 1u);
            asm volatile("s_waitcnt vmcnt(0)" ::: "memory");
        } else {
            XB_SPIN(xb_ld(&bar[XB_XGEN(b.x)]) == gen, bar);
            __builtin_amdgcn_fence(__ATOMIC_ACQUIRE, "agent");
            asm volatile("s_waitcnt vmcnt(0)" ::: "memory");
        }
    }
    __syncthreads();
}

namespace cg = cooperative_groups;
#define REP(id) for (int rep_ = 0; rep_ < ((PROBE_ID) == (id) ? PROBE_N : 1); ++rep_)
constexpr int SMEM_STAT = GEMM_LDS_BYTES;
constexpr int SMEM_BYTES = GEMM_LDS_BYTES + 2048 + 512;
constexpr int NPHASE = 14;
__global__ void __launch_bounds__(256, 2) mega(Params p, int ph_lo, int ph_hi) {
    extern __shared__ __attribute__((aligned(16))) unsigned char smem[];
    bf16_t* lds = (bf16_t*)smem;
    float* stat = (float*)(smem + SMEM_STAT);
    int* s_pref = (int*)(smem + SMEM_STAT + 2048); int* s_cnt = s_pref + 40;
    int* qslot = (int*)(smem + SMEM_STAT + 2048 + 416);
    volatile LAS unsigned* bst = (volatile LAS unsigned*)(LAS unsigned char*)(smem + SMEM_STAT + 2048 + 400);
    if (tid_() < 2) bst[tid_()] = 0u;
    __syncthreads();
    (void)xcd_barrier_post((unsigned*)(kp_().ws + OFF_CTL + 4096), bst);
#define GRID_BAR() do { XcdBarrier xb_; xb_.bar = (unsigned*)(kp_().ws + OFF_CTL + 4096); xb_.x = xb_xcc_id(); \
        xb_.st = (volatile LAS unsigned*)(LAS unsigned char*)(smem + SMEM_STAT + 2048 + 400); xcd_barrier(xb_); } while (0)
#define IN(k) (ph_lo <= (k) && (k) < ph_hi)
#define STAMP(k) do { if ((PROBE_TS) >= 0 && bid_() == 0 && tid_() == 0) ((unsigned long long*)(kp_().ws + OFF_CTL + 2048))[k] = __builtin_amdgcn_s_memrealtime(); } while (0)
#define SEAM(k) do { if (IN(k) && IN((k) + 1)) { if ((k) == 0) cg::this_grid().sync(); else GRID_BAR(); } STAMP((k) + 1); } while (0)
    STAMP(0);
    if (IN(0)) {
        REP(0) { ph_mod(kp_(), (float*)smem); __syncthreads(); }
        ph_rope(kp_());
        ph_routerw(kp_());
        ph_rgprep(kp_());
        REP(1) ph_transpose(kp_().w_in, (bf16_t*)(kp_().ws + OFF_WINT), 1024, 2304, 0, 2, (size_t)1024 * 2304, (size_t)2304 * 1024, (float*)smem);
        ph_transpose(kp_().w_out, (bf16_t*)(kp_().ws + OFF_WOUTT), 1024, 1024, 0, 2, (size_t)1024 * 1024, (size_t)1024 * 1024, (float*)smem);
    }
    SEAM(0);
#define LAYER_BODY(l, pb) { \
        if (IN(pb + 0)) ph_rowin(kp_(), l, lds, qslot, pb + 0); \
        SEAM(pb + 0); \
        if (IN(pb + 1)) ph_inproj2(kp_(), l, lds, qslot, pb + 1); \
        SEAM(pb + 1); \
        if (IN(pb + 2)) ph_mixer(kp_(), l, lds, stat, qslot, pb + 2); \
        SEAM(pb + 2); \
        if (IN(pb + 3)) ph_outproj(kp_(), l, lds, stat); \
        SEAM(pb + 3); \
        if (IN(pb + 4)) { REP(7) { ph_moe<1>(kp_(), l, lds, s_pref, s_cnt); } } \
        SEAM(pb + 4); \
        if (IN(pb + 5)) { REP(8) { ph_moe<2>(kp_(), l, lds, s_pref, s_cnt); } } \
        SEAM(pb + 5); \
    }
    LAYER_BODY(0, 1)
    LAYER_BODY(1, 7)
#undef LAYER_BODY
    if (IN(NPHASE - 1)) ph_rowop<2>(kp_(), 2, NLAT);
    if ((PROBE_TS) >= 0 && bid_() == 0) {
        __syncthreads();
        if (tid_() == 0) {
            unsigned long long* ts = (unsigned long long*)(kp_().ws + OFF_CTL + 2048);
            const unsigned long long now = __builtin_amdgcn_s_memrealtime();
            if ((PROBE_TS) == NPHASE - 1) ts[NPHASE] = now;
            const unsigned long long dt = ts[(PROBE_TS) + 1] - ts[(PROBE_TS)];
            while (__builtin_amdgcn_s_memrealtime() - now < 4ull * dt) __builtin_amdgcn_s_sleep(8);
        }
    }
#undef IN
#undef SEAM
}

#ifndef ONE_LAUNCH
#define ONE_LAUNCH 1
#endif
extern "C" void kernel_launch(void* const* d_in, const int* in_sizes, int n_in, void* d_out, int out_size, void* d_ws, size_t ws_size, hipStream_t stream) {
    if (n_in != 28 || ws_size < WS_TOTAL || out_size != NLAT * D) { fprintf(stderr, "kernel_launch: unexpected shapes / workspace (%d inputs, ws %zu need %zu)\n", n_in, ws_size, (size_t)WS_TOTAL); return; }
    static int grid = 0;
    if (grid == 0) {
        int dev = 0, cus = 0, per_cu = 0;
        (void)hipGetDevice(&dev);
        (void)hipDeviceGetAttribute(&cus, hipDeviceAttributeMultiprocessorCount, dev);
        (void)hipFuncSetAttribute((const void*)mega, hipFuncAttributeMaxDynamicSharedMemorySize, SMEM_BYTES);
        (void)hipOccupancyMaxActiveBlocksPerMultiprocessor(&per_cu, (const void*)mega, 256, SMEM_BYTES);
        if (per_cu > 2) per_cu = 2;
        grid = cus * per_cu;
        if (grid <= 0) { fprintf(stderr, "kernel_launch: occupancy query gave %d blocks per CU on %d CUs\n", per_cu, cus); grid = -1; }
    }
    if (grid < 0) return;
    Params p{};
    const float** pp = (const float**)&p;
    for (int i = 0; i < 28; ++i) pp[i] = (const float*)d_in[i];
    p.out = (float*)d_out; p.ws = (unsigned char*)d_ws;
    (void)hipMemsetAsync((unsigned char*)d_ws + OFF_CTL, 0, CTL_BYTES, stream);
#if ONE_LAUNCH
    int lo = 0, hi = NPHASE;
    void* args[] = {(void*)&p, (void*)&lo, (void*)&hi};
    hipError_t e = hipLaunchCooperativeKernel((const void*)mega, dim3(grid), dim3(256), args, SMEM_BYTES, stream);
    if (e != hipSuccess) fprintf(stderr, "kernel_launch: cooperative launch failed: %s (grid %d)\n", hipGetErrorString(e), grid);
#else
    for (int ph = 0; ph < NPHASE; ++ph) mega<<<grid, 256, SMEM_BYTES, stream>>>(p, ph, ph + 1);
#endif
}
```

```cpp
#include <hip/hip_runtime.h>
#include <hip/hip_cooperative_groups.h>
#include <stdint.h>
#include <cstdio>

typedef unsigned short bf16_t;
typedef short bf16x8 __attribute__((ext_vector_type(8)));
typedef float f32x4 __attribute__((ext_vector_type(4)));

#define DEV __device__ __forceinline__
#define PROBE_ID -1
#define PROBE_N 4
#define PROBE_TS -1

constexpr int D = 1024, NB = 8, S = 8192, CTX = 256;
constexpr int NLAT = NB * S, NCTX = NB * CTX, NTOK = NLAT + NCTX;
constexpr int PWS = 1280;
constexpr int COL_RGX = 0, COL_GATE = 256, COL_NAQ = 512, COL_GQ = 896;
constexpr int KVT = 1024;
constexpr int NE = 32, FF = 512;
constexpr int LISTCAP = NTOK;
constexpr float ALPHA = 1.4142135623730951f;
constexpr float LN_EPS = 1e-5f;

constexpr size_t al256(size_t x) { return (x + 255) & ~(size_t)255; }
constexpr size_t OFF_CTL   = 0;
constexpr size_t CTL_BYTES = 4096 + 16384;
constexpr size_t OFF_MOD   = OFF_CTL + CTL_BYTES;
constexpr size_t OFF_ROPE  = al256(OFF_MOD + (size_t)2 * 9 * 6144 * 4);
constexpr size_t OFF_RTE   = al256(OFF_ROPE + (size_t)2 * 128 * 16 * 4);
constexpr size_t OFF_RTW   = al256(OFF_RTE + (size_t)NTOK * 8);
constexpr size_t OFF_LIST  = al256(OFF_RTW + (size_t)NTOK * 8);
constexpr size_t OFF_WR    = al256(OFF_LIST + (size_t)NE * LISTCAP * 4);
constexpr size_t OFF_WRG   = al256(OFF_WR + (size_t)2 * 2 * 48 * 1024 * 2);
constexpr size_t OFF_RGC   = al256(OFF_WRG + (size_t)2 * 2 * 2 * 4 * 64 * 64 * 2);
constexpr size_t OFF_AGG   = al256(OFF_RGC + (size_t)2 * 2 * 3 * 256 * 4);
constexpr size_t OFF_WINT  = al256(OFF_AGG + (size_t)NB * 66 * 2 * 2 * 256 * 4);
constexpr size_t OFF_WOUTT = al256(OFF_WINT + (size_t)2 * 2304 * 1024 * 2);
constexpr size_t OFF_WGU   = al256(OFF_WOUTT + (size_t)2 * 1024 * 1024 * 2);
constexpr size_t OFF_WD    = al256(OFF_WGU + (size_t)NE * 1024 * 1024 * 2);
constexpr size_t OFF_XCTX  = al256(OFF_WD + (size_t)NE * 1024 * 512 * 2);
constexpr size_t OFF_X1    = al256(OFF_XCTX + (size_t)NCTX * D * 4);
constexpr size_t OFF_X2    = al256(OFF_X1 + (size_t)NTOK * D * 2);
constexpr size_t OFF_P     = al256(OFF_X2 + (size_t)NTOK * D * 2);
constexpr size_t OFF_NAKF  = al256(OFF_P + (size_t)NTOK * PWS * 2);
constexpr size_t OFF_NAVF  = al256(OFF_NAKF + (size_t)NB * 6 * 512 * KVT * 2);
constexpr size_t OFF_GKF   = al256(OFF_NAVF + (size_t)NB * 6 * 512 * KVT * 2);
constexpr size_t OFF_GVF   = al256(OFF_GKF + (size_t)NB * 2 * 512 * KVT * 2);
constexpr size_t OFF_NAKFC = al256(OFF_GVF + (size_t)NB * 2 * 512 * KVT * 2);
constexpr size_t OFF_NAVFC = al256(OFF_NAKFC + (size_t)NB * 6 * 16 * KVT * 2);
constexpr size_t OFF_GKFC  = al256(OFF_NAVFC + (size_t)NB * 6 * 16 * KVT * 2);
constexpr size_t OFF_GVFC  = al256(OFF_GKFC + (size_t)NB * 2 * 16 * KVT * 2);
constexpr size_t OFF_Y     = al256(OFF_GVFC + (size_t)NB * 2 * 16 * KVT * 2);
constexpr size_t WS_TOTAL  = al256(OFF_Y + (size_t)2 * NTOK * D * 2);
constexpr int CW_CNT = 0;

struct Params {
    const float *x, *c, *ctx, *c_ctx, *w_ada, *b_ada, *w_in, *conv_w, *conv_b, *rg_a_w, *rg_a_b, *rg_i_w, *rg_i_b, *rg_lambda,
        *na_rpb, *gqa_sink, *w_out, *ln1_g, *ln1_b, *router_g_w, *router_g_b, *router_e_w, *router_e_b, *exp_w_gate, *exp_w_up,
        *exp_w_down, *ln2_g, *ln2_b;
    float* out;
    unsigned char* ws;
};

DEV const Params& kp_() { const void* q = (const void*)__builtin_amdgcn_kernarg_segment_ptr(); asm volatile("" : "+s"(q)); return *(const Params*)q; }
DEV int tid_() { int t = threadIdx.x; asm volatile("" : "+v"(t)); return t; }
DEV int bid_() { int b = blockIdx.x; asm volatile("" : "+s"(b)); return b; }
DEV float shx(float v, int m) { return __builtin_bit_cast(float, __builtin_amdgcn_ds_bpermute(((tid_() & 63) ^ m) << 2, __builtin_bit_cast(int, v))); }
DEV float shl_(float v, int src) { return __builtin_bit_cast(float, __builtin_amdgcn_ds_bpermute(src << 2, __builtin_bit_cast(int, v))); }
DEV float bf2f(bf16_t h) { return __uint_as_float((unsigned)h << 16); }
DEV bf16_t f2bf(float f) { unsigned r; asm("v_cvt_pk_bf16_f32 %0, %1, %1" : "=v"(r) : "v"(f)); return (bf16_t)(r & 0xffffu); }
DEV unsigned pk2(float lo, float hi) { unsigned r; asm("v_cvt_pk_bf16_f32 %0, %1, %2" : "=v"(r) : "v"(lo), "v"(hi)); return r; }
DEV float wave_sum(float v) {
#pragma unroll
    for (int o = 1; o < 64; o <<= 1) v += shx(v, o);
    return v;
}
DEV float wave_max(float v) {
#pragma unroll
    for (int o = 1; o < 64; o <<= 1) v = fmaxf(v, shx(v, o));
    return v;
}
DEV float sigmoidf_(float x) { return 1.f / (1.f + __expf(-x)); }
DEV float gelu_tanh(float x) {
    const float u = 0.7978845608028654f * (x + 0.044715f * x * x * x);
    const float t = 1.f - 2.f / (1.f + __expf(2.f * u));
    return 0.5f * x * (1.f + t);
}
DEV float* xres_row(const Params& p, int R) {
    return R < NLAT ? p.out + (size_t)R * D : (float*)(p.ws + OFF_XCTX) + (size_t)(R - NLAT) * D;
}
DEV const float* modvec(const Params& p, int l, int R, int seg) {
    const int b = R < NLAT ? R / S : 8;
    return (const float*)(p.ws + OFF_MOD) + ((size_t)(l * 9 + b) * 6 + seg) * 1024;
}

DEV void ph_mod(const Params& p, float* sc  ) {
    if (bid_() >= 192) return;
    for (int i = tid_(); i < 9 * 1024; i += 256) { const float v = (i < 8192) ? p.c[i] : p.c_ctx[i - 8192]; sc[i] = v / (1.f + expf(-v)); }
    __syncthreads();
    const int lane = tid_() & 63, w = tid_() >> 6;
    const int col = bid_() * 64 + lane;
    const int l = col / 6144, j = col % 6144;
    const float* wp = p.w_ada + (size_t)l * 1024 * 6144 + j + (size_t)(w * 256) * 6144;
    const float* s = sc + w * 256;
    float a0 = 0, a1 = 0, a2 = 0, a3 = 0, a4 = 0, a5 = 0, a6 = 0, a7 = 0, a8 = 0;
#pragma unroll 8
    for (int k = 0; k < 256; ++k) {
        const float wv = wp[(size_t)k * 6144];
        a0 += s[k] * wv; a1 += s[1024 + k] * wv; a2 += s[2048 + k] * wv; a3 += s[3072 + k] * wv; a4 += s[4096 + k] * wv;
        a5 += s[5120 + k] * wv; a6 += s[6144 + k] * wv; a7 += s[7168 + k] * wv; a8 += s[8192 + k] * wv;
    }
    __syncthreads();
    float* red = sc + 9 * 1024;
    red[(w * 9 + 0) * 64 + lane] = a0; red[(w * 9 + 1) * 64 + lane] = a1; red[(w * 9 + 2) * 64 + lane] = a2; red[(w * 9 + 3) * 64 + lane] = a3; red[(w * 9 + 4) * 64 + lane] = a4;
    red[(w * 9 + 5) * 64 + lane] = a5; red[(w * 9 + 6) * 64 + lane] = a6; red[(w * 9 + 7) * 64 + lane] = a7; red[(w * 9 + 8) * 64 + lane] = a8;
    __syncthreads();
    if (w == 0) {
        const float bias = p.b_ada[l * 6144 + j];
        float* mod = (float*)(p.ws + OFF_MOD) + (size_t)l * 9 * 6144 + j;
#pragma unroll
        for (int r = 0; r < 9; ++r) mod[r * 6144] = ((red[(0 * 9 + r) * 64 + lane] + red[(1 * 9 + r) * 64 + lane]) + (red[(2 * 9 + r) * 64 + lane] + red[(3 * 9 + r) * 64 + lane])) + bias;
    }
}

DEV void sincos_red(float ang, float& sn, float& cs) {
    const float n = rintf(ang * 0.15915494309189535f);
    float r = fmaf(-n, 6.2831854820251465f, ang);
    r = fmaf(-n, -1.7484555e-07f, r);
    float sgn = 1.f;
    if (r > 1.5707963267948966f) { r = 3.14159265358979f - r; sgn = -1.f; }
    else if (r < -1.5707963267948966f) { r = -3.14159265358979f - r; sgn = -1.f; }
    const float r2 = r * r;
    float sp = -1.6059044e-10f; sp = fmaf(sp, r2, 2.5052108e-08f); sp = fmaf(sp, r2, -2.7557319e-06f); sp = fmaf(sp, r2, 1.9841270e-04f);
    sp = fmaf(sp, r2, -8.3333333e-03f); sp = fmaf(sp, r2, 1.6666667e-01f); sp = fmaf(sp * -1.f, r2, 1.f);
    sn = r * sp;
    float cp = -1.1470746e-11f; cp = fmaf(cp, r2, 2.0876757e-09f); cp = fmaf(cp, r2, -2.7557319e-07f); cp = fmaf(cp, r2, 2.4801587e-05f);
    cp = fmaf(cp, r2, -1.3888889e-03f); cp = fmaf(cp, r2, 4.1666667e-02f); cp = fmaf(cp, r2, -0.5f); cp = fmaf(cp, r2, 1.f);
    cs = sgn * cp;
}
DEV void ph_rope(const Params& p) {
    const int i = (bid_() - 192) * 256 + tid_();
    if (i < 0 || i >= 128 * 16) return;
    const int pos = i >> 4, q = i & 15;
    const float inv = exp2f(-(float)q * (13.287712379549449f / 16.f));
    float sn, cs; sincos_red((float)pos * inv, sn, cs);
    float* tab = (float*)(p.ws + OFF_ROPE);
    tab[i] = cs; tab[2048 + i] = sn;
}

DEV void ph_routerw(const Params& p) {
  for (int i = bid_() * 256 + tid_(); i < 2 * 48 * 1024; i += gridDim.x * 256) {
    const int l = i / (48 * 1024), f = (i / 1024) % 48, k = i & 1023;
    float w = 0.f;
    if (f < 4) w = p.router_g_w[((size_t)l * 1024 + k) * 4 + f]; else if (f < 36) w = p.router_e_w[((size_t)l * 1024 + k) * 32 + (f - 4)];
    const bf16_t hi = f2bf(w), lo = f2bf(w - bf2f(hi));
    bf16_t* WR = (bf16_t*)(p.ws + OFF_WR);
    WR[((size_t)(l * 2 + 0) * 48 + f) * 1024 + k] = hi;
    WR[((size_t)(l * 2 + 1) * 48 + f) * 1024 + k] = lo;
  }
}

DEV void ph_rgprep(const Params& p) {
    bf16_t* W = (bf16_t*)(p.ws + OFF_WRG);
    for (int i = bid_() * 256 + tid_(); i < 2 * 2 * 2 * 4 * 64 * 64; i += gridDim.x * 256) {
        const int d = i & 63, e = (i >> 6) & 63, n = (i >> 12) & 3, gate = (i >> 14) & 1, ld = i >> 15;
        const float* srcw = gate ? p.rg_i_w : p.rg_a_w;
        W[i] = f2bf(srcw[((size_t)(ld * 4 + n) * 64 + d) * 64 + e]);
    }
    float* C = (float*)(p.ws + OFF_RGC);
    for (int i = bid_() * 256 + tid_(); i < 2 * 2 * 256; i += gridDim.x * 256) {
        const int c = i & 255, ld = i >> 8;
        C[(ld * 3 + 0) * 256 + c] = p.rg_a_b[ld * 256 + c];
        C[(ld * 3 + 1) * 256 + c] = p.rg_i_b[ld * 256 + c];
        C[(ld * 3 + 2) * 256 + c] = -8.f * log1pf(expf(-p.rg_lambda[ld * 256 + c]));
    }
}

DEV int tr_row(int n, int mode) { return mode == 0 ? n : ((n >> 7) * 256 + ((n >> 6) & 1) * 128 + (n & 63) + (mode == 2 ? 64 : 0)); }
DEV void transpose_tile(const float* src, bf16_t* dst, int K, int N, int mode, int tile, float* lds) {
    const int ntn = N >> 6, kt = tile / ntn, nt = tile % ntn, k0 = kt * 64, n0 = nt * 64, t = tid_();
#pragma unroll
    for (int i = 0; i < 4; ++i) {
        const int r = (t >> 4) + 16 * i, c4 = (t & 15) * 4;
        const float4 v = *(const float4*)(src + (size_t)(k0 + r) * N + n0 + c4);
        lds[r * 65 + c4] = v.x; lds[r * 65 + c4 + 1] = v.y; lds[r * 65 + c4 + 2] = v.z; lds[r * 65 + c4 + 3] = v.w;
    }
    __syncthreads();
#pragma unroll
    for (int i = 0; i < 2; ++i) {
        const int n = (t >> 3) + 32 * i, kc = (t & 7) * 8;
        uint4 o;
        o.x = pk2(lds[(kc + 0) * 65 + n], lds[(kc + 1) * 65 + n]); o.y = pk2(lds[(kc + 2) * 65 + n], lds[(kc + 3) * 65 + n]);
        o.z = pk2(lds[(kc + 4) * 65 + n], lds[(kc + 5) * 65 + n]); o.w = pk2(lds[(kc + 6) * 65 + n], lds[(kc + 7) * 65 + n]);
        *(uint4*)(dst + (size_t)tr_row(n0 + n, mode) * K + k0 + kc) = o;
    }
    __syncthreads();
}
DEV void transpose_tile_w(const float* src, bf16_t* dst, int K, int N, int mode, int tile, float* lds  ) {
    const int ntn = N >> 6, kt = tile / ntn, nt = tile % ntn, k0 = kt * 64, n0 = nt * 64, t = tid_() & 63;
    float4 v[16];
#pragma unroll
    for (int i = 0; i < 16; ++i) v[i] = *(const float4*)(src + (size_t)(k0 + (t >> 4) + 4 * i) * N + n0 + (t & 15) * 4);
#pragma unroll
    for (int i = 0; i < 16; ++i) { const int r = (t >> 4) + 4 * i, c4 = (t & 15) * 4; lds[r * 65 + c4] = v[i].x; lds[r * 65 + c4 + 1] = v[i].y; lds[r * 65 + c4 + 2] = v[i].z; lds[r * 65 + c4 + 3] = v[i].w; }
    asm volatile("s_waitcnt lgkmcnt(0)" ::: "memory");
#pragma unroll
    for (int i = 0; i < 8; ++i) {
        const int n = (t >> 3) + 8 * i, kc = (t & 7) * 8;
        uint4 o;
        o.x = pk2(lds[(kc + 0) * 65 + n], lds[(kc + 1) * 65 + n]); o.y = pk2(lds[(kc + 2) * 65 + n], lds[(kc + 3) * 65 + n]);
        o.z = pk2(lds[(kc + 4) * 65 + n], lds[(kc + 5) * 65 + n]); o.w = pk2(lds[(kc + 6) * 65 + n], lds[(kc + 7) * 65 + n]);
        *(uint4*)(dst + (size_t)tr_row(n0 + n, mode) * K + k0 + kc) = o;
    }
    asm volatile("s_waitcnt lgkmcnt(0)" ::: "memory");
}
DEV void expert_conv_item(const Params& p, int l, int gi, float* lds) {
    const int w = tid_() >> 6;
    float* my = lds + w * (64 * 65);
#pragma unroll 1
    for (int k = 0; k < 2; ++k) {
        const int T = gi * 8 + w * 2 + k, kind = T >> 12, Tl = T & 4095, e = Tl >> 7, tile = Tl & 127;
        if (kind == 0) transpose_tile_w(p.exp_w_gate + ((size_t)l * NE + e) * 1024 * 512, (bf16_t*)(p.ws + OFF_WGU) + (size_t)e * 1024 * 1024, 1024, 512, 1, tile, my);
        else if (kind == 1) transpose_tile_w(p.exp_w_up + ((size_t)l * NE + e) * 1024 * 512, (bf16_t*)(p.ws + OFF_WGU) + (size_t)e * 1024 * 1024, 1024, 512, 2, tile, my);
        else transpose_tile_w(p.exp_w_down + ((size_t)l * NE + e) * 512 * 1024, (bf16_t*)(p.ws + OFF_WD) + (size_t)e * 1024 * 512, 512, 1024, 0, tile, my);
    }
}
DEV void ph_transpose(const float* src, bf16_t* dst, int K, int N, int mode, int nmat, size_t sstride, size_t dstride, float* lds  ) {
    const int per = (K >> 6) * (N >> 6);
    for (int it = bid_(); it < nmat * per; it += gridDim.x) {
        const int m = it / per, tile = it % per;
        transpose_tile(src + (size_t)m * sstride, dst + (size_t)m * dstride, K, N, mode, tile, lds);
    }
}

template <int MODE, bool WX> DEV void rowop(const Params& p, int l, int R) {
    const int lane = tid_() & 63;
    float4 v[2][4];
    float* xr[2] = {nullptr, nullptr};
    if (MODE == 0) {
#pragma unroll
        for (int r = 0; r < 2; ++r) {
            const int Rr = R + r;
            const float* src = Rr < NLAT ? p.x + (size_t)Rr * D : p.ctx + (size_t)(Rr - NLAT) * D;
#pragma unroll
            for (int i = 0; i < 4; ++i) v[r][i] = *(const float4*)(src + i * 256 + lane * 4);
        }
    } else {
        const float* g2 = modvec(p, l - 1, R, 5);
        const float* lg = p.ln2_g + (l - 1) * D; const float* lb = p.ln2_b + (l - 1) * D;
        float4 xv[2][4]; uint2 ya[2][4], yb[2][4];
#pragma unroll
        for (int r = 0; r < 2; ++r) {
            xr[r] = xres_row(p, R + r);
            const bf16_t* y0 = (const bf16_t*)(p.ws + OFF_Y) + (size_t)(2 * (R + r)) * D;
#pragma unroll
            for (int i = 0; i < 4; ++i) { const int k = i * 256 + lane * 4; xv[r][i] = *(const float4*)(xr[r] + k); ya[r][i] = *(const uint2*)(y0 + k); yb[r][i] = *(const uint2*)(y0 + D + k); }
        }
        float s[2] = {0.f, 0.f};
#pragma unroll
        for (int i = 0; i < 4; ++i) {
            const float4 gv = *(const float4*)(g2 + i * 256 + lane * 4);
#pragma unroll
            for (int r = 0; r < 2; ++r) {
                const uint2 a = ya[r][i], b = yb[r][i];
                float4 u;
                u.x = ALPHA * xv[r][i].x + gv.x * (bf2f((bf16_t)(a.x & 0xffff)) + bf2f((bf16_t)(b.x & 0xffff)));
                u.y = ALPHA * xv[r][i].y + gv.y * (bf2f((bf16_t)(a.x >> 16)) + bf2f((bf16_t)(b.x >> 16)));
                u.z = ALPHA * xv[r][i].z + gv.z * (bf2f((bf16_t)(a.y & 0xffff)) + bf2f((bf16_t)(b.y & 0xffff)));
                u.w = ALPHA * xv[r][i].w + gv.w * (bf2f((bf16_t)(a.y >> 16)) + bf2f((bf16_t)(b.y >> 16)));
                v[r][i] = u; s[r] += (u.x + u.y) + (u.z + u.w);
            }
        }
        float q[2] = {0.f, 0.f};
#pragma unroll
        for (int r = 0; r < 2; ++r) {
            const float mean = wave_sum(s[r]) * (1.f / D);
#pragma unroll
            for (int i = 0; i < 4; ++i) { v[r][i].x -= mean; v[r][i].y -= mean; v[r][i].z -= mean; v[r][i].w -= mean; q[r] += (v[r][i].x * v[r][i].x + v[r][i].y * v[r][i].y) + (v[r][i].z * v[r][i].z + v[r][i].w * v[r][i].w); }
        }
#pragma unroll
        for (int r = 0; r < 2; ++r) q[r] = rsqrtf(wave_sum(q[r]) * (1.f / D) + LN_EPS);
#pragma unroll
        for (int i = 0; i < 4; ++i) {
            const int k = i * 256 + lane * 4;
            const float4 gg = *(const float4*)(lg + k); const float4 bb = *(const float4*)(lb + k);
#pragma unroll
            for (int r = 0; r < 2; ++r) {
                v[r][i].x = v[r][i].x * q[r] * gg.x + bb.x; v[r][i].y = v[r][i].y * q[r] * gg.y + bb.y; v[r][i].z = v[r][i].z * q[r] * gg.z + bb.z; v[r][i].w = v[r][i].w * q[r] * gg.w + bb.w;
                if (WX) *(float4*)(xr[r] + k) = v[r][i];
            }
        }
    }
    if (MODE != 2) {
        const float* sh = modvec(p, l, R, 0); const float* sc = modvec(p, l, R, 1);
#pragma unroll
        for (int i = 0; i < 4; ++i) {
            const int k = i * 256 + lane * 4;
            const float4 s4 = *(const float4*)(sh + k); const float4 c4 = *(const float4*)(sc + k);
#pragma unroll
            for (int r = 0; r < 2; ++r) {
                bf16_t* ha = (bf16_t*)(p.ws + OFF_X1) + (size_t)(R + r) * D;
                uint2 o; o.x = pk2(v[r][i].x * (1.f + c4.x) + s4.x, v[r][i].y * (1.f + c4.y) + s4.y); o.y = pk2(v[r][i].z * (1.f + c4.z) + s4.z, v[r][i].w * (1.f + c4.w) + s4.w);
                *(uint2*)(ha + k) = o;
            }
        }
    }
}
template <int MODE> DEV void ph_rowop(const Params& p, int l, int nrows) {
    const int w = tid_() >> 6;
    for (int R = (bid_() * 4 + w) * 2; R < nrows; R += gridDim.x * 8) rowop<MODE, true>(p, l, R);
}
constexpr int CW_Q = 64;
DEV int q_publish(int nreg, int* slot) {
    __syncthreads();
    if (tid_() == 0) *slot = nreg;
    __syncthreads();
    return *(volatile int*)slot;
}
DEV int q_pull(unsigned* ctr, int* slot) {
    if (tid_() == 0) *slot = (int)atomicAdd(ctr, 1u);
    __syncthreads();
    const int v = *(volatile int*)slot;
    __syncthreads();
    return v;
}

constexpr int GEMM_STAGE_BYTES = 384 * 64;
constexpr int GEMM_NSTAGE = 3;
constexpr int GEMM_LDS_BYTES = GEMM_NSTAGE * GEMM_STAGE_BYTES;
#define LAS __attribute__((address_space(3)))
DEV int gemm_src_chunk(int t) { return ((t & 3) ^ ((0 - (t >> 4)) & 3)) * 8; }
DEV void gemm_mainloop(const bf16_t* Abase, unsigned ao0, unsigned ao1, const bf16_t* Bbase, unsigned bo, unsigned ldb, int nk, bf16_t* lds, f32x4 (&acc)[4][8]) {
    const int t = tid_(), lane = t & 63, w = __builtin_amdgcn_readfirstlane(t >> 6), wm = w >> 1, wn = w & 1;
    LAS unsigned char* L = (LAS unsigned char*)lds;
    const int pc = ((lane >> 4) ^ ((0 - ((lane & 15) >> 2)) & 3)) * 16;
    const int arow = (wm * 64 + (lane & 15)) * 64 + pc, brow = (128 + wn * 128 + (lane & 15)) * 64 + pc;
    const char* Ab = (const char*)Abase; const char* B0 = (const char*)Bbase; const char* B1 = B0 + (size_t)ldb * 128; const char* B2 = B0 + (size_t)ldb * 256; const char* B3 = B0 + (size_t)ldb * 384;
#define GEMM_ISSUE(slot, ko) do { LAS unsigned* d_ = (LAS unsigned*)(L + (slot) * GEMM_STAGE_BYTES + w * 1024); \
        __builtin_amdgcn_global_load_lds((const unsigned*)(Ab + (ao0 + (ko) * 2u)), d_, 16, 0, 0); \
        __builtin_amdgcn_global_load_lds((const unsigned*)(Ab + (ao1 + (ko) * 2u)), d_ + 1024, 16, 0, 0); \
        __builtin_amdgcn_global_load_lds((const unsigned*)(B0 + (bo + (ko) * 2u)), d_ + 2048, 16, 0, 0); \
        __builtin_amdgcn_global_load_lds((const unsigned*)(B1 + (bo + (ko) * 2u)), d_ + 3072, 16, 0, 0); \
        __builtin_amdgcn_global_load_lds((const unsigned*)(B2 + (bo + (ko) * 2u)), d_ + 4096, 16, 0, 0); \
        __builtin_amdgcn_global_load_lds((const unsigned*)(B3 + (bo + (ko) * 2u)), d_ + 5120, 16, 0, 0); } while (0)
    asm volatile("s_waitcnt vmcnt(0)" ::: "memory");
    __builtin_amdgcn_s_barrier();
    asm volatile("" ::: "memory");
    GEMM_ISSUE(0, 0);
    if (nk > 1) GEMM_ISSUE(1, 32);
    int cs = 0, is = 2;
    for (int kt = 0; kt < nk; ++kt) {
        if (kt + 1 < nk) asm volatile("s_waitcnt vmcnt(6)" ::: "memory"); else asm volatile("s_waitcnt vmcnt(0)" ::: "memory");
        __builtin_amdgcn_s_barrier();
        asm volatile("" ::: "memory");
        if (kt + 2 < nk) GEMM_ISSUE(is, (kt + 2) * 32);
        const LAS unsigned char* cur = L + cs * GEMM_STAGE_BYTES;
        const bf16x8 af0 = *(const LAS bf16x8*)(cur + arow), af1 = *(const LAS bf16x8*)(cur + arow + 16 * 64), af2 = *(const LAS bf16x8*)(cur + arow + 32 * 64), af3 = *(const LAS bf16x8*)(cur + arow + 48 * 64);
        bf16x8 bq0 = *(const LAS bf16x8*)(cur + brow), bq1 = *(const LAS bf16x8*)(cur + brow + 16 * 64);
#pragma unroll
        for (int nt = 0; nt < 8; ++nt) {
            const bf16x8 bfr = bq0; bq0 = bq1;
            if (nt + 2 < 8) bq1 = *(const LAS bf16x8*)(cur + brow + (nt + 2) * 16 * 64);
            acc[0][nt] = __builtin_amdgcn_mfma_f32_16x16x32_bf16(bfr, af0, acc[0][nt], 0, 0, 0);
            acc[1][nt] = __builtin_amdgcn_mfma_f32_16x16x32_bf16(bfr, af1, acc[1][nt], 0, 0, 0);
            acc[2][nt] = __builtin_amdgcn_mfma_f32_16x16x32_bf16(bfr, af2, acc[2][nt], 0, 0, 0);
            acc[3][nt] = __builtin_amdgcn_mfma_f32_16x16x32_bf16(bfr, af3, acc[3][nt], 0, 0, 0);
        }
        cs = cs == 2 ? 0 : cs + 1; is = is == 2 ? 0 : is + 1;
    }
#undef GEMM_ISSUE
}
DEV void zero_acc(f32x4 (&acc)[4][8]) {
#pragma unroll
    for (int a = 0; a < 4; ++a)
#pragma unroll
        for (int b = 0; b < 8; ++b) acc[a][b] = (f32x4){0.f, 0.f, 0.f, 0.f};
}

DEV void inproj_item(const Params& p_, int l, int rt, int pass, bf16_t* lds) {
    const Params& p = kp_();
    const int t = tid_(), lane = t & 63, w = t >> 6, wm = w >> 1, wn = w & 1;
    const bf16_t* A = (const bf16_t*)(p.ws + OFF_X1) + (size_t)(rt * 128) * D;
    const bf16_t* Bt = (const bf16_t*)(p.ws + OFF_WINT) + ((size_t)l * 2304 + pass * 256) * 1024;
    const unsigned toff = (unsigned)(((t >> 2) * 1024 + gemm_src_chunk(t)) * 2);
    f32x4 acc[4][8]; zero_acc(acc);
    gemm_mainloop(A, toff, toff + 64 * D * 2, Bt, toff, 1024, 32, lds, acc);
    bf16_t* P = (bf16_t*)(p.ws + OFF_P);
    const float* ctab = (const float*)(p.ws + OFF_ROPE); const float* stab = ctab + 2048;
    const bool isctx = rt >= 512;
    const int fq = lane >> 4, fr = lane & 15;
#pragma unroll
    for (int hci = 0; hci < 2; ++hci) {
        const int hc = pass * 4 + wn * 2 + hci;
        int type, dcol = 0, vh = 0;
        if (hc < 4) { type = 0; dcol = COL_RGX + hc * 64; }
        else if (hc < 10) { type = 4; vh = hc - 4; }
        else if (hc < 16) { type = 5; vh = hc - 10; }
        else if (hc < 18) { type = 6; vh = hc - 16; }
        else if (hc < 20) { type = 7; vh = hc - 18; }
        else if (hc < 24) { type = 0; dcol = COL_GATE + (hc - 20) * 64; }
        else if (hc < 30) { type = 1; dcol = COL_NAQ + (hc - 24) * 64; }
        else { type = 3; dcol = COL_GQ + (hc - 30) * 64; }
#pragma unroll
        for (int mt = 0; mt < 4; ++mt) {
            const int R = rt * 128 + wm * 64 + mt * 16 + fr;
            f32x4 v0 = acc[mt][hci * 4 + 0], v1 = acc[mt][hci * 4 + 1], v2 = acc[mt][hci * 4 + 2], v3 = acc[mt][hci * 4 + 3];
            if ((type == 3 || type == 6) && !isctx) {
                const int tt = R & (S - 1), pr = tt >> 6, pc = tt & 63;
                const f32x4 cr = *(const f32x4*)(ctab + pr * 16 + fq * 4), sr = *(const f32x4*)(stab + pr * 16 + fq * 4);
                const f32x4 cc = *(const f32x4*)(ctab + pc * 16 + fq * 4), sc = *(const f32x4*)(stab + pc * 16 + fq * 4);
                const f32x4 o0 = v0 * cr - v1 * sr, o1 = v1 * cr + v0 * sr, o2 = v2 * cc - v3 * sc, o3 = v3 * cc + v2 * sc;
                v0 = o0; v1 = o1; v2 = o2; v3 = o3;
            }
            if (type == 1 || type == 3) { const float qs = 0.125f * 1.4426950408889634f; v0 = v0 * qs; v1 = v1 * qs; v2 = v2 * qs; v3 = v3 * qs; }
            if (type < 4) {
                bf16_t* o = P + (size_t)R * PWS + dcol + fq * 4;
                uint2 q;
                q.x = pk2(v0[0], v0[1]); q.y = pk2(v0[2], v0[3]); *(uint2*)(o) = q;
                q.x = pk2(v1[0], v1[1]); q.y = pk2(v1[2], v1[3]); *(uint2*)(o + 16) = q;
                q.x = pk2(v2[0], v2[1]); q.y = pk2(v2[2], v2[3]); *(uint2*)(o + 32) = q;
                q.x = pk2(v3[0], v3[1]); q.y = pk2(v3[2], v3[3]); *(uint2*)(o + 48) = q;
            } else {
                const bool na = type < 6, isk = (type == 4 || type == 6);
                bf16_t* tb;
                if (!isctx) { const int b = R >> 13, tile = (R & (S - 1)) >> 4;
                    tb = (bf16_t*)(p.ws + (na ? (isk ? OFF_NAKF : OFF_NAVF) : (isk ? OFF_GKF : OFF_GVF))) + ((size_t)(b * (na ? 6 : 2) + vh) * 512 + tile) * KVT; }
                else { const int cR = R - NLAT, b = cR >> 8, tile = (cR & 255) >> 4;
                    tb = (bf16_t*)(p.ws + (na ? (isk ? OFF_NAKFC : OFF_NAVFC) : (isk ? OFF_GKFC : OFF_GVFC))) + ((size_t)(b * (na ? 6 : 2) + vh) * 16 + tile) * KVT; }
                if (isk) {
                    bf16_t* o = tb + ((fq >> 1) * 16 + fr) * 8 + (fq & 1) * 4;
                    uint2 q;
                    q.x = pk2(v0[0], v0[1]); q.y = pk2(v0[2], v0[3]); *(uint2*)(o) = q;
                    q.x = pk2(v1[0], v1[1]); q.y = pk2(v1[2], v1[3]); *(uint2*)(o + 2 * 16 * 8) = q;
                    q.x = pk2(v2[0], v2[1]); q.y = pk2(v2[2], v2[3]); *(uint2*)(o + 512) = q;
                    q.x = pk2(v3[0], v3[1]); q.y = pk2(v3[2], v3[3]); *(uint2*)(o + 512 + 2 * 16 * 8) = q;
                } else {
                    bf16_t* o = tb + ((fr >> 2) * 16 + fq * 4) * 8 + (fr & 3);
#pragma unroll
                    for (int j = 0; j < 4; ++j) {
                        o[j * 8] = f2bf(v0[j]); o[j * 8 + 4] = f2bf(v1[j]); o[512 + j * 8] = f2bf(v2[j]); o[512 + j * 8 + 4] = f2bf(v3[j]);
                    }
                }
            }
        }
    }
}
DEV void ph_inproj(const Params& p, int l, bf16_t* lds) {
    const int nctxp = (l == 0) ? 9 : 5;
    const int nx = gridDim.x >> 3, xcd = bid_() & 7, j = bid_() >> 3;
    const int nloc = 64 * 9 + 2 * nctxp;
    if (bid_() >= nx * 8) return;
    for (int i0 = j; i0 < nloc * ((PROBE_ID) == 3 ? PROBE_N : 1); i0 += nx) {
        const int i = i0 % nloc;
        int rt, pass;
        if (i < 64 * 9) { rt = xcd * 64 + i / 9; pass = i % 9; } else { const int r = i - 64 * 9; rt = 512 + 2 * xcd + r / nctxp; pass = r % nctxp; }
        inproj_item(p, l, rt, pass, lds);
    }
}

constexpr float LOG2E = 1.4426950408889634f;
struct AttnState { f32x4 o0, o1, o2, o3; float m, lsum; };
struct KVFrag { bf16x8 k00, k01, k10, k11, v0, v1, v2, v3; };
DEV bf16x8 ld16(const bf16_t* p) { return *(const bf16x8*)p; }
DEV bf16x8 lohi(const uint4& a, const uint4& b, int hi) { union { uint4 u; bf16x8 v; } c; c.u = hi ? make_uint4(a.z, a.w, b.z, b.w) : make_uint4(a.x, a.y, b.x, b.y); return c.v; }
DEV void kv_load(const bf16_t* kt0, const bf16_t* kt1, const bf16_t* vt0, const bf16_t* vt1, KVFrag& f) {
    f.k00 = ld16(kt0); f.k01 = ld16(kt0 + 512); f.k10 = ld16(kt1); f.k11 = ld16(kt1 + 512);
    const uint4 a0 = *(const uint4*)vt0, a1 = *(const uint4*)(vt0 + 512), b0 = *(const uint4*)vt1, b1 = *(const uint4*)(vt1 + 512);
    f.v0 = lohi(a0, b0, 0); f.v1 = lohi(a0, b0, 1); f.v2 = lohi(a1, b1, 0); f.v3 = lohi(a1, b1, 1);
}
template <bool HASB> DEV void attn_apply(const KVFrag& f, const bf16x8& q0, const bf16x8& q1, f32x4 b0, f32x4 b1, AttnState& st) {
    const f32x4 z = {0.f, 0.f, 0.f, 0.f};
    f32x4 s0 = __builtin_amdgcn_mfma_f32_16x16x32_bf16(f.k00, q0, z, 0, 0, 0); s0 = __builtin_amdgcn_mfma_f32_16x16x32_bf16(f.k01, q1, s0, 0, 0, 0);
    f32x4 s1 = __builtin_amdgcn_mfma_f32_16x16x32_bf16(f.k10, q0, z, 0, 0, 0); s1 = __builtin_amdgcn_mfma_f32_16x16x32_bf16(f.k11, q1, s1, 0, 0, 0);
    if (HASB) { s0 = s0 + b0; s1 = s1 + b1; }
    float mx = fmaxf(fmaxf(fmaxf(s0[0], s0[1]), fmaxf(s0[2], s0[3])), fmaxf(fmaxf(s1[0], s1[1]), fmaxf(s1[2], s1[3])));
    mx = fmaxf(mx, shx(mx, 16)); mx = fmaxf(mx, shx(mx, 32));
    if (__builtin_amdgcn_ballot_w64(mx > st.m + 8.f) != 0ull) {
        const float mn = fmaxf(st.m, mx);
        const float msn = (mn == -INFINITY) ? 0.f : mn;
        const float alpha = __builtin_amdgcn_exp2f(st.m - msn);
        st.lsum = st.lsum * alpha;
        st.o0 = st.o0 * alpha; st.o1 = st.o1 * alpha; st.o2 = st.o2 * alpha; st.o3 = st.o3 * alpha;
        st.m = mn;
    }
    const float ms = (st.m == -INFINITY) ? 0.f : st.m;
    f32x4 p0, p1;
#pragma unroll
    for (int j = 0; j < 4; ++j) { p0[j] = __builtin_amdgcn_exp2f(s0[j] - ms); p1[j] = __builtin_amdgcn_exp2f(s1[j] - ms); }
    st.lsum = st.lsum + ((p0[0] + p0[1]) + (p0[2] + p0[3])) + ((p1[0] + p1[1]) + (p1[2] + p1[3]));
    union { uint4 u; bf16x8 v; } pt; pt.u = make_uint4(pk2(p0[0], p0[1]), pk2(p0[2], p0[3]), pk2(p1[0], p1[1]), pk2(p1[2], p1[3]));
    st.o0 = __builtin_amdgcn_mfma_f32_16x16x32_bf16(f.v0, pt.v, st.o0, 0, 0, 0);
    st.o1 = __builtin_amdgcn_mfma_f32_16x16x32_bf16(f.v1, pt.v, st.o1, 0, 0, 0);
    st.o2 = __builtin_amdgcn_mfma_f32_16x16x32_bf16(f.v2, pt.v, st.o2, 0, 0, 0);
    st.o3 = __builtin_amdgcn_mfma_f32_16x16x32_bf16(f.v3, pt.v, st.o3, 0, 0, 0);
}
DEV void attn_init(AttnState& st) { const f32x4 z = {0.f, 0.f, 0.f, 0.f}; st.o0 = z; st.o1 = z; st.o2 = z; st.o3 = z; st.m = -INFINITY; st.lsum = 0.f; }
DEV void attn_store(AttnState& st, bf16_t* orow, float sink2  ) {
    float l = st.lsum; l += shx(l, 16); l += shx(l, 32);
    float sc;
    if (sink2 != -INFINITY) { const float mf = fmaxf(st.m, sink2); const float al = __builtin_amdgcn_exp2f(st.m - mf); l = l * al + __builtin_amdgcn_exp2f(sink2 - mf); sc = al / l; }
    else sc = 1.f / l;
    uint2 w;
    w.x = pk2(st.o0[0] * sc, st.o0[1] * sc); w.y = pk2(st.o0[2] * sc, st.o0[3] * sc); *(uint2*)(orow) = w;
    w.x = pk2(st.o1[0] * sc, st.o1[1] * sc); w.y = pk2(st.o1[2] * sc, st.o1[3] * sc); *(uint2*)(orow + 16) = w;
    w.x = pk2(st.o2[0] * sc, st.o2[1] * sc); w.y = pk2(st.o2[2] * sc, st.o2[3] * sc); *(uint2*)(orow + 32) = w;
    w.x = pk2(st.o3[0] * sc, st.o3[1] * sc); w.y = pk2(st.o3[2] * sc, st.o3[3] * sc); *(uint2*)(orow + 48) = w;
}

constexpr int NTASK_NA = NB * 6 * 128 * 4, NTASK_GQ = NB * 2 * 512, NTASK_CNA = NB * 6 * 16, NTASK_CGQ = NB * 2 * 16;
DEV void attn_task(const Params& p, int l, int tk, const float* rpb2  ) {
    const int lane = tid_() & 63, g = lane >> 4, fr = lane & 15;
    const bf16_t* P = (const bf16_t*)(p.ws + OFF_P);
    bf16_t* X1 = (bf16_t*)(p.ws + OFF_X1);
    const f32x4 z4 = {0.f, 0.f, 0.f, 0.f};
    KVFrag f;
    if (tk < NTASK_NA) {
        const int qtile = tk & 3, r = (tk >> 2) & 127, hb = tk >> 9, h = hb % 6, b = hb / 6;
        const int qc = qtile == 0 ? (fr < 8 ? fr : 48 + fr) : 8 + (qtile - 1) * 16 + fr;
        const int ct0 = qtile == 0 ? 0 : qtile - 1, ct1 = qtile == 0 ? 3 : qtile;
        const int R = b * S + r * 64 + qc;
        const bf16_t* qp = P + (size_t)R * PWS + COL_NAQ + h * 64 + g * 8;
        const bf16x8 q0 = ld16(qp), q1 = ld16(qp + 32);
        const int rs = min(max(r - 4, 0), 120), cs = min(max(qc - 8, 0), 48);
        int ci[8]; bool ok[8];
#pragma unroll
        for (int e = 0; e < 8; ++e) { const int kc = ((e >> 2) ? ct1 : ct0) * 16 + g * 4 + (e & 3); ok[e] = (kc >= cs) && (kc < cs + 16); ci[e] = min(max(kc - qc + 15, 0), 30); }
        const bf16_t* kf = (const bf16_t*)(p.ws + OFF_NAKF) + ((size_t)(b * 6 + h) * 512 + rs * 4) * KVT + lane * 8;
        const bf16_t* vf = (const bf16_t*)(p.ws + OFF_NAVF) + ((size_t)(b * 6 + h) * 512 + rs * 4) * KVT + lane * 8;
        AttnState st; attn_init(st);
#pragma unroll
        for (int ri = 0; ri < 8; ++ri) {
            const float* rb = rpb2 + (h * 15 + (rs + ri - r + 7)) * 31;
            f32x4 b0, b1;
#pragma unroll
            for (int j = 0; j < 4; ++j) { b0[j] = ok[j] ? rb[ci[j]] : -INFINITY; b1[j] = ok[4 + j] ? rb[ci[4 + j]] : -INFINITY; }
            kv_load(kf + (size_t)(ri * 4 + ct0) * KVT, kf + (size_t)(ri * 4 + ct1) * KVT, vf + (size_t)(ri * 4 + ct0) * KVT, vf + (size_t)(ri * 4 + ct1) * KVT, f);
            attn_apply<true>(f, q0, q1, b0, b1, st);
        }
        const bf16_t* kc_ = (const bf16_t*)(p.ws + OFF_NAKFC) + (size_t)(b * 6 + h) * 16 * KVT + lane * 8;
        const bf16_t* vc_ = (const bf16_t*)(p.ws + OFF_NAVFC) + (size_t)(b * 6 + h) * 16 * KVT + lane * 8;
#pragma unroll
        for (int pp = 0; pp < 8; ++pp) { kv_load(kc_ + (size_t)(2 * pp) * KVT, kc_ + (size_t)(2 * pp + 1) * KVT, vc_ + (size_t)(2 * pp) * KVT, vc_ + (size_t)(2 * pp + 1) * KVT, f); attn_apply<false>(f, q0, q1, z4, z4, st); }
        attn_store(st, X1 + (size_t)R * D + 256 + h * 64 + g * 4, -INFINITY);
    } else if (tk < NTASK_NA + NTASK_GQ + NTASK_CNA + NTASK_CGQ && (tk < NTASK_NA + NTASK_GQ || tk >= NTASK_NA + NTASK_GQ + NTASK_CNA)) {
        const bool lat = tk < NTASK_NA + NTASK_GQ;
        const int t2 = lat ? tk - NTASK_NA : tk - (NTASK_NA + NTASK_GQ + NTASK_CNA);
        const int qt = lat ? (t2 & 511) : (t2 & 15), hb = lat ? (t2 >> 9) : (t2 >> 4), kvh = hb & 1, b = hb >> 1;
        const int q0i = qt * 16, R = (lat ? b * S : NLAT + b * CTX) + q0i + fr;
        const bf16_t* qp = P + (size_t)R * PWS + COL_GQ + kvh * 192 + g * 8;
        const bf16x8 qa0 = ld16(qp), qa1 = ld16(qp + 32), qb0 = ld16(qp + 64), qb1 = ld16(qp + 96), qc0 = ld16(qp + 128), qc1 = ld16(qp + 160);
        AttnState sa, sb, sc; attn_init(sa); attn_init(sb); attn_init(sc);
        const bf16_t* kf = (const bf16_t*)(p.ws + OFF_GKF) + (size_t)(b * 2 + kvh) * 512 * KVT + lane * 8;
        const bf16_t* vf = (const bf16_t*)(p.ws + OFF_GVF) + (size_t)(b * 2 + kvh) * 512 * KVT + lane * 8;
        const bf16_t* kc_ = (const bf16_t*)(p.ws + OFF_GKFC) + (size_t)(b * 2 + kvh) * 16 * KVT + lane * 8;
        const bf16_t* vc_ = (const bf16_t*)(p.ws + OFF_GVFC) + (size_t)(b * 2 + kvh) * 16 * KVT + lane * 8;
        const int qi = q0i + fr;
#define GQ_LOAD(i, F) do { const int i_ = (i); if (i_ < 9) { const int kt_ = (q0i - 128 + i_ * 32) >> 4; const int ta_ = min(max(kt_, 0), 511), tb_ = min(max(kt_ + 1, 0), 511); \
            kv_load(kf + (size_t)ta_ * KVT, kf + (size_t)tb_ * KVT, vf + (size_t)ta_ * KVT, vf + (size_t)tb_ * KVT, F); } \
        else { const int c_ = (i_ - 9) * 2; kv_load(kc_ + (size_t)c_ * KVT, kc_ + (size_t)(c_ + 1) * KVT, vc_ + (size_t)c_ * KVT, vc_ + (size_t)(c_ + 1) * KVT, F); } } while (0)
#define GQ_APPLY(i, F) do { const int i_ = (i); f32x4 b0_ = z4, b1_ = z4; if (i_ < 9) { const int kb_ = q0i - 128 + i_ * 32; _Pragma("unroll") for (int j = 0; j < 4; ++j) { const int k0_ = kb_ + g * 4 + j, k1_ = k0_ + 16; \
                b0_[j] = (k0_ >= 0 && k0_ < S && k0_ >= qi - 128 && k0_ <= qi + 128) ? 0.f : -INFINITY; b1_[j] = (k1_ >= 0 && k1_ < S && k1_ >= qi - 128 && k1_ <= qi + 128) ? 0.f : -INFINITY; } } \
            if (i_ < 9) { attn_apply<true>(F, qa0, qa1, b0_, b1_, sa); attn_apply<true>(F, qb0, qb1, b0_, b1_, sb); attn_apply<true>(F, qc0, qc1, b0_, b1_, sc); } \
            else { attn_apply<false>(F, qa0, qa1, b0_, b1_, sa); attn_apply<false>(F, qb0, qb1, b0_, b1_, sb); attn_apply<false>(F, qc0, qc1, b0_, b1_, sc); } } while (0)
        KVFrag f2;
        const int i0 = lat ? 0 : 9;
        GQ_LOAD(i0, f);
#pragma unroll 1
        for (int i = i0; i < 17; i += 2) {
            if (i + 1 < 17) GQ_LOAD(i + 1, f2);
            GQ_APPLY(i, f);
            if (i + 1 < 17) { if (i + 2 < 17) GQ_LOAD(i + 2, f); GQ_APPLY(i + 1, f2); }
        }
#undef GQ_LOAD
#undef GQ_APPLY
        bf16_t* o = X1 + (size_t)R * D + 640 + kvh * 192 + g * 4;
        attn_store(sa, o, p.gqa_sink[l * 6 + kvh * 3 + 0] * LOG2E); attn_store(sb, o + 64, p.gqa_sink[l * 6 + kvh * 3 + 1] * LOG2E); attn_store(sc, o + 128, p.gqa_sink[l * 6 + kvh * 3 + 2] * LOG2E);
    } else {
        const int t3 = tk - NTASK_NA - NTASK_GQ, qt = t3 & 15, hb = t3 >> 4, h = hb % 6, b = hb / 6;
        const int R = NLAT + b * CTX + qt * 16 + fr;
        const bf16_t* qp = P + (size_t)R * PWS + COL_NAQ + h * 64 + g * 8;
        const bf16x8 q0 = ld16(qp), q1 = ld16(qp + 32);
        AttnState st; attn_init(st);
        const bf16_t* kc_ = (const bf16_t*)(p.ws + OFF_NAKFC) + (size_t)(b * 6 + h) * 16 * KVT + lane * 8;
        const bf16_t* vc_ = (const bf16_t*)(p.ws + OFF_NAVFC) + (size_t)(b * 6 + h) * 16 * KVT + lane * 8;
#pragma unroll
        for (int pp = 0; pp < 8; ++pp) { kv_load(kc_ + (size_t)(2 * pp) * KVT, kc_ + (size_t)(2 * pp + 1) * KVT, vc_ + (size_t)(2 * pp) * KVT, vc_ + (size_t)(2 * pp + 1) * KVT, f); attn_apply<false>(f, q0, q1, z4, z4, st); }
        attn_store(st, X1 + (size_t)R * D + 256 + h * 64 + g * 4, -INFINITY);
    }
}
DEV void ph_attn(const Params& p, int l, float* rpb2  ) {
    for (int i = tid_(); i < 6 * 15 * 31; i += 256) rpb2[i] = p.na_rpb[(size_t)l * 6 * 15 * 31 + i] * LOG2E;
    __syncthreads();
    const int w = tid_() >> 6;
    const int ntask = NTASK_NA + NTASK_GQ + (l == 0 ? NTASK_CNA + NTASK_CGQ : 0);
    for (int tk0 = bid_() * 4 + w; tk0 < ntask; tk0 += gridDim.x * 4) {
        const int tk = tk0 < NTASK_GQ ? NTASK_NA + tk0 : (tk0 < NTASK_GQ + NTASK_NA ? tk0 - NTASK_GQ : tk0);
        attn_task(p, l, tk, rpb2);
    }
}

template <int CTRL> DEV float dppf(float old, float v) { return __builtin_bit_cast(float, __builtin_amdgcn_update_dpp(__builtin_bit_cast(int, old), __builtin_bit_cast(int, v), CTRL, 0xf, 0xf, false)); }
template <bool FWD> DEV void row_scan(float& a, float& b) {
#define RG_STEP(SHR, SHL) { const float ap = FWD ? dppf<SHR>(1.f, a) : dppf<SHL>(1.f, a); const float bp = FWD ? dppf<SHR>(0.f, b) : dppf<SHL>(0.f, b); b = fmaf(a, bp, b); a = a * ap; }
    RG_STEP(0x111, 0x101) RG_STEP(0x112, 0x102) RG_STEP(0x114, 0x104) RG_STEP(0x118, 0x108)
#undef RG_STEP
}
DEV int rg_bwd_chunk(int pos) { return pos == 0 ? 1 : (pos == 1 ? 0 : 67 - pos); }
DEV void rg_coef(const f32x4& za, const f32x4& zi, const f32x4& ba, const f32x4& bi, const f32x4& spc, const f32x4& xv, f32x4& a, f32x4& b) {
#pragma unroll
    for (int j = 0; j < 4; ++j) {
        const float r = 1.f / (1.f + __expf(-(za[j] + ba[j])));
        const float ig = 1.f / (1.f + __expf(-(zi[j] + bi[j])));
        const float la = spc[j] * r;
        const float av = __expf(la);
        const float x2 = 2.f * la;
        float om = x2 * (1.f / 720.f) + (1.f / 120.f); om = om * x2 + (1.f / 24.f); om = om * x2 + (1.f / 6.f); om = om * x2 + 0.5f; om = om * x2 + 1.f; om = -x2 * om;
        if (x2 < -0.25f) om = 1.f - av * av;
        a[j] = av; b[j] = sqrtf(om) * (ig * xv[j]);
    }
}
DEV void rg_item(const Params& p, int l, int rt, bf16_t* lds) {
    const int t = tid_(), lane = t & 63, n = t >> 6, g = lane >> 4, fr = lane & 15;
    const bf16_t* P = (const bf16_t*)(p.ws + OFF_P);
    const bool isctx = rt >= 512;
    const int b = isctx ? (rt - 512) >> 1 : rt >> 6, idx = isctx ? (rt - 512) & 1 : 2 + (rt & 63);
    const int L = isctx ? CTX : S, t0 = isctx ? idx * 128 : (idx - 2) * 128, seqbase = isctx ? NLAT + b * CTX : b * S;
    bf16_t* xl = lds + n * (128 * 64);
    {
        const int c = lane & 7, ch0 = n * 64 + c * 8;
        f32x4 cwa[4], cwb[4];
#pragma unroll
        for (int j = 0; j < 4; ++j) { cwa[j] = *(const f32x4*)(p.conv_w + (l * 4 + j) * 256 + ch0); cwb[j] = *(const f32x4*)(p.conv_w + (l * 4 + j) * 256 + ch0 + 4); }
        const f32x4 cba = *(const f32x4*)(p.conv_b + l * 256 + ch0), cbb = *(const f32x4*)(p.conv_b + l * 256 + ch0 + 4);
#pragma unroll 2
        for (int it = 0; it < 16; ++it) {
            const int tok = it * 8 + (lane >> 3), ts = t0 + tok;
            f32x4 acca = cba, accb = cbb;
#pragma unroll
            for (int j = 0; j < 4; ++j) {
                const int tj = ts + j - 2;
                if (tj >= 0 && tj < L) {
                    const uint4 v = *(const uint4*)(P + (size_t)(seqbase + tj) * PWS + COL_RGX + ch0);
                    const f32x4 xa = {__uint_as_float(v.x << 16), __uint_as_float(v.x & 0xffff0000u), __uint_as_float(v.y << 16), __uint_as_float(v.y & 0xffff0000u)};
                    const f32x4 xb = {__uint_as_float(v.z << 16), __uint_as_float(v.z & 0xffff0000u), __uint_as_float(v.w << 16), __uint_as_float(v.w & 0xffff0000u)};
                    acca = acca + cwa[j] * xa; accb = accb + cwb[j] * xb;
                }
            }
            uint4 o; o.x = pk2(acca[0], acca[1]); o.y = pk2(acca[2], acca[3]); o.z = pk2(accb[0], accb[1]); o.w = pk2(accb[2], accb[3]);
            *(uint4*)(xl + tok * 64 + ((c ^ ((tok >> 1) & 7)) * 8)) = o;
        }
    }
    asm volatile("s_waitcnt lgkmcnt(0)" ::: "memory");
    const bf16_t* W = (const bf16_t*)(p.ws + OFF_WRG) + (size_t)(l * 2) * 2 * 4 * 64 * 64;
    const float* C = (const float*)(p.ws + OFF_RGC) + (size_t)(l * 2) * 3 * 256;
    float* AGG = (float*)(p.ws + OFF_AGG) + (size_t)(b * 66) * 1024;
    const int swz = (fr >> 1) & 7;
#pragma unroll 1
    for (int ct = 0; ct < 4; ++ct) {
        const int ch = n * 64 + ct * 16 + g * 4;
        const f32x4 z4 = {0.f, 0.f, 0.f, 0.f};
#pragma unroll
        for (int dir = 0; dir < 2; ++dir) {
            const bf16x8 wa0 = ld16(W + ((size_t)((dir * 2 + 0) * 4 + n) * 64 + ct * 16 + fr) * 64 + g * 8), wa1 = ld16(W + ((size_t)((dir * 2 + 0) * 4 + n) * 64 + ct * 16 + fr) * 64 + 32 + g * 8);
            const bf16x8 wi0 = ld16(W + ((size_t)((dir * 2 + 1) * 4 + n) * 64 + ct * 16 + fr) * 64 + g * 8), wi1 = ld16(W + ((size_t)((dir * 2 + 1) * 4 + n) * 64 + ct * 16 + fr) * 64 + 32 + g * 8);
            const f32x4 ba = *(const f32x4*)(C + (dir * 3 + 0) * 256 + ch), bi = *(const f32x4*)(C + (dir * 3 + 1) * 256 + ch), spc = *(const f32x4*)(C + (dir * 3 + 2) * 256 + ch);
            f32x4 hin = z4, apre = {1.f, 1.f, 1.f, 1.f};
#pragma unroll
            for (int s = 0; s < 8; ++s) {
                const int tt = dir == 0 ? s : 7 - s;
                const int row = tt * 16 + fr;
                const bf16x8 x0 = *(const bf16x8*)(xl + row * 64 + ((g ^ swz) * 8)), x1 = *(const bf16x8*)(xl + row * 64 + (((g | 4) ^ swz) * 8));
                f32x4 za = __builtin_amdgcn_mfma_f32_16x16x32_bf16(wa0, x0, z4, 0, 0, 0); za = __builtin_amdgcn_mfma_f32_16x16x32_bf16(wa1, x1, za, 0, 0, 0);
                f32x4 zi = __builtin_amdgcn_mfma_f32_16x16x32_bf16(wi0, x0, z4, 0, 0, 0); zi = __builtin_amdgcn_mfma_f32_16x16x32_bf16(wi1, x1, zi, 0, 0, 0);
                const uint2 xr = *(const uint2*)(xl + row * 64 + (((ct * 2 + (g >> 1)) ^ swz) * 8) + (g & 1) * 4);
                const f32x4 xv = {__uint_as_float(xr.x << 16), __uint_as_float(xr.x & 0xffff0000u), __uint_as_float(xr.y << 16), __uint_as_float(xr.y & 0xffff0000u)};
                f32x4 a, bb;
                rg_coef(za, zi, ba, bi, spc, xv, a, bb);
                f32x4 h, ac;
#pragma unroll
                for (int j = 0; j < 4; ++j) {
                    float aj = a[j], bj = bb[j];
                    if (dir == 0) row_scan<true>(aj, bj); else row_scan<false>(aj, bj);
                    h[j] = fmaf(aj, hin[j], bj);
                    ac[j] = aj * apre[j];
                }
                {
                    bf16_t* xo = (bf16_t*)(p.ws + OFF_X2) + ((size_t)seqbase + t0 + row) * D + dir * 512 + ch;
                    uint2 o; o.x = pk2(ac[0], ac[1]); o.y = pk2(ac[2], ac[3]); *(uint2*)xo = o;
                    o.x = pk2(h[0], h[1]); o.y = pk2(h[2], h[3]); *(uint2*)(xo + 256) = o;
                }
                const int src = (lane & 48) | (dir == 0 ? 15 : 0);
#pragma unroll
                for (int j = 0; j < 4; ++j) { hin[j] = shl_(h[j], src); apre[j] = shl_(ac[j], src); }
            }
            if (fr == 0) { *(f32x4*)(AGG + (size_t)(idx * 2 + dir) * 512 + ch) = apre; *(f32x4*)(AGG + (size_t)(idx * 2 + dir) * 512 + 256 + ch) = hin; }
        }
    }
}
DEV void rg_final(const Params& p, int l, int rt, float* part  ) {
    const int t = tid_(), cg4 = (t & 63) * 4, tp = t >> 6;
    const bool isctx = rt >= 512;
    const int b = isctx ? (rt - 512) >> 1 : rt >> 6, idx = isctx ? (rt - 512) & 1 : 2 + (rt & 63);
    const float* AGG = (const float*)(p.ws + OFF_AGG) + (size_t)(b * 66) * 1024;
    f32x4 hf = {0.f, 0.f, 0.f, 0.f}, hb = {0.f, 0.f, 0.f, 0.f};
    {
        const int nf = idx, nb = idx == 1 ? 0 : (idx == 0 ? 1 : 67 - idx);
        const int qf = (nf + 3) >> 2, qb = (nb + 3) >> 2;
        f32x4 Af = {1.f, 1.f, 1.f, 1.f}, Bf = {0.f, 0.f, 0.f, 0.f}, Ab = Af, Bb = Bf;
#pragma unroll 4
        for (int q = tp * qf; q < min((tp + 1) * qf, nf); ++q) { const f32x4 A = *(const f32x4*)(AGG + (size_t)(q * 2) * 512 + cg4), B = *(const f32x4*)(AGG + (size_t)(q * 2) * 512 + 256 + cg4); Bf = A * Bf + B; Af = A * Af; }
#pragma unroll 4
        for (int q = tp * qb; q < min((tp + 1) * qb, nb); ++q) { const int cq = rg_bwd_chunk(q); const f32x4 A = *(const f32x4*)(AGG + (size_t)(cq * 2 + 1) * 512 + cg4), B = *(const f32x4*)(AGG + (size_t)(cq * 2 + 1) * 512 + 256 + cg4); Bb = A * Bb + B; Ab = A * Ab; }
        *(f32x4*)(part + ((tp * 2 + 0) * 2 + 0) * 256 + cg4) = Af; *(f32x4*)(part + ((tp * 2 + 0) * 2 + 1) * 256 + cg4) = Bf;
        *(f32x4*)(part + ((tp * 2 + 1) * 2 + 0) * 256 + cg4) = Ab; *(f32x4*)(part + ((tp * 2 + 1) * 2 + 1) * 256 + cg4) = Bb;
        __syncthreads();
#pragma unroll
        for (int k = 0; k < 4; ++k) {
            hf = *(const f32x4*)(part + ((k * 2 + 0) * 2 + 0) * 256 + cg4) * hf + *(const f32x4*)(part + ((k * 2 + 0) * 2 + 1) * 256 + cg4);
            hb = *(const f32x4*)(part + ((k * 2 + 1) * 2 + 0) * 256 + cg4) * hb + *(const f32x4*)(part + ((k * 2 + 1) * 2 + 1) * 256 + cg4);
        }
    }
    const bf16_t* X2 = (const bf16_t*)(p.ws + OFF_X2); const bf16_t* P = (const bf16_t*)(p.ws + OFF_P); bf16_t* X1 = (bf16_t*)(p.ws + OFF_X1);
#pragma unroll 4
    for (int i = 0; i < 32; ++i) {
        const size_t R = (size_t)rt * 128 + i * 4 + tp;
        const uint2 af = *(const uint2*)(X2 + R * D + cg4), bf = *(const uint2*)(X2 + R * D + 256 + cg4), ab = *(const uint2*)(X2 + R * D + 512 + cg4), bb = *(const uint2*)(X2 + R * D + 768 + cg4);
        const uint2 gr = *(const uint2*)(P + R * PWS + COL_GATE + cg4);
#define BLO(u) __uint_as_float((u) << 16)
#define BHI(u) __uint_as_float((u) & 0xffff0000u)
        const float h0 = (BLO(af.x) * hf[0] + BLO(bf.x)) + (BLO(ab.x) * hb[0] + BLO(bb.x));
        const float h1 = (BHI(af.x) * hf[1] + BHI(bf.x)) + (BHI(ab.x) * hb[1] + BHI(bb.x));
        const float h2 = (BLO(af.y) * hf[2] + BLO(bf.y)) + (BLO(ab.y) * hb[2] + BLO(bb.y));
        const float h3 = (BHI(af.y) * hf[3] + BHI(bf.y)) + (BHI(ab.y) * hb[3] + BHI(bb.y));
        uint2 o; o.x = pk2(h0 * gelu_tanh(BLO(gr.x)), h1 * gelu_tanh(BHI(gr.x))); o.y = pk2(h2 * gelu_tanh(BLO(gr.y)), h3 * gelu_tanh(BHI(gr.y)));
#undef BLO
#undef BHI
        *(uint2*)(X1 + R * D + cg4) = o;
    }
}
DEV void ph_rgagg(const Params& p, int l, bf16_t* lds) {
    for (int rt = bid_(); rt < 528; rt += gridDim.x) { rg_item(p, l, rt, lds); __syncthreads(); }
}

DEV void outproj_item(const Params& p_, int l, int rt, bf16_t* lds, float* stat  ) {
    const Params& p = kp_();
    const int t = tid_(), lane = t & 63, w = t >> 6, wm = w >> 1, wn = w & 1, fq = lane >> 4, fr = lane & 15;
    const bf16_t* A = (const bf16_t*)(p.ws + OFF_X1) + (size_t)(rt * 128) * D;
    const bool isctx = rt >= 512;
    const float* g1 = modvec(p, l, rt * 128, 2);
    __syncthreads();
    rg_final(p, l, rt, (float*)lds);
    asm volatile("s_waitcnt vmcnt(0)" ::: "memory");
    __syncthreads();
    __builtin_amdgcn_fence(__ATOMIC_ACQUIRE, "agent");
#pragma unroll 1
    for (int pass = 0; pass < 4; ++pass) {
        const bf16_t* Bt = (const bf16_t*)(p.ws + OFF_WOUTT) + ((size_t)l * 1024 + pass * 256) * 1024;
        const unsigned toff = (unsigned)(((tid_() >> 2) * 1024 + gemm_src_chunk(tid_())) * 2);
        f32x4 acc[4][8]; zero_acc(acc);
        gemm_mainloop(A, toff, toff + 64 * D * 2, Bt, toff, 1024, 32, lds, acc);
#pragma unroll
        for (int mt = 0; mt < 4; ++mt) {
            const int rl = wm * 64 + mt * 16 + fr, R = rt * 128 + rl;
            const float* xin = (l == 0) ? (isctx ? p.ctx + (size_t)(R - NLAT) * D : p.x + (size_t)R * D) : xres_row(p, R);
            float* xo = xres_row(p, R);
            float s = 0.f, q = 0.f;
#pragma unroll
            for (int nt = 0; nt < 8; ++nt) {
                const int col = pass * 256 + wn * 128 + nt * 16 + fq * 4;
                const f32x4 xv = *(const f32x4*)(xin + col), gv = *(const f32x4*)(g1 + col);
                const f32x4 u = xv * ALPHA + gv * acc[mt][nt];
                *(f32x4*)(xo + col) = u;
                s += (u[0] + u[1]) + (u[2] + u[3]); q += (u[0] * u[0] + u[1] * u[1]) + (u[2] * u[2] + u[3] * u[3]);
            }
            s += shx(s, 16); s += shx(s, 32); q += shx(q, 16); q += shx(q, 32);
            if (fq == 0) { float* sp = stat + (wn * 128 + rl) * 2; if (pass == 0) { sp[0] = s; sp[1] = q; } else { sp[0] += s; sp[1] += q; } }
        }
    }
    asm volatile("s_waitcnt vmcnt(0)" ::: "memory");
    __syncthreads();
    __builtin_amdgcn_fence(__ATOMIC_ACQUIRE, "agent");
    {
        bf16_t* X2 = (bf16_t*)(p.ws + OFF_X2);
        const bf16_t* WRh = (const bf16_t*)(p.ws + OFF_WR) + (size_t)(l * 2) * 48 * 1024 + (size_t)fr * 1024 + fq * 8;
        const bf16_t* WRl = WRh + 48 * 1024;
        float* vec = (float*)((unsigned char*)lds + 24576);
        {
            const float* lg = p.ln1_g + l * D; const float* lb = p.ln1_b + l * D;
            const float* sh2 = modvec(p, l, rt * 128, 3); const float* sc2 = modvec(p, l, rt * 128, 4);
            const int k4 = t * 4;
            *(f32x4*)(vec + k4) = *(const f32x4*)(lg + k4); *(f32x4*)(vec + 1024 + k4) = *(const f32x4*)(lb + k4);
            *(f32x4*)(vec + 2048 + k4) = *(const f32x4*)(sc2 + k4) + 1.f; *(f32x4*)(vec + 3072 + k4) = *(const f32x4*)(sh2 + k4);
        }
        float mean[2], rstd[2];
#pragma unroll
        for (int tm = 0; tm < 2; ++tm) {
            const int rl = w * 32 + tm * 16 + fr;
            float s = 0.f, q = 0.f;
#pragma unroll
            for (int i = 0; i < 2; ++i) { s += stat[(i * 128 + rl) * 2]; q += stat[(i * 128 + rl) * 2 + 1]; }
            mean[tm] = s * (1.f / D);
            rstd[tm] = rsqrtf(fmaxf(q * (1.f / D) - mean[tm] * mean[tm], 0.f) + LN_EPS);
        }
        __syncthreads();
        float* xr0 = xres_row(p, rt * 128 + w * 32 + fr) + fq * 8;
        float* xr1 = xres_row(p, rt * 128 + w * 32 + 16 + fr) + fq * 8;
        bf16_t* h20 = X2 + (size_t)(rt * 128 + w * 32 + fr) * D + fq * 8; bf16_t* h21 = h20 + (size_t)16 * D;
        f32x4 lacc[3][2];
#pragma unroll
        for (int a = 0; a < 3; ++a) { lacc[a][0] = (f32x4){0.f, 0.f, 0.f, 0.f}; lacc[a][1] = (f32x4){0.f, 0.f, 0.f, 0.f}; }
        f32x4 nu00 = *(const f32x4*)xr0, nu01 = *(const f32x4*)(xr0 + 4), nu10 = *(const f32x4*)xr1, nu11 = *(const f32x4*)(xr1 + 4);
        bf16x8 nwh0 = *(const bf16x8*)(WRh), nwh1 = *(const bf16x8*)(WRh + 16 * 1024), nwh2 = *(const bf16x8*)(WRh + 32 * 1024);
        bf16x8 nwl0 = *(const bf16x8*)(WRl), nwl1 = *(const bf16x8*)(WRl + 16 * 1024), nwl2 = *(const bf16x8*)(WRl + 32 * 1024);
#pragma unroll 2
        for (int ks = 0; ks < 32; ++ks) {
            const f32x4 u00 = nu00, u01 = nu01, u10 = nu10, u11 = nu11;
            const bf16x8 wh0 = nwh0, wh1 = nwh1, wh2 = nwh2, wl0 = nwl0, wl1 = nwl1, wl2 = nwl2;
            if (ks + 1 < 32) {
                const int ko = (ks + 1) * 32;
                nu00 = *(const f32x4*)(xr0 + ko); nu01 = *(const f32x4*)(xr0 + ko + 4); nu10 = *(const f32x4*)(xr1 + ko); nu11 = *(const f32x4*)(xr1 + ko + 4);
                nwh0 = *(const bf16x8*)(WRh + ko); nwh1 = *(const bf16x8*)(WRh + 16 * 1024 + ko); nwh2 = *(const bf16x8*)(WRh + 32 * 1024 + ko);
                nwl0 = *(const bf16x8*)(WRl + ko); nwl1 = *(const bf16x8*)(WRl + 16 * 1024 + ko); nwl2 = *(const bf16x8*)(WRl + 32 * 1024 + ko);
            }
            const int k = ks * 32 + fq * 8;
            const f32x4 g0 = *(const f32x4*)(vec + k), g1v = *(const f32x4*)(vec + k + 4), b0 = *(const f32x4*)(vec + 1024 + k), b1 = *(const f32x4*)(vec + 1024 + k + 4);
            const f32x4 c0 = *(const f32x4*)(vec + 2048 + k), c1 = *(const f32x4*)(vec + 2048 + k + 4), s0 = *(const f32x4*)(vec + 3072 + k), s1 = *(const f32x4*)(vec + 3072 + k + 4);
            bf16x8 hh0, hl0, hh1, hl1;
            {
                const f32x4 x0 = (u00 - mean[0]) * rstd[0] * g0 + b0, x1 = (u01 - mean[0]) * rstd[0] * g1v + b1;
                *(f32x4*)(xr0 + ks * 32) = x0; *(f32x4*)(xr0 + ks * 32 + 4) = x1;
                const f32x4 h0 = x0 * c0 + s0, h1 = x1 * c1 + s1;
#pragma unroll
                for (int e = 0; e < 4; ++e) { const bf16_t a = f2bf(h0[e]), b = f2bf(h1[e]); hh0[e] = (short)a; hh0[4 + e] = (short)b; hl0[e] = (short)f2bf(h0[e] - bf2f(a)); hl0[4 + e] = (short)f2bf(h1[e] - bf2f(b)); }
                *(bf16x8*)(h20 + ks * 32) = hh0;
            }
            {
                const f32x4 x0 = (u10 - mean[1]) * rstd[1] * g0 + b0, x1 = (u11 - mean[1]) * rstd[1] * g1v + b1;
                *(f32x4*)(xr1 + ks * 32) = x0; *(f32x4*)(xr1 + ks * 32 + 4) = x1;
                const f32x4 h0 = x0 * c0 + s0, h1 = x1 * c1 + s1;
#pragma unroll
                for (int e = 0; e < 4; ++e) { const bf16_t a = f2bf(h0[e]), b = f2bf(h1[e]); hh1[e] = (short)a; hh1[4 + e] = (short)b; hl1[e] = (short)f2bf(h0[e] - bf2f(a)); hl1[4 + e] = (short)f2bf(h1[e] - bf2f(b)); }
                *(bf16x8*)(h21 + ks * 32) = hh1;
            }
#define RT_MMA(ft, WH, WL) do { \
            lacc[ft][0] = __builtin_amdgcn_mfma_f32_16x16x32_bf16(WH, hh0, lacc[ft][0], 0, 0, 0); lacc[ft][0] = __builtin_amdgcn_mfma_f32_16x16x32_bf16(WL, hh0, lacc[ft][0], 0, 0, 0); lacc[ft][0] = __builtin_amdgcn_mfma_f32_16x16x32_bf16(WH, hl0, lacc[ft][0], 0, 0, 0); \
            lacc[ft][1] = __builtin_amdgcn_mfma_f32_16x16x32_bf16(WH, hh1, lacc[ft][1], 0, 0, 0); lacc[ft][1] = __builtin_amdgcn_mfma_f32_16x16x32_bf16(WL, hh1, lacc[ft][1], 0, 0, 0); lacc[ft][1] = __builtin_amdgcn_mfma_f32_16x16x32_bf16(WH, hl1, lacc[ft][1], 0, 0, 0); } while (0)
            RT_MMA(0, wh0, wl0); RT_MMA(1, wh1, wl1); RT_MMA(2, wh2, wl2);
#undef RT_MMA
        }
        __syncthreads();
        float* lt = (float*)lds;
        int* lcnt = (int*)((unsigned char*)lds + 24576); int* lbase = lcnt + 32;
        if (t < 32) lcnt[t] = 0;
#pragma unroll
        for (int ft = 0; ft < 3; ++ft)
#pragma unroll
            for (int tm = 0; tm < 2; ++tm)
#pragma unroll
                for (int j = 0; j < 4; ++j) lt[(w * 32 + tm * 16 + fr) * 48 + ft * 16 + fq * 4 + j] = lacc[ft][tm][j];
        __syncthreads();
        int E0 = 0, E1 = 0, r0 = 0, r1 = 0; float w0 = 0.f, w1 = 0.f;
        const int rl = w * 32 + (lane & 31), R = rt * 128 + rl;
        if (lane < 32) {
            const float* lr = lt + rl * 48;
            int gi = 0; float gm = lr[0] + p.router_g_b[l * 4];
            float gl[4]; gl[0] = gm;
#pragma unroll
            for (int j = 1; j < 4; ++j) { gl[j] = lr[j] + p.router_g_b[l * 4 + j]; if (gl[j] > gm) { gm = gl[j]; gi = j; } }
            float gs = 0.f;
#pragma unroll
            for (int j = 0; j < 4; ++j) gs += expf(gl[j] - gm);
            const float ptop = 1.f / gs;
            int e0 = 0, e1 = 0; float m0 = -INFINITY, m1 = -INFINITY;
            for (int j = 0; j < 8; ++j) {
                const float v = lr[4 + gi * 8 + j] + p.router_e_b[l * 32 + gi * 8 + j];
                if (v > m0) { m1 = m0; e1 = e0; m0 = v; e0 = j; } else if (v > m1) { m1 = v; e1 = j; }
            }
            const float ex = expf(m1 - m0);
            w0 = ptop / (1.f + ex); w1 = ptop * ex / (1.f + ex);
            E0 = gi * 8 + e0; E1 = gi * 8 + e1;
            r0 = atomicAdd(lcnt + E0, 1); r1 = atomicAdd(lcnt + E1, 1);
        }
        __syncthreads();
        if (t < 32) { const int c = lcnt[t]; lbase[t] = c ? (int)atomicAdd((unsigned*)(p.ws + OFF_CTL) + CW_CNT + l * 32 + t, (unsigned)c) : 0; }
        __syncthreads();
        if (lane < 32) {
            int* rte = (int*)(p.ws + OFF_RTE); float* rtw = (float*)(p.ws + OFF_RTW);
            int* list = (int*)(p.ws + OFF_LIST);
            rte[R * 2] = E0; rte[R * 2 + 1] = E1; rtw[R * 2] = w0; rtw[R * 2 + 1] = w1;
            list[(size_t)E0 * LISTCAP + lbase[E0] + r0] = R * 2;
            list[(size_t)E1 * LISTCAP + lbase[E1] + r1] = R * 2 + 1;
        }
    }
}
DEV void ph_outproj(const Params& p, int l, bf16_t* lds, float* stat  ) {
    for (int rt = bid_(); rt < 512; rt += gridDim.x) { outproj_item(p, l, rt, lds, stat); __syncthreads(); }
}

DEV void moe1_item(const Params& p_, int l, int e, int jb, int pass, int item, int cnt, bf16_t* lds) {
    const Params& p = kp_();
    const int t = tid_(), lane = t & 63, w = t >> 6, wm = w >> 1, wn = w & 1, fq = lane >> 4, fr = lane & 15;
    const int* list = (const int*)(p.ws + OFF_LIST) + (size_t)e * LISTCAP;
    const bf16_t* X2 = (const bf16_t*)(p.ws + OFF_X2);
    bf16_t* Hs = (bf16_t*)(p.ws + OFF_P) + (size_t)item * 128 * FF;
    unsigned ao0, ao1;
    { const int s0 = jb * 128 + (t >> 2), s1 = s0 + 64;
      const int tok0 = s0 < cnt ? (list[s0] >> 1) : 0, tok1 = s1 < cnt ? (list[s1] >> 1) : 0;
      ao0 = (unsigned)((tok0 * D + gemm_src_chunk(t)) * 2); ao1 = (unsigned)((tok1 * D + gemm_src_chunk(t)) * 2); }
    const bf16_t* Bt = (const bf16_t*)(p.ws + OFF_WGU) + ((size_t)e * 1024 + pass * 256) * 1024;
    f32x4 acc[4][8]; zero_acc(acc);
    gemm_mainloop(X2, ao0, ao1, Bt, (unsigned)(((t >> 2) * 1024 + gemm_src_chunk(t)) * 2), 1024, 32, lds, acc);
#pragma unroll
    for (int mt = 0; mt < 4; ++mt) {
        const int rl = wm * 64 + mt * 16 + fr;
#pragma unroll
        for (int nt = 0; nt < 4; ++nt) {
            const f32x4 gv = acc[mt][nt], uv = acc[mt][nt + 4];
            float hv[4];
#pragma unroll
            for (int jj = 0; jj < 4; ++jj) hv[jj] = gv[jj] / (1.f + __expf(-gv[jj])) * uv[jj];
            uint2 o; o.x = pk2(hv[0], hv[1]); o.y = pk2(hv[2], hv[3]);
            *(uint2*)(Hs + (size_t)rl * FF + pass * 128 + wn * 64 + nt * 16 + fq * 4) = o;
        }
    }
}
DEV void moe2_item(const Params& p_, int l, int e, int jb, int pass, int item, int cnt, bf16_t* lds) {
    const Params& p = kp_();
    const int t = tid_(), lane = t & 63, w = t >> 6, wm = w >> 1, wn = w & 1, fq = lane >> 4, fr = lane & 15;
    const int* list = (const int*)(p.ws + OFF_LIST) + (size_t)e * LISTCAP;
    const bf16_t* Hs = (const bf16_t*)(p.ws + OFF_P) + (size_t)item * 128 * FF;
    const unsigned hoff = (unsigned)(((t >> 2) * FF + gemm_src_chunk(t)) * 2);
    const float* rtw = (const float*)(p.ws + OFF_RTW);
    bf16_t* Y = (bf16_t*)(p.ws + OFF_Y);
    const bf16_t* Bt = (const bf16_t*)(p.ws + OFF_WD) + ((size_t)e * 1024 + pass * 256) * FF;
    f32x4 acc[4][8]; zero_acc(acc);
    gemm_mainloop(Hs, hoff, hoff + 64 * FF * 2, Bt, hoff, FF, 16, lds, acc);
#pragma unroll
    for (int mt = 0; mt < 4; ++mt) {
        const int s = jb * 128 + wm * 64 + mt * 16 + fr;
        if (s < cnt) {
            const int ent = list[s];
            const float gw = rtw[ent];
            bf16_t* yo = Y + (size_t)ent * D + pass * 256 + wn * 128 + fq * 4;
#pragma unroll
            for (int nt = 0; nt < 8; ++nt) { const f32x4 v = acc[mt][nt] * gw; uint2 o; o.x = pk2(v[0], v[1]); o.y = pk2(v[2], v[3]); *(uint2*)(yo + nt * 16) = o; }
        }
    }
}
template <int STAGE> DEV void ph_moe(const Params& p, int l, bf16_t* lds, int* s_pref  , int* s_cnt  , int* slot, int ph) {
    const unsigned* cnt = (const unsigned*)(p.ws + OFF_CTL) + CW_CNT + l * 32;
    if (tid_() == 0) { int a = 0; for (int e = 0; e < 32; ++e) { const int c = (int)cnt[e]; s_cnt[e] = c; s_pref[e] = a; a += (c + 127) >> 7; } s_pref[32] = a; }
    __syncthreads();
#pragma unroll 1
    for (int hop = 0; hop < 8; ++hop) {
        const int xq = (bid_() + hop) & 7;
        unsigned* ctr = (unsigned*)(p.ws + OFF_CTL) + CW_Q + ph * 8 + xq;
        const int n0 = (s_cnt[xq] + 127) >> 7, n1 = (s_cnt[xq + 8] + 127) >> 7, n2 = (s_cnt[xq + 16] + 127) >> 7, n3 = (s_cnt[xq + 24] + 127) >> 7;
        const int nloc = (n0 + n1 + n2 + n3) * 4;
        int it = q_pull(ctr, slot);
        while (it < nloc) {
            int nreg = 0;
            if (tid_() == 0) nreg = (int)atomicAdd(ctr, 1u);
            const int pass = it & 3, ib = it >> 2;
            int e, jb;
            if (ib < n0) { e = xq; jb = ib; } else if (ib < n0 + n1) { e = xq + 8; jb = ib - n0; } else if (ib < n0 + n1 + n2) { e = xq + 16; jb = ib - n0 - n1; } else { e = xq + 24; jb = ib - n0 - n1 - n2; }
            if (STAGE == 1) moe1_item(p, l, e, jb, pass, s_pref[e] + jb, s_cnt[e], lds); else moe2_item(p, l, e, jb, pass, s_pref[e] + jb, s_cnt[e], lds);
            it = q_publish(nreg, slot);
        }
    }
    __syncthreads();
}

DEV void ph_rowin(const Params& p, int l, bf16_t* lds, int* slot, int ph) {
    const int np = l == 0 ? 9 : 5, nci = 16 * np, ntot = nci + 1024;
    unsigned* ctr = (unsigned*)(p.ws + OFF_CTL) + CW_Q + ph * 8;
    const int w = tid_() >> 6;
    for (;;) {
        const int it = q_pull(ctr, slot);
        if (it >= ntot) break;
        if (it < nci) {
            const int rt = 512 + it / np, pass = it % np;
            for (int r = w * 2; r < 128; r += 8) { if (l == 0) rowop<0, true>(p, 0, rt * 128 + r); else rowop<1, false>(p, 1, rt * 128 + r); }
            asm volatile("s_waitcnt vmcnt(0)" ::: "memory");
            __syncthreads();
            __builtin_amdgcn_fence(__ATOMIC_ACQUIRE, "agent");
            inproj_item(p, l, rt, pass, lds);
        } else {
            const int r0 = (it - nci) * 64;
            for (int r = w * 2; r < 64; r += 8) { if (l == 0) rowop<0, true>(p, 0, r0 + r); else rowop<1, true>(p, 1, r0 + r); }
        }
    }
}
DEV void ph_inproj2(const Params& p, int l, bf16_t* lds, int* slot, int ph) {
    const int xcd = bid_() & 7;
    unsigned* ctr = (unsigned*)(p.ws + OFF_CTL) + CW_Q + ph * 8 + xcd;
    const int ntot = 2 + 768 + (l == 0 ? 32 : 0);
    int it = q_pull(ctr, slot);
    while (it < ntot) {
        int nreg = 0;
        if (tid_() == 0) nreg = (int)atomicAdd(ctr, 1u);
        if (it < 2) { rg_item(p, l, 512 + 2 * xcd + it, lds); }
        else if (it < 770) {
            const int q = it - 2, m = q >> 2, r = q & 3;
            if (r < 3) { const int i = m * 3 + r; inproj_item(p, l, xcd * 64 + i / 9, i % 9, lds); }
            else { __syncthreads(); expert_conv_item(p, l, xcd * 192 + m, (float*)lds); }
        }
        else { const int i = it - 770, w = tid_() >> 6;
            const int tk = i < 24 ? NTASK_NA + NTASK_GQ + (xcd * 24 + i) * 4 + w : NTASK_NA + NTASK_GQ + NTASK_CNA + (xcd * 8 + (i - 24)) * 4 + w;
            attn_task(p, l, tk, (const float*)lds); }
        it = q_publish(nreg, slot);
    }
}
DEV void ph_mixer(const Params& p, int l, bf16_t* lds, float* stat, int* slot, int ph) {
    const int xcd = bid_() & 7;
    unsigned* ctr = (unsigned*)(p.ws + OFF_CTL) + CW_Q + ph * 8 + xcd;
    const int n0 = l == 0 ? 2 : 0, n1 = n0 + 64, n2 = n1 + 256, n3 = n2 + 768, ntot = n3;
    bool rpb_ok = false;
    float* rpb2 = (float*)lds;
    int it = q_pull(ctr, slot);
    while (it < ntot) {
        int nreg = 0;
        if (tid_() == 0) nreg = (int)atomicAdd(ctr, 1u);
        if (it < n0) { outproj_item(p, l, 512 + 2 * xcd + it, lds, stat); rpb_ok = false; }
        else if (it < n1) { rg_item(p, l, xcd * 64 + (it - n0), lds); rpb_ok = false; }
        else if (it < n3) {
            if (!rpb_ok) { for (int i = tid_(); i < 6 * 15 * 31; i += 256) rpb2[i] = p.na_rpb[(size_t)l * 6 * 15 * 31 + i] * LOG2E; __syncthreads(); rpb_ok = true; }
            const int w = tid_() >> 6;
            int tk;
            if (it < n2) { const int i = it - n1; tk = NTASK_NA + (2 * xcd + (i >> 7)) * 512 + (i & 127) * 4 + w; }
            else { const int i = it - n2; tk = (6 * xcd + (i >> 7)) * 512 + (i & 127) * 4 + w; }
            attn_task(p, l, tk, rpb2);
        }
        it = q_publish(nreg, slot);
    }
}

#define XB_TMO      128
#define XB_XCNT(j)  (256  + 64 * (j))
#define XB_XSUB(j)  (1280 + 64 * (j))
#define XB_XGEN(j)  (2304 + 64 * (j))
#define XB_TOP      3328
#define XB_TOPGEN   3392
#define XCD_BAR_WORDS 3456
#define XB_SPIN_CAP (1u << 20)
DEV unsigned xb_ld(unsigned* p) { return __hip_atomic_load(p, __ATOMIC_RELAXED, __HIP_MEMORY_SCOPE_AGENT); }
DEV unsigned xb_add(unsigned* p, unsigned v) { return __hip_atomic_fetch_add(p, v, __ATOMIC_RELAXED, __HIP_MEMORY_SCOPE_AGENT); }
DEV unsigned xb_xcc_id() { return (unsigned)__builtin_amdgcn_s_getreg((3 << 11) | 20) & 0xFu; }
#define XB_SPIN(cond, bar) do { unsigned _sp = 0; while (cond) { __builtin_amdgcn_s_sleep(1); \
    if ((++_sp & 255u) == 0u) { if (xb_ld(&(bar)[XB_TMO])) break; if (_sp > XB_SPIN_CAP) { atomicAdd(&(bar)[XB_TMO], 1u); break; } } } } while (0)
struct XcdBarrier { unsigned* bar; unsigned x; volatile LAS unsigned* st; };
DEV XcdBarrier xcd_barrier_post(unsigned* bar, volatile LAS unsigned* st) {
    XcdBarrier b; b.bar = bar; b.x = xb_xcc_id(); b.st = st;
    if (tid_() == 0) (void)xb_add(&bar[XB_XCNT(b.x)], 1u);
    return b;
}
DEV void xcd_barrier_complete(unsigned* bar, unsigned x, unsigned& nloc, unsigned& nx) {
    const unsigned G = gridDim.x * gridDim.y * gridDim.z;
    unsigned sum, cnt, mine, sp = 0u;
    for (;;) {
        sum = 0u; cnt = 0u; mine = 0u;
#pragma unroll
        for (unsigned j = 0; j < 16; ++j) { const unsigned c = xb_ld(&bar[XB_XCNT(j)]); sum += c; cnt += (c > 0u) ? 1u : 0u; mine = (j == x) ? c : mine; }
        if (sum == G) break;
        __builtin_amdgcn_s_sleep(1);
        if ((++sp & 255u) == 0u) { if (xb_ld(&bar[XB_TMO])) break; if (sp > XB_SPIN_CAP) { atomicAdd(&bar[XB_TMO], 1u); break; } }
    }
    nloc = mine > 0u ? mine : 1u; nx = cnt > 0u ? cnt : 1u;
}
DEV void xcd_barrier(const XcdBarrier& b) {
    asm volatile("s_waitcnt vmcnt(0)" ::: "memory");
    __syncthreads();
    if (tid_() == 0) {
        unsigned* bar = b.bar;
        __builtin_amdgcn_s_waitcnt(0);
        unsigned nloc = b.st[0], nx = b.st[1];
        if (nloc == 0u) { xcd_barrier_complete(bar, b.x, nloc, nx); b.st[0] = nloc; b.st[1] = nx; }
        const unsigned old = xb_add(&bar[XB_XSUB(b.x)], 1u);
        const unsigned gen = old / nloc;
        if (old + 1u == (gen + 1u) * nloc) {
            __builtin_amdgcn_fence(__ATOMIC_RELEASE, "agent");
            asm volatile("s_waitcnt vmcnt(0)" ::: "memory");
            const unsigned og = xb_add(&bar[XB_TOP], 1u);
            const unsigned tg = og / nx;
            if (og + 1u == (tg + 1u) * nx) xb_add(&bar[XB_TOPGEN], 1u);
            else XB_SPIN(xb_ld(&bar[XB_TOPGEN]) == tg, bar);
            __builtin_amdgcn_fence(__ATOMIC_ACQUIRE, "agent");
            xb_add(&bar[XB_XGEN(b.x)], 1u);
            asm volatile("s_waitcnt vmcnt(0)" ::: "memory");
        } else {
            XB_SPIN(xb_ld(&bar[XB_XGEN(b.x)]) == gen, bar);
            __builtin_amdgcn_fence(__ATOMIC_ACQUIRE, "agent");
            asm volatile("s_waitcnt vmcnt(0)" ::: "memory");
        }
    }
    __syncthreads();
}

namespace cg = cooperative_groups;
#define REP(id) for (int rep_ = 0; rep_ < ((PROBE_ID) == (id) ? PROBE_N : 1); ++rep_)
constexpr int SMEM_STAT = GEMM_LDS_BYTES;
constexpr int SMEM_BYTES = GEMM_LDS_BYTES + 2048 + 512;
constexpr int NPHASE = 14;
__global__ void __launch_bounds__(256, 2) mega(Params p, int ph_lo, int ph_hi) {
    extern __shared__ __attribute__((aligned(16))) unsigned char smem[];
    bf16_t* lds = (bf16_t*)smem;
    float* stat = (float*)(smem + SMEM_STAT);
    int* s_pref = (int*)(smem + SMEM_STAT + 2048); int* s_cnt = s_pref + 40;
    int* qslot = (int*)(smem + SMEM_STAT + 2048 + 416);
    volatile LAS unsigned* bst = (volatile LAS unsigned*)(LAS unsigned char*)(smem + SMEM_STAT + 2048 + 400);
    if (tid_() < 2) bst[tid_()] = 0u;
    __syncthreads();
    (void)xcd_barrier_post((unsigned*)(kp_().ws + OFF_CTL + 4096), bst);
#define GRID_BAR() do { XcdBarrier xb_; xb_.bar = (unsigned*)(kp_().ws + OFF_CTL + 4096); xb_.x = xb_xcc_id(); \
        xb_.st = (volatile LAS unsigned*)(LAS unsigned char*)(smem + SMEM_STAT + 2048 + 400); xcd_barrier(xb_); } while (0)
#define IN(k) (ph_lo <= (k) && (k) < ph_hi)
#define STAMP(k) do { if ((PROBE_TS) >= 0 && bid_() == 0 && tid_() == 0) ((unsigned long long*)(kp_().ws + OFF_CTL + 2048))[k] = __builtin_amdgcn_s_memrealtime(); } while (0)
#define SEAM(k) do { if (IN(k) && IN((k) + 1)) { if ((k) == 0) cg::this_grid().sync(); else GRID_BAR(); } STAMP((k) + 1); } while (0)
    STAMP(0);
    if (IN(0)) {
        REP(0) { ph_mod(kp_(), (float*)smem); __syncthreads(); }
        ph_rope(kp_());
        ph_routerw(kp_());
        ph_rgprep(kp_());
        REP(1) ph_transpose(kp_().w_in, (bf16_t*)(kp_().ws + OFF_WINT), 1024, 2304, 0, 2, (size_t)1024 * 2304, (size_t)2304 * 1024, (float*)smem);
        ph_transpose(kp_().w_out, (bf16_t*)(kp_().ws + OFF_WOUTT), 1024, 1024, 0, 2, (size_t)1024 * 1024, (size_t)1024 * 1024, (float*)smem);
    }
    SEAM(0);
#define LAYER_BODY(l, pb) { \
        if (IN(pb + 0)) ph_rowin(kp_(), l, lds, qslot, pb + 0); \
        SEAM(pb + 0); \
        if (IN(pb + 1)) ph_inproj2(kp_(), l, lds, qslot, pb + 1); \
        SEAM(pb + 1); \
        if (IN(pb + 2)) ph_mixer(kp_(), l, lds, stat, qslot, pb + 2); \
        SEAM(pb + 2); \
        if (IN(pb + 3)) ph_outproj(kp_(), l, lds, stat); \
        SEAM(pb + 3); \
        if (IN(pb + 4)) { REP(7) { ph_moe<1>(kp_(), l, lds, s_pref, s_cnt, qslot, pb + 4); } } \
        SEAM(pb + 4); \
        if (IN(pb + 5)) { REP(8) { ph_moe<2>(kp_(), l, lds, s_pref, s_cnt, qslot, pb + 5); } } \
        SEAM(pb + 5); \
    }
    LAYER_BODY(0, 1)
    LAYER_BODY(1, 7)
#undef LAYER_BODY
    if (IN(NPHASE - 1)) ph_rowop<2>(kp_(), 2, NLAT);
    if ((PROBE_TS) >= 0 && bid_() == 0) {
        __syncthreads();
        if (tid_() == 0) {
            unsigned long long* ts = (unsigned long long*)(kp_().ws + OFF_CTL + 2048);
            const unsigned long long now = __builtin_amdgcn_s_memrealtime();
            if ((PROBE_TS) == NPHASE - 1) ts[NPHASE] = now;
            const unsigned long long dt = ts[(PROBE_TS) + 1] - ts[(PROBE_TS)];
            while (__builtin_amdgcn_s_memrealtime() - now < 4ull * dt) __builtin_amdgcn_s_sleep(8);
        }
    }
#undef IN
#undef SEAM
}

#ifndef ONE_LAUNCH
#define ONE_LAUNCH 1
#endif
extern "C" void kernel_launch(void* const* d_in, const int* in_sizes, int n_in, void* d_out, int out_size, void* d_ws, size_t ws_size, hipStream_t stream) {
    if (n_in != 28 || ws_size < WS_TOTAL || out_size != NLAT * D) { fprintf(stderr, "kernel_launch: unexpected shapes / workspace (%d inputs, ws %zu need %zu)\n", n_in, ws_size, (size_t)WS_TOTAL); return; }
    static int grid = 0;
    if (grid == 0) {
        int dev = 0, cus = 0, per_cu = 0;
        (void)hipGetDevice(&dev);
        (void)hipDeviceGetAttribute(&cus, hipDeviceAttributeMultiprocessorCount, dev);
        (void)hipFuncSetAttribute((const void*)mega, hipFuncAttributeMaxDynamicSharedMemorySize, SMEM_BYTES);
        (void)hipOccupancyMaxActiveBlocksPerMultiprocessor(&per_cu, (const void*)mega, 256, SMEM_BYTES);
        if (per_cu > 2) per_cu = 2;
        grid = cus * per_cu;
        if (grid <= 0) { fprintf(stderr, "kernel_launch: occupancy query gave %d blocks per CU on %d CUs\n", per_cu, cus); grid = -1; }
    }
    if (grid < 0) return;
    Params p{};
    const float** pp = (const float**)&p;
    for (int i = 0; i < 28; ++i) pp[i] = (const float*)d_in[i];
    p.out = (float*)d_out; p.ws = (unsigned char*)d_ws;
    (void)hipMemsetAsync((unsigned char*)d_ws + OFF_CTL, 0, CTL_BYTES, stream);
#if ONE_LAUNCH
    int lo = 0, hi = NPHASE;
    void* args[] = {(void*)&p, (void*)&lo, (void*)&hi};
    hipError_t e = hipLaunchCooperativeKernel((const void*)mega, dim3(grid), dim3(256), args, SMEM_BYTES, stream);
    if (e != hipSuccess) fprintf(stderr, "kernel_launch: cooperative launch failed: %s (grid %d)\n", hipGetErrorString(e), grid);
#else
    for (int ph = 0; ph < NPHASE; ++ph) mega<<<grid, 256, SMEM_BYTES, stream>>>(p, ph, ph + 1);
#endif
}
```

```cpp
#include <hip/hip_runtime.h>
#include <hip/hip_cooperative_groups.h>
#include <stdint.h>
#include <cstdio>

typedef unsigned short bf16_t;
typedef short bf16x8 __attribute__((ext_vector_type(8)));
typedef float f32x4 __attribute__((ext_vector_type(4)));

#define DEV __device__ __forceinline__
#define PROBE_ID -1
#define PROBE_N 4
#define PROBE_TS -1

constexpr int D = 1024, NB = 8, S = 8192, CTX = 256;
constexpr int NLAT = NB * S, NCTX = NB * CTX, NTOK = NLAT + NCTX;
constexpr int PWS = 1280;
constexpr int COL_RGX = 0, COL_GATE = 256, COL_NAQ = 512, COL_GQ = 896;
constexpr int KVT = 1024;
constexpr int NE = 32, FF = 512;
constexpr int LISTCAP = NTOK;
constexpr float ALPHA = 1.4142135623730951f;
constexpr float LN_EPS = 1e-5f;

constexpr size_t al256(size_t x) { return (x + 255) & ~(size_t)255; }
constexpr size_t OFF_CTL   = 0;
constexpr size_t CTL_BYTES = 4096 + 16384;
constexpr size_t OFF_MOD   = OFF_CTL + CTL_BYTES;
constexpr size_t OFF_ROPE  = al256(OFF_MOD + (size_t)2 * 9 * 6144 * 4);
constexpr size_t OFF_RTE   = al256(OFF_ROPE + (size_t)2 * 128 * 16 * 4);
constexpr size_t OFF_RTW   = al256(OFF_RTE + (size_t)NTOK * 8);
constexpr size_t OFF_LIST  = al256(OFF_RTW + (size_t)NTOK * 8);
constexpr size_t OFF_WR    = al256(OFF_LIST + (size_t)NE * LISTCAP * 4);
constexpr size_t OFF_WRG   = al256(OFF_WR + (size_t)2 * 2 * 48 * 1024 * 2);
constexpr size_t OFF_RGC   = al256(OFF_WRG + (size_t)2 * 2 * 2 * 4 * 64 * 64 * 2);
constexpr size_t OFF_AGG   = al256(OFF_RGC + (size_t)2 * 2 * 3 * 256 * 4);
constexpr size_t OFF_WINT  = al256(OFF_AGG + (size_t)NB * 66 * 2 * 2 * 256 * 4);
constexpr size_t OFF_WOUTT = al256(OFF_WINT + (size_t)2 * 2304 * 1024 * 2);
constexpr size_t OFF_WGU   = al256(OFF_WOUTT + (size_t)2 * 1024 * 1024 * 2);
constexpr size_t OFF_WD    = al256(OFF_WGU + (size_t)NE * 1024 * 1024 * 2);
constexpr size_t OFF_XCTX  = al256(OFF_WD + (size_t)NE * 1024 * 512 * 2);
constexpr size_t OFF_X1    = al256(OFF_XCTX + (size_t)NCTX * D * 4);
constexpr size_t OFF_X2    = al256(OFF_X1 + (size_t)NTOK * D * 2);
constexpr size_t OFF_P     = al256(OFF_X2 + (size_t)NTOK * D * 2);
constexpr size_t OFF_NAKF  = al256(OFF_P + (size_t)NTOK * PWS * 2);
constexpr size_t OFF_NAVF  = al256(OFF_NAKF + (size_t)NB * 6 * 512 * KVT * 2);
constexpr size_t OFF_GKF   = al256(OFF_NAVF + (size_t)NB * 6 * 512 * KVT * 2);
constexpr size_t OFF_GVF   = al256(OFF_GKF + (size_t)NB * 2 * 512 * KVT * 2);
constexpr size_t OFF_NAKFC = al256(OFF_GVF + (size_t)NB * 2 * 512 * KVT * 2);
constexpr size_t OFF_NAVFC = al256(OFF_NAKFC + (size_t)NB * 6 * 16 * KVT * 2);
constexpr size_t OFF_GKFC  = al256(OFF_NAVFC + (size_t)NB * 6 * 16 * KVT * 2);
constexpr size_t OFF_GVFC  = al256(OFF_GKFC + (size_t)NB * 2 * 16 * KVT * 2);
constexpr size_t OFF_Y     = al256(OFF_GVFC + (size_t)NB * 2 * 16 * KVT * 2);
constexpr size_t WS_TOTAL  = al256(OFF_Y + (size_t)2 * NTOK * D * 2);
constexpr int CW_CNT = 0;

struct Params {
    const float *x, *c, *ctx, *c_ctx, *w_ada, *b_ada, *w_in, *conv_w, *conv_b, *rg_a_w, *rg_a_b, *rg_i_w, *rg_i_b, *rg_lambda,
        *na_rpb, *gqa_sink, *w_out, *ln1_g, *ln1_b, *router_g_w, *router_g_b, *router_e_w, *router_e_b, *exp_w_gate, *exp_w_up,
        *exp_w_down, *ln2_g, *ln2_b;
    float* out;
    unsigned char* ws;
};

DEV const Params& kp_() { const void* q = (const void*)__builtin_amdgcn_kernarg_segment_ptr(); asm volatile("" : "+s"(q)); return *(const Params*)q; }
DEV int tid_() { int t = threadIdx.x; asm volatile("" : "+v"(t)); return t; }
DEV int bid_() { int b = blockIdx.x; asm volatile("" : "+s"(b)); return b; }
DEV float shx(float v, int m) { return __builtin_bit_cast(float, __builtin_amdgcn_ds_bpermute(((tid_() & 63) ^ m) << 2, __builtin_bit_cast(int, v))); }
DEV float shl_(float v, int src) { return __builtin_bit_cast(float, __builtin_amdgcn_ds_bpermute(src << 2, __builtin_bit_cast(int, v))); }
DEV float bf2f(bf16_t h) { return __uint_as_float((unsigned)h << 16); }
DEV bf16_t f2bf(float f) { unsigned r; asm("v_cvt_pk_bf16_f32 %0, %1, %1" : "=v"(r) : "v"(f)); return (bf16_t)(r & 0xffffu); }
DEV unsigned pk2(float lo, float hi) { unsigned r; asm("v_cvt_pk_bf16_f32 %0, %1, %2" : "=v"(r) : "v"(lo), "v"(hi)); return r; }
DEV float wave_sum(float v) {
#pragma unroll
    for (int o = 1; o < 64; o <<= 1) v += shx(v, o);
    return v;
}
DEV float wave_max(float v) {
#pragma unroll
    for (int o = 1; o < 64; o <<= 1) v = fmaxf(v, shx(v, o));
    return v;
}
DEV float sigmoidf_(float x) { return 1.f / (1.f + __expf(-x)); }
DEV float gelu_tanh(float x) {
    const float u = 0.7978845608028654f * (x + 0.044715f * x * x * x);
    const float t = 1.f - 2.f * __builtin_amdgcn_rcpf(1.f + __expf(2.f * u));
    return 0.5f * x * (1.f + t);
}
DEV float* xres_row(const Params& p, int R) {
    return R < NLAT ? p.out + (size_t)R * D : (float*)(p.ws + OFF_XCTX) + (size_t)(R - NLAT) * D;
}
DEV const float* modvec(const Params& p, int l, int R, int seg) {
    const int b = R < NLAT ? R / S : 8;
    return (const float*)(p.ws + OFF_MOD) + ((size_t)(l * 9 + b) * 6 + seg) * 1024;
}

DEV void ph_mod(const Params& p, float* sc  ) {
    if (bid_() >= 192) return;
    for (int i = tid_(); i < 9 * 1024; i += 256) { const float v = (i < 8192) ? p.c[i] : p.c_ctx[i - 8192]; sc[i] = v / (1.f + expf(-v)); }
    __syncthreads();
    const int lane = tid_() & 63, w = tid_() >> 6;
    const int col = bid_() * 64 + lane;
    const int l = col / 6144, j = col % 6144;
    const float* wp = p.w_ada + (size_t)l * 1024 * 6144 + j + (size_t)(w * 256) * 6144;
    const float* s = sc + w * 256;
    float a0 = 0, a1 = 0, a2 = 0, a3 = 0, a4 = 0, a5 = 0, a6 = 0, a7 = 0, a8 = 0;
#pragma unroll 8
    for (int k = 0; k < 256; ++k) {
        const float wv = wp[(size_t)k * 6144];
        a0 += s[k] * wv; a1 += s[1024 + k] * wv; a2 += s[2048 + k] * wv; a3 += s[3072 + k] * wv; a4 += s[4096 + k] * wv;
        a5 += s[5120 + k] * wv; a6 += s[6144 + k] * wv; a7 += s[7168 + k] * wv; a8 += s[8192 + k] * wv;
    }
    __syncthreads();
    float* red = sc + 9 * 1024;
    red[(w * 9 + 0) * 64 + lane] = a0; red[(w * 9 + 1) * 64 + lane] = a1; red[(w * 9 + 2) * 64 + lane] = a2; red[(w * 9 + 3) * 64 + lane] = a3; red[(w * 9 + 4) * 64 + lane] = a4;
    red[(w * 9 + 5) * 64 + lane] = a5; red[(w * 9 + 6) * 64 + lane] = a6; red[(w * 9 + 7) * 64 + lane] = a7; red[(w * 9 + 8) * 64 + lane] = a8;
    __syncthreads();
    if (w == 0) {
        const float bias = p.b_ada[l * 6144 + j];
        float* mod = (float*)(p.ws + OFF_MOD) + (size_t)l * 9 * 6144 + j;
#pragma unroll
        for (int r = 0; r < 9; ++r) mod[r * 6144] = ((red[(0 * 9 + r) * 64 + lane] + red[(1 * 9 + r) * 64 + lane]) + (red[(2 * 9 + r) * 64 + lane] + red[(3 * 9 + r) * 64 + lane])) + bias;
    }
}

DEV void sincos_red(float ang, float& sn, float& cs) {
    const float n = rintf(ang * 0.15915494309189535f);
    float r = fmaf(-n, 6.2831854820251465f, ang);
    r = fmaf(-n, -1.7484555e-07f, r);
    float sgn = 1.f;
    if (r > 1.5707963267948966f) { r = 3.14159265358979f - r; sgn = -1.f; }
    else if (r < -1.5707963267948966f) { r = -3.14159265358979f - r; sgn = -1.f; }
    const float r2 = r * r;
    float sp = -1.6059044e-10f; sp = fmaf(sp, r2, 2.5052108e-08f); sp = fmaf(sp, r2, -2.7557319e-06f); sp = fmaf(sp, r2, 1.9841270e-04f);
    sp = fmaf(sp, r2, -8.3333333e-03f); sp = fmaf(sp, r2, 1.6666667e-01f); sp = fmaf(sp * -1.f, r2, 1.f);
    sn = r * sp;
    float cp = -1.1470746e-11f; cp = fmaf(cp, r2, 2.0876757e-09f); cp = fmaf(cp, r2, -2.7557319e-07f); cp = fmaf(cp, r2, 2.4801587e-05f);
    cp = fmaf(cp, r2, -1.3888889e-03f); cp = fmaf(cp, r2, 4.1666667e-02f); cp = fmaf(cp, r2, -0.5f); cp = fmaf(cp, r2, 1.f);
    cs = sgn * cp;
}
DEV void ph_rope(const Params& p) {
    const int i = (bid_() - 192) * 256 + tid_();
    if (i < 0 || i >= 128 * 16) return;
    const int pos = i >> 4, q = i & 15;
    const float inv = exp2f(-(float)q * (13.287712379549449f / 16.f));
    float sn, cs; sincos_red((float)pos * inv, sn, cs);
    float* tab = (float*)(p.ws + OFF_ROPE);
    tab[i] = cs; tab[2048 + i] = sn;
}

DEV void ph_routerw(const Params& p) {
  for (int i = bid_() * 256 + tid_(); i < 2 * 48 * 1024; i += gridDim.x * 256) {
    const int l = i / (48 * 1024), f = (i / 1024) % 48, k = i & 1023;
    float w = 0.f;
    if (f < 4) w = p.router_g_w[((size_t)l * 1024 + k) * 4 + f]; else if (f < 36) w = p.router_e_w[((size_t)l * 1024 + k) * 32 + (f - 4)];
    const bf16_t hi = f2bf(w), lo = f2bf(w - bf2f(hi));
    bf16_t* WR = (bf16_t*)(p.ws + OFF_WR);
    WR[((size_t)(l * 2 + 0) * 48 + f) * 1024 + k] = hi;
    WR[((size_t)(l * 2 + 1) * 48 + f) * 1024 + k] = lo;
  }
}

DEV void ph_rgprep(const Params& p) {
    bf16_t* W = (bf16_t*)(p.ws + OFF_WRG);
    for (int i = bid_() * 256 + tid_(); i < 2 * 2 * 2 * 4 * 64 * 64; i += gridDim.x * 256) {
        const int d = i & 63, e = (i >> 6) & 63, n = (i >> 12) & 3, gate = (i >> 14) & 1, ld = i >> 15;
        const float* srcw = gate ? p.rg_i_w : p.rg_a_w;
        W[i] = f2bf(srcw[((size_t)(ld * 4 + n) * 64 + d) * 64 + e]);
    }
    float* C = (float*)(p.ws + OFF_RGC);
    for (int i = bid_() * 256 + tid_(); i < 2 * 2 * 256; i += gridDim.x * 256) {
        const int c = i & 255, ld = i >> 8;
        C[(ld * 3 + 0) * 256 + c] = p.rg_a_b[ld * 256 + c];
        C[(ld * 3 + 1) * 256 + c] = p.rg_i_b[ld * 256 + c];
        C[(ld * 3 + 2) * 256 + c] = -8.f * log1pf(expf(-p.rg_lambda[ld * 256 + c]));
    }
}

DEV int tr_row(int n, int mode) { return mode == 0 ? n : ((n >> 7) * 256 + ((n >> 6) & 1) * 128 + (n & 63) + (mode == 2 ? 64 : 0)); }
DEV void transpose_tile(const float* src, bf16_t* dst, int K, int N, int mode, int tile, float* lds) {
    const int ntn = N >> 6, kt = tile / ntn, nt = tile % ntn, k0 = kt * 64, n0 = nt * 64, t = tid_();
#pragma unroll
    for (int i = 0; i < 4; ++i) {
        const int r = (t >> 4) + 16 * i, c4 = (t & 15) * 4;
        const float4 v = *(const float4*)(src + (size_t)(k0 + r) * N + n0 + c4);
        lds[r * 65 + c4] = v.x; lds[r * 65 + c4 + 1] = v.y; lds[r * 65 + c4 + 2] = v.z; lds[r * 65 + c4 + 3] = v.w;
    }
    __syncthreads();
#pragma unroll
    for (int i = 0; i < 2; ++i) {
        const int n = (t >> 3) + 32 * i, kc = (t & 7) * 8;
        uint4 o;
        o.x = pk2(lds[(kc + 0) * 65 + n], lds[(kc + 1) * 65 + n]); o.y = pk2(lds[(kc + 2) * 65 + n], lds[(kc + 3) * 65 + n]);
        o.z = pk2(lds[(kc + 4) * 65 + n], lds[(kc + 5) * 65 + n]); o.w = pk2(lds[(kc + 6) * 65 + n], lds[(kc + 7) * 65 + n]);
        *(uint4*)(dst + (size_t)tr_row(n0 + n, mode) * K + k0 + kc) = o;
    }
    __syncthreads();
}
DEV void transpose_tile_w(const float* src, bf16_t* dst, int K, int N, int mode, int tile, float* lds  ) {
    const int ntn = N >> 6, kt = tile / ntn, nt = tile % ntn, k0 = kt * 64, n0 = nt * 64, t = tid_() & 63;
    float4 v[16];
#pragma unroll
    for (int i = 0; i < 16; ++i) v[i] = *(const float4*)(src + (size_t)(k0 + (t >> 4) + 4 * i) * N + n0 + (t & 15) * 4);
#pragma unroll
    for (int i = 0; i < 16; ++i) { const int r = (t >> 4) + 4 * i, c4 = (t & 15) * 4; lds[r * 65 + c4] = v[i].x; lds[r * 65 + c4 + 1] = v[i].y; lds[r * 65 + c4 + 2] = v[i].z; lds[r * 65 + c4 + 3] = v[i].w; }
    asm volatile("s_waitcnt lgkmcnt(0)" ::: "memory");
#pragma unroll
    for (int i = 0; i < 8; ++i) {
        const int n = (t >> 3) + 8 * i, kc = (t & 7) * 8;
        uint4 o;
        o.x = pk2(lds[(kc + 0) * 65 + n], lds[(kc + 1) * 65 + n]); o.y = pk2(lds[(kc + 2) * 65 + n], lds[(kc + 3) * 65 + n]);
        o.z = pk2(lds[(kc + 4) * 65 + n], lds[(kc + 5) * 65 + n]); o.w = pk2(lds[(kc + 6) * 65 + n], lds[(kc + 7) * 65 + n]);
        *(uint4*)(dst + (size_t)tr_row(n0 + n, mode) * K + k0 + kc) = o;
    }
    asm volatile("s_waitcnt lgkmcnt(0)" ::: "memory");
}
DEV void expert_conv_item(const Params& p, int l, int gi, float* lds) {
    const int w = tid_() >> 6;
    float* my = lds + w * (64 * 65);
#pragma unroll 1
    for (int k = 0; k < 2; ++k) {
        const int T = gi * 8 + w * 2 + k, kind = T >> 12, Tl = T & 4095, e = Tl >> 7, tile = Tl & 127;
        if (kind == 0) transpose_tile_w(p.exp_w_gate + ((size_t)l * NE + e) * 1024 * 512, (bf16_t*)(p.ws + OFF_WGU) + (size_t)e * 1024 * 1024, 1024, 512, 1, tile, my);
        else if (kind == 1) transpose_tile_w(p.exp_w_up + ((size_t)l * NE + e) * 1024 * 512, (bf16_t*)(p.ws + OFF_WGU) + (size_t)e * 1024 * 1024, 1024, 512, 2, tile, my);
        else transpose_tile_w(p.exp_w_down + ((size_t)l * NE + e) * 512 * 1024, (bf16_t*)(p.ws + OFF_WD) + (size_t)e * 1024 * 512, 512, 1024, 0, tile, my);
    }
}
DEV void ph_transpose(const float* src, bf16_t* dst, int K, int N, int mode, int nmat, size_t sstride, size_t dstride, float* lds  ) {
    const int per = (K >> 6) * (N >> 6);
    for (int it = bid_(); it < nmat * per; it += gridDim.x) {
        const int m = it / per, tile = it % per;
        transpose_tile(src + (size_t)m * sstride, dst + (size_t)m * dstride, K, N, mode, tile, lds);
    }
}

template <int MODE, bool WX> DEV void rowop(const Params& p, int l, int R) {
    const int lane = tid_() & 63;
    float4 v[2][4];
    float* xr[2] = {nullptr, nullptr};
    if (MODE == 0) {
#pragma unroll
        for (int r = 0; r < 2; ++r) {
            const int Rr = R + r;
            const float* src = Rr < NLAT ? p.x + (size_t)Rr * D : p.ctx + (size_t)(Rr - NLAT) * D;
#pragma unroll
            for (int i = 0; i < 4; ++i) v[r][i] = *(const float4*)(src + i * 256 + lane * 4);
        }
    } else {
        const float* g2 = modvec(p, l - 1, R, 5);
        const float* lg = p.ln2_g + (l - 1) * D; const float* lb = p.ln2_b + (l - 1) * D;
        float4 xv[2][4]; uint2 ya[2][4], yb[2][4];
#pragma unroll
        for (int r = 0; r < 2; ++r) {
            xr[r] = xres_row(p, R + r);
            const bf16_t* y0 = (const bf16_t*)(p.ws + OFF_Y) + (size_t)(2 * (R + r)) * D;
#pragma unroll
            for (int i = 0; i < 4; ++i) { const int k = i * 256 + lane * 4; xv[r][i] = *(const float4*)(xr[r] + k); ya[r][i] = *(const uint2*)(y0 + k); yb[r][i] = *(const uint2*)(y0 + D + k); }
        }
        float s[2] = {0.f, 0.f};
#pragma unroll
        for (int i = 0; i < 4; ++i) {
            const float4 gv = *(const float4*)(g2 + i * 256 + lane * 4);
#pragma unroll
            for (int r = 0; r < 2; ++r) {
                const uint2 a = ya[r][i], b = yb[r][i];
                float4 u;
                u.x = ALPHA * xv[r][i].x + gv.x * (bf2f((bf16_t)(a.x & 0xffff)) + bf2f((bf16_t)(b.x & 0xffff)));
                u.y = ALPHA * xv[r][i].y + gv.y * (bf2f((bf16_t)(a.x >> 16)) + bf2f((bf16_t)(b.x >> 16)));
                u.z = ALPHA * xv[r][i].z + gv.z * (bf2f((bf16_t)(a.y & 0xffff)) + bf2f((bf16_t)(b.y & 0xffff)));
                u.w = ALPHA * xv[r][i].w + gv.w * (bf2f((bf16_t)(a.y >> 16)) + bf2f((bf16_t)(b.y >> 16)));
                v[r][i] = u; s[r] += (u.x + u.y) + (u.z + u.w);
            }
        }
        float q[2] = {0.f, 0.f};
#pragma unroll
        for (int r = 0; r < 2; ++r) {
            const float mean = wave_sum(s[r]) * (1.f / D);
#pragma unroll
            for (int i = 0; i < 4; ++i) { v[r][i].x -= mean; v[r][i].y -= mean; v[r][i].z -= mean; v[r][i].w -= mean; q[r] += (v[r][i].x * v[r][i].x + v[r][i].y * v[r][i].y) + (v[r][i].z * v[r][i].z + v[r][i].w * v[r][i].w); }
        }
#pragma unroll
        for (int r = 0; r < 2; ++r) q[r] = rsqrtf(wave_sum(q[r]) * (1.f / D) + LN_EPS);
#pragma unroll
        for (int i = 0; i < 4; ++i) {
            const int k = i * 256 + lane * 4;
            const float4 gg = *(const float4*)(lg + k); const float4 bb = *(const float4*)(lb + k);
#pragma unroll
            for (int r = 0; r < 2; ++r) {
                v[r][i].x = v[r][i].x * q[r] * gg.x + bb.x; v[r][i].y = v[r][i].y * q[r] * gg.y + bb.y; v[r][i].z = v[r][i].z * q[r] * gg.z + bb.z; v[r][i].w = v[r][i].w * q[r] * gg.w + bb.w;
                if (WX) *(float4*)(xr[r] + k) = v[r][i];
            }
        }
    }
    if (MODE != 2) {
        const float* sh = modvec(p, l, R, 0); const float* sc = modvec(p, l, R, 1);
#pragma unroll
        for (int i = 0; i < 4; ++i) {
            const int k = i * 256 + lane * 4;
            const float4 s4 = *(const float4*)(sh + k); const float4 c4 = *(const float4*)(sc + k);
#pragma unroll
            for (int r = 0; r < 2; ++r) {
                bf16_t* ha = (bf16_t*)(p.ws + OFF_X1) + (size_t)(R + r) * D;
                uint2 o; o.x = pk2(v[r][i].x * (1.f + c4.x) + s4.x, v[r][i].y * (1.f + c4.y) + s4.y); o.y = pk2(v[r][i].z * (1.f + c4.z) + s4.z, v[r][i].w * (1.f + c4.w) + s4.w);
                *(uint2*)(ha + k) = o;
            }
        }
    }
}
template <int MODE> DEV void ph_rowop(const Params& p, int l, int nrows) {
    const int w = tid_() >> 6;
    for (int R = (bid_() * 4 + w) * 2; R < nrows; R += gridDim.x * 8) rowop<MODE, true>(p, l, R);
}
constexpr int CW_Q = 64;
DEV int q_publish(int nreg, int* slot) {
    __syncthreads();
    if (tid_() == 0) *slot = nreg;
    __syncthreads();
    return *(volatile int*)slot;
}
DEV int q_pull(unsigned* ctr, int* slot) {
    if (tid_() == 0) *slot = (int)atomicAdd(ctr, 1u);
    __syncthreads();
    const int v = *(volatile int*)slot;
    __syncthreads();
    return v;
}

constexpr int GEMM_STAGE_BYTES = 384 * 64;
constexpr int GEMM_NSTAGE = 3;
constexpr int GEMM_LDS_BYTES = GEMM_NSTAGE * GEMM_STAGE_BYTES;
#define LAS __attribute__((address_space(3)))
DEV int gemm_src_chunk(int t) { return ((t & 3) ^ ((0 - (t >> 4)) & 3)) * 8; }
DEV void gemm_mainloop(const bf16_t* Abase, unsigned ao0, unsigned ao1, const bf16_t* Bbase, unsigned bo, unsigned ldb, int nk, bf16_t* lds, f32x4 (&acc)[4][8]) {
    const int t = tid_(), lane = t & 63, w = __builtin_amdgcn_readfirstlane(t >> 6), wm = w >> 1, wn = w & 1;
    LAS unsigned char* L = (LAS unsigned char*)lds;
    const int pc = ((lane >> 4) ^ ((0 - ((lane & 15) >> 2)) & 3)) * 16;
    const int arow = (wm * 64 + (lane & 15)) * 64 + pc, brow = (128 + wn * 128 + (lane & 15)) * 64 + pc;
    const char* Ab = (const char*)Abase; const char* B0 = (const char*)Bbase; const char* B1 = B0 + (size_t)ldb * 128; const char* B2 = B0 + (size_t)ldb * 256; const char* B3 = B0 + (size_t)ldb * 384;
#define GEMM_ISSUE(slot, ko) do { LAS unsigned* d_ = (LAS unsigned*)(L + (slot) * GEMM_STAGE_BYTES + w * 1024); \
        __builtin_amdgcn_global_load_lds((const unsigned*)(Ab + (ao0 + (ko) * 2u)), d_, 16, 0, 0); \
        __builtin_amdgcn_global_load_lds((const unsigned*)(Ab + (ao1 + (ko) * 2u)), d_ + 1024, 16, 0, 0); \
        __builtin_amdgcn_global_load_lds((const unsigned*)(B0 + (bo + (ko) * 2u)), d_ + 2048, 16, 0, 0); \
        __builtin_amdgcn_global_load_lds((const unsigned*)(B1 + (bo + (ko) * 2u)), d_ + 3072, 16, 0, 0); \
        __builtin_amdgcn_global_load_lds((const unsigned*)(B2 + (bo + (ko) * 2u)), d_ + 4096, 16, 0, 0); \
        __builtin_amdgcn_global_load_lds((const unsigned*)(B3 + (bo + (ko) * 2u)), d_ + 5120, 16, 0, 0); } while (0)
    asm volatile("s_waitcnt vmcnt(0)" ::: "memory");
    __builtin_amdgcn_s_barrier();
    asm volatile("" ::: "memory");
    GEMM_ISSUE(0, 0);
    if (nk > 1) GEMM_ISSUE(1, 32);
    int cs = 0, is = 2;
    for (int kt = 0; kt < nk; ++kt) {
        if (kt + 1 < nk) asm volatile("s_waitcnt vmcnt(6)" ::: "memory"); else asm volatile("s_waitcnt vmcnt(0)" ::: "memory");
        __builtin_amdgcn_s_barrier();
        asm volatile("" ::: "memory");
        if (kt + 2 < nk) GEMM_ISSUE(is, (kt + 2) * 32);
        const LAS unsigned char* cur = L + cs * GEMM_STAGE_BYTES;
        const bf16x8 af0 = *(const LAS bf16x8*)(cur + arow), af1 = *(const LAS bf16x8*)(cur + arow + 16 * 64), af2 = *(const LAS bf16x8*)(cur + arow + 32 * 64), af3 = *(const LAS bf16x8*)(cur + arow + 48 * 64);
        bf16x8 bq0 = *(const LAS bf16x8*)(cur + brow), bq1 = *(const LAS bf16x8*)(cur + brow + 16 * 64);
#pragma unroll
        for (int nt = 0; nt < 8; ++nt) {
            const bf16x8 bfr = bq0; bq0 = bq1;
            if (nt + 2 < 8) bq1 = *(const LAS bf16x8*)(cur + brow + (nt + 2) * 16 * 64);
            acc[0][nt] = __builtin_amdgcn_mfma_f32_16x16x32_bf16(bfr, af0, acc[0][nt], 0, 0, 0);
            acc[1][nt] = __builtin_amdgcn_mfma_f32_16x16x32_bf16(bfr, af1, acc[1][nt], 0, 0, 0);
            acc[2][nt] = __builtin_amdgcn_mfma_f32_16x16x32_bf16(bfr, af2, acc[2][nt], 0, 0, 0);
            acc[3][nt] = __builtin_amdgcn_mfma_f32_16x16x32_bf16(bfr, af3, acc[3][nt], 0, 0, 0);
        }
        cs = cs == 2 ? 0 : cs + 1; is = is == 2 ? 0 : is + 1;
    }
#undef GEMM_ISSUE
}
DEV void zero_acc(f32x4 (&acc)[4][8]) {
#pragma unroll
    for (int a = 0; a < 4; ++a)
#pragma unroll
        for (int b = 0; b < 8; ++b) acc[a][b] = (f32x4){0.f, 0.f, 0.f, 0.f};
}

DEV void inproj_item(const Params& p_, int l, int rt, int pass, bf16_t* lds) {
    const Params& p = kp_();
    const int t = tid_(), lane = t & 63, w = t >> 6, wm = w >> 1, wn = w & 1;
    const bf16_t* A = (const bf16_t*)(p.ws + OFF_X1) + (size_t)(rt * 128) * D;
    const bf16_t* Bt = (const bf16_t*)(p.ws + OFF_WINT) + ((size_t)l * 2304 + pass * 256) * 1024;
    const unsigned toff = (unsigned)(((t >> 2) * 1024 + gemm_src_chunk(t)) * 2);
    f32x4 acc[4][8]; zero_acc(acc);
    gemm_mainloop(A, toff, toff + 64 * D * 2, Bt, toff, 1024, 32, lds, acc);
    bf16_t* P = (bf16_t*)(p.ws + OFF_P);
    const float* ctab = (const float*)(p.ws + OFF_ROPE); const float* stab = ctab + 2048;
    const bool isctx = rt >= 512;
    const int fq = lane >> 4, fr = lane & 15;
#pragma unroll
    for (int hci = 0; hci < 2; ++hci) {
        const int hc = pass * 4 + wn * 2 + hci;
        int type, dcol = 0, vh = 0;
        if (hc < 4) { type = 0; dcol = COL_RGX + hc * 64; }
        else if (hc < 10) { type = 4; vh = hc - 4; }
        else if (hc < 16) { type = 5; vh = hc - 10; }
        else if (hc < 18) { type = 6; vh = hc - 16; }
        else if (hc < 20) { type = 7; vh = hc - 18; }
        else if (hc < 24) { type = 0; dcol = COL_GATE + (hc - 20) * 64; }
        else if (hc < 30) { type = 1; dcol = COL_NAQ + (hc - 24) * 64; }
        else { type = 3; dcol = COL_GQ + (hc - 30) * 64; }
#pragma unroll
        for (int mt = 0; mt < 4; ++mt) {
            const int R = rt * 128 + wm * 64 + mt * 16 + fr;
            f32x4 v0 = acc[mt][hci * 4 + 0], v1 = acc[mt][hci * 4 + 1], v2 = acc[mt][hci * 4 + 2], v3 = acc[mt][hci * 4 + 3];
            if ((type == 3 || type == 6) && !isctx) {
                const int tt = R & (S - 1), pr = tt >> 6, pc = tt & 63;
                const f32x4 cr = *(const f32x4*)(ctab + pr * 16 + fq * 4), sr = *(const f32x4*)(stab + pr * 16 + fq * 4);
                const f32x4 cc = *(const f32x4*)(ctab + pc * 16 + fq * 4), sc = *(const f32x4*)(stab + pc * 16 + fq * 4);
                const f32x4 o0 = v0 * cr - v1 * sr, o1 = v1 * cr + v0 * sr, o2 = v2 * cc - v3 * sc, o3 = v3 * cc + v2 * sc;
                v0 = o0; v1 = o1; v2 = o2; v3 = o3;
            }
            if (type == 1 || type == 3) { const float qs = 0.125f * 1.4426950408889634f; v0 = v0 * qs; v1 = v1 * qs; v2 = v2 * qs; v3 = v3 * qs; }
            if (type < 4) {
                bf16_t* o = P + (size_t)R * PWS + dcol + fq * 4;
                uint2 q;
                q.x = pk2(v0[0], v0[1]); q.y = pk2(v0[2], v0[3]); *(uint2*)(o) = q;
                q.x = pk2(v1[0], v1[1]); q.y = pk2(v1[2], v1[3]); *(uint2*)(o + 16) = q;
                q.x = pk2(v2[0], v2[1]); q.y = pk2(v2[2], v2[3]); *(uint2*)(o + 32) = q;
                q.x = pk2(v3[0], v3[1]); q.y = pk2(v3[2], v3[3]); *(uint2*)(o + 48) = q;
            } else {
                const bool na = type < 6, isk = (type == 4 || type == 6);
                bf16_t* tb;
                if (!isctx) { const int b = R >> 13, tile = (R & (S - 1)) >> 4;
                    tb = (bf16_t*)(p.ws + (na ? (isk ? OFF_NAKF : OFF_NAVF) : (isk ? OFF_GKF : OFF_GVF))) + ((size_t)(b * (na ? 6 : 2) + vh) * 512 + tile) * KVT; }
                else { const int cR = R - NLAT, b = cR >> 8, tile = (cR & 255) >> 4;
                    tb = (bf16_t*)(p.ws + (na ? (isk ? OFF_NAKFC : OFF_NAVFC) : (isk ? OFF_GKFC : OFF_GVFC))) + ((size_t)(b * (na ? 6 : 2) + vh) * 16 + tile) * KVT; }
                if (isk) {
                    bf16_t* o = tb + ((fq >> 1) * 16 + fr) * 8 + (fq & 1) * 4;
                    uint2 q;
                    q.x = pk2(v0[0], v0[1]); q.y = pk2(v0[2], v0[3]); *(uint2*)(o) = q;
                    q.x = pk2(v1[0], v1[1]); q.y = pk2(v1[2], v1[3]); *(uint2*)(o + 2 * 16 * 8) = q;
                    q.x = pk2(v2[0], v2[1]); q.y = pk2(v2[2], v2[3]); *(uint2*)(o + 512) = q;
                    q.x = pk2(v3[0], v3[1]); q.y = pk2(v3[2], v3[3]); *(uint2*)(o + 512 + 2 * 16 * 8) = q;
                } else {
                    bf16_t* o = tb + ((fr >> 2) * 16 + fq * 4) * 8 + (fr & 3);
#pragma unroll
                    for (int j = 0; j < 4; ++j) {
                        o[j * 8] = f2bf(v0[j]); o[j * 8 + 4] = f2bf(v1[j]); o[512 + j * 8] = f2bf(v2[j]); o[512 + j * 8 + 4] = f2bf(v3[j]);
                    }
                }
            }
        }
    }
}
DEV void ph_inproj(const Params& p, int l, bf16_t* lds) {
    const int nctxp = (l == 0) ? 9 : 5;
    const int nx = gridDim.x >> 3, xcd = bid_() & 7, j = bid_() >> 3;
    const int nloc = 64 * 9 + 2 * nctxp;
    if (bid_() >= nx * 8) return;
    for (int i0 = j; i0 < nloc * ((PROBE_ID) == 3 ? PROBE_N : 1); i0 += nx) {
        const int i = i0 % nloc;
        int rt, pass;
        if (i < 64 * 9) { rt = xcd * 64 + i / 9; pass = i % 9; } else { const int r = i - 64 * 9; rt = 512 + 2 * xcd + r / nctxp; pass = r % nctxp; }
        inproj_item(p, l, rt, pass, lds);
    }
}

constexpr float LOG2E = 1.4426950408889634f;
struct AttnState { f32x4 o0, o1, o2, o3; float m, lsum; };
struct KVFrag { bf16x8 k00, k01, k10, k11, v0, v1, v2, v3; };
DEV bf16x8 ld16(const bf16_t* p) { return *(const bf16x8*)p; }
DEV bf16x8 lohi(const uint4& a, const uint4& b, int hi) { union { uint4 u; bf16x8 v; } c; c.u = hi ? make_uint4(a.z, a.w, b.z, b.w) : make_uint4(a.x, a.y, b.x, b.y); return c.v; }
DEV void kv_load(const bf16_t* kt0, const bf16_t* kt1, const bf16_t* vt0, const bf16_t* vt1, KVFrag& f) {
    f.k00 = ld16(kt0); f.k01 = ld16(kt0 + 512); f.k10 = ld16(kt1); f.k11 = ld16(kt1 + 512);
    const uint4 a0 = *(const uint4*)vt0, a1 = *(const uint4*)(vt0 + 512), b0 = *(const uint4*)vt1, b1 = *(const uint4*)(vt1 + 512);
    f.v0 = lohi(a0, b0, 0); f.v1 = lohi(a0, b0, 1); f.v2 = lohi(a1, b1, 0); f.v3 = lohi(a1, b1, 1);
}
template <bool HASB> DEV void attn_apply(const KVFrag& f, const bf16x8& q0, const bf16x8& q1, f32x4 b0, f32x4 b1, AttnState& st) {
    const f32x4 z = {0.f, 0.f, 0.f, 0.f};
    f32x4 s0 = __builtin_amdgcn_mfma_f32_16x16x32_bf16(f.k00, q0, z, 0, 0, 0); s0 = __builtin_amdgcn_mfma_f32_16x16x32_bf16(f.k01, q1, s0, 0, 0, 0);
    f32x4 s1 = __builtin_amdgcn_mfma_f32_16x16x32_bf16(f.k10, q0, z, 0, 0, 0); s1 = __builtin_amdgcn_mfma_f32_16x16x32_bf16(f.k11, q1, s1, 0, 0, 0);
    if (HASB) { s0 = s0 + b0; s1 = s1 + b1; }
    float mx = fmaxf(fmaxf(fmaxf(s0[0], s0[1]), fmaxf(s0[2], s0[3])), fmaxf(fmaxf(s1[0], s1[1]), fmaxf(s1[2], s1[3])));
    mx = fmaxf(mx, shx(mx, 16)); mx = fmaxf(mx, shx(mx, 32));
    if (__builtin_amdgcn_ballot_w64(mx > st.m + 8.f) != 0ull) {
        const float mn = fmaxf(st.m, mx);
        const float msn = (mn == -INFINITY) ? 0.f : mn;
        const float alpha = __builtin_amdgcn_exp2f(st.m - msn);
        st.lsum = st.lsum * alpha;
        st.o0 = st.o0 * alpha; st.o1 = st.o1 * alpha; st.o2 = st.o2 * alpha; st.o3 = st.o3 * alpha;
        st.m = mn;
    }
    const float ms = (st.m == -INFINITY) ? 0.f : st.m;
    f32x4 p0, p1;
#pragma unroll
    for (int j = 0; j < 4; ++j) { p0[j] = __builtin_amdgcn_exp2f(s0[j] - ms); p1[j] = __builtin_amdgcn_exp2f(s1[j] - ms); }
    st.lsum = st.lsum + ((p0[0] + p0[1]) + (p0[2] + p0[3])) + ((p1[0] + p1[1]) + (p1[2] + p1[3]));
    union { uint4 u; bf16x8 v; } pt; pt.u = make_uint4(pk2(p0[0], p0[1]), pk2(p0[2], p0[3]), pk2(p1[0], p1[1]), pk2(p1[2], p1[3]));
    st.o0 = __builtin_amdgcn_mfma_f32_16x16x32_bf16(f.v0, pt.v, st.o0, 0, 0, 0);
    st.o1 = __builtin_amdgcn_mfma_f32_16x16x32_bf16(f.v1, pt.v, st.o1, 0, 0, 0);
    st.o2 = __builtin_amdgcn_mfma_f32_16x16x32_bf16(f.v2, pt.v, st.o2, 0, 0, 0);
    st.o3 = __builtin_amdgcn_mfma_f32_16x16x32_bf16(f.v3, pt.v, st.o3, 0, 0, 0);
}
DEV void attn_init(AttnState& st) { const f32x4 z = {0.f, 0.f, 0.f, 0.f}; st.o0 = z; st.o1 = z; st.o2 = z; st.o3 = z; st.m = -INFINITY; st.lsum = 0.f; }
DEV void attn_store(AttnState& st, bf16_t* orow, float sink2  ) {
    float l = st.lsum; l += shx(l, 16); l += shx(l, 32);
    float sc;
    if (sink2 != -INFINITY) { const float mf = fmaxf(st.m, sink2); const float al = __builtin_amdgcn_exp2f(st.m - mf); l = l * al + __builtin_amdgcn_exp2f(sink2 - mf); sc = al / l; }
    else sc = 1.f / l;
    uint2 w;
    w.x = pk2(st.o0[0] * sc, st.o0[1] * sc); w.y = pk2(st.o0[2] * sc, st.o0[3] * sc); *(uint2*)(orow) = w;
    w.x = pk2(st.o1[0] * sc, st.o1[1] * sc); w.y = pk2(st.o1[2] * sc, st.o1[3] * sc); *(uint2*)(orow + 16) = w;
    w.x = pk2(st.o2[0] * sc, st.o2[1] * sc); w.y = pk2(st.o2[2] * sc, st.o2[3] * sc); *(uint2*)(orow + 32) = w;
    w.x = pk2(st.o3[0] * sc, st.o3[1] * sc); w.y = pk2(st.o3[2] * sc, st.o3[3] * sc); *(uint2*)(orow + 48) = w;
}

constexpr int NTASK_NA = NB * 6 * 128 * 4, NTASK_GQ = NB * 2 * 512, NTASK_CNA = NB * 6 * 16, NTASK_CGQ = NB * 2 * 16;
DEV void attn_task(const Params& p, int l, int tk, const float* rpb2  ) {
    const int lane = tid_() & 63, g = lane >> 4, fr = lane & 15;
    const bf16_t* P = (const bf16_t*)(p.ws + OFF_P);
    bf16_t* X1 = (bf16_t*)(p.ws + OFF_X1);
    const f32x4 z4 = {0.f, 0.f, 0.f, 0.f};
    KVFrag f;
    if (tk < NTASK_NA) {
        const int qtile = tk & 3, r = (tk >> 2) & 127, hb = tk >> 9, h = hb % 6, b = hb / 6;
        const int qc = qtile == 0 ? (fr < 8 ? fr : 48 + fr) : 8 + (qtile - 1) * 16 + fr;
        const int ct0 = qtile == 0 ? 0 : qtile - 1, ct1 = qtile == 0 ? 3 : qtile;
        const int R = b * S + r * 64 + qc;
        const bf16_t* qp = P + (size_t)R * PWS + COL_NAQ + h * 64 + g * 8;
        const bf16x8 q0 = ld16(qp), q1 = ld16(qp + 32);
        const int rs = min(max(r - 4, 0), 120), cs = min(max(qc - 8, 0), 48);
        int ci[8]; bool ok[8];
#pragma unroll
        for (int e = 0; e < 8; ++e) { const int kc = ((e >> 2) ? ct1 : ct0) * 16 + g * 4 + (e & 3); ok[e] = (kc >= cs) && (kc < cs + 16); ci[e] = min(max(kc - qc + 15, 0), 30); }
        const bf16_t* kf = (const bf16_t*)(p.ws + OFF_NAKF) + ((size_t)(b * 6 + h) * 512 + rs * 4) * KVT + lane * 8;
        const bf16_t* vf = (const bf16_t*)(p.ws + OFF_NAVF) + ((size_t)(b * 6 + h) * 512 + rs * 4) * KVT + lane * 8;
        AttnState st; attn_init(st);
#pragma unroll
        for (int ri = 0; ri < 8; ++ri) {
            const float* rb = rpb2 + (h * 15 + (rs + ri - r + 7)) * 31;
            f32x4 b0, b1;
#pragma unroll
            for (int j = 0; j < 4; ++j) { b0[j] = ok[j] ? rb[ci[j]] : -INFINITY; b1[j] = ok[4 + j] ? rb[ci[4 + j]] : -INFINITY; }
            kv_load(kf + (size_t)(ri * 4 + ct0) * KVT, kf + (size_t)(ri * 4 + ct1) * KVT, vf + (size_t)(ri * 4 + ct0) * KVT, vf + (size_t)(ri * 4 + ct1) * KVT, f);
            attn_apply<true>(f, q0, q1, b0, b1, st);
        }
        const bf16_t* kc_ = (const bf16_t*)(p.ws + OFF_NAKFC) + (size_t)(b * 6 + h) * 16 * KVT + lane * 8;
        const bf16_t* vc_ = (const bf16_t*)(p.ws + OFF_NAVFC) + (size_t)(b * 6 + h) * 16 * KVT + lane * 8;
#pragma unroll
        for (int pp = 0; pp < 8; ++pp) { kv_load(kc_ + (size_t)(2 * pp) * KVT, kc_ + (size_t)(2 * pp + 1) * KVT, vc_ + (size_t)(2 * pp) * KVT, vc_ + (size_t)(2 * pp + 1) * KVT, f); attn_apply<false>(f, q0, q1, z4, z4, st); }
        attn_store(st, X1 + (size_t)R * D + 256 + h * 64 + g * 4, -INFINITY);
    } else if (tk < NTASK_NA + NTASK_GQ + NTASK_CNA + NTASK_CGQ && (tk < NTASK_NA + NTASK_GQ || tk >= NTASK_NA + NTASK_GQ + NTASK_CNA)) {
        const bool lat = tk < NTASK_NA + NTASK_GQ;
        const int t2 = lat ? tk - NTASK_NA : tk - (NTASK_NA + NTASK_GQ + NTASK_CNA);
        const int qt = lat ? (t2 & 511) : (t2 & 15), hb = lat ? (t2 >> 9) : (t2 >> 4), kvh = hb & 1, b = hb >> 1;
        const int q0i = qt * 16, R = (lat ? b * S : NLAT + b * CTX) + q0i + fr;
        const bf16_t* qp = P + (size_t)R * PWS + COL_GQ + kvh * 192 + g * 8;
        const bf16x8 qa0 = ld16(qp), qa1 = ld16(qp + 32), qb0 = ld16(qp + 64), qb1 = ld16(qp + 96), qc0 = ld16(qp + 128), qc1 = ld16(qp + 160);
        AttnState sa, sb, sc; attn_init(sa); attn_init(sb); attn_init(sc);
        const bf16_t* kf = (const bf16_t*)(p.ws + OFF_GKF) + (size_t)(b * 2 + kvh) * 512 * KVT + lane * 8;
        const bf16_t* vf = (const bf16_t*)(p.ws + OFF_GVF) + (size_t)(b * 2 + kvh) * 512 * KVT + lane * 8;
        const bf16_t* kc_ = (const bf16_t*)(p.ws + OFF_GKFC) + (size_t)(b * 2 + kvh) * 16 * KVT + lane * 8;
        const bf16_t* vc_ = (const bf16_t*)(p.ws + OFF_GVFC) + (size_t)(b * 2 + kvh) * 16 * KVT + lane * 8;
        const int qi = q0i + fr;
#define GQ_LOAD(i, F) do { const int i_ = (i); if (i_ < 9) { const int kt_ = (q0i - 128 + i_ * 32) >> 4; const int ta_ = min(max(kt_, 0), 511), tb_ = min(max(kt_ + 1, 0), 511); \
            kv_load(kf + (size_t)ta_ * KVT, kf + (size_t)tb_ * KVT, vf + (size_t)ta_ * KVT, vf + (size_t)tb_ * KVT, F); } \
        else { const int c_ = (i_ - 9) * 2; kv_load(kc_ + (size_t)c_ * KVT, kc_ + (size_t)(c_ + 1) * KVT, vc_ + (size_t)c_ * KVT, vc_ + (size_t)(c_ + 1) * KVT, F); } } while (0)
#define GQ_APPLY(i, F) do { const int i_ = (i); f32x4 b0_ = z4, b1_ = z4; if (i_ < 9) { const int kb_ = q0i - 128 + i_ * 32; _Pragma("unroll") for (int j = 0; j < 4; ++j) { const int k0_ = kb_ + g * 4 + j, k1_ = k0_ + 16; \
                b0_[j] = (k0_ >= 0 && k0_ < S && k0_ >= qi - 128 && k0_ <= qi + 128) ? 0.f : -INFINITY; b1_[j] = (k1_ >= 0 && k1_ < S && k1_ >= qi - 128 && k1_ <= qi + 128) ? 0.f : -INFINITY; } } \
            if (i_ < 9) { attn_apply<true>(F, qa0, qa1, b0_, b1_, sa); attn_apply<true>(F, qb0, qb1, b0_, b1_, sb); attn_apply<true>(F, qc0, qc1, b0_, b1_, sc); } \
            else { attn_apply<false>(F, qa0, qa1, b0_, b1_, sa); attn_apply<false>(F, qb0, qb1, b0_, b1_, sb); attn_apply<false>(F, qc0, qc1, b0_, b1_, sc); } } while (0)
        KVFrag f2;
        const int i0 = lat ? 0 : 9;
        GQ_LOAD(i0, f);
#pragma unroll 1
        for (int i = i0; i < 17; i += 2) {
            if (i + 1 < 17) GQ_LOAD(i + 1, f2);
            GQ_APPLY(i, f);
            if (i + 1 < 17) { if (i + 2 < 17) GQ_LOAD(i + 2, f); GQ_APPLY(i + 1, f2); }
        }
#undef GQ_LOAD
#undef GQ_APPLY
        bf16_t* o = X1 + (size_t)R * D + 640 + kvh * 192 + g * 4;
        attn_store(sa, o, p.gqa_sink[l * 6 + kvh * 3 + 0] * LOG2E); attn_store(sb, o + 64, p.gqa_sink[l * 6 + kvh * 3 + 1] * LOG2E); attn_store(sc, o + 128, p.gqa_sink[l * 6 + kvh * 3 + 2] * LOG2E);
    } else {
        const int t3 = tk - NTASK_NA - NTASK_GQ, qt = t3 & 15, hb = t3 >> 4, h = hb % 6, b = hb / 6;
        const int R = NLAT + b * CTX + qt * 16 + fr;
        const bf16_t* qp = P + (size_t)R * PWS + COL_NAQ + h * 64 + g * 8;
        const bf16x8 q0 = ld16(qp), q1 = ld16(qp + 32);
        AttnState st; attn_init(st);
        const bf16_t* kc_ = (const bf16_t*)(p.ws + OFF_NAKFC) + (size_t)(b * 6 + h) * 16 * KVT + lane * 8;
        const bf16_t* vc_ = (const bf16_t*)(p.ws + OFF_NAVFC) + (size_t)(b * 6 + h) * 16 * KVT + lane * 8;
#pragma unroll
        for (int pp = 0; pp < 8; ++pp) { kv_load(kc_ + (size_t)(2 * pp) * KVT, kc_ + (size_t)(2 * pp + 1) * KVT, vc_ + (size_t)(2 * pp) * KVT, vc_ + (size_t)(2 * pp + 1) * KVT, f); attn_apply<false>(f, q0, q1, z4, z4, st); }
        attn_store(st, X1 + (size_t)R * D + 256 + h * 64 + g * 4, -INFINITY);
    }
}
DEV void ph_attn(const Params& p, int l, float* rpb2  ) {
    for (int i = tid_(); i < 6 * 15 * 31; i += 256) rpb2[i] = p.na_rpb[(size_t)l * 6 * 15 * 31 + i] * LOG2E;
    __syncthreads();
    const int w = tid_() >> 6;
    const int ntask = NTASK_NA + NTASK_GQ + (l == 0 ? NTASK_CNA + NTASK_CGQ : 0);
    for (int tk0 = bid_() * 4 + w; tk0 < ntask; tk0 += gridDim.x * 4) {
        const int tk = tk0 < NTASK_GQ ? NTASK_NA + tk0 : (tk0 < NTASK_GQ + NTASK_NA ? tk0 - NTASK_GQ : tk0);
        attn_task(p, l, tk, rpb2);
    }
}

template <int CTRL> DEV float dppf(float old, float v) { return __builtin_bit_cast(float, __builtin_amdgcn_update_dpp(__builtin_bit_cast(int, old), __builtin_bit_cast(int, v), CTRL, 0xf, 0xf, false)); }
template <bool FWD> DEV void row_scan(float& a, float& b) {
#define RG_STEP(SHR, SHL) { const float ap = FWD ? dppf<SHR>(1.f, a) : dppf<SHL>(1.f, a); const float bp = FWD ? dppf<SHR>(0.f, b) : dppf<SHL>(0.f, b); b = fmaf(a, bp, b); a = a * ap; }
    RG_STEP(0x111, 0x101) RG_STEP(0x112, 0x102) RG_STEP(0x114, 0x104) RG_STEP(0x118, 0x108)
#undef RG_STEP
}
DEV int rg_bwd_chunk(int pos) { return pos == 0 ? 1 : (pos == 1 ? 0 : 67 - pos); }
DEV void rg_coef(const f32x4& za, const f32x4& zi, const f32x4& ba, const f32x4& bi, const f32x4& spc, const f32x4& xv, f32x4& a, f32x4& b) {
#pragma unroll
    for (int j = 0; j < 4; ++j) {
        const float r = __builtin_amdgcn_rcpf(1.f + __expf(-(za[j] + ba[j])));
        const float ig = __builtin_amdgcn_rcpf(1.f + __expf(-(zi[j] + bi[j])));
        const float la = spc[j] * r;
        const float av = __expf(la);
        const float x2 = 2.f * la;
        float om = x2 * (1.f / 720.f) + (1.f / 120.f); om = om * x2 + (1.f / 24.f); om = om * x2 + (1.f / 6.f); om = om * x2 + 0.5f; om = om * x2 + 1.f; om = -x2 * om;
        if (x2 < -0.25f) om = 1.f - av * av;
        a[j] = av; b[j] = __builtin_amdgcn_sqrtf(om) * (ig * xv[j]);
    }
}
DEV void rg_item(const Params& p, int l, int rt, bf16_t* lds) {
    const int t = tid_(), lane = t & 63, n = t >> 6, g = lane >> 4, fr = lane & 15;
    const bf16_t* P = (const bf16_t*)(p.ws + OFF_P);
    const bool isctx = rt >= 512;
    const int b = isctx ? (rt - 512) >> 1 : rt >> 6, idx = isctx ? (rt - 512) & 1 : 2 + (rt & 63);
    const int L = isctx ? CTX : S, t0 = isctx ? idx * 128 : (idx - 2) * 128, seqbase = isctx ? NLAT + b * CTX : b * S;
    bf16_t* xl = lds + n * (128 * 64);
    {
        const int c = lane & 7, ch0 = n * 64 + c * 8;
        f32x4 cwa[4], cwb[4];
#pragma unroll
        for (int j = 0; j < 4; ++j) { cwa[j] = *(const f32x4*)(p.conv_w + (l * 4 + j) * 256 + ch0); cwb[j] = *(const f32x4*)(p.conv_w + (l * 4 + j) * 256 + ch0 + 4); }
        const f32x4 cba = *(const f32x4*)(p.conv_b + l * 256 + ch0), cbb = *(const f32x4*)(p.conv_b + l * 256 + ch0 + 4);
#pragma unroll 2
        for (int it = 0; it < 16; ++it) {
            const int tok = it * 8 + (lane >> 3), ts = t0 + tok;
            f32x4 acca = cba, accb = cbb;
#pragma unroll
            for (int j = 0; j < 4; ++j) {
                const int tj = ts + j - 2;
                if (tj >= 0 && tj < L) {
                    const uint4 v = *(const uint4*)(P + (size_t)(seqbase + tj) * PWS + COL_RGX + ch0);
                    const f32x4 xa = {__uint_as_float(v.x << 16), __uint_as_float(v.x & 0xffff0000u), __uint_as_float(v.y << 16), __uint_as_float(v.y & 0xffff0000u)};
                    const f32x4 xb = {__uint_as_float(v.z << 16), __uint_as_float(v.z & 0xffff0000u), __uint_as_float(v.w << 16), __uint_as_float(v.w & 0xffff0000u)};
                    acca = acca + cwa[j] * xa; accb = accb + cwb[j] * xb;
                }
            }
            uint4 o; o.x = pk2(acca[0], acca[1]); o.y = pk2(acca[2], acca[3]); o.z = pk2(accb[0], accb[1]); o.w = pk2(accb[2], accb[3]);
            *(uint4*)(xl + tok * 64 + ((c ^ ((tok >> 1) & 7)) * 8)) = o;
        }
    }
    asm volatile("s_waitcnt lgkmcnt(0)" ::: "memory");
    const bf16_t* W = (const bf16_t*)(p.ws + OFF_WRG) + (size_t)(l * 2) * 2 * 4 * 64 * 64;
    const float* C = (const float*)(p.ws + OFF_RGC) + (size_t)(l * 2) * 3 * 256;
    float* AGG = (float*)(p.ws + OFF_AGG) + (size_t)(b * 66) * 1024;
    const int swz = (fr >> 1) & 7;
#pragma unroll 1
    for (int ct = 0; ct < 4; ++ct) {
        const int ch = n * 64 + ct * 16 + g * 4;
        const f32x4 z4 = {0.f, 0.f, 0.f, 0.f};
#pragma unroll
        for (int dir = 0; dir < 2; ++dir) {
            const bf16x8 wa0 = ld16(W + ((size_t)((dir * 2 + 0) * 4 + n) * 64 + ct * 16 + fr) * 64 + g * 8), wa1 = ld16(W + ((size_t)((dir * 2 + 0) * 4 + n) * 64 + ct * 16 + fr) * 64 + 32 + g * 8);
            const bf16x8 wi0 = ld16(W + ((size_t)((dir * 2 + 1) * 4 + n) * 64 + ct * 16 + fr) * 64 + g * 8), wi1 = ld16(W + ((size_t)((dir * 2 + 1) * 4 + n) * 64 + ct * 16 + fr) * 64 + 32 + g * 8);
            const f32x4 ba = *(const f32x4*)(C + (dir * 3 + 0) * 256 + ch), bi = *(const f32x4*)(C + (dir * 3 + 1) * 256 + ch), spc = *(const f32x4*)(C + (dir * 3 + 2) * 256 + ch);
            f32x4 hin = z4, apre = {1.f, 1.f, 1.f, 1.f};
#pragma unroll
            for (int s = 0; s < 8; ++s) {
                const int tt = dir == 0 ? s : 7 - s;
                const int row = tt * 16 + fr;
                const bf16x8 x0 = *(const bf16x8*)(xl + row * 64 + ((g ^ swz) * 8)), x1 = *(const bf16x8*)(xl + row * 64 + (((g | 4) ^ swz) * 8));
                f32x4 za = __builtin_amdgcn_mfma_f32_16x16x32_bf16(wa0, x0, z4, 0, 0, 0); za = __builtin_amdgcn_mfma_f32_16x16x32_bf16(wa1, x1, za, 0, 0, 0);
                f32x4 zi = __builtin_amdgcn_mfma_f32_16x16x32_bf16(wi0, x0, z4, 0, 0, 0); zi = __builtin_amdgcn_mfma_f32_16x16x32_bf16(wi1, x1, zi, 0, 0, 0);
                const uint2 xr = *(const uint2*)(xl + row * 64 + (((ct * 2 + (g >> 1)) ^ swz) * 8) + (g & 1) * 4);
                const f32x4 xv = {__uint_as_float(xr.x << 16), __uint_as_float(xr.x & 0xffff0000u), __uint_as_float(xr.y << 16), __uint_as_float(xr.y & 0xffff0000u)};
                f32x4 a, bb;
                rg_coef(za, zi, ba, bi, spc, xv, a, bb);
                f32x4 h, ac;
#pragma unroll
                for (int j = 0; j < 4; ++j) {
                    float aj = a[j], bj = bb[j];
                    if (dir == 0) row_scan<true>(aj, bj); else row_scan<false>(aj, bj);
                    h[j] = fmaf(aj, hin[j], bj);
                    ac[j] = aj * apre[j];
                }
                {
                    bf16_t* xo = (bf16_t*)(p.ws + OFF_X2) + ((size_t)seqbase + t0 + row) * D + dir * 512 + ch;
                    uint2 o; o.x = pk2(ac[0], ac[1]); o.y = pk2(ac[2], ac[3]); *(uint2*)xo = o;
                    o.x = pk2(h[0], h[1]); o.y = pk2(h[2], h[3]); *(uint2*)(xo + 256) = o;
                }
                const int src = (lane & 48) | (dir == 0 ? 15 : 0);
#pragma unroll
                for (int j = 0; j < 4; ++j) { hin[j] = shl_(h[j], src); apre[j] = shl_(ac[j], src); }
            }
            if (fr == 0) { *(f32x4*)(AGG + (size_t)(idx * 2 + dir) * 512 + ch) = apre; *(f32x4*)(AGG + (size_t)(idx * 2 + dir) * 512 + 256 + ch) = hin; }
        }
    }
}
DEV void rg_final(const Params& p, int l, int rt, float* part  ) {
    const int t = tid_(), cg4 = (t & 63) * 4, tp = t >> 6;
    const bool isctx = rt >= 512;
    const int b = isctx ? (rt - 512) >> 1 : rt >> 6, idx = isctx ? (rt - 512) & 1 : 2 + (rt & 63);
    const float* AGG = (const float*)(p.ws + OFF_AGG) + (size_t)(b * 66) * 1024;
    f32x4 hf = {0.f, 0.f, 0.f, 0.f}, hb = {0.f, 0.f, 0.f, 0.f};
    {
        const int nf = idx, nb = idx == 1 ? 0 : (idx == 0 ? 1 : 67 - idx);
        const int qf = (nf + 3) >> 2, qb = (nb + 3) >> 2;
        f32x4 Af = {1.f, 1.f, 1.f, 1.f}, Bf = {0.f, 0.f, 0.f, 0.f}, Ab = Af, Bb = Bf;
#pragma unroll 4
        for (int q = tp * qf; q < min((tp + 1) * qf, nf); ++q) { const f32x4 A = *(const f32x4*)(AGG + (size_t)(q * 2) * 512 + cg4), B = *(const f32x4*)(AGG + (size_t)(q * 2) * 512 + 256 + cg4); Bf = A * Bf + B; Af = A * Af; }
#pragma unroll 4
        for (int q = tp * qb; q < min((tp + 1) * qb, nb); ++q) { const int cq = rg_bwd_chunk(q); const f32x4 A = *(const f32x4*)(AGG + (size_t)(cq * 2 + 1) * 512 + cg4), B = *(const f32x4*)(AGG + (size_t)(cq * 2 + 1) * 512 + 256 + cg4); Bb = A * Bb + B; Ab = A * Ab; }
        *(f32x4*)(part + ((tp * 2 + 0) * 2 + 0) * 256 + cg4) = Af; *(f32x4*)(part + ((tp * 2 + 0) * 2 + 1) * 256 + cg4) = Bf;
        *(f32x4*)(part + ((tp * 2 + 1) * 2 + 0) * 256 + cg4) = Ab; *(f32x4*)(part + ((tp * 2 + 1) * 2 + 1) * 256 + cg4) = Bb;
        __syncthreads();
#pragma unroll
        for (int k = 0; k < 4; ++k) {
            hf = *(const f32x4*)(part + ((k * 2 + 0) * 2 + 0) * 256 + cg4) * hf + *(const f32x4*)(part + ((k * 2 + 0) * 2 + 1) * 256 + cg4);
            hb = *(const f32x4*)(part + ((k * 2 + 1) * 2 + 0) * 256 + cg4) * hb + *(const f32x4*)(part + ((k * 2 + 1) * 2 + 1) * 256 + cg4);
        }
    }
    const bf16_t* X2 = (const bf16_t*)(p.ws + OFF_X2); const bf16_t* P = (const bf16_t*)(p.ws + OFF_P); bf16_t* X1 = (bf16_t*)(p.ws + OFF_X1);
#pragma unroll 4
    for (int i = 0; i < 32; ++i) {
        const size_t R = (size_t)rt * 128 + i * 4 + tp;
        const uint2 af = *(const uint2*)(X2 + R * D + cg4), bf = *(const uint2*)(X2 + R * D + 256 + cg4), ab = *(const uint2*)(X2 + R * D + 512 + cg4), bb = *(const uint2*)(X2 + R * D + 768 + cg4);
        const uint2 gr = *(const uint2*)(P + R * PWS + COL_GATE + cg4);
#define BLO(u) __uint_as_float((u) << 16)
#define BHI(u) __uint_as_float((u) & 0xffff0000u)
        const float h0 = (BLO(af.x) * hf[0] + BLO(bf.x)) + (BLO(ab.x) * hb[0] + BLO(bb.x));
        const float h1 = (BHI(af.x) * hf[1] + BHI(bf.x)) + (BHI(ab.x) * hb[1] + BHI(bb.x));
        const float h2 = (BLO(af.y) * hf[2] + BLO(bf.y)) + (BLO(ab.y) * hb[2] + BLO(bb.y));
        const float h3 = (BHI(af.y) * hf[3] + BHI(bf.y)) + (BHI(ab.y) * hb[3] + BHI(bb.y));
        uint2 o; o.x = pk2(h0 * gelu_tanh(BLO(gr.x)), h1 * gelu_tanh(BHI(gr.x))); o.y = pk2(h2 * gelu_tanh(BLO(gr.y)), h3 * gelu_tanh(BHI(gr.y)));
#undef BLO
#undef BHI
        *(uint2*)(X1 + R * D + cg4) = o;
    }
}
DEV void ph_rgagg(const Params& p, int l, bf16_t* lds) {
    for (int rt = bid_(); rt < 528; rt += gridDim.x) { rg_item(p, l, rt, lds); __syncthreads(); }
}

DEV void outproj_item(const Params& p_, int l, int rt, bf16_t* lds, float* stat  ) {
    const Params& p = kp_();
    const int t = tid_(), lane = t & 63, w = t >> 6, wm = w >> 1, wn = w & 1, fq = lane >> 4, fr = lane & 15;
    const bf16_t* A = (const bf16_t*)(p.ws + OFF_X1) + (size_t)(rt * 128) * D;
    const bool isctx = rt >= 512;
    const float* g1 = modvec(p, l, rt * 128, 2);
    __syncthreads();
    rg_final(p, l, rt, (float*)lds);
    asm volatile("s_waitcnt vmcnt(0)" ::: "memory");
    __syncthreads();
    __builtin_amdgcn_fence(__ATOMIC_ACQUIRE, "agent");
#pragma unroll 1
    for (int pass = 0; pass < 4; ++pass) {
        const bf16_t* Bt = (const bf16_t*)(p.ws + OFF_WOUTT) + ((size_t)l * 1024 + pass * 256) * 1024;
        const unsigned toff = (unsigned)(((tid_() >> 2) * 1024 + gemm_src_chunk(tid_())) * 2);
        f32x4 acc[4][8]; zero_acc(acc);
        gemm_mainloop(A, toff, toff + 64 * D * 2, Bt, toff, 1024, 32, lds, acc);
#pragma unroll
        for (int mt = 0; mt < 4; ++mt) {
            const int rl = wm * 64 + mt * 16 + fr, R = rt * 128 + rl;
            const float* xin = (l == 0) ? (isctx ? p.ctx + (size_t)(R - NLAT) * D : p.x + (size_t)R * D) : xres_row(p, R);
            float* xo = xres_row(p, R);
            float s = 0.f, q = 0.f;
#pragma unroll
            for (int nt = 0; nt < 8; ++nt) {
                const int col = pass * 256 + wn * 128 + nt * 16 + fq * 4;
                const f32x4 xv = *(const f32x4*)(xin + col), gv = *(const f32x4*)(g1 + col);
                const f32x4 u = xv * ALPHA + gv * acc[mt][nt];
                *(f32x4*)(xo + col) = u;
                s += (u[0] + u[1]) + (u[2] + u[3]); q += (u[0] * u[0] + u[1] * u[1]) + (u[2] * u[2] + u[3] * u[3]);
            }
            s += shx(s, 16); s += shx(s, 32); q += shx(q, 16); q += shx(q, 32);
            if (fq == 0) { float* sp = stat + (wn * 128 + rl) * 2; if (pass == 0) { sp[0] = s; sp[1] = q; } else { sp[0] += s; sp[1] += q; } }
        }
    }
    asm volatile("s_waitcnt vmcnt(0)" ::: "memory");
    __syncthreads();
    __builtin_amdgcn_fence(__ATOMIC_ACQUIRE, "agent");
    {
        bf16_t* X2 = (bf16_t*)(p.ws + OFF_X2);
        const bf16_t* WRh = (const bf16_t*)(p.ws + OFF_WR) + (size_t)(l * 2) * 48 * 1024 + (size_t)fr * 1024 + fq * 8;
        const bf16_t* WRl = WRh + 48 * 1024;
        float* vec = (float*)((unsigned char*)lds + 24576);
        {
            const float* lg = p.ln1_g + l * D; const float* lb = p.ln1_b + l * D;
            const float* sh2 = modvec(p, l, rt * 128, 3); const float* sc2 = modvec(p, l, rt * 128, 4);
            const int k4 = t * 4;
            *(f32x4*)(vec + k4) = *(const f32x4*)(lg + k4); *(f32x4*)(vec + 1024 + k4) = *(const f32x4*)(lb + k4);
            *(f32x4*)(vec + 2048 + k4) = *(const f32x4*)(sc2 + k4) + 1.f; *(f32x4*)(vec + 3072 + k4) = *(const f32x4*)(sh2 + k4);
        }
        float mean[2], rstd[2];
#pragma unroll
        for (int tm = 0; tm < 2; ++tm) {
            const int rl = w * 32 + tm * 16 + fr;
            float s = 0.f, q = 0.f;
#pragma unroll
            for (int i = 0; i < 2; ++i) { s += stat[(i * 128 + rl) * 2]; q += stat[(i * 128 + rl) * 2 + 1]; }
            mean[tm] = s * (1.f / D);
            rstd[tm] = rsqrtf(fmaxf(q * (1.f / D) - mean[tm] * mean[tm], 0.f) + LN_EPS);
        }
        __syncthreads();
        float* xr0 = xres_row(p, rt * 128 + w * 32 + fr) + fq * 8;
        float* xr1 = xres_row(p, rt * 128 + w * 32 + 16 + fr) + fq * 8;
        bf16_t* h20 = X2 + (size_t)(rt * 128 + w * 32 + fr) * D + fq * 8; bf16_t* h21 = h20 + (size_t)16 * D;
        f32x4 lacc[3][2];
#pragma unroll
        for (int a = 0; a < 3; ++a) { lacc[a][0] = (f32x4){0.f, 0.f, 0.f, 0.f}; lacc[a][1] = (f32x4){0.f, 0.f, 0.f, 0.f}; }
        f32x4 nu00 = *(const f32x4*)xr0, nu01 = *(const f32x4*)(xr0 + 4), nu10 = *(const f32x4*)xr1, nu11 = *(const f32x4*)(xr1 + 4);
        bf16x8 nwh0 = *(const bf16x8*)(WRh), nwh1 = *(const bf16x8*)(WRh + 16 * 1024), nwh2 = *(const bf16x8*)(WRh + 32 * 1024);
        bf16x8 nwl0 = *(const bf16x8*)(WRl), nwl1 = *(const bf16x8*)(WRl + 16 * 1024), nwl2 = *(const bf16x8*)(WRl + 32 * 1024);
#pragma unroll 2
        for (int ks = 0; ks < 32; ++ks) {
            const f32x4 u00 = nu00, u01 = nu01, u10 = nu10, u11 = nu11;
            const bf16x8 wh0 = nwh0, wh1 = nwh1, wh2 = nwh2, wl0 = nwl0, wl1 = nwl1, wl2 = nwl2;
            if (ks + 1 < 32) {
                const int ko = (ks + 1) * 32;
                nu00 = *(const f32x4*)(xr0 + ko); nu01 = *(const f32x4*)(xr0 + ko + 4); nu10 = *(const f32x4*)(xr1 + ko); nu11 = *(const f32x4*)(xr1 + ko + 4);
                nwh0 = *(const bf16x8*)(WRh + ko); nwh1 = *(const bf16x8*)(WRh + 16 * 1024 + ko); nwh2 = *(const bf16x8*)(WRh + 32 * 1024 + ko);
                nwl0 = *(const bf16x8*)(WRl + ko); nwl1 = *(const bf16x8*)(WRl + 16 * 1024 + ko); nwl2 = *(const bf16x8*)(WRl + 32 * 1024 + ko);
            }
            const int k = ks * 32 + fq * 8;
            const f32x4 g0 = *(const f32x4*)(vec + k), g1v = *(const f32x4*)(vec + k + 4), b0 = *(const f32x4*)(vec + 1024 + k), b1 = *(const f32x4*)(vec + 1024 + k + 4);
            const f32x4 c0 = *(const f32x4*)(vec + 2048 + k), c1 = *(const f32x4*)(vec + 2048 + k + 4), s0 = *(const f32x4*)(vec + 3072 + k), s1 = *(const f32x4*)(vec + 3072 + k + 4);
            bf16x8 hh0, hl0, hh1, hl1;
            {
                const f32x4 x0 = (u00 - mean[0]) * rstd[0] * g0 + b0, x1 = (u01 - mean[0]) * rstd[0] * g1v + b1;
                *(f32x4*)(xr0 + ks * 32) = x0; *(f32x4*)(xr0 + ks * 32 + 4) = x1;
                const f32x4 h0 = x0 * c0 + s0, h1 = x1 * c1 + s1;
#pragma unroll
                for (int e = 0; e < 4; ++e) { const bf16_t a = f2bf(h0[e]), b = f2bf(h1[e]); hh0[e] = (short)a; hh0[4 + e] = (short)b; hl0[e] = (short)f2bf(h0[e] - bf2f(a)); hl0[4 + e] = (short)f2bf(h1[e] - bf2f(b)); }
                *(bf16x8*)(h20 + ks * 32) = hh0;
            }
            {
                const f32x4 x0 = (u10 - mean[1]) * rstd[1] * g0 + b0, x1 = (u11 - mean[1]) * rstd[1] * g1v + b1;
                *(f32x4*)(xr1 + ks * 32) = x0; *(f32x4*)(xr1 + ks * 32 + 4) = x1;
                const f32x4 h0 = x0 * c0 + s0, h1 = x1 * c1 + s1;
#pragma unroll
                for (int e = 0; e < 4; ++e) { const bf16_t a = f2bf(h0[e]), b = f2bf(h1[e]); hh1[e] = (short)a; hh1[4 + e] = (short)b; hl1[e] = (short)f2bf(h0[e] - bf2f(a)); hl1[4 + e] = (short)f2bf(h1[e] - bf2f(b)); }
                *(bf16x8*)(h21 + ks * 32) = hh1;
            }
#define RT_MMA(ft, WH, WL) do { \
            lacc[ft][0] = __builtin_amdgcn_mfma_f32_16x16x32_bf16(WH, hh0, lacc[ft][0], 0, 0, 0); lacc[ft][0] = __builtin_amdgcn_mfma_f32_16x16x32_bf16(WL, hh0, lacc[ft][0], 0, 0, 0); lacc[ft][0] = __builtin_amdgcn_mfma_f32_16x16x32_bf16(WH, hl0, lacc[ft][0], 0, 0, 0); \
            lacc[ft][1] = __builtin_amdgcn_mfma_f32_16x16x32_bf16(WH, hh1, lacc[ft][1], 0, 0, 0); lacc[ft][1] = __builtin_amdgcn_mfma_f32_16x16x32_bf16(WL, hh1, lacc[ft][1], 0, 0, 0); lacc[ft][1] = __builtin_amdgcn_mfma_f32_16x16x32_bf16(WH, hl1, lacc[ft][1], 0, 0, 0); } while (0)
            RT_MMA(0, wh0, wl0); RT_MMA(1, wh1, wl1); RT_MMA(2, wh2, wl2);
#undef RT_MMA
        }
        __syncthreads();
        float* lt = (float*)lds;
        int* lcnt = (int*)((unsigned char*)lds + 24576); int* lbase = lcnt + 32;
        if (t < 32) lcnt[t] = 0;
#pragma unroll
        for (int ft = 0; ft < 3; ++ft)
#pragma unroll
            for (int tm = 0; tm < 2; ++tm)
#pragma unroll
                for (int j = 0; j < 4; ++j) lt[(w * 32 + tm * 16 + fr) * 48 + ft * 16 + fq * 4 + j] = lacc[ft][tm][j];
        __syncthreads();
        int E0 = 0, E1 = 0, r0 = 0, r1 = 0; float w0 = 0.f, w1 = 0.f;
        const int rl = w * 32 + (lane & 31), R = rt * 128 + rl;
        if (lane < 32) {
            const float* lr = lt + rl * 48;
            int gi = 0; float gm = lr[0] + p.router_g_b[l * 4];
            float gl[4]; gl[0] = gm;
#pragma unroll
            for (int j = 1; j < 4; ++j) { gl[j] = lr[j] + p.router_g_b[l * 4 + j]; if (gl[j] > gm) { gm = gl[j]; gi = j; } }
            float gs = 0.f;
#pragma unroll
            for (int j = 0; j < 4; ++j) gs += expf(gl[j] - gm);
            const float ptop = 1.f / gs;
            int e0 = 0, e1 = 0; float m0 = -INFINITY, m1 = -INFINITY;
            for (int j = 0; j < 8; ++j) {
                const float v = lr[4 + gi * 8 + j] + p.router_e_b[l * 32 + gi * 8 + j];
                if (v > m0) { m1 = m0; e1 = e0; m0 = v; e0 = j; } else if (v > m1) { m1 = v; e1 = j; }
            }
            const float ex = expf(m1 - m0);
            w0 = ptop / (1.f + ex); w1 = ptop * ex / (1.f + ex);
            E0 = gi * 8 + e0; E1 = gi * 8 + e1;
            r0 = atomicAdd(lcnt + E0, 1); r1 = atomicAdd(lcnt + E1, 1);
        }
        __syncthreads();
        if (t < 32) { const int c = lcnt[t]; lbase[t] = c ? (int)atomicAdd((unsigned*)(p.ws + OFF_CTL) + CW_CNT + l * 32 + t, (unsigned)c) : 0; }
        __syncthreads();
        if (lane < 32) {
            int* rte = (int*)(p.ws + OFF_RTE); float* rtw = (float*)(p.ws + OFF_RTW);
            int* list = (int*)(p.ws + OFF_LIST);
            rte[R * 2] = E0; rte[R * 2 + 1] = E1; rtw[R * 2] = w0; rtw[R * 2 + 1] = w1;
            list[(size_t)E0 * LISTCAP + lbase[E0] + r0] = R * 2;
            list[(size_t)E1 * LISTCAP + lbase[E1] + r1] = R * 2 + 1;
        }
    }
}
DEV void ph_outproj(const Params& p, int l, bf16_t* lds, float* stat  ) {
    for (int rt = bid_(); rt < 512; rt += gridDim.x) { outproj_item(p, l, rt, lds, stat); __syncthreads(); }
}

DEV void moe1_item(const Params& p_, int l, int e, int jb, int pass, int item, int cnt, bf16_t* lds) {
    const Params& p = kp_();
    const int t = tid_(), lane = t & 63, w = t >> 6, wm = w >> 1, wn = w & 1, fq = lane >> 4, fr = lane & 15;
    const int* list = (const int*)(p.ws + OFF_LIST) + (size_t)e * LISTCAP;
    const bf16_t* X2 = (const bf16_t*)(p.ws + OFF_X2);
    bf16_t* Hs = (bf16_t*)(p.ws + OFF_P) + (size_t)item * 128 * FF;
    unsigned ao0, ao1;
    { const int s0 = jb * 128 + (t >> 2), s1 = s0 + 64;
      const int tok0 = s0 < cnt ? (list[s0] >> 1) : 0, tok1 = s1 < cnt ? (list[s1] >> 1) : 0;
      ao0 = (unsigned)((tok0 * D + gemm_src_chunk(t)) * 2); ao1 = (unsigned)((tok1 * D + gemm_src_chunk(t)) * 2); }
    const bf16_t* Bt = (const bf16_t*)(p.ws + OFF_WGU) + ((size_t)e * 1024 + pass * 256) * 1024;
    f32x4 acc[4][8]; zero_acc(acc);
    gemm_mainloop(X2, ao0, ao1, Bt, (unsigned)(((t >> 2) * 1024 + gemm_src_chunk(t)) * 2), 1024, 32, lds, acc);
#pragma unroll
    for (int mt = 0; mt < 4; ++mt) {
        const int rl = wm * 64 + mt * 16 + fr;
#pragma unroll
        for (int nt = 0; nt < 4; ++nt) {
            const f32x4 gv = acc[mt][nt], uv = acc[mt][nt + 4];
            float hv[4];
#pragma unroll
            for (int jj = 0; jj < 4; ++jj) hv[jj] = gv[jj] * __builtin_amdgcn_rcpf(1.f + __expf(-gv[jj])) * uv[jj];
            uint2 o; o.x = pk2(hv[0], hv[1]); o.y = pk2(hv[2], hv[3]);
            *(uint2*)(Hs + (size_t)rl * FF + pass * 128 + wn * 64 + nt * 16 + fq * 4) = o;
        }
    }
}
DEV void moe2_item(const Params& p_, int l, int e, int jb, int pass, int item, int cnt, bf16_t* lds) {
    const Params& p = kp_();
    const int t = tid_(), lane = t & 63, w = t >> 6, wm = w >> 1, wn = w & 1, fq = lane >> 4, fr = lane & 15;
    const int* list = (const int*)(p.ws + OFF_LIST) + (size_t)e * LISTCAP;
    const bf16_t* Hs = (const bf16_t*)(p.ws + OFF_P) + (size_t)item * 128 * FF;
    const unsigned hoff = (unsigned)(((t >> 2) * FF + gemm_src_chunk(t)) * 2);
    const float* rtw = (const float*)(p.ws + OFF_RTW);
    bf16_t* Y = (bf16_t*)(p.ws + OFF_Y);
    const bf16_t* Bt = (const bf16_t*)(p.ws + OFF_WD) + ((size_t)e * 1024 + pass * 256) * FF;
    f32x4 acc[4][8]; zero_acc(acc);
    gemm_mainloop(Hs, hoff, hoff + 64 * FF * 2, Bt, hoff, FF, 16, lds, acc);
#pragma unroll
    for (int mt = 0; mt < 4; ++mt) {
        const int s = jb * 128 + wm * 64 + mt * 16 + fr;
        if (s < cnt) {
            const int ent = list[s];
            const float gw = rtw[ent];
            bf16_t* yo = Y + (size_t)ent * D + pass * 256 + wn * 128 + fq * 4;
#pragma unroll
            for (int nt = 0; nt < 8; ++nt) { const f32x4 v = acc[mt][nt] * gw; uint2 o; o.x = pk2(v[0], v[1]); o.y = pk2(v[2], v[3]); *(uint2*)(yo + nt * 16) = o; }
        }
    }
}
template <int STAGE> DEV void ph_moe(const Params& p, int l, bf16_t* lds, int* s_pref  , int* s_cnt  , int* slot, int ph) {
    const unsigned* cnt = (const unsigned*)(p.ws + OFF_CTL) + CW_CNT + l * 32;
    if (tid_() == 0) { int a = 0; for (int e = 0; e < 32; ++e) { const int c = (int)cnt[e]; s_cnt[e] = c; s_pref[e] = a; a += (c + 127) >> 7; } s_pref[32] = a; }
    __syncthreads();
#pragma unroll 1
    for (int hop = 0; hop < 8; ++hop) {
        const int xq = (bid_() + hop) & 7;
        unsigned* ctr = (unsigned*)(p.ws + OFF_CTL) + CW_Q + ph * 8 + xq;
        const int n0 = (s_cnt[xq] + 127) >> 7, n1 = (s_cnt[xq + 8] + 127) >> 7, n2 = (s_cnt[xq + 16] + 127) >> 7, n3 = (s_cnt[xq + 24] + 127) >> 7;
        const int nloc = (n0 + n1 + n2 + n3) * 4;
        int it = q_pull(ctr, slot);
        while (it < nloc) {
            int nreg = 0;
            if (tid_() == 0) nreg = (int)atomicAdd(ctr, 1u);
            const int pass = it & 3, ib = it >> 2;
            int e, jb;
            if (ib < n0) { e = xq; jb = ib; } else if (ib < n0 + n1) { e = xq + 8; jb = ib - n0; } else if (ib < n0 + n1 + n2) { e = xq + 16; jb = ib - n0 - n1; } else { e = xq + 24; jb = ib - n0 - n1 - n2; }
            if (STAGE == 1) moe1_item(p, l, e, jb, pass, s_pref[e] + jb, s_cnt[e], lds); else moe2_item(p, l, e, jb, pass, s_pref[e] + jb, s_cnt[e], lds);
            it = q_publish(nreg, slot);
        }
    }
    __syncthreads();
}

DEV void ph_rowin(const Params& p, int l, bf16_t* lds, int* slot, int ph) {
    const int np = l == 0 ? 9 : 5, nci = 16 * np, ntot = nci + 1024;
    unsigned* ctr = (unsigned*)(p.ws + OFF_CTL) + CW_Q + ph * 8;
    const int w = tid_() >> 6;
    for (;;) {
        const int it = q_pull(ctr, slot);
        if (it >= ntot) break;
        if (it < nci) {
            const int rt = 512 + it / np, pass = it % np;
            for (int r = w * 2; r < 128; r += 8) { if (l == 0) rowop<0, true>(p, 0, rt * 128 + r); else rowop<1, false>(p, 1, rt * 128 + r); }
            asm volatile("s_waitcnt vmcnt(0)" ::: "memory");
            __syncthreads();
            __builtin_amdgcn_fence(__ATOMIC_ACQUIRE, "agent");
            inproj_item(p, l, rt, pass, lds);
        } else {
            const int r0 = (it - nci) * 64;
            for (int r = w * 2; r < 64; r += 8) { if (l == 0) rowop<0, true>(p, 0, r0 + r); else rowop<1, true>(p, 1, r0 + r); }
        }
    }
}
DEV void ph_inproj2(const Params& p, int l, bf16_t* lds, int* slot, int ph) {
    const int xcd = bid_() & 7;
    unsigned* ctr = (unsigned*)(p.ws + OFF_CTL) + CW_Q + ph * 8 + xcd;
    const int ntot = 2 + 768 + (l == 0 ? 32 : 0);
    int it = q_pull(ctr, slot);
    while (it < ntot) {
        int nreg = 0;
        if (tid_() == 0) nreg = (int)atomicAdd(ctr, 1u);
        if (it < 2) { rg_item(p, l, 512 + 2 * xcd + it, lds); }
        else if (it < 770) {
            const int q = it - 2, m = q >> 2, r = q & 3;
            if (r < 3) { const int i = m * 3 + r; inproj_item(p, l, xcd * 64 + i / 9, i % 9, lds); }
            else { __syncthreads(); expert_conv_item(p, l, xcd * 192 + m, (float*)lds); }
        }
        else { const int i = it - 770, w = tid_() >> 6;
            const int tk = i < 24 ? NTASK_NA + NTASK_GQ + (xcd * 24 + i) * 4 + w : NTASK_NA + NTASK_GQ + NTASK_CNA + (xcd * 8 + (i - 24)) * 4 + w;
            attn_task(p, l, tk, (const float*)lds); }
        it = q_publish(nreg, slot);
    }
}
DEV void ph_mixer(const Params& p, int l, bf16_t* lds, float* stat, int* slot, int ph) {
    const int xcd = bid_() & 7;
    unsigned* ctr = (unsigned*)(p.ws + OFF_CTL) + CW_Q + ph * 8 + xcd;
    const int n0 = l == 0 ? 2 : 0, n1 = n0 + 64, n2 = n1 + 256, n3 = n2 + 768, ntot = n3;
    bool rpb_ok = false;
    float* rpb2 = (float*)lds;
    int it = q_pull(ctr, slot);
    while (it < ntot) {
        int nreg = 0;
        if (tid_() == 0) nreg = (int)atomicAdd(ctr, 1u);
        if (it < n0) { outproj_item(p, l, 512 + 2 * xcd + it, lds, stat); rpb_ok = false; }
        else if (it < n1) { rg_item(p, l, xcd * 64 + (it - n0), lds); rpb_ok = false; }
        else if (it < n3) {
            if (!rpb_ok) { for (int i = tid_(); i < 6 * 15 * 31; i += 256) rpb2[i] = p.na_rpb[(size_t)l * 6 * 15 * 31 + i] * LOG2E; __syncthreads(); rpb_ok = true; }
            const int w = tid_() >> 6;
            int tk;
            if (it < n2) { const int i = it - n1; tk = NTASK_NA + (2 * xcd + (i >> 7)) * 512 + (i & 127) * 4 + w; }
            else { const int i = it - n2; tk = (6 * xcd + (i >> 7)) * 512 + (i & 127) * 4 + w; }
            attn_task(p, l, tk, rpb2);
        }
        it = q_publish(nreg, slot);
    }
}

#define XB_TMO      128
#define XB_XCNT(j)  (256  + 64 * (j))
#define XB_XSUB(j)  (1280 + 64 * (j))
#define XB_XGEN(j)  (2304 + 64 * (j))
#define XB_TOP      3328
#define XB_TOPGEN   3392
#define XCD_BAR_WORDS 3456
#define XB_SPIN_CAP (1u << 20)
DEV unsigned xb_ld(unsigned* p) { return __hip_atomic_load(p, __ATOMIC_RELAXED, __HIP_MEMORY_SCOPE_AGENT); }
DEV unsigned xb_add(unsigned* p, unsigned v) { return __hip_atomic_fetch_add(p, v, __ATOMIC_RELAXED, __HIP_MEMORY_SCOPE_AGENT); }
DEV unsigned xb_xcc_id() { return (unsigned)__builtin_amdgcn_s_getreg((3 << 11) | 20) & 0xFu; }
#define XB_SPIN(cond, bar) do { unsigned _sp = 0; while (cond) { __builtin_amdgcn_s_sleep(1); \
    if ((++_sp & 255u) == 0u) { if (xb_ld(&(bar)[XB_TMO])) break; if (_sp > XB_SPIN_CAP) { atomicAdd(&(bar)[XB_TMO], 1u); break; } } } } while (0)
struct XcdBarrier { unsigned* bar; unsigned x; volatile LAS unsigned* st; };
DEV XcdBarrier xcd_barrier_post(unsigned* bar, volatile LAS unsigned* st) {
    XcdBarrier b; b.bar = bar; b.x = xb_xcc_id(); b.st = st;
    if (tid_() == 0) (void)xb_add(&bar[XB_XCNT(b.x)], 1u);
    return b;
}
DEV void xcd_barrier_complete(unsigned* bar, unsigned x, unsigned& nloc, unsigned& nx) {
    const unsigned G = gridDim.x * gridDim.y * gridDim.z;
    unsigned sum, cnt, mine, sp = 0u;
    for (;;) {
        sum = 0u; cnt = 0u; mine = 0u;
#pragma unroll
        for (unsigned j = 0; j < 16; ++j) { const unsigned c = xb_ld(&bar[XB_XCNT(j)]); sum += c; cnt += (c > 0u) ? 1u : 0u; mine = (j == x) ? c : mine; }
        if (sum == G) break;
        __builtin_amdgcn_s_sleep(1);
        if ((++sp & 255u) == 0u) { if (xb_ld(&bar[XB_TMO])) break; if (sp > XB_SPIN_CAP) { atomicAdd(&bar[XB_TMO], 1u); break; } }
    }
    nloc = mine > 0u ? mine : 1u; nx = cnt > 0u ? cnt : 1u;
}
DEV void xcd_barrier(const XcdBarrier& b) {
    asm volatile("s_waitcnt vmcnt(0)" ::: "memory");
    __syncthreads();
    if (tid_() == 0) {
        unsigned* bar = b.bar;
        __builtin_amdgcn_s_waitcnt(0);
        unsigned nloc = b.st[0], nx = b.st[1];
        if (nloc == 0u) { xcd_barrier_complete(bar, b.x, nloc, nx); b.st[0] = nloc; b.st[1] = nx; }
        const unsigned old = xb_add(&bar[XB_XSUB(b.x)], 1u);
        const unsigned gen = old / nloc;
        if (old + 1u == (gen + 1u) * nloc) {
            __builtin_amdgcn_fence(__ATOMIC_RELEASE, "agent");
            asm volatile("s_waitcnt vmcnt(0)" ::: "memory");
            const unsigned og = xb_add(&bar[XB_TOP], 1u);
            const unsigned tg = og / nx;
            if (og + 1u == (tg + 1u) * nx) xb_add(&bar[XB_TOPGEN], 1u);
            else XB_SPIN(xb_ld(&bar[XB_TOPGEN]) == tg, bar);
            __builtin_amdgcn_fence(__ATOMIC_ACQUIRE, "agent");
            xb_add(&bar[XB_XGEN(b.x)], 1u);
            asm volatile("s_waitcnt vmcnt(0)" ::: "memory");
        } else {
            XB_SPIN(xb_ld(&bar[XB_XGEN(b.x)]) == gen, bar);
            __builtin_amdgcn_fence(__ATOMIC_ACQUIRE, "agent");
            asm volatile("s_waitcnt vmcnt(0)" ::: "memory");
        }
    }
    __syncthreads();
}

namespace cg = cooperative_groups;
#define REP(id) for (int rep_ = 0; rep_ < ((PROBE_ID) == (id) ? PROBE_N : 1); ++rep_)
constexpr int SMEM_STAT = GEMM_LDS_BYTES;
constexpr int SMEM_BYTES = GEMM_LDS_BYTES + 2048 + 512;
constexpr int NPHASE = 14;
__global__ void __launch_bounds__(256, 2) mega(Params p, int ph_lo, int ph_hi) {
    extern __shared__ __attribute__((aligned(16))) unsigned char smem[];
    bf16_t* lds = (bf16_t*)smem;
    float* stat = (float*)(smem + SMEM_STAT);
    int* s_pref = (int*)(smem + SMEM_STAT + 2048); int* s_cnt = s_pref + 40;
    int* qslot = (int*)(smem + SMEM_STAT + 2048 + 416);
    volatile LAS unsigned* bst = (volatile LAS unsigned*)(LAS unsigned char*)(smem + SMEM_STAT + 2048 + 400);
    if (tid_() < 2) bst[tid_()] = 0u;
    __syncthreads();
    (void)xcd_barrier_post((unsigned*)(kp_().ws + OFF_CTL + 4096), bst);
#define GRID_BAR() do { XcdBarrier xb_; xb_.bar = (unsigned*)(kp_().ws + OFF_CTL + 4096); xb_.x = xb_xcc_id(); \
        xb_.st = (volatile LAS unsigned*)(LAS unsigned char*)(smem + SMEM_STAT + 2048 + 400); xcd_barrier(xb_); } while (0)
#define IN(k) (ph_lo <= (k) && (k) < ph_hi)
#define STAMP(k) do { if ((PROBE_TS) >= 0 && bid_() == 0 && tid_() == 0) ((unsigned long long*)(kp_().ws + OFF_CTL + 2048))[k] = __builtin_amdgcn_s_memrealtime(); } while (0)
#define SEAM(k) do { if (IN(k) && IN((k) + 1)) { if ((k) == 0) cg::this_grid().sync(); else GRID_BAR(); } STAMP((k) + 1); } while (0)
    STAMP(0);
    if (IN(0)) {
        REP(0) { ph_mod(kp_(), (float*)smem); __syncthreads(); }
        ph_rope(kp_());
        ph_routerw(kp_());
        ph_rgprep(kp_());
        REP(1) ph_transpose(kp_().w_in, (bf16_t*)(kp_().ws + OFF_WINT), 1024, 2304, 0, 2, (size_t)1024 * 2304, (size_t)2304 * 1024, (float*)smem);
        ph_transpose(kp_().w_out, (bf16_t*)(kp_().ws + OFF_WOUTT), 1024, 1024, 0, 2, (size_t)1024 * 1024, (size_t)1024 * 1024, (float*)smem);
    }
    SEAM(0);
#define LAYER_BODY(l, pb) { \
        if (IN(pb + 0)) ph_rowin(kp_(), l, lds, qslot, pb + 0); \
        SEAM(pb + 0); \
        if (IN(pb + 1)) ph_inproj2(kp_(), l, lds, qslot, pb + 1); \
        SEAM(pb + 1); \
        if (IN(pb + 2)) ph_mixer(kp_(), l, lds, stat, qslot, pb + 2); \
        SEAM(pb + 2); \
        if (IN(pb + 3)) ph_outproj(kp_(), l, lds, stat); \
        SEAM(pb + 3); \
        if (IN(pb + 4)) { REP(7) { ph_moe<1>(kp_(), l, lds, s_pref, s_cnt, qslot, pb + 4); } } \
        SEAM(pb + 4); \
        if (IN(pb + 5)) { REP(8) { ph_moe<2>(kp_(), l, lds, s_pref, s_cnt, qslot, pb + 5); } } \
        SEAM(pb + 5); \
    }
    LAYER_BODY(0, 1)
    LAYER_BODY(1, 7)
#undef LAYER_BODY
    if (IN(NPHASE - 1)) ph_rowop<2>(kp_(), 2, NLAT);
    if ((PROBE_TS) >= 0 && bid_() == 0) {
        __syncthreads();
        if (tid_() == 0) {
            unsigned long long* ts = (unsigned long long*)(kp_().ws + OFF_CTL + 2048);
            const unsigned long long now = __builtin_amdgcn_s_memrealtime();
            if ((PROBE_TS) == NPHASE - 1) ts[NPHASE] = now;
            const unsigned long long dt = ts[(PROBE_TS) + 1] - ts[(PROBE_TS)];
            while (__builtin_amdgcn_s_memrealtime() - now < 4ull * dt) __builtin_amdgcn_s_sleep(8);
        }
    }
#undef IN
#undef SEAM
}

#ifndef ONE_LAUNCH
#define ONE_LAUNCH 1
#endif
extern "C" void kernel_launch(void* const* d_in, const int* in_sizes, int n_in, void* d_out, int out_size, void* d_ws, size_t ws_size, hipStream_t stream) {
    if (n_in != 28 || ws_size < WS_TOTAL || out_size != NLAT * D) { fprintf(stderr, "kernel_launch: unexpected shapes / workspace (%d inputs, ws %zu need %zu)\n", n_in, ws_size, (size_t)WS_TOTAL); return; }
    static int grid = 0;
    if (grid == 0) {
        int dev = 0, cus = 0, per_cu = 0;
        (void)hipGetDevice(&dev);
        (void)hipDeviceGetAttribute(&cus, hipDeviceAttributeMultiprocessorCount, dev);
        (void)hipFuncSetAttribute((const void*)mega, hipFuncAttributeMaxDynamicSharedMemorySize, SMEM_BYTES);
        (void)hipOccupancyMaxActiveBlocksPerMultiprocessor(&per_cu, (const void*)mega, 256, SMEM_BYTES);
        if (per_cu > 2) per_cu = 2;
        grid = cus * per_cu;
        if (grid <= 0) { fprintf(stderr, "kernel_launch: occupancy query gave %d blocks per CU on %d CUs\n", per_cu, cus); grid = -1; }
    }
    if (grid < 0) return;
    Params p{};
    const float** pp = (const float**)&p;
    for (int i = 0; i < 28; ++i) pp[i] = (const float*)d_in[i];
    p.out = (float*)d_out; p.ws = (unsigned char*)d_ws;
    (void)hipMemsetAsync((unsigned char*)d_ws + OFF_CTL, 0, CTL_BYTES, stream);
#if ONE_LAUNCH
    int lo = 0, hi = NPHASE;
    void* args[] = {(void*)&p, (void*)&lo, (void*)&hi};
    hipError_t e = hipLaunchCooperativeKernel((const void*)mega, dim3(grid), dim3(256), args, SMEM_BYTES, stream);
    if (e != hipSuccess) fprintf(stderr, "kernel_launch: cooperative launch failed: %s (grid %d)\n", hipGetErrorString(e), grid);
#else
    for (int ph = 0; ph < NPHASE; ++ph) mega<<<grid, 256, SMEM_BYTES, stream>>>(p, ph, ph + 1);
#endif
}
```

```cpp
#include <hip/hip_runtime.h>
#include <hip/hip_cooperative_groups.h>
#include <stdint.h>
#include <cstdio>

typedef unsigned short bf16_t;
typedef short bf16x8 __attribute__((ext_vector_type(8)));
typedef float f32x4 __attribute__((ext_vector_type(4)));

#define DEV __device__ __forceinline__
#define PROBE_ID -1
#define PROBE_N 4
#define PROBE_TS -1

constexpr int D = 1024, NB = 8, S = 8192, CTX = 256;
constexpr int NLAT = NB * S, NCTX = NB * CTX, NTOK = NLAT + NCTX;
constexpr int PWS = 1280;
constexpr int COL_RGX = 0, COL_GATE = 256, COL_NAQ = 512, COL_GQ = 896;
constexpr int KVT = 1024;
constexpr int NE = 32, FF = 512;
constexpr int LISTCAP = NTOK;
constexpr float ALPHA = 1.4142135623730951f;
constexpr float LN_EPS = 1e-5f;

constexpr size_t al256(size_t x) { return (x + 255) & ~(size_t)255; }
constexpr size_t OFF_CTL   = 0;
constexpr size_t CTL_BYTES = 4096 + 16384;
constexpr size_t OFF_MOD   = OFF_CTL + CTL_BYTES;
constexpr size_t OFF_ROPE  = al256(OFF_MOD + (size_t)2 * 9 * 6144 * 4);
constexpr size_t OFF_RTE   = al256(OFF_ROPE + (size_t)2 * 128 * 16 * 4);
constexpr size_t OFF_RTW   = al256(OFF_RTE + (size_t)NTOK * 8);
constexpr size_t OFF_LIST  = al256(OFF_RTW + (size_t)NTOK * 8);
constexpr size_t OFF_WR    = al256(OFF_LIST + (size_t)NE * LISTCAP * 4);
constexpr size_t OFF_WRG   = al256(OFF_WR + (size_t)2 * 2 * 48 * 1024 * 2);
constexpr size_t OFF_RGC   = al256(OFF_WRG + (size_t)2 * 2 * 2 * 4 * 64 * 64 * 2);
constexpr size_t OFF_AGG   = al256(OFF_RGC + (size_t)2 * 2 * 3 * 256 * 4);
constexpr size_t OFF_WINT  = al256(OFF_AGG + (size_t)NB * 66 * 2 * 2 * 256 * 4);
constexpr size_t OFF_WOUTT = al256(OFF_WINT + (size_t)2 * 2304 * 1024 * 2);
constexpr size_t OFF_WGU   = al256(OFF_WOUTT + (size_t)2 * 1024 * 1024 * 2);
constexpr size_t OFF_WD    = al256(OFF_WGU + (size_t)NE * 1024 * 1024 * 2);
constexpr size_t OFF_XCTX  = al256(OFF_WD + (size_t)NE * 1024 * 512 * 2);
constexpr size_t OFF_X1    = al256(OFF_XCTX + (size_t)NCTX * D * 4);
constexpr size_t OFF_X2    = al256(OFF_X1 + (size_t)NTOK * D * 2);
constexpr size_t OFF_P     = al256(OFF_X2 + (size_t)NTOK * D * 2);
constexpr size_t OFF_NAKF  = al256(OFF_P + (size_t)NTOK * PWS * 2);
constexpr size_t OFF_NAVF  = al256(OFF_NAKF + (size_t)NB * 6 * 512 * KVT * 2);
constexpr size_t OFF_GKF   = al256(OFF_NAVF + (size_t)NB * 6 * 512 * KVT * 2);
constexpr size_t OFF_GVF   = al256(OFF_GKF + (size_t)NB * 2 * 512 * KVT * 2);
constexpr size_t OFF_NAKFC = al256(OFF_GVF + (size_t)NB * 2 * 512 * KVT * 2);
constexpr size_t OFF_NAVFC = al256(OFF_NAKFC + (size_t)NB * 6 * 16 * KVT * 2);
constexpr size_t OFF_GKFC  = al256(OFF_NAVFC + (size_t)NB * 6 * 16 * KVT * 2);
constexpr size_t OFF_GVFC  = al256(OFF_GKFC + (size_t)NB * 2 * 16 * KVT * 2);
constexpr size_t OFF_Y     = al256(OFF_GVFC + (size_t)NB * 2 * 16 * KVT * 2);
constexpr size_t WS_TOTAL  = al256(OFF_Y + (size_t)2 * NTOK * D * 2);
constexpr int CW_CNT = 0;

struct Params {
    const float *x, *c, *ctx, *c_ctx, *w_ada, *b_ada, *w_in, *conv_w, *conv_b, *rg_a_w, *rg_a_b, *rg_i_w, *rg_i_b, *rg_lambda,
        *na_rpb, *gqa_sink, *w_out, *ln1_g, *ln1_b, *router_g_w, *router_g_b, *router_e_w, *router_e_b, *exp_w_gate, *exp_w_up,
        *exp_w_down, *ln2_g, *ln2_b;
    float* out;
    unsigned char* ws;
};

DEV const Params& kp_() { const void* q = (const void*)__builtin_amdgcn_kernarg_segment_ptr(); asm volatile("" : "+s"(q)); return *(const Params*)q; }
DEV int tid_() { int t = threadIdx.x; asm volatile("" : "+v"(t)); return t; }
DEV int bid_() { int b = blockIdx.x; asm volatile("" : "+s"(b)); return b; }
DEV float shx(float v, int m) { return __builtin_bit_cast(float, __builtin_amdgcn_ds_bpermute(((tid_() & 63) ^ m) << 2, __builtin_bit_cast(int, v))); }
DEV float shl_(float v, int src) { return __builtin_bit_cast(float, __builtin_amdgcn_ds_bpermute(src << 2, __builtin_bit_cast(int, v))); }
DEV float bf2f(bf16_t h) { return __uint_as_float((unsigned)h << 16); }
DEV bf16_t f2bf(float f) { unsigned r; asm("v_cvt_pk_bf16_f32 %0, %1, %1" : "=v"(r) : "v"(f)); return (bf16_t)(r & 0xffffu); }
DEV unsigned pk2(float lo, float hi) { unsigned r; asm("v_cvt_pk_bf16_f32 %0, %1, %2" : "=v"(r) : "v"(lo), "v"(hi)); return r; }
DEV float wave_sum(float v) {
#pragma unroll
    for (int o = 1; o < 64; o <<= 1) v += shx(v, o);
    return v;
}
DEV float wave_max(float v) {
#pragma unroll
    for (int o = 1; o < 64; o <<= 1) v = fmaxf(v, shx(v, o));
    return v;
}
DEV float sigmoidf_(float x) { return 1.f / (1.f + __expf(-x)); }
DEV float gelu_tanh(float x) {
    const float u = 0.7978845608028654f * (x + 0.044715f * x * x * x);
    const float t = 1.f - 2.f * __builtin_amdgcn_rcpf(1.f + __expf(2.f * u));
    return 0.5f * x * (1.f + t);
}
DEV float* xres_row(const Params& p, int R) {
    return R < NLAT ? p.out + (size_t)R * D : (float*)(p.ws + OFF_XCTX) + (size_t)(R - NLAT) * D;
}
DEV const float* modvec(const Params& p, int l, int R, int seg) {
    const int b = R < NLAT ? R / S : 8;
    return (const float*)(p.ws + OFF_MOD) + ((size_t)(l * 9 + b) * 6 + seg) * 1024;
}

DEV void ph_mod(const Params& p, float* sc  ) {
    if (bid_() >= 192) return;
    for (int i = tid_(); i < 9 * 1024; i += 256) { const float v = (i < 8192) ? p.c[i] : p.c_ctx[i - 8192]; sc[i] = v / (1.f + expf(-v)); }
    __syncthreads();
    const int lane = tid_() & 63, w = tid_() >> 6;
    const int col = bid_() * 64 + lane;
    const int l = col / 6144, j = col % 6144;
    const float* wp = p.w_ada + (size_t)l * 1024 * 6144 + j + (size_t)(w * 256) * 6144;
    const float* s = sc + w * 256;
    float a0 = 0, a1 = 0, a2 = 0, a3 = 0, a4 = 0, a5 = 0, a6 = 0, a7 = 0, a8 = 0;
#pragma unroll 8
    for (int k = 0; k < 256; ++k) {
        const float wv = wp[(size_t)k * 6144];
        a0 += s[k] * wv; a1 += s[1024 + k] * wv; a2 += s[2048 + k] * wv; a3 += s[3072 + k] * wv; a4 += s[4096 + k] * wv;
        a5 += s[5120 + k] * wv; a6 += s[6144 + k] * wv; a7 += s[7168 + k] * wv; a8 += s[8192 + k] * wv;
    }
    __syncthreads();
    float* red = sc + 9 * 1024;
    red[(w * 9 + 0) * 64 + lane] = a0; red[(w * 9 + 1) * 64 + lane] = a1; red[(w * 9 + 2) * 64 + lane] = a2; red[(w * 9 + 3) * 64 + lane] = a3; red[(w * 9 + 4) * 64 + lane] = a4;
    red[(w * 9 + 5) * 64 + lane] = a5; red[(w * 9 + 6) * 64 + lane] = a6; red[(w * 9 + 7) * 64 + lane] = a7; red[(w * 9 + 8) * 64 + lane] = a8;
    __syncthreads();
    if (w == 0) {
        const float bias = p.b_ada[l * 6144 + j];
        float* mod = (float*)(p.ws + OFF_MOD) + (size_t)l * 9 * 6144 + j;
#pragma unroll
        for (int r = 0; r < 9; ++r) mod[r * 6144] = ((red[(0 * 9 + r) * 64 + lane] + red[(1 * 9 + r) * 64 + lane]) + (red[(2 * 9 + r) * 64 + lane] + red[(3 * 9 + r) * 64 + lane])) + bias;
    }
}

DEV void sincos_red(float ang, float& sn, float& cs) {
    const float n = rintf(ang * 0.15915494309189535f);
    float r = fmaf(-n, 6.2831854820251465f, ang);
    r = fmaf(-n, -1.7484555e-07f, r);
    float sgn = 1.f;
    if (r > 1.5707963267948966f) { r = 3.14159265358979f - r; sgn = -1.f; }
    else if (r < -1.5707963267948966f) { r = -3.14159265358979f - r; sgn = -1.f; }
    const float r2 = r * r;
    float sp = -1.6059044e-10f; sp = fmaf(sp, r2, 2.5052108e-08f); sp = fmaf(sp, r2, -2.7557319e-06f); sp = fmaf(sp, r2, 1.9841270e-04f);
    sp = fmaf(sp, r2, -8.3333333e-03f); sp = fmaf(sp, r2, 1.6666667e-01f); sp = fmaf(sp * -1.f, r2, 1.f);
    sn = r * sp;
    float cp = -1.1470746e-11f; cp = fmaf(cp, r2, 2.0876757e-09f); cp = fmaf(cp, r2, -2.7557319e-07f); cp = fmaf(cp, r2, 2.4801587e-05f);
    cp = fmaf(cp, r2, -1.3888889e-03f); cp = fmaf(cp, r2, 4.1666667e-02f); cp = fmaf(cp, r2, -0.5f); cp = fmaf(cp, r2, 1.f);
    cs = sgn * cp;
}
DEV void ph_rope(const Params& p) {
    const int i = (bid_() - 192) * 256 + tid_();
    if (i < 0 || i >= 128 * 16) return;
    const int pos = i >> 4, q = i & 15;
    const float inv = exp2f(-(float)q * (13.287712379549449f / 16.f));
    float sn, cs; sincos_red((float)pos * inv, sn, cs);
    float* tab = (float*)(p.ws + OFF_ROPE);
    tab[i] = cs; tab[2048 + i] = sn;
}

DEV void ph_routerw(const Params& p) {
  for (int i = bid_() * 256 + tid_(); i < 2 * 48 * 1024; i += gridDim.x * 256) {
    const int l = i / (48 * 1024), f = (i / 1024) % 48, k = i & 1023;
    float w = 0.f;
    if (f < 4) w = p.router_g_w[((size_t)l * 1024 + k) * 4 + f]; else if (f < 36) w = p.router_e_w[((size_t)l * 1024 + k) * 32 + (f - 4)];
    const bf16_t hi = f2bf(w), lo = f2bf(w - bf2f(hi));
    bf16_t* WR = (bf16_t*)(p.ws + OFF_WR);
    WR[((size_t)(l * 2 + 0) * 48 + f) * 1024 + k] = hi;
    WR[((size_t)(l * 2 + 1) * 48 + f) * 1024 + k] = lo;
  }
}

DEV void ph_rgprep(const Params& p) {
    bf16_t* W = (bf16_t*)(p.ws + OFF_WRG);
    for (int i = bid_() * 256 + tid_(); i < 2 * 2 * 2 * 4 * 64 * 64; i += gridDim.x * 256) {
        const int d = i & 63, e = (i >> 6) & 63, n = (i >> 12) & 3, gate = (i >> 14) & 1, ld = i >> 15;
        const float* srcw = gate ? p.rg_i_w : p.rg_a_w;
        W[i] = f2bf(srcw[((size_t)(ld * 4 + n) * 64 + d) * 64 + e]);
    }
    float* C = (float*)(p.ws + OFF_RGC);
    for (int i = bid_() * 256 + tid_(); i < 2 * 2 * 256; i += gridDim.x * 256) {
        const int c = i & 255, ld = i >> 8;
        C[(ld * 3 + 0) * 256 + c] = p.rg_a_b[ld * 256 + c];
        C[(ld * 3 + 1) * 256 + c] = p.rg_i_b[ld * 256 + c];
        C[(ld * 3 + 2) * 256 + c] = -8.f * log1pf(expf(-p.rg_lambda[ld * 256 + c]));
    }
}

DEV int tr_row(int n, int mode) { return mode == 0 ? n : ((n >> 7) * 256 + ((n >> 6) & 1) * 128 + (n & 63) + (mode == 2 ? 64 : 0)); }
DEV void transpose_tile(const float* src, bf16_t* dst, int K, int N, int mode, int tile, float* lds) {
    const int ntn = N >> 6, kt = tile / ntn, nt = tile % ntn, k0 = kt * 64, n0 = nt * 64, t = tid_();
#pragma unroll
    for (int i = 0; i < 4; ++i) {
        const int r = (t >> 4) + 16 * i, c4 = (t & 15) * 4;
        const float4 v = *(const float4*)(src + (size_t)(k0 + r) * N + n0 + c4);
        lds[r * 65 + c4] = v.x; lds[r * 65 + c4 + 1] = v.y; lds[r * 65 + c4 + 2] = v.z; lds[r * 65 + c4 + 3] = v.w;
    }
    __syncthreads();
#pragma unroll
    for (int i = 0; i < 2; ++i) {
        const int n = (t >> 3) + 32 * i, kc = (t & 7) * 8;
        uint4 o;
        o.x = pk2(lds[(kc + 0) * 65 + n], lds[(kc + 1) * 65 + n]); o.y = pk2(lds[(kc + 2) * 65 + n], lds[(kc + 3) * 65 + n]);
        o.z = pk2(lds[(kc + 4) * 65 + n], lds[(kc + 5) * 65 + n]); o.w = pk2(lds[(kc + 6) * 65 + n], lds[(kc + 7) * 65 + n]);
        *(uint4*)(dst + (size_t)tr_row(n0 + n, mode) * K + k0 + kc) = o;
    }
    __syncthreads();
}
DEV void transpose_tile_w(const float* src, bf16_t* dst, int K, int N, int mode, int tile, float* lds  ) {
    const int ntn = N >> 6, kt = tile / ntn, nt = tile % ntn, k0 = kt * 64, n0 = nt * 64, t = tid_() & 63;
    float4 v[16];
#pragma unroll
    for (int i = 0; i < 16; ++i) v[i] = *(const float4*)(src + (size_t)(k0 + (t >> 4) + 4 * i) * N + n0 + (t & 15) * 4);
#pragma unroll
    for (int i = 0; i < 16; ++i) { const int r = (t >> 4) + 4 * i, c4 = (t & 15) * 4; lds[r * 65 + c4] = v[i].x; lds[r * 65 + c4 + 1] = v[i].y; lds[r * 65 + c4 + 2] = v[i].z; lds[r * 65 + c4 + 3] = v[i].w; }
    asm volatile("s_waitcnt lgkmcnt(0)" ::: "memory");
#pragma unroll
    for (int i = 0; i < 8; ++i) {
        const int n = (t >> 3) + 8 * i, kc = (t & 7) * 8;
        uint4 o;
        o.x = pk2(lds[(kc + 0) * 65 + n], lds[(kc + 1) * 65 + n]); o.y = pk2(lds[(kc + 2) * 65 + n], lds[(kc + 3) * 65 + n]);
        o.z = pk2(lds[(kc + 4) * 65 + n], lds[(kc + 5) * 65 + n]); o.w = pk2(lds[(kc + 6) * 65 + n], lds[(kc + 7) * 65 + n]);
        *(uint4*)(dst + (size_t)tr_row(n0 + n, mode) * K + k0 + kc) = o;
    }
    asm volatile("s_waitcnt lgkmcnt(0)" ::: "memory");
}
DEV void expert_conv_item(const Params& p, int l, int gi, float* lds) {
    const int w = tid_() >> 6;
    float* my = lds + w * (64 * 65);
#pragma unroll 1
    for (int k = 0; k < 2; ++k) {
        const int T = gi * 8 + w * 2 + k, kind = T >> 12, Tl = T & 4095, e = Tl >> 7, tile = Tl & 127;
        if (kind == 0) transpose_tile_w(p.exp_w_gate + ((size_t)l * NE + e) * 1024 * 512, (bf16_t*)(p.ws + OFF_WGU) + (size_t)e * 1024 * 1024, 1024, 512, 1, tile, my);
        else if (kind == 1) transpose_tile_w(p.exp_w_up + ((size_t)l * NE + e) * 1024 * 512, (bf16_t*)(p.ws + OFF_WGU) + (size_t)e * 1024 * 1024, 1024, 512, 2, tile, my);
        else transpose_tile_w(p.exp_w_down + ((size_t)l * NE + e) * 512 * 1024, (bf16_t*)(p.ws + OFF_WD) + (size_t)e * 1024 * 512, 512, 1024, 0, tile, my);
    }
}
DEV void ph_transpose(const float* src, bf16_t* dst, int K, int N, int mode, int nmat, size_t sstride, size_t dstride, float* lds  ) {
    const int per = (K >> 6) * (N >> 6);
    for (int it = bid_(); it < nmat * per; it += gridDim.x) {
        const int m = it / per, tile = it % per;
        transpose_tile(src + (size_t)m * sstride, dst + (size_t)m * dstride, K, N, mode, tile, lds);
    }
}

constexpr int NRW = 4;
template <int MODE, bool WX> DEV void rowop(const Params& p, int l, int R) {
    const int lane = tid_() & 63;
    float4 v[NRW][4];
    float* xr[NRW] = {nullptr, nullptr, nullptr, nullptr};
    if (MODE == 0) {
#pragma unroll
        for (int r = 0; r < NRW; ++r) {
            const int Rr = R + r;
            const float* src = Rr < NLAT ? p.x + (size_t)Rr * D : p.ctx + (size_t)(Rr - NLAT) * D;
#pragma unroll
            for (int i = 0; i < 4; ++i) v[r][i] = *(const float4*)(src + i * 256 + lane * 4);
        }
    } else {
        const float* g2 = modvec(p, l - 1, R, 5);
        const float* lg = p.ln2_g + (l - 1) * D; const float* lb = p.ln2_b + (l - 1) * D;
        float4 xv[NRW][4]; uint2 ya[NRW][4], yb[NRW][4];
#pragma unroll
        for (int r = 0; r < NRW; ++r) {
            xr[r] = xres_row(p, R + r);
            const bf16_t* y0 = (const bf16_t*)(p.ws + OFF_Y) + (size_t)(2 * (R + r)) * D;
#pragma unroll
            for (int i = 0; i < 4; ++i) { const int k = i * 256 + lane * 4; xv[r][i] = *(const float4*)(xr[r] + k); ya[r][i] = *(const uint2*)(y0 + k); yb[r][i] = *(const uint2*)(y0 + D + k); }
        }
        float s[NRW] = {0.f, 0.f, 0.f, 0.f};
#pragma unroll
        for (int i = 0; i < 4; ++i) {
            const float4 gv = *(const float4*)(g2 + i * 256 + lane * 4);
#pragma unroll
            for (int r = 0; r < NRW; ++r) {
                const uint2 a = ya[r][i], b = yb[r][i];
                float4 u;
                u.x = ALPHA * xv[r][i].x + gv.x * (bf2f((bf16_t)(a.x & 0xffff)) + bf2f((bf16_t)(b.x & 0xffff)));
                u.y = ALPHA * xv[r][i].y + gv.y * (bf2f((bf16_t)(a.x >> 16)) + bf2f((bf16_t)(b.x >> 16)));
                u.z = ALPHA * xv[r][i].z + gv.z * (bf2f((bf16_t)(a.y & 0xffff)) + bf2f((bf16_t)(b.y & 0xffff)));
                u.w = ALPHA * xv[r][i].w + gv.w * (bf2f((bf16_t)(a.y >> 16)) + bf2f((bf16_t)(b.y >> 16)));
                v[r][i] = u; s[r] += (u.x + u.y) + (u.z + u.w);
            }
        }
        float q[NRW] = {0.f, 0.f, 0.f, 0.f};
#pragma unroll
        for (int r = 0; r < NRW; ++r) {
            const float mean = wave_sum(s[r]) * (1.f / D);
#pragma unroll
            for (int i = 0; i < 4; ++i) { v[r][i].x -= mean; v[r][i].y -= mean; v[r][i].z -= mean; v[r][i].w -= mean; q[r] += (v[r][i].x * v[r][i].x + v[r][i].y * v[r][i].y) + (v[r][i].z * v[r][i].z + v[r][i].w * v[r][i].w); }
        }
#pragma unroll
        for (int r = 0; r < NRW; ++r) q[r] = rsqrtf(wave_sum(q[r]) * (1.f / D) + LN_EPS);
#pragma unroll
        for (int i = 0; i < 4; ++i) {
            const int k = i * 256 + lane * 4;
            const float4 gg = *(const float4*)(lg + k); const float4 bb = *(const float4*)(lb + k);
#pragma unroll
            for (int r = 0; r < NRW; ++r) {
                v[r][i].x = v[r][i].x * q[r] * gg.x + bb.x; v[r][i].y = v[r][i].y * q[r] * gg.y + bb.y; v[r][i].z = v[r][i].z * q[r] * gg.z + bb.z; v[r][i].w = v[r][i].w * q[r] * gg.w + bb.w;
                if (WX) *(float4*)(xr[r] + k) = v[r][i];
            }
        }
    }
    if (MODE != 2) {
        const float* sh = modvec(p, l, R, 0); const float* sc = modvec(p, l, R, 1);
#pragma unroll
        for (int i = 0; i < 4; ++i) {
            const int k = i * 256 + lane * 4;
            const float4 s4 = *(const float4*)(sh + k); const float4 c4 = *(const float4*)(sc + k);
#pragma unroll
            for (int r = 0; r < NRW; ++r) {
                bf16_t* ha = (bf16_t*)(p.ws + OFF_X1) + (size_t)(R + r) * D;
                uint2 o; o.x = pk2(v[r][i].x * (1.f + c4.x) + s4.x, v[r][i].y * (1.f + c4.y) + s4.y); o.y = pk2(v[r][i].z * (1.f + c4.z) + s4.z, v[r][i].w * (1.f + c4.w) + s4.w);
                *(uint2*)(ha + k) = o;
            }
        }
    }
}
template <int MODE> DEV void ph_rowop(const Params& p, int l, int nrows) {
    const int w = tid_() >> 6;
    for (int R = (bid_() * 4 + w) * NRW; R < nrows; R += gridDim.x * 4 * NRW) rowop<MODE, true>(p, l, R);
}
constexpr int CW_Q = 64;
DEV int q_publish(int nreg, int* slot) {
    __syncthreads();
    if (tid_() == 0) *slot = nreg;
    __syncthreads();
    return *(volatile int*)slot;
}
DEV int q_pull(unsigned* ctr, int* slot) {
    if (tid_() == 0) *slot = (int)atomicAdd(ctr, 1u);
    __syncthreads();
    const int v = *(volatile int*)slot;
    __syncthreads();
    return v;
}

constexpr int GEMM_STAGE_BYTES = 384 * 64;
constexpr int GEMM_NSTAGE = 3;
constexpr int GEMM_LDS_BYTES = GEMM_NSTAGE * GEMM_STAGE_BYTES;
#define LAS __attribute__((address_space(3)))
DEV int gemm_src_chunk(int t) { return ((t & 3) ^ ((0 - (t >> 4)) & 3)) * 8; }
DEV void gemm_mainloop(const bf16_t* Abase, unsigned ao0, unsigned ao1, const bf16_t* Bbase, unsigned bo, unsigned ldb, int nk, bf16_t* lds, f32x4 (&acc)[4][8]) {
    const int t = tid_(), lane = t & 63, w = __builtin_amdgcn_readfirstlane(t >> 6), wm = w >> 1, wn = w & 1;
    LAS unsigned char* L = (LAS unsigned char*)lds;
    const int pc = ((lane >> 4) ^ ((0 - ((lane & 15) >> 2)) & 3)) * 16;
    const int arow = (wm * 64 + (lane & 15)) * 64 + pc, brow = (128 + wn * 128 + (lane & 15)) * 64 + pc;
    const char* Ab = (const char*)Abase; const char* B0 = (const char*)Bbase; const char* B1 = B0 + (size_t)ldb * 128; const char* B2 = B0 + (size_t)ldb * 256; const char* B3 = B0 + (size_t)ldb * 384;
#define GEMM_ISSUE(slot, ko) do { LAS unsigned* d_ = (LAS unsigned*)(L + (slot) * GEMM_STAGE_BYTES + w * 1024); \
        __builtin_amdgcn_global_load_lds((const unsigned*)(Ab + (ao0 + (ko) * 2u)), d_, 16, 0, 0); \
        __builtin_amdgcn_global_load_lds((const unsigned*)(Ab + (ao1 + (ko) * 2u)), d_ + 1024, 16, 0, 0); \
        __builtin_amdgcn_global_load_lds((const unsigned*)(B0 + (bo + (ko) * 2u)), d_ + 2048, 16, 0, 0); \
        __builtin_amdgcn_global_load_lds((const unsigned*)(B1 + (bo + (ko) * 2u)), d_ + 3072, 16, 0, 0); \
        __builtin_amdgcn_global_load_lds((const unsigned*)(B2 + (bo + (ko) * 2u)), d_ + 4096, 16, 0, 0); \
        __builtin_amdgcn_global_load_lds((const unsigned*)(B3 + (bo + (ko) * 2u)), d_ + 5120, 16, 0, 0); } while (0)
    asm volatile("s_waitcnt vmcnt(0)" ::: "memory");
    __builtin_amdgcn_s_barrier();
    asm volatile("" ::: "memory");
    GEMM_ISSUE(0, 0);
    if (nk > 1) GEMM_ISSUE(1, 32);
    int cs = 0, is = 2;
    for (int kt = 0; kt < nk; ++kt) {
        if (kt + 1 < nk) asm volatile("s_waitcnt vmcnt(6)" ::: "memory"); else asm volatile("s_waitcnt vmcnt(0)" ::: "memory");
        __builtin_amdgcn_s_barrier();
        asm volatile("" ::: "memory");
        if (kt + 2 < nk) GEMM_ISSUE(is, (kt + 2) * 32);
        const LAS unsigned char* cur = L + cs * GEMM_STAGE_BYTES;
        const bf16x8 af0 = *(const LAS bf16x8*)(cur + arow), af1 = *(const LAS bf16x8*)(cur + arow + 16 * 64), af2 = *(const LAS bf16x8*)(cur + arow + 32 * 64), af3 = *(const LAS bf16x8*)(cur + arow + 48 * 64);
        bf16x8 bq0 = *(const LAS bf16x8*)(cur + brow), bq1 = *(const LAS bf16x8*)(cur + brow + 16 * 64);
#pragma unroll
        for (int nt = 0; nt < 8; ++nt) {
            const bf16x8 bfr = bq0; bq0 = bq1;
            if (nt + 2 < 8) bq1 = *(const LAS bf16x8*)(cur + brow + (nt + 2) * 16 * 64);
            acc[0][nt] = __builtin_amdgcn_mfma_f32_16x16x32_bf16(bfr, af0, acc[0][nt], 0, 0, 0);
            acc[1][nt] = __builtin_amdgcn_mfma_f32_16x16x32_bf16(bfr, af1, acc[1][nt], 0, 0, 0);
            acc[2][nt] = __builtin_amdgcn_mfma_f32_16x16x32_bf16(bfr, af2, acc[2][nt], 0, 0, 0);
            acc[3][nt] = __builtin_amdgcn_mfma_f32_16x16x32_bf16(bfr, af3, acc[3][nt], 0, 0, 0);
        }
        cs = cs == 2 ? 0 : cs + 1; is = is == 2 ? 0 : is + 1;
    }
#undef GEMM_ISSUE
}
DEV void zero_acc(f32x4 (&acc)[4][8]) {
#pragma unroll
    for (int a = 0; a < 4; ++a)
#pragma unroll
        for (int b = 0; b < 8; ++b) acc[a][b] = (f32x4){0.f, 0.f, 0.f, 0.f};
}

DEV void inproj_item(const Params& p_, int l, int rt, int pass, bf16_t* lds) {
    const Params& p = kp_();
    const int t = tid_(), lane = t & 63, w = t >> 6, wm = w >> 1, wn = w & 1;
    const bf16_t* A = (const bf16_t*)(p.ws + OFF_X1) + (size_t)(rt * 128) * D;
    const bf16_t* Bt = (const bf16_t*)(p.ws + OFF_WINT) + ((size_t)l * 2304 + pass * 256) * 1024;
    const unsigned toff = (unsigned)(((t >> 2) * 1024 + gemm_src_chunk(t)) * 2);
    f32x4 acc[4][8]; zero_acc(acc);
    gemm_mainloop(A, toff, toff + 64 * D * 2, Bt, toff, 1024, 32, lds, acc);
    bf16_t* P = (bf16_t*)(p.ws + OFF_P);
    const float* ctab = (const float*)(p.ws + OFF_ROPE); const float* stab = ctab + 2048;
    const bool isctx = rt >= 512;
    const int fq = lane >> 4, fr = lane & 15;
#pragma unroll
    for (int hci = 0; hci < 2; ++hci) {
        const int hc = pass * 4 + wn * 2 + hci;
        int type, dcol = 0, vh = 0;
        if (hc < 4) { type = 0; dcol = COL_RGX + hc * 64; }
        else if (hc < 10) { type = 4; vh = hc - 4; }
        else if (hc < 16) { type = 5; vh = hc - 10; }
        else if (hc < 18) { type = 6; vh = hc - 16; }
        else if (hc < 20) { type = 7; vh = hc - 18; }
        else if (hc < 24) { type = 0; dcol = COL_GATE + (hc - 20) * 64; }
        else if (hc < 30) { type = 1; dcol = COL_NAQ + (hc - 24) * 64; }
        else { type = 3; dcol = COL_GQ + (hc - 30) * 64; }
#pragma unroll
        for (int mt = 0; mt < 4; ++mt) {
            const int R = rt * 128 + wm * 64 + mt * 16 + fr;
            f32x4 v0 = acc[mt][hci * 4 + 0], v1 = acc[mt][hci * 4 + 1], v2 = acc[mt][hci * 4 + 2], v3 = acc[mt][hci * 4 + 3];
            if ((type == 3 || type == 6) && !isctx) {
                const int tt = R & (S - 1), pr = tt >> 6, pc = tt & 63;
                const f32x4 cr = *(const f32x4*)(ctab + pr * 16 + fq * 4), sr = *(const f32x4*)(stab + pr * 16 + fq * 4);
                const f32x4 cc = *(const f32x4*)(ctab + pc * 16 + fq * 4), sc = *(const f32x4*)(stab + pc * 16 + fq * 4);
                const f32x4 o0 = v0 * cr - v1 * sr, o1 = v1 * cr + v0 * sr, o2 = v2 * cc - v3 * sc, o3 = v3 * cc + v2 * sc;
                v0 = o0; v1 = o1; v2 = o2; v3 = o3;
            }
            if (type == 1 || type == 3) { const float qs = 0.125f * 1.4426950408889634f; v0 = v0 * qs; v1 = v1 * qs; v2 = v2 * qs; v3 = v3 * qs; }
            if (type < 4) {
                bf16_t* o = P + (size_t)R * PWS + dcol + fq * 4;
                uint2 q;
                q.x = pk2(v0[0], v0[1]); q.y = pk2(v0[2], v0[3]); *(uint2*)(o) = q;
                q.x = pk2(v1[0], v1[1]); q.y = pk2(v1[2], v1[3]); *(uint2*)(o + 16) = q;
                q.x = pk2(v2[0], v2[1]); q.y = pk2(v2[2], v2[3]); *(uint2*)(o + 32) = q;
                q.x = pk2(v3[0], v3[1]); q.y = pk2(v3[2], v3[3]); *(uint2*)(o + 48) = q;
            } else {
                const bool na = type < 6, isk = (type == 4 || type == 6);
                bf16_t* tb;
                if (!isctx) { const int b = R >> 13, tile = (R & (S - 1)) >> 4;
                    tb = (bf16_t*)(p.ws + (na ? (isk ? OFF_NAKF : OFF_NAVF) : (isk ? OFF_GKF : OFF_GVF))) + ((size_t)(b * (na ? 6 : 2) + vh) * 512 + tile) * KVT; }
                else { const int cR = R - NLAT, b = cR >> 8, tile = (cR & 255) >> 4;
                    tb = (bf16_t*)(p.ws + (na ? (isk ? OFF_NAKFC : OFF_NAVFC) : (isk ? OFF_GKFC : OFF_GVFC))) + ((size_t)(b * (na ? 6 : 2) + vh) * 16 + tile) * KVT; }
                if (isk) {
                    bf16_t* o = tb + ((fq >> 1) * 16 + fr) * 8 + (fq & 1) * 4;
                    uint2 q;
                    q.x = pk2(v0[0], v0[1]); q.y = pk2(v0[2], v0[3]); *(uint2*)(o) = q;
                    q.x = pk2(v1[0], v1[1]); q.y = pk2(v1[2], v1[3]); *(uint2*)(o + 2 * 16 * 8) = q;
                    q.x = pk2(v2[0], v2[1]); q.y = pk2(v2[2], v2[3]); *(uint2*)(o + 512) = q;
                    q.x = pk2(v3[0], v3[1]); q.y = pk2(v3[2], v3[3]); *(uint2*)(o + 512 + 2 * 16 * 8) = q;
                } else {
                    bf16_t* o = tb + ((fr >> 2) * 16 + fq * 4) * 8 + (fr & 3);
#pragma unroll
                    for (int j = 0; j < 4; ++j) {
                        o[j * 8] = f2bf(v0[j]); o[j * 8 + 4] = f2bf(v1[j]); o[512 + j * 8] = f2bf(v2[j]); o[512 + j * 8 + 4] = f2bf(v3[j]);
                    }
                }
            }
        }
    }
}
DEV void ph_inproj(const Params& p, int l, bf16_t* lds) {
    const int nctxp = (l == 0) ? 9 : 5;
    const int nx = gridDim.x >> 3, xcd = bid_() & 7, j = bid_() >> 3;
    const int nloc = 64 * 9 + 2 * nctxp;
    if (bid_() >= nx * 8) return;
    for (int i0 = j; i0 < nloc * ((PROBE_ID) == 3 ? PROBE_N : 1); i0 += nx) {
        const int i = i0 % nloc;
        int rt, pass;
        if (i < 64 * 9) { rt = xcd * 64 + i / 9; pass = i % 9; } else { const int r = i - 64 * 9; rt = 512 + 2 * xcd + r / nctxp; pass = r % nctxp; }
        inproj_item(p, l, rt, pass, lds);
    }
}

constexpr float LOG2E = 1.4426950408889634f;
struct AttnState { f32x4 o0, o1, o2, o3; float m, lsum; };
struct KVFrag { bf16x8 k00, k01, k10, k11, v0, v1, v2, v3; };
DEV bf16x8 ld16(const bf16_t* p) { return *(const bf16x8*)p; }
DEV bf16x8 lohi(const uint4& a, const uint4& b, int hi) { union { uint4 u; bf16x8 v; } c; c.u = hi ? make_uint4(a.z, a.w, b.z, b.w) : make_uint4(a.x, a.y, b.x, b.y); return c.v; }
DEV void kv_load(const bf16_t* kt0, const bf16_t* kt1, const bf16_t* vt0, const bf16_t* vt1, KVFrag& f) {
    f.k00 = ld16(kt0); f.k01 = ld16(kt0 + 512); f.k10 = ld16(kt1); f.k11 = ld16(kt1 + 512);
    const uint4 a0 = *(const uint4*)vt0, a1 = *(const uint4*)(vt0 + 512), b0 = *(const uint4*)vt1, b1 = *(const uint4*)(vt1 + 512);
    f.v0 = lohi(a0, b0, 0); f.v1 = lohi(a0, b0, 1); f.v2 = lohi(a1, b1, 0); f.v3 = lohi(a1, b1, 1);
}
template <bool HASB> DEV void attn_apply(const KVFrag& f, const bf16x8& q0, const bf16x8& q1, f32x4 b0, f32x4 b1, AttnState& st) {
    const f32x4 z = {0.f, 0.f, 0.f, 0.f};
    f32x4 s0 = __builtin_amdgcn_mfma_f32_16x16x32_bf16(f.k00, q0, z, 0, 0, 0); s0 = __builtin_amdgcn_mfma_f32_16x16x32_bf16(f.k01, q1, s0, 0, 0, 0);
    f32x4 s1 = __builtin_amdgcn_mfma_f32_16x16x32_bf16(f.k10, q0, z, 0, 0, 0); s1 = __builtin_amdgcn_mfma_f32_16x16x32_bf16(f.k11, q1, s1, 0, 0, 0);
    if (HASB) { s0 = s0 + b0; s1 = s1 + b1; }
    float mx = fmaxf(fmaxf(fmaxf(s0[0], s0[1]), fmaxf(s0[2], s0[3])), fmaxf(fmaxf(s1[0], s1[1]), fmaxf(s1[2], s1[3])));
    mx = fmaxf(mx, shx(mx, 16)); mx = fmaxf(mx, shx(mx, 32));
    if (__builtin_amdgcn_ballot_w64(mx > st.m + 8.f) != 0ull) {
        const float mn = fmaxf(st.m, mx);
        const float msn = (mn == -INFINITY) ? 0.f : mn;
        const float alpha = __builtin_amdgcn_exp2f(st.m - msn);
        st.lsum = st.lsum * alpha;
        st.o0 = st.o0 * alpha; st.o1 = st.o1 * alpha; st.o2 = st.o2 * alpha; st.o3 = st.o3 * alpha;
        st.m = mn;
    }
    const float ms = (st.m == -INFINITY) ? 0.f : st.m;
    f32x4 p0, p1;
#pragma unroll
    for (int j = 0; j < 4; ++j) { p0[j] = __builtin_amdgcn_exp2f(s0[j] - ms); p1[j] = __builtin_amdgcn_exp2f(s1[j] - ms); }
    st.lsum = st.lsum + ((p0[0] + p0[1]) + (p0[2] + p0[3])) + ((p1[0] + p1[1]) + (p1[2] + p1[3]));
    union { uint4 u; bf16x8 v; } pt; pt.u = make_uint4(pk2(p0[0], p0[1]), pk2(p0[2], p0[3]), pk2(p1[0], p1[1]), pk2(p1[2], p1[3]));
    st.o0 = __builtin_amdgcn_mfma_f32_16x16x32_bf16(f.v0, pt.v, st.o0, 0, 0, 0);
    st.o1 = __builtin_amdgcn_mfma_f32_16x16x32_bf16(f.v1, pt.v, st.o1, 0, 0, 0);
    st.o2 = __builtin_amdgcn_mfma_f32_16x16x32_bf16(f.v2, pt.v, st.o2, 0, 0, 0);
    st.o3 = __builtin_amdgcn_mfma_f32_16x16x32_bf16(f.v3, pt.v, st.o3, 0, 0, 0);
}
DEV void attn_init(AttnState& st) { const f32x4 z = {0.f, 0.f, 0.f, 0.f}; st.o0 = z; st.o1 = z; st.o2 = z; st.o3 = z; st.m = -INFINITY; st.lsum = 0.f; }
DEV void attn_store(AttnState& st, bf16_t* orow, float sink2  ) {
    float l = st.lsum; l += shx(l, 16); l += shx(l, 32);
    float sc;
    if (sink2 != -INFINITY) { const float mf = fmaxf(st.m, sink2); const float al = __builtin_amdgcn_exp2f(st.m - mf); l = l * al + __builtin_amdgcn_exp2f(sink2 - mf); sc = al / l; }
    else sc = 1.f / l;
    uint2 w;
    w.x = pk2(st.o0[0] * sc, st.o0[1] * sc); w.y = pk2(st.o0[2] * sc, st.o0[3] * sc); *(uint2*)(orow) = w;
    w.x = pk2(st.o1[0] * sc, st.o1[1] * sc); w.y = pk2(st.o1[2] * sc, st.o1[3] * sc); *(uint2*)(orow + 16) = w;
    w.x = pk2(st.o2[0] * sc, st.o2[1] * sc); w.y = pk2(st.o2[2] * sc, st.o2[3] * sc); *(uint2*)(orow + 32) = w;
    w.x = pk2(st.o3[0] * sc, st.o3[1] * sc); w.y = pk2(st.o3[2] * sc, st.o3[3] * sc); *(uint2*)(orow + 48) = w;
}

constexpr int NTASK_NA = NB * 6 * 128 * 4, NTASK_GQ = NB * 2 * 512, NTASK_CNA = NB * 6 * 16, NTASK_CGQ = NB * 2 * 16;
DEV void attn_task(const Params& p, int l, int tk, const float* rpb2  ) {
    const int lane = tid_() & 63, g = lane >> 4, fr = lane & 15;
    const bf16_t* P = (const bf16_t*)(p.ws + OFF_P);
    bf16_t* X1 = (bf16_t*)(p.ws + OFF_X1);
    const f32x4 z4 = {0.f, 0.f, 0.f, 0.f};
    KVFrag f;
    if (tk < NTASK_NA) {
        const int qtile = tk & 3, r = (tk >> 2) & 127, hb = tk >> 9, h = hb % 6, b = hb / 6;
        const int qc = qtile == 0 ? (fr < 8 ? fr : 48 + fr) : 8 + (qtile - 1) * 16 + fr;
        const int ct0 = qtile == 0 ? 0 : qtile - 1, ct1 = qtile == 0 ? 3 : qtile;
        const int R = b * S + r * 64 + qc;
        const bf16_t* qp = P + (size_t)R * PWS + COL_NAQ + h * 64 + g * 8;
        const bf16x8 q0 = ld16(qp), q1 = ld16(qp + 32);
        const int rs = min(max(r - 4, 0), 120), cs = min(max(qc - 8, 0), 48);
        int ci[8]; bool ok[8];
#pragma unroll
        for (int e = 0; e < 8; ++e) { const int kc = ((e >> 2) ? ct1 : ct0) * 16 + g * 4 + (e & 3); ok[e] = (kc >= cs) && (kc < cs + 16); ci[e] = min(max(kc - qc + 15, 0), 30); }
        const bf16_t* kf = (const bf16_t*)(p.ws + OFF_NAKF) + ((size_t)(b * 6 + h) * 512 + rs * 4) * KVT + lane * 8;
        const bf16_t* vf = (const bf16_t*)(p.ws + OFF_NAVF) + ((size_t)(b * 6 + h) * 512 + rs * 4) * KVT + lane * 8;
        AttnState st; attn_init(st);
#pragma unroll
        for (int ri = 0; ri < 8; ++ri) {
            const float* rb = rpb2 + (h * 15 + (rs + ri - r + 7)) * 31;
            f32x4 b0, b1;
#pragma unroll
            for (int j = 0; j < 4; ++j) { b0[j] = ok[j] ? rb[ci[j]] : -INFINITY; b1[j] = ok[4 + j] ? rb[ci[4 + j]] : -INFINITY; }
            kv_load(kf + (size_t)(ri * 4 + ct0) * KVT, kf + (size_t)(ri * 4 + ct1) * KVT, vf + (size_t)(ri * 4 + ct0) * KVT, vf + (size_t)(ri * 4 + ct1) * KVT, f);
            attn_apply<true>(f, q0, q1, b0, b1, st);
        }
        const bf16_t* kc_ = (const bf16_t*)(p.ws + OFF_NAKFC) + (size_t)(b * 6 + h) * 16 * KVT + lane * 8;
        const bf16_t* vc_ = (const bf16_t*)(p.ws + OFF_NAVFC) + (size_t)(b * 6 + h) * 16 * KVT + lane * 8;
#pragma unroll
        for (int pp = 0; pp < 8; ++pp) { kv_load(kc_ + (size_t)(2 * pp) * KVT, kc_ + (size_t)(2 * pp + 1) * KVT, vc_ + (size_t)(2 * pp) * KVT, vc_ + (size_t)(2 * pp + 1) * KVT, f); attn_apply<false>(f, q0, q1, z4, z4, st); }
        attn_store(st, X1 + (size_t)R * D + 256 + h * 64 + g * 4, -INFINITY);
    } else if (tk < NTASK_NA + NTASK_GQ + NTASK_CNA + NTASK_CGQ && (tk < NTASK_NA + NTASK_GQ || tk >= NTASK_NA + NTASK_GQ + NTASK_CNA)) {
        const bool lat = tk < NTASK_NA + NTASK_GQ;
        const int t2 = lat ? tk - NTASK_NA : tk - (NTASK_NA + NTASK_GQ + NTASK_CNA);
        const int qt = lat ? (t2 & 511) : (t2 & 15), hb = lat ? (t2 >> 9) : (t2 >> 4), kvh = hb & 1, b = hb >> 1;
        const int q0i = qt * 16, R = (lat ? b * S : NLAT + b * CTX) + q0i + fr;
        const bf16_t* qp = P + (size_t)R * PWS + COL_GQ + kvh * 192 + g * 8;
        const bf16x8 qa0 = ld16(qp), qa1 = ld16(qp + 32), qb0 = ld16(qp + 64), qb1 = ld16(qp + 96), qc0 = ld16(qp + 128), qc1 = ld16(qp + 160);
        AttnState sa, sb, sc; attn_init(sa); attn_init(sb); attn_init(sc);
        const bf16_t* kf = (const bf16_t*)(p.ws + OFF_GKF) + (size_t)(b * 2 + kvh) * 512 * KVT + lane * 8;
        const bf16_t* vf = (const bf16_t*)(p.ws + OFF_GVF) + (size_t)(b * 2 + kvh) * 512 * KVT + lane * 8;
        const bf16_t* kc_ = (const bf16_t*)(p.ws + OFF_GKFC) + (size_t)(b * 2 + kvh) * 16 * KVT + lane * 8;
        const bf16_t* vc_ = (const bf16_t*)(p.ws + OFF_GVFC) + (size_t)(b * 2 + kvh) * 16 * KVT + lane * 8;
        const int qi = q0i + fr;
#define GQ_LOAD(i, F) do { const int i_ = (i); if (i_ < 9) { const int kt_ = (q0i - 128 + i_ * 32) >> 4; const int ta_ = min(max(kt_, 0), 511), tb_ = min(max(kt_ + 1, 0), 511); \
            kv_load(kf + (size_t)ta_ * KVT, kf + (size_t)tb_ * KVT, vf + (size_t)ta_ * KVT, vf + (size_t)tb_ * KVT, F); } \
        else { const int c_ = (i_ - 9) * 2; kv_load(kc_ + (size_t)c_ * KVT, kc_ + (size_t)(c_ + 1) * KVT, vc_ + (size_t)c_ * KVT, vc_ + (size_t)(c_ + 1) * KVT, F); } } while (0)
#define GQ_APPLY(i, F) do { const int i_ = (i); f32x4 b0_ = z4, b1_ = z4; if (i_ < 9) { const int kb_ = q0i - 128 + i_ * 32; _Pragma("unroll") for (int j = 0; j < 4; ++j) { const int k0_ = kb_ + g * 4 + j, k1_ = k0_ + 16; \
                b0_[j] = (k0_ >= 0 && k0_ < S && k0_ >= qi - 128 && k0_ <= qi + 128) ? 0.f : -INFINITY; b1_[j] = (k1_ >= 0 && k1_ < S && k1_ >= qi - 128 && k1_ <= qi + 128) ? 0.f : -INFINITY; } } \
            if (i_ < 9) { attn_apply<true>(F, qa0, qa1, b0_, b1_, sa); attn_apply<true>(F, qb0, qb1, b0_, b1_, sb); attn_apply<true>(F, qc0, qc1, b0_, b1_, sc); } \
            else { attn_apply<false>(F, qa0, qa1, b0_, b1_, sa); attn_apply<false>(F, qb0, qb1, b0_, b1_, sb); attn_apply<false>(F, qc0, qc1, b0_, b1_, sc); } } while (0)
        KVFrag f2;
        const int i0 = lat ? 0 : 9;
        GQ_LOAD(i0, f);
#pragma unroll 1
        for (int i = i0; i < 17; i += 2) {
            if (i + 1 < 17) GQ_LOAD(i + 1, f2);
            GQ_APPLY(i, f);
            if (i + 1 < 17) { if (i + 2 < 17) GQ_LOAD(i + 2, f); GQ_APPLY(i + 1, f2); }
        }
#undef GQ_LOAD
#undef GQ_APPLY
        bf16_t* o = X1 + (size_t)R * D + 640 + kvh * 192 + g * 4;
        attn_store(sa, o, p.gqa_sink[l * 6 + kvh * 3 + 0] * LOG2E); attn_store(sb, o + 64, p.gqa_sink[l * 6 + kvh * 3 + 1] * LOG2E); attn_store(sc, o + 128, p.gqa_sink[l * 6 + kvh * 3 + 2] * LOG2E);
    } else {
        const int t3 = tk - NTASK_NA - NTASK_GQ, qt = t3 & 15, hb = t3 >> 4, h = hb % 6, b = hb / 6;
        const int R = NLAT + b * CTX + qt * 16 + fr;
        const bf16_t* qp = P + (size_t)R * PWS + COL_NAQ + h * 64 + g * 8;
        const bf16x8 q0 = ld16(qp), q1 = ld16(qp + 32);
        AttnState st; attn_init(st);
        const bf16_t* kc_ = (const bf16_t*)(p.ws + OFF_NAKFC) + (size_t)(b * 6 + h) * 16 * KVT + lane * 8;
        const bf16_t* vc_ = (const bf16_t*)(p.ws + OFF_NAVFC) + (size_t)(b * 6 + h) * 16 * KVT + lane * 8;
#pragma unroll
        for (int pp = 0; pp < 8; ++pp) { kv_load(kc_ + (size_t)(2 * pp) * KVT, kc_ + (size_t)(2 * pp + 1) * KVT, vc_ + (size_t)(2 * pp) * KVT, vc_ + (size_t)(2 * pp + 1) * KVT, f); attn_apply<false>(f, q0, q1, z4, z4, st); }
        attn_store(st, X1 + (size_t)R * D + 256 + h * 64 + g * 4, -INFINITY);
    }
}
DEV void ph_attn(const Params& p, int l, float* rpb2  ) {
    for (int i = tid_(); i < 6 * 15 * 31; i += 256) rpb2[i] = p.na_rpb[(size_t)l * 6 * 15 * 31 + i] * LOG2E;
    __syncthreads();
    const int w = tid_() >> 6;
    const int ntask = NTASK_NA + NTASK_GQ + (l == 0 ? NTASK_CNA + NTASK_CGQ : 0);
    for (int tk0 = bid_() * 4 + w; tk0 < ntask; tk0 += gridDim.x * 4) {
        const int tk = tk0 < NTASK_GQ ? NTASK_NA + tk0 : (tk0 < NTASK_GQ + NTASK_NA ? tk0 - NTASK_GQ : tk0);
        attn_task(p, l, tk, rpb2);
    }
}

template <int CTRL> DEV float dppf(float old, float v) { return __builtin_bit_cast(float, __builtin_amdgcn_update_dpp(__builtin_bit_cast(int, old), __builtin_bit_cast(int, v), CTRL, 0xf, 0xf, false)); }
template <bool FWD> DEV void row_scan(float& a, float& b) {
#define RG_STEP(SHR, SHL) { const float ap = FWD ? dppf<SHR>(1.f, a) : dppf<SHL>(1.f, a); const float bp = FWD ? dppf<SHR>(0.f, b) : dppf<SHL>(0.f, b); b = fmaf(a, bp, b); a = a * ap; }
    RG_STEP(0x111, 0x101) RG_STEP(0x112, 0x102) RG_STEP(0x114, 0x104) RG_STEP(0x118, 0x108)
#undef RG_STEP
}
DEV int rg_bwd_chunk(int pos) { return pos == 0 ? 1 : (pos == 1 ? 0 : 67 - pos); }
DEV void rg_coef(const f32x4& za, const f32x4& zi, const f32x4& ba, const f32x4& bi, const f32x4& spc, const f32x4& xv, f32x4& a, f32x4& b) {
#pragma unroll
    for (int j = 0; j < 4; ++j) {
        const float r = __builtin_amdgcn_rcpf(1.f + __expf(-(za[j] + ba[j])));
        const float ig = __builtin_amdgcn_rcpf(1.f + __expf(-(zi[j] + bi[j])));
        const float la = spc[j] * r;
        const float av = __expf(la);
        const float x2 = 2.f * la;
        float om = x2 * (1.f / 720.f) + (1.f / 120.f); om = om * x2 + (1.f / 24.f); om = om * x2 + (1.f / 6.f); om = om * x2 + 0.5f; om = om * x2 + 1.f; om = -x2 * om;
        if (x2 < -0.25f) om = 1.f - av * av;
        a[j] = av; b[j] = __builtin_amdgcn_sqrtf(om) * (ig * xv[j]);
    }
}
DEV void rg_item(const Params& p, int l, int rt, bf16_t* lds) {
    const int t = tid_(), lane = t & 63, n = t >> 6, g = lane >> 4, fr = lane & 15;
    const bf16_t* P = (const bf16_t*)(p.ws + OFF_P);
    const bool isctx = rt >= 512;
    const int b = isctx ? (rt - 512) >> 1 : rt >> 6, idx = isctx ? (rt - 512) & 1 : 2 + (rt & 63);
    const int L = isctx ? CTX : S, t0 = isctx ? idx * 128 : (idx - 2) * 128, seqbase = isctx ? NLAT + b * CTX : b * S;
    bf16_t* xl = lds + n * (128 * 64);
    {
        const int c = lane & 7, ch0 = n * 64 + c * 8;
        f32x4 cwa[4], cwb[4];
#pragma unroll
        for (int j = 0; j < 4; ++j) { cwa[j] = *(const f32x4*)(p.conv_w + (l * 4 + j) * 256 + ch0); cwb[j] = *(const f32x4*)(p.conv_w + (l * 4 + j) * 256 + ch0 + 4); }
        const f32x4 cba = *(const f32x4*)(p.conv_b + l * 256 + ch0), cbb = *(const f32x4*)(p.conv_b + l * 256 + ch0 + 4);
#pragma unroll 2
        for (int it = 0; it < 16; ++it) {
            const int tok = it * 8 + (lane >> 3), ts = t0 + tok;
            f32x4 acca = cba, accb = cbb;
#pragma unroll
            for (int j = 0; j < 4; ++j) {
                const int tj = ts + j - 2;
                if (tj >= 0 && tj < L) {
                    const uint4 v = *(const uint4*)(P + (size_t)(seqbase + tj) * PWS + COL_RGX + ch0);
                    const f32x4 xa = {__uint_as_float(v.x << 16), __uint_as_float(v.x & 0xffff0000u), __uint_as_float(v.y << 16), __uint_as_float(v.y & 0xffff0000u)};
                    const f32x4 xb = {__uint_as_float(v.z << 16), __uint_as_float(v.z & 0xffff0000u), __uint_as_float(v.w << 16), __uint_as_float(v.w & 0xffff0000u)};
                    acca = acca + cwa[j] * xa; accb = accb + cwb[j] * xb;
                }
            }
            uint4 o; o.x = pk2(acca[0], acca[1]); o.y = pk2(acca[2], acca[3]); o.z = pk2(accb[0], accb[1]); o.w = pk2(accb[2], accb[3]);
            *(uint4*)(xl + tok * 64 + ((c ^ ((tok >> 1) & 7)) * 8)) = o;
        }
    }
    asm volatile("s_waitcnt lgkmcnt(0)" ::: "memory");
    const bf16_t* W = (const bf16_t*)(p.ws + OFF_WRG) + (size_t)(l * 2) * 2 * 4 * 64 * 64;
    const float* C = (const float*)(p.ws + OFF_RGC) + (size_t)(l * 2) * 3 * 256;
    float* AGG = (float*)(p.ws + OFF_AGG) + (size_t)(b * 66) * 1024;
    const int swz = (fr >> 1) & 7;
#pragma unroll 1
    for (int ct = 0; ct < 4; ++ct) {
        const int ch = n * 64 + ct * 16 + g * 4;
        const f32x4 z4 = {0.f, 0.f, 0.f, 0.f};
#pragma unroll
        for (int dir = 0; dir < 2; ++dir) {
            const bf16x8 wa0 = ld16(W + ((size_t)((dir * 2 + 0) * 4 + n) * 64 + ct * 16 + fr) * 64 + g * 8), wa1 = ld16(W + ((size_t)((dir * 2 + 0) * 4 + n) * 64 + ct * 16 + fr) * 64 + 32 + g * 8);
            const bf16x8 wi0 = ld16(W + ((size_t)((dir * 2 + 1) * 4 + n) * 64 + ct * 16 + fr) * 64 + g * 8), wi1 = ld16(W + ((size_t)((dir * 2 + 1) * 4 + n) * 64 + ct * 16 + fr) * 64 + 32 + g * 8);
            const f32x4 ba = *(const f32x4*)(C + (dir * 3 + 0) * 256 + ch), bi = *(const f32x4*)(C + (dir * 3 + 1) * 256 + ch), spc = *(const f32x4*)(C + (dir * 3 + 2) * 256 + ch);
            f32x4 hin = z4, apre = {1.f, 1.f, 1.f, 1.f};
#pragma unroll
            for (int s = 0; s < 8; ++s) {
                const int tt = dir == 0 ? s : 7 - s;
                const int row = tt * 16 + fr;
                const bf16x8 x0 = *(const bf16x8*)(xl + row * 64 + ((g ^ swz) * 8)), x1 = *(const bf16x8*)(xl + row * 64 + (((g | 4) ^ swz) * 8));
                f32x4 za = __builtin_amdgcn_mfma_f32_16x16x32_bf16(wa0, x0, z4, 0, 0, 0); za = __builtin_amdgcn_mfma_f32_16x16x32_bf16(wa1, x1, za, 0, 0, 0);
                f32x4 zi = __builtin_amdgcn_mfma_f32_16x16x32_bf16(wi0, x0, z4, 0, 0, 0); zi = __builtin_amdgcn_mfma_f32_16x16x32_bf16(wi1, x1, zi, 0, 0, 0);
                const uint2 xr = *(const uint2*)(xl + row * 64 + (((ct * 2 + (g >> 1)) ^ swz) * 8) + (g & 1) * 4);
                const f32x4 xv = {__uint_as_float(xr.x << 16), __uint_as_float(xr.x & 0xffff0000u), __uint_as_float(xr.y << 16), __uint_as_float(xr.y & 0xffff0000u)};
                f32x4 a, bb;
                rg_coef(za, zi, ba, bi, spc, xv, a, bb);
                f32x4 h, ac;
#pragma unroll
                for (int j = 0; j < 4; ++j) {
                    float aj = a[j], bj = bb[j];
                    if (dir == 0) row_scan<true>(aj, bj); else row_scan<false>(aj, bj);
                    h[j] = fmaf(aj, hin[j], bj);
                    ac[j] = aj * apre[j];
                }
                {
                    bf16_t* xo = (bf16_t*)(p.ws + OFF_X2) + ((size_t)seqbase + t0 + row) * D + dir * 512 + ch;
                    uint2 o; o.x = pk2(ac[0], ac[1]); o.y = pk2(ac[2], ac[3]); *(uint2*)xo = o;
                    o.x = pk2(h[0], h[1]); o.y = pk2(h[2], h[3]); *(uint2*)(xo + 256) = o;
                }
                const int src = (lane & 48) | (dir == 0 ? 15 : 0);
#pragma unroll
                for (int j = 0; j < 4; ++j) { hin[j] = shl_(h[j], src); apre[j] = shl_(ac[j], src); }
            }
            if (fr == 0) { *(f32x4*)(AGG + (size_t)(idx * 2 + dir) * 512 + ch) = apre; *(f32x4*)(AGG + (size_t)(idx * 2 + dir) * 512 + 256 + ch) = hin; }
        }
    }
}
DEV void rg_final(const Params& p, int l, int rt, float* part  ) {
    const int t = tid_(), cg4 = (t & 63) * 4, tp = t >> 6;
    const bool isctx = rt >= 512;
    const int b = isctx ? (rt - 512) >> 1 : rt >> 6, idx = isctx ? (rt - 512) & 1 : 2 + (rt & 63);
    const float* AGG = (const float*)(p.ws + OFF_AGG) + (size_t)(b * 66) * 1024;
    f32x4 hf = {0.f, 0.f, 0.f, 0.f}, hb = {0.f, 0.f, 0.f, 0.f};
    {
        const int nf = idx, nb = idx == 1 ? 0 : (idx == 0 ? 1 : 67 - idx);
        const int qf = (nf + 3) >> 2, qb = (nb + 3) >> 2;
        f32x4 Af = {1.f, 1.f, 1.f, 1.f}, Bf = {0.f, 0.f, 0.f, 0.f}, Ab = Af, Bb = Bf;
#pragma unroll 4
        for (int q = tp * qf; q < min((tp + 1) * qf, nf); ++q) { const f32x4 A = *(const f32x4*)(AGG + (size_t)(q * 2) * 512 + cg4), B = *(const f32x4*)(AGG + (size_t)(q * 2) * 512 + 256 + cg4); Bf = A * Bf + B; Af = A * Af; }
#pragma unroll 4
        for (int q = tp * qb; q < min((tp + 1) * qb, nb); ++q) { const int cq = rg_bwd_chunk(q); const f32x4 A = *(const f32x4*)(AGG + (size_t)(cq * 2 + 1) * 512 + cg4), B = *(const f32x4*)(AGG + (size_t)(cq * 2 + 1) * 512 + 256 + cg4); Bb = A * Bb + B; Ab = A * Ab; }
        *(f32x4*)(part + ((tp * 2 + 0) * 2 + 0) * 256 + cg4) = Af; *(f32x4*)(part + ((tp * 2 + 0) * 2 + 1) * 256 + cg4) = Bf;
        *(f32x4*)(part + ((tp * 2 + 1) * 2 + 0) * 256 + cg4) = Ab; *(f32x4*)(part + ((tp * 2 + 1) * 2 + 1) * 256 + cg4) = Bb;
        __syncthreads();
#pragma unroll
        for (int k = 0; k < 4; ++k) {
            hf = *(const f32x4*)(part + ((k * 2 + 0) * 2 + 0) * 256 + cg4) * hf + *(const f32x4*)(part + ((k * 2 + 0) * 2 + 1) * 256 + cg4);
            hb = *(const f32x4*)(part + ((k * 2 + 1) * 2 + 0) * 256 + cg4) * hb + *(const f32x4*)(part + ((k * 2 + 1) * 2 + 1) * 256 + cg4);
        }
    }
    const bf16_t* X2 = (const bf16_t*)(p.ws + OFF_X2); const bf16_t* P = (const bf16_t*)(p.ws + OFF_P); bf16_t* X1 = (bf16_t*)(p.ws + OFF_X1);
#pragma unroll 4
    for (int i = 0; i < 32; ++i) {
        const size_t R = (size_t)rt * 128 + i * 4 + tp;
        const uint2 af = *(const uint2*)(X2 + R * D + cg4), bf = *(const uint2*)(X2 + R * D + 256 + cg4), ab = *(const uint2*)(X2 + R * D + 512 + cg4), bb = *(const uint2*)(X2 + R * D + 768 + cg4);
        const uint2 gr = *(const uint2*)(P + R * PWS + COL_GATE + cg4);
#define BLO(u) __uint_as_float((u) << 16)
#define BHI(u) __uint_as_float((u) & 0xffff0000u)
        const float h0 = (BLO(af.x) * hf[0] + BLO(bf.x)) + (BLO(ab.x) * hb[0] + BLO(bb.x));
        const float h1 = (BHI(af.x) * hf[1] + BHI(bf.x)) + (BHI(ab.x) * hb[1] + BHI(bb.x));
        const float h2 = (BLO(af.y) * hf[2] + BLO(bf.y)) + (BLO(ab.y) * hb[2] + BLO(bb.y));
        const float h3 = (BHI(af.y) * hf[3] + BHI(bf.y)) + (BHI(ab.y) * hb[3] + BHI(bb.y));
        uint2 o; o.x = pk2(h0 * gelu_tanh(BLO(gr.x)), h1 * gelu_tanh(BHI(gr.x))); o.y = pk2(h2 * gelu_tanh(BLO(gr.y)), h3 * gelu_tanh(BHI(gr.y)));
#undef BLO
#undef BHI
        *(uint2*)(X1 + R * D + cg4) = o;
    }
}
DEV void ph_rgagg(const Params& p, int l, bf16_t* lds) {
    for (int rt = bid_(); rt < 528; rt += gridDim.x) { rg_item(p, l, rt, lds); __syncthreads(); }
}

DEV void outproj_item(const Params& p_, int l, int rt, bf16_t* lds, float* stat  ) {
    const Params& p = kp_();
    const int t = tid_(), lane = t & 63, w = t >> 6, wm = w >> 1, wn = w & 1, fq = lane >> 4, fr = lane & 15;
    const bf16_t* A = (const bf16_t*)(p.ws + OFF_X1) + (size_t)(rt * 128) * D;
    const bool isctx = rt >= 512;
    const float* g1 = modvec(p, l, rt * 128, 2);
    __syncthreads();
    rg_final(p, l, rt, (float*)lds);
    asm volatile("s_waitcnt vmcnt(0)" ::: "memory");
    __syncthreads();
    __builtin_amdgcn_fence(__ATOMIC_ACQUIRE, "agent");
#pragma unroll 1
    for (int pass = 0; pass < 4; ++pass) {
        const bf16_t* Bt = (const bf16_t*)(p.ws + OFF_WOUTT) + ((size_t)l * 1024 + pass * 256) * 1024;
        const unsigned toff = (unsigned)(((tid_() >> 2) * 1024 + gemm_src_chunk(tid_())) * 2);
        f32x4 acc[4][8]; zero_acc(acc);
        gemm_mainloop(A, toff, toff + 64 * D * 2, Bt, toff, 1024, 32, lds, acc);
#pragma unroll
        for (int mt = 0; mt < 4; ++mt) {
            const int rl = wm * 64 + mt * 16 + fr, R = rt * 128 + rl;
            const float* xin = (l == 0) ? (isctx ? p.ctx + (size_t)(R - NLAT) * D : p.x + (size_t)R * D) : xres_row(p, R);
            float* xo = xres_row(p, R);
            float s = 0.f, q = 0.f;
#pragma unroll
            for (int nt = 0; nt < 8; ++nt) {
                const int col = pass * 256 + wn * 128 + nt * 16 + fq * 4;
                const f32x4 xv = *(const f32x4*)(xin + col), gv = *(const f32x4*)(g1 + col);
                const f32x4 u = xv * ALPHA + gv * acc[mt][nt];
                *(f32x4*)(xo + col) = u;
                s += (u[0] + u[1]) + (u[2] + u[3]); q += (u[0] * u[0] + u[1] * u[1]) + (u[2] * u[2] + u[3] * u[3]);
            }
            s += shx(s, 16); s += shx(s, 32); q += shx(q, 16); q += shx(q, 32);
            if (fq == 0) { float* sp = stat + (wn * 128 + rl) * 2; if (pass == 0) { sp[0] = s; sp[1] = q; } else { sp[0] += s; sp[1] += q; } }
        }
    }
    asm volatile("s_waitcnt vmcnt(0)" ::: "memory");
    __syncthreads();
    __builtin_amdgcn_fence(__ATOMIC_ACQUIRE, "agent");
    {
        bf16_t* X2 = (bf16_t*)(p.ws + OFF_X2);
        const bf16_t* WRh = (const bf16_t*)(p.ws + OFF_WR) + (size_t)(l * 2) * 48 * 1024 + (size_t)fr * 1024 + fq * 8;
        const bf16_t* WRl = WRh + 48 * 1024;
        float* vec = (float*)((unsigned char*)lds + 24576);
        {
            const float* lg = p.ln1_g + l * D; const float* lb = p.ln1_b + l * D;
            const float* sh2 = modvec(p, l, rt * 128, 3); const float* sc2 = modvec(p, l, rt * 128, 4);
            const int k4 = t * 4;
            *(f32x4*)(vec + k4) = *(const f32x4*)(lg + k4); *(f32x4*)(vec + 1024 + k4) = *(const f32x4*)(lb + k4);
            *(f32x4*)(vec + 2048 + k4) = *(const f32x4*)(sc2 + k4) + 1.f; *(f32x4*)(vec + 3072 + k4) = *(const f32x4*)(sh2 + k4);
        }
        float mean[2], rstd[2];
#pragma unroll
        for (int tm = 0; tm < 2; ++tm) {
            const int rl = w * 32 + tm * 16 + fr;
            float s = 0.f, q = 0.f;
#pragma unroll
            for (int i = 0; i < 2; ++i) { s += stat[(i * 128 + rl) * 2]; q += stat[(i * 128 + rl) * 2 + 1]; }
            mean[tm] = s * (1.f / D);
            rstd[tm] = rsqrtf(fmaxf(q * (1.f / D) - mean[tm] * mean[tm], 0.f) + LN_EPS);
        }
        __syncthreads();
        float* xr0 = xres_row(p, rt * 128 + w * 32 + fr) + fq * 8;
        float* xr1 = xres_row(p, rt * 128 + w * 32 + 16 + fr) + fq * 8;
        bf16_t* h20 = X2 + (size_t)(rt * 128 + w * 32 + fr) * D + fq * 8; bf16_t* h21 = h20 + (size_t)16 * D;
        f32x4 lacc[3][2];
#pragma unroll
        for (int a = 0; a < 3; ++a) { lacc[a][0] = (f32x4){0.f, 0.f, 0.f, 0.f}; lacc[a][1] = (f32x4){0.f, 0.f, 0.f, 0.f}; }
        f32x4 nu00 = *(const f32x4*)xr0, nu01 = *(const f32x4*)(xr0 + 4), nu10 = *(const f32x4*)xr1, nu11 = *(const f32x4*)(xr1 + 4);
        bf16x8 nwh0 = *(const bf16x8*)(WRh), nwh1 = *(const bf16x8*)(WRh + 16 * 1024), nwh2 = *(const bf16x8*)(WRh + 32 * 1024);
        bf16x8 nwl0 = *(const bf16x8*)(WRl), nwl1 = *(const bf16x8*)(WRl + 16 * 1024), nwl2 = *(const bf16x8*)(WRl + 32 * 1024);
#pragma unroll 2
        for (int ks = 0; ks < 32; ++ks) {
            const f32x4 u00 = nu00, u01 = nu01, u10 = nu10, u11 = nu11;
            const bf16x8 wh0 = nwh0, wh1 = nwh1, wh2 = nwh2, wl0 = nwl0, wl1 = nwl1, wl2 = nwl2;
            if (ks + 1 < 32) {
                const int ko = (ks + 1) * 32;
                nu00 = *(const f32x4*)(xr0 + ko); nu01 = *(const f32x4*)(xr0 + ko + 4); nu10 = *(const f32x4*)(xr1 + ko); nu11 = *(const f32x4*)(xr1 + ko + 4);
                nwh0 = *(const bf16x8*)(WRh + ko); nwh1 = *(const bf16x8*)(WRh + 16 * 1024 + ko); nwh2 = *(const bf16x8*)(WRh + 32 * 1024 + ko);
                nwl0 = *(const bf16x8*)(WRl + ko); nwl1 = *(const bf16x8*)(WRl + 16 * 1024 + ko); nwl2 = *(const bf16x8*)(WRl + 32 * 1024 + ko);
            }
            const int k = ks * 32 + fq * 8;
            const f32x4 g0 = *(const f32x4*)(vec + k), g1v = *(const f32x4*)(vec + k + 4), b0 = *(const f32x4*)(vec + 1024 + k), b1 = *(const f32x4*)(vec + 1024 + k + 4);
            const f32x4 c0 = *(const f32x4*)(vec + 2048 + k), c1 = *(const f32x4*)(vec + 2048 + k + 4), s0 = *(const f32x4*)(vec + 3072 + k), s1 = *(const f32x4*)(vec + 3072 + k + 4);
            bf16x8 hh0, hl0, hh1, hl1;
            {
                const f32x4 x0 = (u00 - mean[0]) * rstd[0] * g0 + b0, x1 = (u01 - mean[0]) * rstd[0] * g1v + b1;
                *(f32x4*)(xr0 + ks * 32) = x0; *(f32x4*)(xr0 + ks * 32 + 4) = x1;
                const f32x4 h0 = x0 * c0 + s0, h1 = x1 * c1 + s1;
#pragma unroll
                for (int e = 0; e < 4; ++e) { const bf16_t a = f2bf(h0[e]), b = f2bf(h1[e]); hh0[e] = (short)a; hh0[4 + e] = (short)b; hl0[e] = (short)f2bf(h0[e] - bf2f(a)); hl0[4 + e] = (short)f2bf(h1[e] - bf2f(b)); }
                *(bf16x8*)(h20 + ks * 32) = hh0;
            }
            {
                const f32x4 x0 = (u10 - mean[1]) * rstd[1] * g0 + b0, x1 = (u11 - mean[1]) * rstd[1] * g1v + b1;
                *(f32x4*)(xr1 + ks * 32) = x0; *(f32x4*)(xr1 + ks * 32 + 4) = x1;
                const f32x4 h0 = x0 * c0 + s0, h1 = x1 * c1 + s1;
#pragma unroll
                for (int e = 0; e < 4; ++e) { const bf16_t a = f2bf(h0[e]), b = f2bf(h1[e]); hh1[e] = (short)a; hh1[4 + e] = (short)b; hl1[e] = (short)f2bf(h0[e] - bf2f(a)); hl1[4 + e] = (short)f2bf(h1[e] - bf2f(b)); }
                *(bf16x8*)(h21 + ks * 32) = hh1;
            }
#define RT_MMA(ft, WH, WL) do { \
            lacc[ft][0] = __builtin_amdgcn_mfma_f32_16x16x32_bf16(WH, hh0, lacc[ft][0], 0, 0, 0); lacc[ft][0] = __builtin_amdgcn_mfma_f32_16x16x32_bf16(WL, hh0, lacc[ft][0], 0, 0, 0); lacc[ft][0] = __builtin_amdgcn_mfma_f32_16x16x32_bf16(WH, hl0, lacc[ft][0], 0, 0, 0); \
            lacc[ft][1] = __builtin_amdgcn_mfma_f32_16x16x32_bf16(WH, hh1, lacc[ft][1], 0, 0, 0); lacc[ft][1] = __builtin_amdgcn_mfma_f32_16x16x32_bf16(WL, hh1, lacc[ft][1], 0, 0, 0); lacc[ft][1] = __builtin_amdgcn_mfma_f32_16x16x32_bf16(WH, hl1, lacc[ft][1], 0, 0, 0); } while (0)
            RT_MMA(0, wh0, wl0); RT_MMA(1, wh1, wl1); RT_MMA(2, wh2, wl2);
#undef RT_MMA
        }
        __syncthreads();
        float* lt = (float*)lds;
        int* lcnt = (int*)((unsigned char*)lds + 24576); int* lbase = lcnt + 32;
        if (t < 32) lcnt[t] = 0;
#pragma unroll
        for (int ft = 0; ft < 3; ++ft)
#pragma unroll
            for (int tm = 0; tm < 2; ++tm)
#pragma unroll
                for (int j = 0; j < 4; ++j) lt[(w * 32 + tm * 16 + fr) * 48 + ft * 16 + fq * 4 + j] = lacc[ft][tm][j];
        __syncthreads();
        int E0 = 0, E1 = 0, r0 = 0, r1 = 0; float w0 = 0.f, w1 = 0.f;
        const int rl = w * 32 + (lane & 31), R = rt * 128 + rl;
        if (lane < 32) {
            const float* lr = lt + rl * 48;
            int gi = 0; float gm = lr[0] + p.router_g_b[l * 4];
            float gl[4]; gl[0] = gm;
#pragma unroll
            for (int j = 1; j < 4; ++j) { gl[j] = lr[j] + p.router_g_b[l * 4 + j]; if (gl[j] > gm) { gm = gl[j]; gi = j; } }
            float gs = 0.f;
#pragma unroll
            for (int j = 0; j < 4; ++j) gs += expf(gl[j] - gm);
            const float ptop = 1.f / gs;
            int e0 = 0, e1 = 0; float m0 = -INFINITY, m1 = -INFINITY;
            for (int j = 0; j < 8; ++j) {
                const float v = lr[4 + gi * 8 + j] + p.router_e_b[l * 32 + gi * 8 + j];
                if (v > m0) { m1 = m0; e1 = e0; m0 = v; e0 = j; } else if (v > m1) { m1 = v; e1 = j; }
            }
            const float ex = expf(m1 - m0);
            w0 = ptop / (1.f + ex); w1 = ptop * ex / (1.f + ex);
            E0 = gi * 8 + e0; E1 = gi * 8 + e1;
            r0 = atomicAdd(lcnt + E0, 1); r1 = atomicAdd(lcnt + E1, 1);
        }
        __syncthreads();
        if (t < 32) { const int c = lcnt[t]; lbase[t] = c ? (int)atomicAdd((unsigned*)(p.ws + OFF_CTL) + CW_CNT + l * 32 + t, (unsigned)c) : 0; }
        __syncthreads();
        if (lane < 32) {
            int* rte = (int*)(p.ws + OFF_RTE); float* rtw = (float*)(p.ws + OFF_RTW);
            int* list = (int*)(p.ws + OFF_LIST);
            rte[R * 2] = E0; rte[R * 2 + 1] = E1; rtw[R * 2] = w0; rtw[R * 2 + 1] = w1;
            list[(size_t)E0 * LISTCAP + lbase[E0] + r0] = R * 2;
            list[(size_t)E1 * LISTCAP + lbase[E1] + r1] = R * 2 + 1;
        }
    }
}
DEV void ph_outproj(const Params& p, int l, bf16_t* lds, float* stat  ) {
    for (int rt = bid_(); rt < 512; rt += gridDim.x) { outproj_item(p, l, rt, lds, stat); __syncthreads(); }
}

DEV void moe1_item(const Params& p_, int l, int e, int jb, int pass, int item, int cnt, bf16_t* lds) {
    const Params& p = kp_();
    const int t = tid_(), lane = t & 63, w = t >> 6, wm = w >> 1, wn = w & 1, fq = lane >> 4, fr = lane & 15;
    const int* list = (const int*)(p.ws + OFF_LIST) + (size_t)e * LISTCAP;
    const bf16_t* X2 = (const bf16_t*)(p.ws + OFF_X2);
    bf16_t* Hs = (bf16_t*)(p.ws + OFF_P) + (size_t)item * 128 * FF;
    unsigned ao0, ao1;
    { const int s0 = jb * 128 + (t >> 2), s1 = s0 + 64;
      const int tok0 = s0 < cnt ? (list[s0] >> 1) : 0, tok1 = s1 < cnt ? (list[s1] >> 1) : 0;
      ao0 = (unsigned)((tok0 * D + gemm_src_chunk(t)) * 2); ao1 = (unsigned)((tok1 * D + gemm_src_chunk(t)) * 2); }
    const bf16_t* Bt = (const bf16_t*)(p.ws + OFF_WGU) + ((size_t)e * 1024 + pass * 256) * 1024;
    f32x4 acc[4][8]; zero_acc(acc);
    gemm_mainloop(X2, ao0, ao1, Bt, (unsigned)(((t >> 2) * 1024 + gemm_src_chunk(t)) * 2), 1024, 32, lds, acc);
#pragma unroll
    for (int mt = 0; mt < 4; ++mt) {
        const int rl = wm * 64 + mt * 16 + fr;
#pragma unroll
        for (int nt = 0; nt < 4; ++nt) {
            const f32x4 gv = acc[mt][nt], uv = acc[mt][nt + 4];
            float hv[4];
#pragma unroll
            for (int jj = 0; jj < 4; ++jj) hv[jj] = gv[jj] * __builtin_amdgcn_rcpf(1.f + __expf(-gv[jj])) * uv[jj];
            uint2 o; o.x = pk2(hv[0], hv[1]); o.y = pk2(hv[2], hv[3]);
            *(uint2*)(Hs + (size_t)rl * FF + pass * 128 + wn * 64 + nt * 16 + fq * 4) = o;
        }
    }
}
DEV void moe2_item(const Params& p_, int l, int e, int jb, int pass, int item, int cnt, bf16_t* lds) {
    const Params& p = kp_();
    const int t = tid_(), lane = t & 63, w = t >> 6, wm = w >> 1, wn = w & 1, fq = lane >> 4, fr = lane & 15;
    const int* list = (const int*)(p.ws + OFF_LIST) + (size_t)e * LISTCAP;
    const bf16_t* Hs = (const bf16_t*)(p.ws + OFF_P) + (size_t)item * 128 * FF;
    const unsigned hoff = (unsigned)(((t >> 2) * FF + gemm_src_chunk(t)) * 2);
    const float* rtw = (const float*)(p.ws + OFF_RTW);
    bf16_t* Y = (bf16_t*)(p.ws + OFF_Y);
    const bf16_t* Bt = (const bf16_t*)(p.ws + OFF_WD) + ((size_t)e * 1024 + pass * 256) * FF;
    f32x4 acc[4][8]; zero_acc(acc);
    gemm_mainloop(Hs, hoff, hoff + 64 * FF * 2, Bt, hoff, FF, 16, lds, acc);
#pragma unroll
    for (int mt = 0; mt < 4; ++mt) {
        const int s = jb * 128 + wm * 64 + mt * 16 + fr;
        if (s < cnt) {
            const int ent = list[s];
            const float gw = rtw[ent];
            bf16_t* yo = Y + (size_t)ent * D + pass * 256 + wn * 128 + fq * 4;
#pragma unroll
            for (int nt = 0; nt < 8; ++nt) { const f32x4 v = acc[mt][nt] * gw; uint2 o; o.x = pk2(v[0], v[1]); o.y = pk2(v[2], v[3]); *(uint2*)(yo + nt * 16) = o; }
        }
    }
}
template <int STAGE> DEV void ph_moe(const Params& p, int l, bf16_t* lds, int* s_pref  , int* s_cnt  , int* slot, int ph) {
    const unsigned* cnt = (const unsigned*)(p.ws + OFF_CTL) + CW_CNT + l * 32;
    if (tid_() == 0) { int a = 0; for (int e = 0; e < 32; ++e) { const int c = (int)cnt[e]; s_cnt[e] = c; s_pref[e] = a; a += (c + 127) >> 7; } s_pref[32] = a; }
    __syncthreads();
#pragma unroll 1
    for (int hop = 0; hop < 8; ++hop) {
        const int xq = (bid_() + hop) & 7;
        unsigned* ctr = (unsigned*)(p.ws + OFF_CTL) + CW_Q + ph * 8 + xq;
        const int n0 = (s_cnt[xq] + 127) >> 7, n1 = (s_cnt[xq + 8] + 127) >> 7, n2 = (s_cnt[xq + 16] + 127) >> 7, n3 = (s_cnt[xq + 24] + 127) >> 7;
        const int nloc = (n0 + n1 + n2 + n3) * 4;
        int it = q_pull(ctr, slot);
        while (it < nloc) {
            int nreg = 0;
            if (tid_() == 0) nreg = (int)atomicAdd(ctr, 1u);
            const int pass = it & 3, ib = it >> 2;
            int e, jb;
            if (ib < n0) { e = xq; jb = ib; } else if (ib < n0 + n1) { e = xq + 8; jb = ib - n0; } else if (ib < n0 + n1 + n2) { e = xq + 16; jb = ib - n0 - n1; } else { e = xq + 24; jb = ib - n0 - n1 - n2; }
            if (STAGE == 1) moe1_item(p, l, e, jb, pass, s_pref[e] + jb, s_cnt[e], lds); else moe2_item(p, l, e, jb, pass, s_pref[e] + jb, s_cnt[e], lds);
            it = q_publish(nreg, slot);
        }
    }
    __syncthreads();
}

DEV void ph_rowin(const Params& p, int l, bf16_t* lds, int* slot, int ph) {
    const int np = l == 0 ? 9 : 5, nci = 16 * np, ntot = nci + 1024;
    unsigned* ctr = (unsigned*)(p.ws + OFF_CTL) + CW_Q + ph * 8;
    const int w = tid_() >> 6;
    for (;;) {
        const int it = q_pull(ctr, slot);
        if (it >= ntot) break;
        if (it < nci) {
            const int rt = 512 + it / np, pass = it % np;
            for (int r = w * NRW; r < 128; r += 4 * NRW) { if (l == 0) rowop<0, true>(p, 0, rt * 128 + r); else rowop<1, false>(p, 1, rt * 128 + r); }
            asm volatile("s_waitcnt vmcnt(0)" ::: "memory");
            __syncthreads();
            __builtin_amdgcn_fence(__ATOMIC_ACQUIRE, "agent");
            inproj_item(p, l, rt, pass, lds);
        } else {
            const int r0 = (it - nci) * 64;
            for (int r = w * NRW; r < 64; r += 4 * NRW) { if (l == 0) rowop<0, true>(p, 0, r0 + r); else rowop<1, true>(p, 1, r0 + r); }
        }
    }
}
DEV void ph_inproj2(const Params& p, int l, bf16_t* lds, int* slot, int ph) {
    const int xcd = bid_() & 7;
    unsigned* ctr = (unsigned*)(p.ws + OFF_CTL) + CW_Q + ph * 8 + xcd;
    const int ntot = 2 + 768 + (l == 0 ? 32 : 0);
    int it = q_pull(ctr, slot);
    while (it < ntot) {
        int nreg = 0;
        if (tid_() == 0) nreg = (int)atomicAdd(ctr, 1u);
        if (it < 2) { rg_item(p, l, 512 + 2 * xcd + it, lds); }
        else if (it < 770) {
            const int q = it - 2, m = q >> 2, r = q & 3;
            if (r < 3) { const int i = m * 3 + r; inproj_item(p, l, xcd * 64 + i / 9, i % 9, lds); }
            else { __syncthreads(); expert_conv_item(p, l, xcd * 192 + m, (float*)lds); }
        }
        else { const int i = it - 770, w = tid_() >> 6;
            const int tk = i < 24 ? NTASK_NA + NTASK_GQ + (xcd * 24 + i) * 4 + w : NTASK_NA + NTASK_GQ + NTASK_CNA + (xcd * 8 + (i - 24)) * 4 + w;
            attn_task(p, l, tk, (const float*)lds); }
        it = q_publish(nreg, slot);
    }
}
DEV void ph_mixer(const Params& p, int l, bf16_t* lds, float* stat, int* slot, int ph) {
    const int xcd = bid_() & 7;
    unsigned* ctr = (unsigned*)(p.ws + OFF_CTL) + CW_Q + ph * 8 + xcd;
    const int n0 = l == 0 ? 2 : 0, n1 = n0 + 64, n2 = n1 + 256, n3 = n2 + 768, ntot = n3;
    bool rpb_ok = false;
    float* rpb2 = (float*)lds;
    int it = q_pull(ctr, slot);
    while (it < ntot) {
        int nreg = 0;
        if (tid_() == 0) nreg = (int)atomicAdd(ctr, 1u);
        if (it < n0) { outproj_item(p, l, 512 + 2 * xcd + it, lds, stat); rpb_ok = false; }
        else if (it < n1) { rg_item(p, l, xcd * 64 + (it - n0), lds); rpb_ok = false; }
        else if (it < n3) {
            if (!rpb_ok) { for (int i = tid_(); i < 6 * 15 * 31; i += 256) rpb2[i] = p.na_rpb[(size_t)l * 6 * 15 * 31 + i] * LOG2E; __syncthreads(); rpb_ok = true; }
            const int w = tid_() >> 6;
            int tk;
            if (it < n2) { const int i = it - n1; tk = NTASK_NA + (2 * xcd + (i >> 7)) * 512 + (i & 127) * 4 + w; }
            else { const int i = it - n2; tk = (6 * xcd + (i >> 7)) * 512 + (i & 127) * 4 + w; }
            attn_task(p, l, tk, rpb2);
        }
        it = q_publish(nreg, slot);
    }
}

#define XB_TMO      128
#define XB_XCNT(j)  (256  + 64 * (j))
#define XB_XSUB(j)  (1280 + 64 * (j))
#define XB_XGEN(j)  (2304 + 64 * (j))
#define XB_TOP      3328
#define XB_TOPGEN   3392
#define XCD_BAR_WORDS 3456
#define XB_SPIN_CAP (1u << 20)
DEV unsigned xb_ld(unsigned* p) { return __hip_atomic_load(p, __ATOMIC_RELAXED, __HIP_MEMORY_SCOPE_AGENT); }
DEV unsigned xb_add(unsigned* p, unsigned v) { return __hip_atomic_fetch_add(p, v, __ATOMIC_RELAXED, __HIP_MEMORY_SCOPE_AGENT); }
DEV unsigned xb_xcc_id() { return (unsigned)__builtin_amdgcn_s_getreg((3 << 11) | 20) & 0xFu; }
#define XB_SPIN(cond, bar) do { unsigned _sp = 0; while (cond) { __builtin_amdgcn_s_sleep(1); \
    if ((++_sp & 255u) == 0u) { if (xb_ld(&(bar)[XB_TMO])) break; if (_sp > XB_SPIN_CAP) { atomicAdd(&(bar)[XB_TMO], 1u); break; } } } } while (0)
struct XcdBarrier { unsigned* bar; unsigned x; volatile LAS unsigned* st; };
DEV XcdBarrier xcd_barrier_post(unsigned* bar, volatile LAS unsigned* st) {
    XcdBarrier b; b.bar = bar; b.x = xb_xcc_id(); b.st = st;
    if (tid_() == 0) (void)xb_add(&bar[XB_XCNT(b.x)], 1u);
    return b;
}
DEV void xcd_barrier_complete(unsigned* bar, unsigned x, unsigned& nloc, unsigned& nx) {
    const unsigned G = gridDim.x * gridDim.y * gridDim.z;
    unsigned sum, cnt, mine, sp = 0u;
    for (;;) {
        sum = 0u; cnt = 0u; mine = 0u;
#pragma unroll
        for (unsigned j = 0; j < 16; ++j) { const unsigned c = xb_ld(&bar[XB_XCNT(j)]); sum += c; cnt += (c > 0u) ? 1u : 0u; mine = (j == x) ? c : mine; }
        if (sum == G) break;
        __builtin_amdgcn_s_sleep(1);
        if ((++sp & 255u) == 0u) { if (xb_ld(&bar[XB_TMO])) break; if (sp > XB_SPIN_CAP) { atomicAdd(&bar[XB_TMO], 1u); break; } }
    }
    nloc = mine > 0u ? mine : 1u; nx = cnt > 0u ? cnt : 1u;
}
DEV void xcd_barrier(const XcdBarrier& b) {
    asm volatile("s_waitcnt vmcnt(0)" ::: "memory");
    __syncthreads();
    if (tid_() == 0) {
        unsigned* bar = b.bar;
        __builtin_amdgcn_s_waitcnt(0);
        unsigned nloc = b.st[0], nx = b.st[1];
        if (nloc == 0u) { xcd_barrier_complete(bar, b.x, nloc, nx); b.st[0] = nloc; b.st[1] = nx; }
        const unsigned old = xb_add(&bar[XB_XSUB(b.x)], 1u);
        const unsigned gen = old / nloc;
        if (old + 1u == (gen + 1u) * nloc) {
            __builtin_amdgcn_fence(__ATOMIC_RELEASE, "agent");
            asm volatile("s_waitcnt vmcnt(0)" ::: "memory");
            const unsigned og = xb_add(&bar[XB_TOP], 1u);
            const unsigned tg = og / nx;
            if (og + 1u == (tg + 1u) * nx) xb_add(&bar[XB_TOPGEN], 1u);
            else XB_SPIN(xb_ld(&bar[XB_TOPGEN]) == tg, bar);
            __builtin_amdgcn_fence(__ATOMIC_ACQUIRE, "agent");
            xb_add(&bar[XB_XGEN(b.x)], 1u);
            asm volatile("s_waitcnt vmcnt(0)" ::: "memory");
        } else {
            XB_SPIN(xb_ld(&bar[XB_XGEN(b.x)]) == gen, bar);
            __builtin_amdgcn_fence(__ATOMIC_ACQUIRE, "agent");
            asm volatile("s_waitcnt vmcnt(0)" ::: "memory");
        }
    }
    __syncthreads();
}

namespace cg = cooperative_groups;
#define REP(id) for (int rep_ = 0; rep_ < ((PROBE_ID) == (id) ? PROBE_N : 1); ++rep_)
constexpr int SMEM_STAT = GEMM_LDS_BYTES;
constexpr int SMEM_BYTES = GEMM_LDS_BYTES + 2048 + 512;
constexpr int NPHASE = 14;
__global__ void __launch_bounds__(256, 2) mega(Params p, int ph_lo, int ph_hi) {
    extern __shared__ __attribute__((aligned(16))) unsigned char smem[];
    bf16_t* lds = (bf16_t*)smem;
    float* stat = (float*)(smem + SMEM_STAT);
    int* s_pref = (int*)(smem + SMEM_STAT + 2048); int* s_cnt = s_pref + 40;
    int* qslot = (int*)(smem + SMEM_STAT + 2048 + 416);
    volatile LAS unsigned* bst = (volatile LAS unsigned*)(LAS unsigned char*)(smem + SMEM_STAT + 2048 + 400);
    if (tid_() < 2) bst[tid_()] = 0u;
    __syncthreads();
    (void)xcd_barrier_post((unsigned*)(kp_().ws + OFF_CTL + 4096), bst);
#define GRID_BAR() do { XcdBarrier xb_; xb_.bar = (unsigned*)(kp_().ws + OFF_CTL + 4096); xb_.x = xb_xcc_id(); \
        xb_.st = (volatile LAS unsigned*)(LAS unsigned char*)(smem + SMEM_STAT + 2048 + 400); xcd_barrier(xb_); } while (0)
#define IN(k) (ph_lo <= (k) && (k) < ph_hi)
#define STAMP(k) do { if ((PROBE_TS) >= 0 && bid_() == 0 && tid_() == 0) ((unsigned long long*)(kp_().ws + OFF_CTL + 2048))[k] = __builtin_amdgcn_s_memrealtime(); } while (0)
#define SEAM(k) do { if (IN(k) && IN((k) + 1)) { if ((k) == 0) cg::this_grid().sync(); else GRID_BAR(); } STAMP((k) + 1); } while (0)
    STAMP(0);
    if (IN(0)) {
        REP(0) { ph_mod(kp_(), (float*)smem); __syncthreads(); }
        ph_rope(kp_());
        ph_routerw(kp_());
        ph_rgprep(kp_());
        REP(1) ph_transpose(kp_().w_in, (bf16_t*)(kp_().ws + OFF_WINT), 1024, 2304, 0, 2, (size_t)1024 * 2304, (size_t)2304 * 1024, (float*)smem);
        ph_transpose(kp_().w_out, (bf16_t*)(kp_().ws + OFF_WOUTT), 1024, 1024, 0, 2, (size_t)1024 * 1024, (size_t)1024 * 1024, (float*)smem);
    }
    SEAM(0);
#define LAYER_BODY(l, pb) { \
        if (IN(pb + 0)) ph_rowin(kp_(), l, lds, qslot, pb + 0); \
        SEAM(pb + 0); \
        if (IN(pb + 1)) ph_inproj2(kp_(), l, lds, qslot, pb + 1); \
        SEAM(pb + 1); \
        if (IN(pb + 2)) ph_mixer(kp_(), l, lds, stat, qslot, pb + 2); \
        SEAM(pb + 2); \
        if (IN(pb + 3)) ph_outproj(kp_(), l, lds, stat); \
        SEAM(pb + 3); \
        if (IN(pb + 4)) { REP(7) { ph_moe<1>(kp_(), l, lds, s_pref, s_cnt, qslot, pb + 4); } } \
        SEAM(pb + 4); \
        if (IN(pb + 5)) { REP(8) { ph_moe<2>(kp_(), l, lds, s_pref, s_cnt, qslot, pb + 5); } } \
        SEAM(pb + 5); \
    }
    LAYER_BODY(0, 1)
    LAYER_BODY(1, 7)
#undef LAYER_BODY
    if (IN(NPHASE - 1)) ph_rowop<2>(kp_(), 2, NLAT);
    if ((PROBE_TS) >= 0 && bid_() == 0) {
        __syncthreads();
        if (tid_() == 0) {
            unsigned long long* ts = (unsigned long long*)(kp_().ws + OFF_CTL + 2048);
            const unsigned long long now = __builtin_amdgcn_s_memrealtime();
            if ((PROBE_TS) == NPHASE - 1) ts[NPHASE] = now;
            const unsigned long long dt = ts[(PROBE_TS) + 1] - ts[(PROBE_TS)];
            while (__builtin_amdgcn_s_memrealtime() - now < 4ull * dt) __builtin_amdgcn_s_sleep(8);
        }
    }
#undef IN
#undef SEAM
}

#ifndef ONE_LAUNCH
#define ONE_LAUNCH 1
#endif
extern "C" void kernel_launch(void* const* d_in, const int* in_sizes, int n_in, void* d_out, int out_size, void* d_ws, size_t ws_size, hipStream_t stream) {
    if (n_in != 28 || ws_size < WS_TOTAL || out_size != NLAT * D) { fprintf(stderr, "kernel_launch: unexpected shapes / workspace (%d inputs, ws %zu need %zu)\n", n_in, ws_size, (size_t)WS_TOTAL); return; }
    static int grid = 0;
    if (grid == 0) {
        int dev = 0, cus = 0, per_cu = 0;
        (void)hipGetDevice(&dev);
        (void)hipDeviceGetAttribute(&cus, hipDeviceAttributeMultiprocessorCount, dev);
        (void)hipFuncSetAttribute((const void*)mega, hipFuncAttributeMaxDynamicSharedMemorySize, SMEM_BYTES);
        (void)hipOccupancyMaxActiveBlocksPerMultiprocessor(&per_cu, (const void*)mega, 256, SMEM_BYTES);
        if (per_cu > 2) per_cu = 2;
        grid = cus * per_cu;
        if (grid <= 0) { fprintf(stderr, "kernel_launch: occupancy query gave %d blocks per CU on %d CUs\n", per_cu, cus); grid = -1; }
    }
    if (grid < 0) return;
    Params p{};
    const float** pp = (const float**)&p;
    for (int i = 0; i < 28; ++i) pp[i] = (const float*)d_in[i];
    p.out = (float*)d_out; p.ws = (unsigned char*)d_ws;
    (void)hipMemsetAsync((unsigned char*)d_ws + OFF_CTL, 0, CTL_BYTES, stream);
#if ONE_LAUNCH
    int lo = 0, hi = NPHASE;
    void* args[] = {(void*)&p, (void*)&lo, (void*)&hi};
    hipError_t e = hipLaunchCooperativeKernel((const void*)mega, dim3(grid), dim3(256), args, SMEM_BYTES, stream);
    if (e != hipSuccess) fprintf(stderr, "kernel_launch: cooperative launch failed: %s (grid %d)\n", hipGetErrorString(e), grid);
#else
    for (int ph = 0; ph < NPHASE; ++ph) mega<<<grid, 256, SMEM_BYTES, stream>>>(p, ph, ph + 1);
#endif
}
```

```cpp
#include <hip/hip_runtime.h>
#include <hip/hip_cooperative_groups.h>
#include <stdint.h>
#include <cstdio>

typedef unsigned short bf16_t;
typedef short bf16x8 __attribute__((ext_vector_type(8)));
typedef float f32x4 __attribute__((ext_vector_type(4)));

#define DEV __device__ __forceinline__

constexpr int D = 1024, NB = 8, S = 8192, CTX = 256;
constexpr int NLAT = NB * S, NCTX = NB * CTX, NTOK = NLAT + NCTX;
constexpr int PWS = 1280;
constexpr int COL_RGX = 0, COL_GATE = 256, COL_NAQ = 512, COL_GQ = 896;
constexpr int KVT = 1024;
constexpr int NE = 32, FF = 512;
constexpr int LISTCAP = NTOK;
constexpr float ALPHA = 1.4142135623730951f;
constexpr float LN_EPS = 1e-5f;

constexpr size_t al256(size_t x) { return (x + 255) & ~(size_t)255; }
constexpr size_t OFF_CTL   = 0;
constexpr size_t CTL_BYTES = 4096 + 16384;
constexpr size_t OFF_MOD   = OFF_CTL + CTL_BYTES;
constexpr size_t OFF_ROPE  = al256(OFF_MOD + (size_t)2 * 9 * 6144 * 4);
constexpr size_t OFF_RTE   = al256(OFF_ROPE + (size_t)2 * 128 * 16 * 4);
constexpr size_t OFF_RTW   = al256(OFF_RTE + (size_t)NTOK * 8);
constexpr size_t OFF_LIST  = al256(OFF_RTW + (size_t)NTOK * 8);
constexpr size_t OFF_WR    = al256(OFF_LIST + (size_t)NE * LISTCAP * 4);
constexpr size_t OFF_WRG   = al256(OFF_WR + (size_t)2 * 2 * 48 * 1024 * 2);
constexpr size_t OFF_RGC   = al256(OFF_WRG + (size_t)2 * 2 * 2 * 4 * 64 * 64 * 2);
constexpr size_t OFF_AGG   = al256(OFF_RGC + (size_t)2 * 2 * 3 * 256 * 4);
constexpr size_t OFF_WINT  = al256(OFF_AGG + (size_t)NB * 66 * 2 * 2 * 256 * 4);
constexpr size_t OFF_WOUTT = al256(OFF_WINT + (size_t)2 * 2304 * 1024 * 2);
constexpr size_t OFF_WGU   = al256(OFF_WOUTT + (size_t)2 * 1024 * 1024 * 2);
constexpr size_t OFF_WD    = al256(OFF_WGU + (size_t)NE * 1024 * 1024 * 2);
constexpr size_t OFF_XCTX  = al256(OFF_WD + (size_t)NE * 1024 * 512 * 2);
constexpr size_t OFF_X1    = al256(OFF_XCTX + (size_t)NCTX * D * 4);
constexpr size_t OFF_X2    = al256(OFF_X1 + (size_t)NTOK * D * 2);
constexpr size_t OFF_P     = al256(OFF_X2 + (size_t)NTOK * D * 2);
constexpr size_t OFF_NAKF  = al256(OFF_P + (size_t)NTOK * PWS * 2);
constexpr size_t OFF_NAVF  = al256(OFF_NAKF + (size_t)NB * 6 * 512 * KVT * 2);
constexpr size_t OFF_GKF   = al256(OFF_NAVF + (size_t)NB * 6 * 512 * KVT * 2);
constexpr size_t OFF_GVF   = al256(OFF_GKF + (size_t)NB * 2 * 512 * KVT * 2);
constexpr size_t OFF_NAKFC = al256(OFF_GVF + (size_t)NB * 2 * 512 * KVT * 2);
constexpr size_t OFF_NAVFC = al256(OFF_NAKFC + (size_t)NB * 6 * 16 * KVT * 2);
constexpr size_t OFF_GKFC  = al256(OFF_NAVFC + (size_t)NB * 6 * 16 * KVT * 2);
constexpr size_t OFF_GVFC  = al256(OFF_GKFC + (size_t)NB * 2 * 16 * KVT * 2);
constexpr size_t OFF_Y     = al256(OFF_GVFC + (size_t)NB * 2 * 16 * KVT * 2);
constexpr size_t WS_TOTAL  = al256(OFF_Y + (size_t)2 * NTOK * D * 2);
constexpr int CW_CNT = 0;

struct Params {
    const float *x, *c, *ctx, *c_ctx, *w_ada, *b_ada, *w_in, *conv_w, *conv_b, *rg_a_w, *rg_a_b, *rg_i_w, *rg_i_b, *rg_lambda,
        *na_rpb, *gqa_sink, *w_out, *ln1_g, *ln1_b, *router_g_w, *router_g_b, *router_e_w, *router_e_b, *exp_w_gate, *exp_w_up,
        *exp_w_down, *ln2_g, *ln2_b;
    float* out;
    unsigned char* ws;
};

DEV const Params& kp_() { const void* q = (const void*)__builtin_amdgcn_kernarg_segment_ptr(); asm volatile("" : "+s"(q)); return *(const Params*)q; }
DEV int tid_() { int t = threadIdx.x; asm volatile("" : "+v"(t)); return t; }
DEV int bid_() { int b = blockIdx.x; asm volatile("" : "+s"(b)); return b; }
DEV float shx(float v, int m) { return __builtin_bit_cast(float, __builtin_amdgcn_ds_bpermute(((tid_() & 63) ^ m) << 2, __builtin_bit_cast(int, v))); }
DEV float shl_(float v, int src) { return __builtin_bit_cast(float, __builtin_amdgcn_ds_bpermute(src << 2, __builtin_bit_cast(int, v))); }
DEV float bf2f(bf16_t h) { return __uint_as_float((unsigned)h << 16); }
DEV bf16_t f2bf(float f) { unsigned r; asm("v_cvt_pk_bf16_f32 %0, %1, %1" : "=v"(r) : "v"(f)); return (bf16_t)(r & 0xffffu); }
DEV unsigned pk2(float lo, float hi) { unsigned r; asm("v_cvt_pk_bf16_f32 %0, %1, %2" : "=v"(r) : "v"(lo), "v"(hi)); return r; }
DEV float wave_sum(float v) {
#pragma unroll
    for (int o = 1; o < 64; o <<= 1) v += shx(v, o);
    return v;
}
DEV float wave_max(float v) {
#pragma unroll
    for (int o = 1; o < 64; o <<= 1) v = fmaxf(v, shx(v, o));
    return v;
}
DEV float gelu_tanh(float x) {
    const float u = 0.7978845608028654f * (x + 0.044715f * x * x * x);
    const float t = 1.f - 2.f * __builtin_amdgcn_rcpf(1.f + __expf(2.f * u));
    return 0.5f * x * (1.f + t);
}
DEV float* xres_row(const Params& p, int R) {
    return R < NLAT ? p.out + (size_t)R * D : (float*)(p.ws + OFF_XCTX) + (size_t)(R - NLAT) * D;
}
DEV const float* modvec(const Params& p, int l, int R, int seg) {
    const int b = R < NLAT ? R / S : 8;
    return (const float*)(p.ws + OFF_MOD) + ((size_t)(l * 9 + b) * 6 + seg) * 1024;
}

DEV void ph_mod(const Params& p, float* sc  ) {
    if (bid_() >= 192) return;
    for (int i = tid_(); i < 9 * 1024; i += 256) { const float v = (i < 8192) ? p.c[i] : p.c_ctx[i - 8192]; sc[i] = v / (1.f + expf(-v)); }
    __syncthreads();
    const int lane = tid_() & 63, w = tid_() >> 6;
    const int col = bid_() * 64 + lane;
    const int l = col / 6144, j = col % 6144;
    const float* wp = p.w_ada + (size_t)l * 1024 * 6144 + j + (size_t)(w * 256) * 6144;
    const float* s = sc + w * 256;
    float a0 = 0, a1 = 0, a2 = 0, a3 = 0, a4 = 0, a5 = 0, a6 = 0, a7 = 0, a8 = 0;
#pragma unroll 8
    for (int k = 0; k < 256; ++k) {
        const float wv = wp[(size_t)k * 6144];
        a0 += s[k] * wv; a1 += s[1024 + k] * wv; a2 += s[2048 + k] * wv; a3 += s[3072 + k] * wv; a4 += s[4096 + k] * wv;
        a5 += s[5120 + k] * wv; a6 += s[6144 + k] * wv; a7 += s[7168 + k] * wv; a8 += s[8192 + k] * wv;
    }
    __syncthreads();
    float* red = sc + 9 * 1024;
    red[(w * 9 + 0) * 64 + lane] = a0; red[(w * 9 + 1) * 64 + lane] = a1; red[(w * 9 + 2) * 64 + lane] = a2; red[(w * 9 + 3) * 64 + lane] = a3; red[(w * 9 + 4) * 64 + lane] = a4;
    red[(w * 9 + 5) * 64 + lane] = a5; red[(w * 9 + 6) * 64 + lane] = a6; red[(w * 9 + 7) * 64 + lane] = a7; red[(w * 9 + 8) * 64 + lane] = a8;
    __syncthreads();
    if (w == 0) {
        const float bias = p.b_ada[l * 6144 + j];
        float* mod = (float*)(p.ws + OFF_MOD) + (size_t)l * 9 * 6144 + j;
#pragma unroll
        for (int r = 0; r < 9; ++r) mod[r * 6144] = ((red[(0 * 9 + r) * 64 + lane] + red[(1 * 9 + r) * 64 + lane]) + (red[(2 * 9 + r) * 64 + lane] + red[(3 * 9 + r) * 64 + lane])) + bias;
    }
}

DEV void sincos_red(float ang, float& sn, float& cs) {
    const float n = rintf(ang * 0.15915494309189535f);
    float r = fmaf(-n, 6.2831854820251465f, ang);
    r = fmaf(-n, -1.7484555e-07f, r);
    float sgn = 1.f;
    if (r > 1.5707963267948966f) { r = 3.14159265358979f - r; sgn = -1.f; }
    else if (r < -1.5707963267948966f) { r = -3.14159265358979f - r; sgn = -1.f; }
    const float r2 = r * r;
    float sp = -1.6059044e-10f; sp = fmaf(sp, r2, 2.5052108e-08f); sp = fmaf(sp, r2, -2.7557319e-06f); sp = fmaf(sp, r2, 1.9841270e-04f);
    sp = fmaf(sp, r2, -8.3333333e-03f); sp = fmaf(sp, r2, 1.6666667e-01f); sp = fmaf(sp * -1.f, r2, 1.f);
    sn = r * sp;
    float cp = -1.1470746e-11f; cp = fmaf(cp, r2, 2.0876757e-09f); cp = fmaf(cp, r2, -2.7557319e-07f); cp = fmaf(cp, r2, 2.4801587e-05f);
    cp = fmaf(cp, r2, -1.3888889e-03f); cp = fmaf(cp, r2, 4.1666667e-02f); cp = fmaf(cp, r2, -0.5f); cp = fmaf(cp, r2, 1.f);
    cs = sgn * cp;
}
DEV void ph_rope(const Params& p) {
    const int i = (bid_() - 192) * 256 + tid_();
    if (i < 0 || i >= 128 * 16) return;
    const int pos = i >> 4, q = i & 15;
    const float inv = exp2f(-(float)q * (13.287712379549449f / 16.f));
    float sn, cs; sincos_red((float)pos * inv, sn, cs);
    float* tab = (float*)(p.ws + OFF_ROPE);
    tab[i] = cs; tab[2048 + i] = sn;
}

DEV void ph_routerw(const Params& p) {
  for (int i = bid_() * 256 + tid_(); i < 2 * 48 * 1024; i += gridDim.x * 256) {
    const int l = i / (48 * 1024), f = (i / 1024) % 48, k = i & 1023;
    float w = 0.f;
    if (f < 4) w = p.router_g_w[((size_t)l * 1024 + k) * 4 + f]; else if (f < 36) w = p.router_e_w[((size_t)l * 1024 + k) * 32 + (f - 4)];
    const bf16_t hi = f2bf(w), lo = f2bf(w - bf2f(hi));
    bf16_t* WR = (bf16_t*)(p.ws + OFF_WR);
    WR[((size_t)(l * 2 + 0) * 48 + f) * 1024 + k] = hi;
    WR[((size_t)(l * 2 + 1) * 48 + f) * 1024 + k] = lo;
  }
}

DEV void ph_rgprep(const Params& p) {
    bf16_t* W = (bf16_t*)(p.ws + OFF_WRG);
    for (int i = bid_() * 256 + tid_(); i < 2 * 2 * 2 * 4 * 64 * 64; i += gridDim.x * 256) {
        const int d = i & 63, e = (i >> 6) & 63, n = (i >> 12) & 3, gate = (i >> 14) & 1, ld = i >> 15;
        const float* srcw = gate ? p.rg_i_w : p.rg_a_w;
        W[i] = f2bf(srcw[((size_t)(ld * 4 + n) * 64 + d) * 64 + e]);
    }
    float* C = (float*)(p.ws + OFF_RGC);
    for (int i = bid_() * 256 + tid_(); i < 2 * 2 * 256; i += gridDim.x * 256) {
        const int c = i & 255, ld = i >> 8;
        C[(ld * 3 + 0) * 256 + c] = p.rg_a_b[ld * 256 + c];
        C[(ld * 3 + 1) * 256 + c] = p.rg_i_b[ld * 256 + c];
        C[(ld * 3 + 2) * 256 + c] = -8.f * log1pf(expf(-p.rg_lambda[ld * 256 + c]));
    }
}

DEV int tr_row(int n, int mode) { return mode == 0 ? n : ((n >> 7) * 256 + ((n >> 6) & 1) * 128 + (n & 63) + (mode == 2 ? 64 : 0)); }
DEV void transpose_tile(const float* src, bf16_t* dst, int K, int N, int mode, int tile, float* lds) {
    const int ntn = N >> 6, kt = tile / ntn, nt = tile % ntn, k0 = kt * 64, n0 = nt * 64, t = tid_();
#pragma unroll
    for (int i = 0; i < 4; ++i) {
        const int r = (t >> 4) + 16 * i, c4 = (t & 15) * 4;
        const float4 v = *(const float4*)(src + (size_t)(k0 + r) * N + n0 + c4);
        lds[r * 65 + c4] = v.x; lds[r * 65 + c4 + 1] = v.y; lds[r * 65 + c4 + 2] = v.z; lds[r * 65 + c4 + 3] = v.w;
    }
    __syncthreads();
#pragma unroll
    for (int i = 0; i < 2; ++i) {
        const int n = (t >> 3) + 32 * i, kc = (t & 7) * 8;
        uint4 o;
        o.x = pk2(lds[(kc + 0) * 65 + n], lds[(kc + 1) * 65 + n]); o.y = pk2(lds[(kc + 2) * 65 + n], lds[(kc + 3) * 65 + n]);
        o.z = pk2(lds[(kc + 4) * 65 + n], lds[(kc + 5) * 65 + n]); o.w = pk2(lds[(kc + 6) * 65 + n], lds[(kc + 7) * 65 + n]);
        *(uint4*)(dst + (size_t)tr_row(n0 + n, mode) * K + k0 + kc) = o;
    }
    __syncthreads();
}
DEV void transpose_tile_w(const float* src, bf16_t* dst, int K, int N, int mode, int tile, float* lds  ) {
    const int ntn = N >> 6, kt = tile / ntn, nt = tile % ntn, k0 = kt * 64, n0 = nt * 64, t = tid_() & 63;
    float4 v[16];
#pragma unroll
    for (int i = 0; i < 16; ++i) v[i] = *(const float4*)(src + (size_t)(k0 + (t >> 4) + 4 * i) * N + n0 + (t & 15) * 4);
#pragma unroll
    for (int i = 0; i < 16; ++i) { const int r = (t >> 4) + 4 * i, c4 = (t & 15) * 4; lds[r * 65 + c4] = v[i].x; lds[r * 65 + c4 + 1] = v[i].y; lds[r * 65 + c4 + 2] = v[i].z; lds[r * 65 + c4 + 3] = v[i].w; }
    asm volatile("s_waitcnt lgkmcnt(0)" ::: "memory");
#pragma unroll
    for (int i = 0; i < 8; ++i) {
        const int n = (t >> 3) + 8 * i, kc = (t & 7) * 8;
        uint4 o;
        o.x = pk2(lds[(kc + 0) * 65 + n], lds[(kc + 1) * 65 + n]); o.y = pk2(lds[(kc + 2) * 65 + n], lds[(kc + 3) * 65 + n]);
        o.z = pk2(lds[(kc + 4) * 65 + n], lds[(kc + 5) * 65 + n]); o.w = pk2(lds[(kc + 6) * 65 + n], lds[(kc + 7) * 65 + n]);
        *(uint4*)(dst + (size_t)tr_row(n0 + n, mode) * K + k0 + kc) = o;
    }
    asm volatile("s_waitcnt lgkmcnt(0)" ::: "memory");
}
DEV void expert_conv_item(const Params& p, int l, int gi, float* lds) {
    const int w = tid_() >> 6;
    float* my = lds + w * (64 * 65);
#pragma unroll 1
    for (int k = 0; k < 2; ++k) {
        const int T = gi * 8 + w * 2 + k, kind = T >> 12, Tl = T & 4095, e = Tl >> 7, tile = Tl & 127;
        if (kind == 0) transpose_tile_w(p.exp_w_gate + ((size_t)l * NE + e) * 1024 * 512, (bf16_t*)(p.ws + OFF_WGU) + (size_t)e * 1024 * 1024, 1024, 512, 1, tile, my);
        else if (kind == 1) transpose_tile_w(p.exp_w_up + ((size_t)l * NE + e) * 1024 * 512, (bf16_t*)(p.ws + OFF_WGU) + (size_t)e * 1024 * 1024, 1024, 512, 2, tile, my);
        else transpose_tile_w(p.exp_w_down + ((size_t)l * NE + e) * 512 * 1024, (bf16_t*)(p.ws + OFF_WD) + (size_t)e * 1024 * 512, 512, 1024, 0, tile, my);
    }
}
DEV void ph_transpose(const float* src, bf16_t* dst, int K, int N, int mode, int nmat, size_t sstride, size_t dstride, float* lds  ) {
    const int per = (K >> 6) * (N >> 6);
    for (int it = bid_(); it < nmat * per; it += gridDim.x) {
        const int m = it / per, tile = it % per;
        transpose_tile(src + (size_t)m * sstride, dst + (size_t)m * dstride, K, N, mode, tile, lds);
    }
}

constexpr int NRW = 4;
template <int MODE, bool WX> DEV void rowop(const Params& p, int l, int R) {
    const int lane = tid_() & 63;
    float4 v[NRW][4];
    float* xr[NRW] = {nullptr, nullptr, nullptr, nullptr};
    if (MODE == 0) {
#pragma unroll
        for (int r = 0; r < NRW; ++r) {
            const int Rr = R + r;
            const float* src = Rr < NLAT ? p.x + (size_t)Rr * D : p.ctx + (size_t)(Rr - NLAT) * D;
#pragma unroll
            for (int i = 0; i < 4; ++i) v[r][i] = *(const float4*)(src + i * 256 + lane * 4);
        }
    } else {
        const float* g2 = modvec(p, l - 1, R, 5);
        const float* lg = p.ln2_g + (l - 1) * D; const float* lb = p.ln2_b + (l - 1) * D;
        float4 xv[NRW][4]; uint2 ya[NRW][4], yb[NRW][4];
#pragma unroll
        for (int r = 0; r < NRW; ++r) {
            xr[r] = xres_row(p, R + r);
            const bf16_t* y0 = (const bf16_t*)(p.ws + OFF_Y) + (size_t)(2 * (R + r)) * D;
#pragma unroll
            for (int i = 0; i < 4; ++i) { const int k = i * 256 + lane * 4; xv[r][i] = *(const float4*)(xr[r] + k); ya[r][i] = *(const uint2*)(y0 + k); yb[r][i] = *(const uint2*)(y0 + D + k); }
        }
        float s[NRW] = {0.f, 0.f, 0.f, 0.f};
#pragma unroll
        for (int i = 0; i < 4; ++i) {
            const float4 gv = *(const float4*)(g2 + i * 256 + lane * 4);
#pragma unroll
            for (int r = 0; r < NRW; ++r) {
                const uint2 a = ya[r][i], b = yb[r][i];
                float4 u;
                u.x = ALPHA * xv[r][i].x + gv.x * (bf2f((bf16_t)(a.x & 0xffff)) + bf2f((bf16_t)(b.x & 0xffff)));
                u.y = ALPHA * xv[r][i].y + gv.y * (bf2f((bf16_t)(a.x >> 16)) + bf2f((bf16_t)(b.x >> 16)));
                u.z = ALPHA * xv[r][i].z + gv.z * (bf2f((bf16_t)(a.y & 0xffff)) + bf2f((bf16_t)(b.y & 0xffff)));
                u.w = ALPHA * xv[r][i].w + gv.w * (bf2f((bf16_t)(a.y >> 16)) + bf2f((bf16_t)(b.y >> 16)));
                v[r][i] = u; s[r] += (u.x + u.y) + (u.z + u.w);
            }
        }
        float q[NRW] = {0.f, 0.f, 0.f, 0.f};
#pragma unroll
        for (int r = 0; r < NRW; ++r) {
            const float mean = wave_sum(s[r]) * (1.f / D);
#pragma unroll
            for (int i = 0; i < 4; ++i) { v[r][i].x -= mean; v[r][i].y -= mean; v[r][i].z -= mean; v[r][i].w -= mean; q[r] += (v[r][i].x * v[r][i].x + v[r][i].y * v[r][i].y) + (v[r][i].z * v[r][i].z + v[r][i].w * v[r][i].w); }
        }
#pragma unroll
        for (int r = 0; r < NRW; ++r) q[r] = rsqrtf(wave_sum(q[r]) * (1.f / D) + LN_EPS);
#pragma unroll
        for (int i = 0; i < 4; ++i) {
            const int k = i * 256 + lane * 4;
            const float4 gg = *(const float4*)(lg + k); const float4 bb = *(const float4*)(lb + k);
#pragma unroll
            for (int r = 0; r < NRW; ++r) {
                v[r][i].x = v[r][i].x * q[r] * gg.x + bb.x; v[r][i].y = v[r][i].y * q[r] * gg.y + bb.y; v[r][i].z = v[r][i].z * q[r] * gg.z + bb.z; v[r][i].w = v[r][i].w * q[r] * gg.w + bb.w;
                if (WX) *(float4*)(xr[r] + k) = v[r][i];
            }
        }
    }
    if (MODE != 2) {
        const float* sh = modvec(p, l, R, 0); const float* sc = modvec(p, l, R, 1);
#pragma unroll
        for (int i = 0; i < 4; ++i) {
            const int k = i * 256 + lane * 4;
            const float4 s4 = *(const float4*)(sh + k); const float4 c4 = *(const float4*)(sc + k);
#pragma unroll
            for (int r = 0; r < NRW; ++r) {
                bf16_t* ha = (bf16_t*)(p.ws + OFF_X1) + (size_t)(R + r) * D;
                uint2 o; o.x = pk2(v[r][i].x * (1.f + c4.x) + s4.x, v[r][i].y * (1.f + c4.y) + s4.y); o.y = pk2(v[r][i].z * (1.f + c4.z) + s4.z, v[r][i].w * (1.f + c4.w) + s4.w);
                *(uint2*)(ha + k) = o;
            }
        }
    }
}
template <int MODE> DEV void ph_rowop(const Params& p, int l, int nrows) {
    const int w = tid_() >> 6;
    for (int R = (bid_() * 4 + w) * NRW; R < nrows; R += gridDim.x * 4 * NRW) rowop<MODE, true>(p, l, R);
}
constexpr int CW_Q = 64;
DEV int q_publish(int nreg, int* slot) {
    __syncthreads();
    if (tid_() == 0) *slot = nreg;
    __syncthreads();
    return *(volatile int*)slot;
}
DEV int q_pull(unsigned* ctr, int* slot) {
    if (tid_() == 0) *slot = (int)atomicAdd(ctr, 1u);
    __syncthreads();
    const int v = *(volatile int*)slot;
    __syncthreads();
    return v;
}

constexpr int GEMM_STAGE_BYTES = 384 * 64;
constexpr int GEMM_NSTAGE = 3;
constexpr int GEMM_LDS_BYTES = GEMM_NSTAGE * GEMM_STAGE_BYTES;
#define LAS __attribute__((address_space(3)))
DEV int gemm_src_chunk(int t) { return ((t & 3) ^ ((0 - (t >> 4)) & 3)) * 8; }
DEV void gemm_mainloop(const bf16_t* Abase, unsigned ao0, unsigned ao1, const bf16_t* Bbase, unsigned bo, unsigned ldb, int nk, bf16_t* lds, f32x4 (&acc)[4][8]) {
    const int t = tid_(), lane = t & 63, w = __builtin_amdgcn_readfirstlane(t >> 6), wm = w >> 1, wn = w & 1;
    LAS unsigned char* L = (LAS unsigned char*)lds;
    const int pc = ((lane >> 4) ^ ((0 - ((lane & 15) >> 2)) & 3)) * 16;
    const int arow = (wm * 64 + (lane & 15)) * 64 + pc, brow = (128 + wn * 128 + (lane & 15)) * 64 + pc;
    const char* Ab = (const char*)Abase; const char* B0 = (const char*)Bbase; const char* B1 = B0 + (size_t)ldb * 128; const char* B2 = B0 + (size_t)ldb * 256; const char* B3 = B0 + (size_t)ldb * 384;
#define GEMM_ISSUE(slot, ko) do { LAS unsigned* d_ = (LAS unsigned*)(L + (slot) * GEMM_STAGE_BYTES + w * 1024); \
        __builtin_amdgcn_global_load_lds((const unsigned*)(Ab + (ao0 + (ko) * 2u)), d_, 16, 0, 0); \
        __builtin_amdgcn_global_load_lds((const unsigned*)(Ab + (ao1 + (ko) * 2u)), d_ + 1024, 16, 0, 0); \
        __builtin_amdgcn_global_load_lds((const unsigned*)(B0 + (bo + (ko) * 2u)), d_ + 2048, 16, 0, 0); \
        __builtin_amdgcn_global_load_lds((const unsigned*)(B1 + (bo + (ko) * 2u)), d_ + 3072, 16, 0, 0); \
        __builtin_amdgcn_global_load_lds((const unsigned*)(B2 + (bo + (ko) * 2u)), d_ + 4096, 16, 0, 0); \
        __builtin_amdgcn_global_load_lds((const unsigned*)(B3 + (bo + (ko) * 2u)), d_ + 5120, 16, 0, 0); } while (0)
    asm volatile("s_waitcnt vmcnt(0)" ::: "memory");
    __builtin_amdgcn_s_barrier();
    asm volatile("" ::: "memory");
    GEMM_ISSUE(0, 0);
    if (nk > 1) GEMM_ISSUE(1, 32);
    int cs = 0, is = 2;
    for (int kt = 0; kt < nk; ++kt) {
        if (kt + 1 < nk) asm volatile("s_waitcnt vmcnt(6)" ::: "memory"); else asm volatile("s_waitcnt vmcnt(0)" ::: "memory");
        __builtin_amdgcn_s_barrier();
        asm volatile("" ::: "memory");
        if (kt + 2 < nk) GEMM_ISSUE(is, (kt + 2) * 32);
        const LAS unsigned char* cur = L + cs * GEMM_STAGE_BYTES;
        const bf16x8 af0 = *(const LAS bf16x8*)(cur + arow), af1 = *(const LAS bf16x8*)(cur + arow + 16 * 64), af2 = *(const LAS bf16x8*)(cur + arow + 32 * 64), af3 = *(const LAS bf16x8*)(cur + arow + 48 * 64);
        bf16x8 bq0 = *(const LAS bf16x8*)(cur + brow), bq1 = *(const LAS bf16x8*)(cur + brow + 16 * 64);
#pragma unroll
        for (int nt = 0; nt < 8; ++nt) {
            const bf16x8 bfr = bq0; bq0 = bq1;
            if (nt + 2 < 8) bq1 = *(const LAS bf16x8*)(cur + brow + (nt + 2) * 16 * 64);
            acc[0][nt] = __builtin_amdgcn_mfma_f32_16x16x32_bf16(bfr, af0, acc[0][nt], 0, 0, 0);
            acc[1][nt] = __builtin_amdgcn_mfma_f32_16x16x32_bf16(bfr, af1, acc[1][nt], 0, 0, 0);
            acc[2][nt] = __builtin_amdgcn_mfma_f32_16x16x32_bf16(bfr, af2, acc[2][nt], 0, 0, 0);
            acc[3][nt] = __builtin_amdgcn_mfma_f32_16x16x32_bf16(bfr, af3, acc[3][nt], 0, 0, 0);
        }
        cs = cs == 2 ? 0 : cs + 1; is = is == 2 ? 0 : is + 1;
    }
#undef GEMM_ISSUE
}
DEV void zero_acc(f32x4 (&acc)[4][8]) {
#pragma unroll
    for (int a = 0; a < 4; ++a)
#pragma unroll
        for (int b = 0; b < 8; ++b) acc[a][b] = (f32x4){0.f, 0.f, 0.f, 0.f};
}

DEV void inproj_item(const Params& p_, int l, int rt, int pass, bf16_t* lds) {
    const Params& p = kp_();
    const int t = tid_(), lane = t & 63, w = t >> 6, wm = w >> 1, wn = w & 1;
    const bf16_t* A = (const bf16_t*)(p.ws + OFF_X1) + (size_t)(rt * 128) * D;
    const bf16_t* Bt = (const bf16_t*)(p.ws + OFF_WINT) + ((size_t)l * 2304 + pass * 256) * 1024;
    const unsigned toff = (unsigned)(((t >> 2) * 1024 + gemm_src_chunk(t)) * 2);
    f32x4 acc[4][8]; zero_acc(acc);
    gemm_mainloop(A, toff, toff + 64 * D * 2, Bt, toff, 1024, 32, lds, acc);
    bf16_t* P = (bf16_t*)(p.ws + OFF_P);
    const float* ctab = (const float*)(p.ws + OFF_ROPE); const float* stab = ctab + 2048;
    const bool isctx = rt >= 512;
    const int fq = lane >> 4, fr = lane & 15;
#pragma unroll
    for (int hci = 0; hci < 2; ++hci) {
        const int hc = pass * 4 + wn * 2 + hci;
        int type, dcol = 0, vh = 0;
        if (hc < 4) { type = 0; dcol = COL_RGX + hc * 64; }
        else if (hc < 10) { type = 4; vh = hc - 4; }
        else if (hc < 16) { type = 5; vh = hc - 10; }
        else if (hc < 18) { type = 6; vh = hc - 16; }
        else if (hc < 20) { type = 7; vh = hc - 18; }
        else if (hc < 24) { type = 0; dcol = COL_GATE + (hc - 20) * 64; }
        else if (hc < 30) { type = 1; dcol = COL_NAQ + (hc - 24) * 64; }
        else { type = 3; dcol = COL_GQ + (hc - 30) * 64; }
#pragma unroll
        for (int mt = 0; mt < 4; ++mt) {
            const int R = rt * 128 + wm * 64 + mt * 16 + fr;
            f32x4 v0 = acc[mt][hci * 4 + 0], v1 = acc[mt][hci * 4 + 1], v2 = acc[mt][hci * 4 + 2], v3 = acc[mt][hci * 4 + 3];
            if ((type == 3 || type == 6) && !isctx) {
                const int tt = R & (S - 1), pr = tt >> 6, pc = tt & 63;
                const f32x4 cr = *(const f32x4*)(ctab + pr * 16 + fq * 4), sr = *(const f32x4*)(stab + pr * 16 + fq * 4);
                const f32x4 cc = *(const f32x4*)(ctab + pc * 16 + fq * 4), sc = *(const f32x4*)(stab + pc * 16 + fq * 4);
                const f32x4 o0 = v0 * cr - v1 * sr, o1 = v1 * cr + v0 * sr, o2 = v2 * cc - v3 * sc, o3 = v3 * cc + v2 * sc;
                v0 = o0; v1 = o1; v2 = o2; v3 = o3;
            }
            if (type == 1 || type == 3) { const float qs = 0.125f * 1.4426950408889634f; v0 = v0 * qs; v1 = v1 * qs; v2 = v2 * qs; v3 = v3 * qs; }
            if (type < 4) {
                bf16_t* o = P + (size_t)R * PWS + dcol + fq * 4;
                uint2 q;
                q.x = pk2(v0[0], v0[1]); q.y = pk2(v0[2], v0[3]); *(uint2*)(o) = q;
                q.x = pk2(v1[0], v1[1]); q.y = pk2(v1[2], v1[3]); *(uint2*)(o + 16) = q;
                q.x = pk2(v2[0], v2[1]); q.y = pk2(v2[2], v2[3]); *(uint2*)(o + 32) = q;
                q.x = pk2(v3[0], v3[1]); q.y = pk2(v3[2], v3[3]); *(uint2*)(o + 48) = q;
            } else {
                const bool na = type < 6, isk = (type == 4 || type == 6);
                bf16_t* tb;
                if (!isctx) { const int b = R >> 13, tile = (R & (S - 1)) >> 4;
                    tb = (bf16_t*)(p.ws + (na ? (isk ? OFF_NAKF : OFF_NAVF) : (isk ? OFF_GKF : OFF_GVF))) + ((size_t)(b * (na ? 6 : 2) + vh) * 512 + tile) * KVT; }
                else { const int cR = R - NLAT, b = cR >> 8, tile = (cR & 255) >> 4;
                    tb = (bf16_t*)(p.ws + (na ? (isk ? OFF_NAKFC : OFF_NAVFC) : (isk ? OFF_GKFC : OFF_GVFC))) + ((size_t)(b * (na ? 6 : 2) + vh) * 16 + tile) * KVT; }
                if (isk) {
                    bf16_t* o = tb + ((fq >> 1) * 16 + fr) * 8 + (fq & 1) * 4;
                    uint2 q;
                    q.x = pk2(v0[0], v0[1]); q.y = pk2(v0[2], v0[3]); *(uint2*)(o) = q;
                    q.x = pk2(v1[0], v1[1]); q.y = pk2(v1[2], v1[3]); *(uint2*)(o + 2 * 16 * 8) = q;
                    q.x = pk2(v2[0], v2[1]); q.y = pk2(v2[2], v2[3]); *(uint2*)(o + 512) = q;
                    q.x = pk2(v3[0], v3[1]); q.y = pk2(v3[2], v3[3]); *(uint2*)(o + 512 + 2 * 16 * 8) = q;
                } else {
                    bf16_t* o = tb + ((fr >> 2) * 16 + fq * 4) * 8 + (fr & 3);
#pragma unroll
                    for (int j = 0; j < 4; ++j) {
                        o[j * 8] = f2bf(v0[j]); o[j * 8 + 4] = f2bf(v1[j]); o[512 + j * 8] = f2bf(v2[j]); o[512 + j * 8 + 4] = f2bf(v3[j]);
                    }
                }
            }
        }
    }
}
constexpr float LOG2E = 1.4426950408889634f;
struct AttnState { f32x4 o0, o1, o2, o3; float m, lsum; };
struct KVFrag { bf16x8 k00, k01, k10, k11, v0, v1, v2, v3; };
DEV bf16x8 ld16(const bf16_t* p) { return *(const bf16x8*)p; }
DEV bf16x8 lohi(const uint4& a, const uint4& b, int hi) { union { uint4 u; bf16x8 v; } c; c.u = hi ? make_uint4(a.z, a.w, b.z, b.w) : make_uint4(a.x, a.y, b.x, b.y); return c.v; }
DEV void kv_load(const bf16_t* kt0, const bf16_t* kt1, const bf16_t* vt0, const bf16_t* vt1, KVFrag& f) {
    f.k00 = ld16(kt0); f.k01 = ld16(kt0 + 512); f.k10 = ld16(kt1); f.k11 = ld16(kt1 + 512);
    const uint4 a0 = *(const uint4*)vt0, a1 = *(const uint4*)(vt0 + 512), b0 = *(const uint4*)vt1, b1 = *(const uint4*)(vt1 + 512);
    f.v0 = lohi(a0, b0, 0); f.v1 = lohi(a0, b0, 1); f.v2 = lohi(a1, b1, 0); f.v3 = lohi(a1, b1, 1);
}
template <bool HASB> DEV void attn_apply(const KVFrag& f, const bf16x8& q0, const bf16x8& q1, f32x4 b0, f32x4 b1, AttnState& st) {
    const f32x4 z = {0.f, 0.f, 0.f, 0.f};
    f32x4 s0 = __builtin_amdgcn_mfma_f32_16x16x32_bf16(f.k00, q0, z, 0, 0, 0); s0 = __builtin_amdgcn_mfma_f32_16x16x32_bf16(f.k01, q1, s0, 0, 0, 0);
    f32x4 s1 = __builtin_amdgcn_mfma_f32_16x16x32_bf16(f.k10, q0, z, 0, 0, 0); s1 = __builtin_amdgcn_mfma_f32_16x16x32_bf16(f.k11, q1, s1, 0, 0, 0);
    if (HASB) { s0 = s0 + b0; s1 = s1 + b1; }
    float mx = fmaxf(fmaxf(fmaxf(s0[0], s0[1]), fmaxf(s0[2], s0[3])), fmaxf(fmaxf(s1[0], s1[1]), fmaxf(s1[2], s1[3])));
    mx = fmaxf(mx, shx(mx, 16)); mx = fmaxf(mx, shx(mx, 32));
    if (__builtin_amdgcn_ballot_w64(mx > st.m + 8.f) != 0ull) {
        const float mn = fmaxf(st.m, mx);
        const float msn = (mn == -INFINITY) ? 0.f : mn;
        const float alpha = __builtin_amdgcn_exp2f(st.m - msn);
        st.lsum = st.lsum * alpha;
        st.o0 = st.o0 * alpha; st.o1 = st.o1 * alpha; st.o2 = st.o2 * alpha; st.o3 = st.o3 * alpha;
        st.m = mn;
    }
    const float ms = (st.m == -INFINITY) ? 0.f : st.m;
    f32x4 p0, p1;
#pragma unroll
    for (int j = 0; j < 4; ++j) { p0[j] = __builtin_amdgcn_exp2f(s0[j] - ms); p1[j] = __builtin_amdgcn_exp2f(s1[j] - ms); }
    st.lsum = st.lsum + ((p0[0] + p0[1]) + (p0[2] + p0[3])) + ((p1[0] + p1[1]) + (p1[2] + p1[3]));
    union { uint4 u; bf16x8 v; } pt; pt.u = make_uint4(pk2(p0[0], p0[1]), pk2(p0[2], p0[3]), pk2(p1[0], p1[1]), pk2(p1[2], p1[3]));
    st.o0 = __builtin_amdgcn_mfma_f32_16x16x32_bf16(f.v0, pt.v, st.o0, 0, 0, 0);
    st.o1 = __builtin_amdgcn_mfma_f32_16x16x32_bf16(f.v1, pt.v, st.o1, 0, 0, 0);
    st.o2 = __builtin_amdgcn_mfma_f32_16x16x32_bf16(f.v2, pt.v, st.o2, 0, 0, 0);
    st.o3 = __builtin_amdgcn_mfma_f32_16x16x32_bf16(f.v3, pt.v, st.o3, 0, 0, 0);
}
DEV void attn_init(AttnState& st) { const f32x4 z = {0.f, 0.f, 0.f, 0.f}; st.o0 = z; st.o1 = z; st.o2 = z; st.o3 = z; st.m = -INFINITY; st.lsum = 0.f; }
DEV void attn_store(AttnState& st, bf16_t* orow, float sink2  ) {
    float l = st.lsum; l += shx(l, 16); l += shx(l, 32);
    float sc;
    if (sink2 != -INFINITY) { const float mf = fmaxf(st.m, sink2); const float al = __builtin_amdgcn_exp2f(st.m - mf); l = l * al + __builtin_amdgcn_exp2f(sink2 - mf); sc = al / l; }
    else sc = 1.f / l;
    uint2 w;
    w.x = pk2(st.o0[0] * sc, st.o0[1] * sc); w.y = pk2(st.o0[2] * sc, st.o0[3] * sc); *(uint2*)(orow) = w;
    w.x = pk2(st.o1[0] * sc, st.o1[1] * sc); w.y = pk2(st.o1[2] * sc, st.o1[3] * sc); *(uint2*)(orow + 16) = w;
    w.x = pk2(st.o2[0] * sc, st.o2[1] * sc); w.y = pk2(st.o2[2] * sc, st.o2[3] * sc); *(uint2*)(orow + 32) = w;
    w.x = pk2(st.o3[0] * sc, st.o3[1] * sc); w.y = pk2(st.o3[2] * sc, st.o3[3] * sc); *(uint2*)(orow + 48) = w;
}

constexpr int NTASK_NA = NB * 6 * 128 * 4, NTASK_GQ = NB * 2 * 512, NTASK_CNA = NB * 6 * 16, NTASK_CGQ = NB * 2 * 16;
DEV void attn_task(const Params& p, int l, int tk, const float* rpb2  ) {
    const int lane = tid_() & 63, g = lane >> 4, fr = lane & 15;
    const bf16_t* P = (const bf16_t*)(p.ws + OFF_P);
    bf16_t* X1 = (bf16_t*)(p.ws + OFF_X1);
    const f32x4 z4 = {0.f, 0.f, 0.f, 0.f};
    KVFrag f;
    if (tk < NTASK_NA) {
        const int qtile = tk & 3, r = (tk >> 2) & 127, hb = tk >> 9, h = hb % 6, b = hb / 6;
        const int qc = qtile == 0 ? (fr < 8 ? fr : 48 + fr) : 8 + (qtile - 1) * 16 + fr;
        const int ct0 = qtile == 0 ? 0 : qtile - 1, ct1 = qtile == 0 ? 3 : qtile;
        const int R = b * S + r * 64 + qc;
        const bf16_t* qp = P + (size_t)R * PWS + COL_NAQ + h * 64 + g * 8;
        const bf16x8 q0 = ld16(qp), q1 = ld16(qp + 32);
        const int rs = min(max(r - 4, 0), 120), cs = min(max(qc - 8, 0), 48);
        int ci[8]; bool ok[8];
#pragma unroll
        for (int e = 0; e < 8; ++e) { const int kc = ((e >> 2) ? ct1 : ct0) * 16 + g * 4 + (e & 3); ok[e] = (kc >= cs) && (kc < cs + 16); ci[e] = min(max(kc - qc + 15, 0), 30); }
        const bf16_t* kf = (const bf16_t*)(p.ws + OFF_NAKF) + ((size_t)(b * 6 + h) * 512 + rs * 4) * KVT + lane * 8;
        const bf16_t* vf = (const bf16_t*)(p.ws + OFF_NAVF) + ((size_t)(b * 6 + h) * 512 + rs * 4) * KVT + lane * 8;
        AttnState st; attn_init(st);
#pragma unroll
        for (int ri = 0; ri < 8; ++ri) {
            const float* rb = rpb2 + (h * 15 + (rs + ri - r + 7)) * 31;
            f32x4 b0, b1;
#pragma unroll
            for (int j = 0; j < 4; ++j) { b0[j] = ok[j] ? rb[ci[j]] : -INFINITY; b1[j] = ok[4 + j] ? rb[ci[4 + j]] : -INFINITY; }
            kv_load(kf + (size_t)(ri * 4 + ct0) * KVT, kf + (size_t)(ri * 4 + ct1) * KVT, vf + (size_t)(ri * 4 + ct0) * KVT, vf + (size_t)(ri * 4 + ct1) * KVT, f);
            attn_apply<true>(f, q0, q1, b0, b1, st);
        }
        const bf16_t* kc_ = (const bf16_t*)(p.ws + OFF_NAKFC) + (size_t)(b * 6 + h) * 16 * KVT + lane * 8;
        const bf16_t* vc_ = (const bf16_t*)(p.ws + OFF_NAVFC) + (size_t)(b * 6 + h) * 16 * KVT + lane * 8;
#pragma unroll
        for (int pp = 0; pp < 8; ++pp) { kv_load(kc_ + (size_t)(2 * pp) * KVT, kc_ + (size_t)(2 * pp + 1) * KVT, vc_ + (size_t)(2 * pp) * KVT, vc_ + (size_t)(2 * pp + 1) * KVT, f); attn_apply<false>(f, q0, q1, z4, z4, st); }
        attn_store(st, X1 + (size_t)R * D + 256 + h * 64 + g * 4, -INFINITY);
    } else if (tk < NTASK_NA + NTASK_GQ + NTASK_CNA + NTASK_CGQ && (tk < NTASK_NA + NTASK_GQ || tk >= NTASK_NA + NTASK_GQ + NTASK_CNA)) {
        const bool lat = tk < NTASK_NA + NTASK_GQ;
        const int t2 = lat ? tk - NTASK_NA : tk - (NTASK_NA + NTASK_GQ + NTASK_CNA);
        const int qt = lat ? (t2 & 511) : (t2 & 15), hb = lat ? (t2 >> 9) : (t2 >> 4), kvh = hb & 1, b = hb >> 1;
        const int q0i = qt * 16, R = (lat ? b * S : NLAT + b * CTX) + q0i + fr;
        const bf16_t* qp = P + (size_t)R * PWS + COL_GQ + kvh * 192 + g * 8;
        const bf16x8 qa0 = ld16(qp), qa1 = ld16(qp + 32), qb0 = ld16(qp + 64), qb1 = ld16(qp + 96), qc0 = ld16(qp + 128), qc1 = ld16(qp + 160);
        AttnState sa, sb, sc; attn_init(sa); attn_init(sb); attn_init(sc);
        const bf16_t* kf = (const bf16_t*)(p.ws + OFF_GKF) + (size_t)(b * 2 + kvh) * 512 * KVT + lane * 8;
        const bf16_t* vf = (const bf16_t*)(p.ws + OFF_GVF) + (size_t)(b * 2 + kvh) * 512 * KVT + lane * 8;
        const bf16_t* kc_ = (const bf16_t*)(p.ws + OFF_GKFC) + (size_t)(b * 2 + kvh) * 16 * KVT + lane * 8;
        const bf16_t* vc_ = (const bf16_t*)(p.ws + OFF_GVFC) + (size_t)(b * 2 + kvh) * 16 * KVT + lane * 8;
        const int qi = q0i + fr;
#define GQ_LOAD(i, F) do { const int i_ = (i); if (i_ < 9) { const int kt_ = (q0i - 128 + i_ * 32) >> 4; const int ta_ = min(max(kt_, 0), 511), tb_ = min(max(kt_ + 1, 0), 511); \
            kv_load(kf + (size_t)ta_ * KVT, kf + (size_t)tb_ * KVT, vf + (size_t)ta_ * KVT, vf + (size_t)tb_ * KVT, F); } \
        else { const int c_ = (i_ - 9) * 2; kv_load(kc_ + (size_t)c_ * KVT, kc_ + (size_t)(c_ + 1) * KVT, vc_ + (size_t)c_ * KVT, vc_ + (size_t)(c_ + 1) * KVT, F); } } while (0)
#define GQ_APPLY(i, F) do { const int i_ = (i); f32x4 b0_ = z4, b1_ = z4; if (i_ < 9) { const int kb_ = q0i - 128 + i_ * 32; _Pragma("unroll") for (int j = 0; j < 4; ++j) { const int k0_ = kb_ + g * 4 + j, k1_ = k0_ + 16; \
                b0_[j] = (k0_ >= 0 && k0_ < S && k0_ >= qi - 128 && k0_ <= qi + 128) ? 0.f : -INFINITY; b1_[j] = (k1_ >= 0 && k1_ < S && k1_ >= qi - 128 && k1_ <= qi + 128) ? 0.f : -INFINITY; } } \
            if (i_ < 9) { attn_apply<true>(F, qa0, qa1, b0_, b1_, sa); attn_apply<true>(F, qb0, qb1, b0_, b1_, sb); attn_apply<true>(F, qc0, qc1, b0_, b1_, sc); } \
            else { attn_apply<false>(F, qa0, qa1, b0_, b1_, sa); attn_apply<false>(F, qb0, qb1, b0_, b1_, sb); attn_apply<false>(F, qc0, qc1, b0_, b1_, sc); } } while (0)
        KVFrag f2;
        const int i0 = lat ? 0 : 9;
        GQ_LOAD(i0, f);
#pragma unroll 1
        for (int i = i0; i < 17; i += 2) {
            if (i + 1 < 17) GQ_LOAD(i + 1, f2);
            GQ_APPLY(i, f);
            if (i + 1 < 17) { if (i + 2 < 17) GQ_LOAD(i + 2, f); GQ_APPLY(i + 1, f2); }
        }
#undef GQ_LOAD
#undef GQ_APPLY
        bf16_t* o = X1 + (size_t)R * D + 640 + kvh * 192 + g * 4;
        attn_store(sa, o, p.gqa_sink[l * 6 + kvh * 3 + 0] * LOG2E); attn_store(sb, o + 64, p.gqa_sink[l * 6 + kvh * 3 + 1] * LOG2E); attn_store(sc, o + 128, p.gqa_sink[l * 6 + kvh * 3 + 2] * LOG2E);
    } else {
        const int t3 = tk - NTASK_NA - NTASK_GQ, qt = t3 & 15, hb = t3 >> 4, h = hb % 6, b = hb / 6;
        const int R = NLAT + b * CTX + qt * 16 + fr;
        const bf16_t* qp = P + (size_t)R * PWS + COL_NAQ + h * 64 + g * 8;
        const bf16x8 q0 = ld16(qp), q1 = ld16(qp + 32);
        AttnState st; attn_init(st);
        const bf16_t* kc_ = (const bf16_t*)(p.ws + OFF_NAKFC) + (size_t)(b * 6 + h) * 16 * KVT + lane * 8;
        const bf16_t* vc_ = (const bf16_t*)(p.ws + OFF_NAVFC) + (size_t)(b * 6 + h) * 16 * KVT + lane * 8;
#pragma unroll
        for (int pp = 0; pp < 8; ++pp) { kv_load(kc_ + (size_t)(2 * pp) * KVT, kc_ + (size_t)(2 * pp + 1) * KVT, vc_ + (size_t)(2 * pp) * KVT, vc_ + (size_t)(2 * pp + 1) * KVT, f); attn_apply<false>(f, q0, q1, z4, z4, st); }
        attn_store(st, X1 + (size_t)R * D + 256 + h * 64 + g * 4, -INFINITY);
    }
}
template <int CTRL> DEV float dppf(float old, float v) { return __builtin_bit_cast(float, __builtin_amdgcn_update_dpp(__builtin_bit_cast(int, old), __builtin_bit_cast(int, v), CTRL, 0xf, 0xf, false)); }
template <bool FWD> DEV void row_scan(float& a, float& b) {
#define RG_STEP(SHR, SHL) { const float ap = FWD ? dppf<SHR>(1.f, a) : dppf<SHL>(1.f, a); const float bp = FWD ? dppf<SHR>(0.f, b) : dppf<SHL>(0.f, b); b = fmaf(a, bp, b); a = a * ap; }
    RG_STEP(0x111, 0x101) RG_STEP(0x112, 0x102) RG_STEP(0x114, 0x104) RG_STEP(0x118, 0x108)
#undef RG_STEP
}
DEV int rg_bwd_chunk(int pos) { return pos == 0 ? 1 : (pos == 1 ? 0 : 67 - pos); }
DEV void rg_coef(const f32x4& za, const f32x4& zi, const f32x4& ba, const f32x4& bi, const f32x4& spc, const f32x4& xv, f32x4& a, f32x4& b) {
#pragma unroll
    for (int j = 0; j < 4; ++j) {
        const float r = __builtin_amdgcn_rcpf(1.f + __expf(-(za[j] + ba[j])));
        const float ig = __builtin_amdgcn_rcpf(1.f + __expf(-(zi[j] + bi[j])));
        const float la = spc[j] * r;
        const float av = __expf(la);
        const float x2 = 2.f * la;
        float om = x2 * (1.f / 720.f) + (1.f / 120.f); om = om * x2 + (1.f / 24.f); om = om * x2 + (1.f / 6.f); om = om * x2 + 0.5f; om = om * x2 + 1.f; om = -x2 * om;
        if (x2 < -0.25f) om = 1.f - av * av;
        a[j] = av; b[j] = __builtin_amdgcn_sqrtf(om) * (ig * xv[j]);
    }
}
DEV void rg_item(const Params& p, int l, int rt, bf16_t* lds) {
    const int t = tid_(), lane = t & 63, n = t >> 6, g = lane >> 4, fr = lane & 15;
    const bf16_t* P = (const bf16_t*)(p.ws + OFF_P);
    const bool isctx = rt >= 512;
    const int b = isctx ? (rt - 512) >> 1 : rt >> 6, idx = isctx ? (rt - 512) & 1 : 2 + (rt & 63);
    const int L = isctx ? CTX : S, t0 = isctx ? idx * 128 : (idx - 2) * 128, seqbase = isctx ? NLAT + b * CTX : b * S;
    bf16_t* xl = lds + n * (128 * 64);
    {
        const int c = lane & 7, ch0 = n * 64 + c * 8;
        f32x4 cwa[4], cwb[4];
#pragma unroll
        for (int j = 0; j < 4; ++j) { cwa[j] = *(const f32x4*)(p.conv_w + (l * 4 + j) * 256 + ch0); cwb[j] = *(const f32x4*)(p.conv_w + (l * 4 + j) * 256 + ch0 + 4); }
        const f32x4 cba = *(const f32x4*)(p.conv_b + l * 256 + ch0), cbb = *(const f32x4*)(p.conv_b + l * 256 + ch0 + 4);
#pragma unroll 2
        for (int it = 0; it < 16; ++it) {
            const int tok = it * 8 + (lane >> 3), ts = t0 + tok;
            f32x4 acca = cba, accb = cbb;
#pragma unroll
            for (int j = 0; j < 4; ++j) {
                const int tj = ts + j - 2;
                if (tj >= 0 && tj < L) {
                    const uint4 v = *(const uint4*)(P + (size_t)(seqbase + tj) * PWS + COL_RGX + ch0);
                    const f32x4 xa = {__uint_as_float(v.x << 16), __uint_as_float(v.x & 0xffff0000u), __uint_as_float(v.y << 16), __uint_as_float(v.y & 0xffff0000u)};
                    const f32x4 xb = {__uint_as_float(v.z << 16), __uint_as_float(v.z & 0xffff0000u), __uint_as_float(v.w << 16), __uint_as_float(v.w & 0xffff0000u)};
                    acca = acca + cwa[j] * xa; accb = accb + cwb[j] * xb;
                }
            }
            uint4 o; o.x = pk2(acca[0], acca[1]); o.y = pk2(acca[2], acca[3]); o.z = pk2(accb[0], accb[1]); o.w = pk2(accb[2], accb[3]);
            *(uint4*)(xl + tok * 64 + ((c ^ ((tok >> 1) & 7)) * 8)) = o;
        }
    }
    asm volatile("s_waitcnt lgkmcnt(0)" ::: "memory");
    const bf16_t* W = (const bf16_t*)(p.ws + OFF_WRG) + (size_t)(l * 2) * 2 * 4 * 64 * 64;
    const float* C = (const float*)(p.ws + OFF_RGC) + (size_t)(l * 2) * 3 * 256;
    float* AGG = (float*)(p.ws + OFF_AGG) + (size_t)(b * 66) * 1024;
    const int swz = (fr >> 1) & 7;
#pragma unroll 1
    for (int ct = 0; ct < 4; ++ct) {
        const int ch = n * 64 + ct * 16 + g * 4;
        const f32x4 z4 = {0.f, 0.f, 0.f, 0.f};
#pragma unroll
        for (int dir = 0; dir < 2; ++dir) {
            const bf16x8 wa0 = ld16(W + ((size_t)((dir * 2 + 0) * 4 + n) * 64 + ct * 16 + fr) * 64 + g * 8), wa1 = ld16(W + ((size_t)((dir * 2 + 0) * 4 + n) * 64 + ct * 16 + fr) * 64 + 32 + g * 8);
            const bf16x8 wi0 = ld16(W + ((size_t)((dir * 2 + 1) * 4 + n) * 64 + ct * 16 + fr) * 64 + g * 8), wi1 = ld16(W + ((size_t)((dir * 2 + 1) * 4 + n) * 64 + ct * 16 + fr) * 64 + 32 + g * 8);
            const f32x4 ba = *(const f32x4*)(C + (dir * 3 + 0) * 256 + ch), bi = *(const f32x4*)(C + (dir * 3 + 1) * 256 + ch), spc = *(const f32x4*)(C + (dir * 3 + 2) * 256 + ch);
            f32x4 hin = z4, apre = {1.f, 1.f, 1.f, 1.f};
#pragma unroll
            for (int s = 0; s < 8; ++s) {
                const int tt = dir == 0 ? s : 7 - s;
                const int row = tt * 16 + fr;
                const bf16x8 x0 = *(const bf16x8*)(xl + row * 64 + ((g ^ swz) * 8)), x1 = *(const bf16x8*)(xl + row * 64 + (((g | 4) ^ swz) * 8));
                f32x4 za = __builtin_amdgcn_mfma_f32_16x16x32_bf16(wa0, x0, z4, 0, 0, 0); za = __builtin_amdgcn_mfma_f32_16x16x32_bf16(wa1, x1, za, 0, 0, 0);
                f32x4 zi = __builtin_amdgcn_mfma_f32_16x16x32_bf16(wi0, x0, z4, 0, 0, 0); zi = __builtin_amdgcn_mfma_f32_16x16x32_bf16(wi1, x1, zi, 0, 0, 0);
                const uint2 xr = *(const uint2*)(xl + row * 64 + (((ct * 2 + (g >> 1)) ^ swz) * 8) + (g & 1) * 4);
                const f32x4 xv = {__uint_as_float(xr.x << 16), __uint_as_float(xr.x & 0xffff0000u), __uint_as_float(xr.y << 16), __uint_as_float(xr.y & 0xffff0000u)};
                f32x4 a, bb;
                rg_coef(za, zi, ba, bi, spc, xv, a, bb);
                f32x4 h, ac;
#pragma unroll
                for (int j = 0; j < 4; ++j) {
                    float aj = a[j], bj = bb[j];
                    if (dir == 0) row_scan<true>(aj, bj); else row_scan<false>(aj, bj);
                    h[j] = fmaf(aj, hin[j], bj);
                    ac[j] = aj * apre[j];
                }
                {
                    bf16_t* xo = (bf16_t*)(p.ws + OFF_X2) + ((size_t)seqbase + t0 + row) * D + dir * 512 + ch;
                    uint2 o; o.x = pk2(ac[0], ac[1]); o.y = pk2(ac[2], ac[3]); *(uint2*)xo = o;
                    o.x = pk2(h[0], h[1]); o.y = pk2(h[2], h[3]); *(uint2*)(xo + 256) = o;
                }
                const int src = (lane & 48) | (dir == 0 ? 15 : 0);
#pragma unroll
                for (int j = 0; j < 4; ++j) { hin[j] = shl_(h[j], src); apre[j] = shl_(ac[j], src); }
            }
            if (fr == 0) { *(f32x4*)(AGG + (size_t)(idx * 2 + dir) * 512 + ch) = apre; *(f32x4*)(AGG + (size_t)(idx * 2 + dir) * 512 + 256 + ch) = hin; }
        }
    }
}
DEV void rg_final(const Params& p, int l, int rt, float* part  ) {
    const int t = tid_(), cg4 = (t & 63) * 4, tp = t >> 6;
    const bool isctx = rt >= 512;
    const int b = isctx ? (rt - 512) >> 1 : rt >> 6, idx = isctx ? (rt - 512) & 1 : 2 + (rt & 63);
    const float* AGG = (const float*)(p.ws + OFF_AGG) + (size_t)(b * 66) * 1024;
    f32x4 hf = {0.f, 0.f, 0.f, 0.f}, hb = {0.f, 0.f, 0.f, 0.f};
    {
        const int nf = idx, nb = idx == 1 ? 0 : (idx == 0 ? 1 : 67 - idx);
        const int qf = (nf + 3) >> 2, qb = (nb + 3) >> 2;
        f32x4 Af = {1.f, 1.f, 1.f, 1.f}, Bf = {0.f, 0.f, 0.f, 0.f}, Ab = Af, Bb = Bf;
#pragma unroll 4
        for (int q = tp * qf; q < min((tp + 1) * qf, nf); ++q) { const f32x4 A = *(const f32x4*)(AGG + (size_t)(q * 2) * 512 + cg4), B = *(const f32x4*)(AGG + (size_t)(q * 2) * 512 + 256 + cg4); Bf = A * Bf + B; Af = A * Af; }
#pragma unroll 4
        for (int q = tp * qb; q < min((tp + 1) * qb, nb); ++q) { const int cq = rg_bwd_chunk(q); const f32x4 A = *(const f32x4*)(AGG + (size_t)(cq * 2 + 1) * 512 + cg4), B = *(const f32x4*)(AGG + (size_t)(cq * 2 + 1) * 512 + 256 + cg4); Bb = A * Bb + B; Ab = A * Ab; }
        *(f32x4*)(part + ((tp * 2 + 0) * 2 + 0) * 256 + cg4) = Af; *(f32x4*)(part + ((tp * 2 + 0) * 2 + 1) * 256 + cg4) = Bf;
        *(f32x4*)(part + ((tp * 2 + 1) * 2 + 0) * 256 + cg4) = Ab; *(f32x4*)(part + ((tp * 2 + 1) * 2 + 1) * 256 + cg4) = Bb;
        __syncthreads();
#pragma unroll
        for (int k = 0; k < 4; ++k) {
            hf = *(const f32x4*)(part + ((k * 2 + 0) * 2 + 0) * 256 + cg4) * hf + *(const f32x4*)(part + ((k * 2 + 0) * 2 + 1) * 256 + cg4);
            hb = *(const f32x4*)(part + ((k * 2 + 1) * 2 + 0) * 256 + cg4) * hb + *(const f32x4*)(part + ((k * 2 + 1) * 2 + 1) * 256 + cg4);
        }
    }
    const bf16_t* X2 = (const bf16_t*)(p.ws + OFF_X2); const bf16_t* P = (const bf16_t*)(p.ws + OFF_P); bf16_t* X1 = (bf16_t*)(p.ws + OFF_X1);
#pragma unroll 4
    for (int i = 0; i < 32; ++i) {
        const size_t R = (size_t)rt * 128 + i * 4 + tp;
        const uint2 af = *(const uint2*)(X2 + R * D + cg4), bf = *(const uint2*)(X2 + R * D + 256 + cg4), ab = *(const uint2*)(X2 + R * D + 512 + cg4), bb = *(const uint2*)(X2 + R * D + 768 + cg4);
        const uint2 gr = *(const uint2*)(P + R * PWS + COL_GATE + cg4);
#define BLO(u) __uint_as_float((u) << 16)
#define BHI(u) __uint_as_float((u) & 0xffff0000u)
        const float h0 = (BLO(af.x) * hf[0] + BLO(bf.x)) + (BLO(ab.x) * hb[0] + BLO(bb.x));
        const float h1 = (BHI(af.x) * hf[1] + BHI(bf.x)) + (BHI(ab.x) * hb[1] + BHI(bb.x));
        const float h2 = (BLO(af.y) * hf[2] + BLO(bf.y)) + (BLO(ab.y) * hb[2] + BLO(bb.y));
        const float h3 = (BHI(af.y) * hf[3] + BHI(bf.y)) + (BHI(ab.y) * hb[3] + BHI(bb.y));
        uint2 o; o.x = pk2(h0 * gelu_tanh(BLO(gr.x)), h1 * gelu_tanh(BHI(gr.x))); o.y = pk2(h2 * gelu_tanh(BLO(gr.y)), h3 * gelu_tanh(BHI(gr.y)));
#undef BLO
#undef BHI
        *(uint2*)(X1 + R * D + cg4) = o;
    }
}
DEV void ph_rgagg(const Params& p, int l, bf16_t* lds) {
    for (int rt = bid_(); rt < 528; rt += gridDim.x) { rg_item(p, l, rt, lds); __syncthreads(); }
}

DEV void outproj_item(const Params& p_, int l, int rt, bf16_t* lds, float* stat  ) {
    const Params& p = kp_();
    const int t = tid_(), lane = t & 63, w = t >> 6, wm = w >> 1, wn = w & 1, fq = lane >> 4, fr = lane & 15;
    const bf16_t* A = (const bf16_t*)(p.ws + OFF_X1) + (size_t)(rt * 128) * D;
    const bool isctx = rt >= 512;
    const float* g1 = modvec(p, l, rt * 128, 2);
    __syncthreads();
    rg_final(p, l, rt, (float*)lds);
    asm volatile("s_waitcnt vmcnt(0)" ::: "memory");
    __syncthreads();
    __builtin_amdgcn_fence(__ATOMIC_ACQUIRE, "agent");
#pragma unroll 1
    for (int pass = 0; pass < 4; ++pass) {
        const bf16_t* Bt = (const bf16_t*)(p.ws + OFF_WOUTT) + ((size_t)l * 1024 + pass * 256) * 1024;
        const unsigned toff = (unsigned)(((tid_() >> 2) * 1024 + gemm_src_chunk(tid_())) * 2);
        f32x4 acc[4][8]; zero_acc(acc);
        gemm_mainloop(A, toff, toff + 64 * D * 2, Bt, toff, 1024, 32, lds, acc);
#pragma unroll
        for (int mt = 0; mt < 4; ++mt) {
            const int rl = wm * 64 + mt * 16 + fr, R = rt * 128 + rl;
            const float* xin = (l == 0) ? (isctx ? p.ctx + (size_t)(R - NLAT) * D : p.x + (size_t)R * D) : xres_row(p, R);
            float* xo = xres_row(p, R);
            float s = 0.f, q = 0.f;
#pragma unroll
            for (int nt = 0; nt < 8; ++nt) {
                const int col = pass * 256 + wn * 128 + nt * 16 + fq * 4;
                const f32x4 xv = *(const f32x4*)(xin + col), gv = *(const f32x4*)(g1 + col);
                const f32x4 u = xv * ALPHA + gv * acc[mt][nt];
                *(f32x4*)(xo + col) = u;
                s += (u[0] + u[1]) + (u[2] + u[3]); q += (u[0] * u[0] + u[1] * u[1]) + (u[2] * u[2] + u[3] * u[3]);
            }
            s += shx(s, 16); s += shx(s, 32); q += shx(q, 16); q += shx(q, 32);
            if (fq == 0) { float* sp = stat + (wn * 128 + rl) * 2; if (pass == 0) { sp[0] = s; sp[1] = q; } else { sp[0] += s; sp[1] += q; } }
        }
    }
    asm volatile("s_waitcnt vmcnt(0)" ::: "memory");
    __syncthreads();
    __builtin_amdgcn_fence(__ATOMIC_ACQUIRE, "agent");
    {
        bf16_t* X2 = (bf16_t*)(p.ws + OFF_X2);
        const bf16_t* WRh = (const bf16_t*)(p.ws + OFF_WR) + (size_t)(l * 2) * 48 * 1024 + (size_t)fr * 1024 + fq * 8;
        const bf16_t* WRl = WRh + 48 * 1024;
        float* vec = (float*)((unsigned char*)lds + 24576);
        {
            const float* lg = p.ln1_g + l * D; const float* lb = p.ln1_b + l * D;
            const float* sh2 = modvec(p, l, rt * 128, 3); const float* sc2 = modvec(p, l, rt * 128, 4);
            const int k4 = t * 4;
            *(f32x4*)(vec + k4) = *(const f32x4*)(lg + k4); *(f32x4*)(vec + 1024 + k4) = *(const f32x4*)(lb + k4);
            *(f32x4*)(vec + 2048 + k4) = *(const f32x4*)(sc2 + k4) + 1.f; *(f32x4*)(vec + 3072 + k4) = *(const f32x4*)(sh2 + k4);
        }
        float mean[2], rstd[2];
#pragma unroll
        for (int tm = 0; tm < 2; ++tm) {
            const int rl = w * 32 + tm * 16 + fr;
            float s = 0.f, q = 0.f;
#pragma unroll
            for (int i = 0; i < 2; ++i) { s += stat[(i * 128 + rl) * 2]; q += stat[(i * 128 + rl) * 2 + 1]; }
            mean[tm] = s * (1.f / D);
            rstd[tm] = rsqrtf(fmaxf(q * (1.f / D) - mean[tm] * mean[tm], 0.f) + LN_EPS);
        }
        __syncthreads();
        float* xr0 = xres_row(p, rt * 128 + w * 32 + fr) + fq * 8;
        float* xr1 = xres_row(p, rt * 128 + w * 32 + 16 + fr) + fq * 8;
        bf16_t* h20 = X2 + (size_t)(rt * 128 + w * 32 + fr) * D + fq * 8; bf16_t* h21 = h20 + (size_t)16 * D;
        f32x4 lacc[3][2];
#pragma unroll
        for (int a = 0; a < 3; ++a) { lacc[a][0] = (f32x4){0.f, 0.f, 0.f, 0.f}; lacc[a][1] = (f32x4){0.f, 0.f, 0.f, 0.f}; }
        f32x4 nu00 = *(const f32x4*)xr0, nu01 = *(const f32x4*)(xr0 + 4), nu10 = *(const f32x4*)xr1, nu11 = *(const f32x4*)(xr1 + 4);
        bf16x8 nwh0 = *(const bf16x8*)(WRh), nwh1 = *(const bf16x8*)(WRh + 16 * 1024), nwh2 = *(const bf16x8*)(WRh + 32 * 1024);
        bf16x8 nwl0 = *(const bf16x8*)(WRl), nwl1 = *(const bf16x8*)(WRl + 16 * 1024), nwl2 = *(const bf16x8*)(WRl + 32 * 1024);
#pragma unroll 2
        for (int ks = 0; ks < 32; ++ks) {
            const f32x4 u00 = nu00, u01 = nu01, u10 = nu10, u11 = nu11;
            const bf16x8 wh0 = nwh0, wh1 = nwh1, wh2 = nwh2, wl0 = nwl0, wl1 = nwl1, wl2 = nwl2;
            if (ks + 1 < 32) {
                const int ko = (ks + 1) * 32;
                nu00 = *(const f32x4*)(xr0 + ko); nu01 = *(const f32x4*)(xr0 + ko + 4); nu10 = *(const f32x4*)(xr1 + ko); nu11 = *(const f32x4*)(xr1 + ko + 4);
                nwh0 = *(const bf16x8*)(WRh + ko); nwh1 = *(const bf16x8*)(WRh + 16 * 1024 + ko); nwh2 = *(const bf16x8*)(WRh + 32 * 1024 + ko);
                nwl0 = *(const bf16x8*)(WRl + ko); nwl1 = *(const bf16x8*)(WRl + 16 * 1024 + ko); nwl2 = *(const bf16x8*)(WRl + 32 * 1024 + ko);
            }
            const int k = ks * 32 + fq * 8;
            const f32x4 g0 = *(const f32x4*)(vec + k), g1v = *(const f32x4*)(vec + k + 4), b0 = *(const f32x4*)(vec + 1024 + k), b1 = *(const f32x4*)(vec + 1024 + k + 4);
            const f32x4 c0 = *(const f32x4*)(vec + 2048 + k), c1 = *(const f32x4*)(vec + 2048 + k + 4), s0 = *(const f32x4*)(vec + 3072 + k), s1 = *(const f32x4*)(vec + 3072 + k + 4);
            bf16x8 hh0, hl0, hh1, hl1;
            {
                const f32x4 x0 = (u00 - mean[0]) * rstd[0] * g0 + b0, x1 = (u01 - mean[0]) * rstd[0] * g1v + b1;
                *(f32x4*)(xr0 + ks * 32) = x0; *(f32x4*)(xr0 + ks * 32 + 4) = x1;
                const f32x4 h0 = x0 * c0 + s0, h1 = x1 * c1 + s1;
#pragma unroll
                for (int e = 0; e < 4; ++e) { const bf16_t a = f2bf(h0[e]), b = f2bf(h1[e]); hh0[e] = (short)a; hh0[4 + e] = (short)b; hl0[e] = (short)f2bf(h0[e] - bf2f(a)); hl0[4 + e] = (short)f2bf(h1[e] - bf2f(b)); }
                *(bf16x8*)(h20 + ks * 32) = hh0;
            }
            {
                const f32x4 x0 = (u10 - mean[1]) * rstd[1] * g0 + b0, x1 = (u11 - mean[1]) * rstd[1] * g1v + b1;
                *(f32x4*)(xr1 + ks * 32) = x0; *(f32x4*)(xr1 + ks * 32 + 4) = x1;
                const f32x4 h0 = x0 * c0 + s0, h1 = x1 * c1 + s1;
#pragma unroll
                for (int e = 0; e < 4; ++e) { const bf16_t a = f2bf(h0[e]), b = f2bf(h1[e]); hh1[e] = (short)a; hh1[4 + e] = (short)b; hl1[e] = (short)f2bf(h0[e] - bf2f(a)); hl1[4 + e] = (short)f2bf(h1[e] - bf2f(b)); }
                *(bf16x8*)(h21 + ks * 32) = hh1;
            }
#define RT_MMA(ft, WH, WL) do { \
            lacc[ft][0] = __builtin_amdgcn_mfma_f32_16x16x32_bf16(WH, hh0, lacc[ft][0], 0, 0, 0); lacc[ft][0] = __builtin_amdgcn_mfma_f32_16x16x32_bf16(WL, hh0, lacc[ft][0], 0, 0, 0); lacc[ft][0] = __builtin_amdgcn_mfma_f32_16x16x32_bf16(WH, hl0, lacc[ft][0], 0, 0, 0); \
            lacc[ft][1] = __builtin_amdgcn_mfma_f32_16x16x32_bf16(WH, hh1, lacc[ft][1], 0, 0, 0); lacc[ft][1] = __builtin_amdgcn_mfma_f32_16x16x32_bf16(WL, hh1, lacc[ft][1], 0, 0, 0); lacc[ft][1] = __builtin_amdgcn_mfma_f32_16x16x32_bf16(WH, hl1, lacc[ft][1], 0, 0, 0); } while (0)
            RT_MMA(0, wh0, wl0); RT_MMA(1, wh1, wl1); RT_MMA(2, wh2, wl2);
#undef RT_MMA
        }
        __syncthreads();
        float* lt = (float*)lds;
        int* lcnt = (int*)((unsigned char*)lds + 24576); int* lbase = lcnt + 32;
        if (t < 32) lcnt[t] = 0;
#pragma unroll
        for (int ft = 0; ft < 3; ++ft)
#pragma unroll
            for (int tm = 0; tm < 2; ++tm)
#pragma unroll
                for (int j = 0; j < 4; ++j) lt[(w * 32 + tm * 16 + fr) * 48 + ft * 16 + fq * 4 + j] = lacc[ft][tm][j];
        __syncthreads();
        int E0 = 0, E1 = 0, r0 = 0, r1 = 0; float w0 = 0.f, w1 = 0.f;
        const int rl = w * 32 + (lane & 31), R = rt * 128 + rl;
        if (lane < 32) {
            const float* lr = lt + rl * 48;
            int gi = 0; float gm = lr[0] + p.router_g_b[l * 4];
            float gl[4]; gl[0] = gm;
#pragma unroll
            for (int j = 1; j < 4; ++j) { gl[j] = lr[j] + p.router_g_b[l * 4 + j]; if (gl[j] > gm) { gm = gl[j]; gi = j; } }
            float gs = 0.f;
#pragma unroll
            for (int j = 0; j < 4; ++j) gs += expf(gl[j] - gm);
            const float ptop = 1.f / gs;
            int e0 = 0, e1 = 0; float m0 = -INFINITY, m1 = -INFINITY;
            for (int j = 0; j < 8; ++j) {
                const float v = lr[4 + gi * 8 + j] + p.router_e_b[l * 32 + gi * 8 + j];
                if (v > m0) { m1 = m0; e1 = e0; m0 = v; e0 = j; } else if (v > m1) { m1 = v; e1 = j; }
            }
            const float ex = expf(m1 - m0);
            w0 = ptop / (1.f + ex); w1 = ptop * ex / (1.f + ex);
            E0 = gi * 8 + e0; E1 = gi * 8 + e1;
            r0 = atomicAdd(lcnt + E0, 1); r1 = atomicAdd(lcnt + E1, 1);
        }
        __syncthreads();
        if (t < 32) { const int c = lcnt[t]; lbase[t] = c ? (int)atomicAdd((unsigned*)(p.ws + OFF_CTL) + CW_CNT + l * 32 + t, (unsigned)c) : 0; }
        __syncthreads();
        if (lane < 32) {
            int* rte = (int*)(p.ws + OFF_RTE); float* rtw = (float*)(p.ws + OFF_RTW);
            int* list = (int*)(p.ws + OFF_LIST);
            rte[R * 2] = E0; rte[R * 2 + 1] = E1; rtw[R * 2] = w0; rtw[R * 2 + 1] = w1;
            list[(size_t)E0 * LISTCAP + lbase[E0] + r0] = R * 2;
            list[(size_t)E1 * LISTCAP + lbase[E1] + r1] = R * 2 + 1;
        }
    }
}
DEV void ph_outproj(const Params& p, int l, bf16_t* lds, float* stat  ) {
    for (int rt = bid_(); rt < 512; rt += gridDim.x) { outproj_item(p, l, rt, lds, stat); __syncthreads(); }
}

DEV void moe1_item(const Params& p_, int l, int e, int jb, int pass, int item, int cnt, bf16_t* lds) {
    const Params& p = kp_();
    const int t = tid_(), lane = t & 63, w = t >> 6, wm = w >> 1, wn = w & 1, fq = lane >> 4, fr = lane & 15;
    const int* list = (const int*)(p.ws + OFF_LIST) + (size_t)e * LISTCAP;
    const bf16_t* X2 = (const bf16_t*)(p.ws + OFF_X2);
    bf16_t* Hs = (bf16_t*)(p.ws + OFF_P) + (size_t)item * 128 * FF;
    unsigned ao0, ao1;
    { const int s0 = jb * 128 + (t >> 2), s1 = s0 + 64;
      const int tok0 = s0 < cnt ? (list[s0] >> 1) : 0, tok1 = s1 < cnt ? (list[s1] >> 1) : 0;
      ao0 = (unsigned)((tok0 * D + gemm_src_chunk(t)) * 2); ao1 = (unsigned)((tok1 * D + gemm_src_chunk(t)) * 2); }
    const bf16_t* Bt = (const bf16_t*)(p.ws + OFF_WGU) + ((size_t)e * 1024 + pass * 256) * 1024;
    f32x4 acc[4][8]; zero_acc(acc);
    gemm_mainloop(X2, ao0, ao1, Bt, (unsigned)(((t >> 2) * 1024 + gemm_src_chunk(t)) * 2), 1024, 32, lds, acc);
#pragma unroll
    for (int mt = 0; mt < 4; ++mt) {
        const int rl = wm * 64 + mt * 16 + fr;
#pragma unroll
        for (int nt = 0; nt < 4; ++nt) {
            const f32x4 gv = acc[mt][nt], uv = acc[mt][nt + 4];
            float hv[4];
#pragma unroll
            for (int jj = 0; jj < 4; ++jj) hv[jj] = gv[jj] * __builtin_amdgcn_rcpf(1.f + __expf(-gv[jj])) * uv[jj];
            uint2 o; o.x = pk2(hv[0], hv[1]); o.y = pk2(hv[2], hv[3]);
            *(uint2*)(Hs + (size_t)rl * FF + pass * 128 + wn * 64 + nt * 16 + fq * 4) = o;
        }
    }
}
DEV void moe2_item(const Params& p_, int l, int e, int jb, int pass, int item, int cnt, bf16_t* lds) {
    const Params& p = kp_();
    const int t = tid_(), lane = t & 63, w = t >> 6, wm = w >> 1, wn = w & 1, fq = lane >> 4, fr = lane & 15;
    const int* list = (const int*)(p.ws + OFF_LIST) + (size_t)e * LISTCAP;
    const bf16_t* Hs = (const bf16_t*)(p.ws + OFF_P) + (size_t)item * 128 * FF;
    const unsigned hoff = (unsigned)(((t >> 2) * FF + gemm_src_chunk(t)) * 2);
    const float* rtw = (const float*)(p.ws + OFF_RTW);
    bf16_t* Y = (bf16_t*)(p.ws + OFF_Y);
    const bf16_t* Bt = (const bf16_t*)(p.ws + OFF_WD) + ((size_t)e * 1024 + pass * 256) * FF;
    f32x4 acc[4][8]; zero_acc(acc);
    gemm_mainloop(Hs, hoff, hoff + 64 * FF * 2, Bt, hoff, FF, 16, lds, acc);
#pragma unroll
    for (int mt = 0; mt < 4; ++mt) {
        const int s = jb * 128 + wm * 64 + mt * 16 + fr;
        if (s < cnt) {
            const int ent = list[s];
            const float gw = rtw[ent];
            bf16_t* yo = Y + (size_t)ent * D + pass * 256 + wn * 128 + fq * 4;
#pragma unroll
            for (int nt = 0; nt < 8; ++nt) { const f32x4 v = acc[mt][nt] * gw; uint2 o; o.x = pk2(v[0], v[1]); o.y = pk2(v[2], v[3]); *(uint2*)(yo + nt * 16) = o; }
        }
    }
}
template <int STAGE> DEV void ph_moe(const Params& p, int l, bf16_t* lds, int* s_pref  , int* s_cnt  , int* slot, int ph) {
    const unsigned* cnt = (const unsigned*)(p.ws + OFF_CTL) + CW_CNT + l * 32;
    if (tid_() == 0) { int a = 0; for (int e = 0; e < 32; ++e) { const int c = (int)cnt[e]; s_cnt[e] = c; s_pref[e] = a; a += (c + 127) >> 7; } s_pref[32] = a; }
    __syncthreads();
#pragma unroll 1
    for (int hop = 0; hop < 8; ++hop) {
        const int xq = (bid_() + hop) & 7;
        unsigned* ctr = (unsigned*)(p.ws + OFF_CTL) + CW_Q + ph * 8 + xq;
        const int n0 = (s_cnt[xq] + 127) >> 7, n1 = (s_cnt[xq + 8] + 127) >> 7, n2 = (s_cnt[xq + 16] + 127) >> 7, n3 = (s_cnt[xq + 24] + 127) >> 7;
        const int nloc = (n0 + n1 + n2 + n3) * 4;
        int it = q_pull(ctr, slot);
        while (it < nloc) {
            int nreg = 0;
            if (tid_() == 0) nreg = (int)atomicAdd(ctr, 1u);
            const int pass = it & 3, ib = it >> 2;
            int e, jb;
            if (ib < n0) { e = xq; jb = ib; } else if (ib < n0 + n1) { e = xq + 8; jb = ib - n0; } else if (ib < n0 + n1 + n2) { e = xq + 16; jb = ib - n0 - n1; } else { e = xq + 24; jb = ib - n0 - n1 - n2; }
            if (STAGE == 1) moe1_item(p, l, e, jb, pass, s_pref[e] + jb, s_cnt[e], lds); else moe2_item(p, l, e, jb, pass, s_pref[e] + jb, s_cnt[e], lds);
            it = q_publish(nreg, slot);
        }
    }
    __syncthreads();
}

DEV void ph_rowin(const Params& p, int l, bf16_t* lds, int* slot, int ph) {
    const int np = l == 0 ? 9 : 5, nci = 16 * np, ntot = nci + 1024;
    unsigned* ctr = (unsigned*)(p.ws + OFF_CTL) + CW_Q + ph * 8;
    const int w = tid_() >> 6;
    for (;;) {
        const int it = q_pull(ctr, slot);
        if (it >= ntot) break;
        if (it < nci) {
            const int rt = 512 + it / np, pass = it % np;
            for (int r = w * NRW; r < 128; r += 4 * NRW) { if (l == 0) rowop<0, true>(p, 0, rt * 128 + r); else rowop<1, false>(p, 1, rt * 128 + r); }
            asm volatile("s_waitcnt vmcnt(0)" ::: "memory");
            __syncthreads();
            __builtin_amdgcn_fence(__ATOMIC_ACQUIRE, "agent");
            inproj_item(p, l, rt, pass, lds);
        } else {
            const int r0 = (it - nci) * 64;
            for (int r = w * NRW; r < 64; r += 4 * NRW) { if (l == 0) rowop<0, true>(p, 0, r0 + r); else rowop<1, true>(p, 1, r0 + r); }
        }
    }
}
DEV void ph_inproj2(const Params& p, int l, bf16_t* lds, int* slot, int ph) {
    const int xcd = bid_() & 7;
    unsigned* ctr = (unsigned*)(p.ws + OFF_CTL) + CW_Q + ph * 8 + xcd;
    const int ntot = 2 + 768 + (l == 0 ? 32 : 0);
    int it = q_pull(ctr, slot);
    while (it < ntot) {
        int nreg = 0;
        if (tid_() == 0) nreg = (int)atomicAdd(ctr, 1u);
        if (it < 2) { rg_item(p, l, 512 + 2 * xcd + it, lds); }
        else if (it < 770) {
            const int q = it - 2, m = q >> 2, r = q & 3;
            if (r < 3) { const int i = m * 3 + r; inproj_item(p, l, xcd * 64 + i / 9, i % 9, lds); }
            else { __syncthreads(); expert_conv_item(p, l, xcd * 192 + m, (float*)lds); }
        }
        else { const int i = it - 770, w = tid_() >> 6;
            const int tk = i < 24 ? NTASK_NA + NTASK_GQ + (xcd * 24 + i) * 4 + w : NTASK_NA + NTASK_GQ + NTASK_CNA + (xcd * 8 + (i - 24)) * 4 + w;
            attn_task(p, l, tk, (const float*)lds); }
        it = q_publish(nreg, slot);
    }
}
DEV void ph_mixer(const Params& p, int l, bf16_t* lds, float* stat, int* slot, int ph) {
    const int xcd = bid_() & 7;
    unsigned* ctr = (unsigned*)(p.ws + OFF_CTL) + CW_Q + ph * 8 + xcd;
    const int n0 = l == 0 ? 2 : 0, n1 = n0 + 64, n2 = n1 + 256, n3 = n2 + 768, ntot = n3;
    bool rpb_ok = false;
    float* rpb2 = (float*)lds;
    int it = q_pull(ctr, slot);
    while (it < ntot) {
        int nreg = 0;
        if (tid_() == 0) nreg = (int)atomicAdd(ctr, 1u);
        if (it < n0) { outproj_item(p, l, 512 + 2 * xcd + it, lds, stat); rpb_ok = false; }
        else if (it < n1) { rg_item(p, l, xcd * 64 + (it - n0), lds); rpb_ok = false; }
        else if (it < n3) {
            if (!rpb_ok) { for (int i = tid_(); i < 6 * 15 * 31; i += 256) rpb2[i] = p.na_rpb[(size_t)l * 6 * 15 * 31 + i] * LOG2E; __syncthreads(); rpb_ok = true; }
            const int w = tid_() >> 6;
            int tk;
            if (it < n2) { const int i = it - n1; tk = NTASK_NA + (2 * xcd + (i >> 7)) * 512 + (i & 127) * 4 + w; }
            else { const int i = it - n2; tk = (6 * xcd + (i >> 7)) * 512 + (i & 127) * 4 + w; }
            attn_task(p, l, tk, rpb2);
        }
        it = q_publish(nreg, slot);
    }
}

#define XB_TMO      128
#define XB_XCNT(j)  (256  + 64 * (j))
#define XB_XSUB(j)  (1280 + 64 * (j))
#define XB_XGEN(j)  (2304 + 64 * (j))
#define XB_TOP      3328
#define XB_TOPGEN   3392
#define XCD_BAR_WORDS 3456
#define XB_SPIN_CAP (1u << 20)
DEV unsigned xb_ld(unsigned* p) { return __hip_atomic_load(p, __ATOMIC_RELAXED, __HIP_MEMORY_SCOPE_AGENT); }
DEV unsigned xb_add(unsigned* p, unsigned v) { return __hip_atomic_fetch_add(p, v, __ATOMIC_RELAXED, __HIP_MEMORY_SCOPE_AGENT); }
DEV unsigned xb_xcc_id() { return (unsigned)__builtin_amdgcn_s_getreg((3 << 11) | 20) & 0xFu; }
#define XB_SPIN(cond, bar) do { unsigned _sp = 0; while (cond) { __builtin_amdgcn_s_sleep(1); \
    if ((++_sp & 255u) == 0u) { if (xb_ld(&(bar)[XB_TMO])) break; if (_sp > XB_SPIN_CAP) { atomicAdd(&(bar)[XB_TMO], 1u); break; } } } } while (0)
struct XcdBarrier { unsigned* bar; unsigned x; volatile LAS unsigned* st; };
DEV XcdBarrier xcd_barrier_post(unsigned* bar, volatile LAS unsigned* st) {
    XcdBarrier b; b.bar = bar; b.x = xb_xcc_id(); b.st = st;
    if (tid_() == 0) (void)xb_add(&bar[XB_XCNT(b.x)], 1u);
    return b;
}
DEV void xcd_barrier_complete(unsigned* bar, unsigned x, unsigned& nloc, unsigned& nx) {
    const unsigned G = gridDim.x * gridDim.y * gridDim.z;
    unsigned sum, cnt, mine, sp = 0u;
    for (;;) {
        sum = 0u; cnt = 0u; mine = 0u;
#pragma unroll
        for (unsigned j = 0; j < 16; ++j) { const unsigned c = xb_ld(&bar[XB_XCNT(j)]); sum += c; cnt += (c > 0u) ? 1u : 0u; mine = (j == x) ? c : mine; }
        if (sum == G) break;
        __builtin_amdgcn_s_sleep(1);
        if ((++sp & 255u) == 0u) { if (xb_ld(&bar[XB_TMO])) break; if (sp > XB_SPIN_CAP) { atomicAdd(&bar[XB_TMO], 1u); break; } }
    }
    nloc = mine > 0u ? mine : 1u; nx = cnt > 0u ? cnt : 1u;
}
DEV void xcd_barrier(const XcdBarrier& b) {
    asm volatile("s_waitcnt vmcnt(0)" ::: "memory");
    __syncthreads();
    if (tid_() == 0) {
        unsigned* bar = b.bar;
        __builtin_amdgcn_s_waitcnt(0);
        unsigned nloc = b.st[0], nx = b.st[1];
        if (nloc == 0u) { xcd_barrier_complete(bar, b.x, nloc, nx); b.st[0] = nloc; b.st[1] = nx; }
        const unsigned old = xb_add(&bar[XB_XSUB(b.x)], 1u);
        const unsigned gen = old / nloc;
        if (old + 1u == (gen + 1u) * nloc) {
            __builtin_amdgcn_fence(__ATOMIC_RELEASE, "agent");
            asm volatile("s_waitcnt vmcnt(0)" ::: "memory");
            const unsigned og = xb_add(&bar[XB_TOP], 1u);
            const unsigned tg = og / nx;
            if (og + 1u == (tg + 1u) * nx) xb_add(&bar[XB_TOPGEN], 1u);
            else XB_SPIN(xb_ld(&bar[XB_TOPGEN]) == tg, bar);
            __builtin_amdgcn_fence(__ATOMIC_ACQUIRE, "agent");
            xb_add(&bar[XB_XGEN(b.x)], 1u);
            asm volatile("s_waitcnt vmcnt(0)" ::: "memory");
        } else {
            XB_SPIN(xb_ld(&bar[XB_XGEN(b.x)]) == gen, bar);
            __builtin_amdgcn_fence(__ATOMIC_ACQUIRE, "agent");
            asm volatile("s_waitcnt vmcnt(0)" ::: "memory");
        }
    }
    __syncthreads();
}

namespace cg = cooperative_groups;
constexpr int SMEM_STAT = GEMM_LDS_BYTES;
constexpr int SMEM_BYTES = GEMM_LDS_BYTES + 2048 + 512;
constexpr int NPHASE = 14;
__global__ void __launch_bounds__(256, 2) mega(Params p, int ph_lo, int ph_hi) {
    extern __shared__ __attribute__((aligned(16))) unsigned char smem[];
    bf16_t* lds = (bf16_t*)smem;
    float* stat = (float*)(smem + SMEM_STAT);
    int* s_pref = (int*)(smem + SMEM_STAT + 2048); int* s_cnt = s_pref + 40;
    int* qslot = (int*)(smem + SMEM_STAT + 2048 + 416);
    volatile LAS unsigned* bst = (volatile LAS unsigned*)(LAS unsigned char*)(smem + SMEM_STAT + 2048 + 400);
    if (tid_() < 2) bst[tid_()] = 0u;
    __syncthreads();
    (void)xcd_barrier_post((unsigned*)(kp_().ws + OFF_CTL + 4096), bst);
#define GRID_BAR() do { XcdBarrier xb_; xb_.bar = (unsigned*)(kp_().ws + OFF_CTL + 4096); xb_.x = xb_xcc_id(); \
        xb_.st = (volatile LAS unsigned*)(LAS unsigned char*)(smem + SMEM_STAT + 2048 + 400); xcd_barrier(xb_); } while (0)
#define IN(k) (ph_lo <= (k) && (k) < ph_hi)
#define SEAM(k) do { if (IN(k) && IN((k) + 1)) { if ((k) == 0) cg::this_grid().sync(); else GRID_BAR(); } } while (0)
    if (IN(0)) {
        ph_mod(kp_(), (float*)smem); __syncthreads();
        ph_rope(kp_());
        ph_routerw(kp_());
        ph_rgprep(kp_());
        ph_transpose(kp_().w_in, (bf16_t*)(kp_().ws + OFF_WINT), 1024, 2304, 0, 2, (size_t)1024 * 2304, (size_t)2304 * 1024, (float*)smem);
        ph_transpose(kp_().w_out, (bf16_t*)(kp_().ws + OFF_WOUTT), 1024, 1024, 0, 2, (size_t)1024 * 1024, (size_t)1024 * 1024, (float*)smem);
    }
    SEAM(0);
#define LAYER_BODY(l, pb) { \
        if (IN(pb + 0)) ph_rowin(kp_(), l, lds, qslot, pb + 0); \
        SEAM(pb + 0); \
        if (IN(pb + 1)) ph_inproj2(kp_(), l, lds, qslot, pb + 1); \
        SEAM(pb + 1); \
        if (IN(pb + 2)) ph_mixer(kp_(), l, lds, stat, qslot, pb + 2); \
        SEAM(pb + 2); \
        if (IN(pb + 3)) ph_outproj(kp_(), l, lds, stat); \
        SEAM(pb + 3); \
        if (IN(pb + 4)) ph_moe<1>(kp_(), l, lds, s_pref, s_cnt, qslot, pb + 4); \
        SEAM(pb + 4); \
        if (IN(pb + 5)) ph_moe<2>(kp_(), l, lds, s_pref, s_cnt, qslot, pb + 5); \
        SEAM(pb + 5); \
    }
    LAYER_BODY(0, 1)
    LAYER_BODY(1, 7)
#undef LAYER_BODY
    if (IN(NPHASE - 1)) ph_rowop<2>(kp_(), 2, NLAT);
#undef IN
#undef SEAM
}

#ifndef ONE_LAUNCH
#define ONE_LAUNCH 1
#endif
extern "C" void kernel_launch(void* const* d_in, const int* in_sizes, int n_in, void* d_out, int out_size, void* d_ws, size_t ws_size, hipStream_t stream) {
    if (n_in != 28 || ws_size < WS_TOTAL || out_size != NLAT * D) { fprintf(stderr, "kernel_launch: unexpected shapes / workspace (%d inputs, ws %zu need %zu)\n", n_in, ws_size, (size_t)WS_TOTAL); return; }
    static int grid = 0;
    if (grid == 0) {
        int dev = 0, cus = 0, per_cu = 0;
        (void)hipGetDevice(&dev);
        (void)hipDeviceGetAttribute(&cus, hipDeviceAttributeMultiprocessorCount, dev);
        (void)hipFuncSetAttribute((const void*)mega, hipFuncAttributeMaxDynamicSharedMemorySize, SMEM_BYTES);
        (void)hipOccupancyMaxActiveBlocksPerMultiprocessor(&per_cu, (const void*)mega, 256, SMEM_BYTES);
        if (per_cu > 2) per_cu = 2;
        grid = cus * per_cu;
        if (grid <= 0) { fprintf(stderr, "kernel_launch: occupancy query gave %d blocks per CU on %d CUs\n", per_cu, cus); grid = -1; }
    }
    if (grid < 0) return;
    Params p{};
    const float** pp = (const float**)&p;
    for (int i = 0; i < 28; ++i) pp[i] = (const float*)d_in[i];
    p.out = (float*)d_out; p.ws = (unsigned char*)d_ws;
    (void)hipMemsetAsync((unsigned char*)d_ws + OFF_CTL, 0, CTL_BYTES, stream);
#if ONE_LAUNCH
    int lo = 0, hi = NPHASE;
    void* args[] = {(void*)&p, (void*)&lo, (void*)&hi};
    hipError_t e = hipLaunchCooperativeKernel((const void*)mega, dim3(grid), dim3(256), args, SMEM_BYTES, stream);
    if (e != hipSuccess) fprintf(stderr, "kernel_launch: cooperative launch failed: %s (grid %d)\n", hipGetErrorString(e), grid);
#else
    for (int ph = 0; ph < NPHASE; ++ph) mega<<<grid, 256, SMEM_BYTES, stream>>>(p, ph, ph + 1);
#endif
}
```

```cpp
#include <hip/hip_runtime.h>
#include <hip/hip_cooperative_groups.h>
#include <stdint.h>
#include <cstdio>

typedef unsigned short bf16_t;
typedef short bf16x8 __attribute__((ext_vector_type(8)));
typedef float f32x4 __attribute__((ext_vector_type(4)));

#define DEV __device__ __forceinline__

constexpr int D = 1024, NB = 8, S = 8192, CTX = 256;
constexpr int NLAT = NB * S, NCTX = NB * CTX, NTOK = NLAT + NCTX;
constexpr int PWS = 1280;
constexpr int COL_RGX = 0, COL_GATE = 256, COL_NAQ = 512, COL_GQ = 896;
constexpr int KVT = 1024;
constexpr int NE = 32, FF = 512;
constexpr int LISTCAP = NTOK;
constexpr float ALPHA = 1.4142135623730951f;
constexpr float LN_EPS = 1e-5f;

constexpr size_t al256(size_t x) { return (x + 255) & ~(size_t)255; }
constexpr size_t OFF_CTL   = 0;
constexpr size_t CTL_BYTES = 4096 + 16384;
constexpr size_t OFF_MOD   = OFF_CTL + CTL_BYTES;
constexpr size_t OFF_ROPE  = al256(OFF_MOD + (size_t)2 * 9 * 6144 * 4);
constexpr size_t OFF_RTE   = al256(OFF_ROPE + (size_t)2 * 128 * 16 * 4);
constexpr size_t OFF_RTW   = al256(OFF_RTE + (size_t)NTOK * 8);
constexpr size_t OFF_LIST  = al256(OFF_RTW + (size_t)NTOK * 8);
constexpr size_t OFF_WR    = al256(OFF_LIST + (size_t)NE * LISTCAP * 4);
constexpr size_t OFF_WRG   = al256(OFF_WR + (size_t)2 * 2 * 48 * 1024 * 2);
constexpr size_t OFF_RGC   = al256(OFF_WRG + (size_t)2 * 2 * 2 * 4 * 64 * 64 * 2);
constexpr size_t OFF_AGG   = al256(OFF_RGC + (size_t)2 * 2 * 3 * 256 * 4);
constexpr size_t OFF_WINT  = al256(OFF_AGG + (size_t)NB * 66 * 2 * 2 * 256 * 4);
constexpr size_t OFF_WOUTT = al256(OFF_WINT + (size_t)2 * 2304 * 1024 * 2);
constexpr size_t OFF_WGU   = al256(OFF_WOUTT + (size_t)2 * 1024 * 1024 * 2);
constexpr size_t OFF_WD    = al256(OFF_WGU + (size_t)NE * 1024 * 1024 * 2);
constexpr size_t OFF_XCTX  = al256(OFF_WD + (size_t)NE * 1024 * 512 * 2);
constexpr size_t OFF_X1    = al256(OFF_XCTX + (size_t)NCTX * D * 4);
constexpr size_t OFF_X2    = al256(OFF_X1 + (size_t)NTOK * D * 2);
constexpr size_t OFF_P     = al256(OFF_X2 + (size_t)NTOK * D * 2);
constexpr size_t OFF_NAKF  = al256(OFF_P + (size_t)NTOK * PWS * 2);
constexpr size_t OFF_NAVF  = al256(OFF_NAKF + (size_t)NB * 6 * 512 * KVT * 2);
constexpr size_t OFF_GKF   = al256(OFF_NAVF + (size_t)NB * 6 * 512 * KVT * 2);
constexpr size_t OFF_GVF   = al256(OFF_GKF + (size_t)NB * 2 * 512 * KVT * 2);
constexpr size_t OFF_NAKFC = al256(OFF_GVF + (size_t)NB * 2 * 512 * KVT * 2);
constexpr size_t OFF_NAVFC = al256(OFF_NAKFC + (size_t)NB * 6 * 16 * KVT * 2);
constexpr size_t OFF_GKFC  = al256(OFF_NAVFC + (size_t)NB * 6 * 16 * KVT * 2);
constexpr size_t OFF_GVFC  = al256(OFF_GKFC + (size_t)NB * 2 * 16 * KVT * 2);
constexpr size_t OFF_Y     = al256(OFF_GVFC + (size_t)NB * 2 * 16 * KVT * 2);
constexpr size_t WS_TOTAL  = al256(OFF_Y + (size_t)2 * NTOK * D * 2);
constexpr int CW_CNT = 0;

struct Params {
    const float *x, *c, *ctx, *c_ctx, *w_ada, *b_ada, *w_in, *conv_w, *conv_b, *rg_a_w, *rg_a_b, *rg_i_w, *rg_i_b, *rg_lambda,
        *na_rpb, *gqa_sink, *w_out, *ln1_g, *ln1_b, *router_g_w, *router_g_b, *router_e_w, *router_e_b, *exp_w_gate, *exp_w_up,
        *exp_w_down, *ln2_g, *ln2_b;
    float* out;
    unsigned char* ws;
};

DEV const Params& kp_() { const void* q = (const void*)__builtin_amdgcn_kernarg_segment_ptr(); asm volatile("" : "+s"(q)); return *(const Params*)q; }
DEV int tid_() { int t = threadIdx.x; asm volatile("" : "+v"(t)); return t; }
DEV int bid_() { int b = blockIdx.x; asm volatile("" : "+s"(b)); return b; }
DEV float shx(float v, int m) { return __builtin_bit_cast(float, __builtin_amdgcn_ds_bpermute(((tid_() & 63) ^ m) << 2, __builtin_bit_cast(int, v))); }
DEV float shl_(float v, int src) { return __builtin_bit_cast(float, __builtin_amdgcn_ds_bpermute(src << 2, __builtin_bit_cast(int, v))); }
DEV float bf2f(bf16_t h) { return __uint_as_float((unsigned)h << 16); }
DEV bf16_t f2bf(float f) { unsigned r; asm("v_cvt_pk_bf16_f32 %0, %1, %1" : "=v"(r) : "v"(f)); return (bf16_t)(r & 0xffffu); }
DEV unsigned pk2(float lo, float hi) { unsigned r; asm("v_cvt_pk_bf16_f32 %0, %1, %2" : "=v"(r) : "v"(lo), "v"(hi)); return r; }
DEV float wave_sum(float v) {
#pragma unroll
    for (int o = 1; o < 64; o <<= 1) v += shx(v, o);
    return v;
}
DEV float wave_max(float v) {
#pragma unroll
    for (int o = 1; o < 64; o <<= 1) v = fmaxf(v, shx(v, o));
    return v;
}
DEV float gelu_tanh(float x) {
    const float u = 0.7978845608028654f * (x + 0.044715f * x * x * x);
    const float t = 1.f - 2.f * __builtin_amdgcn_rcpf(1.f + __expf(2.f * u));
    return 0.5f * x * (1.f + t);
}
DEV float* xres_row(const Params& p, int R) {
    return R < NLAT ? p.out + (size_t)R * D : (float*)(p.ws + OFF_XCTX) + (size_t)(R - NLAT) * D;
}
DEV const float* modvec(const Params& p, int l, int R, int seg) {
    const int b = R < NLAT ? R / S : 8;
    return (const float*)(p.ws + OFF_MOD) + ((size_t)(l * 9 + b) * 6 + seg) * 1024;
}

DEV void ph_mod(const Params& p, float* sc  ) {
    if (bid_() >= 192) return;
    for (int i = tid_(); i < 9 * 1024; i += 256) { const float v = (i < 8192) ? p.c[i] : p.c_ctx[i - 8192]; sc[i] = v / (1.f + expf(-v)); }
    __syncthreads();
    const int lane = tid_() & 63, w = tid_() >> 6;
    const int col = bid_() * 64 + lane;
    const int l = col / 6144, j = col % 6144;
    const float* wp = p.w_ada + (size_t)l * 1024 * 6144 + j + (size_t)(w * 256) * 6144;
    const float* s = sc + w * 256;
    float a0 = 0, a1 = 0, a2 = 0, a3 = 0, a4 = 0, a5 = 0, a6 = 0, a7 = 0, a8 = 0;
#pragma unroll 8
    for (int k = 0; k < 256; ++k) {
        const float wv = wp[(size_t)k * 6144];
        a0 += s[k] * wv; a1 += s[1024 + k] * wv; a2 += s[2048 + k] * wv; a3 += s[3072 + k] * wv; a4 += s[4096 + k] * wv;
        a5 += s[5120 + k] * wv; a6 += s[6144 + k] * wv; a7 += s[7168 + k] * wv; a8 += s[8192 + k] * wv;
    }
    __syncthreads();
    float* red = sc + 9 * 1024;
    red[(w * 9 + 0) * 64 + lane] = a0; red[(w * 9 + 1) * 64 + lane] = a1; red[(w * 9 + 2) * 64 + lane] = a2; red[(w * 9 + 3) * 64 + lane] = a3; red[(w * 9 + 4) * 64 + lane] = a4;
    red[(w * 9 + 5) * 64 + lane] = a5; red[(w * 9 + 6) * 64 + lane] = a6; red[(w * 9 + 7) * 64 + lane] = a7; red[(w * 9 + 8) * 64 + lane] = a8;
    __syncthreads();
    if (w == 0) {
        const float bias = p.b_ada[l * 6144 + j];
        float* mod = (float*)(p.ws + OFF_MOD) + (size_t)l * 9 * 6144 + j;
#pragma unroll
        for (int r = 0; r < 9; ++r) mod[r * 6144] = ((red[(0 * 9 + r) * 64 + lane] + red[(1 * 9 + r) * 64 + lane]) + (red[(2 * 9 + r) * 64 + lane] + red[(3 * 9 + r) * 64 + lane])) + bias;
    }
}

DEV void sincos_red(float ang, float& sn, float& cs) {
    const float n = rintf(ang * 0.15915494309189535f);
    float r = fmaf(-n, 6.2831854820251465f, ang);
    r = fmaf(-n, -1.7484555e-07f, r);
    float sgn = 1.f;
    if (r > 1.5707963267948966f) { r = 3.14159265358979f - r; sgn = -1.f; }
    else if (r < -1.5707963267948966f) { r = -3.14159265358979f - r; sgn = -1.f; }
    const float r2 = r * r;
    float sp = -1.6059044e-10f; sp = fmaf(sp, r2, 2.5052108e-08f); sp = fmaf(sp, r2, -2.7557319e-06f); sp = fmaf(sp, r2, 1.9841270e-04f);
    sp = fmaf(sp, r2, -8.3333333e-03f); sp = fmaf(sp, r2, 1.6666667e-01f); sp = fmaf(sp * -1.f, r2, 1.f);
    sn = r * sp;
    float cp = -1.1470746e-11f; cp = fmaf(cp, r2, 2.0876757e-09f); cp = fmaf(cp, r2, -2.7557319e-07f); cp = fmaf(cp, r2, 2.4801587e-05f);
    cp = fmaf(cp, r2, -1.3888889e-03f); cp = fmaf(cp, r2, 4.1666667e-02f); cp = fmaf(cp, r2, -0.5f); cp = fmaf(cp, r2, 1.f);
    cs = sgn * cp;
}
DEV void ph_rope(const Params& p) {
    const int i = (bid_() - 192) * 256 + tid_();
    if (i < 0 || i >= 128 * 16) return;
    const int pos = i >> 4, q = i & 15;
    const float inv = exp2f(-(float)q * (13.287712379549449f / 16.f));
    float sn, cs; sincos_red((float)pos * inv, sn, cs);
    float* tab = (float*)(p.ws + OFF_ROPE);
    tab[i] = cs; tab[2048 + i] = sn;
}

DEV void ph_routerw(const Params& p) {
  for (int i = bid_() * 256 + tid_(); i < 2 * 48 * 1024; i += gridDim.x * 256) {
    const int l = i / (48 * 1024), f = (i / 1024) % 48, k = i & 1023;
    float w = 0.f;
    if (f < 4) w = p.router_g_w[((size_t)l * 1024 + k) * 4 + f]; else if (f < 36) w = p.router_e_w[((size_t)l * 1024 + k) * 32 + (f - 4)];
    const bf16_t hi = f2bf(w), lo = f2bf(w - bf2f(hi));
    bf16_t* WR = (bf16_t*)(p.ws + OFF_WR);
    WR[((size_t)(l * 2 + 0) * 48 + f) * 1024 + k] = hi;
    WR[((size_t)(l * 2 + 1) * 48 + f) * 1024 + k] = lo;
  }
}

DEV void ph_rgprep(const Params& p) {
    bf16_t* W = (bf16_t*)(p.ws + OFF_WRG);
    for (int i = bid_() * 256 + tid_(); i < 2 * 2 * 2 * 4 * 64 * 64; i += gridDim.x * 256) {
        const int d = i & 63, e = (i >> 6) & 63, n = (i >> 12) & 3, gate = (i >> 14) & 1, ld = i >> 15;
        const float* srcw = gate ? p.rg_i_w : p.rg_a_w;
        W[i] = f2bf(srcw[((size_t)(ld * 4 + n) * 64 + d) * 64 + e]);
    }
    float* C = (float*)(p.ws + OFF_RGC);
    for (int i = bid_() * 256 + tid_(); i < 2 * 2 * 256; i += gridDim.x * 256) {
        const int c = i & 255, ld = i >> 8;
        C[(ld * 3 + 0) * 256 + c] = p.rg_a_b[ld * 256 + c];
        C[(ld * 3 + 1) * 256 + c] = p.rg_i_b[ld * 256 + c];
        C[(ld * 3 + 2) * 256 + c] = -8.f * log1pf(expf(-p.rg_lambda[ld * 256 + c]));
    }
}

DEV int tr_row(int n, int mode) { return mode == 0 ? n : ((n >> 7) * 256 + ((n >> 6) & 1) * 128 + (n & 63) + (mode == 2 ? 64 : 0)); }
DEV void transpose_tile(const float* src, bf16_t* dst, int K, int N, int mode, int tile, float* lds) {
    const int ntn = N >> 6, kt = tile / ntn, nt = tile % ntn, k0 = kt * 64, n0 = nt * 64, t = tid_();
#pragma unroll
    for (int i = 0; i < 4; ++i) {
        const int r = (t >> 4) + 16 * i, c4 = (t & 15) * 4;
        const float4 v = *(const float4*)(src + (size_t)(k0 + r) * N + n0 + c4);
        lds[r * 65 + c4] = v.x; lds[r * 65 + c4 + 1] = v.y; lds[r * 65 + c4 + 2] = v.z; lds[r * 65 + c4 + 3] = v.w;
    }
    __syncthreads();
#pragma unroll
    for (int i = 0; i < 2; ++i) {
        const int n = (t >> 3) + 32 * i, kc = (t & 7) * 8;
        uint4 o;
        o.x = pk2(lds[(kc + 0) * 65 + n], lds[(kc + 1) * 65 + n]); o.y = pk2(lds[(kc + 2) * 65 + n], lds[(kc + 3) * 65 + n]);
        o.z = pk2(lds[(kc + 4) * 65 + n], lds[(kc + 5) * 65 + n]); o.w = pk2(lds[(kc + 6) * 65 + n], lds[(kc + 7) * 65 + n]);
        *(uint4*)(dst + (size_t)tr_row(n0 + n, mode) * K + k0 + kc) = o;
    }
    __syncthreads();
}
DEV void transpose_tile_w(const float* src, bf16_t* dst, int K, int N, int mode, int tile, float* lds  ) {
    const int ntn = N >> 6, kt = tile / ntn, nt = tile % ntn, k0 = kt * 64, n0 = nt * 64, t = tid_() & 63;
    float4 v[16];
#pragma unroll
    for (int i = 0; i < 16; ++i) v[i] = *(const float4*)(src + (size_t)(k0 + (t >> 4) + 4 * i) * N + n0 + (t & 15) * 4);
#pragma unroll
    for (int i = 0; i < 16; ++i) { const int r = (t >> 4) + 4 * i, c4 = (t & 15) * 4; lds[r * 65 + c4] = v[i].x; lds[r * 65 + c4 + 1] = v[i].y; lds[r * 65 + c4 + 2] = v[i].z; lds[r * 65 + c4 + 3] = v[i].w; }
    asm volatile("s_waitcnt lgkmcnt(0)" ::: "memory");
#pragma unroll
    for (int i = 0; i < 8; ++i) {
        const int n = (t >> 3) + 8 * i, kc = (t & 7) * 8;
        uint4 o;
        o.x = pk2(lds[(kc + 0) * 65 + n], lds[(kc + 1) * 65 + n]); o.y = pk2(lds[(kc + 2) * 65 + n], lds[(kc + 3) * 65 + n]);
        o.z = pk2(lds[(kc + 4) * 65 + n], lds[(kc + 5) * 65 + n]); o.w = pk2(lds[(kc + 6) * 65 + n], lds[(kc + 7) * 65 + n]);
        *(uint4*)(dst + (size_t)tr_row(n0 + n, mode) * K + k0 + kc) = o;
    }
    asm volatile("s_waitcnt lgkmcnt(0)" ::: "memory");
}
DEV void expert_conv_item(const Params& p, int l, int gi, float* lds) {
    const int w = tid_() >> 6;
    float* my = lds + w * (64 * 65);
#pragma unroll 1
    for (int k = 0; k < 2; ++k) {
        const int T = gi * 8 + w * 2 + k, kind = T >> 12, Tl = T & 4095, e = Tl >> 7, tile = Tl & 127;
        if (kind == 0) transpose_tile_w(p.exp_w_gate + ((size_t)l * NE + e) * 1024 * 512, (bf16_t*)(p.ws + OFF_WGU) + (size_t)e * 1024 * 1024, 1024, 512, 1, tile, my);
        else if (kind == 1) transpose_tile_w(p.exp_w_up + ((size_t)l * NE + e) * 1024 * 512, (bf16_t*)(p.ws + OFF_WGU) + (size_t)e * 1024 * 1024, 1024, 512, 2, tile, my);
        else transpose_tile_w(p.exp_w_down + ((size_t)l * NE + e) * 512 * 1024, (bf16_t*)(p.ws + OFF_WD) + (size_t)e * 1024 * 512, 512, 1024, 0, tile, my);
    }
}
DEV void ph_transpose(const float* src, bf16_t* dst, int K, int N, int mode, int nmat, size_t sstride, size_t dstride, float* lds  ) {
    const int per = (K >> 6) * (N >> 6);
    for (int it = bid_(); it < nmat * per; it += gridDim.x) {
        const int m = it / per, tile = it % per;
        transpose_tile(src + (size_t)m * sstride, dst + (size_t)m * dstride, K, N, mode, tile, lds);
    }
}

constexpr int NRW = 4;
template <int MODE, bool WX> DEV void rowop(const Params& p, int l, int R) {
    const int lane = tid_() & 63;
#define RK(i) (((i) >> 1) * 512 + lane * 8 + ((i) & 1) * 4)
    float4 v[NRW][4];
    float* xr[NRW] = {nullptr, nullptr, nullptr, nullptr};
    if (MODE == 0) {
#pragma unroll
        for (int r = 0; r < NRW; ++r) {
            const int Rr = R + r;
            const float* src = Rr < NLAT ? p.x + (size_t)Rr * D : p.ctx + (size_t)(Rr - NLAT) * D;
#pragma unroll
            for (int i = 0; i < 4; ++i) v[r][i] = *(const float4*)(src + RK(i));
        }
    } else {
        const float* g2 = modvec(p, l - 1, R, 5);
        const float* lg = p.ln2_g + (l - 1) * D; const float* lb = p.ln2_b + (l - 1) * D;
        float4 xv[NRW][4]; uint2 ya[NRW][4], yb[NRW][4];
#pragma unroll
        for (int r = 0; r < NRW; ++r) {
            xr[r] = xres_row(p, R + r);
            const bf16_t* y0 = (const bf16_t*)(p.ws + OFF_Y) + (size_t)(2 * (R + r)) * D;
#pragma unroll
            for (int i = 0; i < 4; ++i) xv[r][i] = *(const float4*)(xr[r] + RK(i));
#pragma unroll
            for (int h = 0; h < 2; ++h) { const uint4 a8 = *(const uint4*)(y0 + RK(2 * h)), b8 = *(const uint4*)(y0 + D + RK(2 * h));
                ya[r][2 * h] = make_uint2(a8.x, a8.y); ya[r][2 * h + 1] = make_uint2(a8.z, a8.w); yb[r][2 * h] = make_uint2(b8.x, b8.y); yb[r][2 * h + 1] = make_uint2(b8.z, b8.w); }
        }
        float s[NRW] = {0.f, 0.f, 0.f, 0.f};
#pragma unroll
        for (int i = 0; i < 4; ++i) {
            const float4 gv = *(const float4*)(g2 + RK(i));
#pragma unroll
            for (int r = 0; r < NRW; ++r) {
                const uint2 a = ya[r][i], b = yb[r][i];
                float4 u;
                u.x = ALPHA * xv[r][i].x + gv.x * (bf2f((bf16_t)(a.x & 0xffff)) + bf2f((bf16_t)(b.x & 0xffff)));
                u.y = ALPHA * xv[r][i].y + gv.y * (bf2f((bf16_t)(a.x >> 16)) + bf2f((bf16_t)(b.x >> 16)));
                u.z = ALPHA * xv[r][i].z + gv.z * (bf2f((bf16_t)(a.y & 0xffff)) + bf2f((bf16_t)(b.y & 0xffff)));
                u.w = ALPHA * xv[r][i].w + gv.w * (bf2f((bf16_t)(a.y >> 16)) + bf2f((bf16_t)(b.y >> 16)));
                v[r][i] = u; s[r] += (u.x + u.y) + (u.z + u.w);
            }
        }
        float q[NRW] = {0.f, 0.f, 0.f, 0.f};
#pragma unroll
        for (int r = 0; r < NRW; ++r) {
            const float mean = wave_sum(s[r]) * (1.f / D);
#pragma unroll
            for (int i = 0; i < 4; ++i) { v[r][i].x -= mean; v[r][i].y -= mean; v[r][i].z -= mean; v[r][i].w -= mean; q[r] += (v[r][i].x * v[r][i].x + v[r][i].y * v[r][i].y) + (v[r][i].z * v[r][i].z + v[r][i].w * v[r][i].w); }
        }
#pragma unroll
        for (int r = 0; r < NRW; ++r) q[r] = rsqrtf(wave_sum(q[r]) * (1.f / D) + LN_EPS);
#pragma unroll
        for (int i = 0; i < 4; ++i) {
            const int k = RK(i);
            const float4 gg = *(const float4*)(lg + k); const float4 bb = *(const float4*)(lb + k);
#pragma unroll
            for (int r = 0; r < NRW; ++r) {
                v[r][i].x = v[r][i].x * q[r] * gg.x + bb.x; v[r][i].y = v[r][i].y * q[r] * gg.y + bb.y; v[r][i].z = v[r][i].z * q[r] * gg.z + bb.z; v[r][i].w = v[r][i].w * q[r] * gg.w + bb.w;
                if (WX) *(float4*)(xr[r] + k) = v[r][i];
            }
        }
    }
    if (MODE != 2) {
        const float* sh = modvec(p, l, R, 0); const float* sc = modvec(p, l, R, 1);
#pragma unroll
        for (int h = 0; h < 2; ++h) {
            const int k = RK(2 * h);
            const float4 s4a = *(const float4*)(sh + k), c4a = *(const float4*)(sc + k), s4b = *(const float4*)(sh + k + 4), c4b = *(const float4*)(sc + k + 4);
#pragma unroll
            for (int r = 0; r < NRW; ++r) {
                bf16_t* ha = (bf16_t*)(p.ws + OFF_X1) + (size_t)(R + r) * D;
                const float4 va = v[r][2 * h], vb = v[r][2 * h + 1];
                uint4 o; o.x = pk2(va.x * (1.f + c4a.x) + s4a.x, va.y * (1.f + c4a.y) + s4a.y); o.y = pk2(va.z * (1.f + c4a.z) + s4a.z, va.w * (1.f + c4a.w) + s4a.w);
                o.z = pk2(vb.x * (1.f + c4b.x) + s4b.x, vb.y * (1.f + c4b.y) + s4b.y); o.w = pk2(vb.z * (1.f + c4b.z) + s4b.z, vb.w * (1.f + c4b.w) + s4b.w);
                *(uint4*)(ha + k) = o;
            }
        }
    }
#undef RK
}
template <int MODE> DEV void ph_rowop(const Params& p, int l, int nrows) {
    const int w = tid_() >> 6;
    for (int R = (bid_() * 4 + w) * NRW; R < nrows; R += gridDim.x * 4 * NRW) rowop<MODE, true>(p, l, R);
}
constexpr int CW_Q = 64;
DEV int q_publish(int nreg, int* slot) {
    __syncthreads();
    if (tid_() == 0) *slot = nreg;
    __syncthreads();
    return *(volatile int*)slot;
}
DEV int q_pull(unsigned* ctr, int* slot) {
    if (tid_() == 0) *slot = (int)atomicAdd(ctr, 1u);
    __syncthreads();
    const int v = *(volatile int*)slot;
    __syncthreads();
    return v;
}

constexpr int GEMM_STAGE_BYTES = 384 * 64;
constexpr int GEMM_NSTAGE = 3;
constexpr int GEMM_LDS_BYTES = GEMM_NSTAGE * GEMM_STAGE_BYTES;
#define LAS __attribute__((address_space(3)))
DEV int gemm_perm_row(int r) { const int i = r & 15, n = (r >> 4) & 1; return (r & ~31) + 8 * (i >> 2) + 4 * n + (i & 3); }
DEV int gemm_src_chunk(int t) { return ((t & 3) ^ ((0 - (t >> 4)) & 3)) * 8; }
DEV void gemm_mainloop(const bf16_t* Abase, unsigned ao0, unsigned ao1, const bf16_t* Bbase, unsigned bo, unsigned ldb, int nk, bf16_t* lds, f32x4 (&acc)[4][8]) {
    const int t = tid_(), lane = t & 63, w = __builtin_amdgcn_readfirstlane(t >> 6), wm = w >> 1, wn = w & 1;
    LAS unsigned char* L = (LAS unsigned char*)lds;
    const int pc = ((lane >> 4) ^ ((0 - ((lane & 15) >> 2)) & 3)) * 16;
    const int arow = (wm * 64 + (lane & 15)) * 64 + pc, brow = (128 + wn * 128 + (lane & 15)) * 64 + pc;
    const char* Ab = (const char*)Abase; const char* B0 = (const char*)Bbase; const char* B1 = B0 + (size_t)ldb * 128; const char* B2 = B0 + (size_t)ldb * 256; const char* B3 = B0 + (size_t)ldb * 384;
#define GEMM_ISSUE(slot, ko) do { LAS unsigned* d_ = (LAS unsigned*)(L + (slot) * GEMM_STAGE_BYTES + w * 1024); \
        __builtin_amdgcn_global_load_lds((const unsigned*)(Ab + (ao0 + (ko) * 2u)), d_, 16, 0, 0); \
        __builtin_amdgcn_global_load_lds((const unsigned*)(Ab + (ao1 + (ko) * 2u)), d_ + 1024, 16, 0, 0); \
        __builtin_amdgcn_global_load_lds((const unsigned*)(B0 + (bo + (ko) * 2u)), d_ + 2048, 16, 0, 0); \
        __builtin_amdgcn_global_load_lds((const unsigned*)(B1 + (bo + (ko) * 2u)), d_ + 3072, 16, 0, 0); \
        __builtin_amdgcn_global_load_lds((const unsigned*)(B2 + (bo + (ko) * 2u)), d_ + 4096, 16, 0, 0); \
        __builtin_amdgcn_global_load_lds((const unsigned*)(B3 + (bo + (ko) * 2u)), d_ + 5120, 16, 0, 0); } while (0)
    asm volatile("s_waitcnt vmcnt(0)" ::: "memory");
    __builtin_amdgcn_s_barrier();
    asm volatile("" ::: "memory");
    GEMM_ISSUE(0, 0);
    if (nk > 1) GEMM_ISSUE(1, 32);
    int cs = 0, is = 2;
    for (int kt = 0; kt < nk; ++kt) {
        if (kt + 1 < nk) asm volatile("s_waitcnt vmcnt(6)" ::: "memory"); else asm volatile("s_waitcnt vmcnt(0)" ::: "memory");
        __builtin_amdgcn_s_barrier();
        asm volatile("" ::: "memory");
        if (kt + 2 < nk) GEMM_ISSUE(is, (kt + 2) * 32);
        const LAS unsigned char* cur = L + cs * GEMM_STAGE_BYTES;
        const bf16x8 af0 = *(const LAS bf16x8*)(cur + arow), af1 = *(const LAS bf16x8*)(cur + arow + 16 * 64), af2 = *(const LAS bf16x8*)(cur + arow + 32 * 64), af3 = *(const LAS bf16x8*)(cur + arow + 48 * 64);
        bf16x8 bq0 = *(const LAS bf16x8*)(cur + brow), bq1 = *(const LAS bf16x8*)(cur + brow + 16 * 64);
#pragma unroll
        for (int nt = 0; nt < 8; ++nt) {
            const bf16x8 bfr = bq0; bq0 = bq1;
            if (nt + 2 < 8) bq1 = *(const LAS bf16x8*)(cur + brow + (nt + 2) * 16 * 64);
            acc[0][nt] = __builtin_amdgcn_mfma_f32_16x16x32_bf16(bfr, af0, acc[0][nt], 0, 0, 0);
            acc[1][nt] = __builtin_amdgcn_mfma_f32_16x16x32_bf16(bfr, af1, acc[1][nt], 0, 0, 0);
            acc[2][nt] = __builtin_amdgcn_mfma_f32_16x16x32_bf16(bfr, af2, acc[2][nt], 0, 0, 0);
            acc[3][nt] = __builtin_amdgcn_mfma_f32_16x16x32_bf16(bfr, af3, acc[3][nt], 0, 0, 0);
        }
        cs = cs == 2 ? 0 : cs + 1; is = is == 2 ? 0 : is + 1;
    }
#undef GEMM_ISSUE
}
DEV void zero_acc(f32x4 (&acc)[4][8]) {
#pragma unroll
    for (int a = 0; a < 4; ++a)
#pragma unroll
        for (int b = 0; b < 8; ++b) acc[a][b] = (f32x4){0.f, 0.f, 0.f, 0.f};
}

DEV void inproj_item(const Params& p_, int l, int rt, int pass, bf16_t* lds) {
    const Params& p = kp_();
    const int t = tid_(), lane = t & 63, w = t >> 6, wm = w >> 1, wn = w & 1;
    const bf16_t* A = (const bf16_t*)(p.ws + OFF_X1) + (size_t)(rt * 128) * D;
    const bf16_t* Bt = (const bf16_t*)(p.ws + OFF_WINT) + ((size_t)l * 2304 + pass * 256) * 1024;
    const unsigned toff = (unsigned)(((t >> 2) * 1024 + gemm_src_chunk(t)) * 2);
    f32x4 acc[4][8]; zero_acc(acc);
    gemm_mainloop(A, toff, toff + 64 * D * 2, Bt, toff, 1024, 32, lds, acc);
    bf16_t* P = (bf16_t*)(p.ws + OFF_P);
    const float* ctab = (const float*)(p.ws + OFF_ROPE); const float* stab = ctab + 2048;
    const bool isctx = rt >= 512;
    const int fq = lane >> 4, fr = lane & 15;
#pragma unroll
    for (int hci = 0; hci < 2; ++hci) {
        const int hc = pass * 4 + wn * 2 + hci;
        int type, dcol = 0, vh = 0;
        if (hc < 4) { type = 0; dcol = COL_RGX + hc * 64; }
        else if (hc < 10) { type = 4; vh = hc - 4; }
        else if (hc < 16) { type = 5; vh = hc - 10; }
        else if (hc < 18) { type = 6; vh = hc - 16; }
        else if (hc < 20) { type = 7; vh = hc - 18; }
        else if (hc < 24) { type = 0; dcol = COL_GATE + (hc - 20) * 64; }
        else if (hc < 30) { type = 1; dcol = COL_NAQ + (hc - 24) * 64; }
        else { type = 3; dcol = COL_GQ + (hc - 30) * 64; }
#pragma unroll
        for (int mt = 0; mt < 4; ++mt) {
            const int R = rt * 128 + wm * 64 + mt * 16 + fr;
            f32x4 v0 = acc[mt][hci * 4 + 0], v1 = acc[mt][hci * 4 + 1], v2 = acc[mt][hci * 4 + 2], v3 = acc[mt][hci * 4 + 3];
            if ((type == 3 || type == 6) && !isctx) {
                const int tt = R & (S - 1), pr = tt >> 6, pc = tt & 63;
                const f32x4 cr = *(const f32x4*)(ctab + pr * 16 + fq * 4), sr = *(const f32x4*)(stab + pr * 16 + fq * 4);
                const f32x4 cc = *(const f32x4*)(ctab + pc * 16 + fq * 4), sc = *(const f32x4*)(stab + pc * 16 + fq * 4);
                const f32x4 o0 = v0 * cr - v1 * sr, o1 = v1 * cr + v0 * sr, o2 = v2 * cc - v3 * sc, o3 = v3 * cc + v2 * sc;
                v0 = o0; v1 = o1; v2 = o2; v3 = o3;
            }
            if (type == 1 || type == 3) { const float qs = 0.125f * 1.4426950408889634f; v0 = v0 * qs; v1 = v1 * qs; v2 = v2 * qs; v3 = v3 * qs; }
            if (type < 4) {
                bf16_t* o = P + (size_t)R * PWS + dcol + fq * 4;
                uint2 q;
                q.x = pk2(v0[0], v0[1]); q.y = pk2(v0[2], v0[3]); *(uint2*)(o) = q;
                q.x = pk2(v1[0], v1[1]); q.y = pk2(v1[2], v1[3]); *(uint2*)(o + 16) = q;
                q.x = pk2(v2[0], v2[1]); q.y = pk2(v2[2], v2[3]); *(uint2*)(o + 32) = q;
                q.x = pk2(v3[0], v3[1]); q.y = pk2(v3[2], v3[3]); *(uint2*)(o + 48) = q;
            } else {
                const bool na = type < 6, isk = (type == 4 || type == 6);
                bf16_t* tb;
                if (!isctx) { const int b = R >> 13, tile = (R & (S - 1)) >> 4;
                    tb = (bf16_t*)(p.ws + (na ? (isk ? OFF_NAKF : OFF_NAVF) : (isk ? OFF_GKF : OFF_GVF))) + ((size_t)(b * (na ? 6 : 2) + vh) * 512 + tile) * KVT; }
                else { const int cR = R - NLAT, b = cR >> 8, tile = (cR & 255) >> 4;
                    tb = (bf16_t*)(p.ws + (na ? (isk ? OFF_NAKFC : OFF_NAVFC) : (isk ? OFF_GKFC : OFF_GVFC))) + ((size_t)(b * (na ? 6 : 2) + vh) * 16 + tile) * KVT; }
                if (isk) {
                    bf16_t* o = tb + ((fq >> 1) * 16 + fr) * 8 + (fq & 1) * 4;
                    uint2 q;
                    q.x = pk2(v0[0], v0[1]); q.y = pk2(v0[2], v0[3]); *(uint2*)(o) = q;
                    q.x = pk2(v1[0], v1[1]); q.y = pk2(v1[2], v1[3]); *(uint2*)(o + 2 * 16 * 8) = q;
                    q.x = pk2(v2[0], v2[1]); q.y = pk2(v2[2], v2[3]); *(uint2*)(o + 512) = q;
                    q.x = pk2(v3[0], v3[1]); q.y = pk2(v3[2], v3[3]); *(uint2*)(o + 512 + 2 * 16 * 8) = q;
                } else {
                    bf16_t* o = tb + ((fr >> 2) * 16 + fq * 4) * 8 + (fr & 3);
#pragma unroll
                    for (int j = 0; j < 4; ++j) {
                        o[j * 8] = f2bf(v0[j]); o[j * 8 + 4] = f2bf(v1[j]); o[512 + j * 8] = f2bf(v2[j]); o[512 + j * 8 + 4] = f2bf(v3[j]);
                    }
                }
            }
        }
    }
}
constexpr float LOG2E = 1.4426950408889634f;
struct AttnState { f32x4 o0, o1, o2, o3; float m, lsum; };
struct KVFrag { bf16x8 k00, k01, k10, k11, v0, v1, v2, v3; };
DEV bf16x8 ld16(const bf16_t* p) { return *(const bf16x8*)p; }
DEV bf16x8 lohi(const uint4& a, const uint4& b, int hi) { union { uint4 u; bf16x8 v; } c; c.u = hi ? make_uint4(a.z, a.w, b.z, b.w) : make_uint4(a.x, a.y, b.x, b.y); return c.v; }
DEV void kv_load(const bf16_t* kt0, const bf16_t* kt1, const bf16_t* vt0, const bf16_t* vt1, KVFrag& f) {
    f.k00 = ld16(kt0); f.k01 = ld16(kt0 + 512); f.k10 = ld16(kt1); f.k11 = ld16(kt1 + 512);
    const uint4 a0 = *(const uint4*)vt0, a1 = *(const uint4*)(vt0 + 512), b0 = *(const uint4*)vt1, b1 = *(const uint4*)(vt1 + 512);
    f.v0 = lohi(a0, b0, 0); f.v1 = lohi(a0, b0, 1); f.v2 = lohi(a1, b1, 0); f.v3 = lohi(a1, b1, 1);
}
template <bool HASB> DEV void attn_apply(const KVFrag& f, const bf16x8& q0, const bf16x8& q1, f32x4 b0, f32x4 b1, AttnState& st) {
    const f32x4 z = {0.f, 0.f, 0.f, 0.f};
    f32x4 s0 = __builtin_amdgcn_mfma_f32_16x16x32_bf16(f.k00, q0, z, 0, 0, 0); s0 = __builtin_amdgcn_mfma_f32_16x16x32_bf16(f.k01, q1, s0, 0, 0, 0);
    f32x4 s1 = __builtin_amdgcn_mfma_f32_16x16x32_bf16(f.k10, q0, z, 0, 0, 0); s1 = __builtin_amdgcn_mfma_f32_16x16x32_bf16(f.k11, q1, s1, 0, 0, 0);
    if (HASB) { s0 = s0 + b0; s1 = s1 + b1; }
    float mx = fmaxf(fmaxf(fmaxf(s0[0], s0[1]), fmaxf(s0[2], s0[3])), fmaxf(fmaxf(s1[0], s1[1]), fmaxf(s1[2], s1[3])));
    mx = fmaxf(mx, shx(mx, 16)); mx = fmaxf(mx, shx(mx, 32));
    if (__builtin_amdgcn_ballot_w64(mx > st.m + 8.f) != 0ull) {
        const float mn = fmaxf(st.m, mx);
        const float msn = (mn == -INFINITY) ? 0.f : mn;
        const float alpha = __builtin_amdgcn_exp2f(st.m - msn);
        st.lsum = st.lsum * alpha;
        st.o0 = st.o0 * alpha; st.o1 = st.o1 * alpha; st.o2 = st.o2 * alpha; st.o3 = st.o3 * alpha;
        st.m = mn;
    }
    const float ms = (st.m == -INFINITY) ? 0.f : st.m;
    f32x4 p0, p1;
#pragma unroll
    for (int j = 0; j < 4; ++j) { p0[j] = __builtin_amdgcn_exp2f(s0[j] - ms); p1[j] = __builtin_amdgcn_exp2f(s1[j] - ms); }
    st.lsum = st.lsum + ((p0[0] + p0[1]) + (p0[2] + p0[3])) + ((p1[0] + p1[1]) + (p1[2] + p1[3]));
    union { uint4 u; bf16x8 v; } pt; pt.u = make_uint4(pk2(p0[0], p0[1]), pk2(p0[2], p0[3]), pk2(p1[0], p1[1]), pk2(p1[2], p1[3]));
    st.o0 = __builtin_amdgcn_mfma_f32_16x16x32_bf16(f.v0, pt.v, st.o0, 0, 0, 0);
    st.o1 = __builtin_amdgcn_mfma_f32_16x16x32_bf16(f.v1, pt.v, st.o1, 0, 0, 0);
    st.o2 = __builtin_amdgcn_mfma_f32_16x16x32_bf16(f.v2, pt.v, st.o2, 0, 0, 0);
    st.o3 = __builtin_amdgcn_mfma_f32_16x16x32_bf16(f.v3, pt.v, st.o3, 0, 0, 0);
}
DEV void attn_init(AttnState& st) { const f32x4 z = {0.f, 0.f, 0.f, 0.f}; st.o0 = z; st.o1 = z; st.o2 = z; st.o3 = z; st.m = -INFINITY; st.lsum = 0.f; }
DEV void attn_store(AttnState& st, bf16_t* orow, float sink2  ) {
    float l = st.lsum; l += shx(l, 16); l += shx(l, 32);
    float sc;
    if (sink2 != -INFINITY) { const float mf = fmaxf(st.m, sink2); const float al = __builtin_amdgcn_exp2f(st.m - mf); l = l * al + __builtin_amdgcn_exp2f(sink2 - mf); sc = al / l; }
    else sc = 1.f / l;
    uint2 w;
    w.x = pk2(st.o0[0] * sc, st.o0[1] * sc); w.y = pk2(st.o0[2] * sc, st.o0[3] * sc); *(uint2*)(orow) = w;
    w.x = pk2(st.o1[0] * sc, st.o1[1] * sc); w.y = pk2(st.o1[2] * sc, st.o1[3] * sc); *(uint2*)(orow + 16) = w;
    w.x = pk2(st.o2[0] * sc, st.o2[1] * sc); w.y = pk2(st.o2[2] * sc, st.o2[3] * sc); *(uint2*)(orow + 32) = w;
    w.x = pk2(st.o3[0] * sc, st.o3[1] * sc); w.y = pk2(st.o3[2] * sc, st.o3[3] * sc); *(uint2*)(orow + 48) = w;
}

constexpr int NTASK_NA = NB * 6 * 128 * 4, NTASK_GQ = NB * 2 * 512, NTASK_CNA = NB * 6 * 16, NTASK_CGQ = NB * 2 * 16;
DEV void attn_task(const Params& p, int l, int tk, const float* rpb2  ) {
    const int lane = tid_() & 63, g = lane >> 4, fr = lane & 15;
    const bf16_t* P = (const bf16_t*)(p.ws + OFF_P);
    bf16_t* X1 = (bf16_t*)(p.ws + OFF_X1);
    const f32x4 z4 = {0.f, 0.f, 0.f, 0.f};
    KVFrag f;
    if (tk < NTASK_NA) {
        const int qtile = tk & 3, r = (tk >> 2) & 127, hb = tk >> 9, h = hb % 6, b = hb / 6;
        const int qc = qtile == 0 ? (fr < 8 ? fr : 48 + fr) : 8 + (qtile - 1) * 16 + fr;
        const int ct0 = qtile == 0 ? 0 : qtile - 1, ct1 = qtile == 0 ? 3 : qtile;
        const int R = b * S + r * 64 + qc;
        const bf16_t* qp = P + (size_t)R * PWS + COL_NAQ + h * 64 + g * 8;
        const bf16x8 q0 = ld16(qp), q1 = ld16(qp + 32);
        const int rs = min(max(r - 4, 0), 120), cs = min(max(qc - 8, 0), 48);
        int ci[8]; bool ok[8];
#pragma unroll
        for (int e = 0; e < 8; ++e) { const int kc = ((e >> 2) ? ct1 : ct0) * 16 + g * 4 + (e & 3); ok[e] = (kc >= cs) && (kc < cs + 16); ci[e] = min(max(kc - qc + 15, 0), 30); }
        const bf16_t* kf = (const bf16_t*)(p.ws + OFF_NAKF) + ((size_t)(b * 6 + h) * 512 + rs * 4) * KVT + lane * 8;
        const bf16_t* vf = (const bf16_t*)(p.ws + OFF_NAVF) + ((size_t)(b * 6 + h) * 512 + rs * 4) * KVT + lane * 8;
        AttnState st; attn_init(st);
#pragma unroll
        for (int ri = 0; ri < 8; ++ri) {
            const float* rb = rpb2 + (h * 15 + (rs + ri - r + 7)) * 31;
            f32x4 b0, b1;
#pragma unroll
            for (int j = 0; j < 4; ++j) { b0[j] = ok[j] ? rb[ci[j]] : -INFINITY; b1[j] = ok[4 + j] ? rb[ci[4 + j]] : -INFINITY; }
            kv_load(kf + (size_t)(ri * 4 + ct0) * KVT, kf + (size_t)(ri * 4 + ct1) * KVT, vf + (size_t)(ri * 4 + ct0) * KVT, vf + (size_t)(ri * 4 + ct1) * KVT, f);
            attn_apply<true>(f, q0, q1, b0, b1, st);
        }
        const bf16_t* kc_ = (const bf16_t*)(p.ws + OFF_NAKFC) + (size_t)(b * 6 + h) * 16 * KVT + lane * 8;
        const bf16_t* vc_ = (const bf16_t*)(p.ws + OFF_NAVFC) + (size_t)(b * 6 + h) * 16 * KVT + lane * 8;
#pragma unroll
        for (int pp = 0; pp < 8; ++pp) { kv_load(kc_ + (size_t)(2 * pp) * KVT, kc_ + (size_t)(2 * pp + 1) * KVT, vc_ + (size_t)(2 * pp) * KVT, vc_ + (size_t)(2 * pp + 1) * KVT, f); attn_apply<false>(f, q0, q1, z4, z4, st); }
        attn_store(st, X1 + (size_t)R * D + 256 + h * 64 + g * 4, -INFINITY);
    } else if (tk < NTASK_NA + NTASK_GQ + NTASK_CNA + NTASK_CGQ && (tk < NTASK_NA + NTASK_GQ || tk >= NTASK_NA + NTASK_GQ + NTASK_CNA)) {
        const bool lat = tk < NTASK_NA + NTASK_GQ;
        const int t2 = lat ? tk - NTASK_NA : tk - (NTASK_NA + NTASK_GQ + NTASK_CNA);
        const int qt = lat ? (t2 & 511) : (t2 & 15), hb = lat ? (t2 >> 9) : (t2 >> 4), kvh = hb & 1, b = hb >> 1;
        const int q0i = qt * 16, R = (lat ? b * S : NLAT + b * CTX) + q0i + fr;
        const bf16_t* qp = P + (size_t)R * PWS + COL_GQ + kvh * 192 + g * 8;
        const bf16x8 qa0 = ld16(qp), qa1 = ld16(qp + 32), qb0 = ld16(qp + 64), qb1 = ld16(qp + 96), qc0 = ld16(qp + 128), qc1 = ld16(qp + 160);
        AttnState sa, sb, sc; attn_init(sa); attn_init(sb); attn_init(sc);
        const bf16_t* kf = (const bf16_t*)(p.ws + OFF_GKF) + (size_t)(b * 2 + kvh) * 512 * KVT + lane * 8;
        const bf16_t* vf = (const bf16_t*)(p.ws + OFF_GVF) + (size_t)(b * 2 + kvh) * 512 * KVT + lane * 8;
        const bf16_t* kc_ = (const bf16_t*)(p.ws + OFF_GKFC) + (size_t)(b * 2 + kvh) * 16 * KVT + lane * 8;
        const bf16_t* vc_ = (const bf16_t*)(p.ws + OFF_GVFC) + (size_t)(b * 2 + kvh) * 16 * KVT + lane * 8;
        const int qi = q0i + fr;
#define GQ_LOAD(i, F) do { const int i_ = (i); if (i_ < 9) { const int kt_ = (q0i - 128 + i_ * 32) >> 4; const int ta_ = min(max(kt_, 0), 511), tb_ = min(max(kt_ + 1, 0), 511); \
            kv_load(kf + (size_t)ta_ * KVT, kf + (size_t)tb_ * KVT, vf + (size_t)ta_ * KVT, vf + (size_t)tb_ * KVT, F); } \
        else { const int c_ = (i_ - 9) * 2; kv_load(kc_ + (size_t)c_ * KVT, kc_ + (size_t)(c_ + 1) * KVT, vc_ + (size_t)c_ * KVT, vc_ + (size_t)(c_ + 1) * KVT, F); } } while (0)
#define GQ_APPLY(i, F) do { const int i_ = (i); f32x4 b0_ = z4, b1_ = z4; if (i_ < 9) { const int kb_ = q0i - 128 + i_ * 32; _Pragma("unroll") for (int j = 0; j < 4; ++j) { const int k0_ = kb_ + g * 4 + j, k1_ = k0_ + 16; \
                b0_[j] = (k0_ >= 0 && k0_ < S && k0_ >= qi - 128 && k0_ <= qi + 128) ? 0.f : -INFINITY; b1_[j] = (k1_ >= 0 && k1_ < S && k1_ >= qi - 128 && k1_ <= qi + 128) ? 0.f : -INFINITY; } } \
            if (i_ < 9) { attn_apply<true>(F, qa0, qa1, b0_, b1_, sa); attn_apply<true>(F, qb0, qb1, b0_, b1_, sb); attn_apply<true>(F, qc0, qc1, b0_, b1_, sc); } \
            else { attn_apply<false>(F, qa0, qa1, b0_, b1_, sa); attn_apply<false>(F, qb0, qb1, b0_, b1_, sb); attn_apply<false>(F, qc0, qc1, b0_, b1_, sc); } } while (0)
        KVFrag f2;
        const int i0 = lat ? 0 : 9;
        GQ_LOAD(i0, f);
#pragma unroll 1
        for (int i = i0; i < 17; i += 2) {
            if (i + 1 < 17) GQ_LOAD(i + 1, f2);
            GQ_APPLY(i, f);
            if (i + 1 < 17) { if (i + 2 < 17) GQ_LOAD(i + 2, f); GQ_APPLY(i + 1, f2); }
        }
#undef GQ_LOAD
#undef GQ_APPLY
        bf16_t* o = X1 + (size_t)R * D + 640 + kvh * 192 + g * 4;
        attn_store(sa, o, p.gqa_sink[l * 6 + kvh * 3 + 0] * LOG2E); attn_store(sb, o + 64, p.gqa_sink[l * 6 + kvh * 3 + 1] * LOG2E); attn_store(sc, o + 128, p.gqa_sink[l * 6 + kvh * 3 + 2] * LOG2E);
    } else {
        const int t3 = tk - NTASK_NA - NTASK_GQ, qt = t3 & 15, hb = t3 >> 4, h = hb % 6, b = hb / 6;
        const int R = NLAT + b * CTX + qt * 16 + fr;
        const bf16_t* qp = P + (size_t)R * PWS + COL_NAQ + h * 64 + g * 8;
        const bf16x8 q0 = ld16(qp), q1 = ld16(qp + 32);
        AttnState st; attn_init(st);
        const bf16_t* kc_ = (const bf16_t*)(p.ws + OFF_NAKFC) + (size_t)(b * 6 + h) * 16 * KVT + lane * 8;
        const bf16_t* vc_ = (const bf16_t*)(p.ws + OFF_NAVFC) + (size_t)(b * 6 + h) * 16 * KVT + lane * 8;
#pragma unroll
        for (int pp = 0; pp < 8; ++pp) { kv_load(kc_ + (size_t)(2 * pp) * KVT, kc_ + (size_t)(2 * pp + 1) * KVT, vc_ + (size_t)(2 * pp) * KVT, vc_ + (size_t)(2 * pp + 1) * KVT, f); attn_apply<false>(f, q0, q1, z4, z4, st); }
        attn_store(st, X1 + (size_t)R * D + 256 + h * 64 + g * 4, -INFINITY);
    }
}
template <int CTRL> DEV float dppf(float old, float v) { return __builtin_bit_cast(float, __builtin_amdgcn_update_dpp(__builtin_bit_cast(int, old), __builtin_bit_cast(int, v), CTRL, 0xf, 0xf, false)); }
template <bool FWD> DEV void row_scan(float& a, float& b) {
#define RG_STEP(SHR, SHL) { const float ap = FWD ? dppf<SHR>(1.f, a) : dppf<SHL>(1.f, a); const float bp = FWD ? dppf<SHR>(0.f, b) : dppf<SHL>(0.f, b); b = fmaf(a, bp, b); a = a * ap; }
    RG_STEP(0x111, 0x101) RG_STEP(0x112, 0x102) RG_STEP(0x114, 0x104) RG_STEP(0x118, 0x108)
#undef RG_STEP
}
DEV int rg_bwd_chunk(int pos) { return pos == 0 ? 1 : (pos == 1 ? 0 : 67 - pos); }
DEV void rg_coef(const f32x4& za, const f32x4& zi, const f32x4& ba, const f32x4& bi, const f32x4& spc, const f32x4& xv, f32x4& a, f32x4& b) {
#pragma unroll
    for (int j = 0; j < 4; ++j) {
        const float r = __builtin_amdgcn_rcpf(1.f + __expf(-(za[j] + ba[j])));
        const float ig = __builtin_amdgcn_rcpf(1.f + __expf(-(zi[j] + bi[j])));
        const float la = spc[j] * r;
        const float av = __expf(la);
        const float x2 = 2.f * la;
        float om = x2 * (1.f / 720.f) + (1.f / 120.f); om = om * x2 + (1.f / 24.f); om = om * x2 + (1.f / 6.f); om = om * x2 + 0.5f; om = om * x2 + 1.f; om = -x2 * om;
        if (x2 < -0.25f) om = 1.f - av * av;
        a[j] = av; b[j] = __builtin_amdgcn_sqrtf(om) * (ig * xv[j]);
    }
}
DEV void rg_item(const Params& p, int l, int rt, bf16_t* lds) {
    const int t = tid_(), lane = t & 63, n = t >> 6, g = lane >> 4, fr = lane & 15;
    const bf16_t* P = (const bf16_t*)(p.ws + OFF_P);
    const bool isctx = rt >= 512;
    const int b = isctx ? (rt - 512) >> 1 : rt >> 6, idx = isctx ? (rt - 512) & 1 : 2 + (rt & 63);
    const int L = isctx ? CTX : S, t0 = isctx ? idx * 128 : (idx - 2) * 128, seqbase = isctx ? NLAT + b * CTX : b * S;
    bf16_t* xl = lds + n * (128 * 64);
    {
        const int c = lane & 7, ch0 = n * 64 + c * 8;
        f32x4 cwa[4], cwb[4];
#pragma unroll
        for (int j = 0; j < 4; ++j) { cwa[j] = *(const f32x4*)(p.conv_w + (l * 4 + j) * 256 + ch0); cwb[j] = *(const f32x4*)(p.conv_w + (l * 4 + j) * 256 + ch0 + 4); }
        const f32x4 cba = *(const f32x4*)(p.conv_b + l * 256 + ch0), cbb = *(const f32x4*)(p.conv_b + l * 256 + ch0 + 4);
#pragma unroll 2
        for (int it = 0; it < 16; ++it) {
            const int tok = it * 8 + (lane >> 3), ts = t0 + tok;
            f32x4 acca = cba, accb = cbb;
#pragma unroll
            for (int j = 0; j < 4; ++j) {
                const int tj = ts + j - 2;
                if (tj >= 0 && tj < L) {
                    const uint4 v = *(const uint4*)(P + (size_t)(seqbase + tj) * PWS + COL_RGX + ch0);
                    const f32x4 xa = {__uint_as_float(v.x << 16), __uint_as_float(v.x & 0xffff0000u), __uint_as_float(v.y << 16), __uint_as_float(v.y & 0xffff0000u)};
                    const f32x4 xb = {__uint_as_float(v.z << 16), __uint_as_float(v.z & 0xffff0000u), __uint_as_float(v.w << 16), __uint_as_float(v.w & 0xffff0000u)};
                    acca = acca + cwa[j] * xa; accb = accb + cwb[j] * xb;
                }
            }
            uint4 o; o.x = pk2(acca[0], acca[1]); o.y = pk2(acca[2], acca[3]); o.z = pk2(accb[0], accb[1]); o.w = pk2(accb[2], accb[3]);
            *(uint4*)(xl + tok * 64 + ((c ^ ((tok >> 1) & 7)) * 8)) = o;
        }
    }
    asm volatile("s_waitcnt lgkmcnt(0)" ::: "memory");
    const bf16_t* W = (const bf16_t*)(p.ws + OFF_WRG) + (size_t)(l * 2) * 2 * 4 * 64 * 64;
    const float* C = (const float*)(p.ws + OFF_RGC) + (size_t)(l * 2) * 3 * 256;
    float* AGG = (float*)(p.ws + OFF_AGG) + (size_t)(b * 66) * 1024;
    const int swz = (fr >> 1) & 7;
#pragma unroll 1
    for (int ct = 0; ct < 4; ++ct) {
        const int ch = n * 64 + ct * 16 + g * 4;
        const f32x4 z4 = {0.f, 0.f, 0.f, 0.f};
#pragma unroll
        for (int dir = 0; dir < 2; ++dir) {
            const bf16x8 wa0 = ld16(W + ((size_t)((dir * 2 + 0) * 4 + n) * 64 + ct * 16 + fr) * 64 + g * 8), wa1 = ld16(W + ((size_t)((dir * 2 + 0) * 4 + n) * 64 + ct * 16 + fr) * 64 + 32 + g * 8);
            const bf16x8 wi0 = ld16(W + ((size_t)((dir * 2 + 1) * 4 + n) * 64 + ct * 16 + fr) * 64 + g * 8), wi1 = ld16(W + ((size_t)((dir * 2 + 1) * 4 + n) * 64 + ct * 16 + fr) * 64 + 32 + g * 8);
            const f32x4 ba = *(const f32x4*)(C + (dir * 3 + 0) * 256 + ch), bi = *(const f32x4*)(C + (dir * 3 + 1) * 256 + ch), spc = *(const f32x4*)(C + (dir * 3 + 2) * 256 + ch);
            f32x4 hin = z4, apre = {1.f, 1.f, 1.f, 1.f};
#pragma unroll
            for (int s = 0; s < 8; ++s) {
                const int tt = dir == 0 ? s : 7 - s;
                const int row = tt * 16 + fr;
                const bf16x8 x0 = *(const bf16x8*)(xl + row * 64 + ((g ^ swz) * 8)), x1 = *(const bf16x8*)(xl + row * 64 + (((g | 4) ^ swz) * 8));
                f32x4 za = __builtin_amdgcn_mfma_f32_16x16x32_bf16(wa0, x0, z4, 0, 0, 0); za = __builtin_amdgcn_mfma_f32_16x16x32_bf16(wa1, x1, za, 0, 0, 0);
                f32x4 zi = __builtin_amdgcn_mfma_f32_16x16x32_bf16(wi0, x0, z4, 0, 0, 0); zi = __builtin_amdgcn_mfma_f32_16x16x32_bf16(wi1, x1, zi, 0, 0, 0);
                const uint2 xr = *(const uint2*)(xl + row * 64 + (((ct * 2 + (g >> 1)) ^ swz) * 8) + (g & 1) * 4);
                const f32x4 xv = {__uint_as_float(xr.x << 16), __uint_as_float(xr.x & 0xffff0000u), __uint_as_float(xr.y << 16), __uint_as_float(xr.y & 0xffff0000u)};
                f32x4 a, bb;
                rg_coef(za, zi, ba, bi, spc, xv, a, bb);
                f32x4 h, ac;
#pragma unroll
                for (int j = 0; j < 4; ++j) {
                    float aj = a[j], bj = bb[j];
                    if (dir == 0) row_scan<true>(aj, bj); else row_scan<false>(aj, bj);
                    h[j] = fmaf(aj, hin[j], bj);
                    ac[j] = aj * apre[j];
                }
                {
                    bf16_t* xo = (bf16_t*)(p.ws + OFF_X2) + ((size_t)seqbase + t0 + row) * D + dir * 512 + ch * 2;
                    uint4 o; o.x = pk2(ac[0], ac[1]); o.y = pk2(ac[2], ac[3]); o.z = pk2(h[0], h[1]); o.w = pk2(h[2], h[3]); *(uint4*)xo = o;
                }
                const int src = (lane & 48) | (dir == 0 ? 15 : 0);
#pragma unroll
                for (int j = 0; j < 4; ++j) { hin[j] = shl_(h[j], src); apre[j] = shl_(ac[j], src); }
            }
            if (fr == 0) { *(f32x4*)(AGG + (size_t)(idx * 2 + dir) * 512 + ch) = apre; *(f32x4*)(AGG + (size_t)(idx * 2 + dir) * 512 + 256 + ch) = hin; }
        }
    }
}
DEV void rg_final(const Params& p, int l, int rt, float* part  ) {
    const int t = tid_(), cg4 = (t & 63) * 4, tp = t >> 6;
    const bool isctx = rt >= 512;
    const int b = isctx ? (rt - 512) >> 1 : rt >> 6, idx = isctx ? (rt - 512) & 1 : 2 + (rt & 63);
    const float* AGG = (const float*)(p.ws + OFF_AGG) + (size_t)(b * 66) * 1024;
    f32x4 hf = {0.f, 0.f, 0.f, 0.f}, hb = {0.f, 0.f, 0.f, 0.f};
    {
        const int nf = idx, nb = idx == 1 ? 0 : (idx == 0 ? 1 : 67 - idx);
        const int qf = (nf + 3) >> 2, qb = (nb + 3) >> 2;
        f32x4 Af = {1.f, 1.f, 1.f, 1.f}, Bf = {0.f, 0.f, 0.f, 0.f}, Ab = Af, Bb = Bf;
#pragma unroll 4
        for (int q = tp * qf; q < min((tp + 1) * qf, nf); ++q) { const f32x4 A = *(const f32x4*)(AGG + (size_t)(q * 2) * 512 + cg4), B = *(const f32x4*)(AGG + (size_t)(q * 2) * 512 + 256 + cg4); Bf = A * Bf + B; Af = A * Af; }
#pragma unroll 4
        for (int q = tp * qb; q < min((tp + 1) * qb, nb); ++q) { const int cq = rg_bwd_chunk(q); const f32x4 A = *(const f32x4*)(AGG + (size_t)(cq * 2 + 1) * 512 + cg4), B = *(const f32x4*)(AGG + (size_t)(cq * 2 + 1) * 512 + 256 + cg4); Bb = A * Bb + B; Ab = A * Ab; }
        *(f32x4*)(part + ((tp * 2 + 0) * 2 + 0) * 256 + cg4) = Af; *(f32x4*)(part + ((tp * 2 + 0) * 2 + 1) * 256 + cg4) = Bf;
        *(f32x4*)(part + ((tp * 2 + 1) * 2 + 0) * 256 + cg4) = Ab; *(f32x4*)(part + ((tp * 2 + 1) * 2 + 1) * 256 + cg4) = Bb;
        __syncthreads();
#pragma unroll
        for (int k = 0; k < 4; ++k) {
            hf = *(const f32x4*)(part + ((k * 2 + 0) * 2 + 0) * 256 + cg4) * hf + *(const f32x4*)(part + ((k * 2 + 0) * 2 + 1) * 256 + cg4);
            hb = *(const f32x4*)(part + ((k * 2 + 1) * 2 + 0) * 256 + cg4) * hb + *(const f32x4*)(part + ((k * 2 + 1) * 2 + 1) * 256 + cg4);
        }
    }
    const bf16_t* X2 = (const bf16_t*)(p.ws + OFF_X2); const bf16_t* P = (const bf16_t*)(p.ws + OFF_P); bf16_t* X1 = (bf16_t*)(p.ws + OFF_X1);
#pragma unroll 4
    for (int i = 0; i < 32; ++i) {
        const size_t R = (size_t)rt * 128 + i * 4 + tp;
        const uint4 cf = *(const uint4*)(X2 + R * D + cg4 * 2), cb = *(const uint4*)(X2 + R * D + 512 + cg4 * 2);
        const uint2 af = make_uint2(cf.x, cf.y), bf = make_uint2(cf.z, cf.w), ab = make_uint2(cb.x, cb.y), bb = make_uint2(cb.z, cb.w);
        const uint2 gr = *(const uint2*)(P + R * PWS + COL_GATE + cg4);
#define BLO(u) __uint_as_float((u) << 16)
#define BHI(u) __uint_as_float((u) & 0xffff0000u)
        const float h0 = (BLO(af.x) * hf[0] + BLO(bf.x)) + (BLO(ab.x) * hb[0] + BLO(bb.x));
        const float h1 = (BHI(af.x) * hf[1] + BHI(bf.x)) + (BHI(ab.x) * hb[1] + BHI(bb.x));
        const float h2 = (BLO(af.y) * hf[2] + BLO(bf.y)) + (BLO(ab.y) * hb[2] + BLO(bb.y));
        const float h3 = (BHI(af.y) * hf[3] + BHI(bf.y)) + (BHI(ab.y) * hb[3] + BHI(bb.y));
        uint2 o; o.x = pk2(h0 * gelu_tanh(BLO(gr.x)), h1 * gelu_tanh(BHI(gr.x))); o.y = pk2(h2 * gelu_tanh(BLO(gr.y)), h3 * gelu_tanh(BHI(gr.y)));
#undef BLO
#undef BHI
        *(uint2*)(X1 + R * D + cg4) = o;
    }
}
DEV void ph_rgagg(const Params& p, int l, bf16_t* lds) {
    for (int rt = bid_(); rt < 528; rt += gridDim.x) { rg_item(p, l, rt, lds); __syncthreads(); }
}

DEV void outproj_item(const Params& p_, int l, int rt, bf16_t* lds, float* stat  ) {
    const Params& p = kp_();
    const int t = tid_(), lane = t & 63, w = t >> 6, wm = w >> 1, wn = w & 1, fq = lane >> 4, fr = lane & 15;
    const bf16_t* A = (const bf16_t*)(p.ws + OFF_X1) + (size_t)(rt * 128) * D;
    const bool isctx = rt >= 512;
    const float* g1 = modvec(p, l, rt * 128, 2);
    __syncthreads();
    rg_final(p, l, rt, (float*)lds);
    asm volatile("s_waitcnt vmcnt(0)" ::: "memory");
    __syncthreads();
    __builtin_amdgcn_fence(__ATOMIC_ACQUIRE, "agent");
#pragma unroll 1
    for (int pass = 0; pass < 4; ++pass) {
        const bf16_t* Bt = (const bf16_t*)(p.ws + OFF_WOUTT) + ((size_t)l * 1024 + pass * 256) * 1024;
        const unsigned toff = (unsigned)(((tid_() >> 2) * 1024 + gemm_src_chunk(tid_())) * 2);
        f32x4 acc[4][8]; zero_acc(acc);
        gemm_mainloop(A, toff, toff + 64 * D * 2, Bt, toff, 1024, 32, lds, acc);
#pragma unroll
        for (int mt = 0; mt < 4; ++mt) {
            const int rl = wm * 64 + mt * 16 + fr, R = rt * 128 + rl;
            const float* xin = (l == 0) ? (isctx ? p.ctx + (size_t)(R - NLAT) * D : p.x + (size_t)R * D) : xres_row(p, R);
            float* xo = xres_row(p, R);
            float s = 0.f, q = 0.f;
#pragma unroll
            for (int nt = 0; nt < 8; ++nt) {
                const int col = pass * 256 + wn * 128 + nt * 16 + fq * 4;
                const f32x4 xv = *(const f32x4*)(xin + col), gv = *(const f32x4*)(g1 + col);
                const f32x4 u = xv * ALPHA + gv * acc[mt][nt];
                *(f32x4*)(xo + col) = u;
                s += (u[0] + u[1]) + (u[2] + u[3]); q += (u[0] * u[0] + u[1] * u[1]) + (u[2] * u[2] + u[3] * u[3]);
            }
            s += shx(s, 16); s += shx(s, 32); q += shx(q, 16); q += shx(q, 32);
            if (fq == 0) { float* sp = stat + (wn * 128 + rl) * 2; if (pass == 0) { sp[0] = s; sp[1] = q; } else { sp[0] += s; sp[1] += q; } }
        }
    }
    asm volatile("s_waitcnt vmcnt(0)" ::: "memory");
    __syncthreads();
    __builtin_amdgcn_fence(__ATOMIC_ACQUIRE, "agent");
    {
        bf16_t* X2 = (bf16_t*)(p.ws + OFF_X2);
        const bf16_t* WRh = (const bf16_t*)(p.ws + OFF_WR) + (size_t)(l * 2) * 48 * 1024 + (size_t)fr * 1024 + fq * 8;
        const bf16_t* WRl = WRh + 48 * 1024;
        float* vec = (float*)((unsigned char*)lds + 24576);
        {
            const float* lg = p.ln1_g + l * D; const float* lb = p.ln1_b + l * D;
            const float* sh2 = modvec(p, l, rt * 128, 3); const float* sc2 = modvec(p, l, rt * 128, 4);
            const int k4 = t * 4;
            *(f32x4*)(vec + k4) = *(const f32x4*)(lg + k4); *(f32x4*)(vec + 1024 + k4) = *(const f32x4*)(lb + k4);
            *(f32x4*)(vec + 2048 + k4) = *(const f32x4*)(sc2 + k4) + 1.f; *(f32x4*)(vec + 3072 + k4) = *(const f32x4*)(sh2 + k4);
        }
        float mean[2], rstd[2];
#pragma unroll
        for (int tm = 0; tm < 2; ++tm) {
            const int rl = w * 32 + tm * 16 + fr;
            float s = 0.f, q = 0.f;
#pragma unroll
            for (int i = 0; i < 2; ++i) { s += stat[(i * 128 + rl) * 2]; q += stat[(i * 128 + rl) * 2 + 1]; }
            mean[tm] = s * (1.f / D);
            rstd[tm] = rsqrtf(fmaxf(q * (1.f / D) - mean[tm] * mean[tm], 0.f) + LN_EPS);
        }
        __syncthreads();
        float* xr0 = xres_row(p, rt * 128 + w * 32 + fr) + fq * 8;
        float* xr1 = xres_row(p, rt * 128 + w * 32 + 16 + fr) + fq * 8;
        bf16_t* h20 = X2 + (size_t)(rt * 128 + w * 32 + fr) * D + fq * 8; bf16_t* h21 = h20 + (size_t)16 * D;
        f32x4 lacc[3][2];
#pragma unroll
        for (int a = 0; a < 3; ++a) { lacc[a][0] = (f32x4){0.f, 0.f, 0.f, 0.f}; lacc[a][1] = (f32x4){0.f, 0.f, 0.f, 0.f}; }
        f32x4 nu00 = *(const f32x4*)xr0, nu01 = *(const f32x4*)(xr0 + 4), nu10 = *(const f32x4*)xr1, nu11 = *(const f32x4*)(xr1 + 4);
        bf16x8 nwh0 = *(const bf16x8*)(WRh), nwh1 = *(const bf16x8*)(WRh + 16 * 1024), nwh2 = *(const bf16x8*)(WRh + 32 * 1024);
        bf16x8 nwl0 = *(const bf16x8*)(WRl), nwl1 = *(const bf16x8*)(WRl + 16 * 1024), nwl2 = *(const bf16x8*)(WRl + 32 * 1024);
#pragma unroll 2
        for (int ks = 0; ks < 32; ++ks) {
            const f32x4 u00 = nu00, u01 = nu01, u10 = nu10, u11 = nu11;
            const bf16x8 wh0 = nwh0, wh1 = nwh1, wh2 = nwh2, wl0 = nwl0, wl1 = nwl1, wl2 = nwl2;
            if (ks + 1 < 32) {
                const int ko = (ks + 1) * 32;
                nu00 = *(const f32x4*)(xr0 + ko); nu01 = *(const f32x4*)(xr0 + ko + 4); nu10 = *(const f32x4*)(xr1 + ko); nu11 = *(const f32x4*)(xr1 + ko + 4);
                nwh0 = *(const bf16x8*)(WRh + ko); nwh1 = *(const bf16x8*)(WRh + 16 * 1024 + ko); nwh2 = *(const bf16x8*)(WRh + 32 * 1024 + ko);
                nwl0 = *(const bf16x8*)(WRl + ko); nwl1 = *(const bf16x8*)(WRl + 16 * 1024 + ko); nwl2 = *(const bf16x8*)(WRl + 32 * 1024 + ko);
            }
            const int k = ks * 32 + fq * 8;
            const f32x4 g0 = *(const f32x4*)(vec + k), g1v = *(const f32x4*)(vec + k + 4), b0 = *(const f32x4*)(vec + 1024 + k), b1 = *(const f32x4*)(vec + 1024 + k + 4);
            const f32x4 c0 = *(const f32x4*)(vec + 2048 + k), c1 = *(const f32x4*)(vec + 2048 + k + 4), s0 = *(const f32x4*)(vec + 3072 + k), s1 = *(const f32x4*)(vec + 3072 + k + 4);
            bf16x8 hh0, hl0, hh1, hl1;
            {
                const f32x4 x0 = (u00 - mean[0]) * rstd[0] * g0 + b0, x1 = (u01 - mean[0]) * rstd[0] * g1v + b1;
                *(f32x4*)(xr0 + ks * 32) = x0; *(f32x4*)(xr0 + ks * 32 + 4) = x1;
                const f32x4 h0 = x0 * c0 + s0, h1 = x1 * c1 + s1;
#pragma unroll
                for (int e = 0; e < 4; ++e) { const bf16_t a = f2bf(h0[e]), b = f2bf(h1[e]); hh0[e] = (short)a; hh0[4 + e] = (short)b; hl0[e] = (short)f2bf(h0[e] - bf2f(a)); hl0[4 + e] = (short)f2bf(h1[e] - bf2f(b)); }
                *(bf16x8*)(h20 + ks * 32) = hh0;
            }
            {
                const f32x4 x0 = (u10 - mean[1]) * rstd[1] * g0 + b0, x1 = (u11 - mean[1]) * rstd[1] * g1v + b1;
                *(f32x4*)(xr1 + ks * 32) = x0; *(f32x4*)(xr1 + ks * 32 + 4) = x1;
                const f32x4 h0 = x0 * c0 + s0, h1 = x1 * c1 + s1;
#pragma unroll
                for (int e = 0; e < 4; ++e) { const bf16_t a = f2bf(h0[e]), b = f2bf(h1[e]); hh1[e] = (short)a; hh1[4 + e] = (short)b; hl1[e] = (short)f2bf(h0[e] - bf2f(a)); hl1[4 + e] = (short)f2bf(h1[e] - bf2f(b)); }
                *(bf16x8*)(h21 + ks * 32) = hh1;
            }
#define RT_MMA(ft, WH, WL) do { \
            lacc[ft][0] = __builtin_amdgcn_mfma_f32_16x16x32_bf16(WH, hh0, lacc[ft][0], 0, 0, 0); lacc[ft][0] = __builtin_amdgcn_mfma_f32_16x16x32_bf16(WL, hh0, lacc[ft][0], 0, 0, 0); lacc[ft][0] = __builtin_amdgcn_mfma_f32_16x16x32_bf16(WH, hl0, lacc[ft][0], 0, 0, 0); \
            lacc[ft][1] = __builtin_amdgcn_mfma_f32_16x16x32_bf16(WH, hh1, lacc[ft][1], 0, 0, 0); lacc[ft][1] = __builtin_amdgcn_mfma_f32_16x16x32_bf16(WL, hh1, lacc[ft][1], 0, 0, 0); lacc[ft][1] = __builtin_amdgcn_mfma_f32_16x16x32_bf16(WH, hl1, lacc[ft][1], 0, 0, 0); } while (0)
            RT_MMA(0, wh0, wl0); RT_MMA(1, wh1, wl1); RT_MMA(2, wh2, wl2);
#undef RT_MMA
        }
        __syncthreads();
        float* lt = (float*)lds;
        int* lcnt = (int*)((unsigned char*)lds + 24576); int* lbase = lcnt + 32;
        if (t < 32) lcnt[t] = 0;
#pragma unroll
        for (int ft = 0; ft < 3; ++ft)
#pragma unroll
            for (int tm = 0; tm < 2; ++tm)
#pragma unroll
                for (int j = 0; j < 4; ++j) lt[(w * 32 + tm * 16 + fr) * 48 + ft * 16 + fq * 4 + j] = lacc[ft][tm][j];
        __syncthreads();
        int E0 = 0, E1 = 0, r0 = 0, r1 = 0; float w0 = 0.f, w1 = 0.f;
        const int rl = w * 32 + (lane & 31), R = rt * 128 + rl;
        if (lane < 32) {
            const float* lr = lt + rl * 48;
            int gi = 0; float gm = lr[0] + p.router_g_b[l * 4];
            float gl[4]; gl[0] = gm;
#pragma unroll
            for (int j = 1; j < 4; ++j) { gl[j] = lr[j] + p.router_g_b[l * 4 + j]; if (gl[j] > gm) { gm = gl[j]; gi = j; } }
            float gs = 0.f;
#pragma unroll
            for (int j = 0; j < 4; ++j) gs += expf(gl[j] - gm);
            const float ptop = 1.f / gs;
            int e0 = 0, e1 = 0; float m0 = -INFINITY, m1 = -INFINITY;
            for (int j = 0; j < 8; ++j) {
                const float v = lr[4 + gi * 8 + j] + p.router_e_b[l * 32 + gi * 8 + j];
                if (v > m0) { m1 = m0; e1 = e0; m0 = v; e0 = j; } else if (v > m1) { m1 = v; e1 = j; }
            }
            const float ex = expf(m1 - m0);
            w0 = ptop / (1.f + ex); w1 = ptop * ex / (1.f + ex);
            E0 = gi * 8 + e0; E1 = gi * 8 + e1;
            r0 = atomicAdd(lcnt + E0, 1); r1 = atomicAdd(lcnt + E1, 1);
        }
        __syncthreads();
        if (t < 32) { const int c = lcnt[t]; lbase[t] = c ? (int)atomicAdd((unsigned*)(p.ws + OFF_CTL) + CW_CNT + l * 32 + t, (unsigned)c) : 0; }
        __syncthreads();
        if (lane < 32) {
            int* rte = (int*)(p.ws + OFF_RTE); float* rtw = (float*)(p.ws + OFF_RTW);
            int* list = (int*)(p.ws + OFF_LIST);
            rte[R * 2] = E0; rte[R * 2 + 1] = E1; rtw[R * 2] = w0; rtw[R * 2 + 1] = w1;
            list[(size_t)E0 * LISTCAP + lbase[E0] + r0] = R * 2;
            list[(size_t)E1 * LISTCAP + lbase[E1] + r1] = R * 2 + 1;
        }
    }
}
DEV void ph_outproj(const Params& p, int l, bf16_t* lds, float* stat  ) {
    for (int rt = bid_(); rt < 512; rt += gridDim.x) { outproj_item(p, l, rt, lds, stat); __syncthreads(); }
}

DEV void moe1_item(const Params& p_, int l, int e, int jb, int pass, int item, int cnt, bf16_t* lds) {
    const Params& p = kp_();
    const int t = tid_(), lane = t & 63, w = t >> 6, wm = w >> 1, wn = w & 1, fq = lane >> 4, fr = lane & 15;
    const int* list = (const int*)(p.ws + OFF_LIST) + (size_t)e * LISTCAP;
    const bf16_t* X2 = (const bf16_t*)(p.ws + OFF_X2);
    bf16_t* Hs = (bf16_t*)(p.ws + OFF_P) + (size_t)item * 128 * FF;
    unsigned ao0, ao1;
    { const int s0 = jb * 128 + (t >> 2), s1 = s0 + 64;
      const int tok0 = s0 < cnt ? (list[s0] >> 1) : 0, tok1 = s1 < cnt ? (list[s1] >> 1) : 0;
      ao0 = (unsigned)((tok0 * D + gemm_src_chunk(t)) * 2); ao1 = (unsigned)((tok1 * D + gemm_src_chunk(t)) * 2); }
    const bf16_t* Bt = (const bf16_t*)(p.ws + OFF_WGU) + ((size_t)e * 1024 + pass * 256) * 1024;
    f32x4 acc[4][8]; zero_acc(acc);
    gemm_mainloop(X2, ao0, ao1, Bt, (unsigned)((gemm_perm_row(t >> 2) * 1024 + gemm_src_chunk(t)) * 2), 1024, 32, lds, acc);
#pragma unroll
    for (int mt = 0; mt < 4; ++mt) {
        const int rl = wm * 64 + mt * 16 + fr;
#pragma unroll
        for (int q = 0; q < 2; ++q) {
            const f32x4 g0 = acc[mt][2 * q], g1 = acc[mt][2 * q + 1], u0 = acc[mt][2 * q + 4], u1 = acc[mt][2 * q + 5];
            float h0[4], h1[4];
#pragma unroll
            for (int jj = 0; jj < 4; ++jj) { h0[jj] = g0[jj] * __builtin_amdgcn_rcpf(1.f + __expf(-g0[jj])) * u0[jj]; h1[jj] = g1[jj] * __builtin_amdgcn_rcpf(1.f + __expf(-g1[jj])) * u1[jj]; }
            uint4 o; o.x = pk2(h0[0], h0[1]); o.y = pk2(h0[2], h0[3]); o.z = pk2(h1[0], h1[1]); o.w = pk2(h1[2], h1[3]);
            *(uint4*)(Hs + (size_t)rl * FF + pass * 128 + wn * 64 + q * 32 + fq * 8) = o;
        }
    }
}
DEV void moe2_item(const Params& p_, int l, int e, int jb, int pass, int item, int cnt, bf16_t* lds) {
    const Params& p = kp_();
    const int t = tid_(), lane = t & 63, w = t >> 6, wm = w >> 1, wn = w & 1, fq = lane >> 4, fr = lane & 15;
    const int* list = (const int*)(p.ws + OFF_LIST) + (size_t)e * LISTCAP;
    const bf16_t* Hs = (const bf16_t*)(p.ws + OFF_P) + (size_t)item * 128 * FF;
    const unsigned hoff = (unsigned)(((t >> 2) * FF + gemm_src_chunk(t)) * 2);
    const unsigned boff = (unsigned)((gemm_perm_row(t >> 2) * FF + gemm_src_chunk(t)) * 2);
    const float* rtw = (const float*)(p.ws + OFF_RTW);
    bf16_t* Y = (bf16_t*)(p.ws + OFF_Y);
    const bf16_t* Bt = (const bf16_t*)(p.ws + OFF_WD) + ((size_t)e * 1024 + pass * 256) * FF;
    f32x4 acc[4][8]; zero_acc(acc);
    gemm_mainloop(Hs, hoff, hoff + 64 * FF * 2, Bt, boff, FF, 16, lds, acc);
#pragma unroll
    for (int mt = 0; mt < 4; ++mt) {
        const int s = jb * 128 + wm * 64 + mt * 16 + fr;
        if (s < cnt) {
            const int ent = list[s];
            const float gw = rtw[ent];
            bf16_t* yo = Y + (size_t)ent * D + pass * 256 + wn * 128 + fq * 8;
#pragma unroll
            for (int q = 0; q < 4; ++q) { const f32x4 v0 = acc[mt][2 * q] * gw, v1 = acc[mt][2 * q + 1] * gw; uint4 o; o.x = pk2(v0[0], v0[1]); o.y = pk2(v0[2], v0[3]); o.z = pk2(v1[0], v1[1]); o.w = pk2(v1[2], v1[3]); *(uint4*)(yo + q * 32) = o; }
        }
    }
}
template <int STAGE> DEV void ph_moe(const Params& p, int l, bf16_t* lds, int* s_pref  , int* s_cnt  , int* slot, int ph) {
    const unsigned* cnt = (const unsigned*)(p.ws + OFF_CTL) + CW_CNT + l * 32;
    if (tid_() == 0) { int a = 0; for (int e = 0; e < 32; ++e) { const int c = (int)cnt[e]; s_cnt[e] = c; s_pref[e] = a; a += (c + 127) >> 7; } s_pref[32] = a; }
    __syncthreads();
#pragma unroll 1
    for (int hop = 0; hop < 8; ++hop) {
        const int xq = (bid_() + hop) & 7;
        unsigned* ctr = (unsigned*)(p.ws + OFF_CTL) + CW_Q + ph * 8 + xq;
        const int n0 = (s_cnt[xq] + 127) >> 7, n1 = (s_cnt[xq + 8] + 127) >> 7, n2 = (s_cnt[xq + 16] + 127) >> 7, n3 = (s_cnt[xq + 24] + 127) >> 7;
        const int nloc = (n0 + n1 + n2 + n3) * 4;
        int it = q_pull(ctr, slot);
        while (it < nloc) {
            int nreg = 0;
            if (tid_() == 0) nreg = (int)atomicAdd(ctr, 1u);
            const int pass = it & 3, ib = it >> 2;
            int e, jb;
            if (ib < n0) { e = xq; jb = ib; } else if (ib < n0 + n1) { e = xq + 8; jb = ib - n0; } else if (ib < n0 + n1 + n2) { e = xq + 16; jb = ib - n0 - n1; } else { e = xq + 24; jb = ib - n0 - n1 - n2; }
            if (STAGE == 1) moe1_item(p, l, e, jb, pass, s_pref[e] + jb, s_cnt[e], lds); else moe2_item(p, l, e, jb, pass, s_pref[e] + jb, s_cnt[e], lds);
            it = q_publish(nreg, slot);
        }
    }
    __syncthreads();
}

DEV void ph_rowin(const Params& p, int l, bf16_t* lds, int* slot, int ph) {
    const int np = l == 0 ? 9 : 5, nci = 16 * np, ntot = nci + 1024;
    unsigned* ctr = (unsigned*)(p.ws + OFF_CTL) + CW_Q + ph * 8;
    const int w = tid_() >> 6;
    for (;;) {
        const int it = q_pull(ctr, slot);
        if (it >= ntot) break;
        if (it < nci) {
            const int rt = 512 + it / np, pass = it % np;
            for (int r = w * NRW; r < 128; r += 4 * NRW) { if (l == 0) rowop<0, true>(p, 0, rt * 128 + r); else rowop<1, false>(p, 1, rt * 128 + r); }
            asm volatile("s_waitcnt vmcnt(0)" ::: "memory");
            __syncthreads();
            __builtin_amdgcn_fence(__ATOMIC_ACQUIRE, "agent");
            inproj_item(p, l, rt, pass, lds);
        } else {
            const int r0 = (it - nci) * 64;
            for (int r = w * NRW; r < 64; r += 4 * NRW) { if (l == 0) rowop<0, true>(p, 0, r0 + r); else rowop<1, true>(p, 1, r0 + r); }
        }
    }
}
DEV void ph_inproj2(const Params& p, int l, bf16_t* lds, int* slot, int ph) {
    const int xcd = bid_() & 7;
    unsigned* ctr = (unsigned*)(p.ws + OFF_CTL) + CW_Q + ph * 8 + xcd;
    const int ntot = 2 + 768 + (l == 0 ? 32 : 0);
    int it = q_pull(ctr, slot);
    while (it < ntot) {
        int nreg = 0;
        if (tid_() == 0) nreg = (int)atomicAdd(ctr, 1u);
        if (it < 2) { rg_item(p, l, 512 + 2 * xcd + it, lds); }
        else if (it < 770) {
            const int q = it - 2, m = q >> 2, r = q & 3;
            if (r < 3) { const int i = m * 3 + r; inproj_item(p, l, xcd * 64 + i / 9, i % 9, lds); }
            else { __syncthreads(); expert_conv_item(p, l, xcd * 192 + m, (float*)lds); }
        }
        else { const int i = it - 770, w = tid_() >> 6;
            const int tk = i < 24 ? NTASK_NA + NTASK_GQ + (xcd * 24 + i) * 4 + w : NTASK_NA + NTASK_GQ + NTASK_CNA + (xcd * 8 + (i - 24)) * 4 + w;
            attn_task(p, l, tk, (const float*)lds); }
        it = q_publish(nreg, slot);
    }
}
DEV void ph_mixer(const Params& p, int l, bf16_t* lds, float* stat, int* slot, int ph) {
    const int xcd = bid_() & 7;
    unsigned* ctr = (unsigned*)(p.ws + OFF_CTL) + CW_Q + ph * 8 + xcd;
    const int n0 = l == 0 ? 2 : 0, n1 = n0 + 64, n2 = n1 + 256, n3 = n2 + 768, ntot = n3;
    bool rpb_ok = false;
    float* rpb2 = (float*)lds;
    int it = q_pull(ctr, slot);
    while (it < ntot) {
        int nreg = 0;
        if (tid_() == 0) nreg = (int)atomicAdd(ctr, 1u);
        if (it < n0) { outproj_item(p, l, 512 + 2 * xcd + it, lds, stat); rpb_ok = false; }
        else if (it < n1) { rg_item(p, l, xcd * 64 + (it - n0), lds); rpb_ok = false; }
        else if (it < n3) {
            if (!rpb_ok) { for (int i = tid_(); i < 6 * 15 * 31; i += 256) rpb2[i] = p.na_rpb[(size_t)l * 6 * 15 * 31 + i] * LOG2E; __syncthreads(); rpb_ok = true; }
            const int w = tid_() >> 6;
            int tk;
            if (it < n2) { const int i = it - n1; tk = NTASK_NA + (2 * xcd + (i >> 7)) * 512 + (i & 127) * 4 + w; }
            else { const int i = it - n2; tk = (6 * xcd + (i >> 7)) * 512 + (i & 127) * 4 + w; }
            attn_task(p, l, tk, rpb2);
        }
        it = q_publish(nreg, slot);
    }
}

#define XB_TMO      128
#define XB_XCNT(j)  (256  + 64 * (j))
#define XB_XSUB(j)  (1280 + 64 * (j))
#define XB_XGEN(j)  (2304 + 64 * (j))
#define XB_TOP      3328
#define XB_TOPGEN   3392
#define XCD_BAR_WORDS 3456
#define XB_SPIN_CAP (1u << 20)
DEV unsigned xb_ld(unsigned* p) { return __hip_atomic_load(p, __ATOMIC_RELAXED, __HIP_MEMORY_SCOPE_AGENT); }
DEV unsigned xb_add(unsigned* p, unsigned v) { return __hip_atomic_fetch_add(p, v, __ATOMIC_RELAXED, __HIP_MEMORY_SCOPE_AGENT); }
DEV unsigned xb_xcc_id() { return (unsigned)__builtin_amdgcn_s_getreg((3 << 11) | 20) & 0xFu; }
#define XB_SPIN(cond, bar) do { unsigned _sp = 0; while (cond) { __builtin_amdgcn_s_sleep(1); \
    if ((++_sp & 255u) == 0u) { if (xb_ld(&(bar)[XB_TMO])) break; if (_sp > XB_SPIN_CAP) { atomicAdd(&(bar)[XB_TMO], 1u); break; } } } } while (0)
struct XcdBarrier { unsigned* bar; unsigned x; volatile LAS unsigned* st; };
DEV XcdBarrier xcd_barrier_post(unsigned* bar, volatile LAS unsigned* st) {
    XcdBarrier b; b.bar = bar; b.x = xb_xcc_id(); b.st = st;
    if (tid_() == 0) (void)xb_add(&bar[XB_XCNT(b.x)], 1u);
    return b;
}
DEV void xcd_barrier_complete(unsigned* bar, unsigned x, unsigned& nloc, unsigned& nx) {
    const unsigned G = gridDim.x * gridDim.y * gridDim.z;
    unsigned sum, cnt, mine, sp = 0u;
    for (;;) {
        sum = 0u; cnt = 0u; mine = 0u;
#pragma unroll
        for (unsigned j = 0; j < 16; ++j) { const unsigned c = xb_ld(&bar[XB_XCNT(j)]); sum += c; cnt += (c > 0u) ? 1u : 0u; mine = (j == x) ? c : mine; }
        if (sum == G) break;
        __builtin_amdgcn_s_sleep(1);
        if ((++sp & 255u) == 0u) { if (xb_ld(&bar[XB_TMO])) break; if (sp > XB_SPIN_CAP) { atomicAdd(&bar[XB_TMO], 1u); break; } }
    }
    nloc = mine > 0u ? mine : 1u; nx = cnt > 0u ? cnt : 1u;
}
DEV void xcd_barrier(const XcdBarrier& b) {
    asm volatile("s_waitcnt vmcnt(0)" ::: "memory");
    __syncthreads();
    if (tid_() == 0) {
        unsigned* bar = b.bar;
        __builtin_amdgcn_s_waitcnt(0);
        unsigned nloc = b.st[0], nx = b.st[1];
        if (nloc == 0u) { xcd_barrier_complete(bar, b.x, nloc, nx); b.st[0] = nloc; b.st[1] = nx; }
        const unsigned old = xb_add(&bar[XB_XSUB(b.x)], 1u);
        const unsigned gen = old / nloc;
        if (old + 1u == (gen + 1u) * nloc) {
            __builtin_amdgcn_fence(__ATOMIC_RELEASE, "agent");
            asm volatile("s_waitcnt vmcnt(0)" ::: "memory");
            const unsigned og = xb_add(&bar[XB_TOP], 1u);
            const unsigned tg = og / nx;
            if (og + 1u == (tg + 1u) * nx) xb_add(&bar[XB_TOPGEN], 1u);
            else XB_SPIN(xb_ld(&bar[XB_TOPGEN]) == tg, bar);
            __builtin_amdgcn_fence(__ATOMIC_ACQUIRE, "agent");
            xb_add(&bar[XB_XGEN(b.x)], 1u);
            asm volatile("s_waitcnt vmcnt(0)" ::: "memory");
        } else {
            XB_SPIN(xb_ld(&bar[XB_XGEN(b.x)]) == gen, bar);
            __builtin_amdgcn_fence(__ATOMIC_ACQUIRE, "agent");
            asm volatile("s_waitcnt vmcnt(0)" ::: "memory");
        }
    }
    __syncthreads();
}

namespace cg = cooperative_groups;
constexpr int SMEM_STAT = GEMM_LDS_BYTES;
constexpr int SMEM_BYTES = GEMM_LDS_BYTES + 2048 + 512;
constexpr int NPHASE = 14;
__global__ void __launch_bounds__(256, 2) mega(Params p, int ph_lo, int ph_hi) {
    extern __shared__ __attribute__((aligned(16))) unsigned char smem[];
    bf16_t* lds = (bf16_t*)smem;
    float* stat = (float*)(smem + SMEM_STAT);
    int* s_pref = (int*)(smem + SMEM_STAT + 2048); int* s_cnt = s_pref + 40;
    int* qslot = (int*)(smem + SMEM_STAT + 2048 + 416);
    volatile LAS unsigned* bst = (volatile LAS unsigned*)(LAS unsigned char*)(smem + SMEM_STAT + 2048 + 400);
    if (tid_() < 2) bst[tid_()] = 0u;
    __syncthreads();
    (void)xcd_barrier_post((unsigned*)(kp_().ws + OFF_CTL + 4096), bst);
#define GRID_BAR() do { XcdBarrier xb_; xb_.bar = (unsigned*)(kp_().ws + OFF_CTL + 4096); xb_.x = xb_xcc_id(); \
        xb_.st = (volatile LAS unsigned*)(LAS unsigned char*)(smem + SMEM_STAT + 2048 + 400); xcd_barrier(xb_); } while (0)
#define IN(k) (ph_lo <= (k) && (k) < ph_hi)
#define SEAM(k) do { if (IN(k) && IN((k) + 1)) { if ((k) == 0) cg::this_grid().sync(); else GRID_BAR(); } } while (0)
    if (IN(0)) {
        ph_mod(kp_(), (float*)smem); __syncthreads();
        ph_rope(kp_());
        ph_routerw(kp_());
        ph_rgprep(kp_());
        ph_transpose(kp_().w_in, (bf16_t*)(kp_().ws + OFF_WINT), 1024, 2304, 0, 2, (size_t)1024 * 2304, (size_t)2304 * 1024, (float*)smem);
        ph_transpose(kp_().w_out, (bf16_t*)(kp_().ws + OFF_WOUTT), 1024, 1024, 0, 2, (size_t)1024 * 1024, (size_t)1024 * 1024, (float*)smem);
    }
    SEAM(0);
#define LAYER_BODY(l, pb) { \
        if (IN(pb + 0)) ph_rowin(kp_(), l, lds, qslot, pb + 0); \
        SEAM(pb + 0); \
        if (IN(pb + 1)) ph_inproj2(kp_(), l, lds, qslot, pb + 1); \
        SEAM(pb + 1); \
        if (IN(pb + 2)) ph_mixer(kp_(), l, lds, stat, qslot, pb + 2); \
        SEAM(pb + 2); \
        if (IN(pb + 3)) ph_outproj(kp_(), l, lds, stat); \
        SEAM(pb + 3); \
        if (IN(pb + 4)) ph_moe<1>(kp_(), l, lds, s_pref, s_cnt, qslot, pb + 4); \
        SEAM(pb + 4); \
        if (IN(pb + 5)) ph_moe<2>(kp_(), l, lds, s_pref, s_cnt, qslot, pb + 5); \
        SEAM(pb + 5); \
    }
    LAYER_BODY(0, 1)
    LAYER_BODY(1, 7)
#undef LAYER_BODY
    if (IN(NPHASE - 1)) ph_rowop<2>(kp_(), 2, NLAT);
#undef IN
#undef SEAM
}

#ifndef ONE_LAUNCH
#define ONE_LAUNCH 1
#endif
extern "C" void kernel_launch(void* const* d_in, const int* in_sizes, int n_in, void* d_out, int out_size, void* d_ws, size_t ws_size, hipStream_t stream) {
    if (n_in != 28 || ws_size < WS_TOTAL || out_size != NLAT * D) { fprintf(stderr, "kernel_launch: unexpected shapes / workspace (%d inputs, ws %zu need %zu)\n", n_in, ws_size, (size_t)WS_TOTAL); return; }
    static int grid = 0;
    if (grid == 0) {
        int dev = 0, cus = 0, per_cu = 0;
        (void)hipGetDevice(&dev);
        (void)hipDeviceGetAttribute(&cus, hipDeviceAttributeMultiprocessorCount, dev);
        (void)hipFuncSetAttribute((const void*)mega, hipFuncAttributeMaxDynamicSharedMemorySize, SMEM_BYTES);
        (void)hipOccupancyMaxActiveBlocksPerMultiprocessor(&per_cu, (const void*)mega, 256, SMEM_BYTES);
        if (per_cu > 2) per_cu = 2;
        grid = cus * per_cu;
        if (grid <= 0) { fprintf(stderr, "kernel_launch: occupancy query gave %d blocks per CU on %d CUs\n", per_cu, cus); grid = -1; }
    }
    if (grid < 0) return;
    Params p{};
    const float** pp = (const float**)&p;
    for (int i = 0; i < 28; ++i) pp[i] = (const float*)d_in[i];
    p.out = (float*)d_out; p.ws = (unsigned char*)d_ws;
    (void)hipMemsetAsync((unsigned char*)d_ws + OFF_CTL, 0, CTL_BYTES, stream);
#if ONE_LAUNCH
    int lo = 0, hi = NPHASE;
    void* args[] = {(void*)&p, (void*)&lo, (void*)&hi};
    hipError_t e = hipLaunchCooperativeKernel((const void*)mega, dim3(grid), dim3(256), args, SMEM_BYTES, stream);
    if (e != hipSuccess) fprintf(stderr, "kernel_launch: cooperative launch failed: %s (grid %d)\n", hipGetErrorString(e), grid);
#else
    for (int ph = 0; ph < NPHASE; ++ph) mega<<<grid, 256, SMEM_BYTES, stream>>>(p, ph, ph + 1);
#endif
}
```

```cpp
#include <hip/hip_runtime.h>
#include <hip/hip_cooperative_groups.h>
#include <stdint.h>
#include <cstdio>

typedef unsigned short bf16_t;
typedef short bf16x8 __attribute__((ext_vector_type(8)));
typedef float f32x4 __attribute__((ext_vector_type(4)));

#define DEV __device__ __forceinline__

constexpr int D = 1024, NB = 8, S = 8192, CTX = 256;
constexpr int NLAT = NB * S, NCTX = NB * CTX, NTOK = NLAT + NCTX;
constexpr int PWS = 1280;
constexpr int COL_RGX = 0, COL_GATE = 256, COL_NAQ = 512, COL_GQ = 896;
constexpr int KVT = 1024;
constexpr int NE = 32, FF = 512;
constexpr int LISTCAP = NTOK;
constexpr int NCLS = 112;
constexpr float ALPHA = 1.4142135623730951f;
constexpr float LN_EPS = 1e-5f;

constexpr size_t al256(size_t x) { return (x + 255) & ~(size_t)255; }
constexpr size_t OFF_CTL   = 0;
constexpr size_t CTL_BYTES = 4096 + 16384;
constexpr size_t OFF_MOD   = OFF_CTL + CTL_BYTES;
constexpr size_t OFF_ROPE  = al256(OFF_MOD + (size_t)2 * 9 * 6144 * 4);
constexpr size_t OFF_RTE   = al256(OFF_ROPE + (size_t)2 * 128 * 16 * 4);
constexpr size_t OFF_RTW   = al256(OFF_RTE + (size_t)NTOK * 8);
constexpr size_t OFF_LIST  = al256(OFF_RTW + (size_t)NTOK * 8);
constexpr size_t OFF_WR    = al256(OFF_LIST + (size_t)NE * LISTCAP * 8);
constexpr size_t OFF_WRG   = al256(OFF_WR + (size_t)2 * 2 * 48 * 1024 * 2);
constexpr size_t OFF_RGC   = al256(OFF_WRG + (size_t)2 * 2 * 2 * 4 * 64 * 64 * 2);
constexpr size_t OFF_AGG   = al256(OFF_RGC + (size_t)2 * 2 * 3 * 256 * 4);
constexpr size_t OFF_WINT  = al256(OFF_AGG + (size_t)NB * 66 * 2 * 2 * 256 * 4);
constexpr size_t OFF_WOUTT = al256(OFF_WINT + (size_t)2 * 2304 * 1024 * 2);
constexpr size_t OFF_WGU   = al256(OFF_WOUTT + (size_t)2 * 1024 * 1024 * 2);
constexpr size_t OFF_WD    = al256(OFF_WGU + (size_t)NE * 1024 * 1024 * 2);
constexpr size_t OFF_XCTX  = al256(OFF_WD + (size_t)NE * 1024 * 512 * 2);
constexpr size_t OFF_X1    = al256(OFF_XCTX + (size_t)NCTX * D * 4);
constexpr size_t OFF_X2    = al256(OFF_X1 + (size_t)NTOK * D * 2);
constexpr size_t OFF_P     = al256(OFF_X2 + (size_t)NTOK * D * 2);
constexpr size_t OFF_NAKF  = al256(OFF_P + (size_t)NTOK * PWS * 2);
constexpr size_t OFF_NAVF  = al256(OFF_NAKF + (size_t)NB * 6 * 512 * KVT * 2);
constexpr size_t OFF_GKF   = al256(OFF_NAVF + (size_t)NB * 6 * 512 * KVT * 2);
constexpr size_t OFF_GVF   = al256(OFF_GKF + (size_t)NB * 2 * 512 * KVT * 2);
constexpr size_t OFF_NAKFC = al256(OFF_GVF + (size_t)NB * 2 * 512 * KVT * 2);
constexpr size_t OFF_NAVFC = al256(OFF_NAKFC + (size_t)NB * 6 * 16 * KVT * 2);
constexpr size_t OFF_GKFC  = al256(OFF_NAVFC + (size_t)NB * 6 * 16 * KVT * 2);
constexpr size_t OFF_GVFC  = al256(OFF_GKFC + (size_t)NB * 2 * 16 * KVT * 2);
constexpr size_t OFF_Y     = al256(OFF_GVFC + (size_t)NB * 2 * 16 * KVT * 2);
constexpr size_t OFF_XB    = OFF_Y + (size_t)NTOK * D * 2;
constexpr size_t OFF_LNS   = al256(OFF_Y + (size_t)2 * NTOK * D * 2);
constexpr size_t OFF_LIST2 = al256(OFF_LNS + (size_t)NTOK * 8);
constexpr size_t WS_TOTAL  = al256(OFF_LIST2 + (size_t)NCLS * LISTCAP * 4);
constexpr int CW_CNT = 0;
constexpr int CW_CNT2 = 256;

struct Params {
    const float *x, *c, *ctx, *c_ctx, *w_ada, *b_ada, *w_in, *conv_w, *conv_b, *rg_a_w, *rg_a_b, *rg_i_w, *rg_i_b, *rg_lambda,
        *na_rpb, *gqa_sink, *w_out, *ln1_g, *ln1_b, *router_g_w, *router_g_b, *router_e_w, *router_e_b, *exp_w_gate, *exp_w_up,
        *exp_w_down, *ln2_g, *ln2_b;
    float* out;
    unsigned char* ws;
};

DEV const Params& kp_() { const void* q = (const void*)__builtin_amdgcn_kernarg_segment_ptr(); asm volatile("" : "+s"(q)); return *(const Params*)q; }
#if defined(__HIP_DEVICE_COMPILE__)
template <class T> DEV T* as_global(T* q) { __builtin_assume((!__builtin_amdgcn_is_shared((const void*)q)) & (!__builtin_amdgcn_is_private((const void*)q))); return q; }
#else
template <class T> DEV T* as_global(T* q) { return q; }
#endif
#define G_(x) as_global(x)
#define GAS __attribute__((address_space(1)))
typedef unsigned u32x4_t __attribute__((ext_vector_type(4)));
typedef unsigned u32x2_t __attribute__((ext_vector_type(2)));
typedef float f32x2g_t __attribute__((ext_vector_type(2)));
typedef float f32x4g_t __attribute__((ext_vector_type(4)));
DEV uint4 ldg_u4(const void* q) { const u32x4_t v = *(const GAS u32x4_t*)q; return make_uint4(v.x, v.y, v.z, v.w); }
DEV uint2 ldg_u2(const void* q) { const u32x2_t v = *(const GAS u32x2_t*)q; return make_uint2(v.x, v.y); }
DEV int2 ldg_i2(const void* q) { const u32x2_t v = *(const GAS u32x2_t*)q; return make_int2((int)v.x, (int)v.y); }
DEV float4 ldg_f4(const void* q) { const f32x4g_t v = *(const GAS f32x4g_t*)q; return make_float4(v.x, v.y, v.z, v.w); }
DEV float2 ldg_f2(const void* q) { const f32x2g_t v = *(const GAS f32x2g_t*)q; return make_float2(v.x, v.y); }
DEV void stg_u4(void* q, const uint4& v) { const u32x4_t w = {v.x, v.y, v.z, v.w}; *(GAS u32x4_t*)q = w; }
DEV void stg_u2(void* q, const uint2& v) { const u32x2_t w = {v.x, v.y}; *(GAS u32x2_t*)q = w; }
DEV void stg_i2(void* q, const int2& v) { const u32x2_t w = {(unsigned)v.x, (unsigned)v.y}; *(GAS u32x2_t*)q = w; }
DEV void stg_f4(void* q, const float4& v) { const f32x4g_t w = {v.x, v.y, v.z, v.w}; *(GAS f32x4g_t*)q = w; }
DEV void stg_f2(void* q, const float2& v) { const f32x2g_t w = {v.x, v.y}; *(GAS f32x2g_t*)q = w; }
DEV unsigned char* WS_() { const __attribute__((address_space(4))) Params* q = (const __attribute__((address_space(4))) Params*)__builtin_amdgcn_kernarg_segment_ptr(); asm volatile("" : "+s"(q)); return q->ws; }
#define KP_(m) ([]() __attribute__((always_inline)) { const __attribute__((address_space(4))) Params* q_ = (const __attribute__((address_space(4))) Params*)__builtin_amdgcn_kernarg_segment_ptr(); asm volatile("" : "+s"(q_)); return q_->m; }())
DEV int tid_() { int t = threadIdx.x; asm volatile("" : "+v"(t)); return t; }
DEV int bid_() { int b = blockIdx.x; asm volatile("" : "+s"(b)); return b; }
DEV float shx(float v, int m) { return __builtin_bit_cast(float, __builtin_amdgcn_ds_bpermute(((tid_() & 63) ^ m) << 2, __builtin_bit_cast(int, v))); }
DEV float shl_(float v, int src) { return __builtin_bit_cast(float, __builtin_amdgcn_ds_bpermute(src << 2, __builtin_bit_cast(int, v))); }
DEV float bf2f(bf16_t h) { return __uint_as_float((unsigned)h << 16); }
typedef float f32x2_t __attribute__((ext_vector_type(2)));
typedef __bf16 bf16x2_t __attribute__((ext_vector_type(2)));
DEV unsigned pk2b(float lo, float hi) { const f32x2_t v = {lo, hi}; return __builtin_bit_cast(unsigned, __builtin_convertvector(v, bf16x2_t)); }
DEV bf16_t f2bf(float f) { unsigned r; asm("v_cvt_pk_bf16_f32 %0, %1, %1" : "=v"(r) : "v"(f)); return (bf16_t)(r & 0xffffu); }
DEV unsigned pk2(float lo, float hi) { unsigned r; asm("v_cvt_pk_bf16_f32 %0, %1, %2" : "=v"(r) : "v"(lo), "v"(hi)); return r; }
DEV float wave_sum(float v) {
#pragma unroll
    for (int o = 1; o < 64; o <<= 1) v += shx(v, o);
    return v;
}
DEV float wave_max(float v) {
#pragma unroll
    for (int o = 1; o < 64; o <<= 1) v = fmaxf(v, shx(v, o));
    return v;
}
DEV float gelu_tanh(float x) {
    const float u = 0.7978845608028654f * (x + 0.044715f * x * x * x);
    const float t = 1.f - 2.f * __builtin_amdgcn_rcpf(1.f + __expf(2.f * u));
    return 0.5f * x * (1.f + t);
}
DEV float* xres_row(const Params& p, int R) {
    return R < NLAT ? KP_(out) + (size_t)R * D : (float*)(WS_() + OFF_XCTX) + (size_t)(R - NLAT) * D;
}
DEV const float* modvec(const Params& p, int l, int R, int seg) {
    const int b = R < NLAT ? R / S : 8;
    return (const float*)(WS_() + OFF_MOD) + ((size_t)(l * 9 + b) * 6 + seg) * 1024;
}

DEV void ph_mod(const Params& p, float* sc  ) {
    if (bid_() >= 192) return;
    for (int i = tid_(); i < 9 * 1024; i += 256) { const float v = (i < 8192) ? KP_(c)[i] : KP_(c_ctx)[i - 8192]; sc[i] = v / (1.f + expf(-v)); }
    __syncthreads();
    const int lane = tid_() & 63, w = tid_() >> 6, cg = lane & 15, kg = lane >> 4;
    const int col = bid_() * 64 + cg * 4;
    const int l = col / 6144, j = col % 6144, ks = (w * 4 + kg) * 64;
    const float* wp = KP_(w_ada) + (size_t)l * 1024 * 6144 + j + (size_t)ks * 6144;
    const float* s = sc + ks;
    f32x4 a0 = {0.f, 0.f, 0.f, 0.f}, a1 = a0, a2 = a0, a3 = a0, a4 = a0, a5 = a0, a6 = a0, a7 = a0, a8 = a0;
#pragma unroll 8
    for (int k = 0; k < 64; ++k) {
        const f32x4 wv = *(const GAS f32x4*)(wp + (size_t)k * 6144);
        a0 += s[k] * wv; a1 += s[1024 + k] * wv; a2 += s[2048 + k] * wv; a3 += s[3072 + k] * wv; a4 += s[4096 + k] * wv;
        a5 += s[5120 + k] * wv; a6 += s[6144 + k] * wv; a7 += s[7168 + k] * wv; a8 += s[8192 + k] * wv;
    }
#define MOD_RED(a) do { _Pragma("unroll") for (int e = 0; e < 4; ++e) { float v = a[e]; v += shx(v, 16); v += shx(v, 32); a[e] = v; } } while (0)
    MOD_RED(a0); MOD_RED(a1); MOD_RED(a2); MOD_RED(a3); MOD_RED(a4); MOD_RED(a5); MOD_RED(a6); MOD_RED(a7); MOD_RED(a8);
#undef MOD_RED
    __syncthreads();
    float* red = sc + 9 * 1024;
    if (kg == 0) {
        *(f32x4*)(red + (w * 9 + 0) * 64 + cg * 4) = a0; *(f32x4*)(red + (w * 9 + 1) * 64 + cg * 4) = a1; *(f32x4*)(red + (w * 9 + 2) * 64 + cg * 4) = a2;
        *(f32x4*)(red + (w * 9 + 3) * 64 + cg * 4) = a3; *(f32x4*)(red + (w * 9 + 4) * 64 + cg * 4) = a4; *(f32x4*)(red + (w * 9 + 5) * 64 + cg * 4) = a5;
        *(f32x4*)(red + (w * 9 + 6) * 64 + cg * 4) = a6; *(f32x4*)(red + (w * 9 + 7) * 64 + cg * 4) = a7; *(f32x4*)(red + (w * 9 + 8) * 64 + cg * 4) = a8;
    }
    __syncthreads();
    if (w == 0) {
        const int c1 = bid_() * 64 + lane, j1 = c1 % 6144;
        const float bias = KP_(b_ada)[l * 6144 + j1];
        float* mod = (float*)(WS_() + OFF_MOD) + (size_t)l * 9 * 6144 + j1;
#pragma unroll
        for (int r = 0; r < 9; ++r) mod[r * 6144] = ((red[(0 * 9 + r) * 64 + lane] + red[(1 * 9 + r) * 64 + lane]) + (red[(2 * 9 + r) * 64 + lane] + red[(3 * 9 + r) * 64 + lane])) + bias;
    }
}

DEV void sincos_red(float ang, float& sn, float& cs) {
    const float n = rintf(ang * 0.15915494309189535f);
    float r = fmaf(-n, 6.2831854820251465f, ang);
    r = fmaf(-n, -1.7484555e-07f, r);
    float sgn = 1.f;
    if (r > 1.5707963267948966f) { r = 3.14159265358979f - r; sgn = -1.f; }
    else if (r < -1.5707963267948966f) { r = -3.14159265358979f - r; sgn = -1.f; }
    const float r2 = r * r;
    float sp = -1.6059044e-10f; sp = fmaf(sp, r2, 2.5052108e-08f); sp = fmaf(sp, r2, -2.7557319e-06f); sp = fmaf(sp, r2, 1.9841270e-04f);
    sp = fmaf(sp, r2, -8.3333333e-03f); sp = fmaf(sp, r2, 1.6666667e-01f); sp = fmaf(sp * -1.f, r2, 1.f);
    sn = r * sp;
    float cp = -1.1470746e-11f; cp = fmaf(cp, r2, 2.0876757e-09f); cp = fmaf(cp, r2, -2.7557319e-07f); cp = fmaf(cp, r2, 2.4801587e-05f);
    cp = fmaf(cp, r2, -1.3888889e-03f); cp = fmaf(cp, r2, 4.1666667e-02f); cp = fmaf(cp, r2, -0.5f); cp = fmaf(cp, r2, 1.f);
    cs = sgn * cp;
}
DEV void ph_rope(const Params& p) {
    const int i = (bid_() - 192) * 256 + tid_();
    if (i < 0 || i >= 128 * 16) return;
    const int pos = i >> 4, q = i & 15;
    const float inv = exp2f(-(float)q * (13.287712379549449f / 16.f));
    float sn, cs; sincos_red((float)pos * inv, sn, cs);
    float* tab = (float*)(WS_() + OFF_ROPE);
    tab[i] = cs; tab[2048 + i] = sn;
}

DEV void ph_routerw(const Params& p) {
  for (int i = bid_() * 256 + tid_(); i < 2 * 48 * 1024; i += gridDim.x * 256) {
    const int l = i / (48 * 1024), f = (i / 1024) % 48, k = i & 1023;
    float w = 0.f;
    if (f < 4) w = KP_(router_g_w)[((size_t)l * 1024 + k) * 4 + f]; else if (f < 36) w = KP_(router_e_w)[((size_t)l * 1024 + k) * 32 + (f - 4)];
    const bf16_t hi = f2bf(w), lo = f2bf(w - bf2f(hi));
    bf16_t* WR = (bf16_t*)(WS_() + OFF_WR);
    WR[((size_t)(l * 2 + 0) * 48 + f) * 1024 + k] = hi;
    WR[((size_t)(l * 2 + 1) * 48 + f) * 1024 + k] = lo;
  }
}

DEV void ph_rgprep(const Params& p) {
    bf16_t* W = (bf16_t*)(WS_() + OFF_WRG);
    for (int i = bid_() * 256 + tid_(); i < 2 * 2 * 2 * 4 * 64 * 64; i += gridDim.x * 256) {
        const int d = i & 63, e = (i >> 6) & 63, n = (i >> 12) & 3, gate = (i >> 14) & 1, ld = i >> 15;
        const float* srcw = gate ? KP_(rg_i_w) : KP_(rg_a_w);
        W[i] = f2bf(srcw[((size_t)(ld * 4 + n) * 64 + d) * 64 + e]);
    }
    float* C = (float*)(WS_() + OFF_RGC);
    for (int i = bid_() * 256 + tid_(); i < 2 * 2 * 256; i += gridDim.x * 256) {
        const int c = i & 255, ld = i >> 8;
        C[(ld * 3 + 0) * 256 + c] = KP_(rg_a_b)[ld * 256 + c];
        C[(ld * 3 + 1) * 256 + c] = KP_(rg_i_b)[ld * 256 + c];
        C[(ld * 3 + 2) * 256 + c] = -8.f * log1pf(expf(-KP_(rg_lambda)[ld * 256 + c]));
    }
}

DEV int tr_row(int n, int mode) { return mode == 0 ? n : ((n >> 7) * 256 + ((n >> 6) & 1) * 128 + (n & 63) + (mode == 2 ? 64 : 0)); }
DEV void transpose_tile(const float* src, bf16_t* dst, int K, int N, int mode, int tile, float* lds) {
    const int ntn = N >> 6, kt = tile / ntn, nt = tile % ntn, k0 = kt * 64, n0 = nt * 64, t = tid_();
#pragma unroll
    for (int i = 0; i < 4; ++i) {
        const int r = (t >> 4) + 16 * i, c4 = (t & 15) * 4;
        const float4 v = ldg_f4(src + (size_t)(k0 + r) * N + n0 + c4);
        lds[r * 65 + c4] = v.x; lds[r * 65 + c4 + 1] = v.y; lds[r * 65 + c4 + 2] = v.z; lds[r * 65 + c4 + 3] = v.w;
    }
    __syncthreads();
#pragma unroll
    for (int i = 0; i < 2; ++i) {
        const int n = (t >> 3) + 32 * i, kc = (t & 7) * 8;
        uint4 o;
        o.x = pk2(lds[(kc + 0) * 65 + n], lds[(kc + 1) * 65 + n]); o.y = pk2(lds[(kc + 2) * 65 + n], lds[(kc + 3) * 65 + n]);
        o.z = pk2(lds[(kc + 4) * 65 + n], lds[(kc + 5) * 65 + n]); o.w = pk2(lds[(kc + 6) * 65 + n], lds[(kc + 7) * 65 + n]);
        stg_u4(dst + (size_t)tr_row(n0 + n, mode) * K + k0 + kc, o);
    }
    __syncthreads();
}
DEV void transpose_tile_w(const float* src, bf16_t* dst, int K, int N, int mode, int tile, float* lds  ) {
    const int ntn = N >> 6, kt = tile / ntn, nt = tile % ntn, k0 = kt * 64, n0 = nt * 64, t = tid_() & 63;
    float4 v[16];
#pragma unroll
    for (int i = 0; i < 16; ++i) v[i] = ldg_f4(src + (size_t)(k0 + (t >> 4) + 4 * i) * N + n0 + (t & 15) * 4);
#pragma unroll
    for (int i = 0; i < 16; ++i) { const int r = (t >> 4) + 4 * i, c4 = (t & 15) * 4; lds[r * 65 + c4] = v[i].x; lds[r * 65 + c4 + 1] = v[i].y; lds[r * 65 + c4 + 2] = v[i].z; lds[r * 65 + c4 + 3] = v[i].w; }
    asm volatile("s_waitcnt lgkmcnt(0)" ::: "memory");
#pragma unroll
    for (int i = 0; i < 8; ++i) {
        const int n = (t >> 3) + 8 * i, kc = (t & 7) * 8;
        uint4 o;
        o.x = pk2(lds[(kc + 0) * 65 + n], lds[(kc + 1) * 65 + n]); o.y = pk2(lds[(kc + 2) * 65 + n], lds[(kc + 3) * 65 + n]);
        o.z = pk2(lds[(kc + 4) * 65 + n], lds[(kc + 5) * 65 + n]); o.w = pk2(lds[(kc + 6) * 65 + n], lds[(kc + 7) * 65 + n]);
        stg_u4(dst + (size_t)tr_row(n0 + n, mode) * K + k0 + kc, o);
    }
    asm volatile("s_waitcnt lgkmcnt(0)" ::: "memory");
}
DEV void expert_conv_item(const Params& p, int l, int gi, float* lds) {
    const int w = tid_() >> 6;
    float* my = lds + w * (64 * 65);
#pragma unroll 1
    for (int k = 0; k < 2; ++k) {
        const int T = gi * 8 + w * 2 + k, kind = T >> 12, Tl = T & 4095, e = Tl >> 7, tile = Tl & 127;
        if (kind == 0) transpose_tile_w(KP_(exp_w_gate) + ((size_t)l * NE + e) * 1024 * 512, (bf16_t*)(WS_() + OFF_WGU) + (size_t)e * 1024 * 1024, 1024, 512, 1, tile, my);
        else if (kind == 1) transpose_tile_w(KP_(exp_w_up) + ((size_t)l * NE + e) * 1024 * 512, (bf16_t*)(WS_() + OFF_WGU) + (size_t)e * 1024 * 1024, 1024, 512, 2, tile, my);
        else transpose_tile_w(KP_(exp_w_down) + ((size_t)l * NE + e) * 512 * 1024, (bf16_t*)(WS_() + OFF_WD) + (size_t)e * 1024 * 512, 512, 1024, 0, tile, my);
    }
}
DEV void ph_transpose(const float* src, bf16_t* dst, int K, int N, int mode, int nmat, size_t sstride, size_t dstride, float* lds  ) {
    const int per = (K >> 6) * (N >> 6);
    const int first = (int)gridDim.x > 256 ? 192 : 0, nblk = (int)gridDim.x - first;
    if (bid_() < first) return;
    for (int it = bid_() - first; it < nmat * per; it += nblk) {
        const int m = it / per, tile = it % per;
        transpose_tile(src + (size_t)m * sstride, dst + (size_t)m * dstride, K, N, mode, tile, lds);
    }
}

constexpr int NRW = 4;
template <int MODE, bool WX> DEV void rowop(const Params& p, int l, int R_) {
    const int R = __builtin_amdgcn_readfirstlane(R_);
    const int lane = tid_() & 63;
#define RK(i) (((i) >> 1) * 512 + lane * 8 + ((i) & 1) * 4)
    float4 v[NRW][4];
    float* xr0 = MODE != 0 ? xres_row(p, R) : nullptr;
    if (MODE == 0) {
#pragma unroll
        for (int r = 0; r < NRW; ++r) {
            const int Rr = R + r;
            const float* src = Rr < NLAT ? KP_(x) + (size_t)Rr * D : KP_(ctx) + (size_t)(Rr - NLAT) * D;
#pragma unroll
            for (int i = 0; i < 4; ++i) v[r][i] = ldg_f4(src + RK(i));
        }
    } else {
        const float* g2 = modvec(p, l - 1, R, 5);
        const float* lg = KP_(ln2_g) + (l - 1) * D; const float* lb = KP_(ln2_b) + (l - 1) * D;
        const float* l1g = KP_(ln1_g) + (l - 1) * D; const float* l1b = KP_(ln1_b) + (l - 1) * D;
        float4 xv[NRW][4]; uint2 ya[NRW][4]; float m1[NRW], r1[NRW];
#pragma unroll
        for (int r = 0; r < NRW; ++r) {
            { const float2 st = ldg_f2((const float*)(WS_() + OFF_LNS) + (size_t)(R + r) * 2); m1[r] = st.x; r1[r] = st.y; }
            const bf16_t* y0 = (const bf16_t*)(WS_() + OFF_Y) + (size_t)(R + r) * D;
#pragma unroll
            for (int i = 0; i < 4; ++i) xv[r][i] = ldg_f4(xr0 + r * D + RK(i));
#pragma unroll
            for (int h = 0; h < 2; ++h) { const uint4 a8 = ldg_u4(y0 + RK(2 * h)); ya[r][2 * h] = make_uint2(a8.x, a8.y); ya[r][2 * h + 1] = make_uint2(a8.z, a8.w); }
        }
        float s[NRW] = {0.f, 0.f, 0.f, 0.f};
#pragma unroll
        for (int i = 0; i < 4; ++i) {
            const float4 gv = ldg_f4(g2 + RK(i)), a1 = ldg_f4(l1g + RK(i)), b1 = ldg_f4(l1b + RK(i));
#pragma unroll
            for (int r = 0; r < NRW; ++r) {
                const uint2 a = ya[r][i];
                float4 x1;
                x1.x = (xv[r][i].x - m1[r]) * r1[r] * a1.x + b1.x; x1.y = (xv[r][i].y - m1[r]) * r1[r] * a1.y + b1.y;
                x1.z = (xv[r][i].z - m1[r]) * r1[r] * a1.z + b1.z; x1.w = (xv[r][i].w - m1[r]) * r1[r] * a1.w + b1.w;
                float4 u;
                u.x = ALPHA * x1.x + gv.x * bf2f((bf16_t)(a.x & 0xffff));
                u.y = ALPHA * x1.y + gv.y * bf2f((bf16_t)(a.x >> 16));
                u.z = ALPHA * x1.z + gv.z * bf2f((bf16_t)(a.y & 0xffff));
                u.w = ALPHA * x1.w + gv.w * bf2f((bf16_t)(a.y >> 16));
                v[r][i] = u; s[r] += (u.x + u.y) + (u.z + u.w);
            }
        }
        float q[NRW] = {0.f, 0.f, 0.f, 0.f};
#pragma unroll
        for (int r = 0; r < NRW; ++r) {
            const float mean = wave_sum(s[r]) * (1.f / D);
#pragma unroll
            for (int i = 0; i < 4; ++i) { v[r][i].x -= mean; v[r][i].y -= mean; v[r][i].z -= mean; v[r][i].w -= mean; q[r] += (v[r][i].x * v[r][i].x + v[r][i].y * v[r][i].y) + (v[r][i].z * v[r][i].z + v[r][i].w * v[r][i].w); }
        }
#pragma unroll
        for (int r = 0; r < NRW; ++r) q[r] = rsqrtf(wave_sum(q[r]) * (1.f / D) + LN_EPS);
#pragma unroll
        for (int i = 0; i < 4; ++i) {
            const int k = RK(i);
            const float4 gg = ldg_f4(lg + k); const float4 bb = ldg_f4(lb + k);
#pragma unroll
            for (int r = 0; r < NRW; ++r) {
                v[r][i].x = v[r][i].x * q[r] * gg.x + bb.x; v[r][i].y = v[r][i].y * q[r] * gg.y + bb.y; v[r][i].z = v[r][i].z * q[r] * gg.z + bb.z; v[r][i].w = v[r][i].w * q[r] * gg.w + bb.w;
                if (WX && MODE == 2) stg_f4(xr0 + r * D + k, v[r][i]);
            }
        }
    }
    if (MODE != 2) {
        const float* sh = modvec(p, l, R, 0); const float* sc = modvec(p, l, R, 1);
#pragma unroll
        for (int h = 0; h < 2; ++h) {
            const int k = RK(2 * h);
            const float4 s4a = ldg_f4(sh + k), c4a = ldg_f4(sc + k), s4b = ldg_f4(sh + k + 4), c4b = ldg_f4(sc + k + 4);
#pragma unroll
            for (int r = 0; r < NRW; ++r) {
                bf16_t* ha = (bf16_t*)(WS_() + OFF_X1) + (size_t)(R + r) * D;
                const float4 va = v[r][2 * h], vb = v[r][2 * h + 1];
                uint4 o; o.x = pk2(va.x * (1.f + c4a.x) + s4a.x, va.y * (1.f + c4a.y) + s4a.y); o.y = pk2(va.z * (1.f + c4a.z) + s4a.z, va.w * (1.f + c4a.w) + s4a.w);
                o.z = pk2(vb.x * (1.f + c4b.x) + s4b.x, vb.y * (1.f + c4b.y) + s4b.y); o.w = pk2(vb.z * (1.f + c4b.z) + s4b.z, vb.w * (1.f + c4b.w) + s4b.w);
                stg_u4(ha + k, o);
                if (WX && MODE == 1) {
                    uint4 xo; xo.x = pk2(va.x, va.y); xo.y = pk2(va.z, va.w); xo.z = pk2(vb.x, vb.y); xo.w = pk2(vb.z, vb.w);
                    stg_u4((bf16_t*)(WS_() + OFF_XB) + (size_t)(R + r) * D + k, xo);
                }
            }
        }
    }
#undef RK
}
template <int MODE> DEV void ph_rowop(const Params& p, int l, int nrows) {
    const int w = tid_() >> 6;
    for (int R = (bid_() * 4 + w) * NRW; R < nrows; R += gridDim.x * 4 * NRW) rowop<MODE, true>(p, l, R);
}
constexpr int CW_Q = 64;
DEV int q_publish(int nreg, int* slot) {
    __syncthreads();
    if (tid_() == 0) *slot = nreg;
    __syncthreads();
    return *(volatile int*)slot;
}
DEV int q_pull(unsigned* ctr, int* slot) {
    if (tid_() == 0) *slot = (int)atomicAdd(ctr, 1u);
    __syncthreads();
    const int v = *(volatile int*)slot;
    __syncthreads();
    return v;
}

constexpr int GEMM_STAGE_BYTES = 384 * 64;
constexpr int GEMM_NSTAGE = 3;
constexpr int GEMM_LDS_BYTES = GEMM_NSTAGE * GEMM_STAGE_BYTES;
#define LAS __attribute__((address_space(3)))
DEV int gemm_perm_row(int r) { const int i = r & 15, n = (r >> 4) & 1; return (r & ~31) + 8 * (i >> 2) + 4 * n + (i & 3); }
DEV int gemm_src_chunk(int t) { return ((t & 3) ^ ((0 - (t >> 4)) & 3)) * 8; }
template <bool SWAP = false> DEV void gemm_mainloop(const bf16_t* Abase, unsigned ao0, unsigned ao1, const bf16_t* Bbase, unsigned bo, unsigned ldb, int nk, bf16_t* lds, f32x4 (&acc)[4][8], int ksw = 1 << 30, long bsw = 0) {
    const int t = tid_(), lane = t & 63, w = __builtin_amdgcn_readfirstlane(t >> 6), wm = w >> 1, wn = w & 1;
    LAS unsigned char* L = (LAS unsigned char*)lds;
    const int pc = ((lane >> 4) ^ ((0 - ((lane & 15) >> 2)) & 3)) * 16;
    const int arow = (wm * 64 + (lane & 15)) * 64 + pc, brow = (128 + wn * 128 + (lane & 15)) * 64 + pc;
    const char* Ab = (const char*)Abase; const char* B0 = (const char*)Bbase; const char* B1 = B0 + (size_t)ldb * 128; const char* B2 = B0 + (size_t)ldb * 256; const char* B3 = B0 + (size_t)ldb * 384;
#define GEMM_ISSUE(slot, ko) do { LAS unsigned* d_ = (LAS unsigned*)(L + (slot) * GEMM_STAGE_BYTES + w * 1024); const long sw_ = (int)(ko) >= ksw ? bsw : 0; \
        __builtin_amdgcn_global_load_lds((const unsigned*)(Ab + (ao0 + (ko) * 2u)), d_, 16, 0, 0); \
        __builtin_amdgcn_global_load_lds((const unsigned*)(Ab + (ao1 + (ko) * 2u)), d_ + 1024, 16, 0, 0); \
        __builtin_amdgcn_global_load_lds((const unsigned*)(B0 + sw_ + (bo + (ko) * 2u)), d_ + 2048, 16, 0, 0); \
        __builtin_amdgcn_global_load_lds((const unsigned*)(B1 + sw_ + (bo + (ko) * 2u)), d_ + 3072, 16, 0, 0); \
        __builtin_amdgcn_global_load_lds((const unsigned*)(B2 + sw_ + (bo + (ko) * 2u)), d_ + 4096, 16, 0, 0); \
        __builtin_amdgcn_global_load_lds((const unsigned*)(B3 + sw_ + (bo + (ko) * 2u)), d_ + 5120, 16, 0, 0); } while (0)
    asm volatile("s_waitcnt vmcnt(0)" ::: "memory");
    __builtin_amdgcn_s_barrier();
    asm volatile("" ::: "memory");
    GEMM_ISSUE(0, 0);
    if (nk > 1) GEMM_ISSUE(1, 32);
    int cs = 0, is = 2;
    for (int kt = 0; kt < nk; ++kt) {
        if (kt + 1 < nk) asm volatile("s_waitcnt vmcnt(6)" ::: "memory"); else asm volatile("s_waitcnt vmcnt(0)" ::: "memory");
        __builtin_amdgcn_s_barrier();
        asm volatile("" ::: "memory");
        if (kt + 2 < nk) GEMM_ISSUE(is, (kt + 2) * 32);
        const LAS unsigned char* cur = L + cs * GEMM_STAGE_BYTES;
        const bf16x8 af0 = *(const LAS bf16x8*)(cur + arow), af1 = *(const LAS bf16x8*)(cur + arow + 16 * 64), af2 = *(const LAS bf16x8*)(cur + arow + 32 * 64), af3 = *(const LAS bf16x8*)(cur + arow + 48 * 64);
        bf16x8 bq0 = *(const LAS bf16x8*)(cur + brow), bq1 = *(const LAS bf16x8*)(cur + brow + 16 * 64);
#pragma unroll
        for (int nt = 0; nt < 8; ++nt) {
            const bf16x8 bfr = bq0; bq0 = bq1;
            if (nt + 2 < 8) bq1 = *(const LAS bf16x8*)(cur + brow + (nt + 2) * 16 * 64);
            acc[0][nt] = SWAP ? __builtin_amdgcn_mfma_f32_16x16x32_bf16(af0, bfr, acc[0][nt], 0, 0, 0) : __builtin_amdgcn_mfma_f32_16x16x32_bf16(bfr, af0, acc[0][nt], 0, 0, 0);
            acc[1][nt] = SWAP ? __builtin_amdgcn_mfma_f32_16x16x32_bf16(af1, bfr, acc[1][nt], 0, 0, 0) : __builtin_amdgcn_mfma_f32_16x16x32_bf16(bfr, af1, acc[1][nt], 0, 0, 0);
            acc[2][nt] = SWAP ? __builtin_amdgcn_mfma_f32_16x16x32_bf16(af2, bfr, acc[2][nt], 0, 0, 0) : __builtin_amdgcn_mfma_f32_16x16x32_bf16(bfr, af2, acc[2][nt], 0, 0, 0);
            acc[3][nt] = SWAP ? __builtin_amdgcn_mfma_f32_16x16x32_bf16(af3, bfr, acc[3][nt], 0, 0, 0) : __builtin_amdgcn_mfma_f32_16x16x32_bf16(bfr, af3, acc[3][nt], 0, 0, 0);
        }
        cs = cs == 2 ? 0 : cs + 1; is = is == 2 ? 0 : is + 1;
    }
    asm volatile("s_nop 7\n\ts_nop 7\n\ts_nop 3" ::: "memory");
#undef GEMM_ISSUE
}
DEV void zero_acc(f32x4 (&acc)[4][8]) {
#pragma unroll
    for (int a = 0; a < 4; ++a)
#pragma unroll
        for (int b = 0; b < 8; ++b) acc[a][b] = (f32x4){0.f, 0.f, 0.f, 0.f};
}

DEV void inproj_item(const Params& p_, int l, int rt, int pass, bf16_t* lds) {
    const Params& p = kp_();
    const int t = tid_(), lane = t & 63, w = t >> 6, wm = w >> 1, wn = w & 1;
    const bf16_t* A = (const bf16_t*)(WS_() + OFF_X1) + (size_t)(rt * 128) * D;
    const bf16_t* Bt = (const bf16_t*)(WS_() + OFF_WINT) + ((size_t)l * 2304 + pass * 256) * 1024;
    const unsigned toff = (unsigned)(((t >> 2) * 1024 + gemm_src_chunk(t)) * 2);
    f32x4 acc[4][8]; zero_acc(acc);
    const int wu = __builtin_amdgcn_readfirstlane(t >> 6);
    const bool vsw = pass == 3 || ((pass == 2 || pass == 4) && (wu & 1));
    if (vsw) gemm_mainloop<true>(A, toff, toff + 64 * D * 2, Bt, toff, 1024, 32, lds, acc);
    else gemm_mainloop<false>(A, toff, toff + 64 * D * 2, Bt, toff, 1024, 32, lds, acc);
    bf16_t* P = (bf16_t*)(WS_() + OFF_P);
    const float* ctab = (const float*)(WS_() + OFF_ROPE); const float* stab = ctab + 2048;
    const bool isctx = rt >= 512;
    const int fq = lane >> 4, fr = lane & 15;
#pragma unroll
    for (int hci = 0; hci < 2; ++hci) {
        const int hc = pass * 4 + wn * 2 + hci;
        int type, dcol = 0, vh = 0;
        if (hc < 4) { type = 0; dcol = COL_RGX + hc * 64; }
        else if (hc < 10) { type = 4; vh = hc - 4; }
        else if (hc < 16) { type = 5; vh = hc - 10; }
        else if (hc < 18) { type = 6; vh = hc - 16; }
        else if (hc < 20) { type = 7; vh = hc - 18; }
        else if (hc < 24) { type = 0; dcol = COL_GATE + (hc - 20) * 64; }
        else if (hc < 30) { type = 1; dcol = COL_NAQ + (hc - 24) * 64; }
        else { type = 3; dcol = COL_GQ + (hc - 30) * 64; }
#pragma unroll
        for (int mt = 0; mt < 4; ++mt) {
            const int R = rt * 128 + wm * 64 + mt * 16 + fr;
            f32x4 v0 = acc[mt][hci * 4 + 0], v1 = acc[mt][hci * 4 + 1], v2 = acc[mt][hci * 4 + 2], v3 = acc[mt][hci * 4 + 3];
            if ((type == 3 || type == 6) && !isctx) {
                const int tt = R & (S - 1), pr = tt >> 6, pc = tt & 63;
                const f32x4 cr = *(const GAS f32x4*)(ctab + pr * 16 + fq * 4), sr = *(const GAS f32x4*)(stab + pr * 16 + fq * 4);
                const f32x4 cc = *(const GAS f32x4*)(ctab + pc * 16 + fq * 4), sc = *(const GAS f32x4*)(stab + pc * 16 + fq * 4);
                const f32x4 o0 = v0 * cr - v1 * sr, o1 = v1 * cr + v0 * sr, o2 = v2 * cc - v3 * sc, o3 = v3 * cc + v2 * sc;
                v0 = o0; v1 = o1; v2 = o2; v3 = o3;
            }
            if (type == 1 || type == 3) { const float qs = 0.125f * 1.4426950408889634f; v0 = v0 * qs; v1 = v1 * qs; v2 = v2 * qs; v3 = v3 * qs; }
            if (type < 4) {
                bf16_t* o = P + (size_t)R * PWS + dcol + fq * 4;
                uint2 q;
                q.x = pk2(v0[0], v0[1]); q.y = pk2(v0[2], v0[3]); stg_u2(o, q);
                q.x = pk2(v1[0], v1[1]); q.y = pk2(v1[2], v1[3]); stg_u2(o + 16, q);
                q.x = pk2(v2[0], v2[1]); q.y = pk2(v2[2], v2[3]); stg_u2(o + 32, q);
                q.x = pk2(v3[0], v3[1]); q.y = pk2(v3[2], v3[3]); stg_u2(o + 48, q);
            } else {
                const bool na = type < 6, isk = (type == 4 || type == 6);
                bf16_t* tb;
                if (!isctx) { const int b = R >> 13, tile = (R & (S - 1)) >> 4;
                    tb = (bf16_t*)(WS_() + (na ? (isk ? OFF_NAKF : OFF_NAVF) : (isk ? OFF_GKF : OFF_GVF))) + ((size_t)(b * (na ? 6 : 2) + vh) * 512 + tile) * KVT; }
                else { const int cR = R - NLAT, b = cR >> 8, tile = (cR & 255) >> 4;
                    tb = (bf16_t*)(WS_() + (na ? (isk ? OFF_NAKFC : OFF_NAVFC) : (isk ? OFF_GKFC : OFF_GVFC))) + ((size_t)(b * (na ? 6 : 2) + vh) * 16 + tile) * KVT; }
                if (isk) {
                    bf16_t* o = tb + ((fq >> 1) * 16 + fr) * 8 + (fq & 1) * 4;
                    uint2 q;
                    q.x = pk2(v0[0], v0[1]); q.y = pk2(v0[2], v0[3]); stg_u2(o, q);
                    q.x = pk2(v1[0], v1[1]); q.y = pk2(v1[2], v1[3]); stg_u2(o + 2 * 16 * 8, q);
                    q.x = pk2(v2[0], v2[1]); q.y = pk2(v2[2], v2[3]); stg_u2(o + 512, q);
                    q.x = pk2(v3[0], v3[1]); q.y = pk2(v3[2], v3[3]); stg_u2(o + 512 + 2 * 16 * 8, q);
                } else {
                    bf16_t* o = tb + lane * 8;
                    uint4 q;
                    q.x = pk2(v0[0], v0[1]); q.y = pk2(v0[2], v0[3]); q.z = pk2(v1[0], v1[1]); q.w = pk2(v1[2], v1[3]); stg_u4(o, q);
                    q.x = pk2(v2[0], v2[1]); q.y = pk2(v2[2], v2[3]); q.z = pk2(v3[0], v3[1]); q.w = pk2(v3[2], v3[3]); stg_u4(o + 512, q);
                }
            }
        }
    }
}
constexpr float LOG2E = 1.4426950408889634f;
struct AttnState { f32x4 o0, o1, o2, o3; float m, lsum; };
struct KVFrag { bf16x8 k00, k01, k10, k11, v0, v1, v2, v3; };
DEV bf16x8 ld16(const bf16_t* p) { return *(const GAS bf16x8*)p; }
DEV bf16x8 lohi(const uint4& a, const uint4& b, int hi) { union { uint4 u; bf16x8 v; } c; c.u = hi ? make_uint4(a.z, a.w, b.z, b.w) : make_uint4(a.x, a.y, b.x, b.y); return c.v; }
DEV void kv_load(const bf16_t* kt0, const bf16_t* kt1, const bf16_t* vt0, const bf16_t* vt1, KVFrag& f) {
    f.k00 = ld16(kt0); f.k01 = ld16(kt0 + 512); f.k10 = ld16(kt1); f.k11 = ld16(kt1 + 512);
    const uint4 a0 = ldg_u4(vt0), a1 = ldg_u4(vt0 + 512), b0 = ldg_u4(vt1), b1 = ldg_u4(vt1 + 512);
    f.v0 = lohi(a0, b0, 0); f.v1 = lohi(a0, b0, 1); f.v2 = lohi(a1, b1, 0); f.v3 = lohi(a1, b1, 1);
}
template <bool HASB> DEV void attn_apply(const KVFrag& f, const bf16x8& q0, const bf16x8& q1, f32x4 b0, f32x4 b1, AttnState& st) {
    const f32x4 z = {0.f, 0.f, 0.f, 0.f};
    f32x4 s0 = __builtin_amdgcn_mfma_f32_16x16x32_bf16(f.k00, q0, z, 0, 0, 0); s0 = __builtin_amdgcn_mfma_f32_16x16x32_bf16(f.k01, q1, s0, 0, 0, 0);
    f32x4 s1 = __builtin_amdgcn_mfma_f32_16x16x32_bf16(f.k10, q0, z, 0, 0, 0); s1 = __builtin_amdgcn_mfma_f32_16x16x32_bf16(f.k11, q1, s1, 0, 0, 0);
    if (HASB) { s0 = s0 + b0; s1 = s1 + b1; }
    float mx = fmaxf(fmaxf(fmaxf(s0[0], s0[1]), fmaxf(s0[2], s0[3])), fmaxf(fmaxf(s1[0], s1[1]), fmaxf(s1[2], s1[3])));
    if (__builtin_amdgcn_ballot_w64(mx > st.m + 8.f) != 0ull) {
        mx = fmaxf(mx, shx(mx, 16)); mx = fmaxf(mx, shx(mx, 32));
        const float mn = fmaxf(st.m, mx);
        const float msn = (mn == -INFINITY) ? 0.f : mn;
        const float alpha = __builtin_amdgcn_exp2f(st.m - msn);
        st.lsum = st.lsum * alpha;
        st.o0 = st.o0 * alpha; st.o1 = st.o1 * alpha; st.o2 = st.o2 * alpha; st.o3 = st.o3 * alpha;
        st.m = mn;
    }
    const float ms = (st.m == -INFINITY) ? 0.f : st.m;
    f32x4 p0, p1;
#pragma unroll
    for (int j = 0; j < 4; ++j) { p0[j] = __builtin_amdgcn_exp2f(s0[j] - ms); p1[j] = __builtin_amdgcn_exp2f(s1[j] - ms); }
    st.lsum = st.lsum + ((p0[0] + p0[1]) + (p0[2] + p0[3])) + ((p1[0] + p1[1]) + (p1[2] + p1[3]));
    union { uint4 u; bf16x8 v; } pt; pt.u = make_uint4(pk2b(p0[0], p0[1]), pk2b(p0[2], p0[3]), pk2b(p1[0], p1[1]), pk2b(p1[2], p1[3]));
    st.o0 = __builtin_amdgcn_mfma_f32_16x16x32_bf16(f.v0, pt.v, st.o0, 0, 0, 0);
    st.o1 = __builtin_amdgcn_mfma_f32_16x16x32_bf16(f.v1, pt.v, st.o1, 0, 0, 0);
    st.o2 = __builtin_amdgcn_mfma_f32_16x16x32_bf16(f.v2, pt.v, st.o2, 0, 0, 0);
    st.o3 = __builtin_amdgcn_mfma_f32_16x16x32_bf16(f.v3, pt.v, st.o3, 0, 0, 0);
}
DEV void attn_init(AttnState& st) { const f32x4 z = {0.f, 0.f, 0.f, 0.f}; st.o0 = z; st.o1 = z; st.o2 = z; st.o3 = z; st.m = -INFINITY; st.lsum = 0.f; }
DEV void attn_store(AttnState& st, bf16_t* orow, float sink2  ) {
    float l = st.lsum; l += shx(l, 16); l += shx(l, 32);
    float sc;
    if (sink2 != -INFINITY) { const float mf = fmaxf(st.m, sink2); const float al = __builtin_amdgcn_exp2f(st.m - mf); l = l * al + __builtin_amdgcn_exp2f(sink2 - mf); sc = al / l; }
    else sc = 1.f / l;
    uint2 w;
    w.x = pk2(st.o0[0] * sc, st.o0[1] * sc); w.y = pk2(st.o0[2] * sc, st.o0[3] * sc); stg_u2(orow, w);
    w.x = pk2(st.o1[0] * sc, st.o1[1] * sc); w.y = pk2(st.o1[2] * sc, st.o1[3] * sc); stg_u2(orow + 16, w);
    w.x = pk2(st.o2[0] * sc, st.o2[1] * sc); w.y = pk2(st.o2[2] * sc, st.o2[3] * sc); stg_u2(orow + 32, w);
    w.x = pk2(st.o3[0] * sc, st.o3[1] * sc); w.y = pk2(st.o3[2] * sc, st.o3[3] * sc); stg_u2(orow + 48, w);
}

constexpr int NTASK_NA = NB * 6 * 128 * 4, NTASK_GQ = NB * 2 * 512, NTASK_CNA = NB * 6 * 16, NTASK_CGQ = NB * 2 * 16;
DEV void attn_task(const Params& p, int l, int tk, const float* rpb2g  ) {
    const LAS float* rpb2 = (const LAS float*)rpb2g;
    const int lane = tid_() & 63, g = lane >> 4, fr = lane & 15;
    const bf16_t* P = (const bf16_t*)(WS_() + OFF_P);
    bf16_t* X1 = (bf16_t*)(WS_() + OFF_X1);
    const f32x4 z4 = {0.f, 0.f, 0.f, 0.f};
    KVFrag f;
    if (tk < NTASK_NA / 2) {
        const int qtile = tk & 3, rp = (tk >> 2) & 63, hb = tk >> 8, h = hb % 6, b = hb / 6;
        const int qc = qtile == 0 ? (fr < 8 ? fr : 48 + fr) : 8 + (qtile - 1) * 16 + fr;
        const int ct0 = qtile == 0 ? 0 : qtile - 1, ct1 = qtile == 0 ? 3 : qtile;
        const int rA = 2 * rp, rB = rA + 1;
        const int RA = b * S + rA * 64 + qc, RB = RA + 64;
        const bf16_t* qp = P + (size_t)RA * PWS + COL_NAQ + h * 64 + g * 8;
        const bf16x8 qa0 = ld16(qp), qa1 = ld16(qp + 32), qb0 = ld16(qp + 64 * PWS), qb1 = ld16(qp + 64 * PWS + 32);
        const int rsA = min(max(rA - 4, 0), 120), rsB = min(max(rB - 4, 0), 120), cs = min(max(qc - 8, 0), 48);
        const bool same = __builtin_amdgcn_readfirstlane(rsA == rsB ? 1 : 0) != 0;
        int ci[8]; bool ok[8];
#pragma unroll
        for (int e = 0; e < 8; ++e) { const int kc = ((e >> 2) ? ct1 : ct0) * 16 + g * 4 + (e & 3); ok[e] = (kc >= cs) && (kc < cs + 16); ci[e] = min(max(kc - qc + 15, 0), 30); }
        const bf16_t* kf = (const bf16_t*)(WS_() + OFF_NAKF) + ((size_t)(b * 6 + h) * 512 + rsA * 4) * KVT + lane * 8;
        const bf16_t* vf = (const bf16_t*)(WS_() + OFF_NAVF) + ((size_t)(b * 6 + h) * 512 + rsA * 4) * KVT + lane * 8;
        AttnState sa, sb; attn_init(sa); attn_init(sb);
        const bf16_t* kc_ = (const bf16_t*)(WS_() + OFF_NAKFC) + (size_t)(b * 6 + h) * 16 * KVT + lane * 8;
        const bf16_t* vc_ = (const bf16_t*)(WS_() + OFF_NAVFC) + (size_t)(b * 6 + h) * 16 * KVT + lane * 8;
        KVFrag f2;
#define NA_LOAD(s, F) do { if ((s) < 9) { const int ur = min(rsA + (s), 127) - rsA;   \
                kv_load(kf + (size_t)(ur * 4 + ct0) * KVT, kf + (size_t)(ur * 4 + ct1) * KVT, vf + (size_t)(ur * 4 + ct0) * KVT, vf + (size_t)(ur * 4 + ct1) * KVT, F); } \
            else { const int pp = (s) - 9; kv_load(kc_ + (size_t)(2 * pp) * KVT, kc_ + (size_t)(2 * pp + 1) * KVT, vc_ + (size_t)(2 * pp) * KVT, vc_ + (size_t)(2 * pp + 1) * KVT, F); } } while (0)
#define NA_STEP(u, F) do { if ((u) < 9) { \
                if ((u) < 8) { const LAS float* rb_ = rpb2 + (h * 15 + (rsA + (u) - rA + 7)) * 31; f32x4 b0, b1; \
                    _Pragma("unroll") for (int j = 0; j < 4; ++j) { b0[j] = ok[j] ? rb_[ci[j]] : -INFINITY; b1[j] = ok[4 + j] ? rb_[ci[4 + j]] : -INFINITY; } \
                    attn_apply<true>(F, qa0, qa1, b0, b1, sa); } \
                { const bool mem = (u) == 0 ? same : ((u) == 8 ? !same : true); \
                    const LAS float* rb_ = rpb2 + (h * 15 + (rsA + (u) - rB + 7)) * 31; f32x4 b0, b1; \
                    _Pragma("unroll") for (int j = 0; j < 4; ++j) { b0[j] = (mem && ok[j]) ? rb_[ci[j]] : -INFINITY; b1[j] = (mem && ok[4 + j]) ? rb_[ci[4 + j]] : -INFINITY; } \
                    attn_apply<true>(F, qb0, qb1, b0, b1, sb); } } \
            else { attn_apply<false>(F, qa0, qa1, z4, z4, sa); attn_apply<false>(F, qb0, qb1, z4, z4, sb); } } while (0)
        NA_LOAD(0, f);
#pragma unroll
        for (int s = 0; s < 17; s += 2) {
            if (s + 1 < 17) NA_LOAD(s + 1, f2);
            NA_STEP(s, f);
            if (s + 1 < 17) { if (s + 2 < 17) NA_LOAD(s + 2, f); NA_STEP(s + 1, f2); }
        }
#undef NA_LOAD
#undef NA_STEP
        attn_store(sa, X1 + (size_t)RA * D + 256 + h * 64 + g * 4, -INFINITY);
        attn_store(sb, X1 + (size_t)RB * D + 256 + h * 64 + g * 4, -INFINITY);
    } else if (tk < NTASK_NA + NTASK_GQ + NTASK_CNA + NTASK_CGQ && (tk < NTASK_NA + NTASK_GQ || tk >= NTASK_NA + NTASK_GQ + NTASK_CNA)) {
        const bool lat = tk < NTASK_NA + NTASK_GQ;
        const int t2 = lat ? tk - NTASK_NA : tk - (NTASK_NA + NTASK_GQ + NTASK_CNA);
        const int qt = lat ? (t2 & 511) : (t2 & 15), hb = lat ? (t2 >> 9) : (t2 >> 4), kvh = hb & 1, b = hb >> 1;
        const int q0i = qt * 16, R = (lat ? b * S : NLAT + b * CTX) + q0i + fr;
        const bf16_t* qp = P + (size_t)R * PWS + COL_GQ + kvh * 192 + g * 8;
        const bf16x8 qa0 = ld16(qp), qa1 = ld16(qp + 32), qb0 = ld16(qp + 64), qb1 = ld16(qp + 96), qc0 = ld16(qp + 128), qc1 = ld16(qp + 160);
        AttnState sa, sb, sc; attn_init(sa); attn_init(sb); attn_init(sc);
        const bf16_t* kf = (const bf16_t*)(WS_() + OFF_GKF) + (size_t)(b * 2 + kvh) * 512 * KVT + lane * 8;
        const bf16_t* vf = (const bf16_t*)(WS_() + OFF_GVF) + (size_t)(b * 2 + kvh) * 512 * KVT + lane * 8;
        const bf16_t* kc_ = (const bf16_t*)(WS_() + OFF_GKFC) + (size_t)(b * 2 + kvh) * 16 * KVT + lane * 8;
        const bf16_t* vc_ = (const bf16_t*)(WS_() + OFF_GVFC) + (size_t)(b * 2 + kvh) * 16 * KVT + lane * 8;
        const int qi = q0i + fr;
#define GQ_LOAD(i, F) do { const int i_ = (i); if (i_ < 9) { const int kt_ = (q0i - 128 + i_ * 32) >> 4; const int ta_ = min(max(kt_, 0), 511), tb_ = min(max(kt_ + 1, 0), 511); \
            kv_load(kf + (size_t)ta_ * KVT, kf + (size_t)tb_ * KVT, vf + (size_t)ta_ * KVT, vf + (size_t)tb_ * KVT, F); } \
        else { const int c_ = (i_ - 9) * 2; kv_load(kc_ + (size_t)c_ * KVT, kc_ + (size_t)(c_ + 1) * KVT, vc_ + (size_t)c_ * KVT, vc_ + (size_t)(c_ + 1) * KVT, F); } } while (0)
#define GQ_APPLY(i, F) do { const int i_ = (i); f32x4 b0_ = z4, b1_ = z4; if (i_ < 9) { const int kb_ = q0i - 128 + i_ * 32; _Pragma("unroll") for (int j = 0; j < 4; ++j) { const int k0_ = kb_ + g * 4 + j, k1_ = k0_ + 16; \
                b0_[j] = (k0_ >= 0 && k0_ < S && k0_ >= qi - 128 && k0_ <= qi + 128) ? 0.f : -INFINITY; b1_[j] = (k1_ >= 0 && k1_ < S && k1_ >= qi - 128 && k1_ <= qi + 128) ? 0.f : -INFINITY; } } \
            if (i_ < 9) { attn_apply<true>(F, qa0, qa1, b0_, b1_, sa); attn_apply<true>(F, qb0, qb1, b0_, b1_, sb); attn_apply<true>(F, qc0, qc1, b0_, b1_, sc); } \
            else { attn_apply<false>(F, qa0, qa1, b0_, b1_, sa); attn_apply<false>(F, qb0, qb1, b0_, b1_, sb); attn_apply<false>(F, qc0, qc1, b0_, b1_, sc); } } while (0)
        KVFrag f2;
        const int i0 = lat ? 0 : 9;
        GQ_LOAD(i0, f);
#pragma unroll 1
        for (int i = i0; i < 17; i += 2) {
            if (i + 1 < 17) GQ_LOAD(i + 1, f2);
            GQ_APPLY(i, f);
            if (i + 1 < 17) { if (i + 2 < 17) GQ_LOAD(i + 2, f); GQ_APPLY(i + 1, f2); }
        }
#undef GQ_LOAD
#undef GQ_APPLY
        bf16_t* o = X1 + (size_t)R * D + 640 + kvh * 192 + g * 4;
        attn_store(sa, o, KP_(gqa_sink)[l * 6 + kvh * 3 + 0] * LOG2E); attn_store(sb, o + 64, KP_(gqa_sink)[l * 6 + kvh * 3 + 1] * LOG2E); attn_store(sc, o + 128, KP_(gqa_sink)[l * 6 + kvh * 3 + 2] * LOG2E);
    } else {
        const int t3 = tk - NTASK_NA - NTASK_GQ, qt = t3 & 15, hb = t3 >> 4, h = hb % 6, b = hb / 6;
        const int R = NLAT + b * CTX + qt * 16 + fr;
        const bf16_t* qp = P + (size_t)R * PWS + COL_NAQ + h * 64 + g * 8;
        const bf16x8 q0 = ld16(qp), q1 = ld16(qp + 32);
        AttnState st; attn_init(st);
        const bf16_t* kc_ = (const bf16_t*)(WS_() + OFF_NAKFC) + (size_t)(b * 6 + h) * 16 * KVT + lane * 8;
        const bf16_t* vc_ = (const bf16_t*)(WS_() + OFF_NAVFC) + (size_t)(b * 6 + h) * 16 * KVT + lane * 8;
#pragma unroll
        for (int pp = 0; pp < 8; ++pp) { kv_load(kc_ + (size_t)(2 * pp) * KVT, kc_ + (size_t)(2 * pp + 1) * KVT, vc_ + (size_t)(2 * pp) * KVT, vc_ + (size_t)(2 * pp + 1) * KVT, f); attn_apply<false>(f, q0, q1, z4, z4, st); }
        attn_store(st, X1 + (size_t)R * D + 256 + h * 64 + g * 4, -INFINITY);
    }
}
template <int CTRL> DEV float dppf(float old, float v) { return __builtin_bit_cast(float, __builtin_amdgcn_update_dpp(__builtin_bit_cast(int, old), __builtin_bit_cast(int, v), CTRL, 0xf, 0xf, false)); }
template <bool FWD> DEV void row_scan(float& a, float& b) {
#define RG_STEP(SHR, SHL) { const float ap = FWD ? dppf<SHR>(1.f, a) : dppf<SHL>(1.f, a); const float bp = FWD ? dppf<SHR>(0.f, b) : dppf<SHL>(0.f, b); b = fmaf(a, bp, b); a = a * ap; }
    RG_STEP(0x111, 0x101) RG_STEP(0x112, 0x102) RG_STEP(0x114, 0x104) RG_STEP(0x118, 0x108)
#undef RG_STEP
}
#define RG_S4(SH) \
    "v_fmac_f32_dpp %4, %4, %0 " SH " row_mask:0xf bank_mask:0xf\n\t" "v_fmac_f32_dpp %5, %5, %1 " SH " row_mask:0xf bank_mask:0xf\n\t" \
    "v_fmac_f32_dpp %6, %6, %2 " SH " row_mask:0xf bank_mask:0xf\n\t" "v_fmac_f32_dpp %7, %7, %3 " SH " row_mask:0xf bank_mask:0xf\n\t" \
    "v_mul_f32_dpp %0, %0, %0 " SH " row_mask:0xf bank_mask:0xf\n\t" "v_mul_f32_dpp %1, %1, %1 " SH " row_mask:0xf bank_mask:0xf\n\t" \
    "v_mul_f32_dpp %2, %2, %2 " SH " row_mask:0xf bank_mask:0xf\n\t" "v_mul_f32_dpp %3, %3, %3 " SH " row_mask:0xf bank_mask:0xf\n\t"
template <bool FWD> DEV void row_scan4(f32x4& a, f32x4& b) {
    float a0 = a[0], a1 = a[1], a2 = a[2], a3 = a[3], b0 = b[0], b1 = b[1], b2 = b[2], b3 = b[3];
    if (FWD) asm volatile("s_nop 1\n\t" RG_S4("row_shr:1") RG_S4("row_shr:2") RG_S4("row_shr:4") RG_S4("row_shr:8") "s_nop 0" : "+v"(a0), "+v"(a1), "+v"(a2), "+v"(a3), "+v"(b0), "+v"(b1), "+v"(b2), "+v"(b3));
    else asm volatile("s_nop 1\n\t" RG_S4("row_shl:1") RG_S4("row_shl:2") RG_S4("row_shl:4") RG_S4("row_shl:8") "s_nop 0" : "+v"(a0), "+v"(a1), "+v"(a2), "+v"(a3), "+v"(b0), "+v"(b1), "+v"(b2), "+v"(b3));
    a = (f32x4){a0, a1, a2, a3}; b = (f32x4){b0, b1, b2, b3};
}
#undef RG_S4
DEV int rg_bwd_chunk(int pos) { return pos == 0 ? 1 : (pos == 1 ? 0 : 67 - pos); }
DEV void rg_coef(const f32x4& za, const f32x4& zi, const f32x4& ba, const f32x4& bi, const f32x4& spc, const f32x4& xv, f32x4& a, f32x4& b) {
#pragma unroll
    for (int j = 0; j < 4; ++j) {
        const float r = __builtin_amdgcn_rcpf(1.f + __expf(-(za[j] + ba[j])));
        const float ig = __builtin_amdgcn_rcpf(1.f + __expf(-(zi[j] + bi[j])));
        const float la = spc[j] * r;
        const float av = __expf(la);
        const float x2 = 2.f * la;
        float om = x2 * (1.f / 720.f) + (1.f / 120.f); om = om * x2 + (1.f / 24.f); om = om * x2 + (1.f / 6.f); om = om * x2 + 0.5f; om = om * x2 + 1.f; om = -x2 * om;
        if (x2 < -0.25f) om = 1.f - av * av;
        a[j] = av; b[j] = __builtin_amdgcn_sqrtf(om) * (ig * xv[j]);
    }
}
DEV void rg_item(const Params& p, int l, int rt, bf16_t* lds) {
    const int t = tid_(), lane = t & 63, n = t >> 6, g = lane >> 4, fr = lane & 15;
    const bf16_t* P = (const bf16_t*)(WS_() + OFF_P);
    const bool isctx = rt >= 512;
    const int b = isctx ? (rt - 512) >> 1 : rt >> 6, idx = isctx ? (rt - 512) & 1 : 2 + (rt & 63);
    const int L = isctx ? CTX : S, t0 = isctx ? idx * 128 : (idx - 2) * 128, seqbase = isctx ? NLAT + b * CTX : b * S;
    bf16_t* xl = lds + n * (128 * 64);
    {
        const int c = lane & 7, ch0 = n * 64 + c * 8;
        f32x4 cwa[4], cwb[4];
#pragma unroll
        for (int j = 0; j < 4; ++j) { cwa[j] = *(const GAS f32x4*)(KP_(conv_w) + (l * 4 + j) * 256 + ch0); cwb[j] = *(const GAS f32x4*)(KP_(conv_w) + (l * 4 + j) * 256 + ch0 + 4); }
        const f32x4 cba = *(const GAS f32x4*)(KP_(conv_b) + l * 256 + ch0), cbb = *(const GAS f32x4*)(KP_(conv_b) + l * 256 + ch0 + 4);
#pragma unroll 2
        for (int it = 0; it < 16; ++it) {
            const int tok = it * 8 + (lane >> 3), ts = t0 + tok;
            f32x4 acca = cba, accb = cbb;
#pragma unroll
            for (int j = 0; j < 4; ++j) {
                const int tj = ts + j - 2;
                if (tj >= 0 && tj < L) {
                    const uint4 v = ldg_u4(P + (size_t)(seqbase + tj) * PWS + COL_RGX + ch0);
                    const f32x4 xa = {__uint_as_float(v.x << 16), __uint_as_float(v.x & 0xffff0000u), __uint_as_float(v.y << 16), __uint_as_float(v.y & 0xffff0000u)};
                    const f32x4 xb = {__uint_as_float(v.z << 16), __uint_as_float(v.z & 0xffff0000u), __uint_as_float(v.w << 16), __uint_as_float(v.w & 0xffff0000u)};
                    acca = acca + cwa[j] * xa; accb = accb + cwb[j] * xb;
                }
            }
            uint4 o; o.x = pk2(acca[0], acca[1]); o.y = pk2(acca[2], acca[3]); o.z = pk2(accb[0], accb[1]); o.w = pk2(accb[2], accb[3]);
            *(uint4*)(xl + tok * 64 + ((c ^ ((tok >> 1) & 7)) * 8)) = o;
        }
    }
    asm volatile("s_waitcnt lgkmcnt(0)" ::: "memory");
    const bf16_t* W = (const bf16_t*)(WS_() + OFF_WRG) + (size_t)(l * 2) * 2 * 4 * 64 * 64;
    const float* C = (const float*)(WS_() + OFF_RGC) + (size_t)(l * 2) * 3 * 256;
    float* AGG = (float*)(WS_() + OFF_AGG) + (size_t)(b * 66) * 1024;
    const int swz = (fr >> 1) & 7;
#pragma unroll 1
    for (int ct = 0; ct < 4; ++ct) {
        const int ch = n * 64 + ct * 16 + g * 4;
        const f32x4 z4 = {0.f, 0.f, 0.f, 0.f};
#pragma unroll
        for (int dir = 0; dir < 2; ++dir) {
            const bf16x8 wa0 = ld16(W + ((size_t)((dir * 2 + 0) * 4 + n) * 64 + ct * 16 + fr) * 64 + g * 8), wa1 = ld16(W + ((size_t)((dir * 2 + 0) * 4 + n) * 64 + ct * 16 + fr) * 64 + 32 + g * 8);
            const bf16x8 wi0 = ld16(W + ((size_t)((dir * 2 + 1) * 4 + n) * 64 + ct * 16 + fr) * 64 + g * 8), wi1 = ld16(W + ((size_t)((dir * 2 + 1) * 4 + n) * 64 + ct * 16 + fr) * 64 + 32 + g * 8);
            const f32x4 ba = *(const GAS f32x4*)(C + (dir * 3 + 0) * 256 + ch), bi = *(const GAS f32x4*)(C + (dir * 3 + 1) * 256 + ch), spc = *(const GAS f32x4*)(C + (dir * 3 + 2) * 256 + ch);
            f32x4 hin = z4, apre = {1.f, 1.f, 1.f, 1.f};
#pragma unroll
            for (int s = 0; s < 8; ++s) {
                const int tt = dir == 0 ? s : 7 - s;
                const int row = tt * 16 + fr;
                const bf16x8 x0 = *(const bf16x8*)(xl + row * 64 + ((g ^ swz) * 8)), x1 = *(const bf16x8*)(xl + row * 64 + (((g | 4) ^ swz) * 8));
                f32x4 za = __builtin_amdgcn_mfma_f32_16x16x32_bf16(wa0, x0, z4, 0, 0, 0); za = __builtin_amdgcn_mfma_f32_16x16x32_bf16(wa1, x1, za, 0, 0, 0);
                f32x4 zi = __builtin_amdgcn_mfma_f32_16x16x32_bf16(wi0, x0, z4, 0, 0, 0); zi = __builtin_amdgcn_mfma_f32_16x16x32_bf16(wi1, x1, zi, 0, 0, 0);
                const uint2 xr = *(const uint2*)(xl + row * 64 + (((ct * 2 + (g >> 1)) ^ swz) * 8) + (g & 1) * 4);
                const f32x4 xv = {__uint_as_float(xr.x << 16), __uint_as_float(xr.x & 0xffff0000u), __uint_as_float(xr.y << 16), __uint_as_float(xr.y & 0xffff0000u)};
                f32x4 a, bb;
                rg_coef(za, zi, ba, bi, spc, xv, a, bb);
                f32x4 h, ac;
#pragma unroll
                for (int j = 0; j < 4; ++j) {
                    if (j == 0) { if (dir == 0) row_scan4<true>(a, bb); else row_scan4<false>(a, bb); }
                    h[j] = fmaf(a[j], hin[j], bb[j]);
                    ac[j] = a[j] * apre[j];
                }
                {
                    bf16_t* xo = (bf16_t*)(WS_() + OFF_X2) + ((size_t)seqbase + t0 + row) * D + dir * 512 + ch * 2;
                    uint4 o; o.x = pk2(ac[0], ac[1]); o.y = pk2(ac[2], ac[3]); o.z = pk2(h[0], h[1]); o.w = pk2(h[2], h[3]); stg_u4(xo, o);
                }
                const int src = (lane & 48) | (dir == 0 ? 15 : 0);
#pragma unroll
                for (int j = 0; j < 4; ++j) { hin[j] = shl_(h[j], src); apre[j] = shl_(ac[j], src); }
            }
            if (fr == 0) { *(GAS f32x4*)(AGG + (size_t)(idx * 2 + dir) * 512 + ch) = apre; *(GAS f32x4*)(AGG + (size_t)(idx * 2 + dir) * 512 + 256 + ch) = hin; }
        }
    }
}
DEV void rg_final(const Params& p, int l, int rt, float* part  ) {
    const int t = tid_(), cg4 = (t & 63) * 4, tp = t >> 6;
    const bool isctx = rt >= 512;
    const int b = isctx ? (rt - 512) >> 1 : rt >> 6, idx = isctx ? (rt - 512) & 1 : 2 + (rt & 63);
    const float* AGG = (const float*)(WS_() + OFF_AGG) + (size_t)(b * 66) * 1024;
    f32x4 hf = {0.f, 0.f, 0.f, 0.f}, hb = {0.f, 0.f, 0.f, 0.f};
    {
        const int nf = idx, nb = idx == 1 ? 0 : (idx == 0 ? 1 : 67 - idx);
        const int qf = (nf + 3) >> 2, qb = (nb + 3) >> 2;
        f32x4 Af = {1.f, 1.f, 1.f, 1.f}, Bf = {0.f, 0.f, 0.f, 0.f}, Ab = Af, Bb = Bf;
#pragma unroll 4
        for (int q = tp * qf; q < min((tp + 1) * qf, nf); ++q) { const f32x4 A = *(const GAS f32x4*)(AGG + (size_t)(q * 2) * 512 + cg4), B = *(const GAS f32x4*)(AGG + (size_t)(q * 2) * 512 + 256 + cg4); Bf = A * Bf + B; Af = A * Af; }
#pragma unroll 4
        for (int q = tp * qb; q < min((tp + 1) * qb, nb); ++q) { const int cq = rg_bwd_chunk(q); const f32x4 A = *(const GAS f32x4*)(AGG + (size_t)(cq * 2 + 1) * 512 + cg4), B = *(const GAS f32x4*)(AGG + (size_t)(cq * 2 + 1) * 512 + 256 + cg4); Bb = A * Bb + B; Ab = A * Ab; }
        *(f32x4*)(part + ((tp * 2 + 0) * 2 + 0) * 256 + cg4) = Af; *(f32x4*)(part + ((tp * 2 + 0) * 2 + 1) * 256 + cg4) = Bf;
        *(f32x4*)(part + ((tp * 2 + 1) * 2 + 0) * 256 + cg4) = Ab; *(f32x4*)(part + ((tp * 2 + 1) * 2 + 1) * 256 + cg4) = Bb;
        __syncthreads();
#pragma unroll
        for (int k = 0; k < 4; ++k) {
            hf = *(const f32x4*)(part + ((k * 2 + 0) * 2 + 0) * 256 + cg4) * hf + *(const f32x4*)(part + ((k * 2 + 0) * 2 + 1) * 256 + cg4);
            hb = *(const f32x4*)(part + ((k * 2 + 1) * 2 + 0) * 256 + cg4) * hb + *(const f32x4*)(part + ((k * 2 + 1) * 2 + 1) * 256 + cg4);
        }
    }
    const bf16_t* X2 = (const bf16_t*)(WS_() + OFF_X2); const bf16_t* P = (const bf16_t*)(WS_() + OFF_P); bf16_t* X1 = (bf16_t*)(WS_() + OFF_X1);
#pragma unroll 4
    for (int i = 0; i < 32; ++i) {
        const size_t R = (size_t)rt * 128 + i * 4 + tp;
        const uint4 cf = ldg_u4(X2 + R * D + cg4 * 2), cb = ldg_u4(X2 + R * D + 512 + cg4 * 2);
        const uint2 af = make_uint2(cf.x, cf.y), bf = make_uint2(cf.z, cf.w), ab = make_uint2(cb.x, cb.y), bb = make_uint2(cb.z, cb.w);
        const uint2 gr = ldg_u2(P + R * PWS + COL_GATE + cg4);
#define BLO(u) __uint_as_float((u) << 16)
#define BHI(u) __uint_as_float((u) & 0xffff0000u)
        const float h0 = (BLO(af.x) * hf[0] + BLO(bf.x)) + (BLO(ab.x) * hb[0] + BLO(bb.x));
        const float h1 = (BHI(af.x) * hf[1] + BHI(bf.x)) + (BHI(ab.x) * hb[1] + BHI(bb.x));
        const float h2 = (BLO(af.y) * hf[2] + BLO(bf.y)) + (BLO(ab.y) * hb[2] + BLO(bb.y));
        const float h3 = (BHI(af.y) * hf[3] + BHI(bf.y)) + (BHI(ab.y) * hb[3] + BHI(bb.y));
        uint2 o; o.x = pk2(h0 * gelu_tanh(BLO(gr.x)), h1 * gelu_tanh(BHI(gr.x))); o.y = pk2(h2 * gelu_tanh(BLO(gr.y)), h3 * gelu_tanh(BHI(gr.y)));
#undef BLO
#undef BHI
        stg_u2(X1 + R * D + cg4, o);
    }
}
DEV void ph_rgagg(const Params& p, int l, bf16_t* lds) {
    for (int rt = bid_(); rt < 528; rt += gridDim.x) { rg_item(p, l, rt, lds); __syncthreads(); }
}

DEV void outproj_item(const Params& p_, int l, int rt, bf16_t* lds, float* stat  ) {
    const Params& p = kp_();
    const int t = tid_(), lane = t & 63, w = t >> 6, wm = w >> 1, wn = w & 1, fq = lane >> 4, fr = lane & 15;
    const bf16_t* A = (const bf16_t*)(WS_() + OFF_X1) + (size_t)(rt * 128) * D;
    const bool isctx = rt >= 512;
    const float* g1 = modvec(p, l, rt * 128, 2);
    __syncthreads();
    rg_final(p, l, rt, (float*)lds);
    asm volatile("s_waitcnt vmcnt(0)" ::: "memory");
    __syncthreads();
    __builtin_amdgcn_fence(__ATOMIC_ACQUIRE, "agent");
#pragma unroll 1
    for (int pass = 0; pass < 4; ++pass) {
        const bf16_t* Bt = (const bf16_t*)(WS_() + OFF_WOUTT) + ((size_t)l * 1024 + pass * 256) * 1024;
        const unsigned toff = (unsigned)(((tid_() >> 2) * 1024 + gemm_src_chunk(tid_())) * 2);
        f32x4 acc[4][8]; zero_acc(acc);
        gemm_mainloop(A, toff, toff + 64 * D * 2, Bt, toff, 1024, 32, lds, acc);
#pragma unroll
        for (int mt = 0; mt < 4; ++mt) {
            const int rl = wm * 64 + mt * 16 + fr, R = rt * 128 + rl;
            const unsigned char* xinB = (const unsigned char*)(isctx ? KP_(ctx) : KP_(x));
            unsigned char* xoB = isctx ? (WS_() + OFF_XCTX) : (unsigned char*)KP_(out);
            const unsigned uoff = (unsigned)(isctx ? R - NLAT : R) * (unsigned)(D * 4);
            const unsigned xboff = (unsigned)R * (unsigned)(D * 2);
            float s = 0.f, q = 0.f;
#pragma unroll
            for (int nt = 0; nt < 8; ++nt) {
                const int col = pass * 256 + wn * 128 + nt * 16 + fq * 4;
                f32x4 xv;
                if (l == 0) xv = *(const GAS f32x4*)(xinB + (uoff + (unsigned)col * 4u));
                else { const uint2 xb = ldg_u2(WS_() + OFF_XB + (xboff + (unsigned)col * 2u)); xv = (f32x4){__uint_as_float(xb.x << 16), __uint_as_float(xb.x & 0xffff0000u), __uint_as_float(xb.y << 16), __uint_as_float(xb.y & 0xffff0000u)}; }
                const f32x4 gv = *(const GAS f32x4*)(g1 + col);
                const f32x4 u = xv * ALPHA + gv * acc[mt][nt];
                *(GAS f32x4*)(xoB + (uoff + (unsigned)col * 4u)) = u;
                s += (u[0] + u[1]) + (u[2] + u[3]); q += (u[0] * u[0] + u[1] * u[1]) + (u[2] * u[2] + u[3] * u[3]);
                if (nt == 3) __builtin_amdgcn_sched_barrier(0);
            }
            s += shx(s, 16); s += shx(s, 32); q += shx(q, 16); q += shx(q, 32);
            if (fq == 0) { float* sp = stat + (wn * 128 + rl) * 2; if (pass == 0) { sp[0] = s; sp[1] = q; } else { sp[0] += s; sp[1] += q; } }
        }
    }
    asm volatile("s_waitcnt vmcnt(0)" ::: "memory");
    __syncthreads();
    __builtin_amdgcn_fence(__ATOMIC_ACQUIRE, "agent");
    {
        bf16_t* X2 = (bf16_t*)(WS_() + OFF_X2);
        const bf16_t* WRh = (const bf16_t*)(WS_() + OFF_WR) + (size_t)(l * 2) * 48 * 1024 + (size_t)fr * 1024 + fq * 8;
        const bf16_t* WRl = WRh + 48 * 1024;
        float* vec = (float*)((unsigned char*)lds + 24576);
        {
            const float* lg = KP_(ln1_g) + l * D; const float* lb = KP_(ln1_b) + l * D;
            const float* sh2 = modvec(p, l, rt * 128, 3); const float* sc2 = modvec(p, l, rt * 128, 4);
            const int k4 = t * 4;
            *(f32x4*)(vec + k4) = *(const GAS f32x4*)(lg + k4); *(f32x4*)(vec + 1024 + k4) = *(const GAS f32x4*)(lb + k4);
            *(f32x4*)(vec + 2048 + k4) = *(const GAS f32x4*)(sc2 + k4) + 1.f; *(f32x4*)(vec + 3072 + k4) = *(const GAS f32x4*)(sh2 + k4);
        }
        float mean[2], rstd[2];
#pragma unroll
        for (int tm = 0; tm < 2; ++tm) {
            const int rl = w * 32 + tm * 16 + fr;
            float s = 0.f, q = 0.f;
#pragma unroll
            for (int i = 0; i < 2; ++i) { s += stat[(i * 128 + rl) * 2]; q += stat[(i * 128 + rl) * 2 + 1]; }
            mean[tm] = s * (1.f / D);
            rstd[tm] = rsqrtf(fmaxf(q * (1.f / D) - mean[tm] * mean[tm], 0.f) + LN_EPS);
            if (fq == 0) stg_f2((float*)(WS_() + OFF_LNS) + (size_t)(rt * 128 + rl) * 2, make_float2(mean[tm], rstd[tm]));
        }
        __syncthreads();
        const float* xr0 = xres_row(p, rt * 128 + w * 32 + fr) + fq * 8;
        const float* xr1 = xres_row(p, rt * 128 + w * 32 + 16 + fr) + fq * 8;
        bf16_t* h20 = X2 + (size_t)(rt * 128 + w * 32 + fr) * D + fq * 8; bf16_t* h21 = h20 + (size_t)16 * D;
        f32x4 lacc[3][2];
#pragma unroll
        for (int a = 0; a < 3; ++a) { lacc[a][0] = (f32x4){0.f, 0.f, 0.f, 0.f}; lacc[a][1] = (f32x4){0.f, 0.f, 0.f, 0.f}; }
        f32x4 nu00 = *(const GAS f32x4*)xr0, nu01 = *(const GAS f32x4*)(xr0 + 4), nu10 = *(const GAS f32x4*)xr1, nu11 = *(const GAS f32x4*)(xr1 + 4);
        bf16x8 nwh0 = *(const GAS bf16x8*)(WRh), nwh1 = *(const GAS bf16x8*)(WRh + 16 * 1024), nwh2 = *(const GAS bf16x8*)(WRh + 32 * 1024);
        bf16x8 nwl0 = *(const GAS bf16x8*)(WRl), nwl1 = *(const GAS bf16x8*)(WRl + 16 * 1024), nwl2 = *(const GAS bf16x8*)(WRl + 32 * 1024);
#pragma unroll 2
        for (int ks = 0; ks < 32; ++ks) {
            const f32x4 u00 = nu00, u01 = nu01, u10 = nu10, u11 = nu11;
            const bf16x8 wh0 = nwh0, wh1 = nwh1, wh2 = nwh2, wl0 = nwl0, wl1 = nwl1, wl2 = nwl2;
            if (ks + 1 < 32) {
                const int ko = (ks + 1) * 32;
                nu00 = *(const GAS f32x4*)(xr0 + ko); nu01 = *(const GAS f32x4*)(xr0 + ko + 4); nu10 = *(const GAS f32x4*)(xr1 + ko); nu11 = *(const GAS f32x4*)(xr1 + ko + 4);
                nwh0 = *(const GAS bf16x8*)(WRh + ko); nwh1 = *(const GAS bf16x8*)(WRh + 16 * 1024 + ko); nwh2 = *(const GAS bf16x8*)(WRh + 32 * 1024 + ko);
                nwl0 = *(const GAS bf16x8*)(WRl + ko); nwl1 = *(const GAS bf16x8*)(WRl + 16 * 1024 + ko); nwl2 = *(const GAS bf16x8*)(WRl + 32 * 1024 + ko);
            }
            const int k = ks * 32 + fq * 8;
            const f32x4 g0 = *(const f32x4*)(vec + k), g1v = *(const f32x4*)(vec + k + 4), b0 = *(const f32x4*)(vec + 1024 + k), b1 = *(const f32x4*)(vec + 1024 + k + 4);
            const f32x4 c0 = *(const f32x4*)(vec + 2048 + k), c1 = *(const f32x4*)(vec + 2048 + k + 4), s0 = *(const f32x4*)(vec + 3072 + k), s1 = *(const f32x4*)(vec + 3072 + k + 4);
            bf16x8 hh0, hl0, hh1, hl1;
            {
                const f32x4 x0 = (u00 - mean[0]) * rstd[0] * g0 + b0, x1 = (u01 - mean[0]) * rstd[0] * g1v + b1;
                const f32x4 h0 = x0 * c0 + s0, h1 = x1 * c1 + s1;
#pragma unroll
                for (int e = 0; e < 4; ++e) { const bf16_t a = f2bf(h0[e]), b = f2bf(h1[e]); hh0[e] = (short)a; hh0[4 + e] = (short)b; hl0[e] = (short)f2bf(h0[e] - bf2f(a)); hl0[4 + e] = (short)f2bf(h1[e] - bf2f(b)); }
                *(GAS bf16x8*)(h20 + ks * 32) = hh0;
            }
            {
                const f32x4 x0 = (u10 - mean[1]) * rstd[1] * g0 + b0, x1 = (u11 - mean[1]) * rstd[1] * g1v + b1;
                const f32x4 h0 = x0 * c0 + s0, h1 = x1 * c1 + s1;
#pragma unroll
                for (int e = 0; e < 4; ++e) { const bf16_t a = f2bf(h0[e]), b = f2bf(h1[e]); hh1[e] = (short)a; hh1[4 + e] = (short)b; hl1[e] = (short)f2bf(h0[e] - bf2f(a)); hl1[4 + e] = (short)f2bf(h1[e] - bf2f(b)); }
                *(GAS bf16x8*)(h21 + ks * 32) = hh1;
            }
#define RT_MMA(ft, WH, WL) do { \
            lacc[ft][0] = __builtin_amdgcn_mfma_f32_16x16x32_bf16(WH, hh0, lacc[ft][0], 0, 0, 0); lacc[ft][0] = __builtin_amdgcn_mfma_f32_16x16x32_bf16(WL, hh0, lacc[ft][0], 0, 0, 0); lacc[ft][0] = __builtin_amdgcn_mfma_f32_16x16x32_bf16(WH, hl0, lacc[ft][0], 0, 0, 0); \
            lacc[ft][1] = __builtin_amdgcn_mfma_f32_16x16x32_bf16(WH, hh1, lacc[ft][1], 0, 0, 0); lacc[ft][1] = __builtin_amdgcn_mfma_f32_16x16x32_bf16(WL, hh1, lacc[ft][1], 0, 0, 0); lacc[ft][1] = __builtin_amdgcn_mfma_f32_16x16x32_bf16(WH, hl1, lacc[ft][1], 0, 0, 0); } while (0)
            RT_MMA(0, wh0, wl0); RT_MMA(1, wh1, wl1); RT_MMA(2, wh2, wl2);
#undef RT_MMA
        }
        __syncthreads();
        float* lt = (float*)lds;
        int* lcnt = (int*)((unsigned char*)lds + 24576); int* lbase = lcnt + 32; int* lcnt2 = lcnt + 64; int* lbase2 = lcnt2 + NCLS;
        if (t < 32) lcnt[t] = 0;
        if (t < NCLS) lcnt2[t] = 0;
#pragma unroll
        for (int ft = 0; ft < 3; ++ft)
#pragma unroll
            for (int tm = 0; tm < 2; ++tm)
#pragma unroll
                for (int j = 0; j < 4; ++j) lt[(w * 32 + tm * 16 + fr) * 48 + ft * 16 + fq * 4 + j] = lacc[ft][tm][j];
        __syncthreads();
        int E0 = 0, E1 = 0, r0 = 0, r1 = 0, cls = 0, r2 = 0; float w0 = 0.f, w1 = 0.f;
        const int rl = w * 32 + (lane & 31), R = rt * 128 + rl;
        if (lane < 32) {
            const float* lr = lt + rl * 48;
            int gi = 0; float gm = lr[0] + KP_(router_g_b)[l * 4];
            float gl[4]; gl[0] = gm;
#pragma unroll
            for (int j = 1; j < 4; ++j) { gl[j] = lr[j] + KP_(router_g_b)[l * 4 + j]; if (gl[j] > gm) { gm = gl[j]; gi = j; } }
            float gs = 0.f;
#pragma unroll
            for (int j = 0; j < 4; ++j) gs += expf(gl[j] - gm);
            const float ptop = 1.f / gs;
            int e0 = 0, e1 = 0; float m0 = -INFINITY, m1 = -INFINITY;
            for (int j = 0; j < 8; ++j) {
                const float v = lr[4 + gi * 8 + j] + KP_(router_e_b)[l * 32 + gi * 8 + j];
                if (v > m0) { m1 = m0; e1 = e0; m0 = v; e0 = j; } else if (v > m1) { m1 = v; e1 = j; }
            }
            if (e1 == e0) e1 = (e0 + 1) & 7;
            const float ex = expf(m1 - m0);
            w0 = ptop / (1.f + ex); w1 = ptop * ex / (1.f + ex);
            E0 = gi * 8 + e0; E1 = gi * 8 + e1;
            r0 = atomicAdd(lcnt + E0, 1); r1 = atomicAdd(lcnt + E1, 1);
            { const int a = min(e0, e1), b = max(e0, e1); cls = gi * 28 + ((a * (15 - a)) >> 1) + (b - a - 1); }
            r2 = atomicAdd(lcnt2 + cls, 1);
        }
        __syncthreads();
        if (t < 32) { const int c = lcnt[t]; lbase[t] = c ? (int)atomicAdd((unsigned*)(WS_() + OFF_CTL) + CW_CNT + l * 32 + t, (unsigned)c) : 0; }
        if (t < NCLS) { const int c = lcnt2[t]; lbase2[t] = c ? (int)atomicAdd((unsigned*)(WS_() + OFF_CTL) + CW_CNT2 + l * NCLS + t, (unsigned)c) : 0; }
        __syncthreads();
        if (lane < 32) {
            int2* list = (int2*)(WS_() + OFF_LIST); int* list2 = (int*)(WS_() + OFF_LIST2);
            list[(size_t)E0 * LISTCAP + lbase[E0] + r0] = make_int2(R * 2 | (E0 > E1 ? 1 << 30 : 0), __float_as_int(w0));
            list[(size_t)E1 * LISTCAP + lbase[E1] + r1] = make_int2((R * 2 + 1) | (E1 > E0 ? 1 << 30 : 0), __float_as_int(w1));
            list2[(size_t)cls * LISTCAP + lbase2[cls] + r2] = R;
        }
    }
}
DEV void ph_outproj(const Params& p, int l, bf16_t* lds, float* stat  ) {
    for (int rt = bid_(); rt < 512; rt += gridDim.x) { outproj_item(p, l, rt, lds, stat); __syncthreads(); }
}

DEV void moe1_item(const Params& p_, int l, int e, int jb, int pass, int cnt, bf16_t* lds) {
    const Params& p = kp_();
    const int t = tid_(), lane = t & 63, w = t >> 6, wm = w >> 1, wn = w & 1, fq = lane >> 4, fr = lane & 15;
    const int2* list = (const int2*)(WS_() + OFF_LIST) + (size_t)e * LISTCAP;
    const bf16_t* X2 = (const bf16_t*)(WS_() + OFF_X2);
    bf16_t* Hs = (bf16_t*)(WS_() + OFF_P);
    unsigned ao0, ao1;
    { const int s0 = jb * 128 + (t >> 2), s1 = s0 + 64;
      const int tok0 = s0 < cnt ? ((list[s0].x & 0x3fffffff) >> 1) : 0, tok1 = s1 < cnt ? ((list[s1].x & 0x3fffffff) >> 1) : 0;
      ao0 = (unsigned)((tok0 * D + gemm_src_chunk(t)) * 2); ao1 = (unsigned)((tok1 * D + gemm_src_chunk(t)) * 2); }
    const bf16_t* Bt = (const bf16_t*)(WS_() + OFF_WGU) + ((size_t)e * 1024 + pass * 256) * 1024;
    f32x4 acc[4][8]; zero_acc(acc);
    gemm_mainloop(X2, ao0, ao1, Bt, (unsigned)((gemm_perm_row(t >> 2) * 1024 + gemm_src_chunk(t)) * 2), 1024, 32, lds, acc);
#pragma unroll
    for (int mt = 0; mt < 4; ++mt) {
        const int s = jb * 128 + wm * 64 + mt * 16 + fr;
        if (s < cnt) {
            const int2 en = list[s];
            const float gw = __int_as_float(en.y);
            bf16_t* hrow = Hs + ((size_t)((en.x & 0x3fffffff) >> 1) * 2 + ((unsigned)en.x >> 30)) * FF + pass * 128 + wn * 64 + fq * 8;
#pragma unroll
            for (int q = 0; q < 2; ++q) {
                const f32x4 g0 = acc[mt][2 * q], g1 = acc[mt][2 * q + 1], u0 = acc[mt][2 * q + 4], u1 = acc[mt][2 * q + 5];
                float h0[4], h1[4];
#pragma unroll
                for (int jj = 0; jj < 4; ++jj) { h0[jj] = g0[jj] * __builtin_amdgcn_rcpf(1.f + __expf(-g0[jj])) * (u0[jj] * gw); h1[jj] = g1[jj] * __builtin_amdgcn_rcpf(1.f + __expf(-g1[jj])) * (u1[jj] * gw); }
                uint4 o; o.x = pk2(h0[0], h0[1]); o.y = pk2(h0[2], h0[3]); o.z = pk2(h1[0], h1[1]); o.w = pk2(h1[2], h1[3]);
                stg_u4(hrow + q * 32, o);
            }
        }
    }
}
DEV void moe2_item(const Params& p_, int l, int cls, int jb, int pass, int cnt, bf16_t* lds) {
    const Params& p = kp_();
    const int t = tid_(), lane = t & 63, w = t >> 6, wm = w >> 1, wn = w & 1, fq = lane >> 4, fr = lane & 15;
    const int* list2 = (const int*)(WS_() + OFF_LIST2) + (size_t)cls * LISTCAP;
    const bf16_t* Hs = (const bf16_t*)(WS_() + OFF_P);
    int ea, eb;
    { const int gi = cls / 28; int pi = cls - gi * 28, a = 0;
      while (pi >= 7 - a) { pi -= 7 - a; ++a; }
      ea = gi * 8 + a; eb = ea + 1 + pi; }
    unsigned ao0, ao1;
    { const int s0 = jb * 128 + (t >> 2), s1 = s0 + 64;
      const int tok0 = s0 < cnt ? list2[s0] : 0, tok1 = s1 < cnt ? list2[s1] : 0;
      ao0 = (unsigned)((tok0 * 1024 + gemm_src_chunk(t)) * 2); ao1 = (unsigned)((tok1 * 1024 + gemm_src_chunk(t)) * 2); }
    const unsigned boff = (unsigned)((gemm_perm_row(t >> 2) * FF + gemm_src_chunk(t)) * 2);
    bf16_t* Y = (bf16_t*)(WS_() + OFF_Y);
    const bf16_t* Bt = (const bf16_t*)(WS_() + OFF_WD) + ((size_t)ea * 1024 + pass * 256) * FF;
    const long bsw = ((long)(eb - ea) * 1024 * FF - 512) * 2;
    f32x4 acc[4][8]; zero_acc(acc);
    gemm_mainloop(Hs, ao0, ao1, Bt, boff, FF, 32, lds, acc, 512, bsw);
#pragma unroll
    for (int mt = 0; mt < 4; ++mt) {
        const int s = jb * 128 + wm * 64 + mt * 16 + fr;
        if (s < cnt) {
            const int tok = list2[s];
            bf16_t* yo = Y + (size_t)tok * D + pass * 256 + wn * 128 + fq * 8;
#pragma unroll
            for (int q = 0; q < 4; ++q) { const f32x4 v0 = acc[mt][2 * q], v1 = acc[mt][2 * q + 1]; uint4 o; o.x = pk2(v0[0], v0[1]); o.y = pk2(v0[2], v0[3]); o.z = pk2(v1[0], v1[1]); o.w = pk2(v1[2], v1[3]); stg_u4(yo + q * 32, o); }
        }
    }
}
DEV void ph_moe1(const Params& p, int l, bf16_t* lds, int* s_cnt  , int* slot, int ph) {
    const unsigned* cnt = (const unsigned*)(WS_() + OFF_CTL) + CW_CNT + l * 32;
    if (tid_() < 32) s_cnt[tid_()] = (int)cnt[tid_()];
    __syncthreads();
#pragma unroll 1
    for (int hop = 0; hop < 8; ++hop) {
        const int xq = (bid_() + hop) & 7;
        unsigned* ctr = (unsigned*)(WS_() + OFF_CTL) + CW_Q + ph * 8 + xq;
        const int n0 = (s_cnt[xq] + 127) >> 7, n1 = (s_cnt[xq + 8] + 127) >> 7, n2 = (s_cnt[xq + 16] + 127) >> 7, n3 = (s_cnt[xq + 24] + 127) >> 7;
        const int nloc = (n0 + n1 + n2 + n3) * 4;
        int it = q_pull(ctr, slot);
        while (it < nloc) {
            int nreg = 0;
            if (tid_() == 0) nreg = (int)atomicAdd(ctr, 1u);
            const int pass = it & 3, ib = it >> 2;
            int e, jb;
            if (ib < n0) { e = xq; jb = ib; } else if (ib < n0 + n1) { e = xq + 8; jb = ib - n0; } else if (ib < n0 + n1 + n2) { e = xq + 16; jb = ib - n0 - n1; } else { e = xq + 24; jb = ib - n0 - n1 - n2; }
            moe1_item(p, l, e, jb, pass, s_cnt[e], lds);
            it = q_publish(nreg, slot);
        }
    }
    __syncthreads();
}
DEV void ph_moe2(const Params& p, int l, bf16_t* lds, int* s_cnt2  , int* slot, int ph) {
    const unsigned* cnt = (const unsigned*)(WS_() + OFF_CTL) + CW_CNT2 + l * NCLS;
    if (tid_() < NCLS) s_cnt2[tid_()] = (int)cnt[tid_()];
    __syncthreads();
#pragma unroll 1
    for (int hop = 0; hop < 8; ++hop) {
        const int xq = (bid_() + hop) & 7;
        unsigned* ctr = (unsigned*)(WS_() + OFF_CTL) + CW_Q + ph * 8 + xq;
        int nblk = 0;
#pragma unroll 1
        for (int c = xq * 14; c < xq * 14 + 14; ++c) nblk += (s_cnt2[c] + 127) >> 7;
        const int nloc = nblk * 4;
        int it = q_pull(ctr, slot);
        while (it < nloc) {
            int nreg = 0;
            if (tid_() == 0) nreg = (int)atomicAdd(ctr, 1u);
            const int pass = it & 3;
            int ib = it >> 2, c = xq * 14;
#pragma unroll 1
            for (;;) { const int nb = (s_cnt2[c] + 127) >> 7; if (ib < nb) break; ib -= nb; c += 1; }
            moe2_item(p, l, c, ib, pass, s_cnt2[c], lds);
            it = q_publish(nreg, slot);
        }
    }
    __syncthreads();
}

DEV void ph_rowin(const Params& p, int l, bf16_t* lds, int* slot, int ph) {
    const int np = l == 0 ? 9 : 5, nci = 16 * np, ntot = nci + 1024;
    unsigned* ctr = (unsigned*)(WS_() + OFF_CTL) + CW_Q + ph * 8;
    const int w = tid_() >> 6;
    for (;;) {
        const int it = q_pull(ctr, slot);
        if (it >= ntot) break;
        if (it < nci) {
            const int rt = 512 + it / np, pass = it % np;
            for (int r = w * NRW; r < 128; r += 4 * NRW) { if (l == 0) rowop<0, true>(p, 0, rt * 128 + r); else rowop<1, false>(p, 1, rt * 128 + r); }
            asm volatile("s_waitcnt vmcnt(0)" ::: "memory");
            __syncthreads();
            __builtin_amdgcn_fence(__ATOMIC_ACQUIRE, "agent");
            inproj_item(p, l, rt, pass, lds);
        } else {
            const int r0 = (it - nci) * 64;
            for (int r = w * NRW; r < 64; r += 4 * NRW) { if (l == 0) rowop<0, true>(p, 0, r0 + r); else rowop<1, true>(p, 1, r0 + r); }
        }
    }
}
DEV void ph_inproj2(const Params& p, int l, bf16_t* lds, int* slot, int ph) {
    const int xcd = bid_() & 7;
    unsigned* ctr = (unsigned*)(WS_() + OFF_CTL) + CW_Q + ph * 8 + xcd;
    const int ntot = 2 + 768 + (l == 0 ? 32 : 0);
    int it = q_pull(ctr, slot);
    while (it < ntot) {
        int nreg = 0;
        if (tid_() == 0) nreg = (int)atomicAdd(ctr, 1u);
        if (it < 2) { rg_item(p, l, 512 + 2 * xcd + it, lds); }
        else if (it < 770) {
            const int q = it - 2, m = q >> 2, r = q & 3;
            if (r < 3) { const int i = m * 3 + r, sw = i / 192, rr = i - sw * 192; inproj_item(p, l, xcd * 64 + rr / 3, sw * 3 + rr % 3, lds); }
            else { __syncthreads(); expert_conv_item(p, l, xcd * 192 + m, (float*)lds); }
        }
        else { const int i = it - 770, w = tid_() >> 6;
            const int tk = i < 24 ? NTASK_NA + NTASK_GQ + (xcd * 24 + i) * 4 + w : NTASK_NA + NTASK_GQ + NTASK_CNA + (xcd * 8 + (i - 24)) * 4 + w;
            attn_task(p, l, tk, (const float*)lds); }
        it = q_publish(nreg, slot);
    }
}
DEV void ph_mixer(const Params& p, int l, bf16_t* lds, float* stat, int* slot, int ph) {
    const int xcd = bid_() & 7;
    unsigned* ctr = (unsigned*)(WS_() + OFF_CTL) + CW_Q + ph * 8 + xcd;
    const int n0 = l == 0 ? 2 : 0, n1 = n0 + 64, n2 = n1 + 256, n3 = n2 + 384, ntot = n3;
    bool rpb_ok = false;
    float* rpb2 = (float*)lds;
    int it = q_pull(ctr, slot);
    while (it < ntot) {
        int nreg = 0;
        if (tid_() == 0) nreg = (int)atomicAdd(ctr, 1u);
        if (it < n0) { outproj_item(p, l, 512 + 2 * xcd + it, lds, stat); rpb_ok = false; }
        else if (it < n1) { rg_item(p, l, xcd * 64 + (it - n0), lds); rpb_ok = false; }
        else if (it < n3) {
            if (!rpb_ok) { for (int i = tid_(); i < 6 * 15 * 31; i += 256) rpb2[i] = KP_(na_rpb)[(size_t)l * 6 * 15 * 31 + i] * LOG2E; __syncthreads(); rpb_ok = true; }
            const int w = tid_() >> 6;
            int tk;
            if (it < n2) { const int i = it - n1; tk = NTASK_NA + (2 * xcd + (i >> 7)) * 512 + (i & 127) * 4 + w; }
            else { const int i = it - n2; tk = (6 * xcd + (i >> 6)) * 256 + (i & 63) * 4 + w; }
            attn_task(p, l, tk, rpb2);
        }
        it = q_publish(nreg, slot);
    }
}

#define XB_TMO      128
#define XB_XCNT(j)  (256  + 64 * (j))
#define XB_XSUB(j)  (1280 + 64 * (j))
#define XB_XGEN(j)  (2304 + 64 * (j))
#define XB_TOP      3328
#define XB_TOPGEN   3392
#define XCD_BAR_WORDS 3456
#define XB_SPIN_CAP (1u << 20)
DEV unsigned xb_ld(unsigned* p) { return __hip_atomic_load(p, __ATOMIC_RELAXED, __HIP_MEMORY_SCOPE_AGENT); }
DEV unsigned xb_add(unsigned* p, unsigned v) { return __hip_atomic_fetch_add(p, v, __ATOMIC_RELAXED, __HIP_MEMORY_SCOPE_AGENT); }
DEV unsigned xb_xcc_id() { return (unsigned)__builtin_amdgcn_s_getreg((3 << 11) | 20) & 0xFu; }
#define XB_SPIN(cond, bar) do { unsigned _sp = 0; while (cond) { __builtin_amdgcn_s_sleep(1); \
    if ((++_sp & 255u) == 0u) { if (xb_ld(&(bar)[XB_TMO])) break; if (_sp > XB_SPIN_CAP) { atomicAdd(&(bar)[XB_TMO], 1u); break; } } } } while (0)
struct XcdBarrier { unsigned* bar; unsigned x; volatile LAS unsigned* st; };
DEV XcdBarrier xcd_barrier_post(unsigned* bar, volatile LAS unsigned* st) {
    XcdBarrier b; b.bar = bar; b.x = xb_xcc_id(); b.st = st;
    if (tid_() == 0) (void)xb_add(&bar[XB_XCNT(b.x)], 1u);
    return b;
}
DEV void xcd_barrier_complete(unsigned* bar, unsigned x, unsigned& nloc, unsigned& nx) {
    const unsigned G = gridDim.x * gridDim.y * gridDim.z;
    unsigned sum, cnt, mine, sp = 0u;
    for (;;) {
        sum = 0u; cnt = 0u; mine = 0u;
#pragma unroll
        for (unsigned j = 0; j < 16; ++j) { const unsigned c = xb_ld(&bar[XB_XCNT(j)]); sum += c; cnt += (c > 0u) ? 1u : 0u; mine = (j == x) ? c : mine; }
        if (sum == G) break;
        __builtin_amdgcn_s_sleep(1);
        if ((++sp & 255u) == 0u) { if (xb_ld(&bar[XB_TMO])) break; if (sp > XB_SPIN_CAP) { atomicAdd(&bar[XB_TMO], 1u); break; } }
    }
    nloc = mine > 0u ? mine : 1u; nx = cnt > 0u ? cnt : 1u;
}
DEV void xcd_barrier(const XcdBarrier& b) {
    asm volatile("s_waitcnt vmcnt(0)" ::: "memory");
    __syncthreads();
    if (tid_() == 0) {
        unsigned* bar = b.bar;
        __builtin_amdgcn_s_waitcnt(0);
        unsigned nloc = b.st[0], nx = b.st[1];
        if (nloc == 0u) { xcd_barrier_complete(bar, b.x, nloc, nx); b.st[0] = nloc; b.st[1] = nx; }
        const unsigned old = xb_add(&bar[XB_XSUB(b.x)], 1u);
        const unsigned gen = old / nloc;
        if (old + 1u == (gen + 1u) * nloc) {
            __builtin_amdgcn_fence(__ATOMIC_RELEASE, "agent");
            asm volatile("s_waitcnt vmcnt(0)" ::: "memory");
            const unsigned og = xb_add(&bar[XB_TOP], 1u);
            const unsigned tg = og / nx;
            if (og + 1u == (tg + 1u) * nx) xb_add(&bar[XB_TOPGEN], 1u);
            else XB_SPIN(xb_ld(&bar[XB_TOPGEN]) == tg, bar);
            __builtin_amdgcn_fence(__ATOMIC_ACQUIRE, "agent");
            xb_add(&bar[XB_XGEN(b.x)], 1u);
            asm volatile("s_waitcnt vmcnt(0)" ::: "memory");
        } else {
            XB_SPIN(xb_ld(&bar[XB_XGEN(b.x)]) == gen, bar);
            __builtin_amdgcn_fence(__ATOMIC_ACQUIRE, "agent");
            asm volatile("s_waitcnt vmcnt(0)" ::: "memory");
        }
    }
    __syncthreads();
}

namespace cg = cooperative_groups;
constexpr int SMEM_STAT = GEMM_LDS_BYTES;
constexpr int SMEM_BYTES = GEMM_LDS_BYTES + 2048 + 512;
constexpr int NPHASE = 14;
__global__ void __launch_bounds__(256, 2) mega(Params p, int ph_lo, int ph_hi) {
    extern __shared__ __attribute__((aligned(16))) unsigned char smem[];
    bf16_t* lds = (bf16_t*)smem;
    float* stat = (float*)(smem + SMEM_STAT);
    int* s_pref = (int*)(smem + SMEM_STAT + 2048); int* s_cnt = s_pref + 40;
    int* qslot = (int*)(smem + SMEM_STAT + 2048 + 416);
    volatile LAS unsigned* bst = (volatile LAS unsigned*)(LAS unsigned char*)(smem + SMEM_STAT + 2048 + 400);
    if (tid_() < 2) bst[tid_()] = 0u;
    __syncthreads();
    (void)xcd_barrier_post((unsigned*)(KP_(ws) + OFF_CTL + 4096), bst);
#define GRID_BAR() do { XcdBarrier xb_; xb_.bar = (unsigned*)(KP_(ws) + OFF_CTL + 4096); xb_.x = xb_xcc_id(); \
        xb_.st = (volatile LAS unsigned*)(LAS unsigned char*)(smem + SMEM_STAT + 2048 + 400); xcd_barrier(xb_); } while (0)
#define IN(k) (ph_lo <= (k) && (k) < ph_hi)
#define SEAM(k) do { if (IN(k) && IN((k) + 1)) { if ((k) == 0) cg::this_grid().sync(); else GRID_BAR(); } } while (0)
    if (IN(0)) {
        ph_mod(kp_(), (float*)smem); __syncthreads();
        ph_rope(kp_());
        ph_routerw(kp_());
        ph_rgprep(kp_());
        ph_transpose(KP_(w_in), (bf16_t*)(KP_(ws) + OFF_WINT), 1024, 2304, 0, 2, (size_t)1024 * 2304, (size_t)2304 * 1024, (float*)smem);
        ph_transpose(KP_(w_out), (bf16_t*)(KP_(ws) + OFF_WOUTT), 1024, 1024, 0, 2, (size_t)1024 * 1024, (size_t)1024 * 1024, (float*)smem);
    }
    SEAM(0);
#define LAYER_BODY(l, pb) { \
        if (IN(pb + 0)) ph_rowin(kp_(), l, lds, qslot, pb + 0); \
        SEAM(pb + 0); \
        if (IN(pb + 1)) ph_inproj2(kp_(), l, lds, qslot, pb + 1); \
        SEAM(pb + 1); \
        if (IN(pb + 2)) ph_mixer(kp_(), l, lds, stat, qslot, pb + 2); \
        SEAM(pb + 2); \
        if (IN(pb + 3)) ph_outproj(kp_(), l, lds, stat); \
        SEAM(pb + 3); \
        if (IN(pb + 4)) ph_moe1(kp_(), l, lds, s_cnt, qslot, pb + 4); \
        SEAM(pb + 4); \
        if (IN(pb + 5)) ph_moe2(kp_(), l, lds, (int*)stat, qslot, pb + 5); \
        SEAM(pb + 5); \
    }
    LAYER_BODY(0, 1)
    LAYER_BODY(1, 7)
#undef LAYER_BODY
    if (IN(NPHASE - 1)) ph_rowop<2>(kp_(), 2, NLAT);
#undef IN
#undef SEAM
}

#ifndef ONE_LAUNCH
#define ONE_LAUNCH 1
#endif
extern "C" void kernel_launch(void* const* d_in, const int* in_sizes, int n_in, void* d_out, int out_size, void* d_ws, size_t ws_size, hipStream_t stream) {
    if (n_in != 28 || ws_size < WS_TOTAL || out_size != NLAT * D) { fprintf(stderr, "kernel_launch: unexpected shapes / workspace (%d inputs, ws %zu need %zu)\n", n_in, ws_size, (size_t)WS_TOTAL); return; }
    static int grid = 0;
    if (grid == 0) {
        int dev = 0, cus = 0, per_cu = 0;
        (void)hipGetDevice(&dev);
        (void)hipDeviceGetAttribute(&cus, hipDeviceAttributeMultiprocessorCount, dev);
        (void)hipFuncSetAttribute((const void*)mega, hipFuncAttributeMaxDynamicSharedMemorySize, SMEM_BYTES);
        (void)hipOccupancyMaxActiveBlocksPerMultiprocessor(&per_cu, (const void*)mega, 256, SMEM_BYTES);
        if (per_cu > 2) per_cu = 2;
        grid = cus * per_cu;
        if (grid <= 0) { fprintf(stderr, "kernel_launch: occupancy query gave %d blocks per CU on %d CUs\n", per_cu, cus); grid = -1; }
    }
    if (grid < 0) return;
    Params p{};
    const float** pp = (const float**)&p;
    for (int i = 0; i < 28; ++i) pp[i] = (const float*)d_in[i];
    p.out = (float*)d_out; p.ws = (unsigned char*)d_ws;
    (void)hipMemsetAsync((unsigned char*)d_ws + OFF_CTL, 0, CTL_BYTES, stream);
#if ONE_LAUNCH
    int lo = 0, hi = NPHASE;
    void* args[] = {(void*)&p, (void*)&lo, (void*)&hi};
    hipError_t e = hipLaunchCooperativeKernel((const void*)mega, dim3(grid), dim3(256), args, SMEM_BYTES, stream);
    if (e != hipSuccess) fprintf(stderr, "kernel_launch: cooperative launch failed: %s (grid %d)\n", hipGetErrorString(e), grid);
#else
    for (int ph = 0; ph < NPHASE; ++ph) mega<<<grid, 256, SMEM_BYTES, stream>>>(p, ph, ph + 1);
#endif
}
```
